# Optimizing an MI355X kernel written in HIP

```python
import math
import jax, jax.numpy as jnp
from jax import lax
import numpy as np

D_MODEL = 2048
BATCH = 2
SEQ = 8192
DEPTH = 4
DEC_BATCH = 4
DEC_SEQ = 8192
PAST_LEN = 128

MIX_WIDTH = D_MODEL
HYENA_WIDTH = MIX_WIDTH // 2
ATTN_WIDTH = MIX_WIDTH - HYENA_WIDTH
N_HEADS = 8
HEAD_DIM = ATTN_WIDTH // (2 * N_HEADS)
V_HEAD_DIM = 2 * HEAD_DIM
HYENA_ORDER = 2
HYENA_IN = (HYENA_ORDER + 1) * HYENA_WIDTH
IN_WIDTH = HYENA_IN + 3 * ATTN_WIDTH
SHORT_CONV = 3
FILTER_EMB = 33
FILTER_BANDS = (FILTER_EMB - 1) // 2
FILTER_HIDDEN = 64
DECAY_TARGET = 1e-2
FAST_DECAY_PCT = 0.3
SLOW_DECAY_PCT = 1.5
MIN_DECAY = math.log(DECAY_TARGET) / FAST_DECAY_PCT
MAX_DECAY = math.log(DECAY_TARGET) / SLOW_DECAY_PCT
D_FF = (8 * D_MODEL + 3 * 256 - 1) // (3 * 256) * 256
ROPE_THETA = 10000.0
Q_BLOCK = 128
EPS = 1e-6

kernel_name = 'hymba_hyena_diffattn_encoder'


def rms_norm(x, g):
    xf = x.astype(jnp.float32)
    y = xf * lax.rsqrt(jnp.mean(xf * xf, axis=-1, keepdims=True) + EPS)
    return (y * g.astype(jnp.float32)).astype(x.dtype)


def rope_tables(L):
    inv_freq = 1.0 / (ROPE_THETA ** (jnp.arange(0, HEAD_DIM, 2, dtype=jnp.float32) / HEAD_DIM))
    ang = jnp.arange(L, dtype=jnp.float32)[:, None] * inv_freq[None, :]
    return jnp.cos(ang), jnp.sin(ang)


def apply_rope(x, cos, sin):
    x1, x2 = jnp.split(x, 2, axis=-1)
    c = cos[None, :, None, :]
    s = sin[None, :, None, :]
    return jnp.concatenate([x1 * c - x2 * s, x1 * s + x2 * c], axis=-1)


def short_conv(u, w, b):
    L = u.shape[1]
    pad = SHORT_CONV // 2
    up = jnp.pad(u, ((0, 0), (pad, pad), (0, 0)))
    out = b
    for j in range(SHORT_CONV):
        out = out + up[:, j:j + L] * w[j]
    return out


def hyena_filters(L, w1, b1, f1, w2, b2, f2, w3, b3, f3, w4):
    f32 = jnp.float32
    t = jnp.linspace(0.0, 1.0, L, dtype=f32)[:, None]
    omega = 2.0 * math.pi * jnp.arange(L, dtype=f32) / L
    bands = jnp.linspace(1e-4, FILTER_BANDS - 1, FILTER_BANDS, dtype=f32)
    phase = omega[:, None] * bands[None, :]
    z = jnp.concatenate([t, jnp.cos(phase), -jnp.sin(phase)], axis=-1)
    h = jnp.sin(f1.astype(f32) * (z @ w1.astype(f32) + b1.astype(f32)))
    h = jnp.sin(f2.astype(f32) * (h @ w2.astype(f32) + b2.astype(f32)))
    h = jnp.sin(f3.astype(f32) * (h @ w3.astype(f32) + b3.astype(f32)))
    h = (h @ w4.astype(f32)).reshape(L, HYENA_ORDER, 2, HYENA_WIDTH)
    deltas = jnp.abs(jnp.linspace(MIN_DECAY, MAX_DECAY, HYENA_WIDTH, dtype=f32))
    h = h * jnp.exp(-t * deltas[None, :])[:, None, None, :]
    fwd = h[:, :, 0]
    bwd = h[:, :, 1]
    k = jnp.concatenate([fwd[:1] + bwd[:1], fwd[1:], jnp.zeros_like(fwd[:1]), bwd[:0:-1]], axis=0)
    return jnp.fft.rfft(k, axis=0)


def long_conv(u, k_f, bias):
    L = u.shape[1]
    u_f = jnp.fft.rfft(u, n=2 * L, axis=1)
    y = jnp.fft.irfft(u_f * k_f[None], n=2 * L, axis=1)[:, :L]
    return y + u * bias


def diff_attention(q, k, v, lam, lam_init, subln):
    B, L = q.shape[0], q.shape[1]
    n_blocks = L // Q_BLOCK
    scale = HEAD_DIM ** -0.5
    q_blocks = q.reshape(B, n_blocks, Q_BLOCK, 2 * N_HEADS, HEAD_DIM).transpose(1, 0, 2, 3, 4)

    def one_block(qb):
        s = jnp.einsum('bqhd,bkhd->bhqk', qb, k) * scale
        p = jax.nn.softmax(s, axis=-1).reshape(B, N_HEADS, 2, Q_BLOCK, L)
        a = p[:, :, 0] - lam * p[:, :, 1]
        return jnp.einsum('bhqk,bkhe->bqhe', a, v)

    o = lax.map(one_block, q_blocks)
    o = o.transpose(1, 0, 2, 3, 4).reshape(B, L, N_HEADS, V_HEAD_DIM)
    o = rms_norm(o, subln) * (1.0 - lam_init)
    return o.reshape(B, L, ATTN_WIDTH)


def encoder_layer(x, cos, sin, lam_init, g_mix_pre, g_mix_post, g_ffn_pre, g_ffn_post,
                  w_in, conv_w, conv_b, filt_w1, filt_b1, filt_f1, filt_w2, filt_b2, filt_f2,
                  filt_w3, filt_b3, filt_f3, filt_w4, hyena_bias, hyena_norm,
                  lam_q1, lam_k1, lam_q2, lam_k2, subln, w_out, w_gate, w_up, w_down):
    f32 = jnp.float32
    B, L, _ = x.shape
    h = rms_norm(x, g_mix_pre)
    proj = h @ w_in
    hy, q, k, v = jnp.split(proj, [HYENA_IN, HYENA_IN + ATTN_WIDTH, HYENA_IN + 2 * ATTN_WIDTH], axis=-1)

    u = short_conv(hy.astype(f32), conv_w.astype(f32), conv_b.astype(f32))
    x1, x2, hv = jnp.split(u, 3, axis=-1)
    k_f = hyena_filters(L, filt_w1, filt_b1, filt_f1, filt_w2, filt_b2, filt_f2,
                        filt_w3, filt_b3, filt_f3, filt_w4)
    z = x1 * long_conv(hv, k_f[:, 0], hyena_bias[0].astype(f32))
    z = x2 * long_conv(z, k_f[:, 1], hyena_bias[1].astype(f32))
    hy_out = rms_norm(z, hyena_norm).astype(x.dtype)

    q = apply_rope(q.astype(f32).reshape(B, L, 2 * N_HEADS, HEAD_DIM), cos, sin)
    k = apply_rope(k.astype(f32).reshape(B, L, 2 * N_HEADS, HEAD_DIM), cos, sin)
    v = v.astype(f32).reshape(B, L, N_HEADS, V_HEAD_DIM)
    lam = (jnp.exp(jnp.sum(lam_q1.astype(f32) * lam_k1.astype(f32)))
           - jnp.exp(jnp.sum(lam_q2.astype(f32) * lam_k2.astype(f32))) + lam_init)
    at_out = diff_attention(q, k, v, lam, lam_init, subln).astype(x.dtype)

    mix = jnp.concatenate([hy_out, at_out], axis=-1) @ w_out
    x = x + rms_norm(mix, g_mix_post)

    h = rms_norm(x, g_ffn_pre)
    ff = (jax.nn.silu(h @ w_gate) * (h @ w_up)) @ w_down
    return x + rms_norm(ff, g_ffn_post)


def run_trunk(x, weights):
    (norm_mix_pre, norm_mix_post, norm_ffn_pre, norm_ffn_post, w_in, conv_w, conv_b,
     filt_w1, filt_b1, filt_f1, filt_w2, filt_b2, filt_f2, filt_w3, filt_b3, filt_f3, filt_w4,
     hyena_bias, hyena_norm, lam_q1, lam_k1, lam_q2, lam_k2, subln,
     w_out, w_gate, w_up, w_down) = weights
    L = x.shape[1]
    cos, sin = rope_tables(L)
    for li in range(DEPTH):
        lam_init = 0.8 - 0.6 * math.exp(-0.3 * li)
        x = encoder_layer(x, cos, sin, lam_init,
                          norm_mix_pre[li], norm_mix_post[li], norm_ffn_pre[li], norm_ffn_post[li],
                          w_in[li], conv_w[li], conv_b[li],
                          filt_w1[li], filt_b1[li], filt_f1[li], filt_w2[li], filt_b2[li], filt_f2[li],
                          filt_w3[li], filt_b3[li], filt_f3[li], filt_w4[li],
                          hyena_bias[li], hyena_norm[li],
                          lam_q1[li], lam_k1[li], lam_q2[li], lam_k2[li], subln[li],
                          w_out[li], w_gate[li], w_up[li], w_down[li])
    return x


def setup_inputs(seed: int = 0) -> dict:
    key = jax.random.key(seed)
    ks = jax.random.split(key, 32)
    f32 = jnp.float32

    def nrm(k, shape, scale):
        return jax.random.normal(k, shape, f32) * scale

    def gain(k, n):
        return 1.0 + 0.02 * jax.random.normal(k, (DEPTH, n), f32)

    return {
        'x_prompt': nrm(ks[0], (BATCH, SEQ, D_MODEL), 1.0),
        'x_sample': nrm(ks[1], (DEC_BATCH, DEC_SEQ, D_MODEL), 1.0),
        'norm_mix_pre': gain(ks[2], D_MODEL),
        'norm_mix_post': gain(ks[3], D_MODEL),
        'norm_ffn_pre': gain(ks[4], D_MODEL),
        'norm_ffn_post': gain(ks[5], D_MODEL),
        'w_in': nrm(ks[6], (DEPTH, D_MODEL, IN_WIDTH), D_MODEL ** -0.5),
        'conv_w': nrm(ks[7], (DEPTH, SHORT_CONV, HYENA_IN), SHORT_CONV ** -0.5),
        'conv_b': nrm(ks[8], (DEPTH, HYENA_IN), 0.02),
        'filt_w1': nrm(ks[9], (DEPTH, FILTER_EMB, FILTER_HIDDEN), FILTER_EMB ** -0.5),
        'filt_b1': nrm(ks[10], (DEPTH, FILTER_HIDDEN), 0.02),
        'filt_f1': 1.0 + 0.1 * jax.random.normal(ks[11], (DEPTH, FILTER_HIDDEN), f32),
        'filt_w2': nrm(ks[12], (DEPTH, FILTER_HIDDEN, FILTER_HIDDEN), FILTER_HIDDEN ** -0.5),
        'filt_b2': nrm(ks[13], (DEPTH, FILTER_HIDDEN), 0.02),
        'filt_f2': 1.0 + 0.1 * jax.random.normal(ks[14], (DEPTH, FILTER_HIDDEN), f32),
        'filt_w3': nrm(ks[15], (DEPTH, FILTER_HIDDEN, FILTER_HIDDEN), FILTER_HIDDEN ** -0.5),
        'filt_b3': nrm(ks[16], (DEPTH, FILTER_HIDDEN), 0.02),
        'filt_f3': 1.0 + 0.1 * jax.random.normal(ks[17], (DEPTH, FILTER_HIDDEN), f32),
        'filt_w4': nrm(ks[18], (DEPTH, FILTER_HIDDEN, HYENA_ORDER * 2 * HYENA_WIDTH), FILTER_HIDDEN ** -0.5),
        'hyena_bias': nrm(ks[19], (DEPTH, HYENA_ORDER, HYENA_WIDTH), 1.0),
        'hyena_norm': gain(ks[20], HYENA_WIDTH),
        'lam_q1': nrm(ks[21], (DEPTH, HEAD_DIM), 0.1),
        'lam_k1': nrm(ks[22], (DEPTH, HEAD_DIM), 0.1),
        'lam_q2': nrm(ks[23], (DEPTH, HEAD_DIM), 0.1),
        'lam_k2': nrm(ks[24], (DEPTH, HEAD_DIM), 0.1),
        'subln': gain(ks[25], V_HEAD_DIM),
        'w_out': nrm(ks[26], (DEPTH, MIX_WIDTH, D_MODEL), MIX_WIDTH ** -0.5),
        'w_gate': nrm(ks[27], (DEPTH, D_MODEL, D_FF), D_MODEL ** -0.5),
        'w_up': nrm(ks[28], (DEPTH, D_MODEL, D_FF), D_MODEL ** -0.5),
        'w_down': nrm(ks[29], (DEPTH, D_FF, D_MODEL), D_FF ** -0.5),
    }


def reference(x_prompt, x_sample, norm_mix_pre, norm_mix_post, norm_ffn_pre, norm_ffn_post,
              w_in, conv_w, conv_b, filt_w1, filt_b1, filt_f1, filt_w2, filt_b2, filt_f2,
              filt_w3, filt_b3, filt_f3, filt_w4, hyena_bias, hyena_norm,
              lam_q1, lam_k1, lam_q2, lam_k2, subln, w_out, w_gate, w_up, w_down):
    weights = (norm_mix_pre, norm_mix_post, norm_ffn_pre, norm_ffn_post, w_in, conv_w, conv_b,
               filt_w1, filt_b1, filt_f1, filt_w2, filt_b2, filt_f2, filt_w3, filt_b3, filt_f3, filt_w4,
               hyena_bias, hyena_norm, lam_q1, lam_k1, lam_q2, lam_k2, subln,
               w_out, w_gate, w_up, w_down)
    y_prompt = run_trunk(x_prompt, weights)
    y_sample = run_trunk(x_sample, weights)
    return (y_prompt, y_sample)
```

```cpp
#include <hip/hip_runtime.h>
#include <hip/hip_bf16.h>
#include <cstdio>
#include <cstdint>
#include <cmath>
namespace pg8 {
#define PG8_LAS __attribute__((address_space(3)))
typedef unsigned short bf16_t;
typedef short bf16x8 __attribute__((ext_vector_type(8)));
typedef float f32x4 __attribute__((ext_vector_type(4)));
typedef unsigned u32x4 __attribute__((ext_vector_type(4)));
constexpr int BM = 256, BK = 64, HALF = 128, HTB = HALF * BK * 2  , STAGE_BYTES = 8 * HTB, NXCD = 8, WGM = 8;

__host__ __device__ __forceinline__ int lds_byte(int r, int c) { const int st = (r >> 4) * 2 + (c >> 5), rr = r & 15, cc = c & 31, ob = rr * 64 + cc * 2; return st * 1024 + (ob ^ (((ob >> 9) & 1) << 5)); }
__host__ __device__ __forceinline__ void stage_rc(int b, int& R, int& C) { const int st = b / 1024, sb = b % 1024, swz = sb ^ (((sb >> 9) & 1) << 5); R = (st >> 1) * 16 + swz / 64; C = (st & 1) * 32 + (swz % 64) / 2; }
__host__ __device__ __forceinline__ int perm32(int rho) { const int n = rho >> 4, i = rho & 15; return 8 * (i >> 2) + 4 * n + (i & 3); }

struct Unit { int pm, pn; };
struct Gemm { const bf16_t* A; const bf16_t* Bt; int M, N, K; };

struct StaticOrder {
    int nM, nN, nwg, G, c;
    __host__ __device__ void init(int M, int N, int G_, int c_) { nM = M / BM; nN = N / BM; nwg = nM * nN; G = G_; c = c_; }
    __host__ __device__ bool next(int i, Unit& u) const {
        const long L = (long)i * G + c; if (L >= nwg) return false;
        int wgid = (int)L; { const int q = nwg / NXCD, r = nwg % NXCD, xcd = wgid % NXCD, off = wgid / NXCD; wgid = (xcd < r ? xcd * (q + 1) : r * (q + 1) + (xcd - r) * q) + off; }
        const int nig = WGM * nN, gid = wgid / nig, fm = gid * WGM, gsz = (nM - fm) < WGM ? (nM - fm) : WGM;
        u.pm = fm + ((wgid % nig) % gsz); u.pn = (wgid % nig) / gsz; return true;
    }
    __device__ __forceinline__ void a_ready(const Unit&) const {}
    __device__ __forceinline__ void done(const Unit&) const {}
};

__device__ __forceinline__ unsigned cvt_pk_bf16(float lo, float hi) { unsigned r; asm volatile("v_cvt_pk_bf16_f32 %0, %1, %2" : "=v"(r) : "v"(lo), "v"(hi)); return r; }
typedef float f32x2 __attribute__((ext_vector_type(2)));
struct EpiPlain {
    static constexpr bool PERM = true, AFTER_DRAIN = false;
    bf16_t* O; int ldc;
    __device__ __forceinline__ void operator()(const f32x4 (&acc)[2][2][4][2], const Unit& u, int wr, int wc, int fr, int fq) const {
        const int row0 = u.pm * BM + wr * 64 + fr, col0 = u.pn * BM + wc * 32 + 8 * fq;
#pragma unroll
        for (int ai = 0; ai < 2; ++ai)
#pragma unroll
            for (int m = 0; m < 4; ++m) { bf16_t* rowp = O + (size_t)(row0 + ai * HALF + m * 16) * ldc + col0;
#pragma unroll
                for (int bj = 0; bj < 2; ++bj) { const f32x4 v0 = acc[ai][bj][m][0], v1 = acc[ai][bj][m][1];
                    u32x4 w; w.x = cvt_pk_bf16(v0[0], v0[1]); w.y = cvt_pk_bf16(v0[2], v0[3]); w.z = cvt_pk_bf16(v1[0], v1[1]); w.w = cvt_pk_bf16(v1[2], v1[3]);
                    *(u32x4*)(rowp + bj * HALF) = w; } }
    }
};
struct EpiRope {
    static constexpr bool PERM = true, AFTER_DRAIN = false;
    bf16_t* O; int ldc; const float* cs; float qscale;
    __device__ __forceinline__ void operator()(const f32x4 (&acc)[2][2][4][2], const Unit& u, int wr, int wc, int fr, int fq) const {
        const int row0 = u.pm * BM + wr * 64 + fr, col0 = u.pn * BM + wc * 32 + 8 * fq;
        const bool rope = u.pn < 8; const float sc = u.pn < 4 ? qscale : 1.0f;
        const int p0 = 16 * (wc & 1) + 4 * fq;
#pragma unroll
        for (int ai = 0; ai < 2; ++ai)
#pragma unroll
            for (int m = 0; m < 4; ++m) { const int row = row0 + ai * HALF + m * 16; bf16_t* rowp = O + (size_t)row * ldc + col0;
                f32x4 t0 = {1.f, 0.f, 1.f, 0.f}, t1 = {1.f, 0.f, 1.f, 0.f};
                if (rope) { const float* tp = cs + ((size_t)(row & 8191) * 32 + p0) * 2; t0 = *(const f32x4*)tp; t1 = *(const f32x4*)(tp + 4); }
#pragma unroll
                for (int bj = 0; bj < 2; ++bj) { const f32x4 v0 = acc[ai][bj][m][0], v1 = acc[ai][bj][m][1];
                    f32x4 o0, o1;
                    o0[0] = (v0[0] * t0[0] - v0[1] * t0[1]) * sc; o0[1] = (v0[0] * t0[1] + v0[1] * t0[0]) * sc;
                    o0[2] = (v0[2] * t0[2] - v0[3] * t0[3]) * sc; o0[3] = (v0[2] * t0[3] + v0[3] * t0[2]) * sc;
                    o1[0] = (v1[0] * t1[0] - v1[1] * t1[1]) * sc; o1[1] = (v1[0] * t1[1] + v1[1] * t1[0]) * sc;
                    o1[2] = (v1[2] * t1[2] - v1[3] * t1[3]) * sc; o1[3] = (v1[2] * t1[3] + v1[3] * t1[2]) * sc;
                    u32x4 w; w.x = cvt_pk_bf16(o0[0], o0[1]); w.y = cvt_pk_bf16(o0[2], o0[3]); w.z = cvt_pk_bf16(o1[0], o1[1]); w.w = cvt_pk_bf16(o1[2], o1[3]);
                    *(u32x4*)(rowp + bj * HALF) = w; } }
    }
};
struct EpiSwiGLU {
    static constexpr bool PERM = true, AFTER_DRAIN = false;
    bf16_t* O; int ldc;
    static __device__ __forceinline__ float silu_mul(float g, float u) { return g * u * __builtin_amdgcn_rcpf(1.0f + __builtin_amdgcn_exp2f(-1.4426950408889634f * g)); }
    __device__ __forceinline__ void operator()(const f32x4 (&acc)[2][2][4][2], const Unit& u, int wr, int wc, int fr, int fq) const {
        const int row0 = u.pm * BM + wr * 64 + fr, col0 = u.pn * HALF + wc * 32 + 8 * fq;
#pragma unroll
        for (int ai = 0; ai < 2; ++ai)
#pragma unroll
            for (int m = 0; m < 4; ++m) { bf16_t* rowp = O + (size_t)(row0 + ai * HALF + m * 16) * ldc + col0;
                const f32x4 g0 = acc[ai][0][m][0], g1 = acc[ai][0][m][1], u0 = acc[ai][1][m][0], u1 = acc[ai][1][m][1];
                u32x4 w; w.x = cvt_pk_bf16(silu_mul(g0[0], u0[0]), silu_mul(g0[1], u0[1])); w.y = cvt_pk_bf16(silu_mul(g0[2], u0[2]), silu_mul(g0[3], u0[3]));
                w.z = cvt_pk_bf16(silu_mul(g1[0], u1[0]), silu_mul(g1[1], u1[1])); w.w = cvt_pk_bf16(silu_mul(g1[2], u1[2]), silu_mul(g1[3], u1[3]));
                *(u32x4*)rowp = w; }
    }
};
template <class Epi, class Sched, bool ALIGN_EPI = false, bool SP2 = false>
__device__ __forceinline__ void gemm_phase(PG8_LAS unsigned char* lds, const Gemm g, const Sched& S, const Epi& E) {
    int tid = threadIdx.x; asm volatile("" : "+v"(tid));
    const int wid = __builtin_amdgcn_readfirstlane(tid >> 6), lane = tid & 63, wr = wid >> 2, wc = wid & 3, fr = lane & 15, fq = lane >> 4;
    const int K = g.K, nt = K / BK;
    unsigned voffA[2], voffB[2];
#pragma unroll
    for (int i = 0; i < 2; ++i) { int R, C; stage_rc(tid * 16 + i * 8192, R, C); const int Rb = Epi::PERM ? ((R & ~31) + perm32(R & 31)) : R;
        voffA[i] = (unsigned)(R * K + C) * 2u; voffB[i] = (unsigned)(Rb * K + C) * 2u; }
    const size_t kstep = (size_t)(BK * 2);
    const size_t hstep = (size_t)HALF * K * 2;
    const size_t tstep = 2 * hstep;
    const unsigned ldsw = (unsigned)wid * 1024u;
    const int aoff = lds_byte(wr * 64 + fr, fq * 8), boff = lds_byte(wc * 32 + fr, fq * 8);
#define PG8_SA(b, h) (((b) * 2 + (h)) * HTB)
#define PG8_SB(b, h) ((4 + (b) * 2 + (h)) * HTB)
#define PG8_STAGE(bufoff, gbase, voff) do { _Pragma("unroll") for (int _i = 0; _i < 2; ++_i) \
        __builtin_amdgcn_global_load_lds((const unsigned*)((const char*)(gbase) + (voff)[_i]), (PG8_LAS unsigned*)(lds + (bufoff) + ldsw + _i * 8192), 16, 0, 0); } while (0)
#define PG8_LDA(dst, b, h) do { _Pragma("unroll") for (int m = 0; m < 4; ++m) _Pragma("unroll") for (int k = 0; k < 2; ++k) dst[m][k] = *(const PG8_LAS bf16x8*)(lds + PG8_SA(b, h) + aoff + m * 2048 + k * 1024); } while (0)
#define PG8_LDB(dst, b, h) do { _Pragma("unroll") for (int n = 0; n < 2; ++n) _Pragma("unroll") for (int k = 0; k < 2; ++k) dst[n][k] = *(const PG8_LAS bf16x8*)(lds + PG8_SB(b, h) + boff + n * 2048 + k * 1024); } while (0)
#define PG8_MMA(ai, bj, At, Bt) do { __builtin_amdgcn_s_setprio(1); _Pragma("unroll") for (int m = 0; m < 4; ++m) _Pragma("unroll") for (int n = 0; n < 2; ++n) _Pragma("unroll") for (int k = 0; k < 2; ++k) \
        acc[ai][bj][m][n] = __builtin_amdgcn_mfma_f32_16x16x32_bf16(Bt[n][k], At[m][k], acc[ai][bj][m][n], 0, 0, 0); __builtin_amdgcn_s_setprio(0); } while (0)
#define PG8_WAIT_V(n) asm volatile("s_waitcnt vmcnt(" #n ")" ::: "memory")
#define PG8_WAIT_L(n) asm volatile("s_waitcnt lgkmcnt(" #n ")" ::: "memory")
#define PG8_BAR __builtin_amdgcn_s_barrier()
#define PG8_SCHED __builtin_amdgcn_sched_barrier(0)
    Unit cur, nxt; int ui = 0;
    if (!S.next(0, cur)) return;
    f32x4 acc[2][2][4][2];
#pragma unroll
    for (int a = 0; a < 2; ++a)
#pragma unroll
        for (int b = 0; b < 2; ++b)
#pragma unroll
            for (int m = 0; m < 4; ++m)
#pragma unroll
                for (int n = 0; n < 2; ++n) acc[a][b][m][n] = (f32x4){0.f, 0.f, 0.f, 0.f};
    bf16x8 At[4][2], B0[2][2], B1[2][2];
    const char* cA = (const char*)g.A + (size_t)cur.pm * tstep; const char* cB = (const char*)g.Bt + (size_t)cur.pn * tstep;
    S.a_ready(cur);
    if constexpr (SP2) {
        PG8_STAGE(PG8_SB(0, 0), cB, voffB); PG8_STAGE(PG8_SB(0, 1), cB + hstep, voffB); PG8_STAGE(PG8_SA(0, 0), cA, voffA); PG8_STAGE(PG8_SA(0, 1), cA + hstep, voffA);
        if (wr == 1) PG8_BAR;
        PG8_WAIT_V(2); PG8_BAR;
        PG8_STAGE(PG8_SB(1, 0), cB + kstep, voffB); PG8_STAGE(PG8_SA(1, 0), cA + kstep, voffA); PG8_STAGE(PG8_SB(1, 1), cB + hstep + kstep, voffB);
        PG8_WAIT_V(6); PG8_BAR;
    } else {
        PG8_STAGE(PG8_SB(0, 0), cB, voffB); PG8_STAGE(PG8_SA(0, 0), cA, voffA); PG8_STAGE(PG8_SB(0, 1), cB + hstep, voffB); PG8_STAGE(PG8_SA(0, 1), cA + hstep, voffA);
        if (wr == 1) PG8_BAR;
        PG8_WAIT_V(4); PG8_BAR;
        PG8_STAGE(PG8_SB(1, 0), cB + kstep, voffB); PG8_STAGE(PG8_SA(1, 0), cA + kstep, voffA); PG8_STAGE(PG8_SB(1, 1), cB + hstep + kstep, voffB);
        PG8_WAIT_V(6); PG8_BAR;
    }
    for (;;) {
        const bool has_next = S.next(ui + 1, nxt);
        const char* nA = has_next ? (const char*)g.A + (size_t)nxt.pm * tstep : cA; const char* nB = has_next ? (const char*)g.Bt + (size_t)nxt.pn * tstep : cB;
        for (int t = 0; t < nt; t += 2) {
            const bool last = (t == nt - 2);
            const char* a1 = cA + (size_t)(t + 1) * kstep;
            const char* a2 = last ? nA : cA + (size_t)(t + 2) * kstep; const char* b2 = last ? nB : cB + (size_t)(t + 2) * kstep;
            const char* a3 = a2 + kstep; const char* b3 = b2 + kstep;
            if (last && has_next) S.a_ready(nxt);
            if constexpr (SP2) {
            PG8_LDB(B0, 0, 0); PG8_LDB(B1, 0, 1); PG8_SCHED; PG8_LDA(At, 0, 0); PG8_STAGE(PG8_SA(1, 1), a1 + hstep, voffA);
            PG8_WAIT_V(8); PG8_WAIT_L(0); PG8_BAR; PG8_MMA(0, 0, At, B0); PG8_MMA(0, 1, At, B1); PG8_BAR; PG8_SCHED;
            PG8_LDA(At, 0, 1); PG8_STAGE(PG8_SB(0, 0), b2, voffB); PG8_STAGE(PG8_SB(0, 1), b2 + hstep, voffB); PG8_STAGE(PG8_SA(0, 0), a2, voffA);
            PG8_WAIT_V(8); PG8_WAIT_L(0); PG8_BAR; PG8_MMA(1, 0, At, B0); PG8_MMA(1, 1, At, B1); PG8_BAR; PG8_SCHED;
            PG8_LDB(B0, 1, 0); PG8_LDB(B1, 1, 1); PG8_SCHED; PG8_LDA(At, 1, 0); PG8_STAGE(PG8_SA(0, 1), a2 + hstep, voffA);
            PG8_WAIT_V(8); PG8_WAIT_L(0); PG8_BAR; PG8_MMA(0, 0, At, B0); PG8_MMA(0, 1, At, B1); PG8_BAR; PG8_SCHED;
            PG8_LDA(At, 1, 1); PG8_STAGE(PG8_SB(1, 0), b3, voffB); PG8_STAGE(PG8_SB(1, 1), b3 + hstep, voffB); PG8_STAGE(PG8_SA(1, 0), a3, voffA);
            PG8_WAIT_V(8); PG8_WAIT_L(0); PG8_BAR; PG8_MMA(1, 0, At, B0); PG8_MMA(1, 1, At, B1); PG8_BAR; PG8_SCHED;
            } else {
            PG8_LDB(B0, 0, 0); PG8_SCHED; PG8_LDA(At, 0, 0); PG8_STAGE(PG8_SA(1, 1), a1 + hstep, voffA);
            PG8_WAIT_L(8); PG8_BAR; PG8_WAIT_L(0); PG8_MMA(0, 0, At, B0); PG8_BAR; PG8_SCHED;
            PG8_LDB(B1, 0, 1); PG8_STAGE(PG8_SB(0, 0), b2, voffB);
            PG8_BAR; PG8_WAIT_L(0); PG8_MMA(0, 1, At, B1); PG8_BAR;
            PG8_LDA(At, 0, 1); PG8_STAGE(PG8_SA(0, 0), a2, voffA);
            PG8_BAR; PG8_WAIT_L(0); PG8_MMA(1, 0, At, B0); PG8_BAR; PG8_SCHED;
            PG8_STAGE(PG8_SB(0, 1), b2 + hstep, voffB);
            PG8_WAIT_V(6); PG8_BAR; PG8_MMA(1, 1, At, B1); PG8_BAR;
            PG8_LDB(B0, 1, 0); PG8_SCHED; PG8_LDA(At, 1, 0); PG8_STAGE(PG8_SA(0, 1), a2 + hstep, voffA);
            PG8_WAIT_L(8); PG8_BAR; PG8_WAIT_L(0); PG8_MMA(0, 0, At, B0); PG8_BAR; PG8_SCHED;
            PG8_LDB(B1, 1, 1); PG8_STAGE(PG8_SB(1, 0), b3, voffB);
            PG8_BAR; PG8_WAIT_L(0); PG8_MMA(0, 1, At, B1); PG8_BAR;
            PG8_LDA(At, 1, 1); PG8_STAGE(PG8_SA(1, 0), a3, voffA);
            PG8_BAR; PG8_WAIT_L(0); PG8_MMA(1, 0, At, B0); PG8_BAR; PG8_SCHED;
            PG8_STAGE(PG8_SB(1, 1), b3 + hstep, voffB);
            PG8_WAIT_V(6); PG8_BAR; PG8_MMA(1, 1, At, B1); PG8_BAR;
            }
        }
        if constexpr (ALIGN_EPI) { if (wr == 0) PG8_BAR; }
        if constexpr (!Epi::AFTER_DRAIN) { E(acc, cur, wr, wc, fr, fq); S.done(cur); }
        if (!has_next) break;
#pragma unroll
        for (int a = 0; a < 2; ++a)
#pragma unroll
            for (int b = 0; b < 2; ++b)
#pragma unroll
                for (int m = 0; m < 4; ++m)
#pragma unroll
                    for (int n = 0; n < 2; ++n) acc[a][b][m][n] = (f32x4){0.f, 0.f, 0.f, 0.f};
        cur = nxt; cA = nA; cB = nB; ++ui;
        if constexpr (ALIGN_EPI) { if (wr == 1) PG8_BAR; }
    }
    PG8_WAIT_V(0);
    if constexpr (!ALIGN_EPI) { if (wr == 0) PG8_BAR; }
    PG8_BAR;
    if constexpr (Epi::AFTER_DRAIN) { E.fused(acc, cur, wr, wc, fr, fq, lds, wid, lane); S.done(cur); }
#undef PG8_SA
#undef PG8_SB
#undef PG8_STAGE
#undef PG8_LDA
#undef PG8_LDB
#undef PG8_MMA
#undef PG8_WAIT_V
#undef PG8_WAIT_L
#undef PG8_BAR
#undef PG8_SCHED
}
}
namespace att {
using bf16x8 = __attribute__((ext_vector_type(8))) short;
using s16x4  = __attribute__((ext_vector_type(4))) short;
using f32x16 = __attribute__((ext_vector_type(16))) float;
using u32x4  = __attribute__((ext_vector_type(4))) unsigned;
typedef unsigned short bf16;
constexpr int DQ = 64, DV = 128, NW = 8, QBLK = 32, KVBLK = 64, LDR = 3072;
constexpr int SHM_V = KVBLK * DV * 2, SHM_K = KVBLK * DQ * 2, SHM_ATTN = 2 * SHM_V + 2 * SHM_K + NW * 64 * 4;
constexpr float THR2 = 11.0f;
#define KSWZ64(row, colB) ((row) * 128 + ((colB) ^ ((((row) >> 1) & 7) << 4)))
#define SBAR() __builtin_amdgcn_sched_barrier(0)
template <int K> __device__ __forceinline__ float sx(float v) { return __builtin_bit_cast(float, __builtin_amdgcn_ds_swizzle(__builtin_bit_cast(int, v), (K << 10) | 0x1f)); }
__device__ __forceinline__ int crow(int r, int hi) { return (r & 3) + 8 * (r >> 2) + 4 * hi; }
__device__ __forceinline__ unsigned cvtpk(float lo, float hi) { unsigned r; asm volatile("v_cvt_pk_bf16_f32 %0, %1, %2" : "=v"(r) : "v"(lo), "v"(hi)); return r; }
__device__ __forceinline__ void partialSM(f32x16& p0, f32x16& p1, float& m_reg, float& mn, float& alpha) {
  float pmax = p0[0];
#pragma unroll
  for (int r = 1; r < 16; ++r) pmax = fmaxf(pmax, p0[r]);
#pragma unroll
  for (int r = 0; r < 16; ++r) pmax = fmaxf(pmax, p1[r]);
  { auto rr = __builtin_amdgcn_permlane32_swap(__float_as_uint(pmax), __float_as_uint(pmax), false, false);
    pmax = fmaxf(__uint_as_float(rr[0]), __uint_as_float(rr[1])); }
  if (__builtin_expect(__all(pmax - m_reg <= THR2), 1)) { mn = m_reg; alpha = 1.f; }
  else { mn = fmaxf(m_reg, pmax); alpha = __builtin_amdgcn_exp2f(m_reg - mn); m_reg = mn; }
#pragma unroll
  for (int r = 0; r < 16; ++r) p0[r] = p0[r] - mn;
#pragma unroll
  for (int r = 0; r < 16; ++r) p1[r] = p1[r] - mn;
#pragma unroll
  for (int r = 0; r < 16; ++r) p0[r] = __builtin_amdgcn_exp2f(p0[r]);
}
__device__ __forceinline__ void finishSM(f32x16& p0, f32x16& p1, float alpha, float& l_reg, bf16x8& pa0, bf16x8& pa1, bf16x8& pa2, bf16x8& pa3) {
#pragma unroll
  for (int r = 0; r < 16; ++r) p1[r] = __builtin_amdgcn_exp2f(p1[r]);
  float ps = 0;
#pragma unroll
  for (int r = 0; r < 16; ++r) ps += p0[r];
#pragma unroll
  for (int r = 0; r < 16; ++r) ps += p1[r];
  { auto rr = __builtin_amdgcn_permlane32_swap(__float_as_uint(ps), __float_as_uint(ps), false, false);
    ps = __uint_as_float(rr[0]) + __uint_as_float(rr[1]); }
  l_reg = l_reg * alpha + ps;
#define PK4(P, BASE, OUT) do { unsigned a0 = cvtpk(P[BASE + 0], P[BASE + 1]), a1 = cvtpk(P[BASE + 2], P[BASE + 3]);   \
    unsigned b0 = cvtpk(P[BASE + 4], P[BASE + 5]), b1 = cvtpk(P[BASE + 6], P[BASE + 7]);                              \
    auto r0 = __builtin_amdgcn_permlane32_swap(a0, b0, false, false); auto r1 = __builtin_amdgcn_permlane32_swap(a1, b1, false, false); \
    u32x4 w = {r0[0], r1[0], r0[1], r1[1]}; OUT = *reinterpret_cast<bf16x8*>(&w); } while (0)
  PK4(p0, 0, pa0); PK4(p0, 8, pa1); PK4(p1, 0, pa2); PK4(p1, 8, pa3);
#undef PK4
}
__device__ __forceinline__ void qkt(f32x16& p0, f32x16& p1, const char* Ks, const bf16x8* qr, int r32, int hi) {
  p0 = f32x16{}; p1 = f32x16{};
#pragma unroll
  for (int d0 = 0; d0 < 4; ++d0) { const int cb = (d0 * 16 + hi * 8) * 2;
    bf16x8 b0 = *reinterpret_cast<const bf16x8*>(Ks + KSWZ64(r32, cb));
    bf16x8 b1 = *reinterpret_cast<const bf16x8*>(Ks + KSWZ64(32 + r32, cb));
    p0 = __builtin_amdgcn_mfma_f32_32x32x16_bf16(b0, qr[d0], p0, 0, 0, 0);
    p1 = __builtin_amdgcn_mfma_f32_32x32x16_bf16(b1, qr[d0], p1, 0, 0, 0); }
}
__device__ __forceinline__ int v_st(int k, int c) { const int kk = (k & ~0xC) | ((k & 4) << 1) | ((k & 8) >> 1); return ((kk >> 3) * 4 + (c >> 5)) * 512 + ((kk & 7) * 32 + (c & 31)) * 2; }
__device__ __forceinline__ int v_rd_base(int lane) { return ((lane & 3) << 3) | (((lane >> 2) & 3) << 6) | (((lane >> 4) & 1) << 5) | (((lane >> 5) & 1) << 8); }
constexpr int v_rd_off(int d0, int ks, int half) { return d0 * 512 + ks * 4096 + half * 2048; }
template <int OFF> __device__ __forceinline__ s16x4 tr_read(int vb) {
  s16x4 r; asm volatile("ds_read_b64_tr_b16 %0, %1 offset:%2" : "=&v"(r) : "v"(vb), "i"(OFF) : "memory"); return r;
}
template <int D0> __device__ __forceinline__ void pv_one(f32x16& od, int vb, bf16x8 pa0, bf16x8 pa1, bf16x8 pa2, bf16x8 pa3) {
  const s16x4 l0 = tr_read<v_rd_off(D0, 0, 0)>(vb), h0 = tr_read<v_rd_off(D0, 0, 1)>(vb), l1 = tr_read<v_rd_off(D0, 1, 0)>(vb), h1 = tr_read<v_rd_off(D0, 1, 1)>(vb);
  const s16x4 l2 = tr_read<v_rd_off(D0, 2, 0)>(vb), h2 = tr_read<v_rd_off(D0, 2, 1)>(vb), l3 = tr_read<v_rd_off(D0, 3, 0)>(vb), h3 = tr_read<v_rd_off(D0, 3, 1)>(vb);
  asm volatile("s_waitcnt lgkmcnt(0)" ::: "memory"); SBAR();
#define PK(L, H) (bf16x8){L[0], L[1], L[2], L[3], H[0], H[1], H[2], H[3]}
  od = __builtin_amdgcn_mfma_f32_32x32x16_bf16(pa0, PK(l0, h0), od, 0, 0, 0);
  od = __builtin_amdgcn_mfma_f32_32x32x16_bf16(pa1, PK(l1, h1), od, 0, 0, 0);
  od = __builtin_amdgcn_mfma_f32_32x32x16_bf16(pa2, PK(l2, h2), od, 0, 0, 0);
  od = __builtin_amdgcn_mfma_f32_32x32x16_bf16(pa3, PK(l3, h3), od, 0, 0, 0);
#undef PK
}
__device__ __forceinline__ void pv_d0(f32x16* o, int vb, bf16x8 pa0, bf16x8 pa1, bf16x8 pa2, bf16x8 pa3) {
  pv_one<0>(o[0], vb, pa0, pa1, pa2, pa3); pv_one<1>(o[1], vb, pa0, pa1, pa2, pa3); pv_one<2>(o[2], vb, pa0, pa1, pa2, pa3); pv_one<3>(o[3], vb, pa0, pa1, pa2, pa3);
}
__device__ __forceinline__ void attn_unit(const bf16* __restrict__ qkv, long Qrow0, long Krow0, int vh, int seq, float lam, float oscale, const float* __restrict__ subln,
                                          bf16* __restrict__ Ob, int ldo, float* stash, char* lds) {
  int tid = threadIdx.x; asm volatile("" : "+v"(tid));
  const int wid = __builtin_amdgcn_readfirstlane(tid >> 6), lane = tid & 63, r32 = lane & 31, hi = lane >> 5;
  char* V_lds = lds; char* K_lds = lds + 2 * SHM_V;
  float* ws = (float*)(lds + 2 * SHM_V + 2 * SHM_K) + wid * 64; float* li_l = ws; float* al_l = ws + 32;
  const int sr = tid >> 4, sc = (tid & 15) * 8, vst0 = v_st(sr, sc), vst1 = v_st(32 + sr, sc);
  const int kr = tid >> 3, kc = (tid & 7) * 8, kst = KSWZ64(kr, kc * 2);
  const int vb0 = (int)(uintptr_t)V_lds + v_rd_base(lane);
  const bf16* Vh = qkv + Krow0 * LDR + 2048 + vh * DV;
  for (int s = 0; s < 2; ++s) {
    const int head = 2 * vh + s;
    const bf16* Kh = qkv + Krow0 * LDR + 1024 + head * DQ;
    const bf16* Qw = qkv + (Qrow0 + wid * QBLK + r32) * LDR + head * DQ + hi * 8;
    float m_reg = -1e30f, l_reg = 0; f32x16 o[4] = {}; bf16x8 qr[4];
#pragma unroll
    for (int d0 = 0; d0 < 4; ++d0) qr[d0] = *reinterpret_cast<const bf16x8*>(Qw + d0 * 16);
    struct { bf16x8 vs0, vs1, ks0; } sr_[2];
#define SLOAD(i, k0) do { sr_[i].vs0 = *reinterpret_cast<const bf16x8*>(&Vh[(long)((k0) + sr) * LDR + sc]); sr_[i].vs1 = *reinterpret_cast<const bf16x8*>(&Vh[(long)((k0) + 32 + sr) * LDR + sc]); \
    sr_[i].ks0 = *reinterpret_cast<const bf16x8*>(&Kh[(long)((k0) + kr) * LDR + kc]); } while (0)
#define SWRITE(b, i) do { *(bf16x8*)(V_lds + (b) * SHM_V + vst0) = sr_[i].vs0; *(bf16x8*)(V_lds + (b) * SHM_V + vst1) = sr_[i].vs1; \
    *(bf16x8*)(K_lds + (b) * SHM_K + kst) = sr_[i].ks0; } while (0)
#define SWAIT() asm volatile("s_waitcnt vmcnt(3)" ::: "memory")
#define RESC(a) do { if (__any((a) < 1.f)) { if (hi == 0) al_l[r32] = (a); asm volatile("s_waitcnt lgkmcnt(0)" ::: "memory"); \
    _Pragma("unroll") for (int d = 0; d < 4; ++d) _Pragma("unroll") for (int r = 0; r < 16; ++r) o[d][r] *= al_l[crow(r, hi)]; } } while (0)
    f32x16 pA0, pA1, pB0, pB1; float mnA, mnB, alA, alB; bf16x8 pa0, pa1, pa2, pa3; const int NT = seq / KVBLK;
    constexpr int SE = 0, SO = 1;
    SLOAD(SE, 0); asm volatile("s_waitcnt vmcnt(0)" ::: "memory"); SWRITE(0, SE); __syncthreads();
    qkt(pA0, pA1, K_lds, qr, r32, hi); partialSM(pA0, pA1, m_reg, mnA, alA);
    SLOAD(SO, KVBLK); if (2 < NT) SLOAD(SE, 2 * KVBLK);
    SWAIT(); SWRITE(1, SO); __syncthreads();
    for (int j = 1; j + 1 < NT; j += 2) {
      SBAR(); qkt(pB0, pB1, K_lds + SHM_K, qr, r32, hi);
      finishSM(pA0, pA1, alA, l_reg, pa0, pa1, pa2, pa3); SBAR();
      SLOAD(SO, (j + 2) * KVBLK); SBAR();
      pv_d0(o, vb0, pa0, pa1, pa2, pa3); partialSM(pB0, pB1, m_reg, mnB, alB);
      __syncthreads(); SWAIT(); SWRITE(0, SE);
      RESC(alB); __syncthreads();
      SBAR(); qkt(pA0, pA1, K_lds, qr, r32, hi);
      finishSM(pB0, pB1, alB, l_reg, pa0, pa1, pa2, pa3); SBAR();
      if (j + 3 < NT) SLOAD(SE, (j + 3) * KVBLK); SBAR();
      pv_d0(o, vb0 + SHM_V, pa0, pa1, pa2, pa3); partialSM(pA0, pA1, m_reg, mnA, alA);
      __syncthreads(); SWAIT(); SWRITE(1, SO);
      RESC(alA); __syncthreads();
    }
    SBAR(); qkt(pB0, pB1, K_lds + SHM_K, qr, r32, hi);
    finishSM(pA0, pA1, alA, l_reg, pa0, pa1, pa2, pa3); SBAR();
    pv_d0(o, vb0, pa0, pa1, pa2, pa3); partialSM(pB0, pB1, m_reg, mnB, alB);
    __syncthreads(); RESC(alB);
    finishSM(pB0, pB1, alB, l_reg, pa0, pa1, pa2, pa3); SBAR();
    pv_d0(o, vb0 + SHM_V, pa0, pa1, pa2, pa3);
#undef SLOAD
#undef SWRITE
#undef SWAIT
#undef RESC
    if (hi == 0) li_l[r32] = l_reg; asm volatile("s_waitcnt lgkmcnt(0)" ::: "memory");
    float rli[16];
#pragma unroll
    for (int r = 0; r < 16; ++r) rli[r] = __builtin_amdgcn_rcpf(li_l[crow(r, hi)]);
    typedef float f32x4_t __attribute__((ext_vector_type(4)));
    f32x4_t* st4 = (f32x4_t*)stash + (size_t)tid * 16;
    if (s == 0) {
#pragma unroll
      for (int d0 = 0; d0 < 4; ++d0)
#pragma unroll
        for (int r4 = 0; r4 < 4; ++r4) { f32x4_t v; v[0] = o[d0][4 * r4] * rli[4 * r4]; v[1] = o[d0][4 * r4 + 1] * rli[4 * r4 + 1]; v[2] = o[d0][4 * r4 + 2] * rli[4 * r4 + 2]; v[3] = o[d0][4 * r4 + 3] * rli[4 * r4 + 3]; st4[d0 * 4 + r4] = v; }
    } else {
      float ssq[16];
#pragma unroll
      for (int r = 0; r < 16; ++r) ssq[r] = 0.f;
#pragma unroll
      for (int d0 = 0; d0 < 4; ++d0)
#pragma unroll
        for (int r4 = 0; r4 < 4; ++r4) { const f32x4_t sv = st4[d0 * 4 + r4];
#pragma unroll
          for (int i = 0; i < 4; ++i) { const int r = 4 * r4 + i; const float v = sv[i] - lam * (o[d0][r] * rli[r]); o[d0][r] = v; ssq[r] += v * v; } }
#pragma unroll
      for (int r = 0; r < 16; ++r) {
        float a = ssq[r];
        a += sx<1>(a); a += sx<2>(a); a += sx<4>(a); a += sx<8>(a); a += sx<16>(a);
        ssq[r] = oscale / sqrtf(a * (1.0f / 128.0f) + 1e-6f);
      }
      float g[4];
#pragma unroll
      for (int d0 = 0; d0 < 4; ++d0) g[d0] = subln[d0 * 32 + r32];
      bf16* Ow = Ob + (long)(wid * QBLK) * ldo;
      unsigned voff = (unsigned)(hi * 4 * ldo + r32);
      asm volatile("" : "+v"(voff));
#pragma unroll
      for (int r = 0; r < 16; ++r) {
#pragma unroll
        for (int d0 = 0; d0 < 4; ++d0) { const unsigned w = cvtpk(o[d0][r] * ssq[r] * g[d0], 0.f); (Ow + ((r & 3) + 8 * (r >> 2)) * ldo + d0 * 32)[voff] = (bf16)(w & 0xffffu); } }
    }
  }
}
#undef SBAR
}
#define GAS __attribute__((address_space(1)))
#define LAS __attribute__((address_space(3)))
typedef unsigned short bf16;
typedef unsigned v4u __attribute__((ext_vector_type(4)));
typedef float f32x4 __attribute__((ext_vector_type(4)));
typedef short bf16x8 __attribute__((ext_vector_type(8)));
typedef GAS unsigned gu32;
typedef GAS unsigned long long gu64;
#define RLX_AGENT __ATOMIC_RELAXED, __HIP_MEMORY_SCOPE_AGENT
#define LDS_WAIT() asm volatile("s_waitcnt lgkmcnt(0)" ::: "memory")
#define VM_WAIT() asm volatile("s_waitcnt vmcnt(0)" ::: "memory")
__device__ __forceinline__ unsigned long long rt() { return __builtin_amdgcn_s_memrealtime(); }
__device__ __forceinline__ unsigned f2bf(float f) { unsigned u = __builtin_bit_cast(unsigned, f); return (u + 0x7fffu + ((u >> 16) & 1u)) >> 16; }
__device__ __forceinline__ unsigned pk2(float lo, float hi) { return f2bf(lo) | (f2bf(hi) << 16); }

#define XB_TMO      128
#define XB_XCNT(j)  (256  + 64 * (j))
#define XB_XSUB(j)  (1280 + 64 * (j))
#define XB_XGEN(j)  (2304 + 64 * (j))
#define XB_TOP      3328
#define XB_TOPGEN   3392
#define XCD_BAR_WORDS 3456
#define XB_SPIN_CAP (1u << 18)

__device__ __forceinline__ unsigned xb_ld(unsigned* p)              { return __hip_atomic_load(p, __ATOMIC_RELAXED, __HIP_MEMORY_SCOPE_AGENT); }
__device__ __forceinline__ unsigned xb_add(unsigned* p, unsigned v) { return __hip_atomic_fetch_add(p, v, __ATOMIC_RELAXED, __HIP_MEMORY_SCOPE_AGENT); }
__device__ __forceinline__ unsigned xb_xcc_id() { return (unsigned)__builtin_amdgcn_s_getreg((3 << 11) | 20) & 0xFu; }
#define XB_SPIN(cond, bar) do { unsigned _sp = 0; while (cond) { __builtin_amdgcn_s_sleep(1); \
    if ((++_sp & 255u) == 0u) { if (xb_ld(&(bar)[XB_TMO])) break; if (_sp > XB_SPIN_CAP) { atomicAdd(&(bar)[XB_TMO], 1u); break; } } } } while (0)

struct XcdBarrier {
    unsigned* bar; unsigned x;
    volatile LAS unsigned* st;
};

__device__ __forceinline__ XcdBarrier xcd_barrier_post(unsigned* bar, volatile LAS unsigned* st) {
    XcdBarrier b; b.bar = bar; b.x = xb_xcc_id(); b.st = st;
    if (threadIdx.x == 0) (void)xb_add(&bar[XB_XCNT(b.x)], 1u);
    return b;
}
__device__ __forceinline__ void xcd_barrier_complete(unsigned* bar, unsigned x, unsigned& nloc, unsigned& nx) {
    const unsigned G = gridDim.x * gridDim.y * gridDim.z;
    unsigned sum, cnt, mine, sp = 0u;
    for (;;) {
        sum = 0u; cnt = 0u; mine = 0u;
#pragma unroll
        for (unsigned j = 0; j < 16; ++j) { const unsigned c = xb_ld(&bar[XB_XCNT(j)]); sum += c; cnt += (c > 0u) ? 1u : 0u; mine = (j == x) ? c : mine; }
        if (sum == G) break;
        __builtin_amdgcn_s_sleep(1);
        if ((++sp & 255u) == 0u) { if (xb_ld(&bar[XB_TMO])) break; if (sp > XB_SPIN_CAP) { atomicAdd(&bar[XB_TMO], 1u); break; } }
    }
    nloc = mine > 0u ? mine : 1u; nx = cnt > 0u ? cnt : 1u;
}

__device__ __forceinline__ void xcd_barrier(const XcdBarrier& b) {
    asm volatile("s_waitcnt vmcnt(0)" ::: "memory");
    __syncthreads();
    if (threadIdx.x == 0) {
        unsigned* bar = b.bar;
        __builtin_amdgcn_s_waitcnt(0);
        unsigned nloc = b.st[0], nx = b.st[1];
        if (nloc == 0u) { xcd_barrier_complete(bar, b.x, nloc, nx); b.st[0] = nloc; b.st[1] = nx; }
        const unsigned old = xb_add(&bar[XB_XSUB(b.x)], 1u);
        const unsigned gen = old / nloc;
        if (old + 1u == (gen + 1u) * nloc) {
            __builtin_amdgcn_fence(__ATOMIC_RELEASE, "agent");
            asm volatile("s_waitcnt vmcnt(0)" ::: "memory");
            const unsigned og = xb_add(&bar[XB_TOP], 1u);
            const unsigned tg = og / nx;
            if (og + 1u == (tg + 1u) * nx) xb_add(&bar[XB_TOPGEN], 1u);
            else XB_SPIN(xb_ld(&bar[XB_TOPGEN]) == tg, bar);
            __builtin_amdgcn_fence(__ATOMIC_ACQUIRE, "agent");
            xb_add(&bar[XB_XGEN(b.x)], 1u);
            asm volatile("s_waitcnt vmcnt(0)" ::: "memory");
        } else {
            XB_SPIN(xb_ld(&bar[XB_XGEN(b.x)]) == gen, bar);
            __builtin_amdgcn_fence(__ATOMIC_ACQUIRE, "agent");
            asm volatile("s_waitcnt vmcnt(0)" ::: "memory");
        }
    }
    __syncthreads();
}
#define HYD __device__ __forceinline__
#define HYDM __device__ __forceinline__
typedef float cf __attribute__((ext_vector_type(2)));
HYD cf cf_add(cf a, cf b) { return cf{a.x + b.x, a.y + b.y}; }
HYD cf cf_sub(cf a, cf b) { return cf{a.x - b.x, a.y - b.y}; }
HYD cf cf_mul(cf a, cf b) { return cf{a.x * b.x - a.y * b.y, a.x * b.y + a.y * b.x}; }
HYD cf cf_mulc(cf a, cf b) { return cf{a.x * b.x + a.y * b.y, a.y * b.x - a.x * b.y}; }
constexpr int FN = 16384, FT = 512, FLOG = 14;
#define HY_C1 0.92387953251128674f
#define HY_S1 0.38268343236508977f
#define HY_R2 0.70710678118654752f
template <int M16> HYD cf root16() {
    if (M16 == 0) return cf{1.f, 0.f};
    if (M16 == 1) return cf{HY_C1, -HY_S1};
    if (M16 == 2) return cf{HY_R2, -HY_R2};
    if (M16 == 3) return cf{HY_S1, -HY_C1};
    if (M16 == 4) return cf{0.f, -1.f};
    if (M16 == 5) return cf{-HY_S1, -HY_C1};
    if (M16 == 6) return cf{-HY_R2, -HY_R2};
    return cf{-HY_C1, -HY_S1};
}
template <int Q, int U, bool INV> struct HyStage {
    static HYDM void run(cf (&e)[1 << Q], const cf (&tw)[Q]) {
        constexpr int R = 1 << Q, half = R >> (U + 1);
#pragma unroll
        for (int k = 0; k < R; ++k) {
            if ((k & half) == 0) {
                const int kp = k & (half - 1);
                cf w = tw[U];
                switch (kp * 16 / (2 * half)) {
                    case 0: break;
                    case 1: w = cf_mul(w, root16<1>()); break;
                    case 2: w = cf_mul(w, root16<2>()); break;
                    case 3: w = cf_mul(w, root16<3>()); break;
                    case 4: w = cf_mul(w, root16<4>()); break;
                    case 5: w = cf_mul(w, root16<5>()); break;
                    case 6: w = cf_mul(w, root16<6>()); break;
                    default: w = cf_mul(w, root16<7>()); break;
                }
                if (!INV) { const cf a = e[k], b = e[k + half]; e[k] = cf_add(a, b); e[k + half] = cf_mul(cf_sub(a, b), w); }
                else      { const cf a = e[k], b = cf_mulc(e[k + half], w); e[k] = cf_add(a, b); e[k + half] = cf_sub(a, b); }
            }
        }
    }
};
template <int Q, bool INV> HYD void hy_bfly(cf (&e)[1 << Q], cf t) {
    cf tw[Q]; tw[0] = t;
#pragma unroll
    for (int u = 1; u < Q; ++u) tw[u] = cf_mul(tw[u - 1], tw[u - 1]);
    if (Q == 4) {
        if (!INV) { HyStage<Q, 0, INV>::run(e, tw); HyStage<Q, 1, INV>::run(e, tw); HyStage<Q, 2 % Q, INV>::run(e, tw); HyStage<Q, 3 % Q, INV>::run(e, tw); }
        else      { HyStage<Q, 3 % Q, INV>::run(e, tw); HyStage<Q, 2 % Q, INV>::run(e, tw); HyStage<Q, 1, INV>::run(e, tw); HyStage<Q, 0, INV>::run(e, tw); }
    } else {
        if (!INV) { HyStage<Q, 0, INV>::run(e, tw); HyStage<Q, 1, INV>::run(e, tw); }
        else      { HyStage<Q, 1, INV>::run(e, tw); HyStage<Q, 0, INV>::run(e, tw); }
    }
}
template <class PT> HYD cf hy_twid(PT thi, PT tlo, int e) { return cf_mul(thi[e >> 7], tlo[e & 127]); }
template <int Q, int S, bool INV, class P, class PT, class PK>
HYD void hy_pass(P X, PT thi, PT tlo, int tid, PK KM) {
    constexpr int R = 1 << Q, NG = FN / R;
#pragma unroll 1
    for (int g = tid; g < NG; g += FT) {
        const int lo = g & (S - 1), hi = g / S, base = hi * S * R + lo;
        cf t = cf{1.f, 0.f};
        if (S > 1) t = hy_twid(thi, tlo, lo * (FN / (R * S)));
        cf e[R];
#pragma unroll
        for (int k = 0; k < R; ++k) e[k] = X[base + k * S];
        hy_bfly<Q, INV>(e, t);
        if (KM) {
#pragma unroll
            for (int k = 0; k < R; ++k) e[k] = cf_mul(e[k], KM[base + k * S]);
        }
#pragma unroll
        for (int k = 0; k < R; ++k) X[base + k * S] = e[k];
    }
}
HYD int hy_brev14(int p) {
    unsigned v = (unsigned)p;
    v = ((v >> 1) & 0x55555555u) | ((v & 0x55555555u) << 1);
    v = ((v >> 2) & 0x33333333u) | ((v & 0x33333333u) << 2);
    v = ((v >> 4) & 0x0F0F0F0Fu) | ((v & 0x0F0F0F0Fu) << 4);
    v = ((v >> 8) & 0x00FF00FFu) | ((v & 0x00FF00FFu) << 8);
    v = (v >> 16) | (v << 16);
    return (int)(v >> (32 - FLOG));
}
template <class P> HYD void hy_separate(P X, int p, float sc, cf& k1, cf& k2) {
    const int f = hy_brev14(p), q = hy_brev14((FN - f) & (FN - 1));
    const cf a = X[p], b = X[q];
    k1 = cf{(a.x + b.x) * 0.5f * sc, (a.y - b.y) * 0.5f * sc};
    k2 = cf{(a.y + b.y) * 0.5f * sc, -(a.x - b.x) * 0.5f * sc};
}
HYD float hy_bf2f(unsigned short b) { unsigned u = (unsigned)b << 16; float f; __builtin_memcpy(&f, &u, 4); return f; }
template <class PR> HYD void hy_sconv2(PR rowj  , unsigned tid, int j, float w0, float w1, float w2, float b, float& u0, float& u1) {
    const unsigned d1 = rowj[tid];
    const unsigned d0 = (j > 0 || tid > 0) ? (rowj - 1)[tid] : 0u;
    const unsigned d2 = (j < 7 || tid < (unsigned)(FT - 1)) ? (rowj + 1)[tid] : 0u;
    const float pm1 = hy_bf2f((unsigned short)(d0 >> 16)), p0 = hy_bf2f((unsigned short)(d1 & 0xffffu)), p1 = hy_bf2f((unsigned short)(d1 >> 16)), p2 = hy_bf2f((unsigned short)(d2 & 0xffffu));
    u0 = b + w0 * pm1 + w1 * p0 + w2 * p1;
    u1 = b + w0 * p0 + w1 * p1 + w2 * p2;
}
HYD unsigned hy_f2bf(float f) { unsigned u; __builtin_memcpy(&u, &f, 4); return (u + 0x7fffu + ((u >> 16) & 1u)) >> 16; }
constexpr int SEQL = 8192;
template <class P, class PW> HYD void hy_filter_step(P X, const float* h3, PW w4s, float delta, int tid) {
#pragma unroll 1
    for (int j = 0; j < SEQL / FT; ++j) {
        const int t = tid + FT * j;
        const float* hr = h3 + (size_t)t * 64;
        float a0 = 0.f, a1 = 0.f, a2 = 0.f, a3 = 0.f;
#pragma unroll 16
        for (int i = 0; i < 64; ++i) { const float hv = hr[i]; a0 += hv * w4s[i * 4 + 0]; a1 += hv * w4s[i * 4 + 1]; a2 += hv * w4s[i * 4 + 2]; a3 += hv * w4s[i * 4 + 3]; }
        const float dec = expf(-((float)t * (1.0f / (float)(SEQL - 1))) * delta);
        a0 *= dec; a1 *= dec; a2 *= dec; a3 *= dec;
        if (t == 0) { X[0] = cf{a0 + a1, a2 + a3}; X[SEQL] = cf{0.f, 0.f}; }
        else { X[t] = cf{a0, a2}; X[FN - t] = cf{a1, a3}; }
    }
}
template <class P> HYD void hy_sep_step(P X, cf* K1g, cf* K2g, int tid) {
#pragma unroll 1
    for (int j = 0; j < FN / FT; ++j) { const int p = tid + FT * j; cf k1, k2; hy_separate(X, p, 1.0f / (float)FN, k1, k2); K1g[p] = k1; K2g[p] = k2; }
}
template <class P> HYD void hy_load_step(P X, const unsigned* r0, const unsigned* r1, float w0, float w1, float w2, float b, float (&zr)[8][4], int tid) {
#pragma unroll
    for (int j = 0; j < 8; ++j) {
        const int t = 2 * (tid + FT * j);
        hy_sconv2(r0 + FT * j, (unsigned)tid, j, w0, w1, w2, b, zr[j][0], zr[j][2]);
        hy_sconv2(r1 + FT * j, (unsigned)tid, j, w0, w1, w2, b, zr[j][1], zr[j][3]);
        X[t] = cf{zr[j][0], zr[j][1]}; X[t + 1] = cf{zr[j][2], zr[j][3]};
        X[SEQL + t] = cf{0.f, 0.f}; X[SEQL + t + 1] = cf{0.f, 0.f};
    }
}
template <class P> HYD void hy_gate1_step(P X, const unsigned* r0, const unsigned* r1, float w0, float w1, float w2, float b, float bias, float (&zr)[8][4], int tid) {
#pragma unroll
    for (int j = 0; j < 8; ++j) {
        const int t = 2 * (tid + FT * j);
        float xa0, xa1, xb0, xb1;
        hy_sconv2(r0 + FT * j, (unsigned)tid, j, w0, w1, w2, b, xa0, xa1);
        hy_sconv2(r1 + FT * j, (unsigned)tid, j, w0, w1, w2, b, xb0, xb1);
        const cf y0 = X[t], y1 = X[t + 1];
        zr[j][0] = xa0 * (y0.x + zr[j][0] * bias); zr[j][1] = xb0 * (y0.y + zr[j][1] * bias);
        zr[j][2] = xa1 * (y1.x + zr[j][2] * bias); zr[j][3] = xb1 * (y1.y + zr[j][3] * bias);
        X[t] = cf{zr[j][0], zr[j][1]}; X[t + 1] = cf{zr[j][2], zr[j][3]};
        X[SEQL + t] = cf{0.f, 0.f}; X[SEQL + t + 1] = cf{0.f, 0.f};
    }
}
template <class P> HYD void hy_gate2_step(P X, const unsigned* r0, const unsigned* r1, float w0, float w1, float w2, float b, float bias, const float (&zr)[8][4], unsigned* out0, unsigned* out1, int tid) {
#pragma unroll
    for (int j = 0; j < 8; ++j) {
        const int t = 2 * (tid + FT * j);
        float xa0, xa1, xb0, xb1;
        hy_sconv2(r0 + FT * j, (unsigned)tid, j, w0, w1, w2, b, xa0, xa1);
        hy_sconv2(r1 + FT * j, (unsigned)tid, j, w0, w1, w2, b, xb0, xb1);
        const cf y0 = X[t], y1 = X[t + 1];
        const float za0 = xa0 * (y0.x + zr[j][0] * bias), zb0 = xb0 * (y0.y + zr[j][1] * bias);
        const float za1 = xa1 * (y1.x + zr[j][2] * bias), zb1 = xb1 * (y1.y + zr[j][3] * bias);
        (out0 + FT * j)[(unsigned)tid] = hy_f2bf(za0) | (hy_f2bf(za1) << 16);
        (out1 + FT * j)[(unsigned)tid] = hy_f2bf(zb0) | (hy_f2bf(zb1) << 16);
    }
}
constexpr int NWAVES = 8, NTHR = NWAVES * 64;
constexpr int DM = 2048, SEQ = 8192, DEPTH = 4, NSEQ = 6, GSEQ = 2, NGRP = NSEQ / GSEQ, MG = GSEQ * SEQ;
constexpr int HYW = 1024, HYIN = 3072, QKVW = 3072, DFF = 5632, GU = 2 * DFF, FEMB = 33, FHID = 64;
constexpr float EPS = 1e-6f;
constexpr float QSCALE = 0.125f * 1.4426950408889634f;
constexpr size_t MiB = 1u << 20;
constexpr size_t WS_CTL = 0, CTL_ZERO_BYTES = 1 * MiB;
constexpr size_t SZ_WHY = (size_t)HYIN * DM * 2, SZ_WQKV = (size_t)QKVW * DM * 2, SZ_WOUT = (size_t)DM * DM * 2, SZ_WGU = (size_t)GU * DM * 2, SZ_WDN = (size_t)DM * DFF * 2;
constexpr size_t OFF_WHY = 0, OFF_WQKV = OFF_WHY + SZ_WHY, OFF_WOUT = OFF_WQKV + SZ_WQKV, OFF_WGU = OFF_WOUT + SZ_WOUT, OFF_WDN = OFF_WGU + SZ_WGU, SZ_WLAYER = OFF_WDN + SZ_WDN;
constexpr size_t WS_W = 1 * MiB;
constexpr size_t WS_ROPE = WS_W + DEPTH * SZ_WLAYER;
constexpr size_t WS_H3 = WS_ROPE + (size_t)SEQ * 32 * 8;
constexpr size_t WS_FFTK = WS_H3 + (size_t)DEPTH * SEQ * FHID * 4;
constexpr size_t WS_STASH = WS_FFTK + (size_t)256 * 2 * 16384 * 8;
constexpr size_t WS_H = WS_STASH + (size_t)256 * 64 * 512 * 4;
constexpr size_t WS_ZT = WS_H + (size_t)MG * DM * 2;
constexpr size_t WS_PROJT = WS_ZT + (size_t)HYW * MG * 2;
constexpr size_t WS_QKV = WS_PROJT + (size_t)HYIN * MG * 2;
constexpr size_t WS_MIX = WS_PROJT;
constexpr size_t WS_FFH = WS_PROJT;
constexpr size_t WS_MIXIN = WS_QKV + (size_t)MG * QKVW * 2;
constexpr size_t WS_END = WS_MIXIN + (size_t)MG * DM * 2;
static_assert((size_t)MG * DFF * 2 <= (size_t)HYIN * MG * 2 + (size_t)MG * QKVW * 2, "FFH overlay fits PROJT|QKV");
static_assert(WS_ROPE % 256 == 0 && WS_H3 % 256 == 0 && WS_FFTK % 256 == 0 && WS_STASH % 256 == 0 && WS_H % 256 == 0 && SZ_WLAYER % 256 == 0, "alignment");
constexpr int CW_BAR = 4096;
constexpr int PH_PER_LAYER = 8, PH_PER_GROUP = 1 + DEPTH * PH_PER_LAYER, NPHASE = 1 + NGRP * PH_PER_GROUP;
constexpr int RING_OFF = 0, RING_BYTES = 131072;
constexpr int TAB_OFF = RING_BYTES;
constexpr int MISC_OFF = RING_BYTES + 4096;
constexpr int LDS_BYTES = 147456;
static_assert(MISC_OFF + 128 <= LDS_BYTES, "LDS map");
#ifndef MK_PER_PHASE
#define MK_PER_PHASE 0
#endif

struct Args { const float* in[30]; float* out; unsigned char* ws; int ph_lo, ph_hi; };
enum { I_XP = 0, I_XS, I_GMPRE, I_GMPOST, I_GFPRE, I_GFPOST, I_WIN, I_CONVW, I_CONVB, I_FW1, I_FB1, I_FF1, I_FW2, I_FB2, I_FF2, I_FW3, I_FB3, I_FF3, I_FW4,
       I_HBIAS, I_HNORM, I_LQ1, I_LK1, I_LQ2, I_LK2, I_SUBLN, I_WOUT, I_WGATE, I_WUP, I_WDOWN };

template <int K> __device__ __forceinline__ float swz_xor(float v) { return __builtin_bit_cast(float, __builtin_amdgcn_ds_swizzle(__builtin_bit_cast(int, v), (K << 10) | 0x1f)); }
__device__ __forceinline__ float wave_sum(float v) {
    v += swz_xor<1>(v); v += swz_xor<2>(v); v += swz_xor<4>(v); v += swz_xor<8>(v); v += swz_xor<16>(v);
    auto rr = __builtin_amdgcn_permlane32_swap(__float_as_uint(v), __float_as_uint(v), false, false);
    return __uint_as_float(rr[0]) + __uint_as_float(rr[1]);
}
__device__ __forceinline__ bf16* wt_dst_row(int kind, int n, bf16* d0, bf16* d1, int K) {
    if (kind == 0) return d0 + (size_t)n * K;
    if (kind == 1) { if (n < HYIN) return d0 + (size_t)n * K; int q = n - HYIN; if (q < 2048) { const int hb = q & ~63, i = q & 63; q = hb + (i < 32 ? 2 * i : 2 * (i - 32) + 1); } return d1 + (size_t)q * K; }
    const int r = (n >> 7) * 256 + (n & 127) + (kind == 3 ? 128 : 0); return d0 + (size_t)r * K;
}
__device__ __forceinline__ void p0_transpose_item(const float* W, int K, int N, int kind, bf16* d0, bf16* d1, LAS float* scr, int item, int lane) {
    const int nblk = N / 32, kb = item / nblk, nb = item % nblk, k0 = 64 * kb, n0 = 32 * nb;
#pragma unroll 8
    for (int i = 0; i < 32; ++i) { const int kk = 2 * i + (lane >> 5); scr[kk * 33 + (lane & 31)] = W[(size_t)(k0 + kk) * N + n0 + (lane & 31)]; }
    LDS_WAIT(); asm volatile("" ::: "memory");
    const int c = lane & 7;
#pragma unroll
    for (int j = 0; j < 4; ++j) { const int n = (lane >> 3) + 8 * j; const LAS float* s = scr + (8 * c) * 33 + n;
        v4u o; o.x = pk2(s[0 * 33], s[1 * 33]); o.y = pk2(s[2 * 33], s[3 * 33]); o.z = pk2(s[4 * 33], s[5 * 33]); o.w = pk2(s[6 * 33], s[7 * 33]);
        *(GAS v4u*)(wt_dst_row(kind, n0 + n, d0, d1, K) + k0 + 8 * c) = o; }
    LDS_WAIT(); asm volatile("" ::: "memory");
}
__device__ __forceinline__ void sincos_red(double ang, float& s, float& c) {
    const double k = rint(ang * 0.15915494309189535); const float r = (float)(ang - k * 6.283185307179586);
    s = sinf(r); c = cosf(r);
}
#define LAUNDER_TID(F) do { int t_ = (F).tid; asm volatile("" : "+v"(t_)); (F).tid = t_; (F).lane = t_ & 63; int z_ = 0; asm volatile("" : "+s"(z_)); (F).z = z_; unsigned char* w_ = (F).ws0; asm volatile("" : "+s"(w_)); (F).ws = w_; } while (0)
struct Frame {
    LAS unsigned char* lds; volatile LAS unsigned* MISC; gu32* ctl;
    int tid, lane, wave, vcu, G;
    float* out; unsigned char* ws; unsigned char* ws0; int z;
};
__device__ __forceinline__ void p0_prologue(Frame& F, const Args& A) {
    LAS float* scr = (LAS float*)(F.lds + RING_OFF + F.wave * 16384);
    const int gw = F.vcu * NWAVES + F.wave, NGW = F.G * NWAVES;
    constexpr int I_IN = (DM / 64) * ((HYIN + QKVW) / 32), I_OUT = (DM / 64) * (DM / 32), I_G = (DM / 64) * (DFF / 32), I_D = (DFF / 64) * (DM / 32);
    constexpr int PER_L = I_IN + I_OUT + 2 * I_G + I_D;
    for (int it = gw; it < DEPTH * PER_L; it += NGW) {
        const int l = it / PER_L; int r = it % PER_L;
        unsigned char* wl = F.ws + WS_W + (size_t)l * SZ_WLAYER;
        if (r < I_IN) { p0_transpose_item(A.in[I_WIN + F.z] + (size_t)l * DM * (HYIN + QKVW), DM, HYIN + QKVW, 1, (bf16*)(wl + OFF_WHY), (bf16*)(wl + OFF_WQKV), scr, r, F.lane); continue; } r -= I_IN;
        if (r < I_OUT) { p0_transpose_item(A.in[I_WOUT + F.z] + (size_t)l * DM * DM, DM, DM, 0, (bf16*)(wl + OFF_WOUT), nullptr, scr, r, F.lane); continue; } r -= I_OUT;
        if (r < I_G) { p0_transpose_item(A.in[I_WGATE + F.z] + (size_t)l * DM * DFF, DM, DFF, 2, (bf16*)(wl + OFF_WGU), nullptr, scr, r, F.lane); continue; } r -= I_G;
        if (r < I_G) { p0_transpose_item(A.in[I_WUP + F.z] + (size_t)l * DM * DFF, DM, DFF, 3, (bf16*)(wl + OFF_WGU), nullptr, scr, r, F.lane); continue; } r -= I_G;
        p0_transpose_item(A.in[I_WDOWN + F.z] + (size_t)l * DFF * DM, DFF, DM, 0, (bf16*)(wl + OFF_WDN), nullptr, scr, r, F.lane);
    }
    {
        float* cs = (float*)(F.ws + WS_ROPE);
        for (int e = F.vcu * NTHR + F.tid; e < SEQ * 32; e += F.G * NTHR) {
            const int t = e >> 5, p = e & 31;
            const double inv = exp(-9.210340371976184 * (double)(2 * p) / 64.0);
            float s, c; sincos_red((double)t * inv, s, c);
            cs[2 * e] = c; cs[2 * e + 1] = s;
        }
    }
    {
        float* h3 = (float*)(F.ws + WS_H3);
        const int j = F.lane;
        for (int l = 0; l < DEPTH; ++l) {
            float w1r[FEMB];
            const float* w1 = A.in[I_FW1 + F.z] + (size_t)l * FEMB * FHID; const float* w2 = A.in[I_FW2 + F.z] + (size_t)l * FHID * FHID; const float* w3 = A.in[I_FW3 + F.z] + (size_t)l * FHID * FHID;
#pragma unroll
            for (int i = 0; i < FEMB; ++i) w1r[i] = w1[i * FHID + j];
            const float b1 = A.in[I_FB1 + F.z][l * FHID + j], f1 = A.in[I_FF1 + F.z][l * FHID + j], b2 = A.in[I_FB2 + F.z][l * FHID + j], f2 = A.in[I_FF2 + F.z][l * FHID + j], b3 = A.in[I_FB3 + F.z][l * FHID + j], f3 = A.in[I_FF3 + F.z][l * FHID + j];
            for (int t = gw; t < SEQ; t += NGW) {
                int jz = j; asm volatile("" : "+v"(jz));
                float z = 0.f;
                if (j == 0) z = (float)t * (1.0f / (float)(SEQ - 1));
                else if (j <= 32) { const int bi = (j - 1) & 15; const double band = 1e-4 + (double)bi * ((15.0 - 1e-4) / 15.0);
                    float s, c; sincos_red(6.283185307179586 * (double)t / (double)SEQ * band, s, c); z = (j <= 16) ? c : -s; }
                float a = b1;
#pragma unroll
                for (int i = 0; i < FEMB; ++i) a += __builtin_bit_cast(float, __builtin_amdgcn_readlane(__builtin_bit_cast(int, z), i)) * w1r[i];
                float h = sinf(f1 * a);
                a = b2;
#pragma unroll
                for (int i = 0; i < FHID; ++i) a += __builtin_bit_cast(float, __builtin_amdgcn_readlane(__builtin_bit_cast(int, h), i)) * w2[i * FHID + jz];
                h = sinf(f2 * a);
                a = b3;
#pragma unroll
                for (int i = 0; i < FHID; ++i) a += __builtin_bit_cast(float, __builtin_amdgcn_readlane(__builtin_bit_cast(int, h), i)) * w3[i * FHID + jz];
                h = sinf(f3 * a);
                h3[((size_t)l * SEQ + t) * FHID + j] = h;
            }
        }
    }
}
__device__ __forceinline__ void norm_pass(Frame& F, const float* x_src, const bf16* add, const float* g_add, float* x_dst, const float* g_out, bf16* h_dst) {
    const int gw = F.vcu * NWAVES + F.wave, NGW = F.G * NWAVES;
    typedef unsigned u32x2 __attribute__((ext_vector_type(2)));
    for (int m = gw; m < MG; m += NGW) {
        const f32x4* xr = (const f32x4*)(x_src + (size_t)m * DM) + F.lane;
        f32x4 v[8];
#pragma unroll
        for (int j = 0; j < 8; ++j) v[j] = xr[64 * j];
        if (add) {
            const u32x2* ar = (const u32x2*)(add + (size_t)m * DM) + F.lane;
            f32x4 a[8]; float ss = 0.f;
#pragma unroll
            for (int j = 0; j < 8; ++j) { const u32x2 w = ar[64 * j]; a[j][0] = __uint_as_float(w.x << 16); a[j][1] = __uint_as_float(w.x & 0xffff0000u); a[j][2] = __uint_as_float(w.y << 16); a[j][3] = __uint_as_float(w.y & 0xffff0000u);
                ss += (a[j][0] * a[j][0] + a[j][1] * a[j][1]) + (a[j][2] * a[j][2] + a[j][3] * a[j][3]); }
            const float r1 = 1.0f / sqrtf(wave_sum(ss) * (1.0f / DM) + EPS);
            const f32x4* gr = (const f32x4*)g_add + F.lane;
#pragma unroll
            for (int j = 0; j < 8; ++j) v[j] = v[j] + a[j] * r1 * gr[64 * j];
        }
        if (x_dst) { f32x4* xo = (f32x4*)(x_dst + (size_t)m * DM) + F.lane;
#pragma unroll
            for (int j = 0; j < 8; ++j) xo[64 * j] = v[j]; }
        if (h_dst) {
            float ss = 0.f;
#pragma unroll
            for (int j = 0; j < 8; ++j) ss += (v[j][0] * v[j][0] + v[j][1] * v[j][1]) + (v[j][2] * v[j][2] + v[j][3] * v[j][3]);
            const float r2 = 1.0f / sqrtf(wave_sum(ss) * (1.0f / DM) + EPS);
            const f32x4* gr = (const f32x4*)g_out + F.lane;
            u32x2* ho = (u32x2*)(h_dst + (size_t)m * DM) + F.lane;
#pragma unroll
            for (int j = 0; j < 8; ++j) { const f32x4 o = v[j] * r2 * gr[64 * j]; u32x2 w; w.x = pk2(o[0], o[1]); w.y = pk2(o[2], o[3]); ho[64 * j] = w; }
        }
    }
}
typedef LAS cf* lcf;
__device__ __forceinline__ void hy_fwd(lcf X, lcf thi, lcf tlo, int tid, const cf* KM) {
    const cf* nul = nullptr;
    hy_pass<4, 1024, false>(X, thi, tlo, tid, nul); __syncthreads();
    hy_pass<4, 64, false>(X, thi, tlo, tid, nul); __syncthreads();
    hy_pass<4, 4, false>(X, thi, tlo, tid, nul); __syncthreads();
    hy_pass<2, 1, false>(X, thi, tlo, tid, KM); __syncthreads();
}
__device__ __forceinline__ void hy_inv(lcf X, lcf thi, lcf tlo, int tid) {
    const cf* nul = nullptr;
    hy_pass<2, 1, true>(X, thi, tlo, tid, nul); __syncthreads();
    hy_pass<4, 4, true>(X, thi, tlo, tid, nul); __syncthreads();
    hy_pass<4, 64, true>(X, thi, tlo, tid, nul); __syncthreads();
    hy_pass<4, 1024, true>(X, thi, tlo, tid, nul); __syncthreads();
}
__device__ __forceinline__ void hyena_phase(Frame& F, const Args& A, int l) {
    lcf X = (lcf)(F.lds + RING_OFF); lcf thi = (lcf)(F.lds + TAB_OFF); lcf tlo = thi + 128; LAS float* w4s = (LAS float*)(F.lds + TAB_OFF + 2048);
    const int tid = F.tid;
    if (tid < 256) { const int a = tid & 127; const double ang = -6.283185307179586 * (double)(tid < 128 ? 128 * a : a) / (double)FN; float s, c; sincos_red(ang, s, c); (tid < 128 ? thi : tlo)[a] = cf{c, s}; }
    cf* K1g = (cf*)(F.ws + WS_FFTK) + (size_t)blockIdx.x * 2 * FN; cf* K2g = K1g + FN;
    const float* h3 = (const float*)(F.ws + WS_H3) + (size_t)l * SEQ * FHID;
    const float* w4 = A.in[I_FW4 + F.z] + (size_t)l * FHID * 4096;
    const float* cw = A.in[I_CONVW + F.z] + (size_t)l * 3 * HYIN; const float* cb = A.in[I_CONVB + F.z] + (size_t)l * HYIN; const float* hb = A.in[I_HBIAS + F.z] + (size_t)l * 2 * HYW;
    const bf16* projT = (const bf16*)(F.ws + WS_PROJT); bf16* zT = (bf16*)(F.ws + WS_ZT);
    for (int c = F.vcu; c < HYW; c += F.G) {
        __syncthreads();
        if (tid < 256) w4s[tid] = w4[(size_t)(tid >> 2) * 4096 + (tid & 3) * 1024 + c];
        __syncthreads();
        const float delta = fabsf(-15.350567286626973f + (float)c * ((-3.0701134573253945f + 15.350567286626973f) / 1023.0f));
        hy_filter_step(X, h3, w4s, delta, tid);
        __syncthreads();
        hy_fwd(X, thi, tlo, tid, nullptr);
        hy_sep_step(X, K1g, K2g, tid);
        asm volatile("s_waitcnt vmcnt(0)" ::: "memory"); __syncthreads();
        float zr[8][4];
        const unsigned* rx1 = (const unsigned*)(projT + (size_t)c * MG); const unsigned* rx2 = (const unsigned*)(projT + (size_t)(HYW + c) * MG); const unsigned* rv = (const unsigned*)(projT + (size_t)(2 * HYW + c) * MG);
        hy_load_step(X, rv, rv + SEQ / 2, cw[2 * HYW + c], cw[HYIN + 2 * HYW + c], cw[2 * HYIN + 2 * HYW + c], cb[2 * HYW + c], zr, tid);
        __syncthreads();
        hy_fwd(X, thi, tlo, tid, K1g); hy_inv(X, thi, tlo, tid);
        hy_gate1_step(X, rx1, rx1 + SEQ / 2, cw[c], cw[HYIN + c], cw[2 * HYIN + c], cb[c], hb[c], zr, tid);
        __syncthreads();
        hy_fwd(X, thi, tlo, tid, K2g); hy_inv(X, thi, tlo, tid);
        unsigned* zo = (unsigned*)(zT + (size_t)c * MG);
        hy_gate2_step(X, rx2, rx2 + SEQ / 2, cw[HYW + c], cw[HYIN + HYW + c], cw[2 * HYIN + HYW + c], cb[HYW + c], hb[HYW + c], zr, zo, zo + SEQ / 2, tid);
    }
    __syncthreads();
}
__device__ __forceinline__ void hynorm_phase(Frame& F, const Args& A, int l) {
    constexpr int TB = 32, PITCH = 68;
    LAS unsigned char* tile = F.lds + RING_OFF; LAS float* red = (LAS float*)(F.lds + RING_OFF + HYW * PITCH); LAS float* red2 = red + 128 * TB; LAS float* rinv = red2 + 16 * TB;
    const bf16* zT = (const bf16*)(F.ws + WS_ZT); bf16* mixin = (bf16*)(F.ws + WS_MIXIN); const float* gn = A.in[I_HNORM + F.z] + (size_t)l * HYW;
    const int tid = F.tid;
    for (int tb = F.vcu; tb < MG / TB; tb += F.G) {
        const int t0 = tb * TB; __syncthreads();
        float ps[8];
#pragma unroll
        for (int i = 0; i < 8; ++i) ps[i] = 0.f;
        const int k = tid & 3;
#pragma unroll
        for (int it = 0; it < 8; ++it) { const int c = it * 128 + (tid >> 2);
            const v4u w = *(const GAS v4u*)(zT + (size_t)c * MG + t0 + 8 * k);
            LAS unsigned* d = (LAS unsigned*)(tile + c * PITCH + 16 * k); d[0] = w.x; d[1] = w.y; d[2] = w.z; d[3] = w.w;
            const unsigned ww[4] = {w.x, w.y, w.z, w.w};
#pragma unroll
            for (int i = 0; i < 4; ++i) { const float a = __uint_as_float(ww[i] << 16), b = __uint_as_float(ww[i] & 0xffff0000u); ps[2 * i] += a * a; ps[2 * i + 1] += b * b; } }
#pragma unroll
        for (int i = 0; i < 8; ++i) red[(tid >> 2) * TB + 8 * k + i] = ps[i];
        __syncthreads();
        { const int tok = tid & 31, part = tid >> 5; float s = 0.f;
#pragma unroll
          for (int g = 0; g < 8; ++g) s += red[(part * 8 + g) * TB + tok];
          red2[part * TB + tok] = s; }
        __syncthreads();
        if (tid < TB) { float s = 0.f;
#pragma unroll
            for (int p = 0; p < 16; ++p) s += red2[p * TB + tid];
            rinv[tid] = 1.0f / sqrtf(s * (1.0f / HYW) + EPS); }
        __syncthreads();
#pragma unroll
        for (int it = 0; it < 8; ++it) { const int idx = it * NTHR + tid, cg = idx & 127, tok = idx >> 7; const float r = rinv[tok];
            float v[8];
#pragma unroll
            for (int j = 0; j < 8; ++j) v[j] = __uint_as_float((unsigned)(*(const LAS unsigned short*)(tile + (8 * cg + j) * PITCH + 2 * tok)) << 16);
            const f32x4 g0 = *(const f32x4*)(gn + 8 * cg), g1 = *(const f32x4*)(gn + 8 * cg + 4);
            v4u o; o.x = pk2(v[0] * r * g0[0], v[1] * r * g0[1]); o.y = pk2(v[2] * r * g0[2], v[3] * r * g0[3]); o.z = pk2(v[4] * r * g1[0], v[5] * r * g1[1]); o.w = pk2(v[6] * r * g1[2], v[7] * r * g1[3]);
            *(GAS v4u*)(mixin + (size_t)(t0 + tok) * DM + 8 * cg) = o; }
    }
    __syncthreads();
}
__device__ __forceinline__ void attn_phase(Frame& F, const Args& A, int l, unsigned char* lds_generic) {
    const float li = 0.8f - 0.6f * expf(-0.3f * (float)l);
    float lam;
    { const int j = F.lane; const float a = A.in[I_LQ1 + F.z][l * 64 + j] * A.in[I_LK1 + F.z][l * 64 + j], b = A.in[I_LQ2 + F.z][l * 64 + j] * A.in[I_LK2 + F.z][l * 64 + j];
      lam = expf(wave_sum(a)) - expf(wave_sum(b)) + li; }
    const att::bf16* qkv = (const att::bf16*)(F.ws + WS_QKV); att::bf16* mixin = (att::bf16*)(F.ws + WS_MIXIN);
    float* stash = (float*)(F.ws + WS_STASH) + (size_t)blockIdx.x * 64 * 512;
    const float* subln = A.in[I_SUBLN + F.z] + (size_t)l * 128;
    constexpr int NU = GSEQ * 8 * (SEQ / 256);
    for (int u = F.vcu; u < NU; u += F.G) {
        const int bvh = u >> 5, qb = u & 31, b = bvh >> 3, vh = bvh & 7;
        const long krow0 = (long)b * SEQ, qrow0 = krow0 + qb * 256;
        att::attn_unit(qkv, qrow0, krow0, vh, SEQ, lam, 1.0f - li, subln, mixin + (size_t)qrow0 * DM + HYW + vh * 128, DM, stash, (char*)lds_generic);
        __syncthreads();
    }
}
#ifndef PHMASK
#define PHMASK 511
#endif
__global__ void __launch_bounds__(NTHR, 2) hymba_fwd(Args args) {
    extern __shared__ __attribute__((aligned(16))) unsigned char lds[];
    Frame F;
    F.lds = (LAS unsigned char*)lds; F.MISC = (volatile LAS unsigned*)(F.lds + MISC_OFF);
    F.tid = threadIdx.x; F.lane = F.tid & 63; F.wave = __builtin_amdgcn_readfirstlane(F.tid >> 6);
    F.G = gridDim.x; { const int bx = blockIdx.x; F.vcu = (F.G % 8 == 0) ? (bx % 8) * (F.G / 8) + bx / 8 : bx; }
    F.ctl = (gu32*)(args.ws + WS_CTL); F.out = args.out; F.ws = args.ws; F.ws0 = args.ws; F.z = 0;
    for (int u = F.tid; u < (LDS_BYTES - MISC_OFF) / 4; u += NTHR) ((LAS unsigned*)(F.lds + MISC_OFF))[u] = 0u;
    __syncthreads();
    XcdBarrier bar; bar.bar = (unsigned*)(F.ctl + CW_BAR); bar.x = 0; bar.st = nullptr;
    if (!MK_PER_PHASE) bar = xcd_barrier_post((unsigned*)(F.ctl + CW_BAR), F.MISC + 8);
    const int lo = args.ph_lo, hi = args.ph_hi;
    int ph = 0;
#define IN_() (lo <= ph && ph < hi && ({ LAUNDER_TID(F); true; }))
#define SEAM() do { if (!MK_PER_PHASE && lo <= ph && ph + 1 < hi) xcd_barrier(bar); ++ph; } while (0)
    if ((PHMASK & 1) && IN_()) p0_prologue(F, args);
    SEAM();
#define Hb ((bf16*)(F.ws + WS_H))
#define projT ((bf16*)(F.ws + WS_PROJT))
#define qkv ((bf16*)(F.ws + WS_QKV))
#define mix ((bf16*)(F.ws + WS_MIX))
#define ffh ((bf16*)(F.ws + WS_FFH))
#define mixin ((bf16*)(F.ws + WS_MIXIN))
#define wl (F.ws + WS_W + (size_t)l * SZ_WLAYER)
#define xin ((g == 0) ? args.in[I_XP + F.z] : args.in[I_XS + F.z] + (size_t)(g - 1) * MG * DM)
#define xres (args.out + (size_t)g * MG * DM)
    for (int g = 0; g < NGRP; ++g) {
        if ((PHMASK & 2) && IN_()) norm_pass(F, xin, nullptr, nullptr, nullptr, args.in[I_GMPRE + F.z], Hb);
        SEAM();
        for (int l = 0; l < DEPTH; ++l) {
            if ((PHMASK & 4) && IN_()) {
                { pg8::Gemm gm{(const bf16*)(wl + OFF_WHY), Hb, HYIN, MG, DM}; pg8::StaticOrder S; S.init(HYIN, MG, F.G, (int)blockIdx.x);
                  pg8::EpiPlain E{projT, MG};
                  pg8::gemm_phase<pg8::EpiPlain, pg8::StaticOrder, true, true>(F.lds + RING_OFF, gm, S, E); }
                { pg8::Gemm gm{Hb, (const bf16*)(wl + OFF_WQKV), MG, QKVW, DM}; pg8::StaticOrder S; S.init(MG, QKVW, F.G, (int)blockIdx.x);
                  pg8::EpiRope E{qkv, QKVW, (const float*)(F.ws + WS_ROPE), QSCALE};
                  pg8::gemm_phase<pg8::EpiRope, pg8::StaticOrder, true, true>(F.lds + RING_OFF, gm, S, E); }
            }
            SEAM();
            if (IN_()) { if (PHMASK & 8) hyena_phase(F, args, l); if (PHMASK & 16) attn_phase(F, args, l, lds); }
            SEAM();
            if ((PHMASK & 32) && IN_()) hynorm_phase(F, args, l);
            SEAM();
            if ((PHMASK & 64) && IN_()) { pg8::Gemm gm{mixin, (const bf16*)(wl + OFF_WOUT), MG, DM, DM}; pg8::StaticOrder S; S.init(MG, DM, F.G, (int)blockIdx.x);
                pg8::EpiPlain E{mix, DM};
                pg8::gemm_phase<pg8::EpiPlain, pg8::StaticOrder, true, true>(F.lds + RING_OFF, gm, S, E); }
            SEAM();
            if ((PHMASK & 2) && IN_()) norm_pass(F, l == 0 ? xin : xres, mix, args.in[I_GMPOST + F.z] + (size_t)l * DM, xres, args.in[I_GFPRE + F.z] + (size_t)l * DM, Hb);
            SEAM();
            if ((PHMASK & 128) && IN_()) { pg8::Gemm gm{Hb, (const bf16*)(wl + OFF_WGU), MG, GU, DM}; pg8::StaticOrder S; S.init(MG, GU, F.G, (int)blockIdx.x);
                pg8::EpiSwiGLU E{ffh, DFF};
                pg8::gemm_phase<pg8::EpiSwiGLU, pg8::StaticOrder, true, true>(F.lds + RING_OFF, gm, S, E); }
            SEAM();
            if ((PHMASK & 256) && IN_()) { pg8::Gemm gm{ffh, (const bf16*)(wl + OFF_WDN), MG, DM, DFF}; pg8::StaticOrder S; S.init(MG, DM, F.G, (int)blockIdx.x);
                pg8::EpiPlain E{mixin, DM};
                pg8::gemm_phase<pg8::EpiPlain, pg8::StaticOrder, true, true>(F.lds + RING_OFF, gm, S, E); }
            SEAM();
            if ((PHMASK & 2) && IN_()) norm_pass(F, xres, mixin, args.in[I_GFPOST + F.z] + (size_t)l * DM, xres, args.in[I_GMPRE + F.z] + (size_t)((l + 1) % DEPTH) * DM, (l + 1 < DEPTH) ? Hb : nullptr);
            SEAM();
        }
    }
#undef IN_
#undef SEAM
#undef Hb
#undef projT
#undef qkv
#undef mix
#undef ffh
#undef mixin
#undef wl
#undef xin
#undef xres
}

extern "C" void kernel_launch(void* const* d_in, const int* in_sizes, int n_in, void* d_out, int out_size, void* d_ws, size_t ws_size, hipStream_t stream) {
    static int grid = 0;
    if (grid == 0) {
        if (n_in != 30 || in_sizes[0] != 2 * SEQ * DM || in_sizes[1] != 4 * SEQ * DM || out_size != NSEQ * SEQ * DM || ws_size < WS_END) {
            fprintf(stderr, "kernel_launch: shape mismatch (n_in %d, out %d, ws %zu, need %zu)\n", n_in, out_size, ws_size, (size_t)WS_END); grid = -1; return; }
        int dev = 0, cus = 0;
        if (hipGetDevice(&dev) != hipSuccess || hipDeviceGetAttribute(&cus, hipDeviceAttributeMultiprocessorCount, dev) != hipSuccess) { grid = -1; return; }
        if (hipFuncSetAttribute((const void*)hymba_fwd, hipFuncAttributeMaxDynamicSharedMemorySize, LDS_BYTES) != hipSuccess) { fprintf(stderr, "kernel_launch: hipFuncSetAttribute failed\n"); grid = -1; return; }
        int per_cu = 0;
        if (hipOccupancyMaxActiveBlocksPerMultiprocessor(&per_cu, (const void*)hymba_fwd, NTHR, LDS_BYTES) != hipSuccess || per_cu < 1) fprintf(stderr, "kernel_launch: occupancy query says %d\n", per_cu);
        (void)hipGetLastError();
        grid = cus;
    }
    if (grid < 0) return;
    if (hipMemsetAsync((char*)d_ws + WS_CTL, 0, CTL_ZERO_BYTES, stream) != hipSuccess) return;
    Args a{};
    for (int i = 0; i < 30; ++i) a.in[i] = (const float*)d_in[i];
    a.out = (float*)d_out; a.ws = (unsigned char*)d_ws;
#if MK_PER_PHASE
    for (int p = 0; p < NPHASE; ++p) { a.ph_lo = p; a.ph_hi = p + 1; hipLaunchKernelGGL(hymba_fwd, dim3(grid), dim3(NTHR), LDS_BYTES, stream, a); }
#else
    a.ph_lo = 0; a.ph_hi = NPHASE;
    hipLaunchKernelGGL(hymba_fwd, dim3(grid), dim3(NTHR), LDS_BYTES, stream, a);
#endif
    const hipError_t le = hipPeekAtLastError();
    if (le != hipSuccess) fprintf(stderr, "kernel_launch: launch failed: %s\n", hipGetErrorName(le));
}
```

```cpp
#include <hip/hip_runtime.h>
#include <hip/hip_bf16.h>
#include <cstdio>
#include <cstdint>
#include <cmath>
namespace pg8 {
#define PG8_LAS __attribute__((address_space(3)))
typedef unsigned short bf16_t;
typedef short bf16x8 __attribute__((ext_vector_type(8)));
typedef float f32x4 __attribute__((ext_vector_type(4)));
typedef unsigned u32x4 __attribute__((ext_vector_type(4)));
constexpr int BM = 256, BK = 64, HALF = 128, HTB = HALF * BK * 2  , STAGE_BYTES = 8 * HTB, NXCD = 8, WGM = 8;

__host__ __device__ __forceinline__ int lds_byte(int r, int c) { const int st = (r >> 4) * 2 + (c >> 5), rr = r & 15, cc = c & 31, ob = rr * 64 + cc * 2; return st * 1024 + (ob ^ (((ob >> 9) & 1) << 5)); }
__host__ __device__ __forceinline__ void stage_rc(int b, int& R, int& C) { const int st = b / 1024, sb = b % 1024, swz = sb ^ (((sb >> 9) & 1) << 5); R = (st >> 1) * 16 + swz / 64; C = (st & 1) * 32 + (swz % 64) / 2; }
__host__ __device__ __forceinline__ int perm32(int rho) { const int n = rho >> 4, i = rho & 15; return 8 * (i >> 2) + 4 * n + (i & 3); }

struct Unit { int pm, pn; };
struct Gemm { const bf16_t* A; const bf16_t* Bt; int M, N, K; };

struct StaticOrder {
    int nM, nN, nwg, G, c;
    __host__ __device__ void init(int M, int N, int G_, int c_) { nM = M / BM; nN = N / BM; nwg = nM * nN; G = G_; c = c_; }
    __host__ __device__ bool next(int i, Unit& u) const {
        const long L = (long)i * G + c; if (L >= nwg) return false;
        int wgid = (int)L; { const int q = nwg / NXCD, r = nwg % NXCD, xcd = wgid % NXCD, off = wgid / NXCD; wgid = (xcd < r ? xcd * (q + 1) : r * (q + 1) + (xcd - r) * q) + off; }
        const int nig = WGM * nN, gid = wgid / nig, fm = gid * WGM, gsz = (nM - fm) < WGM ? (nM - fm) : WGM;
        u.pm = fm + ((wgid % nig) % gsz); u.pn = (wgid % nig) / gsz; return true;
    }
    __device__ __forceinline__ void a_ready(const Unit&) const {}
    __device__ __forceinline__ void done(const Unit&) const {}
};

__device__ __forceinline__ unsigned cvt_pk_bf16(float lo, float hi) { unsigned r; asm volatile("v_cvt_pk_bf16_f32 %0, %1, %2" : "=v"(r) : "v"(lo), "v"(hi)); return r; }
typedef float f32x2 __attribute__((ext_vector_type(2)));
struct EpiPlain {
    static constexpr bool PERM = true, AFTER_DRAIN = false;
    bf16_t* O; int ldc;
    __device__ __forceinline__ void operator()(const f32x4 (&acc)[2][2][4][2], const Unit& u, int wr, int wc, int fr, int fq) const {
        const int row0 = u.pm * BM + wr * 64 + fr, col0 = u.pn * BM + wc * 32 + 8 * fq;
#pragma unroll
        for (int ai = 0; ai < 2; ++ai)
#pragma unroll
            for (int m = 0; m < 4; ++m) { bf16_t* rowp = O + (size_t)(row0 + ai * HALF + m * 16) * ldc + col0;
#pragma unroll
                for (int bj = 0; bj < 2; ++bj) { const f32x4 v0 = acc[ai][bj][m][0], v1 = acc[ai][bj][m][1];
                    u32x4 w; w.x = cvt_pk_bf16(v0[0], v0[1]); w.y = cvt_pk_bf16(v0[2], v0[3]); w.z = cvt_pk_bf16(v1[0], v1[1]); w.w = cvt_pk_bf16(v1[2], v1[3]);
                    *(u32x4*)(rowp + bj * HALF) = w; } }
    }
};
struct EpiRope {
    static constexpr bool PERM = true, AFTER_DRAIN = false;
    bf16_t* O; int ldc; const float* cs; float qscale;
    __device__ __forceinline__ void operator()(const f32x4 (&acc)[2][2][4][2], const Unit& u, int wr, int wc, int fr, int fq) const {
        const int row0 = u.pm * BM + wr * 64 + fr, col0 = u.pn * BM + wc * 32 + 8 * fq;
        const bool rope = u.pn < 8; const float sc = u.pn < 4 ? qscale : 1.0f;
        const int p0 = 16 * (wc & 1) + 4 * fq;
#pragma unroll
        for (int ai = 0; ai < 2; ++ai)
#pragma unroll
            for (int m = 0; m < 4; ++m) { const int row = row0 + ai * HALF + m * 16; bf16_t* rowp = O + (size_t)row * ldc + col0;
                f32x4 t0 = {1.f, 0.f, 1.f, 0.f}, t1 = {1.f, 0.f, 1.f, 0.f};
                if (rope) { const float* tp = cs + ((size_t)(row & 8191) * 32 + p0) * 2; t0 = *(const f32x4*)tp; t1 = *(const f32x4*)(tp + 4); }
#pragma unroll
                for (int bj = 0; bj < 2; ++bj) { const f32x4 v0 = acc[ai][bj][m][0], v1 = acc[ai][bj][m][1];
                    f32x4 o0, o1;
                    o0[0] = (v0[0] * t0[0] - v0[1] * t0[1]) * sc; o0[1] = (v0[0] * t0[1] + v0[1] * t0[0]) * sc;
                    o0[2] = (v0[2] * t0[2] - v0[3] * t0[3]) * sc; o0[3] = (v0[2] * t0[3] + v0[3] * t0[2]) * sc;
                    o1[0] = (v1[0] * t1[0] - v1[1] * t1[1]) * sc; o1[1] = (v1[0] * t1[1] + v1[1] * t1[0]) * sc;
                    o1[2] = (v1[2] * t1[2] - v1[3] * t1[3]) * sc; o1[3] = (v1[2] * t1[3] + v1[3] * t1[2]) * sc;
                    u32x4 w; w.x = cvt_pk_bf16(o0[0], o0[1]); w.y = cvt_pk_bf16(o0[2], o0[3]); w.z = cvt_pk_bf16(o1[0], o1[1]); w.w = cvt_pk_bf16(o1[2], o1[3]);
                    *(u32x4*)(rowp + bj * HALF) = w; } }
    }
};
struct EpiSwiGLU {
    static constexpr bool PERM = true, AFTER_DRAIN = false;
    bf16_t* O; int ldc;
    static __device__ __forceinline__ float silu_mul(float g, float u) { return g * u * __builtin_amdgcn_rcpf(1.0f + __builtin_amdgcn_exp2f(-1.4426950408889634f * g)); }
    __device__ __forceinline__ void operator()(const f32x4 (&acc)[2][2][4][2], const Unit& u, int wr, int wc, int fr, int fq) const {
        const int row0 = u.pm * BM + wr * 64 + fr, col0 = u.pn * HALF + wc * 32 + 8 * fq;
#pragma unroll
        for (int ai = 0; ai < 2; ++ai)
#pragma unroll
            for (int m = 0; m < 4; ++m) { bf16_t* rowp = O + (size_t)(row0 + ai * HALF + m * 16) * ldc + col0;
                const f32x4 g0 = acc[ai][0][m][0], g1 = acc[ai][0][m][1], u0 = acc[ai][1][m][0], u1 = acc[ai][1][m][1];
                u32x4 w; w.x = cvt_pk_bf16(silu_mul(g0[0], u0[0]), silu_mul(g0[1], u0[1])); w.y = cvt_pk_bf16(silu_mul(g0[2], u0[2]), silu_mul(g0[3], u0[3]));
                w.z = cvt_pk_bf16(silu_mul(g1[0], u1[0]), silu_mul(g1[1], u1[1])); w.w = cvt_pk_bf16(silu_mul(g1[2], u1[2]), silu_mul(g1[3], u1[3]));
                *(u32x4*)rowp = w; }
    }
};
template <class Epi, class Sched, bool ALIGN_EPI = false, bool SP2 = false>
__device__ __forceinline__ void gemm_phase(PG8_LAS unsigned char* lds, const Gemm g, const Sched& S, const Epi& E) {
    int tid = threadIdx.x; asm volatile("" : "+v"(tid));
    const int wid = __builtin_amdgcn_readfirstlane(tid >> 6), lane = tid & 63, wr = wid >> 2, wc = wid & 3, fr = lane & 15, fq = lane >> 4;
    const int K = g.K, nt = K / BK;
    unsigned voffA[2], voffB[2];
#pragma unroll
    for (int i = 0; i < 2; ++i) { int R, C; stage_rc(tid * 16 + i * 8192, R, C); const int Rb = Epi::PERM ? ((R & ~31) + perm32(R & 31)) : R;
        voffA[i] = (unsigned)(R * K + C) * 2u; voffB[i] = (unsigned)(Rb * K + C) * 2u; }
    const size_t kstep = (size_t)(BK * 2);
    const size_t hstep = (size_t)HALF * K * 2;
    const size_t tstep = 2 * hstep;
    const unsigned ldsw = (unsigned)wid * 1024u;
    const int aoff = lds_byte(wr * 64 + fr, fq * 8), boff = lds_byte(wc * 32 + fr, fq * 8);
#define PG8_SA(b, h) (((b) * 2 + (h)) * HTB)
#define PG8_SB(b, h) ((4 + (b) * 2 + (h)) * HTB)
#define PG8_STAGE(bufoff, gbase, voff) do { _Pragma("unroll") for (int _i = 0; _i < 2; ++_i) \
        __builtin_amdgcn_global_load_lds((const unsigned*)((const char*)(gbase) + (voff)[_i]), (PG8_LAS unsigned*)(lds + (bufoff) + ldsw + _i * 8192), 16, 0, 0); } while (0)
#define PG8_LDA(dst, b, h) do { _Pragma("unroll") for (int m = 0; m < 4; ++m) _Pragma("unroll") for (int k = 0; k < 2; ++k) dst[m][k] = *(const PG8_LAS bf16x8*)(lds + PG8_SA(b, h) + aoff + m * 2048 + k * 1024); } while (0)
#define PG8_LDB(dst, b, h) do { _Pragma("unroll") for (int n = 0; n < 2; ++n) _Pragma("unroll") for (int k = 0; k < 2; ++k) dst[n][k] = *(const PG8_LAS bf16x8*)(lds + PG8_SB(b, h) + boff + n * 2048 + k * 1024); } while (0)
#define PG8_MMA(ai, bj, At, Bt) do { __builtin_amdgcn_s_setprio(1); _Pragma("unroll") for (int m = 0; m < 4; ++m) _Pragma("unroll") for (int n = 0; n < 2; ++n) _Pragma("unroll") for (int k = 0; k < 2; ++k) \
        acc[ai][bj][m][n] = __builtin_amdgcn_mfma_f32_16x16x32_bf16(Bt[n][k], At[m][k], acc[ai][bj][m][n], 0, 0, 0); __builtin_amdgcn_s_setprio(0); } while (0)
#define PG8_WAIT_V(n) asm volatile("s_waitcnt vmcnt(" #n ")" ::: "memory")
#define PG8_WAIT_L(n) asm volatile("s_waitcnt lgkmcnt(" #n ")" ::: "memory")
#define PG8_BAR __builtin_amdgcn_s_barrier()
#define PG8_SCHED __builtin_amdgcn_sched_barrier(0)
    Unit cur, nxt; int ui = 0;
    if (!S.next(0, cur)) return;
    f32x4 acc[2][2][4][2];
#pragma unroll
    for (int a = 0; a < 2; ++a)
#pragma unroll
        for (int b = 0; b < 2; ++b)
#pragma unroll
            for (int m = 0; m < 4; ++m)
#pragma unroll
                for (int n = 0; n < 2; ++n) acc[a][b][m][n] = (f32x4){0.f, 0.f, 0.f, 0.f};
    bf16x8 At[4][2], B0[2][2], B1[2][2];
    const char* cA = (const char*)g.A + (size_t)cur.pm * tstep; const char* cB = (const char*)g.Bt + (size_t)cur.pn * tstep;
    S.a_ready(cur);
    if constexpr (SP2) {
        PG8_STAGE(PG8_SB(0, 0), cB, voffB); PG8_STAGE(PG8_SB(0, 1), cB + hstep, voffB); PG8_STAGE(PG8_SA(0, 0), cA, voffA); PG8_STAGE(PG8_SA(0, 1), cA + hstep, voffA);
        if (wr == 1) PG8_BAR;
        PG8_WAIT_V(2); PG8_BAR;
        PG8_STAGE(PG8_SB(1, 0), cB + kstep, voffB); PG8_STAGE(PG8_SA(1, 0), cA + kstep, voffA); PG8_STAGE(PG8_SB(1, 1), cB + hstep + kstep, voffB);
        PG8_WAIT_V(6); PG8_BAR;
    } else {
        PG8_STAGE(PG8_SB(0, 0), cB, voffB); PG8_STAGE(PG8_SA(0, 0), cA, voffA); PG8_STAGE(PG8_SB(0, 1), cB + hstep, voffB); PG8_STAGE(PG8_SA(0, 1), cA + hstep, voffA);
        if (wr == 1) PG8_BAR;
        PG8_WAIT_V(4); PG8_BAR;
        PG8_STAGE(PG8_SB(1, 0), cB + kstep, voffB); PG8_STAGE(PG8_SA(1, 0), cA + kstep, voffA); PG8_STAGE(PG8_SB(1, 1), cB + hstep + kstep, voffB);
        PG8_WAIT_V(6); PG8_BAR;
    }
    for (;;) {
        const bool has_next = S.next(ui + 1, nxt);
        const char* nA = has_next ? (const char*)g.A + (size_t)nxt.pm * tstep : cA; const char* nB = has_next ? (const char*)g.Bt + (size_t)nxt.pn * tstep : cB;
        for (int t = 0; t < nt; t += 2) {
            const bool last = (t == nt - 2);
            const char* a1 = cA + (size_t)(t + 1) * kstep;
            const char* a2 = last ? nA : cA + (size_t)(t + 2) * kstep; const char* b2 = last ? nB : cB + (size_t)(t + 2) * kstep;
            const char* a3 = a2 + kstep; const char* b3 = b2 + kstep;
            if (last && has_next) S.a_ready(nxt);
            if constexpr (SP2) {
            PG8_LDB(B0, 0, 0); PG8_LDB(B1, 0, 1); PG8_SCHED; PG8_LDA(At, 0, 0); PG8_STAGE(PG8_SA(1, 1), a1 + hstep, voffA);
            PG8_WAIT_V(8); PG8_WAIT_L(0); PG8_BAR; PG8_MMA(0, 0, At, B0); PG8_MMA(0, 1, At, B1); PG8_BAR; PG8_SCHED;
            PG8_LDA(At, 0, 1); PG8_STAGE(PG8_SB(0, 0), b2, voffB); PG8_STAGE(PG8_SB(0, 1), b2 + hstep, voffB); PG8_STAGE(PG8_SA(0, 0), a2, voffA);
            PG8_WAIT_V(8); PG8_WAIT_L(0); PG8_BAR; PG8_MMA(1, 0, At, B0); PG8_MMA(1, 1, At, B1); PG8_BAR; PG8_SCHED;
            PG8_LDB(B0, 1, 0); PG8_LDB(B1, 1, 1); PG8_SCHED; PG8_LDA(At, 1, 0); PG8_STAGE(PG8_SA(0, 1), a2 + hstep, voffA);
            PG8_WAIT_V(8); PG8_WAIT_L(0); PG8_BAR; PG8_MMA(0, 0, At, B0); PG8_MMA(0, 1, At, B1); PG8_BAR; PG8_SCHED;
            PG8_LDA(At, 1, 1); PG8_STAGE(PG8_SB(1, 0), b3, voffB); PG8_STAGE(PG8_SB(1, 1), b3 + hstep, voffB); PG8_STAGE(PG8_SA(1, 0), a3, voffA);
            PG8_WAIT_V(8); PG8_WAIT_L(0); PG8_BAR; PG8_MMA(1, 0, At, B0); PG8_MMA(1, 1, At, B1); PG8_BAR; PG8_SCHED;
            } else {
            PG8_LDB(B0, 0, 0); PG8_SCHED; PG8_LDA(At, 0, 0); PG8_STAGE(PG8_SA(1, 1), a1 + hstep, voffA);
            PG8_WAIT_L(8); PG8_BAR; PG8_WAIT_L(0); PG8_MMA(0, 0, At, B0); PG8_BAR; PG8_SCHED;
            PG8_LDB(B1, 0, 1); PG8_STAGE(PG8_SB(0, 0), b2, voffB);
            PG8_BAR; PG8_WAIT_L(0); PG8_MMA(0, 1, At, B1); PG8_BAR;
            PG8_LDA(At, 0, 1); PG8_STAGE(PG8_SA(0, 0), a2, voffA);
            PG8_BAR; PG8_WAIT_L(0); PG8_MMA(1, 0, At, B0); PG8_BAR; PG8_SCHED;
            PG8_STAGE(PG8_SB(0, 1), b2 + hstep, voffB);
            PG8_WAIT_V(6); PG8_BAR; PG8_MMA(1, 1, At, B1); PG8_BAR;
            PG8_LDB(B0, 1, 0); PG8_SCHED; PG8_LDA(At, 1, 0); PG8_STAGE(PG8_SA(0, 1), a2 + hstep, voffA);
            PG8_WAIT_L(8); PG8_BAR; PG8_WAIT_L(0); PG8_MMA(0, 0, At, B0); PG8_BAR; PG8_SCHED;
            PG8_LDB(B1, 1, 1); PG8_STAGE(PG8_SB(1, 0), b3, voffB);
            PG8_BAR; PG8_WAIT_L(0); PG8_MMA(0, 1, At, B1); PG8_BAR;
            PG8_LDA(At, 1, 1); PG8_STAGE(PG8_SA(1, 0), a3, voffA);
            PG8_BAR; PG8_WAIT_L(0); PG8_MMA(1, 0, At, B0); PG8_BAR; PG8_SCHED;
            PG8_STAGE(PG8_SB(1, 1), b3 + hstep, voffB);
            PG8_WAIT_V(6); PG8_BAR; PG8_MMA(1, 1, At, B1); PG8_BAR;
            }
        }
        if constexpr (ALIGN_EPI) { if (wr == 0) PG8_BAR; }
        if constexpr (!Epi::AFTER_DRAIN) { E(acc, cur, wr, wc, fr, fq); S.done(cur); }
        if (!has_next) break;
#pragma unroll
        for (int a = 0; a < 2; ++a)
#pragma unroll
            for (int b = 0; b < 2; ++b)
#pragma unroll
                for (int m = 0; m < 4; ++m)
#pragma unroll
                    for (int n = 0; n < 2; ++n) acc[a][b][m][n] = (f32x4){0.f, 0.f, 0.f, 0.f};
        cur = nxt; cA = nA; cB = nB; ++ui;
        if constexpr (ALIGN_EPI) { if (wr == 1) PG8_BAR; }
    }
    PG8_WAIT_V(0);
    if constexpr (!ALIGN_EPI) { if (wr == 0) PG8_BAR; }
    PG8_BAR;
    if constexpr (Epi::AFTER_DRAIN) { E.fused(acc, cur, wr, wc, fr, fq, lds, wid, lane); S.done(cur); }
#undef PG8_SA
#undef PG8_SB
#undef PG8_STAGE
#undef PG8_LDA
#undef PG8_LDB
#undef PG8_MMA
#undef PG8_WAIT_V
#undef PG8_WAIT_L
#undef PG8_BAR
#undef PG8_SCHED
}
}
namespace att {
using bf16x8 = __attribute__((ext_vector_type(8))) short;
using s16x4  = __attribute__((ext_vector_type(4))) short;
using f32x16 = __attribute__((ext_vector_type(16))) float;
using u32x4  = __attribute__((ext_vector_type(4))) unsigned;
typedef unsigned short bf16;
constexpr int DQ = 64, DV = 128, NW = 8, QBLK = 32, KVBLK = 64, LDR = 3072;
constexpr int SHM_V = KVBLK * DV * 2, SHM_K = KVBLK * DQ * 2, SHM_ATTN = 3 * SHM_V + 3 * SHM_K + NW * 64 * 4 + 64;
constexpr int SHM_ATTN_ALL = SHM_ATTN + NW * QBLK * DV * 2;
#ifndef ATT_OVF_LIMIT
#define ATT_OVF_LIMIT 1.152921504606847e18f
#endif
#ifndef ATT_SDEPTH
#define ATT_SDEPTH 2
#endif
constexpr float THR2 = 11.0f;
#define KSWZ64(row, colB) ((row) * 128 + ((colB) ^ ((((row) >> 1) & 7) << 4)))
#define SBAR() __builtin_amdgcn_sched_barrier(0)
template <int K> __device__ __forceinline__ float sx(float v) { return __builtin_bit_cast(float, __builtin_amdgcn_ds_swizzle(__builtin_bit_cast(int, v), (K << 10) | 0x1f)); }
__device__ __forceinline__ int crow(int r, int hi) { return (r & 3) + 8 * (r >> 2) + 4 * hi; }
__device__ __forceinline__ unsigned cvtpk(float lo, float hi) { unsigned r; asm volatile("v_cvt_pk_bf16_f32 %0, %1, %2" : "=v"(r) : "v"(lo), "v"(hi)); return r; }
__device__ __forceinline__ void partialSM(f32x16& p0, f32x16& p1, float& m_reg, float& mn, float& alpha) {
  float pmax = p0[0];
#pragma unroll
  for (int r = 1; r < 16; ++r) pmax = fmaxf(pmax, p0[r]);
#pragma unroll
  for (int r = 0; r < 16; ++r) pmax = fmaxf(pmax, p1[r]);
  { auto rr = __builtin_amdgcn_permlane32_swap(__float_as_uint(pmax), __float_as_uint(pmax), false, false);
    pmax = fmaxf(__uint_as_float(rr[0]), __uint_as_float(rr[1])); }
  if (__builtin_expect(__all(pmax - m_reg <= THR2), 1)) { mn = m_reg; alpha = 1.f; }
  else { mn = fmaxf(m_reg, pmax); alpha = __builtin_amdgcn_exp2f(m_reg - mn); m_reg = mn; }
#pragma unroll
  for (int r = 0; r < 16; ++r) p0[r] = p0[r] - mn;
#pragma unroll
  for (int r = 0; r < 16; ++r) p1[r] = p1[r] - mn;
#pragma unroll
  for (int r = 0; r < 16; ++r) p0[r] = __builtin_amdgcn_exp2f(p0[r]);
}
__device__ __forceinline__ void finishSM(f32x16& p0, f32x16& p1, float alpha, float& l_reg, bf16x8& pa0, bf16x8& pa1, bf16x8& pa2, bf16x8& pa3) {
#pragma unroll
  for (int r = 0; r < 16; ++r) p1[r] = __builtin_amdgcn_exp2f(p1[r]);
  float ps = 0;
#pragma unroll
  for (int r = 0; r < 16; ++r) ps += p0[r];
#pragma unroll
  for (int r = 0; r < 16; ++r) ps += p1[r];
  { auto rr = __builtin_amdgcn_permlane32_swap(__float_as_uint(ps), __float_as_uint(ps), false, false);
    ps = __uint_as_float(rr[0]) + __uint_as_float(rr[1]); }
  l_reg = l_reg * alpha + ps;
#define PK4(P, BASE, OUT) do { unsigned a0 = cvtpk(P[BASE + 0], P[BASE + 1]), a1 = cvtpk(P[BASE + 2], P[BASE + 3]);   \
    unsigned b0 = cvtpk(P[BASE + 4], P[BASE + 5]), b1 = cvtpk(P[BASE + 6], P[BASE + 7]);                              \
    auto r0 = __builtin_amdgcn_permlane32_swap(a0, b0, false, false); auto r1 = __builtin_amdgcn_permlane32_swap(a1, b1, false, false); \
    u32x4 w = {r0[0], r1[0], r0[1], r1[1]}; OUT = *reinterpret_cast<bf16x8*>(&w); } while (0)
  PK4(p0, 0, pa0); PK4(p0, 8, pa1); PK4(p1, 0, pa2); PK4(p1, 8, pa3);
#undef PK4
}
__device__ __forceinline__ void qkt(f32x16& p0, f32x16& p1, const char* Ks, const bf16x8* qr, int r32, int hi) {
  p0 = f32x16{}; p1 = f32x16{};
#pragma unroll
  for (int d0 = 0; d0 < 4; ++d0) { const int cb = (d0 * 16 + hi * 8) * 2;
    bf16x8 b0 = *reinterpret_cast<const bf16x8*>(Ks + KSWZ64(r32, cb));
    bf16x8 b1 = *reinterpret_cast<const bf16x8*>(Ks + KSWZ64(32 + r32, cb));
    p0 = __builtin_amdgcn_mfma_f32_32x32x16_bf16(b0, qr[d0], p0, 0, 0, 0);
    p1 = __builtin_amdgcn_mfma_f32_32x32x16_bf16(b1, qr[d0], p1, 0, 0, 0); }
}
__device__ __forceinline__ void qkt_ref(f32x16& p0, f32x16& p1, const char* Ks, const bf16x8* qr, const f32x16& negm, int r32, int hi) {
#pragma unroll
  for (int d0 = 0; d0 < 4; ++d0) { const int cb = (d0 * 16 + hi * 8) * 2;
    bf16x8 b0 = *reinterpret_cast<const bf16x8*>(Ks + KSWZ64(r32, cb));
    bf16x8 b1 = *reinterpret_cast<const bf16x8*>(Ks + KSWZ64(32 + r32, cb));
    if (d0 == 0) { p0 = __builtin_amdgcn_mfma_f32_32x32x16_bf16(b0, qr[0], negm, 0, 0, 0); p1 = __builtin_amdgcn_mfma_f32_32x32x16_bf16(b1, qr[0], negm, 0, 0, 0); }
    else { p0 = __builtin_amdgcn_mfma_f32_32x32x16_bf16(b0, qr[d0], p0, 0, 0, 0); p1 = __builtin_amdgcn_mfma_f32_32x32x16_bf16(b1, qr[d0], p1, 0, 0, 0); } }
}
__device__ __forceinline__ void exp_half(f32x16& p) {
#pragma unroll
  for (int r = 0; r < 16; ++r) p[r] = __builtin_amdgcn_exp2f(p[r]);
}
__device__ __forceinline__ void sub_exp_half(f32x16& p0, f32x16& p1, float m) {
#pragma unroll
  for (int r = 0; r < 16; ++r) p0[r] = p0[r] - m;
#pragma unroll
  for (int r = 0; r < 16; ++r) p1[r] = p1[r] - m;
#pragma unroll
  for (int r = 0; r < 16; ++r) p0[r] = __builtin_amdgcn_exp2f(p0[r]);
}
__device__ __forceinline__ void finishSM_fast(f32x16& p0, f32x16& p1, float& l_reg, bool& ovf, bf16x8& pa0, bf16x8& pa1, bf16x8& pa2, bf16x8& pa3) {
  float al = 1.f; float l0 = 0.f;
  finishSM(p0, p1, al, l0, pa0, pa1, pa2, pa3);
  ovf = ovf || !(l0 < ATT_OVF_LIMIT);
  l_reg += l0;
}
__device__ __forceinline__ int v_st(int k, int c) { const int kk = (k & ~0xC) | ((k & 4) << 1) | ((k & 8) >> 1); return ((kk >> 3) * 4 + (c >> 5)) * 512 + ((kk & 7) * 32 + (c & 31)) * 2; }
__device__ __forceinline__ int v_rd_base(int lane) { return ((lane & 3) << 3) | (((lane >> 2) & 3) << 6) | (((lane >> 4) & 1) << 5) | (((lane >> 5) & 1) << 8); }
constexpr int v_rd_off(int d0, int ks, int half) { return d0 * 512 + ks * 4096 + half * 2048; }
template <int OFF> __device__ __forceinline__ s16x4 tr_read(int vb) {
  s16x4 r; asm volatile("ds_read_b64_tr_b16 %0, %1 offset:%2" : "=&v"(r) : "v"(vb), "i"(OFF) : "memory"); return r;
}
template <int D0> __device__ __forceinline__ void pv_one(f32x16& od, int vb, bf16x8 pa0, bf16x8 pa1, bf16x8 pa2, bf16x8 pa3) {
  const s16x4 l0 = tr_read<v_rd_off(D0, 0, 0)>(vb), h0 = tr_read<v_rd_off(D0, 0, 1)>(vb), l1 = tr_read<v_rd_off(D0, 1, 0)>(vb), h1 = tr_read<v_rd_off(D0, 1, 1)>(vb);
  const s16x4 l2 = tr_read<v_rd_off(D0, 2, 0)>(vb), h2 = tr_read<v_rd_off(D0, 2, 1)>(vb), l3 = tr_read<v_rd_off(D0, 3, 0)>(vb), h3 = tr_read<v_rd_off(D0, 3, 1)>(vb);
  asm volatile("s_waitcnt lgkmcnt(0)" ::: "memory"); SBAR();
#define PK(L, H) (bf16x8){L[0], L[1], L[2], L[3], H[0], H[1], H[2], H[3]}
  od = __builtin_amdgcn_mfma_f32_32x32x16_bf16(pa0, PK(l0, h0), od, 0, 0, 0);
  od = __builtin_amdgcn_mfma_f32_32x32x16_bf16(pa1, PK(l1, h1), od, 0, 0, 0);
  od = __builtin_amdgcn_mfma_f32_32x32x16_bf16(pa2, PK(l2, h2), od, 0, 0, 0);
  od = __builtin_amdgcn_mfma_f32_32x32x16_bf16(pa3, PK(l3, h3), od, 0, 0, 0);
#undef PK
}
__device__ __forceinline__ void pv_d0(f32x16* o, int vb, bf16x8 pa0, bf16x8 pa1, bf16x8 pa2, bf16x8 pa3) {
  pv_one<0>(o[0], vb, pa0, pa1, pa2, pa3); pv_one<1>(o[1], vb, pa0, pa1, pa2, pa3); pv_one<2>(o[2], vb, pa0, pa1, pa2, pa3); pv_one<3>(o[3], vb, pa0, pa1, pa2, pa3);
}
__device__ __forceinline__ void glds16(const void* gsrc, unsigned lds_dst) { unsigned keep;
  asm volatile("s_mov_b32 %0, m0\n\ts_mov_b32 m0, %2\n\ts_nop 0\n\tglobal_load_lds_dwordx4 %1, off\n\ts_mov_b32 m0, %0" : "=&s"(keep) : "v"(gsrc), "s"(lds_dst) : "memory"); }
template <bool FAST>
__device__ __forceinline__ bool attn_map(const bf16* __restrict__ Kh, const bf16* __restrict__ Vh, const bf16* __restrict__ Qh  , int seq, char* V_lds, char* K_lds, float* ws_base,
                                         f32x16 (&o)[4], float& l_out) {
    int tid = threadIdx.x; asm volatile("" : "+v"(tid));
    const int wid = __builtin_amdgcn_readfirstlane(tid >> 6), r32 = tid & 31, hi = (tid >> 5) & 1;
    float* al_l = ws_base + wid * 64 + 32;
    const bf16* Qw = Qh + (long)(wid * QBLK + r32) * LDR + hi * 8;
    const int lane_ = tid & 63;
    const unsigned lds0 = (unsigned)(uintptr_t)V_lds;
    const bf16 *vsrc0, *vsrc1, *ksrc;
    { const int o0 = (2 * wid) * 1024 + 16 * lane_, o1 = o0 + 1024, ok = wid * 1024 + 16 * lane_;
      auto vmap = [](int o, int& k, int& c) { const int sub = o >> 9, w = o & 511, kk = ((sub >> 2) << 3) | (w >> 6); k = (kk & ~0xC) | ((kk & 4) << 1) | ((kk & 8) >> 1); c = (sub & 3) * 32 + ((w & 63) >> 1); };
      int k0_, c0_, k1_, c1_; vmap(o0, k0_, c0_); vmap(o1, k1_, c1_);
      vsrc0 = Vh + (long)k0_ * LDR + c0_; vsrc1 = Vh + (long)k1_ * LDR + c1_;
      const int row = ok >> 7, cb = (ok & 127) ^ (((row >> 1) & 7) << 4);
      ksrc = Kh + (long)row * LDR + (cb >> 1); }
    const int vb0 = (int)(uintptr_t)V_lds + v_rd_base(tid & 63);
    float m_reg = -1e30f, l_reg = 0; bf16x8 qr[4]; bool ovf = false;
#pragma unroll
    for (int d0 = 0; d0 < 4; ++d0) { o[d0] = f32x16{}; qr[d0] = *reinterpret_cast<const bf16x8*>(Qw + d0 * 16); }
#define DMA_TILE(t, b) do { const long ro_ = (long)(t) * KVBLK * LDR; \
      glds16(vsrc0 + ro_, (unsigned)__builtin_amdgcn_readfirstlane(lds0 + (b) * SHM_V + (2 * wid) * 1024)); \
      glds16(vsrc1 + ro_, (unsigned)__builtin_amdgcn_readfirstlane(lds0 + (b) * SHM_V + (2 * wid + 1) * 1024)); \
      glds16(ksrc + ro_, (unsigned)__builtin_amdgcn_readfirstlane(lds0 + 3 * SHM_V + (b) * SHM_K + wid * 1024)); } while (0)
#define DMA_WAIT() asm volatile("s_waitcnt vmcnt(0)" ::: "memory")
#define RESC(a) do { if constexpr (!FAST) { if (__any((a) < 1.f)) { if (hi == 0) al_l[r32] = (a); asm volatile("s_waitcnt lgkmcnt(0)" ::: "memory"); \
    _Pragma("unroll") for (int d = 0; d < 4; ++d) _Pragma("unroll") for (int r = 0; r < 16; ++r) o[d][r] *= al_l[crow(r, hi)]; } } } while (0)
#define PSM(P0, P1, MN, AL) do { if constexpr (FAST) exp_half(P0); else partialSM(P0, P1, m_reg, MN, AL); } while (0)
#define FSM(P0, P1, AL) do { if constexpr (FAST) finishSM_fast(P0, P1, l_reg, ovf, pa0, pa1, pa2, pa3); else finishSM(P0, P1, AL, l_reg, pa0, pa1, pa2, pa3); } while (0)
#define STEP(PN0, PN1, MNN, ALN, PO0, PO1, ALO, jj) do { \
      SBAR(); if constexpr (FAST) qkt_ref(PN0, PN1, K_lds + bc * SHM_K, qr, negm, r32, hi); else qkt(PN0, PN1, K_lds + bc * SHM_K, qr, r32, hi); \
      if ((jj) + 1 < NT) DMA_TILE((jj) + 1, bn);              \
      FSM(PO0, PO1, ALO); SBAR(); \
      pv_d0(o, vb0 + bp * SHM_V, pa0, pa1, pa2, pa3); PSM(PN0, PN1, MNN, ALN); RESC(ALN); \
      DMA_WAIT(); __syncthreads(); \
      bp = bc; bc = bn; bn = (bn == 2) ? 0 : bn + 1; } while (0)
    f32x16 pA0, pA1, pB0, pB1; float mnA = 0.f, mnB = 0.f, alA = 1.f, alB = 1.f; bf16x8 pa0, pa1, pa2, pa3; const int NT = seq / KVBLK;
    DMA_TILE(0, 0); DMA_WAIT(); __syncthreads();
    if (1 < NT) DMA_TILE(1, 1);
    qkt(pA0, pA1, K_lds, qr, r32, hi); partialSM(pA0, pA1, m_reg, mnA, alA);
    f32x16 negm = f32x16{};
    if constexpr (FAST) {
#pragma unroll
      for (int r = 0; r < 16; ++r) negm[r] = -m_reg;
      asm volatile("" : "+v"(negm));
    }
    DMA_WAIT(); __syncthreads();
    int bp = 0, bc = 1, bn = 2;
    for (int j = 1; j + 1 < NT; j += 2) {
      STEP(pB0, pB1, mnB, alB, pA0, pA1, alA, j);
      STEP(pA0, pA1, mnA, alA, pB0, pB1, alB, j + 1);
    }
    STEP(pB0, pB1, mnB, alB, pA0, pA1, alA, NT - 1);
    FSM(pB0, pB1, alB); SBAR();
    pv_d0(o, vb0 + bp * SHM_V, pa0, pa1, pa2, pa3);
#undef DMA_TILE
#undef DMA_WAIT
#undef RESC
#undef PSM
#undef FSM
#undef STEP
    l_out = l_reg;
    return ovf;
}
__device__ __forceinline__ void attn_unit(const bf16* __restrict__ qkv, long Qrow0, long Krow0, int vh, int seq, float lam, float oscale, const float* __restrict__ subln,
                                          bf16* __restrict__ Ob, int ldo, float* stash, char* lds) {
  int tid = threadIdx.x; asm volatile("" : "+v"(tid));
  const int wid = __builtin_amdgcn_readfirstlane(tid >> 6), lane = tid & 63, r32 = lane & 31, hi = lane >> 5;
  char* V_lds = lds; char* K_lds = lds + 3 * SHM_V;
  float* wsb = (float*)(lds + 3 * SHM_V + 3 * SHM_K); float* li_l = wsb + wid * 64;
  volatile unsigned* ovw = (volatile unsigned*)(lds + 3 * SHM_V + 3 * SHM_K + NW * 64 * 4);
  const bf16* Vh = qkv + Krow0 * LDR + 2048 + vh * DV;
  for (int s = 0; s < 2; ++s) {
    const int head = 2 * vh + s;
    const bf16* Kh = qkv + Krow0 * LDR + 1024 + head * DQ;
    const bf16* Qh = qkv + Qrow0 * LDR + head * DQ;
    f32x16 o[4]; float l_reg;
    const bool ovf = attn_map<true>(Kh, Vh, Qh, seq, V_lds, K_lds, wsb, o, l_reg);
    if (lane == 0) ovw[wid] = __any(ovf) ? 1u : 0u;
    __syncthreads();
    unsigned anyovf = 0u;
#pragma unroll
    for (int w = 0; w < NW; ++w) anyovf |= ovw[w];
    __syncthreads();
    if (__builtin_amdgcn_readfirstlane(anyovf) != 0u) (void)attn_map<false>(Kh, Vh, Qh, seq, V_lds, K_lds, wsb, o, l_reg);
    if (hi == 0) li_l[r32] = l_reg; asm volatile("s_waitcnt lgkmcnt(0)" ::: "memory");
    float rli[16];
#pragma unroll
    for (int r = 0; r < 16; ++r) rli[r] = __builtin_amdgcn_rcpf(li_l[crow(r, hi)]);
    typedef float f32x4_t __attribute__((ext_vector_type(4)));
    f32x4_t* st4 = (f32x4_t*)stash + (size_t)tid * 16;
    if (s == 0) {
#pragma unroll
      for (int d0 = 0; d0 < 4; ++d0)
#pragma unroll
        for (int r4 = 0; r4 < 4; ++r4) { f32x4_t v; v[0] = o[d0][4 * r4] * rli[4 * r4]; v[1] = o[d0][4 * r4 + 1] * rli[4 * r4 + 1]; v[2] = o[d0][4 * r4 + 2] * rli[4 * r4 + 2]; v[3] = o[d0][4 * r4 + 3] * rli[4 * r4 + 3]; st4[d0 * 4 + r4] = v; }
    } else {
      float ssq[16];
#pragma unroll
      for (int r = 0; r < 16; ++r) ssq[r] = 0.f;
#pragma unroll
      for (int d0 = 0; d0 < 4; ++d0)
#pragma unroll
        for (int r4 = 0; r4 < 4; ++r4) { const f32x4_t sv = st4[d0 * 4 + r4];
#pragma unroll
          for (int i = 0; i < 4; ++i) { const int r = 4 * r4 + i; const float v = sv[i] - lam * (o[d0][r] * rli[r]); o[d0][r] = v; ssq[r] += v * v; } }
#pragma unroll
      for (int r = 0; r < 16; ++r) {
        float a = ssq[r];
        a += sx<1>(a); a += sx<2>(a); a += sx<4>(a); a += sx<8>(a); a += sx<16>(a);
        ssq[r] = oscale / sqrtf(a * (1.0f / 128.0f) + 1e-6f);
      }
      float g[4];
#pragma unroll
      for (int d0 = 0; d0 < 4; ++d0) g[d0] = subln[d0 * 32 + r32];
      bf16* stg = (bf16*)(lds + SHM_ATTN) + wid * (QBLK * DV);
      unsigned so = (unsigned)((4 * hi) * DV + r32); asm volatile("" : "+v"(so));
#pragma unroll
      for (int r = 0; r < 16; ++r) {
#pragma unroll
        for (int d0 = 0; d0 < 4; ++d0) { const unsigned w = cvtpk(o[d0][r] * ssq[r] * g[d0], 0.f); (stg + ((r & 3) + 8 * (r >> 2)) * DV + d0 * 32)[so] = (bf16)(w & 0xffffu); } }
      asm volatile("s_waitcnt lgkmcnt(0)" ::: "memory");
      int ldo_ = ldo; asm volatile("" : "+s"(ldo_));
      bf16* Ow = Ob + (long)(wid * QBLK) * ldo_;
      const int srow = lane >> 4, sch = lane & 15;
#pragma unroll
      for (int i = 0; i < 8; ++i) { const int row = i * 4 + srow; const u32x4 v = *(const u32x4*)(stg + row * DV + sch * 8); *(u32x4*)(Ow + (long)row * ldo_ + sch * 8) = v; }
    }
  }
}
#undef SBAR
}
#define GAS __attribute__((address_space(1)))
#define LAS __attribute__((address_space(3)))
typedef unsigned short bf16;
typedef unsigned v4u __attribute__((ext_vector_type(4)));
typedef float f32x4 __attribute__((ext_vector_type(4)));
typedef short bf16x8 __attribute__((ext_vector_type(8)));
typedef GAS unsigned gu32;
typedef GAS unsigned long long gu64;
#define RLX_AGENT __ATOMIC_RELAXED, __HIP_MEMORY_SCOPE_AGENT
#define LDS_WAIT() asm volatile("s_waitcnt lgkmcnt(0)" ::: "memory")
#define VM_WAIT() asm volatile("s_waitcnt vmcnt(0)" ::: "memory")
__device__ __forceinline__ unsigned long long rt() { return __builtin_amdgcn_s_memrealtime(); }
__device__ __forceinline__ unsigned f2bf(float f) { unsigned u = __builtin_bit_cast(unsigned, f); return (u + 0x7fffu + ((u >> 16) & 1u)) >> 16; }
__device__ __forceinline__ unsigned pk2(float lo, float hi) { return f2bf(lo) | (f2bf(hi) << 16); }

#define XB_TMO      128
#define XB_XCNT(j)  (256  + 64 * (j))
#define XB_XSUB(j)  (1280 + 64 * (j))
#define XB_XGEN(j)  (2304 + 64 * (j))
#define XB_TOP      3328
#define XB_TOPGEN   3392
#define XCD_BAR_WORDS 3456
#define XB_SPIN_CAP (1u << 18)

__device__ __forceinline__ unsigned xb_ld(unsigned* p)              { return __hip_atomic_load(p, __ATOMIC_RELAXED, __HIP_MEMORY_SCOPE_AGENT); }
__device__ __forceinline__ unsigned xb_add(unsigned* p, unsigned v) { return __hip_atomic_fetch_add(p, v, __ATOMIC_RELAXED, __HIP_MEMORY_SCOPE_AGENT); }
__device__ __forceinline__ unsigned xb_xcc_id() { return (unsigned)__builtin_amdgcn_s_getreg((3 << 11) | 20) & 0xFu; }
#define XB_SPIN(cond, bar) do { unsigned _sp = 0; while (cond) { __builtin_amdgcn_s_sleep(1); \
    if ((++_sp & 255u) == 0u) { if (xb_ld(&(bar)[XB_TMO])) break; if (_sp > XB_SPIN_CAP) { atomicAdd(&(bar)[XB_TMO], 1u); break; } } } } while (0)

struct XcdBarrier {
    unsigned* bar; unsigned x;
    volatile LAS unsigned* st;
};

__device__ __forceinline__ XcdBarrier xcd_barrier_post(unsigned* bar, volatile LAS unsigned* st) {
    XcdBarrier b; b.bar = bar; b.x = xb_xcc_id(); b.st = st;
    if (threadIdx.x == 0) (void)xb_add(&bar[XB_XCNT(b.x)], 1u);
    return b;
}
__device__ __forceinline__ void xcd_barrier_complete(unsigned* bar, unsigned x, unsigned& nloc, unsigned& nx) {
    const unsigned G = gridDim.x * gridDim.y * gridDim.z;
    unsigned sum, cnt, mine, sp = 0u;
    for (;;) {
        sum = 0u; cnt = 0u; mine = 0u;
#pragma unroll
        for (unsigned j = 0; j < 16; ++j) { const unsigned c = xb_ld(&bar[XB_XCNT(j)]); sum += c; cnt += (c > 0u) ? 1u : 0u; mine = (j == x) ? c : mine; }
        if (sum == G) break;
        __builtin_amdgcn_s_sleep(1);
        if ((++sp & 255u) == 0u) { if (xb_ld(&bar[XB_TMO])) break; if (sp > XB_SPIN_CAP) { atomicAdd(&bar[XB_TMO], 1u); break; } }
    }
    nloc = mine > 0u ? mine : 1u; nx = cnt > 0u ? cnt : 1u;
}

__device__ __forceinline__ void xcd_barrier(const XcdBarrier& b) {
    asm volatile("s_waitcnt vmcnt(0)" ::: "memory");
    __syncthreads();
    if (threadIdx.x == 0) {
        unsigned* bar = b.bar;
        __builtin_amdgcn_s_waitcnt(0);
        unsigned nloc = b.st[0], nx = b.st[1];
        if (nloc == 0u) { xcd_barrier_complete(bar, b.x, nloc, nx); b.st[0] = nloc; b.st[1] = nx; }
        const unsigned old = xb_add(&bar[XB_XSUB(b.x)], 1u);
        const unsigned gen = old / nloc;
        if (old + 1u == (gen + 1u) * nloc) {
            __builtin_amdgcn_fence(__ATOMIC_RELEASE, "agent");
            asm volatile("s_waitcnt vmcnt(0)" ::: "memory");
            const unsigned og = xb_add(&bar[XB_TOP], 1u);
            const unsigned tg = og / nx;
            if (og + 1u == (tg + 1u) * nx) xb_add(&bar[XB_TOPGEN], 1u);
            else XB_SPIN(xb_ld(&bar[XB_TOPGEN]) == tg, bar);
            __builtin_amdgcn_fence(__ATOMIC_ACQUIRE, "agent");
            xb_add(&bar[XB_XGEN(b.x)], 1u);
            asm volatile("s_waitcnt vmcnt(0)" ::: "memory");
        } else {
            XB_SPIN(xb_ld(&bar[XB_XGEN(b.x)]) == gen, bar);
            __builtin_amdgcn_fence(__ATOMIC_ACQUIRE, "agent");
            asm volatile("s_waitcnt vmcnt(0)" ::: "memory");
        }
    }
    __syncthreads();
}
#define HYD __device__ __forceinline__
#define HYDM __device__ __forceinline__
#define HY_DEVICE 1
#ifdef HY_DEVICE
#define HY_OPAQUE(x) asm volatile("" : "+v"(x))
#else
#define HY_OPAQUE(x) (void)(x)
#endif
typedef float cf __attribute__((ext_vector_type(2)));
typedef float cf2 __attribute__((ext_vector_type(4)));
template <class P> struct HyP2 {};
template <> struct HyP2<cf*> { typedef cf2* type; };
#ifdef HY_DEVICE
template <> struct HyP2<__attribute__((address_space(3))) cf*> { typedef __attribute__((address_space(3))) cf2* type; };
#endif
HYD cf cf_add(cf a, cf b) { return a + b; }
HYD cf cf_sub(cf a, cf b) { return a - b; }
HYD cf cf_mul(cf a, cf b) { return cf{a.x * b.x - a.y * b.y, a.x * b.y + a.y * b.x}; }
HYD cf cf_mulc(cf a, cf b) { return cf{a.x * b.x + a.y * b.y, a.y * b.x - a.x * b.y}; }
constexpr int FN = 16384, FT = 512, FLOG = 14, FNP = FN + 4 * (FN >> 6);
constexpr int SEQL = 8192;
HYD int HP(int i) { return i + ((i >> 6) << 2); }
#define HY_C1 0.92387953251128674f
#define HY_S1 0.38268343236508977f
#define HY_R2 0.70710678118654752f
template <int M16> HYD cf mul_root16(cf w) {
    if (M16 == 0) return w;
    if (M16 == 4) return cf{w.y, -w.x};
    if (M16 == 2) return cf{(w.x + w.y) * HY_R2, (w.y - w.x) * HY_R2};
    if (M16 == 6) return cf{(w.y - w.x) * HY_R2, -(w.x + w.y) * HY_R2};
    if (M16 == 1) return cf_mul(w, cf{HY_C1, -HY_S1});
    if (M16 == 3) return cf_mul(w, cf{HY_S1, -HY_C1});
    if (M16 == 5) return cf_mul(w, cf{-HY_S1, -HY_C1});
    return cf_mul(w, cf{-HY_C1, -HY_S1});
}
template <int Q, int U, bool INV, bool ZUP, bool HLO> struct HyStage {
    static HYDM void run(cf (&e)[1 << Q], const cf (&tw)[Q]) {
        constexpr int R = 1 << Q, half = R >> (U + 1);
#pragma unroll
        for (int k = 0; k < R; ++k) {
            if ((k & half) == 0) {
                const int kp = k & (half - 1);
                cf w = tw[U];
                switch (kp * 16 / (2 * half)) {
                    case 0: break;
                    case 1: w = mul_root16<1>(w); break;
                    case 2: w = mul_root16<2>(w); break;
                    case 3: w = mul_root16<3>(w); break;
                    case 4: w = mul_root16<4>(w); break;
                    case 5: w = mul_root16<5>(w); break;
                    case 6: w = mul_root16<6>(w); break;
                    default: w = mul_root16<7>(w); break;
                }
                if (!INV) {
                    if (ZUP && U == 0) { e[k + half] = cf_mul(e[k], w); }
                    else { const cf a = e[k], b = e[k + half]; e[k] = cf_add(a, b); e[k + half] = cf_mul(cf_sub(a, b), w); }
                } else {
                    const cf a = e[k], b = cf_mulc(e[k + half], w); e[k] = cf_add(a, b);
                    if (!(HLO && U == 0)) e[k + half] = cf_sub(a, b);
                }
            }
        }
    }
};
template <int Q, bool INV, bool ZUP, bool HLO> HYD void hy_bfly(cf (&e)[1 << Q], cf t) {
    cf tw[Q]; tw[0] = t;
#pragma unroll
    for (int u = 1; u < Q; ++u) tw[u] = cf_mul(tw[u - 1], tw[u - 1]);
    if (Q == 4) {
        if (!INV) { HyStage<Q, 0, INV, ZUP, HLO>::run(e, tw); HyStage<Q, 1, INV, ZUP, HLO>::run(e, tw); HyStage<Q, 2 % Q, INV, ZUP, HLO>::run(e, tw); HyStage<Q, 3 % Q, INV, ZUP, HLO>::run(e, tw); }
        else      { HyStage<Q, 3 % Q, INV, ZUP, HLO>::run(e, tw); HyStage<Q, 2 % Q, INV, ZUP, HLO>::run(e, tw); HyStage<Q, 1, INV, ZUP, HLO>::run(e, tw); HyStage<Q, 0, INV, ZUP, HLO>::run(e, tw); }
    } else {
        if (!INV) { HyStage<Q, 0, INV, ZUP, HLO>::run(e, tw); HyStage<Q, 1, INV, ZUP, HLO>::run(e, tw); }
        else      { HyStage<Q, 1, INV, ZUP, HLO>::run(e, tw); HyStage<Q, 0, INV, ZUP, HLO>::run(e, tw); }
    }
}
#ifdef HY_DEVICE
#define HY_MULT(T, X, Y) "v_pk_mul_f32 " T ", " X ", " Y " op_sel:[1,1] op_sel_hi:[1,0]\n\t"
#define HY_FMAP(R, X, Y, T) "v_pk_fma_f32 " R ", " X ", " Y ", " T " op_sel_hi:[0,1,1] neg_lo:[0,0,1]\n\t"
#define HY_FMAC(R, X, Y, T) "v_pk_fma_f32 " R ", " X ", " Y ", " T " op_sel_hi:[0,1,1] neg_hi:[1,0,0]\n\t"
#define HY_ADD(R, A, B) "v_pk_add_f32 " R ", " A ", " B "\n\t"
#define HY_SUB(R, A, B) "v_pk_add_f32 " R ", " A ", " B " neg_lo:[0,1] neg_hi:[0,1]\n\t"
HYD void hy_cmul2(cf& r0, cf x0, cf y0, cf& r1, cf x1, cf y1) { cf t0, t1;
    asm(HY_MULT("%0", "%4", "%5") HY_MULT("%1", "%6", "%7") HY_FMAP("%2", "%4", "%5", "%0") HY_FMAP("%3", "%6", "%7", "%1")
        : "=&v"(t0), "=&v"(t1), "=&v"(r0), "=&v"(r1) : "v"(x0), "v"(y0), "v"(x1), "v"(y1)); }
HYD cf hy_cmul1(cf x, cf y) { cf t, r;
    asm(HY_MULT("%0", "%2", "%3") "s_nop 0\n\t" HY_FMAP("%1", "%2", "%3", "%0") : "=&v"(t), "=&v"(r) : "v"(x), "v"(y)); return r; }
HYD void hy_bf2_fwd(cf& a0, cf& b0, cf w0, cf& a1, cf& b1, cf w1) { cf d0, d1, t0, t1;
    asm(HY_SUB("%4", "%0", "%1") HY_ADD("%0", "%0", "%1") HY_SUB("%5", "%2", "%3") HY_ADD("%2", "%2", "%3")
        HY_MULT("%6", "%4", "%8") HY_MULT("%7", "%5", "%9") HY_FMAP("%1", "%4", "%8", "%6") HY_FMAP("%3", "%5", "%9", "%7")
        : "+v"(a0), "+v"(b0), "+v"(a1), "+v"(b1), "=&v"(d0), "=&v"(d1), "=&v"(t0), "=&v"(t1) : "v"(w0), "v"(w1)); }
HYD void hy_bf2_fwdz(cf a0, cf& b0, cf w0, cf a1, cf& b1, cf w1) { hy_cmul2(b0, a0, w0, b1, a1, w1); }
HYD void hy_bf2_inv(cf& a0, cf& b0, cf w0, cf& a1, cf& b1, cf w1) { cf t0, t1;
    asm(HY_MULT("%4", "%1", "%6") HY_MULT("%5", "%3", "%7") HY_FMAC("%4", "%1", "%6", "%4") HY_FMAC("%5", "%3", "%7", "%5")
        HY_SUB("%1", "%0", "%4") HY_SUB("%3", "%2", "%5") HY_ADD("%0", "%0", "%4") HY_ADD("%2", "%2", "%5")
        : "+v"(a0), "+v"(b0), "+v"(a1), "+v"(b1), "=&v"(t0), "=&v"(t1) : "v"(w0), "v"(w1)); }
HYD void hy_bf2_invl(cf& a0, cf b0, cf w0, cf& a1, cf b1, cf w1) { cf t0, t1;
    asm(HY_MULT("%2", "%4", "%6") HY_MULT("%3", "%5", "%7") HY_FMAC("%2", "%4", "%6", "%2") HY_FMAC("%3", "%5", "%7", "%3")
        HY_ADD("%0", "%0", "%2") HY_ADD("%1", "%1", "%3")
        : "+v"(a0), "+v"(a1), "=&v"(t0), "=&v"(t1) : "v"(b0), "v"(b1), "v"(w0), "v"(w1)); }
HYD cf hy_rot(cf w) { cf r; asm("v_pk_add_f32 %0, %1, 0 op_sel:[1,0] op_sel_hi:[0,0] neg_hi:[1,0]" : "=v"(r) : "v"(w)); return r; }
#else
HYD void hy_cmul2(cf& r0, cf x0, cf y0, cf& r1, cf x1, cf y1) { const cf p0 = cf_mul(x0, y0), p1 = cf_mul(x1, y1); r0 = p0; r1 = p1; }
HYD cf hy_cmul1(cf x, cf y) { return cf_mul(x, y); }
HYD void hy_bf2_fwd(cf& a0, cf& b0, cf w0, cf& a1, cf& b1, cf w1) { const cf d0 = cf_sub(a0, b0), d1 = cf_sub(a1, b1); a0 = cf_add(a0, b0); a1 = cf_add(a1, b1); b0 = cf_mul(d0, w0); b1 = cf_mul(d1, w1); }
HYD void hy_bf2_fwdz(cf a0, cf& b0, cf w0, cf a1, cf& b1, cf w1) { b0 = cf_mul(a0, w0); b1 = cf_mul(a1, w1); }
HYD void hy_bf2_inv(cf& a0, cf& b0, cf w0, cf& a1, cf& b1, cf w1) { const cf p0 = cf_mulc(b0, w0), p1 = cf_mulc(b1, w1); b0 = cf_sub(a0, p0); b1 = cf_sub(a1, p1); a0 = cf_add(a0, p0); a1 = cf_add(a1, p1); }
HYD void hy_bf2_invl(cf& a0, cf b0, cf w0, cf& a1, cf b1, cf w1) { a0 = cf_add(a0, cf_mulc(b0, w0)); a1 = cf_add(a1, cf_mulc(b1, w1)); }
HYD cf hy_rot(cf w) { return cf{w.y, -w.x}; }
#endif
template <int U, bool INV, bool ZUP, bool HLO> HYD void hy_stage16(cf (&e)[16], const cf* W) {
    constexpr int half = 8 >> U;
#pragma unroll
    for (int j = 0; j < 8; j += 2) {
        const int k0 = ((j / half) * 2 * half) + (j % half), k1 = (((j + 1) / half) * 2 * half) + ((j + 1) % half);
        const cf w0 = W[k0 & (half - 1)], w1 = W[k1 & (half - 1)];
        if (!INV) { if (ZUP && U == 0) hy_bf2_fwdz(e[k0], e[k0 + half], w0, e[k1], e[k1 + half], w1); else hy_bf2_fwd(e[k0], e[k0 + half], w0, e[k1], e[k1 + half], w1); }
        else { if (HLO && U == 0) hy_bf2_invl(e[k0], e[k0 + half], w0, e[k1], e[k1 + half], w1); else hy_bf2_inv(e[k0], e[k0 + half], w0, e[k1], e[k1 + half], w1); }
    }
}
template <bool INV, bool ZUP, bool HLO> HYD void hy_bfly16(cf (&e)[16], cf t) {
    cf W0[8], W1[4], W2[2], W3[1], tw1, tw2;
    cf k1 = cf{HY_C1, -HY_S1}, k2 = cf{HY_R2, -HY_R2}, k3 = cf{HY_S1, -HY_C1};
    W0[0] = t;
    hy_cmul2(W0[1], t, k1, W0[3], t, k3);
    hy_cmul2(W0[2], t, k2, tw1, t, t);
    W1[0] = tw1;
    hy_cmul2(W1[1], tw1, k2, tw2, tw1, tw1);
    W2[0] = tw2;
    W3[0] = hy_cmul1(tw2, tw2);
#pragma unroll
    for (int i = 0; i < 4; ++i) W0[4 + i] = hy_rot(W0[i]);
    W1[2] = hy_rot(W1[0]); W1[3] = hy_rot(W1[1]); W2[1] = hy_rot(W2[0]);
    if (!INV) { hy_stage16<0, INV, ZUP, HLO>(e, W0); hy_stage16<1, INV, ZUP, HLO>(e, W1); hy_stage16<2, INV, ZUP, HLO>(e, W2); hy_stage16<3, INV, ZUP, HLO>(e, W3); }
    else      { hy_stage16<3, INV, ZUP, HLO>(e, W3); hy_stage16<2, INV, ZUP, HLO>(e, W2); hy_stage16<1, INV, ZUP, HLO>(e, W1); hy_stage16<0, INV, ZUP, HLO>(e, W0); }
}
template <class PT> HYD cf hy_twid(PT thi, PT tlo, int e) { return hy_cmul1(thi[e >> 7], tlo[e & 127]); }
template <int S, bool INV, bool ZUP, bool HLO, class P, class PT>
HYD void hy_pass16(P X, PT thi, PT tlo, int tid) {
    constexpr int R = 16;
    constexpr int SP = (S >= 64) ? S + S / 16 : S;
    const int g0 = tid, g1 = tid + FT;
    const int lo0 = g0 & (S - 1), pb0 = HP((g0 / S) * S * R + lo0);
    const int lo1 = g1 & (S - 1), pb1 = HP((g1 / S) * S * R + lo1);
    cf e0[R], e1[R];
#pragma unroll
    for (int k = 0; k < R; ++k) { if (ZUP && k >= 8) e0[k] = cf{0.f, 0.f}; else e0[k] = X[pb0 + k * SP]; }
#pragma unroll
    for (int k = 0; k < R; ++k) { if (ZUP && k >= 8) e1[k] = cf{0.f, 0.f}; else e1[k] = X[pb1 + k * SP]; }
    const cf t0 = hy_twid(thi, tlo, lo0 * (FN / (R * S))), t1 = hy_twid(thi, tlo, lo1 * (FN / (R * S)));
    hy_bfly16<INV, ZUP, HLO>(e0, t0);
#pragma unroll
    for (int k = 0; k < R; ++k) { if (!(HLO && k >= 8)) X[pb0 + k * SP] = e0[k]; }
    hy_bfly16<INV, ZUP, HLO>(e1, t1);
#pragma unroll
    for (int k = 0; k < R; ++k) { if (!(HLO && k >= 8)) X[pb1 + k * SP] = e1[k]; }
}
template <bool INV> HYD void hy_r4(cf (&e)[4]) {
    if (!INV) {
        const cf a0 = e[0] + e[2], b0 = e[0] - e[2], a1 = e[1] + e[3], d = e[1] - e[3], b1 = cf{d.y, -d.x};
        e[0] = a0 + a1; e[1] = a0 - a1; e[2] = b0 + b1; e[3] = b0 - b1;
    } else {
        const cf a0 = e[0] + e[1], a1 = e[0] - e[1], a2 = e[2] + e[3], d = e[2] - e[3], b = cf{-d.y, d.x};
        e[0] = a0 + a2; e[2] = a0 - a2; e[1] = a1 + b; e[3] = a1 - b;
    }
}
template <bool INV, class P, class PK>
HYD void hy_pass4(P X, int tid, PK KM) {
    typedef typename HyP2<P>::type P2;
    const int w = tid >> 6, lane = tid & 63;
#pragma unroll 1
    for (int gb = 0; gb < 2; ++gb) {
        cf2 a[4], b[4], ka[4], kb[4];
        const int g0 = (gb * 8 + w) * 256 + lane;
#pragma unroll
        for (int u = 0; u < 4; ++u) { const int g = g0 + 64 * u; P2 X2 = (P2)(X + HP(4 * g)); a[u] = X2[0]; b[u] = X2[1];
            if (KM) { const unsigned gi = (unsigned)(4 * g) & 0x3fffu; ka[u] = ((const cf2*)(KM + gi))[0]; kb[u] = ((const cf2*)(KM + gi))[1]; } }
#pragma unroll
        for (int u = 0; u < 4; ++u) { const int g = g0 + 64 * u; P2 X2 = (P2)(X + HP(4 * g));
            cf e[4] = {cf{a[u].x, a[u].y}, cf{a[u].z, a[u].w}, cf{b[u].x, b[u].y}, cf{b[u].z, b[u].w}};
            hy_r4<INV>(e);
            if (KM) { cf q0, q1, q2, q3; hy_cmul2(q0, e[0], cf{ka[u].x, ka[u].y}, q1, e[1], cf{ka[u].z, ka[u].w}); hy_cmul2(q2, e[2], cf{kb[u].x, kb[u].y}, q3, e[3], cf{kb[u].z, kb[u].w}); e[0] = q0; e[1] = q1; e[2] = q2; e[3] = q3; }
            X2[0] = cf2{e[0].x, e[0].y, e[1].x, e[1].y}; X2[1] = cf2{e[2].x, e[2].y, e[3].x, e[3].y}; }
    }
}
HYD int hy_brev14(int p) {
    unsigned v = (unsigned)p;
    v = ((v >> 1) & 0x55555555u) | ((v & 0x55555555u) << 1);
    v = ((v >> 2) & 0x33333333u) | ((v & 0x33333333u) << 2);
    v = ((v >> 4) & 0x0F0F0F0Fu) | ((v & 0x0F0F0F0Fu) << 4);
    v = ((v >> 8) & 0x00FF00FFu) | ((v & 0x00FF00FFu) << 8);
    v = (v >> 16) | (v << 16);
    return (int)(v >> (32 - FLOG));
}
HYD float hy_bf2f(unsigned short b) { unsigned u = (unsigned)b << 16; float f; __builtin_memcpy(&f, &u, 4); return f; }
HYD unsigned hy_f2bf(float f) { unsigned u; __builtin_memcpy(&u, &f, 4); return (u + 0x7fffu + ((u >> 16) & 1u)) >> 16; }
template <class PR> HYD void hy_sconv2(PR rowj  , unsigned tid, int j, float w0, float w1, float w2, float b, float& u0, float& u1) {
    const unsigned d1 = rowj[tid];
    const unsigned d0r = (rowj - 1)[tid], d2r = (rowj + 1)[tid];
    const unsigned d0 = (j > 0 || tid > 0) ? d0r : 0u;
    const unsigned d2 = (j < 7 || tid < (unsigned)(FT - 1)) ? d2r : 0u;
    const float pm1 = hy_bf2f((unsigned short)(d0 >> 16)), p0 = hy_bf2f((unsigned short)(d1 & 0xffffu)), p1 = hy_bf2f((unsigned short)(d1 >> 16)), p2 = hy_bf2f((unsigned short)(d2 & 0xffffu));
    u0 = b + w0 * pm1 + w1 * p0 + w2 * p1;
    u1 = b + w0 * p0 + w1 * p1 + w2 * p2;
}
template <class P> HYD void hy_filter_step(P X, const unsigned short* taps, float delta, int tid) {
    typedef typename HyP2<P>::type P2;
    typedef unsigned u32x2h __attribute__((ext_vector_type(2)));
    u32x2h raw[SEQL / (4 * FT)][4];
    const float dscale = -delta * (1.4426950408889634f / (float)(SEQL - 1)); (void)dscale;
#pragma unroll
    for (int j = 0; j < SEQL / (4 * FT); ++j)
#pragma unroll
        for (int q = 0; q < 4; ++q) raw[j][q] = *(const u32x2h*)(taps + (size_t)q * 1024 * SEQL + ((unsigned)(4 * (tid + FT * j)) & 0x1fffu));
#pragma unroll
    for (int j = 0; j < SEQL / (4 * FT); ++j) {
        const int t = 4 * (tid + FT * j);
        cf2 a[4];
#pragma unroll
        for (int q = 0; q < 4; ++q) a[q] = cf2{hy_bf2f((unsigned short)(raw[j][q].x & 0xffffu)), hy_bf2f((unsigned short)(raw[j][q].x >> 16)), hy_bf2f((unsigned short)(raw[j][q].y & 0xffffu)), hy_bf2f((unsigned short)(raw[j][q].y >> 16))};
        cf2 dec;
#pragma unroll
#ifdef HY_DEVICE
        for (int e = 0; e < 4; ++e) dec[e] = __builtin_amdgcn_exp2f((float)(t + e) * dscale);
#else
        for (int e = 0; e < 4; ++e) dec[e] = expf(-((float)(t + e) * (1.0f / (float)(SEQL - 1))) * delta);
#endif
        const cf2 a0 = a[0] * dec, a1 = a[1] * dec, a2 = a[2] * dec, a3 = a[3] * dec;
        P2 Xf = (P2)(X + HP(t));
        if (t == 0) { Xf[0] = cf2{a0[0] + a1[0], a2[0] + a3[0], a0[1], a2[1]}; float z0 = 0.f; HY_OPAQUE(z0); X[HP(SEQL)] = cf{z0, z0}; }
        else Xf[0] = cf2{a0[0], a2[0], a0[1], a2[1]};
        Xf[1] = cf2{a0[2], a2[2], a0[3], a2[3]};
        const int pbk = HP(FN - t - 4);
        X[pbk + 1] = cf{a1[3], a3[3]}; X[pbk + 2] = cf{a1[2], a3[2]}; X[pbk + 3] = cf{a1[1], a3[1]};
        if (t > 0) X[HP(FN - t)] = cf{a1[0], a3[0]};
    }
}
template <class P> HYD void hy_sep_step(P X, cf* K1g, cf* K2g, int tid) {
    const float sc = 0.5f / (float)FN;
#pragma unroll 1
    for (int j0 = 0; j0 < FN / FT; j0 += 4) {
        cf a[4], b[4];
#pragma unroll
        for (int u = 0; u < 4; ++u) { const int p = tid + FT * (j0 + u);
            const int f = hy_brev14(p), q = hy_brev14((FN - f) & (FN - 1));
            a[u] = X[HP(p)]; b[u] = X[HP(q)]; }
#pragma unroll
        for (int u = 0; u < 4; ++u) { const int p = tid + FT * (j0 + u);
            const unsigned pi = (unsigned)p & 0x3fffu;
            K1g[pi] = cf{(a[u].x + b[u].x) * sc, (a[u].y - b[u].y) * sc};
            K2g[pi] = cf{(a[u].y + b[u].y) * sc, -(a[u].x - b[u].x) * sc}; }
    }
}
template <class P> HYD void hy_load_step(P X, const unsigned* r0, const unsigned* r1, float w0, float w1, float w2, float b, float (&zr)[8][4], int tid) {
    typedef typename HyP2<P>::type P2;
#pragma unroll
    for (int j = 0; j < 8; ++j) {
        const int t = 2 * (tid + FT * j);
        hy_sconv2(r0 + FT * j, (unsigned)tid, j, w0, w1, w2, b, zr[j][0], zr[j][2]);
        hy_sconv2(r1 + FT * j, (unsigned)tid, j, w0, w1, w2, b, zr[j][1], zr[j][3]);
        *(P2)(X + HP(t)) = cf2{zr[j][0], zr[j][1], zr[j][2], zr[j][3]};
    }
}
template <class P> HYD void hy_gate1_step(P X, const unsigned* r0, const unsigned* r1, float w0, float w1, float w2, float b, float bias, float (&zr)[8][4], int tid) {
    typedef typename HyP2<P>::type P2;
#pragma unroll
    for (int j = 0; j < 8; ++j) {
        const int t = 2 * (tid + FT * j);
        float xa0, xa1, xb0, xb1;
        hy_sconv2(r0 + FT * j, (unsigned)tid, j, w0, w1, w2, b, xa0, xa1);
        hy_sconv2(r1 + FT * j, (unsigned)tid, j, w0, w1, w2, b, xb0, xb1);
        P2 xp = (P2)(X + HP(t));
        const cf2 y = *xp;
        zr[j][0] = xa0 * (y.x + zr[j][0] * bias); zr[j][1] = xb0 * (y.y + zr[j][1] * bias);
        zr[j][2] = xa1 * (y.z + zr[j][2] * bias); zr[j][3] = xb1 * (y.w + zr[j][3] * bias);
        *xp = cf2{zr[j][0], zr[j][1], zr[j][2], zr[j][3]};
    }
}
template <class P> HYD void hy_gate2_step(P X, const unsigned* r0, const unsigned* r1, float w0, float w1, float w2, float b, float bias, const float (&zr)[8][4], unsigned* out0, unsigned* out1, int tid) {
    typedef typename HyP2<P>::type P2;
#pragma unroll
    for (int j = 0; j < 8; ++j) {
        const int t = 2 * (tid + FT * j);
        float xa0, xa1, xb0, xb1;
        hy_sconv2(r0 + FT * j, (unsigned)tid, j, w0, w1, w2, b, xa0, xa1);
        hy_sconv2(r1 + FT * j, (unsigned)tid, j, w0, w1, w2, b, xb0, xb1);
        const cf2 y = *(P2)(X + HP(t));
        const float za0 = xa0 * (y.x + zr[j][0] * bias), zb0 = xb0 * (y.y + zr[j][1] * bias);
        const float za1 = xa1 * (y.z + zr[j][2] * bias), zb1 = xb1 * (y.w + zr[j][3] * bias);
        (out0 + FT * j)[(unsigned)tid] = hy_f2bf(za0) | (hy_f2bf(za1) << 16);
        (out1 + FT * j)[(unsigned)tid] = hy_f2bf(zb0) | (hy_f2bf(zb1) << 16);
    }
}
HYD float hy_sconv1(unsigned D0, unsigned D1, int t, float w0, float w1, float w2, float b, bool pad0, bool padL) {
    const unsigned sh = ((unsigned)(t - 1) & 1u) << 4;
#ifdef HY_DEVICE
    const unsigned lo = __builtin_amdgcn_alignbit(D1, D0, sh), hi = D1 >> sh;
#else
    const unsigned long long w = (((unsigned long long)D1 << 32) | D0) >> sh; const unsigned lo = (unsigned)w, hi = (unsigned)(w >> 32);
#endif
    float e0 = hy_bf2f((unsigned short)(lo & 0xffffu)), e1 = hy_bf2f((unsigned short)(lo >> 16)), e2 = hy_bf2f((unsigned short)(hi & 0xffffu));
    if (pad0 && t == 0) e0 = 0.f;
    if (padL && t == SEQL - 1) e2 = 0.f;
    return b + w0 * e0 + w1 * e1 + w2 * e2;
}
struct HyRaw { unsigned d[2][8][4]; };
HYD void hy_raw_load(HyRaw& R, const unsigned* r0, const unsigned* r1, int tid) {
#pragma unroll
    for (int r = 0; r < 2; ++r)
#pragma unroll
        for (int k = 0; k < 8; ++k) { const unsigned du = ((unsigned)(tid + FT * r + 1024 * k + 1) >> 1) & 0x1fffu;
            R.d[r][k][0] = (r0 - 1)[du]; R.d[r][k][1] = r0[du]; R.d[r][k][2] = (r1 - 1)[du]; R.d[r][k][3] = r1[du]; }
}
template <class P, class PT> HYD void hy_convA_fwd(P X, PT thi, PT tlo, int tid, const HyRaw& R, float w0, float w1, float w2, float b, cf (&zr)[2][8]) {
#pragma unroll
    for (int r = 0; r < 2; ++r) {
        const int i0 = tid + FT * r, pb = HP(i0);
        cf e[16];
#pragma unroll
        for (int k = 0; k < 8; ++k) { const int t = i0 + 1024 * k; const bool p0 = (r == 0 && k == 0), pL = (r == 1 && k == 7); e[k] = cf{hy_sconv1(R.d[r][k][0], R.d[r][k][1], t, w0, w1, w2, b, p0, pL), hy_sconv1(R.d[r][k][2], R.d[r][k][3], t, w0, w1, w2, b, p0, pL)}; zr[r][k] = e[k]; }
#pragma unroll
        for (int k = 8; k < 16; ++k) e[k] = cf{0.f, 0.f};
        hy_bfly16<false, true, false>(e, hy_twid(thi, tlo, i0));
#pragma unroll
        for (int k = 0; k < 16; ++k) X[pb + k * 1088] = e[k];
    }
}
template <bool LAST, class P, class PT> HYD void hy_gateA(P X, PT thi, PT tlo, int tid, const HyRaw& R, float w0, float w1, float w2, float b, float bias,
                                                           cf (&zr)[2][8], unsigned short* out0, unsigned short* out1) {
#pragma unroll
    for (int r = 0; r < 2; ++r) {
        const int i0 = tid + FT * r, pb = HP(i0);
        cf e[16];
#pragma unroll
        for (int k = 0; k < 16; ++k) e[k] = X[pb + k * 1088];
        const cf tw = hy_twid(thi, tlo, i0);
        hy_bfly16<true, false, true>(e, tw);
#pragma unroll
        for (int k = 0; k < 8; ++k) { const int t = i0 + 1024 * k;
            const bool p0 = (r == 0 && k == 0), pL = (r == 1 && k == 7);
            const float xa = hy_sconv1(R.d[r][k][0], R.d[r][k][1], t, w0, w1, w2, b, p0, pL), xb = hy_sconv1(R.d[r][k][2], R.d[r][k][3], t, w0, w1, w2, b, p0, pL);
            const cf z = cf{xa * (e[k].x + zr[r][k].x * bias), xb * (e[k].y + zr[r][k].y * bias)};
            if (LAST) {
#ifdef HY_DEVICE
                unsigned pk; asm("v_cvt_pk_bf16_f32 %0, %1, %2" : "=v"(pk) : "v"(z.x), "v"(z.y)); const unsigned ti = (unsigned)t & 0x1fffu; out0[ti] = (unsigned short)(pk & 0xffffu); out1[ti] = (unsigned short)(pk >> 16);
#else
                out0[t] = (unsigned short)hy_f2bf(z.x); out1[t] = (unsigned short)hy_f2bf(z.y);
#endif
            }
            else { zr[r][k] = z; e[k] = z; } }
        if (!LAST) {
#pragma unroll
            for (int k = 8; k < 16; ++k) e[k] = cf{0.f, 0.f};
            hy_bfly16<false, true, false>(e, tw);
#pragma unroll
            for (int k = 0; k < 16; ++k) X[pb + k * 1088] = e[k];
        }
    }
}
constexpr int NWAVES = 8, NTHR = NWAVES * 64;
constexpr int DM = 2048, SEQ = 8192, DEPTH = 4, NSEQ = 6, GSEQ = 2, NGRP = NSEQ / GSEQ, MG = GSEQ * SEQ;
constexpr int HYW = 1024, HYIN = 3072, QKVW = 3072, DFF = 5632, GU = 2 * DFF, FEMB = 33, FHID = 64;
constexpr float EPS = 1e-6f;
constexpr float QSCALE = 0.125f * 1.4426950408889634f;
constexpr size_t MiB = 1u << 20;
constexpr size_t WS_CTL = 0, CTL_ZERO_BYTES = 1 * MiB;
constexpr size_t SZ_WHY = (size_t)HYIN * DM * 2, SZ_WQKV = (size_t)QKVW * DM * 2, SZ_WOUT = (size_t)DM * DM * 2, SZ_WGU = (size_t)GU * DM * 2, SZ_WDN = (size_t)DM * DFF * 2;
constexpr size_t OFF_WHY = 0, OFF_WQKV = OFF_WHY + SZ_WHY, OFF_WOUT = OFF_WQKV + SZ_WQKV, OFF_WGU = OFF_WOUT + SZ_WOUT, OFF_WDN = OFF_WGU + SZ_WGU, SZ_WLAYER = OFF_WDN + SZ_WDN;
constexpr size_t WS_W = 1 * MiB;
constexpr size_t WS_ROPE = WS_W + DEPTH * SZ_WLAYER;
constexpr int KPAD = 256;
constexpr size_t WS_H3 = WS_ROPE + (size_t)SEQ * 32 * 8;
constexpr size_t WS_W4T = WS_H3 + (size_t)DEPTH * SEQ * KPAD * 2;
constexpr size_t WS_TAPS = WS_W4T + (size_t)DEPTH * 4096 * KPAD * 2;
constexpr size_t WS_FFTK = WS_TAPS + (size_t)4096 * SEQ * 2;
constexpr size_t WS_STASH = WS_FFTK + (size_t)256 * 2 * 16384 * 8;
constexpr size_t WS_XB = WS_STASH;
constexpr size_t WS_H = WS_XB + (size_t)MG * DM * 2;
constexpr size_t WS_ZT = WS_H + (size_t)MG * DM * 2;
constexpr size_t WS_PROJT = WS_ZT + (size_t)HYW * MG * 2;
constexpr size_t WS_QKV = WS_PROJT + (size_t)HYIN * MG * 2;
constexpr size_t WS_MIX = WS_PROJT;
constexpr size_t WS_FFH = WS_PROJT;
constexpr size_t WS_MIXIN = WS_QKV + (size_t)MG * QKVW * 2;
constexpr size_t WS_END = WS_MIXIN + (size_t)MG * DM * 2;
constexpr size_t SZ_TAPS = (size_t)4096 * SEQ * 2, WS_TAPS_X = WS_END, WS_END_X = WS_TAPS_X + (DEPTH - 1) * SZ_TAPS;
static_assert((size_t)MG * DFF * 2 <= (size_t)HYIN * MG * 2 + (size_t)MG * QKVW * 2, "FFH overlay fits PROJT|QKV");
static_assert(WS_W4T % 256 == 0 && WS_TAPS % 256 == 0 && WS_ROPE % 256 == 0 && WS_H3 % 256 == 0 && WS_FFTK % 256 == 0 && WS_XB % 256 == 0 && WS_H % 256 == 0 && SZ_WLAYER % 256 == 0, "alignment");
constexpr int CW_BAR = 4096;
constexpr int PH_PER_LAYER = 8, PH_PER_GROUP = 1 + DEPTH * PH_PER_LAYER, NPHASE = 1 + NGRP * PH_PER_GROUP;
constexpr int RING_OFF = 0, RING_BYTES = 131072;
constexpr int TAB_OFF = 139264;
constexpr int MISC_OFF = TAB_OFF + 4096;
constexpr int LDS_BYTES = 147456;
static_assert(MISC_OFF + 128 <= LDS_BYTES, "LDS map");
static_assert(att::SHM_ATTN_ALL <= MISC_OFF, "attention LDS fits below the control words");
#ifndef PROBE_DUP
#define PROBE_DUP 0
#endif
#ifndef MK_PER_PHASE
#define MK_PER_PHASE 0
#endif

struct Args { const float* in[30]; float* out; unsigned char* ws; int ph_lo, ph_hi, taps_all, pad; };
enum { I_XP = 0, I_XS, I_GMPRE, I_GMPOST, I_GFPRE, I_GFPOST, I_WIN, I_CONVW, I_CONVB, I_FW1, I_FB1, I_FF1, I_FW2, I_FB2, I_FF2, I_FW3, I_FB3, I_FF3, I_FW4,
       I_HBIAS, I_HNORM, I_LQ1, I_LK1, I_LQ2, I_LK2, I_SUBLN, I_WOUT, I_WGATE, I_WUP, I_WDOWN };

template <int K> __device__ __forceinline__ float swz_xor(float v) { return __builtin_bit_cast(float, __builtin_amdgcn_ds_swizzle(__builtin_bit_cast(int, v), (K << 10) | 0x1f)); }
__device__ __forceinline__ float wave_sum(float v) {
    v += swz_xor<1>(v); v += swz_xor<2>(v); v += swz_xor<4>(v); v += swz_xor<8>(v); v += swz_xor<16>(v);
    auto rr = __builtin_amdgcn_permlane32_swap(__float_as_uint(v), __float_as_uint(v), false, false);
    return __uint_as_float(rr[0]) + __uint_as_float(rr[1]);
}
__device__ __forceinline__ bf16* wt_dst_row(int kind, int n, bf16* d0, bf16* d1, int K) {
    if (kind == 0) return d0 + (size_t)n * K;
    if (kind == 1) { if (n < HYIN) return d0 + (size_t)n * K; int q = n - HYIN; if (q < 2048) { const int hb = q & ~63, i = q & 63; q = hb + (i < 32 ? 2 * i : 2 * (i - 32) + 1); } return d1 + (size_t)q * K; }
    if (kind == 4) return d0 + (size_t)n * KPAD;
    const int r = (n >> 7) * 256 + (n & 127) + (kind == 3 ? 128 : 0); return d0 + (size_t)r * K;
}
__device__ __forceinline__ void p0_transpose_item(const float* W, int K, int N, int kind, bf16* d0, bf16* d1, LAS float* scr, int item, int lane) {
    const int nblk = N / 32, kb = item / nblk, nb = item % nblk, k0 = 64 * kb, n0 = 32 * nb;
#pragma unroll 8
    for (int i = 0; i < 32; ++i) { const int kk = 2 * i + (lane >> 5); scr[kk * 33 + (lane & 31)] = W[(size_t)(k0 + kk) * N + n0 + (lane & 31)]; }
    LDS_WAIT(); asm volatile("" ::: "memory");
    const int c = lane & 7;
#pragma unroll
    for (int j = 0; j < 4; ++j) { const int n = (lane >> 3) + 8 * j; const LAS float* s = scr + (8 * c) * 33 + n;
        v4u o; o.x = pk2(s[0 * 33], s[1 * 33]); o.y = pk2(s[2 * 33], s[3 * 33]); o.z = pk2(s[4 * 33], s[5 * 33]); o.w = pk2(s[6 * 33], s[7 * 33]);
        *(GAS v4u*)(wt_dst_row(kind, n0 + n, d0, d1, K) + k0 + 8 * c) = o; }
    LDS_WAIT(); asm volatile("" ::: "memory");
}
__device__ __forceinline__ void sincos_red(double ang, float& s, float& c) {
    const double k = rint(ang * 0.15915494309189535); const float r = (float)(ang - k * 6.283185307179586);
    s = sinf(r); c = cosf(r);
}
#define GP(p) ((const float*)(const GAS float*)(p))
#define LAUNDER_TID(F) do { int t_ = (F).tid; asm volatile("" : "+v"(t_)); (F).tid = t_; (F).lane = t_ & 63; int z_ = 0; asm volatile("" : "+s"(z_)); (F).z = z_; unsigned long long w_ = (unsigned long long)(F).ws0; asm volatile("" : "+s"(w_)); (F).ws = (unsigned char*)(GAS unsigned char*)w_; int b_ = (F).bx0, v_ = (F).vcu0, g_ = (F).G0; asm volatile("" : "+s"(b_), "+s"(v_), "+s"(g_)); (F).bx = b_; (F).vcu = v_; (F).G = g_; } while (0)
struct Frame {
    LAS unsigned char* lds; volatile LAS unsigned* MISC; gu32* ctl;
    int tid, lane, wave, vcu, G, bx;
    int vcu0, G0, bx0;
    float* out; unsigned char* ws; unsigned char* ws0; int z;
};
__device__ __forceinline__ void p0_prologue(Frame& F, const Args& A) {
    LAS float* scr = (LAS float*)(F.lds + RING_OFF + F.wave * 16384);
    const int gw = F.vcu * NWAVES + F.wave, NGW = F.G * NWAVES;
    constexpr int I_IN = (DM / 64) * ((HYIN + QKVW) / 32), I_OUT = (DM / 64) * (DM / 32), I_G = (DM / 64) * (DFF / 32), I_D = (DFF / 64) * (DM / 32);
    constexpr int I_W4 = 4096 / 32;
    constexpr int PER_L = I_IN + I_OUT + 2 * I_G + I_D + I_W4;
    for (int it = gw; it < DEPTH * PER_L; it += NGW) {
        const int l = it / PER_L; int r = it % PER_L;
        unsigned char* wl = F.ws + WS_W + (size_t)l * SZ_WLAYER;
        if (r < I_IN) { p0_transpose_item(GP(A.in[I_WIN + F.z]) + (size_t)l * DM * (HYIN + QKVW), DM, HYIN + QKVW, 1, (bf16*)(wl + OFF_WHY), (bf16*)(wl + OFF_WQKV), scr, r, F.lane); continue; } r -= I_IN;
        if (r < I_OUT) { p0_transpose_item(GP(A.in[I_WOUT + F.z]) + (size_t)l * DM * DM, DM, DM, 0, (bf16*)(wl + OFF_WOUT), nullptr, scr, r, F.lane); continue; } r -= I_OUT;
        if (r < I_G) { p0_transpose_item(GP(A.in[I_WGATE + F.z]) + (size_t)l * DM * DFF, DM, DFF, 2, (bf16*)(wl + OFF_WGU), nullptr, scr, r, F.lane); continue; } r -= I_G;
        if (r < I_G) { p0_transpose_item(GP(A.in[I_WUP + F.z]) + (size_t)l * DM * DFF, DM, DFF, 3, (bf16*)(wl + OFF_WGU), nullptr, scr, r, F.lane); continue; } r -= I_G;
        if (r < I_D) { p0_transpose_item(GP(A.in[I_WDOWN + F.z]) + (size_t)l * DFF * DM, DFF, DM, 0, (bf16*)(wl + OFF_WDN), nullptr, scr, r, F.lane); continue; } r -= I_D;
        { bf16* w4t = (bf16*)(F.ws + WS_W4T) + (size_t)l * 4096 * KPAD;
          p0_transpose_item(GP(A.in[I_FW4 + F.z]) + (size_t)l * FHID * 4096, FHID, 4096, 4, w4t, nullptr, scr, r, F.lane);
          for (int e = F.lane; e < 32 * 24; e += 64) *(GAS v4u*)(w4t + (size_t)(32 * r + e / 24) * KPAD + 64 + 8 * (e % 24)) = (v4u){0u, 0u, 0u, 0u}; }
    }
    {
        float* cs = (float*)(F.ws + WS_ROPE);
        for (int e = F.vcu * NTHR + F.tid; e < SEQ * 32; e += F.G * NTHR) {
            const int t = e >> 5, p = e & 31;
            const double inv = exp(-9.210340371976184 * (double)(2 * p) / 64.0);
            float s, c; sincos_red((double)t * inv, s, c);
            cs[2 * e] = c; cs[2 * e + 1] = s;
        }
    }
    {
        bf16* h3b = (bf16*)(F.ws + WS_H3);
        LAS float* hb = (LAS float*)(F.lds + RING_OFF + F.wave * 16384);
        for (int task = gw; task < DEPTH * (SEQ / 64); task += NGW) {
            const int l = task / (SEQ / 64), t = (task % (SEQ / 64)) * 64 + F.lane;
            const float* w1 = GP(A.in[I_FW1 + F.z]) + (size_t)l * FEMB * FHID; const float* w2 = GP(A.in[I_FW2 + F.z]) + (size_t)l * FHID * FHID; const float* w3 = GP(A.in[I_FW3 + F.z]) + (size_t)l * FHID * FHID;
            hb[F.lane] = (float)t * (1.0f / (float)(SEQ - 1));
#pragma unroll 1
            for (int bi = 0; bi < 16; ++bi) { const double band = 1e-4 + (double)bi * ((15.0 - 1e-4) / 15.0);
                float s, c; sincos_red(6.283185307179586 * (double)t / (double)SEQ * band, s, c); hb[(1 + bi) * 64 + F.lane] = c; hb[(17 + bi) * 64 + F.lane] = -s; }
#pragma unroll 1
            for (int stage = 0; stage < 3; ++stage) {
                const float* w = stage == 0 ? w1 : (stage == 1 ? w2 : w3);
                const float* bb = (stage == 0 ? GP(A.in[I_FB1 + F.z]) : (stage == 1 ? GP(A.in[I_FB2 + F.z]) : GP(A.in[I_FB3 + F.z]))) + l * FHID;
                const float* ff = (stage == 0 ? GP(A.in[I_FF1 + F.z]) : (stage == 1 ? GP(A.in[I_FF2 + F.z]) : GP(A.in[I_FF3 + F.z]))) + l * FHID;
                const int nin = stage == 0 ? FEMB : FHID;
                typedef float f32x16_t __attribute__((ext_vector_type(16)));
                f32x16_t c0 = {}, c1 = {}, c2 = {}, c3 = {};
                LDS_WAIT();
#pragma unroll 1
                for (int i = 0; i < nin; ++i) { const float hv = hb[i * 64 + F.lane]; const f32x16_t* wr = (const f32x16_t*)(w + i * FHID);
                    c0 += wr[0] * hv; c1 += wr[1] * hv; c2 += wr[2] * hv; c3 += wr[3] * hv; }
                const f32x16_t* b16 = (const f32x16_t*)bb; const f32x16_t* f16 = (const f32x16_t*)ff;
                c0 = (c0 + b16[0]) * f16[0]; c1 = (c1 + b16[1]) * f16[1]; c2 = (c2 + b16[2]) * f16[2]; c3 = (c3 + b16[3]) * f16[3];
                if (stage < 2) {
#pragma unroll
                    for (int e = 0; e < 16; ++e) { hb[e * 64 + F.lane] = sinf(c0[e]); hb[(16 + e) * 64 + F.lane] = sinf(c1[e]); hb[(32 + e) * 64 + F.lane] = sinf(c2[e]); hb[(48 + e) * 64 + F.lane] = sinf(c3[e]); }
                } else {
                    GAS v4u* o = (GAS v4u*)(h3b + ((size_t)l * SEQ + t) * KPAD);
#pragma unroll
                    for (int q = 0; q < 2; ++q) { v4u w; w.x = pk2(sinf(c0[8 * q]), sinf(c0[8 * q + 1])); w.y = pk2(sinf(c0[8 * q + 2]), sinf(c0[8 * q + 3])); w.z = pk2(sinf(c0[8 * q + 4]), sinf(c0[8 * q + 5])); w.w = pk2(sinf(c0[8 * q + 6]), sinf(c0[8 * q + 7])); o[q] = w; }
#pragma unroll
                    for (int q = 0; q < 2; ++q) { v4u w; w.x = pk2(sinf(c1[8 * q]), sinf(c1[8 * q + 1])); w.y = pk2(sinf(c1[8 * q + 2]), sinf(c1[8 * q + 3])); w.z = pk2(sinf(c1[8 * q + 4]), sinf(c1[8 * q + 5])); w.w = pk2(sinf(c1[8 * q + 6]), sinf(c1[8 * q + 7])); o[2 + q] = w; }
#pragma unroll
                    for (int q = 0; q < 2; ++q) { v4u w; w.x = pk2(sinf(c2[8 * q]), sinf(c2[8 * q + 1])); w.y = pk2(sinf(c2[8 * q + 2]), sinf(c2[8 * q + 3])); w.z = pk2(sinf(c2[8 * q + 4]), sinf(c2[8 * q + 5])); w.w = pk2(sinf(c2[8 * q + 6]), sinf(c2[8 * q + 7])); o[4 + q] = w; }
#pragma unroll
                    for (int q = 0; q < 2; ++q) { v4u w; w.x = pk2(sinf(c3[8 * q]), sinf(c3[8 * q + 1])); w.y = pk2(sinf(c3[8 * q + 2]), sinf(c3[8 * q + 3])); w.z = pk2(sinf(c3[8 * q + 4]), sinf(c3[8 * q + 5])); w.w = pk2(sinf(c3[8 * q + 6]), sinf(c3[8 * q + 7])); o[6 + q] = w; }
#pragma unroll 1
                    for (int q = 8; q < 32; ++q) o[q] = (v4u){0u, 0u, 0u, 0u};
                }
            }
        }
    }
}
template <bool XSB>
__device__ __forceinline__ void norm_pass(Frame& F, const void* x_src, const bf16* add, const float* g_add, bf16* xb_dst, float* xf_dst, const float* g_out, bf16* h_dst) {
    const int gw = F.vcu * NWAVES + F.wave, NGW = F.G * NWAVES;
    typedef unsigned u32x2 __attribute__((ext_vector_type(2)));
    for (int m0 = gw; m0 < MG; m0 += 2 * NGW) {
        const int m1 = m0 + NGW; const bool two = m1 < MG; const int mb = two ? m1 : m0;
        f32x4 va[8], vb[8];
        if (XSB) {
            const GAS u32x2* xa = (const GAS u32x2*)((const bf16*)x_src + (size_t)m0 * DM) + F.lane; const GAS u32x2* xb = (const GAS u32x2*)((const bf16*)x_src + (size_t)mb * DM) + F.lane;
#pragma unroll
            for (int j = 0; j < 8; ++j) { const u32x2 a = xa[64 * j], b = xb[64 * j];
                va[j] = (f32x4){__uint_as_float(a.x << 16), __uint_as_float(a.x & 0xffff0000u), __uint_as_float(a.y << 16), __uint_as_float(a.y & 0xffff0000u)};
                vb[j] = (f32x4){__uint_as_float(b.x << 16), __uint_as_float(b.x & 0xffff0000u), __uint_as_float(b.y << 16), __uint_as_float(b.y & 0xffff0000u)}; }
        } else {
            const GAS f32x4* xa = (const GAS f32x4*)((const float*)x_src + (size_t)m0 * DM) + F.lane; const GAS f32x4* xb = (const GAS f32x4*)((const float*)x_src + (size_t)mb * DM) + F.lane;
#pragma unroll
            for (int j = 0; j < 8; ++j) { va[j] = xa[64 * j]; vb[j] = xb[64 * j]; }
        }
        if (add) {
            const GAS u32x2* aa = (const GAS u32x2*)(add + (size_t)m0 * DM) + F.lane; const GAS u32x2* ab = (const GAS u32x2*)(add + (size_t)mb * DM) + F.lane;
            u32x2 wa[8], wb[8];
#pragma unroll
            for (int j = 0; j < 8; ++j) { wa[j] = aa[64 * j]; wb[j] = ab[64 * j]; }
            float sa = 0.f, sb = 0.f;
#pragma unroll
            for (int j = 0; j < 8; ++j) { const float a0 = __uint_as_float(wa[j].x << 16), a1 = __uint_as_float(wa[j].x & 0xffff0000u), a2 = __uint_as_float(wa[j].y << 16), a3 = __uint_as_float(wa[j].y & 0xffff0000u);
                sa += (a0 * a0 + a1 * a1) + (a2 * a2 + a3 * a3);
                const float b0 = __uint_as_float(wb[j].x << 16), b1 = __uint_as_float(wb[j].x & 0xffff0000u), b2 = __uint_as_float(wb[j].y << 16), b3 = __uint_as_float(wb[j].y & 0xffff0000u);
                sb += (b0 * b0 + b1 * b1) + (b2 * b2 + b3 * b3); }
            const float ra = 1.0f / sqrtf(wave_sum(sa) * (1.0f / DM) + EPS), rb = 1.0f / sqrtf(wave_sum(sb) * (1.0f / DM) + EPS);
            const GAS f32x4* gr = (const GAS f32x4*)g_add + F.lane;
#pragma unroll
            for (int j = 0; j < 8; ++j) { const f32x4 g = gr[64 * j];
                const f32x4 a = {__uint_as_float(wa[j].x << 16), __uint_as_float(wa[j].x & 0xffff0000u), __uint_as_float(wa[j].y << 16), __uint_as_float(wa[j].y & 0xffff0000u)};
                const f32x4 b = {__uint_as_float(wb[j].x << 16), __uint_as_float(wb[j].x & 0xffff0000u), __uint_as_float(wb[j].y << 16), __uint_as_float(wb[j].y & 0xffff0000u)};
                va[j] = va[j] + a * ra * g; vb[j] = vb[j] + b * rb * g; }
        }
        if (xf_dst) { GAS f32x4* oa = (GAS f32x4*)(xf_dst + (size_t)m0 * DM) + F.lane; GAS f32x4* ob = (GAS f32x4*)(xf_dst + (size_t)mb * DM) + F.lane;
#pragma unroll
            for (int j = 0; j < 8; ++j) { oa[64 * j] = va[j]; if (two) ob[64 * j] = vb[j]; } }
        if (xb_dst) { GAS u32x2* oa = (GAS u32x2*)(xb_dst + (size_t)m0 * DM) + F.lane; GAS u32x2* ob = (GAS u32x2*)(xb_dst + (size_t)mb * DM) + F.lane;
#pragma unroll
            for (int j = 0; j < 8; ++j) { u32x2 w; w.x = pk2(va[j][0], va[j][1]); w.y = pk2(va[j][2], va[j][3]); oa[64 * j] = w;
                va[j] = (f32x4){__uint_as_float(w.x << 16), __uint_as_float(w.x & 0xffff0000u), __uint_as_float(w.y << 16), __uint_as_float(w.y & 0xffff0000u)};
                u32x2 w2; w2.x = pk2(vb[j][0], vb[j][1]); w2.y = pk2(vb[j][2], vb[j][3]); if (two) ob[64 * j] = w2;
                vb[j] = (f32x4){__uint_as_float(w2.x << 16), __uint_as_float(w2.x & 0xffff0000u), __uint_as_float(w2.y << 16), __uint_as_float(w2.y & 0xffff0000u)}; } }
        if (h_dst) {
            float sa = 0.f, sb = 0.f;
#pragma unroll
            for (int j = 0; j < 8; ++j) { sa += (va[j][0] * va[j][0] + va[j][1] * va[j][1]) + (va[j][2] * va[j][2] + va[j][3] * va[j][3]); sb += (vb[j][0] * vb[j][0] + vb[j][1] * vb[j][1]) + (vb[j][2] * vb[j][2] + vb[j][3] * vb[j][3]); }
            const float ra = 1.0f / sqrtf(wave_sum(sa) * (1.0f / DM) + EPS), rb = 1.0f / sqrtf(wave_sum(sb) * (1.0f / DM) + EPS);
            const GAS f32x4* gr = (const GAS f32x4*)g_out + F.lane;
            GAS u32x2* ha = (GAS u32x2*)(h_dst + (size_t)m0 * DM) + F.lane; GAS u32x2* hb2 = (GAS u32x2*)(h_dst + (size_t)mb * DM) + F.lane;
#pragma unroll
            for (int j = 0; j < 8; ++j) { const f32x4 g = gr[64 * j]; const f32x4 oa = va[j] * ra * g, ob = vb[j] * rb * g;
                u32x2 w; w.x = pk2(oa[0], oa[1]); w.y = pk2(oa[2], oa[3]); ha[64 * j] = w;
                if (two) { u32x2 w2; w2.x = pk2(ob[0], ob[1]); w2.y = pk2(ob[2], ob[3]); hb2[64 * j] = w2; } }
        }
    }
}
typedef LAS cf* lcf;
template <bool ZUP> __device__ __forceinline__ void hy_fwd(lcf X, lcf thi, lcf tlo, int tid, const cf* KM) {
    if (ZUP) hy_pass16<1024, false, true, false>(X, thi, tlo, tid); else hy_pass16<1024, false, false, false>(X, thi, tlo, tid);
    __syncthreads();
    hy_pass16<64, false, false, false>(X, thi, tlo, tid);
    hy_pass16<4, false, false, false>(X, thi, tlo, tid);
    hy_pass4<false>(X, tid, KM); __syncthreads();
}
__device__ __forceinline__ void hy_inv(lcf X, lcf thi, lcf tlo, int tid) {
    const cf* nul = nullptr;
    hy_pass4<true>(X, tid, nul); __syncthreads();
    hy_pass16<4, true, false, false>(X, thi, tlo, tid); __syncthreads();
    hy_pass16<64, true, false, false>(X, thi, tlo, tid); __syncthreads();
    hy_pass16<1024, true, false, true>(X, thi, tlo, tid); __syncthreads();
}
__device__ __forceinline__ void hy_mid(lcf X, lcf thi, lcf tlo, int tid, const cf* KM) {
    const cf* nul = nullptr;
    hy_pass16<64, false, false, false>(X, thi, tlo, tid);
    hy_pass16<4, false, false, false>(X, thi, tlo, tid);
    hy_pass4<false>(X, tid, KM);
    hy_pass4<true>(X, tid, nul);
    hy_pass16<4, true, false, false>(X, thi, tlo, tid);
    hy_pass16<64, true, false, false>(X, thi, tlo, tid); __syncthreads();
}
__device__ __forceinline__ void hyena_phase(Frame& F, const Args& A, int l) {
    lcf X = (lcf)(F.lds + RING_OFF); lcf thi = (lcf)(F.lds + TAB_OFF); lcf tlo = thi + 128;
    const int tid = F.tid;
    if (tid < 256) { const int a = tid & 127; const double ang = -6.283185307179586 * (double)(tid < 128 ? 128 * a : a) / (double)FN; float s, c; sincos_red(ang, s, c); (tid < 128 ? thi : tlo)[a] = cf{c, s}; }
    cf* K1g = (cf*)(F.ws + WS_FFTK) + (size_t)F.bx * 2 * FN; cf* K2g = K1g + FN;
    const bf16* taps = (const bf16*)(F.ws + ((A.taps_all && l > 0) ? WS_TAPS_X + (size_t)(l - 1) * SZ_TAPS : WS_TAPS));
    const float* cw = GP(A.in[I_CONVW + F.z]) + (size_t)l * 3 * HYIN; const float* cb = GP(A.in[I_CONVB + F.z]) + (size_t)l * HYIN; const float* hb = GP(A.in[I_HBIAS + F.z]) + (size_t)l * 2 * HYW;
    const bf16* projT = (const bf16*)(F.ws + WS_PROJT); bf16* zT = (bf16*)(F.ws + WS_ZT);
    for (int c = F.vcu; c < HYW; c += F.G) {
        __syncthreads();
        const float delta = fabsf(-15.350567286626973f + (float)c * ((-3.0701134573253945f + 15.350567286626973f) / 1023.0f));
#define TIDX(v) int v = tid; asm volatile("" : "+v"(v))
        { TIDX(t_); hy_filter_step(X, taps + (size_t)c * SEQ, delta, t_); }
        const unsigned* rx1 = (const unsigned*)(projT + (size_t)c * MG); const unsigned* rx2 = (const unsigned*)(projT + (size_t)(HYW + c) * MG); const unsigned* rv = (const unsigned*)(projT + (size_t)(2 * HYW + c) * MG);
        HyRaw R;
        { TIDX(t_); hy_raw_load(R, rv, rv + SEQ / 2, t_); }
        __syncthreads();
        { TIDX(t_); hy_fwd<false>(X, thi, tlo, t_, nullptr); }
        { TIDX(t_); hy_sep_step(X, K1g, K2g, t_); }
        asm volatile("s_waitcnt vmcnt(0)" ::: "memory"); __syncthreads();
        cf zr[2][8];
        { TIDX(t_); hy_convA_fwd(X, thi, tlo, t_, R, cw[2 * HYW + c], cw[HYIN + 2 * HYW + c], cw[2 * HYIN + 2 * HYW + c], cb[2 * HYW + c], zr); }
        { TIDX(t_); hy_raw_load(R, rx1, rx1 + SEQ / 2, t_); }
        __syncthreads();
        unsigned short* zo = (unsigned short*)(zT + (size_t)c * MG);
        int nconv = 2; asm volatile("" : "+s"(nconv));
#pragma unroll 1
        for (int ci = 0; ci < nconv; ++ci) {
            { TIDX(t_); hy_mid(X, thi, tlo, t_, ci ? K2g : K1g); }
            if (ci == 0) {
                { TIDX(t_); hy_gateA<false>(X, thi, tlo, t_, R, cw[c], cw[HYIN + c], cw[2 * HYIN + c], cb[c], hb[c], zr, (unsigned short*)nullptr, (unsigned short*)nullptr); }
                { TIDX(t_); hy_raw_load(R, rx2, rx2 + SEQ / 2, t_); }
                __syncthreads();
            } else {
                { TIDX(t_); hy_gateA<true>(X, thi, tlo, t_, R, cw[HYW + c], cw[HYIN + HYW + c], cw[2 * HYIN + HYW + c], cb[HYW + c], hb[HYW + c], zr, zo, zo + SEQ); }
            }
        }
#undef TIDX
    }
    __syncthreads();
}
__device__ __forceinline__ void hynorm_phase(Frame& F, const Args& A, int l) {
    constexpr int TB = 64;
    LAS unsigned char* tile = F.lds + RING_OFF; LAS float* red = (LAS float*)(F.lds + RING_OFF + TB * HYW * 2); LAS float* rinv = red + 8 * TB;
    const bf16* zT = (const bf16*)(F.ws + WS_ZT); bf16* mixin = (bf16*)(F.ws + WS_MIXIN); const float* gn = GP(A.in[I_HNORM + F.z]) + (size_t)l * HYW;
    const int tid = F.tid;
    for (int tb = F.vcu; tb < MG / TB; tb += F.G) {
        const int t0 = tb * TB; __syncthreads();
        float ps[8];
#pragma unroll
        for (int i = 0; i < 8; ++i) ps[i] = 0.f;
        const int k = tid & 7, crow = tid >> 3;
#pragma unroll
        for (int hb = 0; hb < 2; ++hb) {
            v4u w[8];
#pragma unroll
            for (int it = 0; it < 8; ++it) { const unsigned c = (unsigned)((hb * 8 + it) * 64 + crow) & 1023u; w[it] = *(const GAS v4u*)(zT + (size_t)c * MG + (unsigned)(t0 + 8 * k)); }
#pragma unroll
            for (int it = 0; it < 8; ++it) { const int c = (hb * 8 + it) * 64 + crow;
                LAS unsigned short* d = (LAS unsigned short*)(tile + (8 * k) * 2048 + (((c >> 3) ^ k) << 4) + (c & 7) * 2);
                const unsigned ww[4] = {w[it].x, w[it].y, w[it].z, w[it].w};
#pragma unroll
                for (int i = 0; i < 4; ++i) { d[(2 * i) * 1024] = (unsigned short)(ww[i] & 0xffffu); d[(2 * i + 1) * 1024] = (unsigned short)(ww[i] >> 16);
                    const float a = __uint_as_float(ww[i] << 16), b = __uint_as_float(ww[i] & 0xffff0000u); ps[2 * i] += a * a; ps[2 * i + 1] += b * b; } }
        }
#pragma unroll
        for (int i = 0; i < 8; ++i) { float v = ps[i]; v += swz_xor<8>(v); v += swz_xor<16>(v);
            auto rr = __builtin_amdgcn_permlane32_swap(__float_as_uint(v), __float_as_uint(v), false, false); ps[i] = __uint_as_float(rr[0]) + __uint_as_float(rr[1]); }
        if ((F.lane >> 3) == 0) {
#pragma unroll
            for (int i = 0; i < 8; ++i) red[F.wave * TB + 8 * k + i] = ps[i]; }
        __syncthreads();
        if (tid < TB) { float s = 0.f;
#pragma unroll
            for (int w8 = 0; w8 < 8; ++w8) s += red[w8 * TB + tid];
            rinv[tid] = 1.0f / sqrtf(s * (1.0f / HYW) + EPS); }
        __syncthreads();
        const int cg = tid & 127;
        const f32x4 g0 = *(const f32x4*)(gn + 8 * cg), g1 = *(const f32x4*)(gn + 8 * cg + 4);
#pragma unroll 4
        for (int it = 0; it < 16; ++it) { const int tok = it * 4 + (tid >> 7); const float r = rinv[tok];
            const v4u q = *(const LAS v4u*)(tile + tok * 2048 + ((cg ^ (tok >> 3)) << 4));
            v4u o; o.x = pk2(__uint_as_float(q.x << 16) * r * g0[0], __uint_as_float(q.x & 0xffff0000u) * r * g0[1]); o.y = pk2(__uint_as_float(q.y << 16) * r * g0[2], __uint_as_float(q.y & 0xffff0000u) * r * g0[3]);
            o.z = pk2(__uint_as_float(q.z << 16) * r * g1[0], __uint_as_float(q.z & 0xffff0000u) * r * g1[1]); o.w = pk2(__uint_as_float(q.w << 16) * r * g1[2], __uint_as_float(q.w & 0xffff0000u) * r * g1[3]);
            *(GAS v4u*)(mixin + (size_t)(t0 + tok) * DM + 8 * cg) = o; }
    }
    __syncthreads();
}
__device__ __forceinline__ void attn_phase(Frame& F, const Args& A, int l, unsigned char* lds_generic) {
    const float li = 0.8f - 0.6f * expf(-0.3f * (float)l);
    float lam;
    { const int j = F.lane; const float a = GP(A.in[I_LQ1 + F.z])[l * 64 + j] * GP(A.in[I_LK1 + F.z])[l * 64 + j], b = GP(A.in[I_LQ2 + F.z])[l * 64 + j] * GP(A.in[I_LK2 + F.z])[l * 64 + j];
      lam = expf(wave_sum(a)) - expf(wave_sum(b)) + li; }
    const att::bf16* qkv = (const att::bf16*)(F.ws + WS_QKV); att::bf16* mixin = (att::bf16*)(F.ws + WS_MIXIN);
    float* stash = (float*)(F.ws + WS_H) + (size_t)F.bx * 64 * 512;
    const float* subln = GP(A.in[I_SUBLN + F.z]) + (size_t)l * 128;
    constexpr int NU = GSEQ * 8 * (SEQ / 256);
    for (int u = F.vcu; u < NU; u += F.G) {
        const int bvh = u >> 5, qb = u & 31, b = bvh >> 3, vh = bvh & 7;
        const long krow0 = (long)b * SEQ, qrow0 = krow0 + qb * 256;
        att::attn_unit(qkv, qrow0, krow0, vh, SEQ, lam, 1.0f - li, subln, mixin + (size_t)qrow0 * DM + HYW + vh * 128, DM, stash, (char*)lds_generic);
        __syncthreads();
    }
}
#ifndef PHMASK
#define PHMASK 511
#endif
__global__ void __launch_bounds__(NTHR, 2) hymba_fwd(Args args) {
    extern __shared__ __attribute__((aligned(16))) unsigned char lds[];
    Frame F;
    F.lds = (LAS unsigned char*)lds; F.MISC = (volatile LAS unsigned*)(F.lds + MISC_OFF);
    F.tid = threadIdx.x; F.lane = F.tid & 63; F.wave = __builtin_amdgcn_readfirstlane(F.tid >> 6);
    F.G = gridDim.x; { const int bx = blockIdx.x; F.vcu = (F.G % 8 == 0) ? (bx % 8) * (F.G / 8) + bx / 8 : bx; F.bx = bx; }
    F.vcu0 = F.vcu; F.G0 = F.G; F.bx0 = F.bx;
    F.ctl = (gu32*)(args.ws + WS_CTL); F.out = args.out; F.ws = args.ws; F.ws0 = args.ws; F.z = 0;
    for (int u = F.tid; u < (LDS_BYTES - MISC_OFF) / 4; u += NTHR) ((LAS unsigned*)(F.lds + MISC_OFF))[u] = 0u;
    __syncthreads();
    XcdBarrier bar; bar.bar = (unsigned*)(F.ctl + CW_BAR); bar.x = 0; bar.st = nullptr;
    if (!MK_PER_PHASE) bar = xcd_barrier_post((unsigned*)(F.ctl + CW_BAR), F.MISC + 8);
    const int lo = args.ph_lo, hi = args.ph_hi;
    int ph = 0;
#define IN_() (lo <= ph && ph < hi && ({ LAUNDER_TID(F); true; }))
#define DUP3(...) do { __VA_ARGS__; if (PROBE_DUP == 3) { __VA_ARGS__; } } while (0)
#define SEAM() do { if (!MK_PER_PHASE && lo <= ph && ph + 1 < hi) { XcdBarrier b_ = bar; { unsigned long long p_ = (unsigned long long)b_.bar; unsigned x_ = b_.x; asm volatile("" : "+s"(p_), "+s"(x_)); b_.bar = (unsigned*)(GAS unsigned*)p_; b_.x = x_; } \
        xcd_barrier(b_); if (PROBE_DUP == 7) xcd_barrier(b_); } ++ph; } while (0)
    if ((PHMASK & 1) && IN_()) { p0_prologue(F, args); if (PROBE_DUP == 4) p0_prologue(F, args); }
    SEAM();
#define Hb ((bf16*)(F.ws + WS_H))
#define XB ((bf16*)(F.ws + WS_XB))
#define projT ((bf16*)(F.ws + WS_PROJT))
#define qkv ((bf16*)(F.ws + WS_QKV))
#define mix ((bf16*)(F.ws + WS_MIX))
#define ffh ((bf16*)(F.ws + WS_FFH))
#define mixin ((bf16*)(F.ws + WS_MIXIN))
#define wl (F.ws + WS_W + (size_t)l * SZ_WLAYER)
#define xin ((g == 0) ? GP(args.in[I_XP + F.z]) : GP(args.in[I_XS + F.z]) + (size_t)(g - 1) * MG * DM)
#define xres ((float*)(GAS float*)args.out + (size_t)g * MG * DM)
    for (int g = 0; g < NGRP; ++g) {
        if ((PHMASK & 2) && IN_()) norm_pass<false>(F, xin, nullptr, nullptr, nullptr, nullptr, GP(args.in[I_GMPRE + F.z]), Hb);
        SEAM();
        for (int l = 0; l < DEPTH; ++l) {
            if ((PHMASK & 4) && IN_()) {
                { pg8::Gemm gm{(const bf16*)(wl + OFF_WHY), Hb, HYIN, MG, DM}; pg8::StaticOrder S; S.init(HYIN, MG, F.G, F.bx);
                  pg8::EpiPlain E{projT, MG};
                  DUP3(pg8::gemm_phase<pg8::EpiPlain, pg8::StaticOrder, true, true>(F.lds + RING_OFF, gm, S, E)); }
                if (g == 0 || !args.taps_all) { pg8::Gemm gm{(const bf16*)(F.ws + WS_W4T) + (size_t)l * 4096 * KPAD, (const bf16*)(F.ws + WS_H3) + (size_t)l * SEQ * KPAD, 4096, SEQ, KPAD}; pg8::StaticOrder S; S.init(4096, SEQ, F.G, F.bx);
                  pg8::EpiPlain E{(bf16*)(F.ws + ((args.taps_all && l > 0) ? WS_TAPS_X + (size_t)(l - 1) * SZ_TAPS : WS_TAPS)), SEQ};
                  DUP3(pg8::gemm_phase<pg8::EpiPlain, pg8::StaticOrder, true, true>(F.lds + RING_OFF, gm, S, E)); }
                { pg8::Gemm gm{Hb, (const bf16*)(wl + OFF_WQKV), MG, QKVW, DM}; pg8::StaticOrder S; S.init(MG, QKVW, F.G, F.bx);
                  pg8::EpiRope E{qkv, QKVW, (const float*)(F.ws + WS_ROPE), QSCALE};
                  DUP3(pg8::gemm_phase<pg8::EpiRope, pg8::StaticOrder, true, true>(F.lds + RING_OFF, gm, S, E)); }
            }
            SEAM();
            if (IN_()) { if (PHMASK & 8) hyena_phase(F, args, l); if (PROBE_DUP == 2) hyena_phase(F, args, l); if (PHMASK & 16) attn_phase(F, args, l, lds); if (PROBE_DUP == 1) attn_phase(F, args, l, lds); }
            SEAM();
            if ((PHMASK & 32) && IN_()) { hynorm_phase(F, args, l); if (PROBE_DUP == 4) hynorm_phase(F, args, l); }
            SEAM();
            if ((PHMASK & 64) && IN_()) { pg8::Gemm gm{mixin, (const bf16*)(wl + OFF_WOUT), MG, DM, DM}; pg8::StaticOrder S; S.init(MG, DM, F.G, F.bx);
                pg8::EpiPlain E{mix, DM};
                DUP3(pg8::gemm_phase<pg8::EpiPlain, pg8::StaticOrder, true, true>(F.lds + RING_OFF, gm, S, E)); }
            SEAM();
            if ((PHMASK & 2) && IN_()) { if (l == 0) norm_pass<false>(F, xin, mix, GP(args.in[I_GMPOST + F.z]) + (size_t)l * DM, XB, nullptr, GP(args.in[I_GFPRE + F.z]) + (size_t)l * DM, Hb);
                else norm_pass<true>(F, XB, mix, GP(args.in[I_GMPOST + F.z]) + (size_t)l * DM, XB, nullptr, GP(args.in[I_GFPRE + F.z]) + (size_t)l * DM, Hb); }
            SEAM();
            if ((PHMASK & 128) && IN_()) { pg8::Gemm gm{Hb, (const bf16*)(wl + OFF_WGU), MG, GU, DM}; pg8::StaticOrder S; S.init(MG, GU, F.G, F.bx);
                pg8::EpiSwiGLU E{ffh, DFF};
                DUP3(pg8::gemm_phase<pg8::EpiSwiGLU, pg8::StaticOrder, true, true>(F.lds + RING_OFF, gm, S, E)); }
            SEAM();
            if ((PHMASK & 256) && IN_()) { pg8::Gemm gm{ffh, (const bf16*)(wl + OFF_WDN), MG, DM, DFF}; pg8::StaticOrder S; S.init(MG, DM, F.G, F.bx);
                pg8::EpiPlain E{mixin, DM};
                DUP3(pg8::gemm_phase<pg8::EpiPlain, pg8::StaticOrder, true, true>(F.lds + RING_OFF, gm, S, E)); }
            SEAM();
            if ((PHMASK & 2) && IN_()) { if (l + 1 < DEPTH) norm_pass<true>(F, XB, mixin, GP(args.in[I_GFPOST + F.z]) + (size_t)l * DM, XB, nullptr, GP(args.in[I_GMPRE + F.z]) + (size_t)(l + 1) * DM, Hb);
                else norm_pass<true>(F, XB, mixin, GP(args.in[I_GFPOST + F.z]) + (size_t)l * DM, nullptr, xres, nullptr, nullptr); }
            SEAM();
        }
    }
#undef IN_
#undef SEAM
#undef Hb
#undef XB
#undef projT
#undef qkv
#undef mix
#undef ffh
#undef mixin
#undef wl
#undef xin
#undef xres
}

extern "C" void kernel_launch(void* const* d_in, const int* in_sizes, int n_in, void* d_out, int out_size, void* d_ws, size_t ws_size, hipStream_t stream) {
    static int grid = 0;
    if (grid == 0) {
        if (n_in != 30 || in_sizes[0] != 2 * SEQ * DM || in_sizes[1] != 4 * SEQ * DM || out_size != NSEQ * SEQ * DM || ws_size < WS_END) {
            fprintf(stderr, "kernel_launch: shape mismatch (n_in %d, out %d, ws %zu, need %zu)\n", n_in, out_size, ws_size, (size_t)WS_END); grid = -1; return; }
        int dev = 0, cus = 0;
        if (hipGetDevice(&dev) != hipSuccess || hipDeviceGetAttribute(&cus, hipDeviceAttributeMultiprocessorCount, dev) != hipSuccess) { grid = -1; return; }
        if (hipFuncSetAttribute((const void*)hymba_fwd, hipFuncAttributeMaxDynamicSharedMemorySize, LDS_BYTES) != hipSuccess) { fprintf(stderr, "kernel_launch: hipFuncSetAttribute failed\n"); grid = -1; return; }
        int per_cu = 0;
        if (hipOccupancyMaxActiveBlocksPerMultiprocessor(&per_cu, (const void*)hymba_fwd, NTHR, LDS_BYTES) != hipSuccess || per_cu < 1) fprintf(stderr, "kernel_launch: occupancy query says %d\n", per_cu);
        (void)hipGetLastError();
        grid = cus;
    }
    if (grid < 0) return;
    if (hipMemsetAsync((char*)d_ws + WS_CTL, 0, CTL_ZERO_BYTES, stream) != hipSuccess) return;
    Args a{};
    for (int i = 0; i < 30; ++i) a.in[i] = (const float*)d_in[i];
    a.out = (float*)d_out; a.ws = (unsigned char*)d_ws; a.taps_all = (ws_size >= WS_END_X) ? 1 : 0;
#if MK_PER_PHASE
    for (int p = 0; p < NPHASE; ++p) { a.ph_lo = p; a.ph_hi = p + 1; hipLaunchKernelGGL(hymba_fwd, dim3(grid), dim3(NTHR), LDS_BYTES, stream, a); }
#else
    a.ph_lo = 0; a.ph_hi = NPHASE;
    hipLaunchKernelGGL(hymba_fwd, dim3(grid), dim3(NTHR), LDS_BYTES, stream, a);
#endif
    const hipError_t le = hipPeekAtLastError();
    if (le != hipSuccess) fprintf(stderr, "kernel_launch: launch failed: %s\n", hipGetErrorName(le));
}
```

```cpp
#include <hip/hip_runtime.h>
#include <hip/hip_bf16.h>
#include <cstdio>
#include <cstdint>
#include <cmath>
namespace pg8 {
#define PG8_LAS __attribute__((address_space(3)))
typedef unsigned short bf16_t;
typedef short bf16x8 __attribute__((ext_vector_type(8)));
typedef float f32x4 __attribute__((ext_vector_type(4)));
typedef unsigned u32x4 __attribute__((ext_vector_type(4)));
constexpr int BM = 256, BK = 64, HALF = 128, HTB = HALF * BK * 2  , STAGE_BYTES = 8 * HTB, NXCD = 8, WGM = 8;

__host__ __device__ __forceinline__ int lds_byte(int r, int c) { const int st = (r >> 4) * 2 + (c >> 5), rr = r & 15, cc = c & 31, ob = rr * 64 + cc * 2; return st * 1024 + (ob ^ (((ob >> 9) & 1) << 5)); }
__host__ __device__ __forceinline__ void stage_rc(int b, int& R, int& C) { const int st = b / 1024, sb = b % 1024, swz = sb ^ (((sb >> 9) & 1) << 5); R = (st >> 1) * 16 + swz / 64; C = (st & 1) * 32 + (swz % 64) / 2; }
__host__ __device__ __forceinline__ int perm32(int rho) { const int n = rho >> 4, i = rho & 15; return 8 * (i >> 2) + 4 * n + (i & 3); }

struct Unit { int pm, pn; };
struct Gemm { const bf16_t* A; const bf16_t* Bt; int M, N, K; };

struct StaticOrder {
    int nM, nN, nwg, G, c;
    __host__ __device__ void init(int M, int N, int G_, int c_) { nM = M / BM; nN = N / BM; nwg = nM * nN; G = G_; c = c_; }
    __host__ __device__ bool next(int i, Unit& u) const {
        const long L = (long)i * G + c; if (L >= nwg) return false;
        int wgid = (int)L; { const int q = nwg / NXCD, r = nwg % NXCD, xcd = wgid % NXCD, off = wgid / NXCD; wgid = (xcd < r ? xcd * (q + 1) : r * (q + 1) + (xcd - r) * q) + off; }
        const int nig = WGM * nN, gid = wgid / nig, fm = gid * WGM, gsz = (nM - fm) < WGM ? (nM - fm) : WGM;
        u.pm = fm + ((wgid % nig) % gsz); u.pn = (wgid % nig) / gsz; return true;
    }
    __device__ __forceinline__ void a_ready(const Unit&) const {}
    __device__ __forceinline__ void done(const Unit&) const {}
};

__device__ __forceinline__ unsigned cvt_pk_bf16(float lo, float hi) { unsigned r; asm volatile("v_cvt_pk_bf16_f32 %0, %1, %2" : "=v"(r) : "v"(lo), "v"(hi)); return r; }
typedef float f32x2 __attribute__((ext_vector_type(2)));
struct EpiPlain {
    static constexpr bool PERM = true, AFTER_DRAIN = false;
    bf16_t* O; int ldc;
    __device__ __forceinline__ void operator()(const f32x4 (&acc)[2][2][4][2], const Unit& u, int wr, int wc, int fr, int fq) const {
        const int row0 = u.pm * BM + wr * 64 + fr, col0 = u.pn * BM + wc * 32 + 8 * fq;
#pragma unroll
        for (int ai = 0; ai < 2; ++ai)
#pragma unroll
            for (int m = 0; m < 4; ++m) { bf16_t* rowp = O + (size_t)(row0 + ai * HALF + m * 16) * ldc + col0;
#pragma unroll
                for (int bj = 0; bj < 2; ++bj) { const f32x4 v0 = acc[ai][bj][m][0], v1 = acc[ai][bj][m][1];
                    u32x4 w; w.x = cvt_pk_bf16(v0[0], v0[1]); w.y = cvt_pk_bf16(v0[2], v0[3]); w.z = cvt_pk_bf16(v1[0], v1[1]); w.w = cvt_pk_bf16(v1[2], v1[3]);
                    *(u32x4*)(rowp + bj * HALF) = w; } }
    }
};
struct EpiRope {
    static constexpr bool PERM = true, AFTER_DRAIN = false;
    bf16_t* O; int ldc; const float* cs; float qscale;
    __device__ __forceinline__ void operator()(const f32x4 (&acc)[2][2][4][2], const Unit& u, int wr, int wc, int fr, int fq) const {
        const int row0 = u.pm * BM + wr * 64 + fr, col0 = u.pn * BM + wc * 32 + 8 * fq;
        const bool rope = u.pn < 8; const float sc = u.pn < 4 ? qscale : 1.0f;
        const int p0 = 16 * (wc & 1) + 4 * fq;
#pragma unroll
        for (int ai = 0; ai < 2; ++ai)
#pragma unroll
            for (int m = 0; m < 4; ++m) { const int row = row0 + ai * HALF + m * 16; bf16_t* rowp = O + (size_t)row * ldc + col0;
                f32x4 t0 = {1.f, 0.f, 1.f, 0.f}, t1 = {1.f, 0.f, 1.f, 0.f};
                if (rope) { const float* tp = cs + ((size_t)(row & 8191) * 32 + p0) * 2; t0 = *(const f32x4*)tp; t1 = *(const f32x4*)(tp + 4); }
#pragma unroll
                for (int bj = 0; bj < 2; ++bj) { const f32x4 v0 = acc[ai][bj][m][0], v1 = acc[ai][bj][m][1];
                    f32x4 o0, o1;
                    o0[0] = (v0[0] * t0[0] - v0[1] * t0[1]) * sc; o0[1] = (v0[0] * t0[1] + v0[1] * t0[0]) * sc;
                    o0[2] = (v0[2] * t0[2] - v0[3] * t0[3]) * sc; o0[3] = (v0[2] * t0[3] + v0[3] * t0[2]) * sc;
                    o1[0] = (v1[0] * t1[0] - v1[1] * t1[1]) * sc; o1[1] = (v1[0] * t1[1] + v1[1] * t1[0]) * sc;
                    o1[2] = (v1[2] * t1[2] - v1[3] * t1[3]) * sc; o1[3] = (v1[2] * t1[3] + v1[3] * t1[2]) * sc;
                    u32x4 w; w.x = cvt_pk_bf16(o0[0], o0[1]); w.y = cvt_pk_bf16(o0[2], o0[3]); w.z = cvt_pk_bf16(o1[0], o1[1]); w.w = cvt_pk_bf16(o1[2], o1[3]);
                    *(u32x4*)(rowp + bj * HALF) = w; } }
    }
};
struct EpiSwiGLU {
    static constexpr bool PERM = true, AFTER_DRAIN = false;
    bf16_t* O; int ldc;
    static __device__ __forceinline__ float silu_mul(float g, float u) { return g * u * __builtin_amdgcn_rcpf(1.0f + __builtin_amdgcn_exp2f(-1.4426950408889634f * g)); }
    __device__ __forceinline__ void operator()(const f32x4 (&acc)[2][2][4][2], const Unit& u, int wr, int wc, int fr, int fq) const {
        const int row0 = u.pm * BM + wr * 64 + fr, col0 = u.pn * HALF + wc * 32 + 8 * fq;
#pragma unroll
        for (int ai = 0; ai < 2; ++ai)
#pragma unroll
            for (int m = 0; m < 4; ++m) { bf16_t* rowp = O + (size_t)(row0 + ai * HALF + m * 16) * ldc + col0;
                const f32x4 g0 = acc[ai][0][m][0], g1 = acc[ai][0][m][1], u0 = acc[ai][1][m][0], u1 = acc[ai][1][m][1];
                u32x4 w; w.x = cvt_pk_bf16(silu_mul(g0[0], u0[0]), silu_mul(g0[1], u0[1])); w.y = cvt_pk_bf16(silu_mul(g0[2], u0[2]), silu_mul(g0[3], u0[3]));
                w.z = cvt_pk_bf16(silu_mul(g1[0], u1[0]), silu_mul(g1[1], u1[1])); w.w = cvt_pk_bf16(silu_mul(g1[2], u1[2]), silu_mul(g1[3], u1[3]));
                *(u32x4*)rowp = w; }
    }
};
template <class Epi, class Sched, bool ALIGN_EPI = false, bool SP2 = false>
__device__ __forceinline__ void gemm_phase(PG8_LAS unsigned char* lds, const Gemm g, const Sched& S, const Epi& E) {
    int tid = threadIdx.x; asm volatile("" : "+v"(tid));
    const int wid = __builtin_amdgcn_readfirstlane(tid >> 6), lane = tid & 63, wr = wid >> 2, wc = wid & 3, fr = lane & 15, fq = lane >> 4;
    const int K = g.K, nt = K / BK;
    unsigned voffA[2], voffB[2];
#pragma unroll
    for (int i = 0; i < 2; ++i) { int R, C; stage_rc(tid * 16 + i * 8192, R, C); const int Rb = Epi::PERM ? ((R & ~31) + perm32(R & 31)) : R;
        voffA[i] = (unsigned)(R * K + C) * 2u; voffB[i] = (unsigned)(Rb * K + C) * 2u; }
    const size_t kstep = (size_t)(BK * 2);
    const size_t hstep = (size_t)HALF * K * 2;
    const size_t tstep = 2 * hstep;
    const unsigned ldsw = (unsigned)wid * 1024u;
    const int aoff = lds_byte(wr * 64 + fr, fq * 8), boff = lds_byte(wc * 32 + fr, fq * 8);
#define PG8_SA(b, h) (((b) * 2 + (h)) * HTB)
#define PG8_SB(b, h) ((4 + (b) * 2 + (h)) * HTB)
#define PG8_STAGE(bufoff, gbase, voff) do { _Pragma("unroll") for (int _i = 0; _i < 2; ++_i) \
        __builtin_amdgcn_global_load_lds((const unsigned*)((const char*)(gbase) + (voff)[_i]), (PG8_LAS unsigned*)(lds + (bufoff) + ldsw + _i * 8192), 16, 0, 0); } while (0)
#define PG8_LDA(dst, b, h) do { _Pragma("unroll") for (int m = 0; m < 4; ++m) _Pragma("unroll") for (int k = 0; k < 2; ++k) dst[m][k] = *(const PG8_LAS bf16x8*)(lds + PG8_SA(b, h) + aoff + m * 2048 + k * 1024); } while (0)
#define PG8_LDB(dst, b, h) do { _Pragma("unroll") for (int n = 0; n < 2; ++n) _Pragma("unroll") for (int k = 0; k < 2; ++k) dst[n][k] = *(const PG8_LAS bf16x8*)(lds + PG8_SB(b, h) + boff + n * 2048 + k * 1024); } while (0)
#define PG8_MMA(ai, bj, At, Bt) do { __builtin_amdgcn_s_setprio(1); _Pragma("unroll") for (int m = 0; m < 4; ++m) _Pragma("unroll") for (int n = 0; n < 2; ++n) _Pragma("unroll") for (int k = 0; k < 2; ++k) \
        acc[ai][bj][m][n] = __builtin_amdgcn_mfma_f32_16x16x32_bf16(Bt[n][k], At[m][k], acc[ai][bj][m][n], 0, 0, 0); __builtin_amdgcn_s_setprio(0); } while (0)
#define PG8_WAIT_V(n) asm volatile("s_waitcnt vmcnt(" #n ")" ::: "memory")
#define PG8_WAIT_L(n) asm volatile("s_waitcnt lgkmcnt(" #n ")" ::: "memory")
#define PG8_BAR __builtin_amdgcn_s_barrier()
#define PG8_SCHED __builtin_amdgcn_sched_barrier(0)
    Unit cur, nxt; int ui = 0;
    if (!S.next(0, cur)) return;
    f32x4 acc[2][2][4][2];
#pragma unroll
    for (int a = 0; a < 2; ++a)
#pragma unroll
        for (int b = 0; b < 2; ++b)
#pragma unroll
            for (int m = 0; m < 4; ++m)
#pragma unroll
                for (int n = 0; n < 2; ++n) acc[a][b][m][n] = (f32x4){0.f, 0.f, 0.f, 0.f};
    bf16x8 At[4][2], B0[2][2], B1[2][2];
    const char* cA = (const char*)g.A + (size_t)cur.pm * tstep; const char* cB = (const char*)g.Bt + (size_t)cur.pn * tstep;
    S.a_ready(cur);
    if constexpr (SP2) {
        PG8_STAGE(PG8_SB(0, 0), cB, voffB); PG8_STAGE(PG8_SB(0, 1), cB + hstep, voffB); PG8_STAGE(PG8_SA(0, 0), cA, voffA); PG8_STAGE(PG8_SA(0, 1), cA + hstep, voffA);
        if (wr == 1) PG8_BAR;
        PG8_WAIT_V(2); PG8_BAR;
        PG8_STAGE(PG8_SB(1, 0), cB + kstep, voffB); PG8_STAGE(PG8_SA(1, 0), cA + kstep, voffA); PG8_STAGE(PG8_SB(1, 1), cB + hstep + kstep, voffB);
        PG8_WAIT_V(6); PG8_BAR;
    } else {
        PG8_STAGE(PG8_SB(0, 0), cB, voffB); PG8_STAGE(PG8_SA(0, 0), cA, voffA); PG8_STAGE(PG8_SB(0, 1), cB + hstep, voffB); PG8_STAGE(PG8_SA(0, 1), cA + hstep, voffA);
        if (wr == 1) PG8_BAR;
        PG8_WAIT_V(4); PG8_BAR;
        PG8_STAGE(PG8_SB(1, 0), cB + kstep, voffB); PG8_STAGE(PG8_SA(1, 0), cA + kstep, voffA); PG8_STAGE(PG8_SB(1, 1), cB + hstep + kstep, voffB);
        PG8_WAIT_V(6); PG8_BAR;
    }
    for (;;) {
        const bool has_next = S.next(ui + 1, nxt);
        const char* nA = has_next ? (const char*)g.A + (size_t)nxt.pm * tstep : cA; const char* nB = has_next ? (const char*)g.Bt + (size_t)nxt.pn * tstep : cB;
        for (int t = 0; t < nt; t += 2) {
            const bool last = (t == nt - 2);
            const char* a1 = cA + (size_t)(t + 1) * kstep;
            const char* a2 = last ? nA : cA + (size_t)(t + 2) * kstep; const char* b2 = last ? nB : cB + (size_t)(t + 2) * kstep;
            const char* a3 = a2 + kstep; const char* b3 = b2 + kstep;
            if (last && has_next) S.a_ready(nxt);
            if constexpr (SP2) {
            PG8_LDB(B0, 0, 0); PG8_LDB(B1, 0, 1); PG8_SCHED; PG8_LDA(At, 0, 0); PG8_STAGE(PG8_SA(1, 1), a1 + hstep, voffA);
            PG8_WAIT_V(8); PG8_WAIT_L(0); PG8_BAR; PG8_MMA(0, 0, At, B0); PG8_MMA(0, 1, At, B1); PG8_BAR; PG8_SCHED;
            PG8_LDA(At, 0, 1); PG8_STAGE(PG8_SB(0, 0), b2, voffB); PG8_STAGE(PG8_SB(0, 1), b2 + hstep, voffB); PG8_STAGE(PG8_SA(0, 0), a2, voffA);
            PG8_WAIT_V(8); PG8_WAIT_L(0); PG8_BAR; PG8_MMA(1, 0, At, B0); PG8_MMA(1, 1, At, B1); PG8_BAR; PG8_SCHED;
            PG8_LDB(B0, 1, 0); PG8_LDB(B1, 1, 1); PG8_SCHED; PG8_LDA(At, 1, 0); PG8_STAGE(PG8_SA(0, 1), a2 + hstep, voffA);
            PG8_WAIT_V(8); PG8_WAIT_L(0); PG8_BAR; PG8_MMA(0, 0, At, B0); PG8_MMA(0, 1, At, B1); PG8_BAR; PG8_SCHED;
            PG8_LDA(At, 1, 1); PG8_STAGE(PG8_SB(1, 0), b3, voffB); PG8_STAGE(PG8_SB(1, 1), b3 + hstep, voffB); PG8_STAGE(PG8_SA(1, 0), a3, voffA);
            PG8_WAIT_V(8); PG8_WAIT_L(0); PG8_BAR; PG8_MMA(1, 0, At, B0); PG8_MMA(1, 1, At, B1); PG8_BAR; PG8_SCHED;
            } else {
            PG8_LDB(B0, 0, 0); PG8_SCHED; PG8_LDA(At, 0, 0); PG8_STAGE(PG8_SA(1, 1), a1 + hstep, voffA);
            PG8_WAIT_L(8); PG8_BAR; PG8_WAIT_L(0); PG8_MMA(0, 0, At, B0); PG8_BAR; PG8_SCHED;
            PG8_LDB(B1, 0, 1); PG8_STAGE(PG8_SB(0, 0), b2, voffB);
            PG8_BAR; PG8_WAIT_L(0); PG8_MMA(0, 1, At, B1); PG8_BAR;
            PG8_LDA(At, 0, 1); PG8_STAGE(PG8_SA(0, 0), a2, voffA);
            PG8_BAR; PG8_WAIT_L(0); PG8_MMA(1, 0, At, B0); PG8_BAR; PG8_SCHED;
            PG8_STAGE(PG8_SB(0, 1), b2 + hstep, voffB);
            PG8_WAIT_V(6); PG8_BAR; PG8_MMA(1, 1, At, B1); PG8_BAR;
            PG8_LDB(B0, 1, 0); PG8_SCHED; PG8_LDA(At, 1, 0); PG8_STAGE(PG8_SA(0, 1), a2 + hstep, voffA);
            PG8_WAIT_L(8); PG8_BAR; PG8_WAIT_L(0); PG8_MMA(0, 0, At, B0); PG8_BAR; PG8_SCHED;
            PG8_LDB(B1, 1, 1); PG8_STAGE(PG8_SB(1, 0), b3, voffB);
            PG8_BAR; PG8_WAIT_L(0); PG8_MMA(0, 1, At, B1); PG8_BAR;
            PG8_LDA(At, 1, 1); PG8_STAGE(PG8_SA(1, 0), a3, voffA);
            PG8_BAR; PG8_WAIT_L(0); PG8_MMA(1, 0, At, B0); PG8_BAR; PG8_SCHED;
            PG8_STAGE(PG8_SB(1, 1), b3 + hstep, voffB);
            PG8_WAIT_V(6); PG8_BAR; PG8_MMA(1, 1, At, B1); PG8_BAR;
            }
        }
        if constexpr (ALIGN_EPI) { if (wr == 0) PG8_BAR; }
        if constexpr (!Epi::AFTER_DRAIN) { E(acc, cur, wr, wc, fr, fq); S.done(cur); }
        if (!has_next) break;
#pragma unroll
        for (int a = 0; a < 2; ++a)
#pragma unroll
            for (int b = 0; b < 2; ++b)
#pragma unroll
                for (int m = 0; m < 4; ++m)
#pragma unroll
                    for (int n = 0; n < 2; ++n) acc[a][b][m][n] = (f32x4){0.f, 0.f, 0.f, 0.f};
        cur = nxt; cA = nA; cB = nB; ++ui;
        if constexpr (ALIGN_EPI) { if (wr == 1) PG8_BAR; }
    }
    PG8_WAIT_V(0);
    if constexpr (!ALIGN_EPI) { if (wr == 0) PG8_BAR; }
    PG8_BAR;
    if constexpr (Epi::AFTER_DRAIN) { E.fused(acc, cur, wr, wc, fr, fq, lds, wid, lane); S.done(cur); }
#undef PG8_SA
#undef PG8_SB
#undef PG8_STAGE
#undef PG8_LDA
#undef PG8_LDB
#undef PG8_MMA
#undef PG8_WAIT_V
#undef PG8_WAIT_L
#undef PG8_BAR
#undef PG8_SCHED
}
}
namespace att {
using bf16x8 = __attribute__((ext_vector_type(8))) short;
using s16x4  = __attribute__((ext_vector_type(4))) short;
using f32x16 = __attribute__((ext_vector_type(16))) float;
using u32x4  = __attribute__((ext_vector_type(4))) unsigned;
typedef unsigned short bf16;
constexpr int DQ = 64, DV = 128, NW = 8, QBLK = 32, KVBLK = 64, LDR = 3072;
constexpr int SHM_V = KVBLK * DV * 2, SHM_K = KVBLK * DQ * 2, SHM_ATTN = 3 * SHM_V + 3 * SHM_K + NW * 64 * 4 + 64;
constexpr int SHM_ATTN_ALL = SHM_ATTN + NW * QBLK * DV * 2;
#ifndef ATT_OVF_LIMIT
#define ATT_OVF_LIMIT 1.152921504606847e18f
#endif
#ifndef ATT_SDEPTH
#define ATT_SDEPTH 2
#endif
constexpr float THR2 = 11.0f;
#define KSWZ64(row, colB) ((row) * 128 + ((colB) ^ ((((row) >> 1) & 7) << 4)))
#define SBAR() __builtin_amdgcn_sched_barrier(0)
template <int K> __device__ __forceinline__ float sx(float v) { return __builtin_bit_cast(float, __builtin_amdgcn_ds_swizzle(__builtin_bit_cast(int, v), (K << 10) | 0x1f)); }
__device__ __forceinline__ int crow(int r, int hi) { return (r & 3) + 8 * (r >> 2) + 4 * hi; }
__device__ __forceinline__ unsigned cvtpk(float lo, float hi) { unsigned r; asm volatile("v_cvt_pk_bf16_f32 %0, %1, %2" : "=v"(r) : "v"(lo), "v"(hi)); return r; }
__device__ __forceinline__ void partialSM(f32x16& p0, f32x16& p1, float& m_reg, float& mn, float& alpha) {
  float pmax = p0[0];
#pragma unroll
  for (int r = 1; r < 16; ++r) pmax = fmaxf(pmax, p0[r]);
#pragma unroll
  for (int r = 0; r < 16; ++r) pmax = fmaxf(pmax, p1[r]);
  { auto rr = __builtin_amdgcn_permlane32_swap(__float_as_uint(pmax), __float_as_uint(pmax), false, false);
    pmax = fmaxf(__uint_as_float(rr[0]), __uint_as_float(rr[1])); }
  if (__builtin_expect(__all(pmax - m_reg <= THR2), 1)) { mn = m_reg; alpha = 1.f; }
  else { mn = fmaxf(m_reg, pmax); alpha = __builtin_amdgcn_exp2f(m_reg - mn); m_reg = mn; }
#pragma unroll
  for (int r = 0; r < 16; ++r) p0[r] = p0[r] - mn;
#pragma unroll
  for (int r = 0; r < 16; ++r) p1[r] = p1[r] - mn;
#pragma unroll
  for (int r = 0; r < 16; ++r) p0[r] = __builtin_amdgcn_exp2f(p0[r]);
}
__device__ __forceinline__ void finishSM(f32x16& p0, f32x16& p1, float alpha, float& l_reg, bf16x8& pa0, bf16x8& pa1, bf16x8& pa2, bf16x8& pa3) {
#pragma unroll
  for (int r = 0; r < 16; ++r) p1[r] = __builtin_amdgcn_exp2f(p1[r]);
  float ps = 0;
#pragma unroll
  for (int r = 0; r < 16; ++r) ps += p0[r];
#pragma unroll
  for (int r = 0; r < 16; ++r) ps += p1[r];
  { auto rr = __builtin_amdgcn_permlane32_swap(__float_as_uint(ps), __float_as_uint(ps), false, false);
    ps = __uint_as_float(rr[0]) + __uint_as_float(rr[1]); }
  l_reg = l_reg * alpha + ps;
#define PK4(P, BASE, OUT) do { unsigned a0 = cvtpk(P[BASE + 0], P[BASE + 1]), a1 = cvtpk(P[BASE + 2], P[BASE + 3]);   \
    unsigned b0 = cvtpk(P[BASE + 4], P[BASE + 5]), b1 = cvtpk(P[BASE + 6], P[BASE + 7]);                              \
    auto r0 = __builtin_amdgcn_permlane32_swap(a0, b0, false, false); auto r1 = __builtin_amdgcn_permlane32_swap(a1, b1, false, false); \
    u32x4 w = {r0[0], r1[0], r0[1], r1[1]}; OUT = *reinterpret_cast<bf16x8*>(&w); } while (0)
  PK4(p0, 0, pa0); PK4(p0, 8, pa1); PK4(p1, 0, pa2); PK4(p1, 8, pa3);
#undef PK4
}
__device__ __forceinline__ void qkt(f32x16& p0, f32x16& p1, const char* Ks, const bf16x8* qr, int r32, int hi) {
  p0 = f32x16{}; p1 = f32x16{};
#pragma unroll
  for (int d0 = 0; d0 < 4; ++d0) { const int cb = (d0 * 16 + hi * 8) * 2;
    bf16x8 b0 = *reinterpret_cast<const bf16x8*>(Ks + KSWZ64(r32, cb));
    bf16x8 b1 = *reinterpret_cast<const bf16x8*>(Ks + KSWZ64(32 + r32, cb));
    p0 = __builtin_amdgcn_mfma_f32_32x32x16_bf16(b0, qr[d0], p0, 0, 0, 0);
    p1 = __builtin_amdgcn_mfma_f32_32x32x16_bf16(b1, qr[d0], p1, 0, 0, 0); }
}
__device__ __forceinline__ void qkt_ref(f32x16& p0, f32x16& p1, const char* Ks, const bf16x8* qr, const f32x16& negm, int r32, int hi) {
#pragma unroll
  for (int d0 = 0; d0 < 4; ++d0) { const int cb = (d0 * 16 + hi * 8) * 2;
    bf16x8 b0 = *reinterpret_cast<const bf16x8*>(Ks + KSWZ64(r32, cb));
    bf16x8 b1 = *reinterpret_cast<const bf16x8*>(Ks + KSWZ64(32 + r32, cb));
    if (d0 == 0) { p0 = __builtin_amdgcn_mfma_f32_32x32x16_bf16(b0, qr[0], negm, 0, 0, 0); p1 = __builtin_amdgcn_mfma_f32_32x32x16_bf16(b1, qr[0], negm, 0, 0, 0); }
    else { p0 = __builtin_amdgcn_mfma_f32_32x32x16_bf16(b0, qr[d0], p0, 0, 0, 0); p1 = __builtin_amdgcn_mfma_f32_32x32x16_bf16(b1, qr[d0], p1, 0, 0, 0); } }
}
__device__ __forceinline__ void exp_half(f32x16& p) {
#pragma unroll
  for (int r = 0; r < 16; ++r) p[r] = __builtin_amdgcn_exp2f(p[r]);
}
__device__ __forceinline__ void sub_exp_half(f32x16& p0, f32x16& p1, float m) {
#pragma unroll
  for (int r = 0; r < 16; ++r) p0[r] = p0[r] - m;
#pragma unroll
  for (int r = 0; r < 16; ++r) p1[r] = p1[r] - m;
#pragma unroll
  for (int r = 0; r < 16; ++r) p0[r] = __builtin_amdgcn_exp2f(p0[r]);
}
__device__ __forceinline__ void finishSM_fast(f32x16& p0, f32x16& p1, float& l_reg, bool& ovf, bf16x8& pa0, bf16x8& pa1, bf16x8& pa2, bf16x8& pa3) {
  float al = 1.f; float l0 = 0.f;
  finishSM(p0, p1, al, l0, pa0, pa1, pa2, pa3);
  ovf = ovf || !(l0 < ATT_OVF_LIMIT);
  l_reg += l0;
}
__device__ __forceinline__ int v_st(int k, int c) { const int kk = (k & ~0xC) | ((k & 4) << 1) | ((k & 8) >> 1); return ((kk >> 3) * 4 + (c >> 5)) * 512 + ((kk & 7) * 32 + (c & 31)) * 2; }
__device__ __forceinline__ int v_rd_base(int lane) { return ((lane & 3) << 3) | (((lane >> 2) & 3) << 6) | (((lane >> 4) & 1) << 5) | (((lane >> 5) & 1) << 8); }
constexpr int v_rd_off(int d0, int ks, int half) { return d0 * 512 + ks * 4096 + half * 2048; }
template <int OFF> __device__ __forceinline__ s16x4 tr_read(int vb) {
  s16x4 r; asm volatile("ds_read_b64_tr_b16 %0, %1 offset:%2" : "=&v"(r) : "v"(vb), "i"(OFF) : "memory"); return r;
}
template <int D0> __device__ __forceinline__ void pv_one(f32x16& od, int vb, bf16x8 pa0, bf16x8 pa1, bf16x8 pa2, bf16x8 pa3) {
  const s16x4 l0 = tr_read<v_rd_off(D0, 0, 0)>(vb), h0 = tr_read<v_rd_off(D0, 0, 1)>(vb), l1 = tr_read<v_rd_off(D0, 1, 0)>(vb), h1 = tr_read<v_rd_off(D0, 1, 1)>(vb);
  const s16x4 l2 = tr_read<v_rd_off(D0, 2, 0)>(vb), h2 = tr_read<v_rd_off(D0, 2, 1)>(vb), l3 = tr_read<v_rd_off(D0, 3, 0)>(vb), h3 = tr_read<v_rd_off(D0, 3, 1)>(vb);
  asm volatile("s_waitcnt lgkmcnt(0)" ::: "memory"); SBAR();
#define PK(L, H) (bf16x8){L[0], L[1], L[2], L[3], H[0], H[1], H[2], H[3]}
  od = __builtin_amdgcn_mfma_f32_32x32x16_bf16(pa0, PK(l0, h0), od, 0, 0, 0);
  od = __builtin_amdgcn_mfma_f32_32x32x16_bf16(pa1, PK(l1, h1), od, 0, 0, 0);
  od = __builtin_amdgcn_mfma_f32_32x32x16_bf16(pa2, PK(l2, h2), od, 0, 0, 0);
  od = __builtin_amdgcn_mfma_f32_32x32x16_bf16(pa3, PK(l3, h3), od, 0, 0, 0);
#undef PK
}
__device__ __forceinline__ void pv_d0(f32x16* o, int vb, bf16x8 pa0, bf16x8 pa1, bf16x8 pa2, bf16x8 pa3) {
  pv_one<0>(o[0], vb, pa0, pa1, pa2, pa3); pv_one<1>(o[1], vb, pa0, pa1, pa2, pa3); pv_one<2>(o[2], vb, pa0, pa1, pa2, pa3); pv_one<3>(o[3], vb, pa0, pa1, pa2, pa3);
}
__device__ __forceinline__ void glds16(const void* gsrc, unsigned lds_dst) { unsigned keep;
  asm volatile("s_mov_b32 %0, m0\n\ts_mov_b32 m0, %2\n\ts_nop 0\n\tglobal_load_lds_dwordx4 %1, off\n\ts_mov_b32 m0, %0" : "=&s"(keep) : "v"(gsrc), "s"(lds_dst) : "memory"); }
template <bool FAST>
__device__ __forceinline__ bool attn_map(const bf16* __restrict__ Kh, const bf16* __restrict__ Vh, const bf16* __restrict__ Qh  , int seq, char* V_lds, char* K_lds, float* ws_base,
                                         f32x16 (&o)[4], float& l_out) {
    int tid = threadIdx.x; asm volatile("" : "+v"(tid));
    const int wid = __builtin_amdgcn_readfirstlane(tid >> 6), r32 = tid & 31, hi = (tid >> 5) & 1;
    float* al_l = ws_base + wid * 64 + 32;
    const bf16* Qw = Qh + (long)(wid * QBLK + r32) * LDR + hi * 8;
    const int lane_ = tid & 63;
    const unsigned lds0 = (unsigned)(uintptr_t)V_lds;
    const bf16 *vsrc0, *vsrc1, *ksrc;
    { const int o0 = (2 * wid) * 1024 + 16 * lane_, o1 = o0 + 1024, ok = wid * 1024 + 16 * lane_;
      auto vmap = [](int o, int& k, int& c) { const int sub = o >> 9, w = o & 511, kk = ((sub >> 2) << 3) | (w >> 6); k = (kk & ~0xC) | ((kk & 4) << 1) | ((kk & 8) >> 1); c = (sub & 3) * 32 + ((w & 63) >> 1); };
      int k0_, c0_, k1_, c1_; vmap(o0, k0_, c0_); vmap(o1, k1_, c1_);
      vsrc0 = Vh + (long)k0_ * LDR + c0_; vsrc1 = Vh + (long)k1_ * LDR + c1_;
      const int row = ok >> 7, cb = (ok & 127) ^ (((row >> 1) & 7) << 4);
      ksrc = Kh + (long)row * LDR + (cb >> 1); }
    const int vb0 = (int)(uintptr_t)V_lds + v_rd_base(tid & 63);
    float m_reg = -1e30f, l_reg = 0; bf16x8 qr[4]; bool ovf = false;
#pragma unroll
    for (int d0 = 0; d0 < 4; ++d0) { o[d0] = f32x16{}; qr[d0] = *reinterpret_cast<const bf16x8*>(Qw + d0 * 16); }
#define DMA_TILE(t, b) do { const long ro_ = (long)(t) * KVBLK * LDR; \
      glds16(vsrc0 + ro_, (unsigned)__builtin_amdgcn_readfirstlane(lds0 + (b) * SHM_V + (2 * wid) * 1024)); \
      glds16(vsrc1 + ro_, (unsigned)__builtin_amdgcn_readfirstlane(lds0 + (b) * SHM_V + (2 * wid + 1) * 1024)); \
      glds16(ksrc + ro_, (unsigned)__builtin_amdgcn_readfirstlane(lds0 + 3 * SHM_V + (b) * SHM_K + wid * 1024)); } while (0)
#define DMA_WAIT() asm volatile("s_waitcnt vmcnt(0)" ::: "memory")
#define RESC(a) do { if constexpr (!FAST) { if (__any((a) < 1.f)) { if (hi == 0) al_l[r32] = (a); asm volatile("s_waitcnt lgkmcnt(0)" ::: "memory"); \
    _Pragma("unroll") for (int d = 0; d < 4; ++d) _Pragma("unroll") for (int r = 0; r < 16; ++r) o[d][r] *= al_l[crow(r, hi)]; } } } while (0)
#define PSM(P0, P1, MN, AL) do { if constexpr (FAST) exp_half(P0); else partialSM(P0, P1, m_reg, MN, AL); } while (0)
#define FSM(P0, P1, AL) do { if constexpr (FAST) finishSM_fast(P0, P1, l_reg, ovf, pa0, pa1, pa2, pa3); else finishSM(P0, P1, AL, l_reg, pa0, pa1, pa2, pa3); } while (0)
#define STEP(PN0, PN1, MNN, ALN, PO0, PO1, ALO, jj) do { \
      SBAR(); if constexpr (FAST) qkt_ref(PN0, PN1, K_lds + bc * SHM_K, qr, negm, r32, hi); else qkt(PN0, PN1, K_lds + bc * SHM_K, qr, r32, hi); \
      if ((jj) + 1 < NT) DMA_TILE((jj) + 1, bn);              \
      FSM(PO0, PO1, ALO); SBAR(); \
      pv_d0(o, vb0 + bp * SHM_V, pa0, pa1, pa2, pa3); PSM(PN0, PN1, MNN, ALN); RESC(ALN); \
      DMA_WAIT(); __syncthreads(); \
      bp = bc; bc = bn; bn = (bn == 2) ? 0 : bn + 1; } while (0)
    f32x16 pA0, pA1, pB0, pB1; float mnA = 0.f, mnB = 0.f, alA = 1.f, alB = 1.f; bf16x8 pa0, pa1, pa2, pa3; const int NT = seq / KVBLK;
    DMA_TILE(0, 0); DMA_WAIT(); __syncthreads();
    if (1 < NT) DMA_TILE(1, 1);
    qkt(pA0, pA1, K_lds, qr, r32, hi); partialSM(pA0, pA1, m_reg, mnA, alA);
    f32x16 negm = f32x16{};
    if constexpr (FAST) {
#pragma unroll
      for (int r = 0; r < 16; ++r) negm[r] = -m_reg;
      asm volatile("" : "+v"(negm));
    }
    DMA_WAIT(); __syncthreads();
    int bp = 0, bc = 1, bn = 2;
    for (int j = 1; j + 1 < NT; j += 2) {
      STEP(pB0, pB1, mnB, alB, pA0, pA1, alA, j);
      STEP(pA0, pA1, mnA, alA, pB0, pB1, alB, j + 1);
    }
    STEP(pB0, pB1, mnB, alB, pA0, pA1, alA, NT - 1);
    FSM(pB0, pB1, alB); SBAR();
    pv_d0(o, vb0 + bp * SHM_V, pa0, pa1, pa2, pa3);
#undef DMA_TILE
#undef DMA_WAIT
#undef RESC
#undef PSM
#undef FSM
#undef STEP
    l_out = l_reg;
    return ovf;
}
__device__ __forceinline__ void attn_unit(const bf16* __restrict__ qkv, long Qrow0, long Krow0, int vh, int seq, float lam, float oscale, const float* __restrict__ subln,
                                          bf16* __restrict__ Ob, int ldo, float* stash, char* lds) {
  int tid = threadIdx.x; asm volatile("" : "+v"(tid));
  const int wid = __builtin_amdgcn_readfirstlane(tid >> 6), lane = tid & 63, r32 = lane & 31, hi = lane >> 5;
  char* V_lds = lds; char* K_lds = lds + 3 * SHM_V;
  float* wsb = (float*)(lds + 3 * SHM_V + 3 * SHM_K); float* li_l = wsb + wid * 64;
  volatile unsigned* ovw = (volatile unsigned*)(lds + 3 * SHM_V + 3 * SHM_K + NW * 64 * 4);
  const bf16* Vh = qkv + Krow0 * LDR + 2048 + vh * DV;
  for (int s = 0; s < 2; ++s) {
    const int head = 2 * vh + s;
    const bf16* Kh = qkv + Krow0 * LDR + 1024 + head * DQ;
    const bf16* Qh = qkv + Qrow0 * LDR + head * DQ;
    f32x16 o[4]; float l_reg;
    const bool ovf = attn_map<true>(Kh, Vh, Qh, seq, V_lds, K_lds, wsb, o, l_reg);
    if (lane == 0) ovw[wid] = __any(ovf) ? 1u : 0u;
    __syncthreads();
    unsigned anyovf = 0u;
#pragma unroll
    for (int w = 0; w < NW; ++w) anyovf |= ovw[w];
    __syncthreads();
    if (__builtin_amdgcn_readfirstlane(anyovf) != 0u) (void)attn_map<false>(Kh, Vh, Qh, seq, V_lds, K_lds, wsb, o, l_reg);
    if (hi == 0) li_l[r32] = l_reg; asm volatile("s_waitcnt lgkmcnt(0)" ::: "memory");
    float rli[16];
#pragma unroll
    for (int r = 0; r < 16; ++r) rli[r] = __builtin_amdgcn_rcpf(li_l[crow(r, hi)]);
    typedef float f32x4_t __attribute__((ext_vector_type(4)));
    f32x4_t* st4 = (f32x4_t*)stash + (size_t)tid * 16;
    if (s == 0) {
#pragma unroll
      for (int d0 = 0; d0 < 4; ++d0)
#pragma unroll
        for (int r4 = 0; r4 < 4; ++r4) { f32x4_t v; v[0] = o[d0][4 * r4] * rli[4 * r4]; v[1] = o[d0][4 * r4 + 1] * rli[4 * r4 + 1]; v[2] = o[d0][4 * r4 + 2] * rli[4 * r4 + 2]; v[3] = o[d0][4 * r4 + 3] * rli[4 * r4 + 3]; st4[d0 * 4 + r4] = v; }
    } else {
      float ssq[16];
#pragma unroll
      for (int r = 0; r < 16; ++r) ssq[r] = 0.f;
#pragma unroll
      for (int d0 = 0; d0 < 4; ++d0)
#pragma unroll
        for (int r4 = 0; r4 < 4; ++r4) { const f32x4_t sv = st4[d0 * 4 + r4];
#pragma unroll
          for (int i = 0; i < 4; ++i) { const int r = 4 * r4 + i; const float v = sv[i] - lam * (o[d0][r] * rli[r]); o[d0][r] = v; ssq[r] += v * v; } }
#pragma unroll
      for (int r = 0; r < 16; ++r) {
        float a = ssq[r];
        a += sx<1>(a); a += sx<2>(a); a += sx<4>(a); a += sx<8>(a); a += sx<16>(a);
        ssq[r] = oscale / sqrtf(a * (1.0f / 128.0f) + 1e-6f);
      }
      float g[4];
#pragma unroll
      for (int d0 = 0; d0 < 4; ++d0) g[d0] = subln[d0 * 32 + r32];
      bf16* stg = (bf16*)(lds + SHM_ATTN) + wid * (QBLK * DV);
      unsigned so = (unsigned)((4 * hi) * DV + r32); asm volatile("" : "+v"(so));
#pragma unroll
      for (int r = 0; r < 16; ++r) {
#pragma unroll
        for (int d0 = 0; d0 < 4; ++d0) { const unsigned w = cvtpk(o[d0][r] * ssq[r] * g[d0], 0.f); (stg + ((r & 3) + 8 * (r >> 2)) * DV + d0 * 32)[so] = (bf16)(w & 0xffffu); } }
      asm volatile("s_waitcnt lgkmcnt(0)" ::: "memory");
      int ldo_ = ldo; asm volatile("" : "+s"(ldo_));
      bf16* Ow = Ob + (long)(wid * QBLK) * ldo_;
      const int srow = lane >> 4, sch = lane & 15;
#pragma unroll
      for (int i = 0; i < 8; ++i) { const int row = i * 4 + srow; const u32x4 v = *(const u32x4*)(stg + row * DV + sch * 8); *(u32x4*)(Ow + (long)row * ldo_ + sch * 8) = v; }
    }
  }
}
#undef SBAR
}
#define GAS __attribute__((address_space(1)))
#define LAS __attribute__((address_space(3)))
typedef unsigned short bf16;
typedef unsigned v4u __attribute__((ext_vector_type(4)));
typedef float f32x4 __attribute__((ext_vector_type(4)));
typedef short bf16x8 __attribute__((ext_vector_type(8)));
typedef GAS unsigned gu32;
typedef GAS unsigned long long gu64;
#define RLX_AGENT __ATOMIC_RELAXED, __HIP_MEMORY_SCOPE_AGENT
#define LDS_WAIT() asm volatile("s_waitcnt lgkmcnt(0)" ::: "memory")
#define VM_WAIT() asm volatile("s_waitcnt vmcnt(0)" ::: "memory")
__device__ __forceinline__ unsigned long long rt() { return __builtin_amdgcn_s_memrealtime(); }
__device__ __forceinline__ unsigned f2bf(float f) { unsigned u = __builtin_bit_cast(unsigned, f); return (u + 0x7fffu + ((u >> 16) & 1u)) >> 16; }
__device__ __forceinline__ unsigned pk2(float lo, float hi) { return f2bf(lo) | (f2bf(hi) << 16); }

#define XB_TMO      128
#define XB_XCNT(j)  (256  + 64 * (j))
#define XB_XSUB(j)  (1280 + 64 * (j))
#define XB_XGEN(j)  (2304 + 64 * (j))
#define XB_TOP      3328
#define XB_TOPGEN   3392
#define XCD_BAR_WORDS 3456
#define XB_SPIN_CAP (1u << 18)

__device__ __forceinline__ unsigned xb_ld(unsigned* p)              { return __hip_atomic_load(p, __ATOMIC_RELAXED, __HIP_MEMORY_SCOPE_AGENT); }
__device__ __forceinline__ unsigned xb_add(unsigned* p, unsigned v) { return __hip_atomic_fetch_add(p, v, __ATOMIC_RELAXED, __HIP_MEMORY_SCOPE_AGENT); }
__device__ __forceinline__ unsigned xb_xcc_id() { return (unsigned)__builtin_amdgcn_s_getreg((3 << 11) | 20) & 0xFu; }
#define XB_SPIN(cond, bar) do { unsigned _sp = 0; while (cond) { __builtin_amdgcn_s_sleep(1); \
    if ((++_sp & 255u) == 0u) { if (xb_ld(&(bar)[XB_TMO])) break; if (_sp > XB_SPIN_CAP) { atomicAdd(&(bar)[XB_TMO], 1u); break; } } } } while (0)

struct XcdBarrier {
    unsigned* bar; unsigned x;
    volatile LAS unsigned* st;
};

__device__ __forceinline__ XcdBarrier xcd_barrier_post(unsigned* bar, volatile LAS unsigned* st) {
    XcdBarrier b; b.bar = bar; b.x = xb_xcc_id(); b.st = st;
    if (threadIdx.x == 0) (void)xb_add(&bar[XB_XCNT(b.x)], 1u);
    return b;
}
__device__ __forceinline__ void xcd_barrier_complete(unsigned* bar, unsigned x, unsigned& nloc, unsigned& nx) {
    const unsigned G = gridDim.x * gridDim.y * gridDim.z;
    unsigned sum, cnt, mine, sp = 0u;
    for (;;) {
        sum = 0u; cnt = 0u; mine = 0u;
#pragma unroll
        for (unsigned j = 0; j < 16; ++j) { const unsigned c = xb_ld(&bar[XB_XCNT(j)]); sum += c; cnt += (c > 0u) ? 1u : 0u; mine = (j == x) ? c : mine; }
        if (sum == G) break;
        __builtin_amdgcn_s_sleep(1);
        if ((++sp & 255u) == 0u) { if (xb_ld(&bar[XB_TMO])) break; if (sp > XB_SPIN_CAP) { atomicAdd(&bar[XB_TMO], 1u); break; } }
    }
    nloc = mine > 0u ? mine : 1u; nx = cnt > 0u ? cnt : 1u;
}

__device__ __forceinline__ void xcd_barrier(const XcdBarrier& b) {
    asm volatile("s_waitcnt vmcnt(0)" ::: "memory");
    __syncthreads();
    if (threadIdx.x == 0) {
        unsigned* bar = b.bar;
        __builtin_amdgcn_s_waitcnt(0);
        unsigned nloc = b.st[0], nx = b.st[1];
        if (nloc == 0u) { xcd_barrier_complete(bar, b.x, nloc, nx); b.st[0] = nloc; b.st[1] = nx; }
        const unsigned old = xb_add(&bar[XB_XSUB(b.x)], 1u);
        const unsigned gen = old / nloc;
        if (old + 1u == (gen + 1u) * nloc) {
            __builtin_amdgcn_fence(__ATOMIC_RELEASE, "agent");
            asm volatile("s_waitcnt vmcnt(0)" ::: "memory");
            const unsigned og = xb_add(&bar[XB_TOP], 1u);
            const unsigned tg = og / nx;
            if (og + 1u == (tg + 1u) * nx) xb_add(&bar[XB_TOPGEN], 1u);
            else XB_SPIN(xb_ld(&bar[XB_TOPGEN]) == tg, bar);
            __builtin_amdgcn_fence(__ATOMIC_ACQUIRE, "agent");
            xb_add(&bar[XB_XGEN(b.x)], 1u);
            asm volatile("s_waitcnt vmcnt(0)" ::: "memory");
        } else {
            XB_SPIN(xb_ld(&bar[XB_XGEN(b.x)]) == gen, bar);
            __builtin_amdgcn_fence(__ATOMIC_ACQUIRE, "agent");
            asm volatile("s_waitcnt vmcnt(0)" ::: "memory");
        }
    }
    __syncthreads();
}
#define HYD __device__ __forceinline__
#define HYDM __device__ __forceinline__
#define HY_DEVICE 1
#ifdef HY_DEVICE
#define HY_OPAQUE(x) asm volatile("" : "+v"(x))
#else
#define HY_OPAQUE(x) (void)(x)
#endif
typedef float cf __attribute__((ext_vector_type(2)));
typedef float cf2 __attribute__((ext_vector_type(4)));
template <class P> struct HyP2 {};
template <> struct HyP2<cf*> { typedef cf2* type; };
#ifdef HY_DEVICE
template <> struct HyP2<__attribute__((address_space(3))) cf*> { typedef __attribute__((address_space(3))) cf2* type; };
#endif
HYD cf cf_add(cf a, cf b) { return a + b; }
HYD cf cf_sub(cf a, cf b) { return a - b; }
HYD cf cf_mul(cf a, cf b) { return cf{a.x * b.x - a.y * b.y, a.x * b.y + a.y * b.x}; }
HYD cf cf_mulc(cf a, cf b) { return cf{a.x * b.x + a.y * b.y, a.y * b.x - a.x * b.y}; }
constexpr int FN = 16384, FT = 512, FLOG = 14, FNP = FN + 4 * (FN >> 6);
constexpr int SEQL = 8192;
HYD int HP(int i) { return i + ((i >> 6) << 2); }
#define HY_C1 0.92387953251128674f
#define HY_S1 0.38268343236508977f
#define HY_R2 0.70710678118654752f
template <int M16> HYD cf mul_root16(cf w) {
    if (M16 == 0) return w;
    if (M16 == 4) return cf{w.y, -w.x};
    if (M16 == 2) return cf{(w.x + w.y) * HY_R2, (w.y - w.x) * HY_R2};
    if (M16 == 6) return cf{(w.y - w.x) * HY_R2, -(w.x + w.y) * HY_R2};
    if (M16 == 1) return cf_mul(w, cf{HY_C1, -HY_S1});
    if (M16 == 3) return cf_mul(w, cf{HY_S1, -HY_C1});
    if (M16 == 5) return cf_mul(w, cf{-HY_S1, -HY_C1});
    return cf_mul(w, cf{-HY_C1, -HY_S1});
}
template <int Q, int U, bool INV, bool ZUP, bool HLO> struct HyStage {
    static HYDM void run(cf (&e)[1 << Q], const cf (&tw)[Q]) {
        constexpr int R = 1 << Q, half = R >> (U + 1);
#pragma unroll
        for (int k = 0; k < R; ++k) {
            if ((k & half) == 0) {
                const int kp = k & (half - 1);
                cf w = tw[U];
                switch (kp * 16 / (2 * half)) {
                    case 0: break;
                    case 1: w = mul_root16<1>(w); break;
                    case 2: w = mul_root16<2>(w); break;
                    case 3: w = mul_root16<3>(w); break;
                    case 4: w = mul_root16<4>(w); break;
                    case 5: w = mul_root16<5>(w); break;
                    case 6: w = mul_root16<6>(w); break;
                    default: w = mul_root16<7>(w); break;
                }
                if (!INV) {
                    if (ZUP && U == 0) { e[k + half] = cf_mul(e[k], w); }
                    else { const cf a = e[k], b = e[k + half]; e[k] = cf_add(a, b); e[k + half] = cf_mul(cf_sub(a, b), w); }
                } else {
                    const cf a = e[k], b = cf_mulc(e[k + half], w); e[k] = cf_add(a, b);
                    if (!(HLO && U == 0)) e[k + half] = cf_sub(a, b);
                }
            }
        }
    }
};
template <int Q, bool INV, bool ZUP, bool HLO> HYD void hy_bfly(cf (&e)[1 << Q], cf t) {
    cf tw[Q]; tw[0] = t;
#pragma unroll
    for (int u = 1; u < Q; ++u) tw[u] = cf_mul(tw[u - 1], tw[u - 1]);
    if (Q == 4) {
        if (!INV) { HyStage<Q, 0, INV, ZUP, HLO>::run(e, tw); HyStage<Q, 1, INV, ZUP, HLO>::run(e, tw); HyStage<Q, 2 % Q, INV, ZUP, HLO>::run(e, tw); HyStage<Q, 3 % Q, INV, ZUP, HLO>::run(e, tw); }
        else      { HyStage<Q, 3 % Q, INV, ZUP, HLO>::run(e, tw); HyStage<Q, 2 % Q, INV, ZUP, HLO>::run(e, tw); HyStage<Q, 1, INV, ZUP, HLO>::run(e, tw); HyStage<Q, 0, INV, ZUP, HLO>::run(e, tw); }
    } else {
        if (!INV) { HyStage<Q, 0, INV, ZUP, HLO>::run(e, tw); HyStage<Q, 1, INV, ZUP, HLO>::run(e, tw); }
        else      { HyStage<Q, 1, INV, ZUP, HLO>::run(e, tw); HyStage<Q, 0, INV, ZUP, HLO>::run(e, tw); }
    }
}
#ifdef HY_DEVICE
#define HY_MULT(T, X, Y) "v_pk_mul_f32 " T ", " X ", " Y " op_sel:[1,1] op_sel_hi:[1,0]\n\t"
#define HY_FMAP(R, X, Y, T) "v_pk_fma_f32 " R ", " X ", " Y ", " T " op_sel_hi:[0,1,1] neg_lo:[0,0,1]\n\t"
#define HY_FMAC(R, X, Y, T) "v_pk_fma_f32 " R ", " X ", " Y ", " T " op_sel_hi:[0,1,1] neg_hi:[1,0,0]\n\t"
#define HY_ADD(R, A, B) "v_pk_add_f32 " R ", " A ", " B "\n\t"
#define HY_SUB(R, A, B) "v_pk_add_f32 " R ", " A ", " B " neg_lo:[0,1] neg_hi:[0,1]\n\t"
HYD void hy_cmul2(cf& r0, cf x0, cf y0, cf& r1, cf x1, cf y1) { cf t0, t1;
    asm(HY_MULT("%0", "%4", "%5") HY_MULT("%1", "%6", "%7") HY_FMAP("%2", "%4", "%5", "%0") HY_FMAP("%3", "%6", "%7", "%1")
        : "=&v"(t0), "=&v"(t1), "=&v"(r0), "=&v"(r1) : "v"(x0), "v"(y0), "v"(x1), "v"(y1)); }
HYD cf hy_cmul1(cf x, cf y) { cf t, r;
    asm(HY_MULT("%0", "%2", "%3") "s_nop 0\n\t" HY_FMAP("%1", "%2", "%3", "%0") : "=&v"(t), "=&v"(r) : "v"(x), "v"(y)); return r; }
HYD void hy_bf2_fwd(cf& a0, cf& b0, cf w0, cf& a1, cf& b1, cf w1) { cf d0, d1, t0, t1;
    asm(HY_SUB("%4", "%0", "%1") HY_ADD("%0", "%0", "%1") HY_SUB("%5", "%2", "%3") HY_ADD("%2", "%2", "%3")
        HY_MULT("%6", "%4", "%8") HY_MULT("%7", "%5", "%9") HY_FMAP("%1", "%4", "%8", "%6") HY_FMAP("%3", "%5", "%9", "%7")
        : "+v"(a0), "+v"(b0), "+v"(a1), "+v"(b1), "=&v"(d0), "=&v"(d1), "=&v"(t0), "=&v"(t1) : "v"(w0), "v"(w1)); }
HYD void hy_bf2_fwdz(cf a0, cf& b0, cf w0, cf a1, cf& b1, cf w1) { hy_cmul2(b0, a0, w0, b1, a1, w1); }
HYD void hy_bf2_inv(cf& a0, cf& b0, cf w0, cf& a1, cf& b1, cf w1) { cf t0, t1;
    asm(HY_MULT("%4", "%1", "%6") HY_MULT("%5", "%3", "%7") HY_FMAC("%4", "%1", "%6", "%4") HY_FMAC("%5", "%3", "%7", "%5")
        HY_SUB("%1", "%0", "%4") HY_SUB("%3", "%2", "%5") HY_ADD("%0", "%0", "%4") HY_ADD("%2", "%2", "%5")
        : "+v"(a0), "+v"(b0), "+v"(a1), "+v"(b1), "=&v"(t0), "=&v"(t1) : "v"(w0), "v"(w1)); }
HYD void hy_bf2_invl(cf& a0, cf b0, cf w0, cf& a1, cf b1, cf w1) { cf t0, t1;
    asm(HY_MULT("%2", "%4", "%6") HY_MULT("%3", "%5", "%7") HY_FMAC("%2", "%4", "%6", "%2") HY_FMAC("%3", "%5", "%7", "%3")
        HY_ADD("%0", "%0", "%2") HY_ADD("%1", "%1", "%3")
        : "+v"(a0), "+v"(a1), "=&v"(t0), "=&v"(t1) : "v"(b0), "v"(b1), "v"(w0), "v"(w1)); }
HYD cf hy_rot(cf w) { cf r; asm("v_pk_add_f32 %0, %1, 0 op_sel:[1,0] op_sel_hi:[0,0] neg_hi:[1,0]" : "=v"(r) : "v"(w)); return r; }
#else
HYD void hy_cmul2(cf& r0, cf x0, cf y0, cf& r1, cf x1, cf y1) { const cf p0 = cf_mul(x0, y0), p1 = cf_mul(x1, y1); r0 = p0; r1 = p1; }
HYD cf hy_cmul1(cf x, cf y) { return cf_mul(x, y); }
HYD void hy_bf2_fwd(cf& a0, cf& b0, cf w0, cf& a1, cf& b1, cf w1) { const cf d0 = cf_sub(a0, b0), d1 = cf_sub(a1, b1); a0 = cf_add(a0, b0); a1 = cf_add(a1, b1); b0 = cf_mul(d0, w0); b1 = cf_mul(d1, w1); }
HYD void hy_bf2_fwdz(cf a0, cf& b0, cf w0, cf a1, cf& b1, cf w1) { b0 = cf_mul(a0, w0); b1 = cf_mul(a1, w1); }
HYD void hy_bf2_inv(cf& a0, cf& b0, cf w0, cf& a1, cf& b1, cf w1) { const cf p0 = cf_mulc(b0, w0), p1 = cf_mulc(b1, w1); b0 = cf_sub(a0, p0); b1 = cf_sub(a1, p1); a0 = cf_add(a0, p0); a1 = cf_add(a1, p1); }
HYD void hy_bf2_invl(cf& a0, cf b0, cf w0, cf& a1, cf b1, cf w1) { a0 = cf_add(a0, cf_mulc(b0, w0)); a1 = cf_add(a1, cf_mulc(b1, w1)); }
HYD cf hy_rot(cf w) { return cf{w.y, -w.x}; }
#endif
template <int U, bool INV, bool ZUP, bool HLO> HYD void hy_stage16(cf (&e)[16], const cf* W) {
    constexpr int half = 8 >> U;
#pragma unroll
    for (int j = 0; j < 8; j += 2) {
        const int k0 = ((j / half) * 2 * half) + (j % half), k1 = (((j + 1) / half) * 2 * half) + ((j + 1) % half);
        const cf w0 = W[k0 & (half - 1)], w1 = W[k1 & (half - 1)];
        if (!INV) { if (ZUP && U == 0) hy_bf2_fwdz(e[k0], e[k0 + half], w0, e[k1], e[k1 + half], w1); else hy_bf2_fwd(e[k0], e[k0 + half], w0, e[k1], e[k1 + half], w1); }
        else { if (HLO && U == 0) hy_bf2_invl(e[k0], e[k0 + half], w0, e[k1], e[k1 + half], w1); else hy_bf2_inv(e[k0], e[k0 + half], w0, e[k1], e[k1 + half], w1); }
    }
}
template <bool INV, bool ZUP, bool HLO> HYD void hy_bfly16(cf (&e)[16], cf t) {
    cf W0[8], W1[4], W2[2], W3[1], tw1, tw2;
    cf k1 = cf{HY_C1, -HY_S1}, k2 = cf{HY_R2, -HY_R2}, k3 = cf{HY_S1, -HY_C1};
    W0[0] = t;
    hy_cmul2(W0[1], t, k1, W0[3], t, k3);
    hy_cmul2(W0[2], t, k2, tw1, t, t);
    W1[0] = tw1;
    hy_cmul2(W1[1], tw1, k2, tw2, tw1, tw1);
    W2[0] = tw2;
    W3[0] = hy_cmul1(tw2, tw2);
#pragma unroll
    for (int i = 0; i < 4; ++i) W0[4 + i] = hy_rot(W0[i]);
    W1[2] = hy_rot(W1[0]); W1[3] = hy_rot(W1[1]); W2[1] = hy_rot(W2[0]);
    if (!INV) { hy_stage16<0, INV, ZUP, HLO>(e, W0); hy_stage16<1, INV, ZUP, HLO>(e, W1); hy_stage16<2, INV, ZUP, HLO>(e, W2); hy_stage16<3, INV, ZUP, HLO>(e, W3); }
    else      { hy_stage16<3, INV, ZUP, HLO>(e, W3); hy_stage16<2, INV, ZUP, HLO>(e, W2); hy_stage16<1, INV, ZUP, HLO>(e, W1); hy_stage16<0, INV, ZUP, HLO>(e, W0); }
}
template <class PT> HYD cf hy_twid(PT thi, PT tlo, int e) { return hy_cmul1(thi[e >> 7], tlo[e & 127]); }
template <int S, bool INV, bool ZUP, bool HLO, class P, class PT>
HYD void hy_pass16(P X, PT thi, PT tlo, int tid) {
    constexpr int R = 16;
    constexpr int SP = (S >= 64) ? S + S / 16 : S;
    const int g0 = tid, g1 = tid + FT;
    const int lo0 = g0 & (S - 1), pb0 = HP((g0 / S) * S * R + lo0);
    const int lo1 = g1 & (S - 1), pb1 = HP((g1 / S) * S * R + lo1);
    cf e0[R], e1[R];
#pragma unroll
    for (int k = 0; k < R; ++k) { if (ZUP && k >= 8) e0[k] = cf{0.f, 0.f}; else e0[k] = X[pb0 + k * SP]; }
#pragma unroll
    for (int k = 0; k < R; ++k) { if (ZUP && k >= 8) e1[k] = cf{0.f, 0.f}; else e1[k] = X[pb1 + k * SP]; }
    const cf t0 = hy_twid(thi, tlo, lo0 * (FN / (R * S))), t1 = hy_twid(thi, tlo, lo1 * (FN / (R * S)));
    hy_bfly16<INV, ZUP, HLO>(e0, t0);
#pragma unroll
    for (int k = 0; k < R; ++k) { if (!(HLO && k >= 8)) X[pb0 + k * SP] = e0[k]; }
    hy_bfly16<INV, ZUP, HLO>(e1, t1);
#pragma unroll
    for (int k = 0; k < R; ++k) { if (!(HLO && k >= 8)) X[pb1 + k * SP] = e1[k]; }
}
template <bool INV> HYD void hy_r4(cf (&e)[4]) {
    if (!INV) {
        const cf a0 = e[0] + e[2], b0 = e[0] - e[2], a1 = e[1] + e[3], d = e[1] - e[3], b1 = cf{d.y, -d.x};
        e[0] = a0 + a1; e[1] = a0 - a1; e[2] = b0 + b1; e[3] = b0 - b1;
    } else {
        const cf a0 = e[0] + e[1], a1 = e[0] - e[1], a2 = e[2] + e[3], d = e[2] - e[3], b = cf{-d.y, d.x};
        e[0] = a0 + a2; e[2] = a0 - a2; e[1] = a1 + b; e[3] = a1 - b;
    }
}
template <bool INV, class P, class PK>
HYD void hy_pass4(P X, int tid, PK KM) {
    typedef typename HyP2<P>::type P2;
    const int w = tid >> 6, lane = tid & 63;
#pragma unroll 1
    for (int gb = 0; gb < 2; ++gb) {
        cf2 a[4], b[4], ka[4], kb[4];
        const int g0 = (gb * 8 + w) * 256 + lane;
#pragma unroll
        for (int u = 0; u < 4; ++u) { const int g = g0 + 64 * u; P2 X2 = (P2)(X + HP(4 * g)); a[u] = X2[0]; b[u] = X2[1];
            if (KM) { const unsigned gi = (unsigned)(4 * g) & 0x3fffu; ka[u] = ((const cf2*)(KM + gi))[0]; kb[u] = ((const cf2*)(KM + gi))[1]; } }
#pragma unroll
        for (int u = 0; u < 4; ++u) { const int g = g0 + 64 * u; P2 X2 = (P2)(X + HP(4 * g));
            cf e[4] = {cf{a[u].x, a[u].y}, cf{a[u].z, a[u].w}, cf{b[u].x, b[u].y}, cf{b[u].z, b[u].w}};
            hy_r4<INV>(e);
            if (KM) { cf q0, q1, q2, q3; hy_cmul2(q0, e[0], cf{ka[u].x, ka[u].y}, q1, e[1], cf{ka[u].z, ka[u].w}); hy_cmul2(q2, e[2], cf{kb[u].x, kb[u].y}, q3, e[3], cf{kb[u].z, kb[u].w}); e[0] = q0; e[1] = q1; e[2] = q2; e[3] = q3; }
            X2[0] = cf2{e[0].x, e[0].y, e[1].x, e[1].y}; X2[1] = cf2{e[2].x, e[2].y, e[3].x, e[3].y}; }
    }
}
HYD int hy_brev14(int p) {
    unsigned v = (unsigned)p;
    v = ((v >> 1) & 0x55555555u) | ((v & 0x55555555u) << 1);
    v = ((v >> 2) & 0x33333333u) | ((v & 0x33333333u) << 2);
    v = ((v >> 4) & 0x0F0F0F0Fu) | ((v & 0x0F0F0F0Fu) << 4);
    v = ((v >> 8) & 0x00FF00FFu) | ((v & 0x00FF00FFu) << 8);
    v = (v >> 16) | (v << 16);
    return (int)(v >> (32 - FLOG));
}
HYD float hy_bf2f(unsigned short b) { unsigned u = (unsigned)b << 16; float f; __builtin_memcpy(&f, &u, 4); return f; }
HYD unsigned hy_f2bf(float f) { unsigned u; __builtin_memcpy(&u, &f, 4); return (u + 0x7fffu + ((u >> 16) & 1u)) >> 16; }
template <class PR> HYD void hy_sconv2(PR rowj  , unsigned tid, int j, float w0, float w1, float w2, float b, float& u0, float& u1) {
    const unsigned d1 = rowj[tid];
    const unsigned d0r = (rowj - 1)[tid], d2r = (rowj + 1)[tid];
    const unsigned d0 = (j > 0 || tid > 0) ? d0r : 0u;
    const unsigned d2 = (j < 7 || tid < (unsigned)(FT - 1)) ? d2r : 0u;
    const float pm1 = hy_bf2f((unsigned short)(d0 >> 16)), p0 = hy_bf2f((unsigned short)(d1 & 0xffffu)), p1 = hy_bf2f((unsigned short)(d1 >> 16)), p2 = hy_bf2f((unsigned short)(d2 & 0xffffu));
    u0 = b + w0 * pm1 + w1 * p0 + w2 * p1;
    u1 = b + w0 * p0 + w1 * p1 + w2 * p2;
}
template <class P> HYD void hy_filter_step(P X, const unsigned short* taps, float delta, int tid) {
    typedef typename HyP2<P>::type P2;
    typedef unsigned u32x2h __attribute__((ext_vector_type(2)));
    u32x2h raw[SEQL / (4 * FT)][4];
    const float dscale = -delta * (1.4426950408889634f / (float)(SEQL - 1)); (void)dscale;
#pragma unroll
    for (int j = 0; j < SEQL / (4 * FT); ++j)
#pragma unroll
        for (int q = 0; q < 4; ++q) raw[j][q] = *(const u32x2h*)(taps + (size_t)q * 1024 * SEQL + ((unsigned)(4 * (tid + FT * j)) & 0x1fffu));
#pragma unroll
    for (int j = 0; j < SEQL / (4 * FT); ++j) {
        const int t = 4 * (tid + FT * j);
        cf2 a[4];
#pragma unroll
        for (int q = 0; q < 4; ++q) a[q] = cf2{hy_bf2f((unsigned short)(raw[j][q].x & 0xffffu)), hy_bf2f((unsigned short)(raw[j][q].x >> 16)), hy_bf2f((unsigned short)(raw[j][q].y & 0xffffu)), hy_bf2f((unsigned short)(raw[j][q].y >> 16))};
        cf2 dec;
#pragma unroll
#ifdef HY_DEVICE
        for (int e = 0; e < 4; ++e) dec[e] = __builtin_amdgcn_exp2f((float)(t + e) * dscale);
#else
        for (int e = 0; e < 4; ++e) dec[e] = expf(-((float)(t + e) * (1.0f / (float)(SEQL - 1))) * delta);
#endif
        const cf2 a0 = a[0] * dec, a1 = a[1] * dec, a2 = a[2] * dec, a3 = a[3] * dec;
        P2 Xf = (P2)(X + HP(t));
        if (t == 0) { Xf[0] = cf2{a0[0] + a1[0], a2[0] + a3[0], a0[1], a2[1]}; float z0 = 0.f; HY_OPAQUE(z0); X[HP(SEQL)] = cf{z0, z0}; }
        else Xf[0] = cf2{a0[0], a2[0], a0[1], a2[1]};
        Xf[1] = cf2{a0[2], a2[2], a0[3], a2[3]};
        const int pbk = HP(FN - t - 4);
        X[pbk + 1] = cf{a1[3], a3[3]}; X[pbk + 2] = cf{a1[2], a3[2]}; X[pbk + 3] = cf{a1[1], a3[1]};
        if (t > 0) X[HP(FN - t)] = cf{a1[0], a3[0]};
    }
}
template <class P> HYD void hy_sep_step(P X, cf* K1g, cf* K2g, int tid) {
    const float sc = 0.5f / (float)FN;
#pragma unroll 1
    for (int j0 = 0; j0 < FN / FT; j0 += 4) {
        cf a[4], b[4];
#pragma unroll
        for (int u = 0; u < 4; ++u) { const int p = tid + FT * (j0 + u);
            const int f = hy_brev14(p), q = hy_brev14((FN - f) & (FN - 1));
            a[u] = X[HP(p)]; b[u] = X[HP(q)]; }
#pragma unroll
        for (int u = 0; u < 4; ++u) { const int p = tid + FT * (j0 + u);
            const unsigned pi = (unsigned)p & 0x3fffu;
            K1g[pi] = cf{(a[u].x + b[u].x) * sc, (a[u].y - b[u].y) * sc};
            K2g[pi] = cf{(a[u].y + b[u].y) * sc, -(a[u].x - b[u].x) * sc}; }
    }
}
template <class P> HYD void hy_load_step(P X, const unsigned* r0, const unsigned* r1, float w0, float w1, float w2, float b, float (&zr)[8][4], int tid) {
    typedef typename HyP2<P>::type P2;
#pragma unroll
    for (int j = 0; j < 8; ++j) {
        const int t = 2 * (tid + FT * j);
        hy_sconv2(r0 + FT * j, (unsigned)tid, j, w0, w1, w2, b, zr[j][0], zr[j][2]);
        hy_sconv2(r1 + FT * j, (unsigned)tid, j, w0, w1, w2, b, zr[j][1], zr[j][3]);
        *(P2)(X + HP(t)) = cf2{zr[j][0], zr[j][1], zr[j][2], zr[j][3]};
    }
}
template <class P> HYD void hy_gate1_step(P X, const unsigned* r0, const unsigned* r1, float w0, float w1, float w2, float b, float bias, float (&zr)[8][4], int tid) {
    typedef typename HyP2<P>::type P2;
#pragma unroll
    for (int j = 0; j < 8; ++j) {
        const int t = 2 * (tid + FT * j);
        float xa0, xa1, xb0, xb1;
        hy_sconv2(r0 + FT * j, (unsigned)tid, j, w0, w1, w2, b, xa0, xa1);
        hy_sconv2(r1 + FT * j, (unsigned)tid, j, w0, w1, w2, b, xb0, xb1);
        P2 xp = (P2)(X + HP(t));
        const cf2 y = *xp;
        zr[j][0] = xa0 * (y.x + zr[j][0] * bias); zr[j][1] = xb0 * (y.y + zr[j][1] * bias);
        zr[j][2] = xa1 * (y.z + zr[j][2] * bias); zr[j][3] = xb1 * (y.w + zr[j][3] * bias);
        *xp = cf2{zr[j][0], zr[j][1], zr[j][2], zr[j][3]};
    }
}
template <class P> HYD void hy_gate2_step(P X, const unsigned* r0, const unsigned* r1, float w0, float w1, float w2, float b, float bias, const float (&zr)[8][4], unsigned* out0, unsigned* out1, int tid) {
    typedef typename HyP2<P>::type P2;
#pragma unroll
    for (int j = 0; j < 8; ++j) {
        const int t = 2 * (tid + FT * j);
        float xa0, xa1, xb0, xb1;
        hy_sconv2(r0 + FT * j, (unsigned)tid, j, w0, w1, w2, b, xa0, xa1);
        hy_sconv2(r1 + FT * j, (unsigned)tid, j, w0, w1, w2, b, xb0, xb1);
        const cf2 y = *(P2)(X + HP(t));
        const float za0 = xa0 * (y.x + zr[j][0] * bias), zb0 = xb0 * (y.y + zr[j][1] * bias);
        const float za1 = xa1 * (y.z + zr[j][2] * bias), zb1 = xb1 * (y.w + zr[j][3] * bias);
        (out0 + FT * j)[(unsigned)tid] = hy_f2bf(za0) | (hy_f2bf(za1) << 16);
        (out1 + FT * j)[(unsigned)tid] = hy_f2bf(zb0) | (hy_f2bf(zb1) << 16);
    }
}
HYD float hy_sconv1(unsigned D0, unsigned D1, int t, float w0, float w1, float w2, float b, bool pad0, bool padL) {
    const unsigned sh = ((unsigned)(t - 1) & 1u) << 4;
#ifdef HY_DEVICE
    const unsigned lo = __builtin_amdgcn_alignbit(D1, D0, sh), hi = D1 >> sh;
#else
    const unsigned long long w = (((unsigned long long)D1 << 32) | D0) >> sh; const unsigned lo = (unsigned)w, hi = (unsigned)(w >> 32);
#endif
    float e0 = hy_bf2f((unsigned short)(lo & 0xffffu)), e1 = hy_bf2f((unsigned short)(lo >> 16)), e2 = hy_bf2f((unsigned short)(hi & 0xffffu));
    if (pad0 && t == 0) e0 = 0.f;
    if (padL && t == SEQL - 1) e2 = 0.f;
    return b + w0 * e0 + w1 * e1 + w2 * e2;
}
struct HyRaw { unsigned d[2][8][4]; };
HYD void hy_raw_load(HyRaw& R, const unsigned* r0, const unsigned* r1, int tid) {
#pragma unroll
    for (int r = 0; r < 2; ++r)
#pragma unroll
        for (int k = 0; k < 8; ++k) { const unsigned du = ((unsigned)(tid + FT * r + 1024 * k + 1) >> 1) & 0x1fffu;
            R.d[r][k][0] = (r0 - 1)[du]; R.d[r][k][1] = r0[du]; R.d[r][k][2] = (r1 - 1)[du]; R.d[r][k][3] = r1[du]; }
}
template <class P, class PT> HYD void hy_convA_fwd(P X, PT thi, PT tlo, int tid, const HyRaw& R, float w0, float w1, float w2, float b, cf (&zr)[2][8]) {
#pragma unroll
    for (int r = 0; r < 2; ++r) {
        const int i0 = tid + FT * r, pb = HP(i0);
        cf e[16];
#pragma unroll
        for (int k = 0; k < 8; ++k) { const int t = i0 + 1024 * k; const bool p0 = (r == 0 && k == 0), pL = (r == 1 && k == 7); e[k] = cf{hy_sconv1(R.d[r][k][0], R.d[r][k][1], t, w0, w1, w2, b, p0, pL), hy_sconv1(R.d[r][k][2], R.d[r][k][3], t, w0, w1, w2, b, p0, pL)}; zr[r][k] = e[k]; }
#pragma unroll
        for (int k = 8; k < 16; ++k) e[k] = cf{0.f, 0.f};
        hy_bfly16<false, true, false>(e, hy_twid(thi, tlo, i0));
#pragma unroll
        for (int k = 0; k < 16; ++k) X[pb + k * 1088] = e[k];
    }
}
template <bool LAST, class P, class PT> HYD void hy_gateA(P X, PT thi, PT tlo, int tid, const HyRaw& R, float w0, float w1, float w2, float b, float bias,
                                                           cf (&zr)[2][8], unsigned short* out0, unsigned short* out1) {
#pragma unroll
    for (int r = 0; r < 2; ++r) {
        const int i0 = tid + FT * r, pb = HP(i0);
        cf e[16];
#pragma unroll
        for (int k = 0; k < 16; ++k) e[k] = X[pb + k * 1088];
        const cf tw = hy_twid(thi, tlo, i0);
        hy_bfly16<true, false, true>(e, tw);
#pragma unroll
        for (int k = 0; k < 8; ++k) { const int t = i0 + 1024 * k;
            const bool p0 = (r == 0 && k == 0), pL = (r == 1 && k == 7);
            const float xa = hy_sconv1(R.d[r][k][0], R.d[r][k][1], t, w0, w1, w2, b, p0, pL), xb = hy_sconv1(R.d[r][k][2], R.d[r][k][3], t, w0, w1, w2, b, p0, pL);
            const cf z = cf{xa * (e[k].x + zr[r][k].x * bias), xb * (e[k].y + zr[r][k].y * bias)};
            if (LAST) {
#ifdef HY_DEVICE
                unsigned pk; asm("v_cvt_pk_bf16_f32 %0, %1, %2" : "=v"(pk) : "v"(z.x), "v"(z.y)); const unsigned ti = (unsigned)t & 0x1fffu; out0[ti] = (unsigned short)(pk & 0xffffu); out1[ti] = (unsigned short)(pk >> 16);
#else
                out0[t] = (unsigned short)hy_f2bf(z.x); out1[t] = (unsigned short)hy_f2bf(z.y);
#endif
            }
            else { zr[r][k] = z; e[k] = z; } }
        if (!LAST) {
#pragma unroll
            for (int k = 8; k < 16; ++k) e[k] = cf{0.f, 0.f};
            hy_bfly16<false, true, false>(e, tw);
#pragma unroll
            for (int k = 0; k < 16; ++k) X[pb + k * 1088] = e[k];
        }
    }
}
constexpr int NWAVES = 8, NTHR = NWAVES * 64;
constexpr int DM = 2048, SEQ = 8192, DEPTH = 4, NSEQ = 6, GSEQ = 2, NGRP = NSEQ / GSEQ, MG = GSEQ * SEQ;
constexpr int HYW = 1024, HYIN = 3072, QKVW = 3072, DFF = 5632, GU = 2 * DFF, FEMB = 33, FHID = 64;
constexpr float EPS = 1e-6f;
constexpr float QSCALE = 0.125f * 1.4426950408889634f;
constexpr size_t MiB = 1u << 20;
constexpr size_t WS_CTL = 0, CTL_ZERO_BYTES = 1 * MiB;
constexpr size_t SZ_WHY = (size_t)HYIN * DM * 2, SZ_WQKV = (size_t)QKVW * DM * 2, SZ_WOUT = (size_t)DM * DM * 2, SZ_WGU = (size_t)GU * DM * 2, SZ_WDN = (size_t)DM * DFF * 2;
constexpr size_t OFF_WHY = 0, OFF_WQKV = OFF_WHY + SZ_WHY, OFF_WOUT = OFF_WQKV + SZ_WQKV, OFF_WGU = OFF_WOUT + SZ_WOUT, OFF_WDN = OFF_WGU + SZ_WGU, SZ_WLAYER = OFF_WDN + SZ_WDN;
constexpr size_t WS_W = 1 * MiB;
constexpr size_t WS_ROPE = WS_W + DEPTH * SZ_WLAYER;
constexpr int KPAD = 256;
constexpr size_t WS_H3 = WS_ROPE + (size_t)SEQ * 32 * 8;
constexpr size_t WS_W4T = WS_H3 + (size_t)DEPTH * SEQ * KPAD * 2;
constexpr size_t WS_TAPS = WS_W4T + (size_t)DEPTH * 4096 * KPAD * 2;
constexpr size_t WS_FFTK = WS_TAPS + (size_t)4096 * SEQ * 2;
constexpr size_t WS_STASH = WS_FFTK + (size_t)256 * 2 * 16384 * 8;
constexpr size_t WS_XB = WS_STASH;
constexpr size_t WS_H = WS_XB + (size_t)MG * DM * 2;
constexpr size_t WS_ZT = WS_H + (size_t)MG * DM * 2;
constexpr size_t WS_PROJT = WS_ZT + (size_t)HYW * MG * 2;
constexpr size_t WS_QKV = WS_PROJT + (size_t)HYIN * MG * 2;
constexpr size_t WS_MIX = WS_PROJT;
constexpr size_t WS_FFH = WS_PROJT;
constexpr size_t WS_MIXIN = WS_QKV + (size_t)MG * QKVW * 2;
constexpr size_t WS_END = WS_MIXIN + (size_t)MG * DM * 2;
constexpr size_t SZ_TAPS = (size_t)4096 * SEQ * 2, WS_TAPS_X = WS_END, WS_END_X = WS_TAPS_X + (DEPTH - 1) * SZ_TAPS;
static_assert((size_t)MG * DFF * 2 <= (size_t)HYIN * MG * 2 + (size_t)MG * QKVW * 2, "FFH overlay fits PROJT|QKV");
static_assert(WS_W4T % 256 == 0 && WS_TAPS % 256 == 0 && WS_ROPE % 256 == 0 && WS_H3 % 256 == 0 && WS_FFTK % 256 == 0 && WS_XB % 256 == 0 && WS_H % 256 == 0 && SZ_WLAYER % 256 == 0, "alignment");
constexpr int CW_BAR = 4096;
constexpr int PH_PER_LAYER = 8, PH_PER_GROUP = 1 + DEPTH * PH_PER_LAYER, NPHASE = 1 + NGRP * PH_PER_GROUP;
constexpr int RING_OFF = 0, RING_BYTES = 131072;
constexpr int TAB_OFF = 139264;
constexpr int MISC_OFF = TAB_OFF + 4096;
constexpr int LDS_BYTES = 147456;
static_assert(MISC_OFF + 128 <= LDS_BYTES, "LDS map");
static_assert(att::SHM_ATTN_ALL <= MISC_OFF, "attention LDS fits below the control words");
#ifndef PROBE_DUP
#define PROBE_DUP 0
#endif
#ifndef MK_PER_PHASE
#define MK_PER_PHASE 0
#endif

struct Args { const float* in[30]; float* out; unsigned char* ws; int ph_lo, ph_hi, taps_all, pad; };
enum { I_XP = 0, I_XS, I_GMPRE, I_GMPOST, I_GFPRE, I_GFPOST, I_WIN, I_CONVW, I_CONVB, I_FW1, I_FB1, I_FF1, I_FW2, I_FB2, I_FF2, I_FW3, I_FB3, I_FF3, I_FW4,
       I_HBIAS, I_HNORM, I_LQ1, I_LK1, I_LQ2, I_LK2, I_SUBLN, I_WOUT, I_WGATE, I_WUP, I_WDOWN };

template <int K> __device__ __forceinline__ float swz_xor(float v) { return __builtin_bit_cast(float, __builtin_amdgcn_ds_swizzle(__builtin_bit_cast(int, v), (K << 10) | 0x1f)); }
__device__ __forceinline__ float wave_sum(float v) {
    v += swz_xor<1>(v); v += swz_xor<2>(v); v += swz_xor<4>(v); v += swz_xor<8>(v); v += swz_xor<16>(v);
    auto rr = __builtin_amdgcn_permlane32_swap(__float_as_uint(v), __float_as_uint(v), false, false);
    return __uint_as_float(rr[0]) + __uint_as_float(rr[1]);
}
__device__ __forceinline__ bf16* wt_dst_row(int kind, int n, bf16* d0, bf16* d1, int K) {
    if (kind == 0) return d0 + (size_t)n * K;
    if (kind == 1) { if (n < HYIN) return d0 + (size_t)n * K; int q = n - HYIN; if (q < 2048) { const int hb = q & ~63, i = q & 63; q = hb + (i < 32 ? 2 * i : 2 * (i - 32) + 1); } return d1 + (size_t)q * K; }
    if (kind == 4) return d0 + (size_t)n * KPAD;
    const int r = (n >> 7) * 256 + (n & 127) + (kind == 3 ? 128 : 0); return d0 + (size_t)r * K;
}
__device__ __forceinline__ void p0_transpose_item(const float* W, int K, int N, int kind, bf16* d0, bf16* d1, LAS float* scr, int item, int lane) {
    const int nblk = N / 32, kb = item / nblk, nb = item % nblk, k0 = 64 * kb, n0 = 32 * nb;
    float wv[32];
#pragma unroll
    for (int i = 0; i < 32; ++i) { const int kk = 2 * i + (lane >> 5); wv[i] = W[(size_t)(k0 + kk) * N + n0 + (lane & 31)]; }
#pragma unroll
    for (int i = 0; i < 32; ++i) { const int kk = 2 * i + (lane >> 5); scr[kk * 33 + (lane & 31)] = wv[i]; }
    LDS_WAIT(); asm volatile("" ::: "memory");
    const int c = lane & 7;
#pragma unroll
    for (int j = 0; j < 4; ++j) { const int n = (lane >> 3) + 8 * j; const LAS float* s = scr + (8 * c) * 33 + n;
        v4u o; o.x = pk2(s[0 * 33], s[1 * 33]); o.y = pk2(s[2 * 33], s[3 * 33]); o.z = pk2(s[4 * 33], s[5 * 33]); o.w = pk2(s[6 * 33], s[7 * 33]);
        *(GAS v4u*)(wt_dst_row(kind, n0 + n, d0, d1, K) + k0 + 8 * c) = o; }
    LDS_WAIT(); asm volatile("" ::: "memory");
}
__device__ __forceinline__ void sincos_red(double ang, float& s, float& c) {
    const double k = rint(ang * 0.15915494309189535); const float r = (float)(ang - k * 6.283185307179586);
    s = sinf(r); c = cosf(r);
}
#define GP(p) ((const float*)(const GAS float*)(p))
#define LAUNDER_TID(F) do { int t_ = (F).tid; asm volatile("" : "+v"(t_)); (F).tid = t_; (F).lane = t_ & 63; int z_ = 0; asm volatile("" : "+s"(z_)); (F).z = z_; unsigned long long w_ = (unsigned long long)(F).ws0; asm volatile("" : "+s"(w_)); (F).ws = (unsigned char*)(GAS unsigned char*)w_; int b_ = (F).bx0, v_ = (F).vcu0, g_ = (F).G0; asm volatile("" : "+s"(b_), "+s"(v_), "+s"(g_)); (F).bx = b_; (F).vcu = v_; (F).G = g_; } while (0)
struct Frame {
    LAS unsigned char* lds; volatile LAS unsigned* MISC; gu32* ctl;
    int tid, lane, wave, vcu, G, bx;
    int vcu0, G0, bx0;
    float* out; unsigned char* ws; unsigned char* ws0; int z;
};
__device__ __forceinline__ void p0_prologue(Frame& F, const Args& A) {
    LAS float* scr = (LAS float*)(F.lds + RING_OFF + F.wave * 16384);
    const int gw = F.vcu * NWAVES + F.wave, NGW = F.G * NWAVES;
    constexpr int I_IN = (DM / 64) * ((HYIN + QKVW) / 32), I_OUT = (DM / 64) * (DM / 32), I_G = (DM / 64) * (DFF / 32), I_D = (DFF / 64) * (DM / 32);
    constexpr int I_W4 = 4096 / 32;
    constexpr int PER_L = I_IN + I_OUT + 2 * I_G + I_D + I_W4;
    for (int it = gw; it < DEPTH * PER_L; it += NGW) {
        const int l = it / PER_L; int r = it % PER_L;
        unsigned char* wl = F.ws + WS_W + (size_t)l * SZ_WLAYER;
        if (r < I_IN) { p0_transpose_item(GP(A.in[I_WIN + F.z]) + (size_t)l * DM * (HYIN + QKVW), DM, HYIN + QKVW, 1, (bf16*)(wl + OFF_WHY), (bf16*)(wl + OFF_WQKV), scr, r, F.lane); continue; } r -= I_IN;
        if (r < I_OUT) { p0_transpose_item(GP(A.in[I_WOUT + F.z]) + (size_t)l * DM * DM, DM, DM, 0, (bf16*)(wl + OFF_WOUT), nullptr, scr, r, F.lane); continue; } r -= I_OUT;
        if (r < I_G) { p0_transpose_item(GP(A.in[I_WGATE + F.z]) + (size_t)l * DM * DFF, DM, DFF, 2, (bf16*)(wl + OFF_WGU), nullptr, scr, r, F.lane); continue; } r -= I_G;
        if (r < I_G) { p0_transpose_item(GP(A.in[I_WUP + F.z]) + (size_t)l * DM * DFF, DM, DFF, 3, (bf16*)(wl + OFF_WGU), nullptr, scr, r, F.lane); continue; } r -= I_G;
        if (r < I_D) { p0_transpose_item(GP(A.in[I_WDOWN + F.z]) + (size_t)l * DFF * DM, DFF, DM, 0, (bf16*)(wl + OFF_WDN), nullptr, scr, r, F.lane); continue; } r -= I_D;
        { bf16* w4t = (bf16*)(F.ws + WS_W4T) + (size_t)l * 4096 * KPAD;
          p0_transpose_item(GP(A.in[I_FW4 + F.z]) + (size_t)l * FHID * 4096, FHID, 4096, 4, w4t, nullptr, scr, r, F.lane);
          for (int e = F.lane; e < 32 * 24; e += 64) *(GAS v4u*)(w4t + (size_t)(32 * r + e / 24) * KPAD + 64 + 8 * (e % 24)) = (v4u){0u, 0u, 0u, 0u}; }
    }
    {
        float* cs = (float*)(F.ws + WS_ROPE);
        for (int e = F.vcu * NTHR + F.tid; e < SEQ * 32; e += F.G * NTHR) {
            const int t = e >> 5, p = e & 31;
            const double inv = exp(-9.210340371976184 * (double)(2 * p) / 64.0);
            float s, c; sincos_red((double)t * inv, s, c);
            cs[2 * e] = c; cs[2 * e + 1] = s;
        }
    }
    {
        bf16* h3b = (bf16*)(F.ws + WS_H3);
        LAS float* hb = (LAS float*)(F.lds + RING_OFF + F.wave * 16384);
        for (int task = gw; task < DEPTH * (SEQ / 64); task += NGW) {
            const int l = task / (SEQ / 64), t = (task % (SEQ / 64)) * 64 + F.lane;
            const float* w1 = GP(A.in[I_FW1 + F.z]) + (size_t)l * FEMB * FHID; const float* w2 = GP(A.in[I_FW2 + F.z]) + (size_t)l * FHID * FHID; const float* w3 = GP(A.in[I_FW3 + F.z]) + (size_t)l * FHID * FHID;
            hb[F.lane] = (float)t * (1.0f / (float)(SEQ - 1));
#pragma unroll 1
            for (int bi = 0; bi < 16; ++bi) { const double band = 1e-4 + (double)bi * ((15.0 - 1e-4) / 15.0);
                float s, c; sincos_red(6.283185307179586 * (double)t / (double)SEQ * band, s, c); hb[(1 + bi) * 64 + F.lane] = c; hb[(17 + bi) * 64 + F.lane] = -s; }
#pragma unroll 1
            for (int stage = 0; stage < 3; ++stage) {
                const float* w = stage == 0 ? w1 : (stage == 1 ? w2 : w3);
                const float* bb = (stage == 0 ? GP(A.in[I_FB1 + F.z]) : (stage == 1 ? GP(A.in[I_FB2 + F.z]) : GP(A.in[I_FB3 + F.z]))) + l * FHID;
                const float* ff = (stage == 0 ? GP(A.in[I_FF1 + F.z]) : (stage == 1 ? GP(A.in[I_FF2 + F.z]) : GP(A.in[I_FF3 + F.z]))) + l * FHID;
                const int nin = stage == 0 ? FEMB : FHID;
                typedef float f32x16_t __attribute__((ext_vector_type(16)));
                f32x16_t c0 = {}, c1 = {}, c2 = {}, c3 = {};
                LDS_WAIT();
#pragma unroll 1
                for (int i = 0; i < nin; ++i) { const float hv = hb[i * 64 + F.lane]; const f32x16_t* wr = (const f32x16_t*)(w + i * FHID);
                    c0 += wr[0] * hv; c1 += wr[1] * hv; c2 += wr[2] * hv; c3 += wr[3] * hv; }
                const f32x16_t* b16 = (const f32x16_t*)bb; const f32x16_t* f16 = (const f32x16_t*)ff;
                c0 = (c0 + b16[0]) * f16[0]; c1 = (c1 + b16[1]) * f16[1]; c2 = (c2 + b16[2]) * f16[2]; c3 = (c3 + b16[3]) * f16[3];
                if (stage < 2) {
#pragma unroll
                    for (int e = 0; e < 16; ++e) { hb[e * 64 + F.lane] = sinf(c0[e]); hb[(16 + e) * 64 + F.lane] = sinf(c1[e]); hb[(32 + e) * 64 + F.lane] = sinf(c2[e]); hb[(48 + e) * 64 + F.lane] = sinf(c3[e]); }
                } else {
                    GAS v4u* o = (GAS v4u*)(h3b + ((size_t)l * SEQ + t) * KPAD);
#pragma unroll
                    for (int q = 0; q < 2; ++q) { v4u w; w.x = pk2(sinf(c0[8 * q]), sinf(c0[8 * q + 1])); w.y = pk2(sinf(c0[8 * q + 2]), sinf(c0[8 * q + 3])); w.z = pk2(sinf(c0[8 * q + 4]), sinf(c0[8 * q + 5])); w.w = pk2(sinf(c0[8 * q + 6]), sinf(c0[8 * q + 7])); o[q] = w; }
#pragma unroll
                    for (int q = 0; q < 2; ++q) { v4u w; w.x = pk2(sinf(c1[8 * q]), sinf(c1[8 * q + 1])); w.y = pk2(sinf(c1[8 * q + 2]), sinf(c1[8 * q + 3])); w.z = pk2(sinf(c1[8 * q + 4]), sinf(c1[8 * q + 5])); w.w = pk2(sinf(c1[8 * q + 6]), sinf(c1[8 * q + 7])); o[2 + q] = w; }
#pragma unroll
                    for (int q = 0; q < 2; ++q) { v4u w; w.x = pk2(sinf(c2[8 * q]), sinf(c2[8 * q + 1])); w.y = pk2(sinf(c2[8 * q + 2]), sinf(c2[8 * q + 3])); w.z = pk2(sinf(c2[8 * q + 4]), sinf(c2[8 * q + 5])); w.w = pk2(sinf(c2[8 * q + 6]), sinf(c2[8 * q + 7])); o[4 + q] = w; }
#pragma unroll
                    for (int q = 0; q < 2; ++q) { v4u w; w.x = pk2(sinf(c3[8 * q]), sinf(c3[8 * q + 1])); w.y = pk2(sinf(c3[8 * q + 2]), sinf(c3[8 * q + 3])); w.z = pk2(sinf(c3[8 * q + 4]), sinf(c3[8 * q + 5])); w.w = pk2(sinf(c3[8 * q + 6]), sinf(c3[8 * q + 7])); o[6 + q] = w; }
#pragma unroll 1
                    for (int q = 8; q < 32; ++q) o[q] = (v4u){0u, 0u, 0u, 0u};
                }
            }
        }
    }
}
template <bool XSB>
__device__ __forceinline__ void norm_pass(Frame& F, const void* x_src, const bf16* add, const float* g_add, bf16* xb_dst, float* xf_dst, const float* g_out, bf16* h_dst) {
    const int gw = F.vcu * NWAVES + F.wave, NGW = F.G * NWAVES;
    typedef unsigned u32x2 __attribute__((ext_vector_type(2)));
    for (int m0 = gw; m0 < MG; m0 += 2 * NGW) {
        const int m1 = m0 + NGW; const bool two = m1 < MG; const int mb = two ? m1 : m0;
        f32x4 va[8], vb[8];
        if (XSB) {
            const GAS u32x2* xa = (const GAS u32x2*)((const bf16*)x_src + (size_t)m0 * DM) + F.lane; const GAS u32x2* xb = (const GAS u32x2*)((const bf16*)x_src + (size_t)mb * DM) + F.lane;
#pragma unroll
            for (int j = 0; j < 8; ++j) { const u32x2 a = xa[64 * j], b = xb[64 * j];
                va[j] = (f32x4){__uint_as_float(a.x << 16), __uint_as_float(a.x & 0xffff0000u), __uint_as_float(a.y << 16), __uint_as_float(a.y & 0xffff0000u)};
                vb[j] = (f32x4){__uint_as_float(b.x << 16), __uint_as_float(b.x & 0xffff0000u), __uint_as_float(b.y << 16), __uint_as_float(b.y & 0xffff0000u)}; }
        } else {
            const GAS f32x4* xa = (const GAS f32x4*)((const float*)x_src + (size_t)m0 * DM) + F.lane; const GAS f32x4* xb = (const GAS f32x4*)((const float*)x_src + (size_t)mb * DM) + F.lane;
#pragma unroll
            for (int j = 0; j < 8; ++j) { va[j] = xa[64 * j]; vb[j] = xb[64 * j]; }
        }
        if (add) {
            const GAS u32x2* aa = (const GAS u32x2*)(add + (size_t)m0 * DM) + F.lane; const GAS u32x2* ab = (const GAS u32x2*)(add + (size_t)mb * DM) + F.lane;
            u32x2 wa[8], wb[8];
#pragma unroll
            for (int j = 0; j < 8; ++j) { wa[j] = aa[64 * j]; wb[j] = ab[64 * j]; }
            float sa = 0.f, sb = 0.f;
#pragma unroll
            for (int j = 0; j < 8; ++j) { const float a0 = __uint_as_float(wa[j].x << 16), a1 = __uint_as_float(wa[j].x & 0xffff0000u), a2 = __uint_as_float(wa[j].y << 16), a3 = __uint_as_float(wa[j].y & 0xffff0000u);
                sa += (a0 * a0 + a1 * a1) + (a2 * a2 + a3 * a3);
                const float b0 = __uint_as_float(wb[j].x << 16), b1 = __uint_as_float(wb[j].x & 0xffff0000u), b2 = __uint_as_float(wb[j].y << 16), b3 = __uint_as_float(wb[j].y & 0xffff0000u);
                sb += (b0 * b0 + b1 * b1) + (b2 * b2 + b3 * b3); }
            const float ra = 1.0f / sqrtf(wave_sum(sa) * (1.0f / DM) + EPS), rb = 1.0f / sqrtf(wave_sum(sb) * (1.0f / DM) + EPS);
            const GAS f32x4* gr = (const GAS f32x4*)g_add + F.lane;
#pragma unroll
            for (int j = 0; j < 8; ++j) { const f32x4 g = gr[64 * j];
                const f32x4 a = {__uint_as_float(wa[j].x << 16), __uint_as_float(wa[j].x & 0xffff0000u), __uint_as_float(wa[j].y << 16), __uint_as_float(wa[j].y & 0xffff0000u)};
                const f32x4 b = {__uint_as_float(wb[j].x << 16), __uint_as_float(wb[j].x & 0xffff0000u), __uint_as_float(wb[j].y << 16), __uint_as_float(wb[j].y & 0xffff0000u)};
                va[j] = va[j] + a * ra * g; vb[j] = vb[j] + b * rb * g; }
        }
        if (xf_dst) { GAS f32x4* oa = (GAS f32x4*)(xf_dst + (size_t)m0 * DM) + F.lane; GAS f32x4* ob = (GAS f32x4*)(xf_dst + (size_t)mb * DM) + F.lane;
#pragma unroll
            for (int j = 0; j < 8; ++j) { oa[64 * j] = va[j]; if (two) ob[64 * j] = vb[j]; } }
        if (xb_dst) { GAS u32x2* oa = (GAS u32x2*)(xb_dst + (size_t)m0 * DM) + F.lane; GAS u32x2* ob = (GAS u32x2*)(xb_dst + (size_t)mb * DM) + F.lane;
#pragma unroll
            for (int j = 0; j < 8; ++j) { u32x2 w; w.x = pk2(va[j][0], va[j][1]); w.y = pk2(va[j][2], va[j][3]); oa[64 * j] = w;
                va[j] = (f32x4){__uint_as_float(w.x << 16), __uint_as_float(w.x & 0xffff0000u), __uint_as_float(w.y << 16), __uint_as_float(w.y & 0xffff0000u)};
                u32x2 w2; w2.x = pk2(vb[j][0], vb[j][1]); w2.y = pk2(vb[j][2], vb[j][3]); if (two) ob[64 * j] = w2;
                vb[j] = (f32x4){__uint_as_float(w2.x << 16), __uint_as_float(w2.x & 0xffff0000u), __uint_as_float(w2.y << 16), __uint_as_float(w2.y & 0xffff0000u)}; } }
        if (h_dst) {
            float sa = 0.f, sb = 0.f;
#pragma unroll
            for (int j = 0; j < 8; ++j) { sa += (va[j][0] * va[j][0] + va[j][1] * va[j][1]) + (va[j][2] * va[j][2] + va[j][3] * va[j][3]); sb += (vb[j][0] * vb[j][0] + vb[j][1] * vb[j][1]) + (vb[j][2] * vb[j][2] + vb[j][3] * vb[j][3]); }
            const float ra = 1.0f / sqrtf(wave_sum(sa) * (1.0f / DM) + EPS), rb = 1.0f / sqrtf(wave_sum(sb) * (1.0f / DM) + EPS);
            const GAS f32x4* gr = (const GAS f32x4*)g_out + F.lane;
            GAS u32x2* ha = (GAS u32x2*)(h_dst + (size_t)m0 * DM) + F.lane; GAS u32x2* hb2 = (GAS u32x2*)(h_dst + (size_t)mb * DM) + F.lane;
#pragma unroll
            for (int j = 0; j < 8; ++j) { const f32x4 g = gr[64 * j]; const f32x4 oa = va[j] * ra * g, ob = vb[j] * rb * g;
                u32x2 w; w.x = pk2(oa[0], oa[1]); w.y = pk2(oa[2], oa[3]); ha[64 * j] = w;
                if (two) { u32x2 w2; w2.x = pk2(ob[0], ob[1]); w2.y = pk2(ob[2], ob[3]); hb2[64 * j] = w2; } }
        }
    }
}
typedef LAS cf* lcf;
template <bool ZUP> __device__ __forceinline__ void hy_fwd(lcf X, lcf thi, lcf tlo, int tid, const cf* KM) {
    if (ZUP) hy_pass16<1024, false, true, false>(X, thi, tlo, tid); else hy_pass16<1024, false, false, false>(X, thi, tlo, tid);
    __syncthreads();
    hy_pass16<64, false, false, false>(X, thi, tlo, tid);
    hy_pass16<4, false, false, false>(X, thi, tlo, tid);
    hy_pass4<false>(X, tid, KM); __syncthreads();
}
__device__ __forceinline__ void hy_inv(lcf X, lcf thi, lcf tlo, int tid) {
    const cf* nul = nullptr;
    hy_pass4<true>(X, tid, nul); __syncthreads();
    hy_pass16<4, true, false, false>(X, thi, tlo, tid); __syncthreads();
    hy_pass16<64, true, false, false>(X, thi, tlo, tid); __syncthreads();
    hy_pass16<1024, true, false, true>(X, thi, tlo, tid); __syncthreads();
}
__device__ __forceinline__ void hy_mid(lcf X, lcf thi, lcf tlo, int tid, const cf* KM) {
    const cf* nul = nullptr;
    hy_pass16<64, false, false, false>(X, thi, tlo, tid);
    hy_pass16<4, false, false, false>(X, thi, tlo, tid);
    hy_pass4<false>(X, tid, KM);
    hy_pass4<true>(X, tid, nul);
    hy_pass16<4, true, false, false>(X, thi, tlo, tid);
    hy_pass16<64, true, false, false>(X, thi, tlo, tid); __syncthreads();
}
__device__ __forceinline__ void hyena_phase(Frame& F, const Args& A, int l) {
    lcf X = (lcf)(F.lds + RING_OFF); lcf thi = (lcf)(F.lds + TAB_OFF); lcf tlo = thi + 128;
    const int tid = F.tid;
    if (tid < 256) { const int a = tid & 127; const double ang = -6.283185307179586 * (double)(tid < 128 ? 128 * a : a) / (double)FN; float s, c; sincos_red(ang, s, c); (tid < 128 ? thi : tlo)[a] = cf{c, s}; }
    cf* K1g = (cf*)(F.ws + WS_FFTK) + (size_t)F.bx * 2 * FN; cf* K2g = K1g + FN;
    const bf16* taps = (const bf16*)(F.ws + ((A.taps_all && l > 0) ? WS_TAPS_X + (size_t)(l - 1) * SZ_TAPS : WS_TAPS));
    const float* cw = GP(A.in[I_CONVW + F.z]) + (size_t)l * 3 * HYIN; const float* cb = GP(A.in[I_CONVB + F.z]) + (size_t)l * HYIN; const float* hb = GP(A.in[I_HBIAS + F.z]) + (size_t)l * 2 * HYW;
    const bf16* projT = (const bf16*)(F.ws + WS_PROJT); bf16* zT = (bf16*)(F.ws + WS_ZT);
    for (int c = F.vcu; c < HYW; c += F.G) {
        __syncthreads();
        const float delta = fabsf(-15.350567286626973f + (float)c * ((-3.0701134573253945f + 15.350567286626973f) / 1023.0f));
#define TIDX(v) int v = tid; asm volatile("" : "+v"(v))
        { TIDX(t_); hy_filter_step(X, taps + (size_t)c * SEQ, delta, t_); }
        const unsigned* rx1 = (const unsigned*)(projT + (size_t)c * MG); const unsigned* rx2 = (const unsigned*)(projT + (size_t)(HYW + c) * MG); const unsigned* rv = (const unsigned*)(projT + (size_t)(2 * HYW + c) * MG);
        HyRaw R;
        { TIDX(t_); hy_raw_load(R, rv, rv + SEQ / 2, t_); }
        __syncthreads();
        { TIDX(t_); hy_fwd<false>(X, thi, tlo, t_, nullptr); }
        { TIDX(t_); hy_sep_step(X, K1g, K2g, t_); }
        asm volatile("s_waitcnt vmcnt(0)" ::: "memory"); __syncthreads();
        cf zr[2][8];
        { TIDX(t_); hy_convA_fwd(X, thi, tlo, t_, R, cw[2 * HYW + c], cw[HYIN + 2 * HYW + c], cw[2 * HYIN + 2 * HYW + c], cb[2 * HYW + c], zr); }
        { TIDX(t_); hy_raw_load(R, rx1, rx1 + SEQ / 2, t_); }
        __syncthreads();
        { TIDX(t_); hy_mid(X, thi, tlo, t_, K1g); }
        { TIDX(t_); hy_gateA<false>(X, thi, tlo, t_, R, cw[c], cw[HYIN + c], cw[2 * HYIN + c], cb[c], hb[c], zr, (unsigned short*)nullptr, (unsigned short*)nullptr); }
        { TIDX(t_); hy_raw_load(R, rx2, rx2 + SEQ / 2, t_); }
        __syncthreads();
        { TIDX(t_); hy_mid(X, thi, tlo, t_, K2g); }
        unsigned short* zo = (unsigned short*)(zT + (size_t)c * MG);
        { TIDX(t_); hy_gateA<true>(X, thi, tlo, t_, R, cw[HYW + c], cw[HYIN + HYW + c], cw[2 * HYIN + HYW + c], cb[HYW + c], hb[HYW + c], zr, zo, zo + SEQ); }
#undef TIDX
    }
    __syncthreads();
}
__device__ __forceinline__ void hynorm_phase(Frame& F, const Args& A, int l) {
    constexpr int TB = 64;
    LAS unsigned char* tile = F.lds + RING_OFF; LAS float* red = (LAS float*)(F.lds + RING_OFF + TB * HYW * 2); LAS float* rinv = red + 8 * TB;
    const bf16* zT = (const bf16*)(F.ws + WS_ZT); bf16* mixin = (bf16*)(F.ws + WS_MIXIN); const float* gn = GP(A.in[I_HNORM + F.z]) + (size_t)l * HYW;
    const int tid = F.tid;
    for (int tb = F.vcu; tb < MG / TB; tb += F.G) {
        const int t0 = tb * TB; __syncthreads();
        float ps[8];
#pragma unroll
        for (int i = 0; i < 8; ++i) ps[i] = 0.f;
        const int k = tid & 7, crow = tid >> 3;
#pragma unroll
        for (int hb = 0; hb < 2; ++hb) {
            v4u w[8];
#pragma unroll
            for (int it = 0; it < 8; ++it) { const unsigned c = (unsigned)((hb * 8 + it) * 64 + crow) & 1023u; w[it] = *(const GAS v4u*)(zT + (size_t)c * MG + (unsigned)(t0 + 8 * k)); }
#pragma unroll
            for (int it = 0; it < 8; ++it) { const int c = (hb * 8 + it) * 64 + crow;
                LAS unsigned short* d = (LAS unsigned short*)(tile + (8 * k) * 2048 + (((c >> 3) ^ k) << 4) + (c & 7) * 2);
                const unsigned ww[4] = {w[it].x, w[it].y, w[it].z, w[it].w};
#pragma unroll
                for (int i = 0; i < 4; ++i) { d[(2 * i) * 1024] = (unsigned short)(ww[i] & 0xffffu); d[(2 * i + 1) * 1024] = (unsigned short)(ww[i] >> 16);
                    const float a = __uint_as_float(ww[i] << 16), b = __uint_as_float(ww[i] & 0xffff0000u); ps[2 * i] += a * a; ps[2 * i + 1] += b * b; } }
        }
#pragma unroll
        for (int i = 0; i < 8; ++i) { float v = ps[i]; v += swz_xor<8>(v); v += swz_xor<16>(v);
            auto rr = __builtin_amdgcn_permlane32_swap(__float_as_uint(v), __float_as_uint(v), false, false); ps[i] = __uint_as_float(rr[0]) + __uint_as_float(rr[1]); }
        if ((F.lane >> 3) == 0) {
#pragma unroll
            for (int i = 0; i < 8; ++i) red[F.wave * TB + 8 * k + i] = ps[i]; }
        __syncthreads();
        if (tid < TB) { float s = 0.f;
#pragma unroll
            for (int w8 = 0; w8 < 8; ++w8) s += red[w8 * TB + tid];
            rinv[tid] = 1.0f / sqrtf(s * (1.0f / HYW) + EPS); }
        __syncthreads();
        const int cg = tid & 127;
        const f32x4 g0 = *(const f32x4*)(gn + 8 * cg), g1 = *(const f32x4*)(gn + 8 * cg + 4);
#pragma unroll 4
        for (int it = 0; it < 16; ++it) { const int tok = it * 4 + (tid >> 7); const float r = rinv[tok];
            const v4u q = *(const LAS v4u*)(tile + tok * 2048 + ((cg ^ (tok >> 3)) << 4));
            v4u o; o.x = pk2(__uint_as_float(q.x << 16) * r * g0[0], __uint_as_float(q.x & 0xffff0000u) * r * g0[1]); o.y = pk2(__uint_as_float(q.y << 16) * r * g0[2], __uint_as_float(q.y & 0xffff0000u) * r * g0[3]);
            o.z = pk2(__uint_as_float(q.z << 16) * r * g1[0], __uint_as_float(q.z & 0xffff0000u) * r * g1[1]); o.w = pk2(__uint_as_float(q.w << 16) * r * g1[2], __uint_as_float(q.w & 0xffff0000u) * r * g1[3]);
            *(GAS v4u*)(mixin + (size_t)(t0 + tok) * DM + 8 * cg) = o; }
    }
    __syncthreads();
}
__device__ __forceinline__ void attn_phase(Frame& F, const Args& A, int l, unsigned char* lds_generic) {
    const float li = 0.8f - 0.6f * expf(-0.3f * (float)l);
    float lam;
    { const int j = F.lane; const float a = GP(A.in[I_LQ1 + F.z])[l * 64 + j] * GP(A.in[I_LK1 + F.z])[l * 64 + j], b = GP(A.in[I_LQ2 + F.z])[l * 64 + j] * GP(A.in[I_LK2 + F.z])[l * 64 + j];
      lam = expf(wave_sum(a)) - expf(wave_sum(b)) + li; }
    const att::bf16* qkv = (const att::bf16*)(F.ws + WS_QKV); att::bf16* mixin = (att::bf16*)(F.ws + WS_MIXIN);
    float* stash = (float*)(F.ws + WS_H) + (size_t)F.bx * 64 * 512;
    const float* subln = GP(A.in[I_SUBLN + F.z]) + (size_t)l * 128;
    constexpr int NU = GSEQ * 8 * (SEQ / 256);
    for (int u = F.vcu; u < NU; u += F.G) {
        const int bvh = u >> 5, qb = u & 31, b = bvh >> 3, vh = bvh & 7;
        const long krow0 = (long)b * SEQ, qrow0 = krow0 + qb * 256;
        att::attn_unit(qkv, qrow0, krow0, vh, SEQ, lam, 1.0f - li, subln, mixin + (size_t)qrow0 * DM + HYW + vh * 128, DM, stash, (char*)lds_generic);
        __syncthreads();
    }
}
#ifndef PHMASK
#define PHMASK 511
#endif
__global__ void __launch_bounds__(NTHR, 2) hymba_fwd(Args args) {
    extern __shared__ __attribute__((aligned(16))) unsigned char lds[];
    Frame F;
    F.lds = (LAS unsigned char*)lds; F.MISC = (volatile LAS unsigned*)(F.lds + MISC_OFF);
    F.tid = threadIdx.x; F.lane = F.tid & 63; F.wave = __builtin_amdgcn_readfirstlane(F.tid >> 6);
    F.G = gridDim.x; { const int bx = blockIdx.x; F.vcu = (F.G % 8 == 0) ? (bx % 8) * (F.G / 8) + bx / 8 : bx; F.bx = bx; }
    F.vcu0 = F.vcu; F.G0 = F.G; F.bx0 = F.bx;
    F.ctl = (gu32*)(args.ws + WS_CTL); F.out = args.out; F.ws = args.ws; F.ws0 = args.ws; F.z = 0;
    for (int u = F.tid; u < (LDS_BYTES - MISC_OFF) / 4; u += NTHR) ((LAS unsigned*)(F.lds + MISC_OFF))[u] = 0u;
    __syncthreads();
    XcdBarrier bar; bar.bar = (unsigned*)(F.ctl + CW_BAR); bar.x = 0; bar.st = nullptr;
    if (!MK_PER_PHASE) bar = xcd_barrier_post((unsigned*)(F.ctl + CW_BAR), F.MISC + 8);
    const int lo = args.ph_lo, hi = args.ph_hi;
    int ph = 0;
#define IN_() (lo <= ph && ph < hi && ({ LAUNDER_TID(F); true; }))
#define DUP3(...) do { __VA_ARGS__; if (PROBE_DUP == 3) { __VA_ARGS__; } } while (0)
#define SEAM() do { if (!MK_PER_PHASE && lo <= ph && ph + 1 < hi) { XcdBarrier b_ = bar; { unsigned long long p_ = (unsigned long long)b_.bar; unsigned x_ = b_.x; asm volatile("" : "+s"(p_), "+s"(x_)); b_.bar = (unsigned*)(GAS unsigned*)p_; b_.x = x_; } \
        xcd_barrier(b_); if (PROBE_DUP == 7) xcd_barrier(b_); } ++ph; } while (0)
    if ((PHMASK & 1) && IN_()) { p0_prologue(F, args); if (PROBE_DUP == 4) p0_prologue(F, args); }
    SEAM();
#define Hb ((bf16*)(F.ws + WS_H))
#define XB ((bf16*)(F.ws + WS_XB))
#define projT ((bf16*)(F.ws + WS_PROJT))
#define qkv ((bf16*)(F.ws + WS_QKV))
#define mix ((bf16*)(F.ws + WS_MIX))
#define ffh ((bf16*)(F.ws + WS_FFH))
#define mixin ((bf16*)(F.ws + WS_MIXIN))
#define wl (F.ws + WS_W + (size_t)l * SZ_WLAYER)
#define xin ((g == 0) ? GP(args.in[I_XP + F.z]) : GP(args.in[I_XS + F.z]) + (size_t)(g - 1) * MG * DM)
#define xres ((float*)(GAS float*)args.out + (size_t)g * MG * DM)
    for (int g = 0; g < NGRP; ++g) {
        if ((PHMASK & 2) && IN_()) norm_pass<false>(F, xin, nullptr, nullptr, nullptr, nullptr, GP(args.in[I_GMPRE + F.z]), Hb);
        SEAM();
        for (int l = 0; l < DEPTH; ++l) {
            if ((PHMASK & 4) && IN_()) {
                { pg8::Gemm gm{(const bf16*)(wl + OFF_WHY), Hb, HYIN, MG, DM}; pg8::StaticOrder S; S.init(HYIN, MG, F.G, F.bx);
                  pg8::EpiPlain E{projT, MG};
                  DUP3(pg8::gemm_phase<pg8::EpiPlain, pg8::StaticOrder, true, true>(F.lds + RING_OFF, gm, S, E)); }
                if (g == 0 || !args.taps_all) { pg8::Gemm gm{(const bf16*)(F.ws + WS_W4T) + (size_t)l * 4096 * KPAD, (const bf16*)(F.ws + WS_H3) + (size_t)l * SEQ * KPAD, 4096, SEQ, KPAD}; pg8::StaticOrder S; S.init(4096, SEQ, F.G, F.bx);
                  pg8::EpiPlain E{(bf16*)(F.ws + ((args.taps_all && l > 0) ? WS_TAPS_X + (size_t)(l - 1) * SZ_TAPS : WS_TAPS)), SEQ};
                  DUP3(pg8::gemm_phase<pg8::EpiPlain, pg8::StaticOrder, true, true>(F.lds + RING_OFF, gm, S, E)); }
                { pg8::Gemm gm{Hb, (const bf16*)(wl + OFF_WQKV), MG, QKVW, DM}; pg8::StaticOrder S; S.init(MG, QKVW, F.G, F.bx);
                  pg8::EpiRope E{qkv, QKVW, (const float*)(F.ws + WS_ROPE), QSCALE};
                  DUP3(pg8::gemm_phase<pg8::EpiRope, pg8::StaticOrder, true, true>(F.lds + RING_OFF, gm, S, E)); }
            }
            SEAM();
            if (IN_()) { if (PHMASK & 8) hyena_phase(F, args, l); if (PROBE_DUP == 2) hyena_phase(F, args, l); if (PHMASK & 16) attn_phase(F, args, l, lds); if (PROBE_DUP == 1) attn_phase(F, args, l, lds); }
            SEAM();
            if ((PHMASK & 32) && IN_()) { hynorm_phase(F, args, l); if (PROBE_DUP == 4) hynorm_phase(F, args, l); }
            SEAM();
            if ((PHMASK & 64) && IN_()) { pg8::Gemm gm{mixin, (const bf16*)(wl + OFF_WOUT), MG, DM, DM}; pg8::StaticOrder S; S.init(MG, DM, F.G, F.bx);
                pg8::EpiPlain E{mix, DM};
                DUP3(pg8::gemm_phase<pg8::EpiPlain, pg8::StaticOrder, true, true>(F.lds + RING_OFF, gm, S, E)); }
            SEAM();
            if ((PHMASK & 2) && IN_()) { if (l == 0) norm_pass<false>(F, xin, mix, GP(args.in[I_GMPOST + F.z]) + (size_t)l * DM, XB, nullptr, GP(args.in[I_GFPRE + F.z]) + (size_t)l * DM, Hb);
                else norm_pass<true>(F, XB, mix, GP(args.in[I_GMPOST + F.z]) + (size_t)l * DM, XB, nullptr, GP(args.in[I_GFPRE + F.z]) + (size_t)l * DM, Hb); }
            SEAM();
            if ((PHMASK & 128) && IN_()) { pg8::Gemm gm{Hb, (const bf16*)(wl + OFF_WGU), MG, GU, DM}; pg8::StaticOrder S; S.init(MG, GU, F.G, F.bx);
                pg8::EpiSwiGLU E{ffh, DFF};
                DUP3(pg8::gemm_phase<pg8::EpiSwiGLU, pg8::StaticOrder, true, true>(F.lds + RING_OFF, gm, S, E)); }
            SEAM();
            if ((PHMASK & 256) && IN_()) { pg8::Gemm gm{ffh, (const bf16*)(wl + OFF_WDN), MG, DM, DFF}; pg8::StaticOrder S; S.init(MG, DM, F.G, F.bx);
                pg8::EpiPlain E{mixin, DM};
                DUP3(pg8::gemm_phase<pg8::EpiPlain, pg8::StaticOrder, true, true>(F.lds + RING_OFF, gm, S, E)); }
            SEAM();
            if ((PHMASK & 2) && IN_()) { if (l + 1 < DEPTH) norm_pass<true>(F, XB, mixin, GP(args.in[I_GFPOST + F.z]) + (size_t)l * DM, XB, nullptr, GP(args.in[I_GMPRE + F.z]) + (size_t)(l + 1) * DM, Hb);
                else norm_pass<true>(F, XB, mixin, GP(args.in[I_GFPOST + F.z]) + (size_t)l * DM, nullptr, xres, nullptr, nullptr); }
            SEAM();
        }
    }
#undef IN_
#undef SEAM
#undef Hb
#undef XB
#undef projT
#undef qkv
#undef mix
#undef ffh
#undef mixin
#undef wl
#undef xin
#undef xres
}

extern "C" void kernel_launch(void* const* d_in, const int* in_sizes, int n_in, void* d_out, int out_size, void* d_ws, size_t ws_size, hipStream_t stream) {
    static int grid = 0;
    if (grid == 0) {
        if (n_in != 30 || in_sizes[0] != 2 * SEQ * DM || in_sizes[1] != 4 * SEQ * DM || out_size != NSEQ * SEQ * DM || ws_size < WS_END) {
            fprintf(stderr, "kernel_launch: shape mismatch (n_in %d, out %d, ws %zu, need %zu)\n", n_in, out_size, ws_size, (size_t)WS_END); grid = -1; return; }
        int dev = 0, cus = 0;
        if (hipGetDevice(&dev) != hipSuccess || hipDeviceGetAttribute(&cus, hipDeviceAttributeMultiprocessorCount, dev) != hipSuccess) { grid = -1; return; }
        if (hipFuncSetAttribute((const void*)hymba_fwd, hipFuncAttributeMaxDynamicSharedMemorySize, LDS_BYTES) != hipSuccess) { fprintf(stderr, "kernel_launch: hipFuncSetAttribute failed\n"); grid = -1; return; }
        int per_cu = 0;
        if (hipOccupancyMaxActiveBlocksPerMultiprocessor(&per_cu, (const void*)hymba_fwd, NTHR, LDS_BYTES) != hipSuccess || per_cu < 1) fprintf(stderr, "kernel_launch: occupancy query says %d\n", per_cu);
        (void)hipGetLastError();
        grid = cus;
    }
    if (grid < 0) return;
    if (hipMemsetAsync((char*)d_ws + WS_CTL, 0, CTL_ZERO_BYTES, stream) != hipSuccess) return;
    Args a{};
    for (int i = 0; i < 30; ++i) a.in[i] = (const float*)d_in[i];
    a.out = (float*)d_out; a.ws = (unsigned char*)d_ws; a.taps_all = (ws_size >= WS_END_X) ? 1 : 0;
#if MK_PER_PHASE
    for (int p = 0; p < NPHASE; ++p) { a.ph_lo = p; a.ph_hi = p + 1; hipLaunchKernelGGL(hymba_fwd, dim3(grid), dim3(NTHR), LDS_BYTES, stream, a); }
#else
    a.ph_lo = 0; a.ph_hi = NPHASE;
    hipLaunchKernelGGL(hymba_fwd, dim3(grid), dim3(NTHR), LDS_BYTES, stream, a);
#endif
    const hipError_t le = hipPeekAtLastError();
    if (le != hipSuccess) fprintf(stderr, "kernel_launch: launch failed: %s\n", hipGetErrorName(le));
}
```

```cpp
#include <hip/hip_runtime.h>
#include <hip/hip_bf16.h>
#include <cstdio>
#include <cstdint>
#include <cmath>
namespace pg8 {
#define PG8_LAS __attribute__((address_space(3)))
typedef unsigned short bf16_t;
typedef short bf16x8 __attribute__((ext_vector_type(8)));
typedef float f32x4 __attribute__((ext_vector_type(4)));
typedef unsigned u32x4 __attribute__((ext_vector_type(4)));
constexpr int BM = 256, BK = 64, HALF = 128, HTB = HALF * BK * 2  , STAGE_BYTES = 8 * HTB, NXCD = 8, WGM = 8;

__host__ __device__ __forceinline__ int lds_byte(int r, int c) { const int st = (r >> 4) * 2 + (c >> 5), rr = r & 15, cc = c & 31, ob = rr * 64 + cc * 2; return st * 1024 + (ob ^ (((ob >> 9) & 1) << 5)); }
__host__ __device__ __forceinline__ void stage_rc(int b, int& R, int& C) { const int st = b / 1024, sb = b % 1024, swz = sb ^ (((sb >> 9) & 1) << 5); R = (st >> 1) * 16 + swz / 64; C = (st & 1) * 32 + (swz % 64) / 2; }
__host__ __device__ __forceinline__ int perm32(int rho) { const int n = rho >> 4, i = rho & 15; return 8 * (i >> 2) + 4 * n + (i & 3); }

struct Unit { int pm, pn; };
struct Gemm { const bf16_t* A; const bf16_t* Bt; int M, N, K; };

struct StaticOrder {
    int nM, nN, nwg, G, c;
    __host__ __device__ void init(int M, int N, int G_, int c_) { nM = M / BM; nN = N / BM; nwg = nM * nN; G = G_; c = c_; }
    __host__ __device__ bool next(int i, Unit& u) const {
        const long L = (long)i * G + c; if (L >= nwg) return false;
        int wgid = (int)L; { const int q = nwg / NXCD, r = nwg % NXCD, xcd = wgid % NXCD, off = wgid / NXCD; wgid = (xcd < r ? xcd * (q + 1) : r * (q + 1) + (xcd - r) * q) + off; }
        const int nig = WGM * nN, gid = wgid / nig, fm = gid * WGM, gsz = (nM - fm) < WGM ? (nM - fm) : WGM;
        u.pm = fm + ((wgid % nig) % gsz); u.pn = (wgid % nig) / gsz; return true;
    }
    __device__ __forceinline__ void a_ready(const Unit&) const {}
    __device__ __forceinline__ void done(const Unit&) const {}
};

__device__ __forceinline__ unsigned cvt_pk_bf16(float lo, float hi) { unsigned r; asm volatile("v_cvt_pk_bf16_f32 %0, %1, %2" : "=v"(r) : "v"(lo), "v"(hi)); return r; }
typedef float f32x2 __attribute__((ext_vector_type(2)));
struct EpiPlain {
    static constexpr bool PERM = true, AFTER_DRAIN = false;
    bf16_t* O; int ldc;
    __device__ __forceinline__ void operator()(const f32x4 (&acc)[2][2][4][2], const Unit& u, int wr, int wc, int fr, int fq) const {
        const int row0 = u.pm * BM + wr * 64 + fr, col0 = u.pn * BM + wc * 32 + 8 * fq;
#pragma unroll
        for (int ai = 0; ai < 2; ++ai)
#pragma unroll
            for (int m = 0; m < 4; ++m) { bf16_t* rowp = O + (size_t)(row0 + ai * HALF + m * 16) * ldc + col0;
#pragma unroll
                for (int bj = 0; bj < 2; ++bj) { const f32x4 v0 = acc[ai][bj][m][0], v1 = acc[ai][bj][m][1];
                    u32x4 w; w.x = cvt_pk_bf16(v0[0], v0[1]); w.y = cvt_pk_bf16(v0[2], v0[3]); w.z = cvt_pk_bf16(v1[0], v1[1]); w.w = cvt_pk_bf16(v1[2], v1[3]);
                    *(u32x4*)(rowp + bj * HALF) = w; } }
    }
};
struct EpiRope {
    static constexpr bool PERM = true, AFTER_DRAIN = false;
    bf16_t* O; int ldc; const float* cs; float qscale;
    __device__ __forceinline__ void operator()(const f32x4 (&acc)[2][2][4][2], const Unit& u, int wr, int wc, int fr, int fq) const {
        const int row0 = u.pm * BM + wr * 64 + fr, col0 = u.pn * BM + wc * 32 + 8 * fq;
        const bool rope = u.pn < 8; const float sc = u.pn < 4 ? qscale : 1.0f;
        const int p0 = 16 * (wc & 1) + 4 * fq;
#pragma unroll
        for (int ai = 0; ai < 2; ++ai)
#pragma unroll
            for (int m = 0; m < 4; ++m) { const int row = row0 + ai * HALF + m * 16; bf16_t* rowp = O + (size_t)row * ldc + col0;
                f32x4 t0 = {1.f, 0.f, 1.f, 0.f}, t1 = {1.f, 0.f, 1.f, 0.f};
                if (rope) { const float* tp = cs + ((size_t)(row & 8191) * 32 + p0) * 2; t0 = *(const f32x4*)tp; t1 = *(const f32x4*)(tp + 4); }
#pragma unroll
                for (int bj = 0; bj < 2; ++bj) { const f32x4 v0 = acc[ai][bj][m][0], v1 = acc[ai][bj][m][1];
                    f32x4 o0, o1;
                    o0[0] = (v0[0] * t0[0] - v0[1] * t0[1]) * sc; o0[1] = (v0[0] * t0[1] + v0[1] * t0[0]) * sc;
                    o0[2] = (v0[2] * t0[2] - v0[3] * t0[3]) * sc; o0[3] = (v0[2] * t0[3] + v0[3] * t0[2]) * sc;
                    o1[0] = (v1[0] * t1[0] - v1[1] * t1[1]) * sc; o1[1] = (v1[0] * t1[1] + v1[1] * t1[0]) * sc;
                    o1[2] = (v1[2] * t1[2] - v1[3] * t1[3]) * sc; o1[3] = (v1[2] * t1[3] + v1[3] * t1[2]) * sc;
                    u32x4 w; w.x = cvt_pk_bf16(o0[0], o0[1]); w.y = cvt_pk_bf16(o0[2], o0[3]); w.z = cvt_pk_bf16(o1[0], o1[1]); w.w = cvt_pk_bf16(o1[2], o1[3]);
                    *(u32x4*)(rowp + bj * HALF) = w; } }
    }
};
struct EpiSwiGLU {
    static constexpr bool PERM = true, AFTER_DRAIN = false;
    bf16_t* O; int ldc;
    static __device__ __forceinline__ float silu_mul(float g, float u) { return g * u * __builtin_amdgcn_rcpf(1.0f + __builtin_amdgcn_exp2f(-1.4426950408889634f * g)); }
    __device__ __forceinline__ void operator()(const f32x4 (&acc)[2][2][4][2], const Unit& u, int wr, int wc, int fr, int fq) const {
        const int row0 = u.pm * BM + wr * 64 + fr, col0 = u.pn * HALF + wc * 32 + 8 * fq;
#pragma unroll
        for (int ai = 0; ai < 2; ++ai)
#pragma unroll
            for (int m = 0; m < 4; ++m) { bf16_t* rowp = O + (size_t)(row0 + ai * HALF + m * 16) * ldc + col0;
                const f32x4 g0 = acc[ai][0][m][0], g1 = acc[ai][0][m][1], u0 = acc[ai][1][m][0], u1 = acc[ai][1][m][1];
                u32x4 w; w.x = cvt_pk_bf16(silu_mul(g0[0], u0[0]), silu_mul(g0[1], u0[1])); w.y = cvt_pk_bf16(silu_mul(g0[2], u0[2]), silu_mul(g0[3], u0[3]));
                w.z = cvt_pk_bf16(silu_mul(g1[0], u1[0]), silu_mul(g1[1], u1[1])); w.w = cvt_pk_bf16(silu_mul(g1[2], u1[2]), silu_mul(g1[3], u1[3]));
                *(u32x4*)rowp = w; }
    }
};
template <class Epi, class Sched, bool ALIGN_EPI = false, bool SP2 = false>
__device__ __forceinline__ void gemm_phase(PG8_LAS unsigned char* lds, const Gemm g, const Sched& S, const Epi& E) {
    int tid = threadIdx.x; asm volatile("" : "+v"(tid));
    const int wid = __builtin_amdgcn_readfirstlane(tid >> 6), lane = tid & 63, wr = wid >> 2, wc = wid & 3, fr = lane & 15, fq = lane >> 4;
    const int K = g.K, nt = K / BK;
    unsigned voffA[2], voffB[2];
#pragma unroll
    for (int i = 0; i < 2; ++i) { int R, C; stage_rc(tid * 16 + i * 8192, R, C); const int Rb = Epi::PERM ? ((R & ~31) + perm32(R & 31)) : R;
        voffA[i] = (unsigned)(R * K + C) * 2u; voffB[i] = (unsigned)(Rb * K + C) * 2u; }
    const size_t kstep = (size_t)(BK * 2);
    const size_t hstep = (size_t)HALF * K * 2;
    const size_t tstep = 2 * hstep;
    const unsigned ldsw = (unsigned)wid * 1024u;
    const int aoff = lds_byte(wr * 64 + fr, fq * 8), boff = lds_byte(wc * 32 + fr, fq * 8);
#define PG8_SA(b, h) (((b) * 2 + (h)) * HTB)
#define PG8_SB(b, h) ((4 + (b) * 2 + (h)) * HTB)
#define PG8_STAGE(bufoff, gbase, voff) do { _Pragma("unroll") for (int _i = 0; _i < 2; ++_i) \
        __builtin_amdgcn_global_load_lds((const unsigned*)((const char*)(gbase) + (voff)[_i]), (PG8_LAS unsigned*)(lds + (bufoff) + ldsw + _i * 8192), 16, 0, 0); } while (0)
#define PG8_LDA(dst, b, h) do { _Pragma("unroll") for (int m = 0; m < 4; ++m) _Pragma("unroll") for (int k = 0; k < 2; ++k) dst[m][k] = *(const PG8_LAS bf16x8*)(lds + PG8_SA(b, h) + aoff + m * 2048 + k * 1024); } while (0)
#define PG8_LDB(dst, b, h) do { _Pragma("unroll") for (int n = 0; n < 2; ++n) _Pragma("unroll") for (int k = 0; k < 2; ++k) dst[n][k] = *(const PG8_LAS bf16x8*)(lds + PG8_SB(b, h) + boff + n * 2048 + k * 1024); } while (0)
#define PG8_MMA(ai, bj, At, Bt) do { __builtin_amdgcn_s_setprio(1); _Pragma("unroll") for (int m = 0; m < 4; ++m) _Pragma("unroll") for (int n = 0; n < 2; ++n) _Pragma("unroll") for (int k = 0; k < 2; ++k) \
        acc[ai][bj][m][n] = __builtin_amdgcn_mfma_f32_16x16x32_bf16(Bt[n][k], At[m][k], acc[ai][bj][m][n], 0, 0, 0); __builtin_amdgcn_s_setprio(0); } while (0)
#define PG8_WAIT_V(n) asm volatile("s_waitcnt vmcnt(" #n ")" ::: "memory")
#define PG8_WAIT_L(n) asm volatile("s_waitcnt lgkmcnt(" #n ")" ::: "memory")
#define PG8_BAR __builtin_amdgcn_s_barrier()
#define PG8_SCHED __builtin_amdgcn_sched_barrier(0)
    Unit cur, nxt; int ui = 0;
    if (!S.next(0, cur)) return;
    f32x4 acc[2][2][4][2];
#pragma unroll
    for (int a = 0; a < 2; ++a)
#pragma unroll
        for (int b = 0; b < 2; ++b)
#pragma unroll
            for (int m = 0; m < 4; ++m)
#pragma unroll
                for (int n = 0; n < 2; ++n) acc[a][b][m][n] = (f32x4){0.f, 0.f, 0.f, 0.f};
    bf16x8 At[4][2], B0[2][2], B1[2][2];
    const char* cA = (const char*)g.A + (size_t)cur.pm * tstep; const char* cB = (const char*)g.Bt + (size_t)cur.pn * tstep;
    S.a_ready(cur);
    if constexpr (SP2) {
        PG8_STAGE(PG8_SB(0, 0), cB, voffB); PG8_STAGE(PG8_SB(0, 1), cB + hstep, voffB); PG8_STAGE(PG8_SA(0, 0), cA, voffA); PG8_STAGE(PG8_SA(0, 1), cA + hstep, voffA);
        if (wr == 1) PG8_BAR;
        PG8_WAIT_V(2); PG8_BAR;
        PG8_STAGE(PG8_SB(1, 0), cB + kstep, voffB); PG8_STAGE(PG8_SA(1, 0), cA + kstep, voffA); PG8_STAGE(PG8_SB(1, 1), cB + hstep + kstep, voffB);
        PG8_WAIT_V(6); PG8_BAR;
    } else {
        PG8_STAGE(PG8_SB(0, 0), cB, voffB); PG8_STAGE(PG8_SA(0, 0), cA, voffA); PG8_STAGE(PG8_SB(0, 1), cB + hstep, voffB); PG8_STAGE(PG8_SA(0, 1), cA + hstep, voffA);
        if (wr == 1) PG8_BAR;
        PG8_WAIT_V(4); PG8_BAR;
        PG8_STAGE(PG8_SB(1, 0), cB + kstep, voffB); PG8_STAGE(PG8_SA(1, 0), cA + kstep, voffA); PG8_STAGE(PG8_SB(1, 1), cB + hstep + kstep, voffB);
        PG8_WAIT_V(6); PG8_BAR;
    }
    for (;;) {
        const bool has_next = S.next(ui + 1, nxt);
        const char* nA = has_next ? (const char*)g.A + (size_t)nxt.pm * tstep : cA; const char* nB = has_next ? (const char*)g.Bt + (size_t)nxt.pn * tstep : cB;
        for (int t = 0; t < nt; t += 2) {
            const bool last = (t == nt - 2);
            const char* a1 = cA + (size_t)(t + 1) * kstep;
            const char* a2 = last ? nA : cA + (size_t)(t + 2) * kstep; const char* b2 = last ? nB : cB + (size_t)(t + 2) * kstep;
            const char* a3 = a2 + kstep; const char* b3 = b2 + kstep;
            if (last && has_next) S.a_ready(nxt);
            if constexpr (SP2) {
            PG8_LDB(B0, 0, 0); PG8_LDB(B1, 0, 1); PG8_SCHED; PG8_LDA(At, 0, 0); PG8_STAGE(PG8_SA(1, 1), a1 + hstep, voffA);
            PG8_WAIT_V(8); PG8_WAIT_L(0); PG8_BAR; PG8_MMA(0, 0, At, B0); PG8_MMA(0, 1, At, B1); PG8_BAR; PG8_SCHED;
            PG8_LDA(At, 0, 1); PG8_STAGE(PG8_SB(0, 0), b2, voffB); PG8_STAGE(PG8_SB(0, 1), b2 + hstep, voffB); PG8_STAGE(PG8_SA(0, 0), a2, voffA);
            PG8_WAIT_V(8); PG8_WAIT_L(0); PG8_BAR; PG8_MMA(1, 0, At, B0); PG8_MMA(1, 1, At, B1); PG8_BAR; PG8_SCHED;
            PG8_LDB(B0, 1, 0); PG8_LDB(B1, 1, 1); PG8_SCHED; PG8_LDA(At, 1, 0); PG8_STAGE(PG8_SA(0, 1), a2 + hstep, voffA);
            PG8_WAIT_V(8); PG8_WAIT_L(0); PG8_BAR; PG8_MMA(0, 0, At, B0); PG8_MMA(0, 1, At, B1); PG8_BAR; PG8_SCHED;
            PG8_LDA(At, 1, 1); PG8_STAGE(PG8_SB(1, 0), b3, voffB); PG8_STAGE(PG8_SB(1, 1), b3 + hstep, voffB); PG8_STAGE(PG8_SA(1, 0), a3, voffA);
            PG8_WAIT_V(8); PG8_WAIT_L(0); PG8_BAR; PG8_MMA(1, 0, At, B0); PG8_MMA(1, 1, At, B1); PG8_BAR; PG8_SCHED;
            } else {
            PG8_LDB(B0, 0, 0); PG8_SCHED; PG8_LDA(At, 0, 0); PG8_STAGE(PG8_SA(1, 1), a1 + hstep, voffA);
            PG8_WAIT_L(8); PG8_BAR; PG8_WAIT_L(0); PG8_MMA(0, 0, At, B0); PG8_BAR; PG8_SCHED;
            PG8_LDB(B1, 0, 1); PG8_STAGE(PG8_SB(0, 0), b2, voffB);
            PG8_BAR; PG8_WAIT_L(0); PG8_MMA(0, 1, At, B1); PG8_BAR;
            PG8_LDA(At, 0, 1); PG8_STAGE(PG8_SA(0, 0), a2, voffA);
            PG8_BAR; PG8_WAIT_L(0); PG8_MMA(1, 0, At, B0); PG8_BAR; PG8_SCHED;
            PG8_STAGE(PG8_SB(0, 1), b2 + hstep, voffB);
            PG8_WAIT_V(6); PG8_BAR; PG8_MMA(1, 1, At, B1); PG8_BAR;
            PG8_LDB(B0, 1, 0); PG8_SCHED; PG8_LDA(At, 1, 0); PG8_STAGE(PG8_SA(0, 1), a2 + hstep, voffA);
            PG8_WAIT_L(8); PG8_BAR; PG8_WAIT_L(0); PG8_MMA(0, 0, At, B0); PG8_BAR; PG8_SCHED;
            PG8_LDB(B1, 1, 1); PG8_STAGE(PG8_SB(1, 0), b3, voffB);
            PG8_BAR; PG8_WAIT_L(0); PG8_MMA(0, 1, At, B1); PG8_BAR;
            PG8_LDA(At, 1, 1); PG8_STAGE(PG8_SA(1, 0), a3, voffA);
            PG8_BAR; PG8_WAIT_L(0); PG8_MMA(1, 0, At, B0); PG8_BAR; PG8_SCHED;
            PG8_STAGE(PG8_SB(1, 1), b3 + hstep, voffB);
            PG8_WAIT_V(6); PG8_BAR; PG8_MMA(1, 1, At, B1); PG8_BAR;
            }
        }
        if constexpr (ALIGN_EPI) { if (wr == 0) PG8_BAR; }
        if constexpr (!Epi::AFTER_DRAIN) { E(acc, cur, wr, wc, fr, fq); S.done(cur); }
        if (!has_next) break;
#pragma unroll
        for (int a = 0; a < 2; ++a)
#pragma unroll
            for (int b = 0; b < 2; ++b)
#pragma unroll
                for (int m = 0; m < 4; ++m)
#pragma unroll
                    for (int n = 0; n < 2; ++n) acc[a][b][m][n] = (f32x4){0.f, 0.f, 0.f, 0.f};
        cur = nxt; cA = nA; cB = nB; ++ui;
        if constexpr (ALIGN_EPI) { if (wr == 1) PG8_BAR; }
    }
    PG8_WAIT_V(0);
    if constexpr (!ALIGN_EPI) { if (wr == 0) PG8_BAR; }
    PG8_BAR;
    if constexpr (Epi::AFTER_DRAIN) { E.fused(acc, cur, wr, wc, fr, fq, lds, wid, lane); S.done(cur); }
#undef PG8_SA
#undef PG8_SB
#undef PG8_STAGE
#undef PG8_LDA
#undef PG8_LDB
#undef PG8_MMA
#undef PG8_WAIT_V
#undef PG8_WAIT_L
#undef PG8_BAR
#undef PG8_SCHED
}
}
namespace att {
using bf16x8 = __attribute__((ext_vector_type(8))) short;
using s16x4  = __attribute__((ext_vector_type(4))) short;
using f32x16 = __attribute__((ext_vector_type(16))) float;
using u32x4  = __attribute__((ext_vector_type(4))) unsigned;
typedef unsigned short bf16;
constexpr int DQ = 64, DV = 128, NW = 8, QBLK = 32, KVBLK = 64, LDR = 3072;
constexpr int SHM_V = KVBLK * DV * 2, SHM_K = KVBLK * DQ * 2, SHM_ATTN = 3 * SHM_V + 3 * SHM_K + NW * 64 * 4 + 64;
constexpr int SHM_ATTN_ALL = SHM_ATTN + NW * QBLK * DV * 2;
#ifndef ATT_OVF_LIMIT
#define ATT_OVF_LIMIT 1.152921504606847e18f
#endif
#ifndef ATT_SDEPTH
#define ATT_SDEPTH 2
#endif
constexpr float THR2 = 11.0f;
#define KSWZ64(row, colB) ((row) * 128 + ((colB) ^ ((((row) >> 1) & 7) << 4)))
#define SBAR() __builtin_amdgcn_sched_barrier(0)
template <int K> __device__ __forceinline__ float sx(float v) { return __builtin_bit_cast(float, __builtin_amdgcn_ds_swizzle(__builtin_bit_cast(int, v), (K << 10) | 0x1f)); }
__device__ __forceinline__ int crow(int r, int hi) { return (r & 3) + 8 * (r >> 2) + 4 * hi; }
__device__ __forceinline__ unsigned cvtpk(float lo, float hi) { unsigned r; asm volatile("v_cvt_pk_bf16_f32 %0, %1, %2" : "=v"(r) : "v"(lo), "v"(hi)); return r; }
__device__ __forceinline__ void partialSM(f32x16& p0, f32x16& p1, float& m_reg, float& mn, float& alpha) {
  float pmax = p0[0];
#pragma unroll
  for (int r = 1; r < 16; ++r) pmax = fmaxf(pmax, p0[r]);
#pragma unroll
  for (int r = 0; r < 16; ++r) pmax = fmaxf(pmax, p1[r]);
  { auto rr = __builtin_amdgcn_permlane32_swap(__float_as_uint(pmax), __float_as_uint(pmax), false, false);
    pmax = fmaxf(__uint_as_float(rr[0]), __uint_as_float(rr[1])); }
  if (__builtin_expect(__all(pmax - m_reg <= THR2), 1)) { mn = m_reg; alpha = 1.f; }
  else { mn = fmaxf(m_reg, pmax); alpha = __builtin_amdgcn_exp2f(m_reg - mn); m_reg = mn; }
#pragma unroll
  for (int r = 0; r < 16; ++r) p0[r] = p0[r] - mn;
#pragma unroll
  for (int r = 0; r < 16; ++r) p1[r] = p1[r] - mn;
#pragma unroll
  for (int r = 0; r < 16; ++r) p0[r] = __builtin_amdgcn_exp2f(p0[r]);
}
__device__ __forceinline__ void finishSM(f32x16& p0, f32x16& p1, float alpha, float& l_reg, bf16x8& pa0, bf16x8& pa1, bf16x8& pa2, bf16x8& pa3) {
#pragma unroll
  for (int r = 0; r < 16; ++r) p1[r] = __builtin_amdgcn_exp2f(p1[r]);
  float ps = 0;
#pragma unroll
  for (int r = 0; r < 16; ++r) ps += p0[r];
#pragma unroll
  for (int r = 0; r < 16; ++r) ps += p1[r];
  { auto rr = __builtin_amdgcn_permlane32_swap(__float_as_uint(ps), __float_as_uint(ps), false, false);
    ps = __uint_as_float(rr[0]) + __uint_as_float(rr[1]); }
  l_reg = l_reg * alpha + ps;
#define PK4(P, BASE, OUT) do { unsigned a0 = cvtpk(P[BASE + 0], P[BASE + 1]), a1 = cvtpk(P[BASE + 2], P[BASE + 3]);   \
    unsigned b0 = cvtpk(P[BASE + 4], P[BASE + 5]), b1 = cvtpk(P[BASE + 6], P[BASE + 7]);                              \
    auto r0 = __builtin_amdgcn_permlane32_swap(a0, b0, false, false); auto r1 = __builtin_amdgcn_permlane32_swap(a1, b1, false, false); \
    u32x4 w = {r0[0], r1[0], r0[1], r1[1]}; OUT = *reinterpret_cast<bf16x8*>(&w); } while (0)
  PK4(p0, 0, pa0); PK4(p0, 8, pa1); PK4(p1, 0, pa2); PK4(p1, 8, pa3);
#undef PK4
}
__device__ __forceinline__ void qkt(f32x16& p0, f32x16& p1, const char* Ks, const bf16x8* qr, int r32, int hi) {
  p0 = f32x16{}; p1 = f32x16{};
#pragma unroll
  for (int d0 = 0; d0 < 4; ++d0) { const int cb = (d0 * 16 + hi * 8) * 2;
    bf16x8 b0 = *reinterpret_cast<const bf16x8*>(Ks + KSWZ64(r32, cb));
    bf16x8 b1 = *reinterpret_cast<const bf16x8*>(Ks + KSWZ64(32 + r32, cb));
    p0 = __builtin_amdgcn_mfma_f32_32x32x16_bf16(b0, qr[d0], p0, 0, 0, 0);
    p1 = __builtin_amdgcn_mfma_f32_32x32x16_bf16(b1, qr[d0], p1, 0, 0, 0); }
}
__device__ __forceinline__ void qkt_ref(f32x16& p0, f32x16& p1, const char* Ks, const bf16x8* qr, const f32x16& negm, int r32, int hi) {
#pragma unroll
  for (int d0 = 0; d0 < 4; ++d0) { const int cb = (d0 * 16 + hi * 8) * 2;
    bf16x8 b0 = *reinterpret_cast<const bf16x8*>(Ks + KSWZ64(r32, cb));
    bf16x8 b1 = *reinterpret_cast<const bf16x8*>(Ks + KSWZ64(32 + r32, cb));
    if (d0 == 0) { p0 = __builtin_amdgcn_mfma_f32_32x32x16_bf16(b0, qr[0], negm, 0, 0, 0); p1 = __builtin_amdgcn_mfma_f32_32x32x16_bf16(b1, qr[0], negm, 0, 0, 0); }
    else { p0 = __builtin_amdgcn_mfma_f32_32x32x16_bf16(b0, qr[d0], p0, 0, 0, 0); p1 = __builtin_amdgcn_mfma_f32_32x32x16_bf16(b1, qr[d0], p1, 0, 0, 0); } }
}
__device__ __forceinline__ void exp_half(f32x16& p) {
#pragma unroll
  for (int r = 0; r < 16; ++r) p[r] = __builtin_amdgcn_exp2f(p[r]);
}
__device__ __forceinline__ void sub_exp_half(f32x16& p0, f32x16& p1, float m) {
#pragma unroll
  for (int r = 0; r < 16; ++r) p0[r] = p0[r] - m;
#pragma unroll
  for (int r = 0; r < 16; ++r) p1[r] = p1[r] - m;
#pragma unroll
  for (int r = 0; r < 16; ++r) p0[r] = __builtin_amdgcn_exp2f(p0[r]);
}
__device__ __forceinline__ void finishSM_fast(f32x16& p0, f32x16& p1, float& l_reg, bool& ovf, bf16x8& pa0, bf16x8& pa1, bf16x8& pa2, bf16x8& pa3) {
  float al = 1.f; float l0 = 0.f;
  finishSM(p0, p1, al, l0, pa0, pa1, pa2, pa3);
  ovf = ovf || !(l0 < ATT_OVF_LIMIT);
  l_reg += l0;
}
__device__ __forceinline__ int v_st(int k, int c) { const int kk = (k & ~0xC) | ((k & 4) << 1) | ((k & 8) >> 1); return ((kk >> 3) * 4 + (c >> 5)) * 512 + ((kk & 7) * 32 + (c & 31)) * 2; }
__device__ __forceinline__ int v_rd_base(int lane) { return ((lane & 3) << 3) | (((lane >> 2) & 3) << 6) | (((lane >> 4) & 1) << 5) | (((lane >> 5) & 1) << 8); }
constexpr int v_rd_off(int d0, int ks, int half) { return d0 * 512 + ks * 4096 + half * 2048; }
template <int OFF> __device__ __forceinline__ s16x4 tr_read(int vb) {
  s16x4 r; asm volatile("ds_read_b64_tr_b16 %0, %1 offset:%2" : "=&v"(r) : "v"(vb), "i"(OFF) : "memory"); return r;
}
template <int D0> __device__ __forceinline__ void pv_one(f32x16& od, int vb, bf16x8 pa0, bf16x8 pa1, bf16x8 pa2, bf16x8 pa3) {
  const s16x4 l0 = tr_read<v_rd_off(D0, 0, 0)>(vb), h0 = tr_read<v_rd_off(D0, 0, 1)>(vb), l1 = tr_read<v_rd_off(D0, 1, 0)>(vb), h1 = tr_read<v_rd_off(D0, 1, 1)>(vb);
  const s16x4 l2 = tr_read<v_rd_off(D0, 2, 0)>(vb), h2 = tr_read<v_rd_off(D0, 2, 1)>(vb), l3 = tr_read<v_rd_off(D0, 3, 0)>(vb), h3 = tr_read<v_rd_off(D0, 3, 1)>(vb);
  asm volatile("s_waitcnt lgkmcnt(0)" ::: "memory"); SBAR();
#define PK(L, H) (bf16x8){L[0], L[1], L[2], L[3], H[0], H[1], H[2], H[3]}
  od = __builtin_amdgcn_mfma_f32_32x32x16_bf16(pa0, PK(l0, h0), od, 0, 0, 0);
  od = __builtin_amdgcn_mfma_f32_32x32x16_bf16(pa1, PK(l1, h1), od, 0, 0, 0);
  od = __builtin_amdgcn_mfma_f32_32x32x16_bf16(pa2, PK(l2, h2), od, 0, 0, 0);
  od = __builtin_amdgcn_mfma_f32_32x32x16_bf16(pa3, PK(l3, h3), od, 0, 0, 0);
#undef PK
}
__device__ __forceinline__ void pv_d0(f32x16* o, int vb, bf16x8 pa0, bf16x8 pa1, bf16x8 pa2, bf16x8 pa3) {
  pv_one<0>(o[0], vb, pa0, pa1, pa2, pa3); pv_one<1>(o[1], vb, pa0, pa1, pa2, pa3); pv_one<2>(o[2], vb, pa0, pa1, pa2, pa3); pv_one<3>(o[3], vb, pa0, pa1, pa2, pa3);
}
__device__ __forceinline__ void glds16(const void* gsrc, unsigned lds_dst) { unsigned keep;
  asm volatile("s_mov_b32 %0, m0\n\ts_mov_b32 m0, %2\n\ts_nop 0\n\tglobal_load_lds_dwordx4 %1, off\n\ts_mov_b32 m0, %0" : "=&s"(keep) : "v"(gsrc), "s"(lds_dst) : "memory"); }
template <bool FAST>
__device__ __forceinline__ bool attn_map(const bf16* __restrict__ Kh, const bf16* __restrict__ Vh, const bf16* __restrict__ Qh  , int seq, char* V_lds, char* K_lds, float* ws_base,
                                         f32x16 (&o)[4], float& l_out) {
    int tid = threadIdx.x; asm volatile("" : "+v"(tid));
    const int wid = __builtin_amdgcn_readfirstlane(tid >> 6), r32 = tid & 31, hi = (tid >> 5) & 1;
    float* al_l = ws_base + wid * 64 + 32;
    const bf16* Qw = Qh + (long)(wid * QBLK + r32) * LDR + hi * 8;
    const int lane_ = tid & 63;
    const unsigned lds0 = (unsigned)(uintptr_t)V_lds;
    const bf16 *vsrc0, *vsrc1, *ksrc;
    { const int o0 = (2 * wid) * 1024 + 16 * lane_, o1 = o0 + 1024, ok = wid * 1024 + 16 * lane_;
      auto vmap = [](int o, int& k, int& c) { const int sub = o >> 9, w = o & 511, kk = ((sub >> 2) << 3) | (w >> 6); k = (kk & ~0xC) | ((kk & 4) << 1) | ((kk & 8) >> 1); c = (sub & 3) * 32 + ((w & 63) >> 1); };
      int k0_, c0_, k1_, c1_; vmap(o0, k0_, c0_); vmap(o1, k1_, c1_);
      vsrc0 = Vh + (long)k0_ * LDR + c0_; vsrc1 = Vh + (long)k1_ * LDR + c1_;
      const int row = ok >> 7, cb = (ok & 127) ^ (((row >> 1) & 7) << 4);
      ksrc = Kh + (long)row * LDR + (cb >> 1); }
    const int vb0 = (int)(uintptr_t)V_lds + v_rd_base(tid & 63);
    float m_reg = -1e30f, l_reg = 0; bf16x8 qr[4]; bool ovf = false;
#pragma unroll
    for (int d0 = 0; d0 < 4; ++d0) { o[d0] = f32x16{}; qr[d0] = *reinterpret_cast<const bf16x8*>(Qw + d0 * 16); }
#define DMA_TILE(t, b) do { const long ro_ = (long)(t) * KVBLK * LDR; \
      glds16(vsrc0 + ro_, (unsigned)__builtin_amdgcn_readfirstlane(lds0 + (b) * SHM_V + (2 * wid) * 1024)); \
      glds16(vsrc1 + ro_, (unsigned)__builtin_amdgcn_readfirstlane(lds0 + (b) * SHM_V + (2 * wid + 1) * 1024)); \
      glds16(ksrc + ro_, (unsigned)__builtin_amdgcn_readfirstlane(lds0 + 3 * SHM_V + (b) * SHM_K + wid * 1024)); } while (0)
#define DMA_WAIT() asm volatile("s_waitcnt vmcnt(0)" ::: "memory")
#define RESC(a) do { if constexpr (!FAST) { if (__any((a) < 1.f)) { if (hi == 0) al_l[r32] = (a); asm volatile("s_waitcnt lgkmcnt(0)" ::: "memory"); \
    _Pragma("unroll") for (int d = 0; d < 4; ++d) _Pragma("unroll") for (int r = 0; r < 16; ++r) o[d][r] *= al_l[crow(r, hi)]; } } } while (0)
#define PSM(P0, P1, MN, AL) do { if constexpr (FAST) exp_half(P0); else partialSM(P0, P1, m_reg, MN, AL); } while (0)
#define FSM(P0, P1, AL) do { if constexpr (FAST) finishSM_fast(P0, P1, l_reg, ovf, pa0, pa1, pa2, pa3); else finishSM(P0, P1, AL, l_reg, pa0, pa1, pa2, pa3); } while (0)
#define STEP(PN0, PN1, MNN, ALN, PO0, PO1, ALO, jj) do { \
      SBAR(); if constexpr (FAST) qkt_ref(PN0, PN1, K_lds + bc * SHM_K, qr, negm, r32, hi); else qkt(PN0, PN1, K_lds + bc * SHM_K, qr, r32, hi); \
      if ((jj) + 1 < NT) DMA_TILE((jj) + 1, bn);              \
      FSM(PO0, PO1, ALO); SBAR(); \
      pv_d0(o, vb0 + bp * SHM_V, pa0, pa1, pa2, pa3); PSM(PN0, PN1, MNN, ALN); RESC(ALN); \
      DMA_WAIT(); __syncthreads(); \
      bp = bc; bc = bn; bn = (bn == 2) ? 0 : bn + 1; } while (0)
    f32x16 pA0, pA1, pB0, pB1; float mnA = 0.f, mnB = 0.f, alA = 1.f, alB = 1.f; bf16x8 pa0, pa1, pa2, pa3; const int NT = seq / KVBLK;
    DMA_TILE(0, 0); DMA_WAIT(); __syncthreads();
    if (1 < NT) DMA_TILE(1, 1);
    qkt(pA0, pA1, K_lds, qr, r32, hi); partialSM(pA0, pA1, m_reg, mnA, alA);
    f32x16 negm = f32x16{};
    if constexpr (FAST) {
#pragma unroll
      for (int r = 0; r < 16; ++r) negm[r] = -m_reg;
      asm volatile("" : "+v"(negm));
    }
    DMA_WAIT(); __syncthreads();
    int bp = 0, bc = 1, bn = 2;
    for (int j = 1; j + 1 < NT; j += 2) {
      STEP(pB0, pB1, mnB, alB, pA0, pA1, alA, j);
      STEP(pA0, pA1, mnA, alA, pB0, pB1, alB, j + 1);
    }
    STEP(pB0, pB1, mnB, alB, pA0, pA1, alA, NT - 1);
    FSM(pB0, pB1, alB); SBAR();
    pv_d0(o, vb0 + bp * SHM_V, pa0, pa1, pa2, pa3);
#undef DMA_TILE
#undef DMA_WAIT
#undef RESC
#undef PSM
#undef FSM
#undef STEP
    l_out = l_reg;
    return ovf;
}
__device__ __forceinline__ void attn_unit(const bf16* __restrict__ qkv, long Qrow0, long Krow0, int vh, int seq, float lam, float oscale, const float* __restrict__ subln,
                                          bf16* __restrict__ Ob, int ldo, float* stash, char* lds) {
  int tid = threadIdx.x; asm volatile("" : "+v"(tid));
  const int wid = __builtin_amdgcn_readfirstlane(tid >> 6), lane = tid & 63, r32 = lane & 31, hi = lane >> 5;
  char* V_lds = lds; char* K_lds = lds + 3 * SHM_V;
  float* wsb = (float*)(lds + 3 * SHM_V + 3 * SHM_K); float* li_l = wsb + wid * 64;
  volatile unsigned* ovw = (volatile unsigned*)(lds + 3 * SHM_V + 3 * SHM_K + NW * 64 * 4);
  const bf16* Vh = qkv + Krow0 * LDR + 2048 + vh * DV;
  for (int s = 0; s < 2; ++s) {
    const int head = 2 * vh + s;
    const bf16* Kh = qkv + Krow0 * LDR + 1024 + head * DQ;
    const bf16* Qh = qkv + Qrow0 * LDR + head * DQ;
    f32x16 o[4]; float l_reg;
    const bool ovf = attn_map<true>(Kh, Vh, Qh, seq, V_lds, K_lds, wsb, o, l_reg);
    if (lane == 0) ovw[wid] = __any(ovf) ? 1u : 0u;
    __syncthreads();
    unsigned anyovf = 0u;
#pragma unroll
    for (int w = 0; w < NW; ++w) anyovf |= ovw[w];
    __syncthreads();
    if (__builtin_amdgcn_readfirstlane(anyovf) != 0u) (void)attn_map<false>(Kh, Vh, Qh, seq, V_lds, K_lds, wsb, o, l_reg);
    if (hi == 0) li_l[r32] = l_reg; asm volatile("s_waitcnt lgkmcnt(0)" ::: "memory");
    float rli[16];
#pragma unroll
    for (int r = 0; r < 16; ++r) rli[r] = __builtin_amdgcn_rcpf(li_l[crow(r, hi)]);
    typedef float f32x4_t __attribute__((ext_vector_type(4)));
    f32x4_t* st4 = (f32x4_t*)stash + (size_t)tid * 16;
    if (s == 0) {
#pragma unroll
      for (int d0 = 0; d0 < 4; ++d0)
#pragma unroll
        for (int r4 = 0; r4 < 4; ++r4) { f32x4_t v; v[0] = o[d0][4 * r4] * rli[4 * r4]; v[1] = o[d0][4 * r4 + 1] * rli[4 * r4 + 1]; v[2] = o[d0][4 * r4 + 2] * rli[4 * r4 + 2]; v[3] = o[d0][4 * r4 + 3] * rli[4 * r4 + 3]; st4[d0 * 4 + r4] = v; }
    } else {
      float ssq[16];
#pragma unroll
      for (int r = 0; r < 16; ++r) ssq[r] = 0.f;
#pragma unroll
      for (int d0 = 0; d0 < 4; ++d0)
#pragma unroll
        for (int r4 = 0; r4 < 4; ++r4) { const f32x4_t sv = st4[d0 * 4 + r4];
#pragma unroll
          for (int i = 0; i < 4; ++i) { const int r = 4 * r4 + i; const float v = sv[i] - lam * (o[d0][r] * rli[r]); o[d0][r] = v; ssq[r] += v * v; } }
#pragma unroll
      for (int r = 0; r < 16; ++r) {
        float a = ssq[r];
        a += sx<1>(a); a += sx<2>(a); a += sx<4>(a); a += sx<8>(a); a += sx<16>(a);
        ssq[r] = oscale / sqrtf(a * (1.0f / 128.0f) + 1e-6f);
      }
      float g[4];
#pragma unroll
      for (int d0 = 0; d0 < 4; ++d0) g[d0] = subln[d0 * 32 + r32];
      bf16* stg = (bf16*)(lds + SHM_ATTN) + wid * (QBLK * DV);
      unsigned so = (unsigned)((4 * hi) * DV + r32); asm volatile("" : "+v"(so));
#pragma unroll
      for (int r = 0; r < 16; ++r) {
#pragma unroll
        for (int d0 = 0; d0 < 4; ++d0) { const unsigned w = cvtpk(o[d0][r] * ssq[r] * g[d0], 0.f); (stg + ((r & 3) + 8 * (r >> 2)) * DV + d0 * 32)[so] = (bf16)(w & 0xffffu); } }
      asm volatile("s_waitcnt lgkmcnt(0)" ::: "memory");
      int ldo_ = ldo; asm volatile("" : "+s"(ldo_));
      bf16* Ow = Ob + (long)(wid * QBLK) * ldo_;
      const int srow = lane >> 4, sch = lane & 15;
#pragma unroll
      for (int i = 0; i < 8; ++i) { const int row = i * 4 + srow; const u32x4 v = *(const u32x4*)(stg + row * DV + sch * 8); *(u32x4*)(Ow + (long)row * ldo_ + sch * 8) = v; }
    }
  }
}
#undef SBAR
}
#define GAS __attribute__((address_space(1)))
#define LAS __attribute__((address_space(3)))
typedef unsigned short bf16;
typedef unsigned v4u __attribute__((ext_vector_type(4)));
typedef float f32x4 __attribute__((ext_vector_type(4)));
typedef short bf16x8 __attribute__((ext_vector_type(8)));
typedef GAS unsigned gu32;
typedef GAS unsigned long long gu64;
#define RLX_AGENT __ATOMIC_RELAXED, __HIP_MEMORY_SCOPE_AGENT
#define LDS_WAIT() asm volatile("s_waitcnt lgkmcnt(0)" ::: "memory")
#define VM_WAIT() asm volatile("s_waitcnt vmcnt(0)" ::: "memory")
__device__ __forceinline__ unsigned long long rt() { return __builtin_amdgcn_s_memrealtime(); }
__device__ __forceinline__ unsigned f2bf(float f) { unsigned u = __builtin_bit_cast(unsigned, f); return (u + 0x7fffu + ((u >> 16) & 1u)) >> 16; }
__device__ __forceinline__ unsigned pk2(float lo, float hi) { unsigned r; asm("v_cvt_pk_bf16_f32 %0, %1, %2" : "=v"(r) : "v"(lo), "v"(hi)); return r; }

#define XB_TMO      128
#define XB_XCNT(j)  (256  + 64 * (j))
#define XB_XSUB(j)  (1280 + 64 * (j))
#define XB_XGEN(j)  (2304 + 64 * (j))
#define XB_TOP      3328
#define XB_TOPGEN   3392
#define XCD_BAR_WORDS 3456
#define XB_SPIN_CAP (1u << 18)

__device__ __forceinline__ unsigned xb_ld(unsigned* p)              { return __hip_atomic_load(p, __ATOMIC_RELAXED, __HIP_MEMORY_SCOPE_AGENT); }
__device__ __forceinline__ unsigned xb_add(unsigned* p, unsigned v) { return __hip_atomic_fetch_add(p, v, __ATOMIC_RELAXED, __HIP_MEMORY_SCOPE_AGENT); }
__device__ __forceinline__ unsigned xb_xcc_id() { return (unsigned)__builtin_amdgcn_s_getreg((3 << 11) | 20) & 0xFu; }
#define XB_SPIN(cond, bar) do { unsigned _sp = 0; while (cond) { __builtin_amdgcn_s_sleep(1); \
    if ((++_sp & 255u) == 0u) { if (xb_ld(&(bar)[XB_TMO])) break; if (_sp > XB_SPIN_CAP) { atomicAdd(&(bar)[XB_TMO], 1u); break; } } } } while (0)

struct XcdBarrier {
    unsigned* bar; unsigned x;
    volatile LAS unsigned* st;
};

__device__ __forceinline__ XcdBarrier xcd_barrier_post(unsigned* bar, volatile LAS unsigned* st) {
    XcdBarrier b; b.bar = bar; b.x = xb_xcc_id(); b.st = st;
    if (threadIdx.x == 0) (void)xb_add(&bar[XB_XCNT(b.x)], 1u);
    return b;
}
__device__ __forceinline__ void xcd_barrier_complete(unsigned* bar, unsigned x, unsigned& nloc, unsigned& nx) {
    const unsigned G = gridDim.x * gridDim.y * gridDim.z;
    unsigned sum, cnt, mine, sp = 0u;
    for (;;) {
        sum = 0u; cnt = 0u; mine = 0u;
#pragma unroll
        for (unsigned j = 0; j < 16; ++j) { const unsigned c = xb_ld(&bar[XB_XCNT(j)]); sum += c; cnt += (c > 0u) ? 1u : 0u; mine = (j == x) ? c : mine; }
        if (sum == G) break;
        __builtin_amdgcn_s_sleep(1);
        if ((++sp & 255u) == 0u) { if (xb_ld(&bar[XB_TMO])) break; if (sp > XB_SPIN_CAP) { atomicAdd(&bar[XB_TMO], 1u); break; } }
    }
    nloc = mine > 0u ? mine : 1u; nx = cnt > 0u ? cnt : 1u;
}

__device__ __forceinline__ void xcd_barrier(const XcdBarrier& b) {
    asm volatile("s_waitcnt vmcnt(0)" ::: "memory");
    __syncthreads();
    if (threadIdx.x == 0) {
        unsigned* bar = b.bar;
        __builtin_amdgcn_s_waitcnt(0);
        unsigned nloc = b.st[0], nx = b.st[1];
        if (nloc == 0u) { xcd_barrier_complete(bar, b.x, nloc, nx); b.st[0] = nloc; b.st[1] = nx; }
        const unsigned old = xb_add(&bar[XB_XSUB(b.x)], 1u);
        const unsigned gen = old / nloc;
        if (old + 1u == (gen + 1u) * nloc) {
            __builtin_amdgcn_fence(__ATOMIC_RELEASE, "agent");
            asm volatile("s_waitcnt vmcnt(0)" ::: "memory");
            const unsigned og = xb_add(&bar[XB_TOP], 1u);
            const unsigned tg = og / nx;
            if (og + 1u == (tg + 1u) * nx) xb_add(&bar[XB_TOPGEN], 1u);
            else XB_SPIN(xb_ld(&bar[XB_TOPGEN]) == tg, bar);
            __builtin_amdgcn_fence(__ATOMIC_ACQUIRE, "agent");
            xb_add(&bar[XB_XGEN(b.x)], 1u);
            asm volatile("s_waitcnt vmcnt(0)" ::: "memory");
        } else {
            XB_SPIN(xb_ld(&bar[XB_XGEN(b.x)]) == gen, bar);
            __builtin_amdgcn_fence(__ATOMIC_ACQUIRE, "agent");
            asm volatile("s_waitcnt vmcnt(0)" ::: "memory");
        }
    }
    __syncthreads();
}
#define HYD __device__ __forceinline__
#define HYDM __device__ __forceinline__
#define HY_DEVICE 1
#ifdef HY_DEVICE
#define HY_OPAQUE(x) asm volatile("" : "+v"(x))
#else
#define HY_OPAQUE(x) (void)(x)
#endif
typedef float cf __attribute__((ext_vector_type(2)));
typedef float cf2 __attribute__((ext_vector_type(4)));
template <class P> struct HyP2 {};
template <> struct HyP2<cf*> { typedef cf2* type; };
#ifdef HY_DEVICE
template <> struct HyP2<__attribute__((address_space(3))) cf*> { typedef __attribute__((address_space(3))) cf2* type; };
#endif
HYD cf cf_add(cf a, cf b) { return a + b; }
HYD cf cf_sub(cf a, cf b) { return a - b; }
HYD cf cf_mul(cf a, cf b) { return cf{a.x * b.x - a.y * b.y, a.x * b.y + a.y * b.x}; }
HYD cf cf_mulc(cf a, cf b) { return cf{a.x * b.x + a.y * b.y, a.y * b.x - a.x * b.y}; }
constexpr int FN = 16384, FT = 512, FLOG = 14, FNP = FN + 4 * (FN >> 6);
constexpr int SEQL = 8192;
HYD int HP(int i) { return i + ((i >> 6) << 2); }
#define HY_C1 0.92387953251128674f
#define HY_S1 0.38268343236508977f
#define HY_R2 0.70710678118654752f
template <int M16> HYD cf mul_root16(cf w) {
    if (M16 == 0) return w;
    if (M16 == 4) return cf{w.y, -w.x};
    if (M16 == 2) return cf{(w.x + w.y) * HY_R2, (w.y - w.x) * HY_R2};
    if (M16 == 6) return cf{(w.y - w.x) * HY_R2, -(w.x + w.y) * HY_R2};
    if (M16 == 1) return cf_mul(w, cf{HY_C1, -HY_S1});
    if (M16 == 3) return cf_mul(w, cf{HY_S1, -HY_C1});
    if (M16 == 5) return cf_mul(w, cf{-HY_S1, -HY_C1});
    return cf_mul(w, cf{-HY_C1, -HY_S1});
}
template <int Q, int U, bool INV, bool ZUP, bool HLO> struct HyStage {
    static HYDM void run(cf (&e)[1 << Q], const cf (&tw)[Q]) {
        constexpr int R = 1 << Q, half = R >> (U + 1);
#pragma unroll
        for (int k = 0; k < R; ++k) {
            if ((k & half) == 0) {
                const int kp = k & (half - 1);
                cf w = tw[U];
                switch (kp * 16 / (2 * half)) {
                    case 0: break;
                    case 1: w = mul_root16<1>(w); break;
                    case 2: w = mul_root16<2>(w); break;
                    case 3: w = mul_root16<3>(w); break;
                    case 4: w = mul_root16<4>(w); break;
                    case 5: w = mul_root16<5>(w); break;
                    case 6: w = mul_root16<6>(w); break;
                    default: w = mul_root16<7>(w); break;
                }
                if (!INV) {
                    if (ZUP && U == 0) { e[k + half] = cf_mul(e[k], w); }
                    else { const cf a = e[k], b = e[k + half]; e[k] = cf_add(a, b); e[k + half] = cf_mul(cf_sub(a, b), w); }
                } else {
                    const cf a = e[k], b = cf_mulc(e[k + half], w); e[k] = cf_add(a, b);
                    if (!(HLO && U == 0)) e[k + half] = cf_sub(a, b);
                }
            }
        }
    }
};
template <int Q, bool INV, bool ZUP, bool HLO> HYD void hy_bfly(cf (&e)[1 << Q], cf t) {
    cf tw[Q]; tw[0] = t;
#pragma unroll
    for (int u = 1; u < Q; ++u) tw[u] = cf_mul(tw[u - 1], tw[u - 1]);
    if (Q == 4) {
        if (!INV) { HyStage<Q, 0, INV, ZUP, HLO>::run(e, tw); HyStage<Q, 1, INV, ZUP, HLO>::run(e, tw); HyStage<Q, 2 % Q, INV, ZUP, HLO>::run(e, tw); HyStage<Q, 3 % Q, INV, ZUP, HLO>::run(e, tw); }
        else      { HyStage<Q, 3 % Q, INV, ZUP, HLO>::run(e, tw); HyStage<Q, 2 % Q, INV, ZUP, HLO>::run(e, tw); HyStage<Q, 1, INV, ZUP, HLO>::run(e, tw); HyStage<Q, 0, INV, ZUP, HLO>::run(e, tw); }
    } else {
        if (!INV) { HyStage<Q, 0, INV, ZUP, HLO>::run(e, tw); HyStage<Q, 1, INV, ZUP, HLO>::run(e, tw); }
        else      { HyStage<Q, 1, INV, ZUP, HLO>::run(e, tw); HyStage<Q, 0, INV, ZUP, HLO>::run(e, tw); }
    }
}
#ifdef HY_DEVICE
#define HY_MULT(T, X, Y) "v_pk_mul_f32 " T ", " X ", " Y " op_sel:[1,1] op_sel_hi:[1,0]\n\t"
#define HY_FMAP(R, X, Y, T) "v_pk_fma_f32 " R ", " X ", " Y ", " T " op_sel_hi:[0,1,1] neg_lo:[0,0,1]\n\t"
#define HY_FMAC(R, X, Y, T) "v_pk_fma_f32 " R ", " X ", " Y ", " T " op_sel_hi:[0,1,1] neg_hi:[1,0,0]\n\t"
#define HY_ADD(R, A, B) "v_pk_add_f32 " R ", " A ", " B "\n\t"
#define HY_SUB(R, A, B) "v_pk_add_f32 " R ", " A ", " B " neg_lo:[0,1] neg_hi:[0,1]\n\t"
HYD void hy_cmul2(cf& r0, cf x0, cf y0, cf& r1, cf x1, cf y1) { cf t0, t1;
    asm(HY_MULT("%0", "%4", "%5") HY_MULT("%1", "%6", "%7") HY_FMAP("%2", "%4", "%5", "%0") HY_FMAP("%3", "%6", "%7", "%1")
        : "=&v"(t0), "=&v"(t1), "=&v"(r0), "=&v"(r1) : "v"(x0), "v"(y0), "v"(x1), "v"(y1)); }
HYD cf hy_cmul1(cf x, cf y) { cf t, r;
    asm(HY_MULT("%0", "%2", "%3") "s_nop 0\n\t" HY_FMAP("%1", "%2", "%3", "%0") : "=&v"(t), "=&v"(r) : "v"(x), "v"(y)); return r; }
HYD void hy_bf2_fwd(cf& a0, cf& b0, cf w0, cf& a1, cf& b1, cf w1) { cf d0, d1, t0, t1;
    asm(HY_SUB("%4", "%0", "%1") HY_ADD("%0", "%0", "%1") HY_SUB("%5", "%2", "%3") HY_ADD("%2", "%2", "%3")
        HY_MULT("%6", "%4", "%8") HY_MULT("%7", "%5", "%9") HY_FMAP("%1", "%4", "%8", "%6") HY_FMAP("%3", "%5", "%9", "%7")
        : "+v"(a0), "+v"(b0), "+v"(a1), "+v"(b1), "=&v"(d0), "=&v"(d1), "=&v"(t0), "=&v"(t1) : "v"(w0), "v"(w1)); }
HYD void hy_bf2_fwdz(cf a0, cf& b0, cf w0, cf a1, cf& b1, cf w1) { hy_cmul2(b0, a0, w0, b1, a1, w1); }
HYD void hy_bf2_inv(cf& a0, cf& b0, cf w0, cf& a1, cf& b1, cf w1) { cf t0, t1;
    asm(HY_MULT("%4", "%1", "%6") HY_MULT("%5", "%3", "%7") HY_FMAC("%4", "%1", "%6", "%4") HY_FMAC("%5", "%3", "%7", "%5")
        HY_SUB("%1", "%0", "%4") HY_SUB("%3", "%2", "%5") HY_ADD("%0", "%0", "%4") HY_ADD("%2", "%2", "%5")
        : "+v"(a0), "+v"(b0), "+v"(a1), "+v"(b1), "=&v"(t0), "=&v"(t1) : "v"(w0), "v"(w1)); }
HYD void hy_bf2_invl(cf& a0, cf b0, cf w0, cf& a1, cf b1, cf w1) { cf t0, t1;
    asm(HY_MULT("%2", "%4", "%6") HY_MULT("%3", "%5", "%7") HY_FMAC("%2", "%4", "%6", "%2") HY_FMAC("%3", "%5", "%7", "%3")
        HY_ADD("%0", "%0", "%2") HY_ADD("%1", "%1", "%3")
        : "+v"(a0), "+v"(a1), "=&v"(t0), "=&v"(t1) : "v"(b0), "v"(b1), "v"(w0), "v"(w1)); }
HYD cf hy_rot(cf w) { cf r; asm("v_pk_add_f32 %0, %1, 0 op_sel:[1,0] op_sel_hi:[0,0] neg_hi:[1,0]" : "=v"(r) : "v"(w)); return r; }
#else
HYD void hy_cmul2(cf& r0, cf x0, cf y0, cf& r1, cf x1, cf y1) { const cf p0 = cf_mul(x0, y0), p1 = cf_mul(x1, y1); r0 = p0; r1 = p1; }
HYD cf hy_cmul1(cf x, cf y) { return cf_mul(x, y); }
HYD void hy_bf2_fwd(cf& a0, cf& b0, cf w0, cf& a1, cf& b1, cf w1) { const cf d0 = cf_sub(a0, b0), d1 = cf_sub(a1, b1); a0 = cf_add(a0, b0); a1 = cf_add(a1, b1); b0 = cf_mul(d0, w0); b1 = cf_mul(d1, w1); }
HYD void hy_bf2_fwdz(cf a0, cf& b0, cf w0, cf a1, cf& b1, cf w1) { b0 = cf_mul(a0, w0); b1 = cf_mul(a1, w1); }
HYD void hy_bf2_inv(cf& a0, cf& b0, cf w0, cf& a1, cf& b1, cf w1) { const cf p0 = cf_mulc(b0, w0), p1 = cf_mulc(b1, w1); b0 = cf_sub(a0, p0); b1 = cf_sub(a1, p1); a0 = cf_add(a0, p0); a1 = cf_add(a1, p1); }
HYD void hy_bf2_invl(cf& a0, cf b0, cf w0, cf& a1, cf b1, cf w1) { a0 = cf_add(a0, cf_mulc(b0, w0)); a1 = cf_add(a1, cf_mulc(b1, w1)); }
HYD cf hy_rot(cf w) { return cf{w.y, -w.x}; }
#endif
template <int U, bool INV, bool ZUP, bool HLO> HYD void hy_stage16(cf (&e)[16], const cf* W) {
    constexpr int half = 8 >> U;
#pragma unroll
    for (int j = 0; j < 8; j += 2) {
        const int k0 = ((j / half) * 2 * half) + (j % half), k1 = (((j + 1) / half) * 2 * half) + ((j + 1) % half);
        const cf w0 = W[k0 & (half - 1)], w1 = W[k1 & (half - 1)];
        if (!INV) { if (ZUP && U == 0) hy_bf2_fwdz(e[k0], e[k0 + half], w0, e[k1], e[k1 + half], w1); else hy_bf2_fwd(e[k0], e[k0 + half], w0, e[k1], e[k1 + half], w1); }
        else { if (HLO && U == 0) hy_bf2_invl(e[k0], e[k0 + half], w0, e[k1], e[k1 + half], w1); else hy_bf2_inv(e[k0], e[k0 + half], w0, e[k1], e[k1 + half], w1); }
    }
}
template <bool INV, bool ZUP, bool HLO> HYD void hy_bfly16(cf (&e)[16], cf t) {
    cf W0[8], W1[4], W2[2], W3[1], tw1, tw2;
    cf k1 = cf{HY_C1, -HY_S1}, k2 = cf{HY_R2, -HY_R2}, k3 = cf{HY_S1, -HY_C1};
    W0[0] = t;
    hy_cmul2(W0[1], t, k1, W0[3], t, k3);
    hy_cmul2(W0[2], t, k2, tw1, t, t);
    W1[0] = tw1;
    hy_cmul2(W1[1], tw1, k2, tw2, tw1, tw1);
    W2[0] = tw2;
    W3[0] = hy_cmul1(tw2, tw2);
#pragma unroll
    for (int i = 0; i < 4; ++i) W0[4 + i] = hy_rot(W0[i]);
    W1[2] = hy_rot(W1[0]); W1[3] = hy_rot(W1[1]); W2[1] = hy_rot(W2[0]);
    if (!INV) { hy_stage16<0, INV, ZUP, HLO>(e, W0); hy_stage16<1, INV, ZUP, HLO>(e, W1); hy_stage16<2, INV, ZUP, HLO>(e, W2); hy_stage16<3, INV, ZUP, HLO>(e, W3); }
    else      { hy_stage16<3, INV, ZUP, HLO>(e, W3); hy_stage16<2, INV, ZUP, HLO>(e, W2); hy_stage16<1, INV, ZUP, HLO>(e, W1); hy_stage16<0, INV, ZUP, HLO>(e, W0); }
}
template <class PT> HYD cf hy_twid(PT thi, PT tlo, int e) { return hy_cmul1(thi[e >> 7], tlo[e & 127]); }
template <int S, bool INV, bool ZUP, bool HLO, class P, class PT>
HYD void hy_pass16(P X, PT thi, PT tlo, int tid) {
    constexpr int R = 16;
    constexpr int SP = (S >= 64) ? S + S / 16 : S;
    const int g0 = tid, g1 = tid + FT;
    const int lo0 = g0 & (S - 1), pb0 = HP((g0 / S) * S * R + lo0);
    const int lo1 = g1 & (S - 1), pb1 = HP((g1 / S) * S * R + lo1);
    cf e0[R], e1[R];
#pragma unroll
    for (int k = 0; k < R; ++k) { if (ZUP && k >= 8) e0[k] = cf{0.f, 0.f}; else e0[k] = X[pb0 + k * SP]; }
#pragma unroll
    for (int k = 0; k < R; ++k) { if (ZUP && k >= 8) e1[k] = cf{0.f, 0.f}; else e1[k] = X[pb1 + k * SP]; }
    const cf t0 = hy_twid(thi, tlo, lo0 * (FN / (R * S))), t1 = hy_twid(thi, tlo, lo1 * (FN / (R * S)));
    hy_bfly16<INV, ZUP, HLO>(e0, t0);
#pragma unroll
    for (int k = 0; k < R; ++k) { if (!(HLO && k >= 8)) X[pb0 + k * SP] = e0[k]; }
    hy_bfly16<INV, ZUP, HLO>(e1, t1);
#pragma unroll
    for (int k = 0; k < R; ++k) { if (!(HLO && k >= 8)) X[pb1 + k * SP] = e1[k]; }
}
template <bool INV> HYD void hy_r4(cf (&e)[4]) {
    if (!INV) {
        const cf a0 = e[0] + e[2], b0 = e[0] - e[2], a1 = e[1] + e[3], d = e[1] - e[3], b1 = cf{d.y, -d.x};
        e[0] = a0 + a1; e[1] = a0 - a1; e[2] = b0 + b1; e[3] = b0 - b1;
    } else {
        const cf a0 = e[0] + e[1], a1 = e[0] - e[1], a2 = e[2] + e[3], d = e[2] - e[3], b = cf{-d.y, d.x};
        e[0] = a0 + a2; e[2] = a0 - a2; e[1] = a1 + b; e[3] = a1 - b;
    }
}
template <bool INV, class P, class PK>
HYD void hy_pass4(P X, int tid, PK KM) {
    typedef typename HyP2<P>::type P2;
    const int w = tid >> 6, lane = tid & 63;
#pragma unroll 1
    for (int gb = 0; gb < 2; ++gb) {
        cf2 a[4], b[4], ka[4], kb[4];
        const int g0 = (gb * 8 + w) * 256 + lane;
#pragma unroll
        for (int u = 0; u < 4; ++u) { const int g = g0 + 64 * u; P2 X2 = (P2)(X + HP(4 * g)); a[u] = X2[0]; b[u] = X2[1];
            if (KM) { const unsigned gi = (unsigned)(4 * g) & 0x3fffu; ka[u] = ((const cf2*)(KM + gi))[0]; kb[u] = ((const cf2*)(KM + gi))[1]; } }
#pragma unroll
        for (int u = 0; u < 4; ++u) { const int g = g0 + 64 * u; P2 X2 = (P2)(X + HP(4 * g));
            cf e[4] = {cf{a[u].x, a[u].y}, cf{a[u].z, a[u].w}, cf{b[u].x, b[u].y}, cf{b[u].z, b[u].w}};
            hy_r4<INV>(e);
            if (KM) { cf q0, q1, q2, q3; hy_cmul2(q0, e[0], cf{ka[u].x, ka[u].y}, q1, e[1], cf{ka[u].z, ka[u].w}); hy_cmul2(q2, e[2], cf{kb[u].x, kb[u].y}, q3, e[3], cf{kb[u].z, kb[u].w}); e[0] = q0; e[1] = q1; e[2] = q2; e[3] = q3; }
            X2[0] = cf2{e[0].x, e[0].y, e[1].x, e[1].y}; X2[1] = cf2{e[2].x, e[2].y, e[3].x, e[3].y}; }
    }
}
HYD int hy_brev14(int p) {
    unsigned v = (unsigned)p;
    v = ((v >> 1) & 0x55555555u) | ((v & 0x55555555u) << 1);
    v = ((v >> 2) & 0x33333333u) | ((v & 0x33333333u) << 2);
    v = ((v >> 4) & 0x0F0F0F0Fu) | ((v & 0x0F0F0F0Fu) << 4);
    v = ((v >> 8) & 0x00FF00FFu) | ((v & 0x00FF00FFu) << 8);
    v = (v >> 16) | (v << 16);
    return (int)(v >> (32 - FLOG));
}
HYD float hy_bf2f(unsigned short b) { unsigned u = (unsigned)b << 16; float f; __builtin_memcpy(&f, &u, 4); return f; }
HYD unsigned hy_f2bf(float f) { unsigned u; __builtin_memcpy(&u, &f, 4); return (u + 0x7fffu + ((u >> 16) & 1u)) >> 16; }
template <class PR> HYD void hy_sconv2(PR rowj  , unsigned tid, int j, float w0, float w1, float w2, float b, float& u0, float& u1) {
    const unsigned d1 = rowj[tid];
    const unsigned d0r = (rowj - 1)[tid], d2r = (rowj + 1)[tid];
    const unsigned d0 = (j > 0 || tid > 0) ? d0r : 0u;
    const unsigned d2 = (j < 7 || tid < (unsigned)(FT - 1)) ? d2r : 0u;
    const float pm1 = hy_bf2f((unsigned short)(d0 >> 16)), p0 = hy_bf2f((unsigned short)(d1 & 0xffffu)), p1 = hy_bf2f((unsigned short)(d1 >> 16)), p2 = hy_bf2f((unsigned short)(d2 & 0xffffu));
    u0 = b + w0 * pm1 + w1 * p0 + w2 * p1;
    u1 = b + w0 * p0 + w1 * p1 + w2 * p2;
}
template <class P> HYD void hy_filter_step(P X, const unsigned short* taps, float delta, int tid) {
    typedef typename HyP2<P>::type P2;
    typedef unsigned u32x2h __attribute__((ext_vector_type(2)));
    u32x2h raw[SEQL / (4 * FT)][4];
    const float dscale = -delta * (1.4426950408889634f / (float)(SEQL - 1)); (void)dscale;
#pragma unroll
    for (int j = 0; j < SEQL / (4 * FT); ++j)
#pragma unroll
        for (int q = 0; q < 4; ++q) raw[j][q] = *(const u32x2h*)(taps + (size_t)q * 1024 * SEQL + ((unsigned)(4 * (tid + FT * j)) & 0x1fffu));
#pragma unroll
    for (int j = 0; j < SEQL / (4 * FT); ++j) {
        const int t = 4 * (tid + FT * j);
        cf2 a[4];
#pragma unroll
        for (int q = 0; q < 4; ++q) a[q] = cf2{hy_bf2f((unsigned short)(raw[j][q].x & 0xffffu)), hy_bf2f((unsigned short)(raw[j][q].x >> 16)), hy_bf2f((unsigned short)(raw[j][q].y & 0xffffu)), hy_bf2f((unsigned short)(raw[j][q].y >> 16))};
        cf2 dec;
#pragma unroll
#ifdef HY_DEVICE
        for (int e = 0; e < 4; ++e) dec[e] = __builtin_amdgcn_exp2f((float)(t + e) * dscale);
#else
        for (int e = 0; e < 4; ++e) dec[e] = expf(-((float)(t + e) * (1.0f / (float)(SEQL - 1))) * delta);
#endif
        const cf2 a0 = a[0] * dec, a1 = a[1] * dec, a2 = a[2] * dec, a3 = a[3] * dec;
        P2 Xf = (P2)(X + HP(t));
        if (t == 0) { Xf[0] = cf2{a0[0] + a1[0], a2[0] + a3[0], a0[1], a2[1]}; float z0 = 0.f; HY_OPAQUE(z0); X[HP(SEQL)] = cf{z0, z0}; }
        else Xf[0] = cf2{a0[0], a2[0], a0[1], a2[1]};
        Xf[1] = cf2{a0[2], a2[2], a0[3], a2[3]};
        const int pbk = HP(FN - t - 4);
        X[pbk + 1] = cf{a1[3], a3[3]}; X[pbk + 2] = cf{a1[2], a3[2]}; X[pbk + 3] = cf{a1[1], a3[1]};
        if (t > 0) X[HP(FN - t)] = cf{a1[0], a3[0]};
    }
}
template <class P> HYD void hy_sep_step(P X, cf* K1g, cf* K2g, int tid) {
    const float sc = 0.5f / (float)FN;
#pragma unroll 1
    for (int j0 = 0; j0 < FN / FT; j0 += 4) {
        cf a[4], b[4];
#pragma unroll
        for (int u = 0; u < 4; ++u) { const int p = tid + FT * (j0 + u);
            const int f = hy_brev14(p), q = hy_brev14((FN - f) & (FN - 1));
            a[u] = X[HP(p)]; b[u] = X[HP(q)]; }
#pragma unroll
        for (int u = 0; u < 4; ++u) { const int p = tid + FT * (j0 + u);
            const unsigned pi = (unsigned)p & 0x3fffu;
            K1g[pi] = cf{(a[u].x + b[u].x) * sc, (a[u].y - b[u].y) * sc};
            K2g[pi] = cf{(a[u].y + b[u].y) * sc, -(a[u].x - b[u].x) * sc}; }
    }
}
template <class P> HYD void hy_load_step(P X, const unsigned* r0, const unsigned* r1, float w0, float w1, float w2, float b, float (&zr)[8][4], int tid) {
    typedef typename HyP2<P>::type P2;
#pragma unroll
    for (int j = 0; j < 8; ++j) {
        const int t = 2 * (tid + FT * j);
        hy_sconv2(r0 + FT * j, (unsigned)tid, j, w0, w1, w2, b, zr[j][0], zr[j][2]);
        hy_sconv2(r1 + FT * j, (unsigned)tid, j, w0, w1, w2, b, zr[j][1], zr[j][3]);
        *(P2)(X + HP(t)) = cf2{zr[j][0], zr[j][1], zr[j][2], zr[j][3]};
    }
}
template <class P> HYD void hy_gate1_step(P X, const unsigned* r0, const unsigned* r1, float w0, float w1, float w2, float b, float bias, float (&zr)[8][4], int tid) {
    typedef typename HyP2<P>::type P2;
#pragma unroll
    for (int j = 0; j < 8; ++j) {
        const int t = 2 * (tid + FT * j);
        float xa0, xa1, xb0, xb1;
        hy_sconv2(r0 + FT * j, (unsigned)tid, j, w0, w1, w2, b, xa0, xa1);
        hy_sconv2(r1 + FT * j, (unsigned)tid, j, w0, w1, w2, b, xb0, xb1);
        P2 xp = (P2)(X + HP(t));
        const cf2 y = *xp;
        zr[j][0] = xa0 * (y.x + zr[j][0] * bias); zr[j][1] = xb0 * (y.y + zr[j][1] * bias);
        zr[j][2] = xa1 * (y.z + zr[j][2] * bias); zr[j][3] = xb1 * (y.w + zr[j][3] * bias);
        *xp = cf2{zr[j][0], zr[j][1], zr[j][2], zr[j][3]};
    }
}
template <class P> HYD void hy_gate2_step(P X, const unsigned* r0, const unsigned* r1, float w0, float w1, float w2, float b, float bias, const float (&zr)[8][4], unsigned* out0, unsigned* out1, int tid) {
    typedef typename HyP2<P>::type P2;
#pragma unroll
    for (int j = 0; j < 8; ++j) {
        const int t = 2 * (tid + FT * j);
        float xa0, xa1, xb0, xb1;
        hy_sconv2(r0 + FT * j, (unsigned)tid, j, w0, w1, w2, b, xa0, xa1);
        hy_sconv2(r1 + FT * j, (unsigned)tid, j, w0, w1, w2, b, xb0, xb1);
        const cf2 y = *(P2)(X + HP(t));
        const float za0 = xa0 * (y.x + zr[j][0] * bias), zb0 = xb0 * (y.y + zr[j][1] * bias);
        const float za1 = xa1 * (y.z + zr[j][2] * bias), zb1 = xb1 * (y.w + zr[j][3] * bias);
        (out0 + FT * j)[(unsigned)tid] = hy_f2bf(za0) | (hy_f2bf(za1) << 16);
        (out1 + FT * j)[(unsigned)tid] = hy_f2bf(zb0) | (hy_f2bf(zb1) << 16);
    }
}
HYD float hy_sconv1(unsigned D0, unsigned D1, int t, float w0, float w1, float w2, float b, bool pad0, bool padL) {
    const unsigned sh = ((unsigned)(t - 1) & 1u) << 4;
#ifdef HY_DEVICE
    const unsigned lo = __builtin_amdgcn_alignbit(D1, D0, sh), hi = D1 >> sh;
#else
    const unsigned long long w = (((unsigned long long)D1 << 32) | D0) >> sh; const unsigned lo = (unsigned)w, hi = (unsigned)(w >> 32);
#endif
    float e0 = hy_bf2f((unsigned short)(lo & 0xffffu)), e1 = hy_bf2f((unsigned short)(lo >> 16)), e2 = hy_bf2f((unsigned short)(hi & 0xffffu));
    if (pad0 && t == 0) e0 = 0.f;
    if (padL && t == SEQL - 1) e2 = 0.f;
    return b + w0 * e0 + w1 * e1 + w2 * e2;
}
struct HyRaw { unsigned d[2][8][4]; };
HYD void hy_raw_load(HyRaw& R, const unsigned* r0, const unsigned* r1, int tid) {
#pragma unroll
    for (int r = 0; r < 2; ++r)
#pragma unroll
        for (int k = 0; k < 8; ++k) { const unsigned du = ((unsigned)(tid + FT * r + 1024 * k + 1) >> 1) & 0x1fffu;
            R.d[r][k][0] = (r0 - 1)[du]; R.d[r][k][1] = r0[du]; R.d[r][k][2] = (r1 - 1)[du]; R.d[r][k][3] = r1[du]; }
}
template <class P, class PT> HYD void hy_convA_fwd(P X, PT thi, PT tlo, int tid, const HyRaw& R, float w0, float w1, float w2, float b, cf (&zr)[2][8]) {
#pragma unroll
    for (int r = 0; r < 2; ++r) {
        const int i0 = tid + FT * r, pb = HP(i0);
        cf e[16];
#pragma unroll
        for (int k = 0; k < 8; ++k) { const int t = i0 + 1024 * k; const bool p0 = (r == 0 && k == 0), pL = (r == 1 && k == 7); e[k] = cf{hy_sconv1(R.d[r][k][0], R.d[r][k][1], t, w0, w1, w2, b, p0, pL), hy_sconv1(R.d[r][k][2], R.d[r][k][3], t, w0, w1, w2, b, p0, pL)}; zr[r][k] = e[k]; }
#pragma unroll
        for (int k = 8; k < 16; ++k) e[k] = cf{0.f, 0.f};
        hy_bfly16<false, true, false>(e, hy_twid(thi, tlo, i0));
#pragma unroll
        for (int k = 0; k < 16; ++k) X[pb + k * 1088] = e[k];
    }
}
template <bool LAST, class P, class PT> HYD void hy_gateA(P X, PT thi, PT tlo, int tid, const HyRaw& R, float w0, float w1, float w2, float b, float bias,
                                                           cf (&zr)[2][8], unsigned short* out0, unsigned short* out1) {
#pragma unroll
    for (int r = 0; r < 2; ++r) {
        const int i0 = tid + FT * r, pb = HP(i0);
        cf e[16];
#pragma unroll
        for (int k = 0; k < 16; ++k) e[k] = X[pb + k * 1088];
        const cf tw = hy_twid(thi, tlo, i0);
        hy_bfly16<true, false, true>(e, tw);
#pragma unroll
        for (int k = 0; k < 8; ++k) { const int t = i0 + 1024 * k;
            const bool p0 = (r == 0 && k == 0), pL = (r == 1 && k == 7);
            const float xa = hy_sconv1(R.d[r][k][0], R.d[r][k][1], t, w0, w1, w2, b, p0, pL), xb = hy_sconv1(R.d[r][k][2], R.d[r][k][3], t, w0, w1, w2, b, p0, pL);
            const cf z = cf{xa * (e[k].x + zr[r][k].x * bias), xb * (e[k].y + zr[r][k].y * bias)};
            if (LAST) {
#ifdef HY_DEVICE
                unsigned pk; asm("v_cvt_pk_bf16_f32 %0, %1, %2" : "=v"(pk) : "v"(z.x), "v"(z.y)); const unsigned ti = (unsigned)t & 0x1fffu; out0[ti] = (unsigned short)(pk & 0xffffu); out1[ti] = (unsigned short)(pk >> 16);
#else
                out0[t] = (unsigned short)hy_f2bf(z.x); out1[t] = (unsigned short)hy_f2bf(z.y);
#endif
            }
            else { zr[r][k] = z; e[k] = z; } }
        if (!LAST) {
#pragma unroll
            for (int k = 8; k < 16; ++k) e[k] = cf{0.f, 0.f};
            hy_bfly16<false, true, false>(e, tw);
#pragma unroll
            for (int k = 0; k < 16; ++k) X[pb + k * 1088] = e[k];
        }
    }
}
constexpr int NWAVES = 8, NTHR = NWAVES * 64;
constexpr int DM = 2048, SEQ = 8192, DEPTH = 4, NSEQ = 6, GSEQ = 2, NGRP = NSEQ / GSEQ, MG = GSEQ * SEQ;
constexpr int HYW = 1024, HYIN = 3072, QKVW = 3072, DFF = 5632, GU = 2 * DFF, FEMB = 33, FHID = 64;
constexpr float EPS = 1e-6f;
constexpr float QSCALE = 0.125f * 1.4426950408889634f;
constexpr size_t MiB = 1u << 20;
constexpr size_t WS_CTL = 0, CTL_ZERO_BYTES = 1 * MiB;
constexpr size_t SZ_WHY = (size_t)HYIN * DM * 2, SZ_WQKV = (size_t)QKVW * DM * 2, SZ_WOUT = (size_t)DM * DM * 2, SZ_WGU = (size_t)GU * DM * 2, SZ_WDN = (size_t)DM * DFF * 2;
constexpr size_t OFF_WHY = 0, OFF_WQKV = OFF_WHY + SZ_WHY, OFF_WOUT = OFF_WQKV + SZ_WQKV, OFF_WGU = OFF_WOUT + SZ_WOUT, OFF_WDN = OFF_WGU + SZ_WGU, SZ_WLAYER = OFF_WDN + SZ_WDN;
constexpr size_t WS_W = 1 * MiB;
constexpr size_t WS_ROPE = WS_W + DEPTH * SZ_WLAYER;
constexpr int KPAD = 256;
constexpr size_t WS_H3 = WS_ROPE + (size_t)SEQ * 32 * 8;
constexpr size_t WS_W4T = WS_H3 + (size_t)DEPTH * SEQ * KPAD * 2;
constexpr size_t WS_TAPS = WS_W4T + (size_t)DEPTH * 4096 * KPAD * 2;
constexpr size_t WS_FFTK = WS_TAPS + (size_t)4096 * SEQ * 2;
constexpr size_t WS_STASH = WS_FFTK + (size_t)256 * 2 * 16384 * 8;
constexpr size_t WS_XB = WS_STASH;
constexpr size_t WS_H = WS_XB + (size_t)MG * DM * 2;
constexpr size_t WS_ZT = WS_H + (size_t)MG * DM * 2;
constexpr size_t WS_PROJT = WS_ZT + (size_t)HYW * MG * 2;
constexpr size_t WS_QKV = WS_PROJT + (size_t)HYIN * MG * 2;
constexpr size_t WS_MIX = WS_PROJT;
constexpr size_t WS_FFH = WS_PROJT;
constexpr size_t WS_MIXIN = WS_QKV + (size_t)MG * QKVW * 2;
constexpr size_t WS_END = WS_MIXIN + (size_t)MG * DM * 2;
constexpr size_t SZ_TAPS = (size_t)4096 * SEQ * 2, WS_TAPS_X = WS_END, WS_END_X = WS_TAPS_X + (DEPTH - 1) * SZ_TAPS;
static_assert((size_t)MG * DFF * 2 <= (size_t)HYIN * MG * 2 + (size_t)MG * QKVW * 2, "FFH overlay fits PROJT|QKV");
static_assert(WS_W4T % 256 == 0 && WS_TAPS % 256 == 0 && WS_ROPE % 256 == 0 && WS_H3 % 256 == 0 && WS_FFTK % 256 == 0 && WS_XB % 256 == 0 && WS_H % 256 == 0 && SZ_WLAYER % 256 == 0, "alignment");
constexpr int CW_BAR = 4096;
constexpr int PH_PER_LAYER = 8, PH_PER_GROUP = 1 + DEPTH * PH_PER_LAYER, NPHASE = 1 + NGRP * PH_PER_GROUP;
constexpr int RING_OFF = 0, RING_BYTES = 131072;
constexpr int TAB_OFF = 139264;
constexpr int MISC_OFF = TAB_OFF + 4096;
constexpr int LDS_BYTES = 147456;
static_assert(MISC_OFF + 128 <= LDS_BYTES, "LDS map");
static_assert(att::SHM_ATTN_ALL <= MISC_OFF, "attention LDS fits below the control words");
#ifndef PROBE_DUP
#define PROBE_DUP 0
#endif
#ifndef MK_PER_PHASE
#define MK_PER_PHASE 0
#endif

struct Args { const float* in[30]; float* out; unsigned char* ws; int ph_lo, ph_hi, taps_all, pad; };
enum { I_XP = 0, I_XS, I_GMPRE, I_GMPOST, I_GFPRE, I_GFPOST, I_WIN, I_CONVW, I_CONVB, I_FW1, I_FB1, I_FF1, I_FW2, I_FB2, I_FF2, I_FW3, I_FB3, I_FF3, I_FW4,
       I_HBIAS, I_HNORM, I_LQ1, I_LK1, I_LQ2, I_LK2, I_SUBLN, I_WOUT, I_WGATE, I_WUP, I_WDOWN };

template <int K> __device__ __forceinline__ float swz_xor(float v) { return __builtin_bit_cast(float, __builtin_amdgcn_ds_swizzle(__builtin_bit_cast(int, v), (K << 10) | 0x1f)); }
__device__ __forceinline__ float wave_sum(float v) {
    v += swz_xor<1>(v); v += swz_xor<2>(v); v += swz_xor<4>(v); v += swz_xor<8>(v); v += swz_xor<16>(v);
    auto rr = __builtin_amdgcn_permlane32_swap(__float_as_uint(v), __float_as_uint(v), false, false);
    return __uint_as_float(rr[0]) + __uint_as_float(rr[1]);
}
__device__ __forceinline__ bf16* wt_dst_row(int kind, int n, bf16* d0, bf16* d1, int K) {
    if (kind == 0) return d0 + (size_t)n * K;
    if (kind == 1) { if (n < HYIN) return d0 + (size_t)n * K; int q = n - HYIN; if (q < 2048) { const int hb = q & ~63, i = q & 63; q = hb + (i < 32 ? 2 * i : 2 * (i - 32) + 1); } return d1 + (size_t)q * K; }
    if (kind == 4) return d0 + (size_t)n * KPAD;
    const int r = (n >> 7) * 256 + (n & 127) + (kind == 3 ? 128 : 0); return d0 + (size_t)r * K;
}
__device__ __forceinline__ void p0_transpose_item(const float* W, int K, int N, int kind, bf16* d0, bf16* d1, LAS float* scr, int item, int lane) {
    const int nblk = N / 32, kb = item / nblk, nb = item % nblk, k0 = 64 * kb, n0 = 32 * nb;
#pragma unroll 8
    for (int i = 0; i < 32; ++i) { const int kk = 2 * i + (lane >> 5); scr[kk * 33 + (lane & 31)] = W[(size_t)(k0 + kk) * N + n0 + (lane & 31)]; }
    LDS_WAIT(); asm volatile("" ::: "memory");
    const int c = lane & 7;
#pragma unroll
    for (int j = 0; j < 4; ++j) { const int n = (lane >> 3) + 8 * j; const LAS float* s = scr + (8 * c) * 33 + n;
        v4u o; o.x = pk2(s[0 * 33], s[1 * 33]); o.y = pk2(s[2 * 33], s[3 * 33]); o.z = pk2(s[4 * 33], s[5 * 33]); o.w = pk2(s[6 * 33], s[7 * 33]);
        *(GAS v4u*)(wt_dst_row(kind, n0 + n, d0, d1, K) + k0 + 8 * c) = o; }
    LDS_WAIT(); asm volatile("" ::: "memory");
}
__device__ __forceinline__ void sincos_red(double ang, float& s, float& c) {
    const double k = rint(ang * 0.15915494309189535); const float r = (float)(ang - k * 6.283185307179586);
    s = sinf(r); c = cosf(r);
}
#define GP(p) ((const float*)(const GAS float*)(p))
#define LAUNDER_TID(F) do { int t_ = (F).tid; asm volatile("" : "+v"(t_)); (F).tid = t_; (F).lane = t_ & 63; int z_ = 0; asm volatile("" : "+s"(z_)); (F).z = z_; unsigned long long w_ = (unsigned long long)(F).ws0; asm volatile("" : "+s"(w_)); (F).ws = (unsigned char*)(GAS unsigned char*)w_; int b_ = (F).bx0, v_ = (F).vcu0, g_ = (F).G0; asm volatile("" : "+s"(b_), "+s"(v_), "+s"(g_)); (F).bx = b_; (F).vcu = v_; (F).G = g_; } while (0)
struct Frame {
    LAS unsigned char* lds; volatile LAS unsigned* MISC; gu32* ctl;
    int tid, lane, wave, vcu, G, bx;
    int vcu0, G0, bx0;
    float* out; unsigned char* ws; unsigned char* ws0; int z;
};
__device__ __forceinline__ void p0_prologue(Frame& F, const Args& A) {
    LAS float* scr = (LAS float*)(F.lds + RING_OFF + F.wave * 16384);
    const int gw = F.vcu * NWAVES + F.wave, NGW = F.G * NWAVES;
    constexpr int I_IN = (DM / 64) * ((HYIN + QKVW) / 32), I_OUT = (DM / 64) * (DM / 32), I_G = (DM / 64) * (DFF / 32), I_D = (DFF / 64) * (DM / 32);
    constexpr int I_W4 = 4096 / 32;
    constexpr int PER_L = I_IN + I_OUT + 2 * I_G + I_D + I_W4;
    for (int it = gw; it < DEPTH * PER_L; it += NGW) {
        const int l = it / PER_L; int r = it % PER_L;
        unsigned char* wl = F.ws + WS_W + (size_t)l * SZ_WLAYER;
        if (r < I_IN) { p0_transpose_item(GP(A.in[I_WIN + F.z]) + (size_t)l * DM * (HYIN + QKVW), DM, HYIN + QKVW, 1, (bf16*)(wl + OFF_WHY), (bf16*)(wl + OFF_WQKV), scr, r, F.lane); continue; } r -= I_IN;
        if (r < I_OUT) { p0_transpose_item(GP(A.in[I_WOUT + F.z]) + (size_t)l * DM * DM, DM, DM, 0, (bf16*)(wl + OFF_WOUT), nullptr, scr, r, F.lane); continue; } r -= I_OUT;
        if (r < I_G) { p0_transpose_item(GP(A.in[I_WGATE + F.z]) + (size_t)l * DM * DFF, DM, DFF, 2, (bf16*)(wl + OFF_WGU), nullptr, scr, r, F.lane); continue; } r -= I_G;
        if (r < I_G) { p0_transpose_item(GP(A.in[I_WUP + F.z]) + (size_t)l * DM * DFF, DM, DFF, 3, (bf16*)(wl + OFF_WGU), nullptr, scr, r, F.lane); continue; } r -= I_G;
        if (r < I_D) { p0_transpose_item(GP(A.in[I_WDOWN + F.z]) + (size_t)l * DFF * DM, DFF, DM, 0, (bf16*)(wl + OFF_WDN), nullptr, scr, r, F.lane); continue; } r -= I_D;
        { bf16* w4t = (bf16*)(F.ws + WS_W4T) + (size_t)l * 4096 * KPAD;
          p0_transpose_item(GP(A.in[I_FW4 + F.z]) + (size_t)l * FHID * 4096, FHID, 4096, 4, w4t, nullptr, scr, r, F.lane);
          for (int e = F.lane; e < 32 * 24; e += 64) *(GAS v4u*)(w4t + (size_t)(32 * r + e / 24) * KPAD + 64 + 8 * (e % 24)) = (v4u){0u, 0u, 0u, 0u}; }
    }
    {
        float* cs = (float*)(F.ws + WS_ROPE);
        for (int e = F.vcu * NTHR + F.tid; e < SEQ * 32; e += F.G * NTHR) {
            const int t = e >> 5, p = e & 31;
            const double inv = exp(-9.210340371976184 * (double)(2 * p) / 64.0);
            float s, c; sincos_red((double)t * inv, s, c);
            cs[2 * e] = c; cs[2 * e + 1] = s;
        }
    }
    {
        bf16* h3b = (bf16*)(F.ws + WS_H3);
        LAS float* hb = (LAS float*)(F.lds + RING_OFF + F.wave * 16384);
        for (int task = gw; task < DEPTH * (SEQ / 64); task += NGW) {
            const int l = task / (SEQ / 64), t = (task % (SEQ / 64)) * 64 + F.lane;
            const float* w1 = GP(A.in[I_FW1 + F.z]) + (size_t)l * FEMB * FHID; const float* w2 = GP(A.in[I_FW2 + F.z]) + (size_t)l * FHID * FHID; const float* w3 = GP(A.in[I_FW3 + F.z]) + (size_t)l * FHID * FHID;
            hb[F.lane] = (float)t * (1.0f / (float)(SEQ - 1));
#pragma unroll 1
            for (int bi = 0; bi < 16; ++bi) { const double band = 1e-4 + (double)bi * ((15.0 - 1e-4) / 15.0);
                float s, c; sincos_red(6.283185307179586 * (double)t / (double)SEQ * band, s, c); hb[(1 + bi) * 64 + F.lane] = c; hb[(17 + bi) * 64 + F.lane] = -s; }
#pragma unroll 1
            for (int stage = 0; stage < 3; ++stage) {
                const float* w = stage == 0 ? w1 : (stage == 1 ? w2 : w3);
                const float* bb = (stage == 0 ? GP(A.in[I_FB1 + F.z]) : (stage == 1 ? GP(A.in[I_FB2 + F.z]) : GP(A.in[I_FB3 + F.z]))) + l * FHID;
                const float* ff = (stage == 0 ? GP(A.in[I_FF1 + F.z]) : (stage == 1 ? GP(A.in[I_FF2 + F.z]) : GP(A.in[I_FF3 + F.z]))) + l * FHID;
                const int nin = stage == 0 ? FEMB : FHID;
                typedef float f32x16_t __attribute__((ext_vector_type(16)));
                f32x16_t c0 = {}, c1 = {}, c2 = {}, c3 = {};
                LDS_WAIT();
#pragma unroll 1
                for (int i = 0; i < nin; ++i) { const float hv = hb[i * 64 + F.lane]; const f32x16_t* wr = (const f32x16_t*)(w + i * FHID);
                    c0 += wr[0] * hv; c1 += wr[1] * hv; c2 += wr[2] * hv; c3 += wr[3] * hv; }
                const f32x16_t* b16 = (const f32x16_t*)bb; const f32x16_t* f16 = (const f32x16_t*)ff;
                c0 = (c0 + b16[0]) * f16[0]; c1 = (c1 + b16[1]) * f16[1]; c2 = (c2 + b16[2]) * f16[2]; c3 = (c3 + b16[3]) * f16[3];
                if (stage < 2) {
#pragma unroll
                    for (int e = 0; e < 16; ++e) { hb[e * 64 + F.lane] = sinf(c0[e]); hb[(16 + e) * 64 + F.lane] = sinf(c1[e]); hb[(32 + e) * 64 + F.lane] = sinf(c2[e]); hb[(48 + e) * 64 + F.lane] = sinf(c3[e]); }
                } else {
                    GAS v4u* o = (GAS v4u*)(h3b + ((size_t)l * SEQ + t) * KPAD);
#pragma unroll
                    for (int q = 0; q < 2; ++q) { v4u w; w.x = pk2(sinf(c0[8 * q]), sinf(c0[8 * q + 1])); w.y = pk2(sinf(c0[8 * q + 2]), sinf(c0[8 * q + 3])); w.z = pk2(sinf(c0[8 * q + 4]), sinf(c0[8 * q + 5])); w.w = pk2(sinf(c0[8 * q + 6]), sinf(c0[8 * q + 7])); o[q] = w; }
#pragma unroll
                    for (int q = 0; q < 2; ++q) { v4u w; w.x = pk2(sinf(c1[8 * q]), sinf(c1[8 * q + 1])); w.y = pk2(sinf(c1[8 * q + 2]), sinf(c1[8 * q + 3])); w.z = pk2(sinf(c1[8 * q + 4]), sinf(c1[8 * q + 5])); w.w = pk2(sinf(c1[8 * q + 6]), sinf(c1[8 * q + 7])); o[2 + q] = w; }
#pragma unroll
                    for (int q = 0; q < 2; ++q) { v4u w; w.x = pk2(sinf(c2[8 * q]), sinf(c2[8 * q + 1])); w.y = pk2(sinf(c2[8 * q + 2]), sinf(c2[8 * q + 3])); w.z = pk2(sinf(c2[8 * q + 4]), sinf(c2[8 * q + 5])); w.w = pk2(sinf(c2[8 * q + 6]), sinf(c2[8 * q + 7])); o[4 + q] = w; }
#pragma unroll
                    for (int q = 0; q < 2; ++q) { v4u w; w.x = pk2(sinf(c3[8 * q]), sinf(c3[8 * q + 1])); w.y = pk2(sinf(c3[8 * q + 2]), sinf(c3[8 * q + 3])); w.z = pk2(sinf(c3[8 * q + 4]), sinf(c3[8 * q + 5])); w.w = pk2(sinf(c3[8 * q + 6]), sinf(c3[8 * q + 7])); o[6 + q] = w; }
#pragma unroll 1
                    for (int q = 8; q < 32; ++q) o[q] = (v4u){0u, 0u, 0u, 0u};
                }
            }
        }
    }
}
template <bool XSB>
__device__ __forceinline__ void norm_pass(Frame& F, const void* x_src, const bf16* add, const float* g_add, bf16* xb_dst, float* xf_dst, const float* g_out, bf16* h_dst) {
    const int gw = F.vcu * NWAVES + F.wave, NGW = F.G * NWAVES;
#define UNPK(q, lo, hi) do { lo = (f32x4){__uint_as_float((q).x << 16), __uint_as_float((q).x & 0xffff0000u), __uint_as_float((q).y << 16), __uint_as_float((q).y & 0xffff0000u)}; \
                             hi = (f32x4){__uint_as_float((q).z << 16), __uint_as_float((q).z & 0xffff0000u), __uint_as_float((q).w << 16), __uint_as_float((q).w & 0xffff0000u)}; } while (0)
#define PK8(lo, hi) (v4u){pk2((lo)[0], (lo)[1]), pk2((lo)[2], (lo)[3]), pk2((hi)[0], (hi)[1]), pk2((hi)[2], (hi)[3])}
    for (int m0 = gw; m0 < MG; m0 += 2 * NGW) {
        const int m1 = m0 + NGW; const bool two = m1 < MG; const int mb = two ? m1 : m0;
        f32x4 va[8], vb[8];
        if (XSB) {
            const GAS v4u* xa = (const GAS v4u*)((const bf16*)x_src + (size_t)m0 * DM) + F.lane; const GAS v4u* xb = (const GAS v4u*)((const bf16*)x_src + (size_t)mb * DM) + F.lane;
            v4u qa[4], qb[4];
#pragma unroll
            for (int j = 0; j < 4; ++j) { qa[j] = xa[64 * j]; qb[j] = xb[64 * j]; }
#pragma unroll
            for (int j = 0; j < 4; ++j) { UNPK(qa[j], va[2 * j], va[2 * j + 1]); UNPK(qb[j], vb[2 * j], vb[2 * j + 1]); }
        } else {
            const GAS f32x4* xa = (const GAS f32x4*)((const float*)x_src + (size_t)m0 * DM) + 2 * F.lane; const GAS f32x4* xb = (const GAS f32x4*)((const float*)x_src + (size_t)mb * DM) + 2 * F.lane;
#pragma unroll
            for (int j = 0; j < 4; ++j) { va[2 * j] = xa[128 * j]; va[2 * j + 1] = xa[128 * j + 1]; vb[2 * j] = xb[128 * j]; vb[2 * j + 1] = xb[128 * j + 1]; }
        }
        if (add) {
            const GAS v4u* aa = (const GAS v4u*)(add + (size_t)m0 * DM) + F.lane; const GAS v4u* ab = (const GAS v4u*)(add + (size_t)mb * DM) + F.lane;
            v4u wa[4], wb[4];
#pragma unroll
            for (int j = 0; j < 4; ++j) { wa[j] = aa[64 * j]; wb[j] = ab[64 * j]; }
            float sa = 0.f, sb = 0.f;
#pragma unroll
            for (int j = 0; j < 4; ++j) { f32x4 a0, a1, b0, b1; UNPK(wa[j], a0, a1); UNPK(wb[j], b0, b1);
                sa += ((a0[0] * a0[0] + a0[1] * a0[1]) + (a0[2] * a0[2] + a0[3] * a0[3])) + ((a1[0] * a1[0] + a1[1] * a1[1]) + (a1[2] * a1[2] + a1[3] * a1[3]));
                sb += ((b0[0] * b0[0] + b0[1] * b0[1]) + (b0[2] * b0[2] + b0[3] * b0[3])) + ((b1[0] * b1[0] + b1[1] * b1[1]) + (b1[2] * b1[2] + b1[3] * b1[3])); }
            const float ra = 1.0f / sqrtf(wave_sum(sa) * (1.0f / DM) + EPS), rb = 1.0f / sqrtf(wave_sum(sb) * (1.0f / DM) + EPS);
            const GAS f32x4* gr = (const GAS f32x4*)g_add + 2 * F.lane;
#pragma unroll
            for (int j = 0; j < 4; ++j) { const f32x4 g0 = gr[128 * j], g1 = gr[128 * j + 1]; f32x4 a0, a1, b0, b1; UNPK(wa[j], a0, a1); UNPK(wb[j], b0, b1);
                va[2 * j] = va[2 * j] + a0 * ra * g0; va[2 * j + 1] = va[2 * j + 1] + a1 * ra * g1; vb[2 * j] = vb[2 * j] + b0 * rb * g0; vb[2 * j + 1] = vb[2 * j + 1] + b1 * rb * g1; }
        }
        if (xf_dst) { GAS f32x4* oa = (GAS f32x4*)(xf_dst + (size_t)m0 * DM) + 2 * F.lane; GAS f32x4* ob = (GAS f32x4*)(xf_dst + (size_t)mb * DM) + 2 * F.lane;
#pragma unroll
            for (int j = 0; j < 4; ++j) { oa[128 * j] = va[2 * j]; oa[128 * j + 1] = va[2 * j + 1]; if (two) { ob[128 * j] = vb[2 * j]; ob[128 * j + 1] = vb[2 * j + 1]; } } }
        if (xb_dst) { GAS v4u* oa = (GAS v4u*)(xb_dst + (size_t)m0 * DM) + F.lane; GAS v4u* ob = (GAS v4u*)(xb_dst + (size_t)mb * DM) + F.lane;
#pragma unroll
            for (int j = 0; j < 4; ++j) { const v4u w = PK8(va[2 * j], va[2 * j + 1]); oa[64 * j] = w;
                UNPK(w, va[2 * j], va[2 * j + 1]);
                const v4u w2 = PK8(vb[2 * j], vb[2 * j + 1]); if (two) ob[64 * j] = w2;
                UNPK(w2, vb[2 * j], vb[2 * j + 1]); } }
        if (h_dst) {
            float sa = 0.f, sb = 0.f;
#pragma unroll
            for (int j = 0; j < 8; ++j) { sa += (va[j][0] * va[j][0] + va[j][1] * va[j][1]) + (va[j][2] * va[j][2] + va[j][3] * va[j][3]); sb += (vb[j][0] * vb[j][0] + vb[j][1] * vb[j][1]) + (vb[j][2] * vb[j][2] + vb[j][3] * vb[j][3]); }
            const float ra = 1.0f / sqrtf(wave_sum(sa) * (1.0f / DM) + EPS), rb = 1.0f / sqrtf(wave_sum(sb) * (1.0f / DM) + EPS);
            const GAS f32x4* gr = (const GAS f32x4*)g_out + 2 * F.lane;
            GAS v4u* ha = (GAS v4u*)(h_dst + (size_t)m0 * DM) + F.lane; GAS v4u* hb2 = (GAS v4u*)(h_dst + (size_t)mb * DM) + F.lane;
#pragma unroll
            for (int j = 0; j < 4; ++j) { const f32x4 g0 = gr[128 * j], g1 = gr[128 * j + 1];
                const f32x4 oa0 = va[2 * j] * ra * g0, oa1 = va[2 * j + 1] * ra * g1, ob0 = vb[2 * j] * rb * g0, ob1 = vb[2 * j + 1] * rb * g1;
                ha[64 * j] = PK8(oa0, oa1);
                if (two) hb2[64 * j] = PK8(ob0, ob1); }
        }
    }
#undef UNPK
#undef PK8
}
typedef LAS cf* lcf;
template <bool ZUP> __device__ __forceinline__ void hy_fwd(lcf X, lcf thi, lcf tlo, int tid, const cf* KM) {
    if (ZUP) hy_pass16<1024, false, true, false>(X, thi, tlo, tid); else hy_pass16<1024, false, false, false>(X, thi, tlo, tid);
    __syncthreads();
    hy_pass16<64, false, false, false>(X, thi, tlo, tid);
    hy_pass16<4, false, false, false>(X, thi, tlo, tid);
    hy_pass4<false>(X, tid, KM); __syncthreads();
}
__device__ __forceinline__ void hy_inv(lcf X, lcf thi, lcf tlo, int tid) {
    const cf* nul = nullptr;
    hy_pass4<true>(X, tid, nul); __syncthreads();
    hy_pass16<4, true, false, false>(X, thi, tlo, tid); __syncthreads();
    hy_pass16<64, true, false, false>(X, thi, tlo, tid); __syncthreads();
    hy_pass16<1024, true, false, true>(X, thi, tlo, tid); __syncthreads();
}
__device__ __forceinline__ void hy_mid(lcf X, lcf thi, lcf tlo, int tid, const cf* KM) {
    const cf* nul = nullptr;
    hy_pass16<64, false, false, false>(X, thi, tlo, tid);
    hy_pass16<4, false, false, false>(X, thi, tlo, tid);
    hy_pass4<false>(X, tid, KM);
    hy_pass4<true>(X, tid, nul);
    hy_pass16<4, true, false, false>(X, thi, tlo, tid);
    hy_pass16<64, true, false, false>(X, thi, tlo, tid); __syncthreads();
}
__device__ __forceinline__ void hyena_phase(Frame& F, const Args& A, int l) {
    lcf X = (lcf)(F.lds + RING_OFF); lcf thi = (lcf)(F.lds + TAB_OFF); lcf tlo = thi + 128;
    const int tid = F.tid;
    if (tid < 256) { const int a = tid & 127; const double ang = -6.283185307179586 * (double)(tid < 128 ? 128 * a : a) / (double)FN; float s, c; sincos_red(ang, s, c); (tid < 128 ? thi : tlo)[a] = cf{c, s}; }
    cf* K1g = (cf*)(F.ws + WS_FFTK) + (size_t)F.bx * 2 * FN; cf* K2g = K1g + FN;
    const bf16* taps = (const bf16*)(F.ws + ((A.taps_all && l > 0) ? WS_TAPS_X + (size_t)(l - 1) * SZ_TAPS : WS_TAPS));
    const float* cw = GP(A.in[I_CONVW + F.z]) + (size_t)l * 3 * HYIN; const float* cb = GP(A.in[I_CONVB + F.z]) + (size_t)l * HYIN; const float* hb = GP(A.in[I_HBIAS + F.z]) + (size_t)l * 2 * HYW;
    const bf16* projT = (const bf16*)(F.ws + WS_PROJT); bf16* zT = (bf16*)(F.ws + WS_ZT);
    for (int c = F.vcu; c < HYW; c += F.G) {
        __syncthreads();
        const float delta = fabsf(-15.350567286626973f + (float)c * ((-3.0701134573253945f + 15.350567286626973f) / 1023.0f));
#define TIDX(v) int v = tid; asm volatile("" : "+v"(v))
        { TIDX(t_); hy_filter_step(X, taps + (size_t)c * SEQ, delta, t_); }
        const unsigned* rx1 = (const unsigned*)(projT + (size_t)c * MG); const unsigned* rx2 = (const unsigned*)(projT + (size_t)(HYW + c) * MG); const unsigned* rv = (const unsigned*)(projT + (size_t)(2 * HYW + c) * MG);
        HyRaw R;
        { TIDX(t_); hy_raw_load(R, rv, rv + SEQ / 2, t_); }
        __syncthreads();
        { TIDX(t_); hy_fwd<false>(X, thi, tlo, t_, nullptr); }
        { TIDX(t_); hy_sep_step(X, K1g, K2g, t_); }
        asm volatile("s_waitcnt vmcnt(0)" ::: "memory"); __syncthreads();
        cf zr[2][8];
        { TIDX(t_); hy_convA_fwd(X, thi, tlo, t_, R, cw[2 * HYW + c], cw[HYIN + 2 * HYW + c], cw[2 * HYIN + 2 * HYW + c], cb[2 * HYW + c], zr); }
        { TIDX(t_); hy_raw_load(R, rx1, rx1 + SEQ / 2, t_); }
        __syncthreads();
        { TIDX(t_); hy_mid(X, thi, tlo, t_, K1g); }
        { TIDX(t_); hy_gateA<false>(X, thi, tlo, t_, R, cw[c], cw[HYIN + c], cw[2 * HYIN + c], cb[c], hb[c], zr, (unsigned short*)nullptr, (unsigned short*)nullptr); }
        { TIDX(t_); hy_raw_load(R, rx2, rx2 + SEQ / 2, t_); }
        __syncthreads();
        { TIDX(t_); hy_mid(X, thi, tlo, t_, K2g); }
        unsigned short* zo = (unsigned short*)(zT + (size_t)c * MG);
        { TIDX(t_); hy_gateA<true>(X, thi, tlo, t_, R, cw[HYW + c], cw[HYIN + HYW + c], cw[2 * HYIN + HYW + c], cb[HYW + c], hb[HYW + c], zr, zo, zo + SEQ); }
#undef TIDX
    }
    __syncthreads();
}
__device__ __forceinline__ void hynorm_phase(Frame& F, const Args& A, int l) {
    constexpr int TB = 64;
    LAS unsigned char* tile = F.lds + RING_OFF; LAS float* red = (LAS float*)(F.lds + RING_OFF + TB * HYW * 2); LAS float* rinv = red + 8 * TB;
    const bf16* zT = (const bf16*)(F.ws + WS_ZT); bf16* mixin = (bf16*)(F.ws + WS_MIXIN); const float* gn = GP(A.in[I_HNORM + F.z]) + (size_t)l * HYW;
    const int tid = F.tid;
    for (int tb = F.vcu; tb < MG / TB; tb += F.G) {
        const int t0 = tb * TB; __syncthreads();
        float ps[8];
#pragma unroll
        for (int i = 0; i < 8; ++i) ps[i] = 0.f;
        const int k = tid & 7, crow = tid >> 3;
#pragma unroll
        for (int hb = 0; hb < 2; ++hb) {
            v4u w[8];
#pragma unroll
            for (int it = 0; it < 8; ++it) { const unsigned c = (unsigned)((hb * 8 + it) * 64 + crow) & 1023u; w[it] = *(const GAS v4u*)(zT + (size_t)c * MG + (unsigned)(t0 + 8 * k)); }
#pragma unroll
            for (int it = 0; it < 8; ++it) { const int c = (hb * 8 + it) * 64 + crow;
                LAS unsigned short* d = (LAS unsigned short*)(tile + (8 * k) * 2048 + (((c >> 3) ^ k) << 4) + (c & 7) * 2);
                const unsigned ww[4] = {w[it].x, w[it].y, w[it].z, w[it].w};
#pragma unroll
                for (int i = 0; i < 4; ++i) { d[(2 * i) * 1024] = (unsigned short)(ww[i] & 0xffffu); d[(2 * i + 1) * 1024] = (unsigned short)(ww[i] >> 16);
                    const float a = __uint_as_float(ww[i] << 16), b = __uint_as_float(ww[i] & 0xffff0000u); ps[2 * i] += a * a; ps[2 * i + 1] += b * b; } }
        }
#pragma unroll
        for (int i = 0; i < 8; ++i) { float v = ps[i]; v += swz_xor<8>(v); v += swz_xor<16>(v);
            auto rr = __builtin_amdgcn_permlane32_swap(__float_as_uint(v), __float_as_uint(v), false, false); ps[i] = __uint_as_float(rr[0]) + __uint_as_float(rr[1]); }
        if ((F.lane >> 3) == 0) {
#pragma unroll
            for (int i = 0; i < 8; ++i) red[F.wave * TB + 8 * k + i] = ps[i]; }
        __syncthreads();
        if (tid < TB) { float s = 0.f;
#pragma unroll
            for (int w8 = 0; w8 < 8; ++w8) s += red[w8 * TB + tid];
            rinv[tid] = 1.0f / sqrtf(s * (1.0f / HYW) + EPS); }
        __syncthreads();
        const int cg = tid & 127;
        const f32x4 g0 = *(const f32x4*)(gn + 8 * cg), g1 = *(const f32x4*)(gn + 8 * cg + 4);
#pragma unroll 4
        for (int it = 0; it < 16; ++it) { const int tok = it * 4 + (tid >> 7); const float r = rinv[tok];
            const v4u q = *(const LAS v4u*)(tile + tok * 2048 + ((cg ^ (tok >> 3)) << 4));
            v4u o; o.x = pk2(__uint_as_float(q.x << 16) * r * g0[0], __uint_as_float(q.x & 0xffff0000u) * r * g0[1]); o.y = pk2(__uint_as_float(q.y << 16) * r * g0[2], __uint_as_float(q.y & 0xffff0000u) * r * g0[3]);
            o.z = pk2(__uint_as_float(q.z << 16) * r * g1[0], __uint_as_float(q.z & 0xffff0000u) * r * g1[1]); o.w = pk2(__uint_as_float(q.w << 16) * r * g1[2], __uint_as_float(q.w & 0xffff0000u) * r * g1[3]);
            *(GAS v4u*)(mixin + (size_t)(t0 + tok) * DM + 8 * cg) = o; }
    }
    __syncthreads();
}
__device__ __forceinline__ void attn_phase(Frame& F, const Args& A, int l, unsigned char* lds_generic) {
    const float li = 0.8f - 0.6f * expf(-0.3f * (float)l);
    float lam;
    { const int j = F.lane; const float a = GP(A.in[I_LQ1 + F.z])[l * 64 + j] * GP(A.in[I_LK1 + F.z])[l * 64 + j], b = GP(A.in[I_LQ2 + F.z])[l * 64 + j] * GP(A.in[I_LK2 + F.z])[l * 64 + j];
      lam = expf(wave_sum(a)) - expf(wave_sum(b)) + li; }
    const att::bf16* qkv = (const att::bf16*)(F.ws + WS_QKV); att::bf16* mixin = (att::bf16*)(F.ws + WS_MIXIN);
    float* stash = (float*)(F.ws + WS_H) + (size_t)F.bx * 64 * 512;
    const float* subln = GP(A.in[I_SUBLN + F.z]) + (size_t)l * 128;
    constexpr int NU = GSEQ * 8 * (SEQ / 256);
    for (int u = F.vcu; u < NU; u += F.G) {
        const int bvh = u >> 5, qb = u & 31, b = bvh >> 3, vh = bvh & 7;
        const long krow0 = (long)b * SEQ, qrow0 = krow0 + qb * 256;
        att::attn_unit(qkv, qrow0, krow0, vh, SEQ, lam, 1.0f - li, subln, mixin + (size_t)qrow0 * DM + HYW + vh * 128, DM, stash, (char*)lds_generic);
        __syncthreads();
    }
}
#ifndef PHMASK
#define PHMASK 511
#endif
__global__ void __launch_bounds__(NTHR, 2) hymba_fwd(Args args) {
    extern __shared__ __attribute__((aligned(16))) unsigned char lds[];
    Frame F;
    F.lds = (LAS unsigned char*)lds; F.MISC = (volatile LAS unsigned*)(F.lds + MISC_OFF);
    F.tid = threadIdx.x; F.lane = F.tid & 63; F.wave = __builtin_amdgcn_readfirstlane(F.tid >> 6);
    F.G = gridDim.x; { const int bx = blockIdx.x; F.vcu = (F.G % 8 == 0) ? (bx % 8) * (F.G / 8) + bx / 8 : bx; F.bx = bx; }
    F.vcu0 = F.vcu; F.G0 = F.G; F.bx0 = F.bx;
    F.ctl = (gu32*)(args.ws + WS_CTL); F.out = args.out; F.ws = args.ws; F.ws0 = args.ws; F.z = 0;
    for (int u = F.tid; u < (LDS_BYTES - MISC_OFF) / 4; u += NTHR) ((LAS unsigned*)(F.lds + MISC_OFF))[u] = 0u;
    __syncthreads();
    XcdBarrier bar; bar.bar = (unsigned*)(F.ctl + CW_BAR); bar.x = 0; bar.st = nullptr;
    if (!MK_PER_PHASE) bar = xcd_barrier_post((unsigned*)(F.ctl + CW_BAR), F.MISC + 8);
    const int lo = args.ph_lo, hi = args.ph_hi;
    int ph = 0;
#define IN_() (lo <= ph && ph < hi && ({ LAUNDER_TID(F); true; }))
#define DUP3(...) do { __VA_ARGS__; if (PROBE_DUP == 3) { __VA_ARGS__; } } while (0)
#define SEAM() do { if (!MK_PER_PHASE && lo <= ph && ph + 1 < hi) { XcdBarrier b_ = bar; { unsigned long long p_ = (unsigned long long)b_.bar; unsigned x_ = b_.x; asm volatile("" : "+s"(p_), "+s"(x_)); b_.bar = (unsigned*)(GAS unsigned*)p_; b_.x = x_; } \
        xcd_barrier(b_); if (PROBE_DUP == 7) xcd_barrier(b_); } ++ph; } while (0)
    if ((PHMASK & 1) && IN_()) { p0_prologue(F, args); if (PROBE_DUP == 4) p0_prologue(F, args); }
    SEAM();
#define Hb ((bf16*)(F.ws + WS_H))
#define XB ((bf16*)(F.ws + WS_XB))
#define projT ((bf16*)(F.ws + WS_PROJT))
#define qkv ((bf16*)(F.ws + WS_QKV))
#define mix ((bf16*)(F.ws + WS_MIX))
#define ffh ((bf16*)(F.ws + WS_FFH))
#define mixin ((bf16*)(F.ws + WS_MIXIN))
#define wl (F.ws + WS_W + (size_t)l * SZ_WLAYER)
#define xin ((g == 0) ? GP(args.in[I_XP + F.z]) : GP(args.in[I_XS + F.z]) + (size_t)(g - 1) * MG * DM)
#define xres ((float*)(GAS float*)args.out + (size_t)g * MG * DM)
    for (int g = 0; g < NGRP; ++g) {
        if ((PHMASK & 2) && IN_()) norm_pass<false>(F, xin, nullptr, nullptr, nullptr, nullptr, GP(args.in[I_GMPRE + F.z]), Hb);
        SEAM();
        for (int l = 0; l < DEPTH; ++l) {
            if ((PHMASK & 4) && IN_()) {
                { pg8::Gemm gm{(const bf16*)(wl + OFF_WHY), Hb, HYIN, MG, DM}; pg8::StaticOrder S; S.init(HYIN, MG, F.G, F.bx);
                  pg8::EpiPlain E{projT, MG};
                  DUP3(pg8::gemm_phase<pg8::EpiPlain, pg8::StaticOrder, true, true>(F.lds + RING_OFF, gm, S, E)); }
                if (g == 0 || !args.taps_all) { pg8::Gemm gm{(const bf16*)(F.ws + WS_W4T) + (size_t)l * 4096 * KPAD, (const bf16*)(F.ws + WS_H3) + (size_t)l * SEQ * KPAD, 4096, SEQ, KPAD}; pg8::StaticOrder S; S.init(4096, SEQ, F.G, F.bx);
                  pg8::EpiPlain E{(bf16*)(F.ws + ((args.taps_all && l > 0) ? WS_TAPS_X + (size_t)(l - 1) * SZ_TAPS : WS_TAPS)), SEQ};
                  DUP3(pg8::gemm_phase<pg8::EpiPlain, pg8::StaticOrder, true, true>(F.lds + RING_OFF, gm, S, E)); }
                { pg8::Gemm gm{Hb, (const bf16*)(wl + OFF_WQKV), MG, QKVW, DM}; pg8::StaticOrder S; S.init(MG, QKVW, F.G, F.bx);
                  pg8::EpiRope E{qkv, QKVW, (const float*)(F.ws + WS_ROPE), QSCALE};
                  DUP3(pg8::gemm_phase<pg8::EpiRope, pg8::StaticOrder, true, true>(F.lds + RING_OFF, gm, S, E)); }
            }
            SEAM();
            if (IN_()) { if (PHMASK & 8) hyena_phase(F, args, l); if (PROBE_DUP == 2) hyena_phase(F, args, l); if (PHMASK & 16) attn_phase(F, args, l, lds); if (PROBE_DUP == 1) attn_phase(F, args, l, lds); }
            SEAM();
            if ((PHMASK & 32) && IN_()) { hynorm_phase(F, args, l); if (PROBE_DUP == 4) hynorm_phase(F, args, l); }
            SEAM();
            if ((PHMASK & 64) && IN_()) { pg8::Gemm gm{mixin, (const bf16*)(wl + OFF_WOUT), MG, DM, DM}; pg8::StaticOrder S; S.init(MG, DM, F.G, F.bx);
                pg8::EpiPlain E{mix, DM};
                DUP3(pg8::gemm_phase<pg8::EpiPlain, pg8::StaticOrder, true, true>(F.lds + RING_OFF, gm, S, E)); }
            SEAM();
            if ((PHMASK & 2) && IN_()) { if (l == 0) norm_pass<false>(F, xin, mix, GP(args.in[I_GMPOST + F.z]) + (size_t)l * DM, XB, nullptr, GP(args.in[I_GFPRE + F.z]) + (size_t)l * DM, Hb);
                else norm_pass<true>(F, XB, mix, GP(args.in[I_GMPOST + F.z]) + (size_t)l * DM, XB, nullptr, GP(args.in[I_GFPRE + F.z]) + (size_t)l * DM, Hb); }
            SEAM();
            if ((PHMASK & 128) && IN_()) { pg8::Gemm gm{Hb, (const bf16*)(wl + OFF_WGU), MG, GU, DM}; pg8::StaticOrder S; S.init(MG, GU, F.G, F.bx);
                pg8::EpiSwiGLU E{ffh, DFF};
                DUP3(pg8::gemm_phase<pg8::EpiSwiGLU, pg8::StaticOrder, true, true>(F.lds + RING_OFF, gm, S, E)); }
            SEAM();
            if ((PHMASK & 256) && IN_()) { pg8::Gemm gm{ffh, (const bf16*)(wl + OFF_WDN), MG, DM, DFF}; pg8::StaticOrder S; S.init(MG, DM, F.G, F.bx);
                pg8::EpiPlain E{mixin, DM};
                DUP3(pg8::gemm_phase<pg8::EpiPlain, pg8::StaticOrder, true, true>(F.lds + RING_OFF, gm, S, E)); }
            SEAM();
            if ((PHMASK & 2) && IN_()) { if (l + 1 < DEPTH) norm_pass<true>(F, XB, mixin, GP(args.in[I_GFPOST + F.z]) + (size_t)l * DM, XB, nullptr, GP(args.in[I_GMPRE + F.z]) + (size_t)(l + 1) * DM, Hb);
                else norm_pass<true>(F, XB, mixin, GP(args.in[I_GFPOST + F.z]) + (size_t)l * DM, nullptr, xres, nullptr, nullptr); }
            SEAM();
        }
    }
#undef IN_
#undef SEAM
#undef Hb
#undef XB
#undef projT
#undef qkv
#undef mix
#undef ffh
#undef mixin
#undef wl
#undef xin
#undef xres
}

extern "C" void kernel_launch(void* const* d_in, const int* in_sizes, int n_in, void* d_out, int out_size, void* d_ws, size_t ws_size, hipStream_t stream) {
    static int grid = 0;
    if (grid == 0) {
        if (n_in != 30 || in_sizes[0] != 2 * SEQ * DM || in_sizes[1] != 4 * SEQ * DM || out_size != NSEQ * SEQ * DM || ws_size < WS_END) {
            fprintf(stderr, "kernel_launch: shape mismatch (n_in %d, out %d, ws %zu, need %zu)\n", n_in, out_size, ws_size, (size_t)WS_END); grid = -1; return; }
        int dev = 0, cus = 0;
        if (hipGetDevice(&dev) != hipSuccess || hipDeviceGetAttribute(&cus, hipDeviceAttributeMultiprocessorCount, dev) != hipSuccess) { grid = -1; return; }
        if (hipFuncSetAttribute((const void*)hymba_fwd, hipFuncAttributeMaxDynamicSharedMemorySize, LDS_BYTES) != hipSuccess) { fprintf(stderr, "kernel_launch: hipFuncSetAttribute failed\n"); grid = -1; return; }
        int per_cu = 0;
        if (hipOccupancyMaxActiveBlocksPerMultiprocessor(&per_cu, (const void*)hymba_fwd, NTHR, LDS_BYTES) != hipSuccess || per_cu < 1) fprintf(stderr, "kernel_launch: occupancy query says %d\n", per_cu);
        (void)hipGetLastError();
        grid = cus;
    }
    if (grid < 0) return;
    if (hipMemsetAsync((char*)d_ws + WS_CTL, 0, CTL_ZERO_BYTES, stream) != hipSuccess) return;
    Args a{};
    for (int i = 0; i < 30; ++i) a.in[i] = (const float*)d_in[i];
    a.out = (float*)d_out; a.ws = (unsigned char*)d_ws; a.taps_all = (ws_size >= WS_END_X) ? 1 : 0;
#if MK_PER_PHASE
    for (int p = 0; p < NPHASE; ++p) { a.ph_lo = p; a.ph_hi = p + 1; hipLaunchKernelGGL(hymba_fwd, dim3(grid), dim3(NTHR), LDS_BYTES, stream, a); }
#else
    a.ph_lo = 0; a.ph_hi = NPHASE;
    hipLaunchKernelGGL(hymba_fwd, dim3(grid), dim3(NTHR), LDS_BYTES, stream, a);
#endif
    const hipError_t le = hipPeekAtLastError();
    if (le != hipSuccess) fprintf(stderr, "kernel_launch: launch failed: %s\n", hipGetErrorName(le));
}
```

```cpp
#include <hip/hip_runtime.h>
#include <hip/hip_bf16.h>
#include <cstdio>
#include <cstdint>
#include <cmath>
namespace pg8 {
#define PG8_LAS __attribute__((address_space(3)))
typedef unsigned short bf16_t;
typedef short bf16x8 __attribute__((ext_vector_type(8)));
typedef float f32x4 __attribute__((ext_vector_type(4)));
typedef unsigned u32x4 __attribute__((ext_vector_type(4)));
constexpr int BM = 256, BK = 64, HALF = 128, HTB = HALF * BK * 2  , STAGE_BYTES = 8 * HTB, NXCD = 8, WGM = 8;

__host__ __device__ __forceinline__ int lds_byte(int r, int c) { const int st = (r >> 4) * 2 + (c >> 5), rr = r & 15, cc = c & 31, ob = rr * 64 + cc * 2; return st * 1024 + (ob ^ (((ob >> 9) & 1) << 5)); }
__host__ __device__ __forceinline__ void stage_rc(int b, int& R, int& C) { const int st = b / 1024, sb = b % 1024, swz = sb ^ (((sb >> 9) & 1) << 5); R = (st >> 1) * 16 + swz / 64; C = (st & 1) * 32 + (swz % 64) / 2; }
__host__ __device__ __forceinline__ int perm32(int rho) { const int n = rho >> 4, i = rho & 15; return 8 * (i >> 2) + 4 * n + (i & 3); }

struct Unit { int pm, pn; };
struct Gemm { const bf16_t* A; const bf16_t* Bt; int M, N, K; };

struct StaticOrder {
    int nM, nN, nwg, G, c;
    __host__ __device__ void init(int M, int N, int G_, int c_) { nM = M / BM; nN = N / BM; nwg = nM * nN; G = G_; c = c_; }
    __host__ __device__ bool next(int i, Unit& u) const {
        const long L = (long)i * G + c; if (L >= nwg) return false;
        int wgid = (int)L; { const int q = nwg / NXCD, r = nwg % NXCD, xcd = wgid % NXCD, off = wgid / NXCD; wgid = (xcd < r ? xcd * (q + 1) : r * (q + 1) + (xcd - r) * q) + off; }
        const int nig = WGM * nN, gid = wgid / nig, fm = gid * WGM, gsz = (nM - fm) < WGM ? (nM - fm) : WGM;
        u.pm = fm + ((wgid % nig) % gsz); u.pn = (wgid % nig) / gsz; return true;
    }
    __device__ __forceinline__ void a_ready(const Unit&) const {}
    __device__ __forceinline__ void done(const Unit&) const {}
};

__device__ __forceinline__ unsigned cvt_pk_bf16(float lo, float hi) { unsigned r; asm volatile("v_cvt_pk_bf16_f32 %0, %1, %2" : "=v"(r) : "v"(lo), "v"(hi)); return r; }
typedef float f32x2 __attribute__((ext_vector_type(2)));
struct EpiPlain {
    static constexpr bool PERM = true, AFTER_DRAIN = false;
    bf16_t* O; int ldc;
    __device__ __forceinline__ void operator()(const f32x4 (&acc)[2][2][4][2], const Unit& u, int wr, int wc, int fr, int fq) const {
        const int row0 = u.pm * BM + wr * 64 + fr, col0 = u.pn * BM + wc * 32 + 8 * fq;
#pragma unroll
        for (int ai = 0; ai < 2; ++ai)
#pragma unroll
            for (int m = 0; m < 4; ++m) { bf16_t* rowp = O + (size_t)(row0 + ai * HALF + m * 16) * ldc + col0;
#pragma unroll
                for (int bj = 0; bj < 2; ++bj) { const f32x4 v0 = acc[ai][bj][m][0], v1 = acc[ai][bj][m][1];
                    u32x4 w; w.x = cvt_pk_bf16(v0[0], v0[1]); w.y = cvt_pk_bf16(v0[2], v0[3]); w.z = cvt_pk_bf16(v1[0], v1[1]); w.w = cvt_pk_bf16(v1[2], v1[3]);
                    *(u32x4*)(rowp + bj * HALF) = w; } }
    }
};
struct EpiRope {
    static constexpr bool PERM = true, AFTER_DRAIN = false;
    bf16_t* O; int ldc; const float* cs; float qscale;
    __device__ __forceinline__ void operator()(const f32x4 (&acc)[2][2][4][2], const Unit& u, int wr, int wc, int fr, int fq) const {
        const int row0 = u.pm * BM + wr * 64 + fr, col0 = u.pn * BM + wc * 32 + 8 * fq;
        const bool rope = u.pn < 8; const float sc = u.pn < 4 ? qscale : 1.0f;
        const int p0 = 16 * (wc & 1) + 4 * fq;
#pragma unroll
        for (int ai = 0; ai < 2; ++ai)
#pragma unroll
            for (int m = 0; m < 4; ++m) { const int row = row0 + ai * HALF + m * 16; bf16_t* rowp = O + (size_t)row * ldc + col0;
                f32x4 t0 = {1.f, 0.f, 1.f, 0.f}, t1 = {1.f, 0.f, 1.f, 0.f};
                if (rope) { const float* tp = cs + ((size_t)(row & 8191) * 32 + p0) * 2; t0 = *(const f32x4*)tp; t1 = *(const f32x4*)(tp + 4); }
#pragma unroll
                for (int bj = 0; bj < 2; ++bj) { const f32x4 v0 = acc[ai][bj][m][0], v1 = acc[ai][bj][m][1];
                    f32x4 o0, o1;
                    o0[0] = (v0[0] * t0[0] - v0[1] * t0[1]) * sc; o0[1] = (v0[0] * t0[1] + v0[1] * t0[0]) * sc;
                    o0[2] = (v0[2] * t0[2] - v0[3] * t0[3]) * sc; o0[3] = (v0[2] * t0[3] + v0[3] * t0[2]) * sc;
                    o1[0] = (v1[0] * t1[0] - v1[1] * t1[1]) * sc; o1[1] = (v1[0] * t1[1] + v1[1] * t1[0]) * sc;
                    o1[2] = (v1[2] * t1[2] - v1[3] * t1[3]) * sc; o1[3] = (v1[2] * t1[3] + v1[3] * t1[2]) * sc;
                    u32x4 w; w.x = cvt_pk_bf16(o0[0], o0[1]); w.y = cvt_pk_bf16(o0[2], o0[3]); w.z = cvt_pk_bf16(o1[0], o1[1]); w.w = cvt_pk_bf16(o1[2], o1[3]);
                    *(u32x4*)(rowp + bj * HALF) = w; } }
    }
};
struct EpiSwiGLU {
    static constexpr bool PERM = true, AFTER_DRAIN = false;
    bf16_t* O; int ldc;
    static __device__ __forceinline__ float silu_mul(float g, float u) { return g * u * __builtin_amdgcn_rcpf(1.0f + __builtin_amdgcn_exp2f(-1.4426950408889634f * g)); }
    __device__ __forceinline__ void operator()(const f32x4 (&acc)[2][2][4][2], const Unit& u, int wr, int wc, int fr, int fq) const {
        const int row0 = u.pm * BM + wr * 64 + fr, col0 = u.pn * HALF + wc * 32 + 8 * fq;
#pragma unroll
        for (int ai = 0; ai < 2; ++ai)
#pragma unroll
            for (int m = 0; m < 4; ++m) { bf16_t* rowp = O + (size_t)(row0 + ai * HALF + m * 16) * ldc + col0;
                const f32x4 g0 = acc[ai][0][m][0], g1 = acc[ai][0][m][1], u0 = acc[ai][1][m][0], u1 = acc[ai][1][m][1];
                u32x4 w; w.x = cvt_pk_bf16(silu_mul(g0[0], u0[0]), silu_mul(g0[1], u0[1])); w.y = cvt_pk_bf16(silu_mul(g0[2], u0[2]), silu_mul(g0[3], u0[3]));
                w.z = cvt_pk_bf16(silu_mul(g1[0], u1[0]), silu_mul(g1[1], u1[1])); w.w = cvt_pk_bf16(silu_mul(g1[2], u1[2]), silu_mul(g1[3], u1[3]));
                *(u32x4*)rowp = w; }
    }
};
template <class Epi, class Sched, bool ALIGN_EPI = false, bool SP2 = false>
__device__ __forceinline__ void gemm_phase(PG8_LAS unsigned char* lds, const Gemm g, const Sched& S, const Epi& E) {
    int tid = threadIdx.x; asm volatile("" : "+v"(tid));
    const int wid = __builtin_amdgcn_readfirstlane(tid >> 6), lane = tid & 63, wr = wid >> 2, wc = wid & 3, fr = lane & 15, fq = lane >> 4;
    const int K = g.K, nt = K / BK;
    unsigned voffA[2], voffB[2];
#pragma unroll
    for (int i = 0; i < 2; ++i) { int R, C; stage_rc(tid * 16 + i * 8192, R, C); const int Rb = Epi::PERM ? ((R & ~31) + perm32(R & 31)) : R;
        voffA[i] = (unsigned)(R * K + C) * 2u; voffB[i] = (unsigned)(Rb * K + C) * 2u; }
    const size_t kstep = (size_t)(BK * 2);
    const size_t hstep = (size_t)HALF * K * 2;
    const size_t tstep = 2 * hstep;
    const unsigned ldsw = (unsigned)wid * 1024u;
    const int aoff = lds_byte(wr * 64 + fr, fq * 8), boff = lds_byte(wc * 32 + fr, fq * 8);
#define PG8_SA(b, h) (((b) * 2 + (h)) * HTB)
#define PG8_SB(b, h) ((4 + (b) * 2 + (h)) * HTB)
#define PG8_STAGE(bufoff, gbase, voff) do { _Pragma("unroll") for (int _i = 0; _i < 2; ++_i) \
        __builtin_amdgcn_global_load_lds((const unsigned*)((const char*)(gbase) + (voff)[_i]), (PG8_LAS unsigned*)(lds + (bufoff) + ldsw + _i * 8192), 16, 0, 0); } while (0)
#define PG8_LDA(dst, b, h) do { _Pragma("unroll") for (int m = 0; m < 4; ++m) _Pragma("unroll") for (int k = 0; k < 2; ++k) dst[m][k] = *(const PG8_LAS bf16x8*)(lds + PG8_SA(b, h) + aoff + m * 2048 + k * 1024); } while (0)
#define PG8_LDB(dst, b, h) do { _Pragma("unroll") for (int n = 0; n < 2; ++n) _Pragma("unroll") for (int k = 0; k < 2; ++k) dst[n][k] = *(const PG8_LAS bf16x8*)(lds + PG8_SB(b, h) + boff + n * 2048 + k * 1024); } while (0)
#define PG8_MMA(ai, bj, At, Bt) do { __builtin_amdgcn_s_setprio(1); _Pragma("unroll") for (int m = 0; m < 4; ++m) _Pragma("unroll") for (int n = 0; n < 2; ++n) _Pragma("unroll") for (int k = 0; k < 2; ++k) \
        acc[ai][bj][m][n] = __builtin_amdgcn_mfma_f32_16x16x32_bf16(Bt[n][k], At[m][k], acc[ai][bj][m][n], 0, 0, 0); __builtin_amdgcn_s_setprio(0); } while (0)
#define PG8_WAIT_V(n) asm volatile("s_waitcnt vmcnt(" #n ")" ::: "memory")
#define PG8_WAIT_L(n) asm volatile("s_waitcnt lgkmcnt(" #n ")" ::: "memory")
#define PG8_BAR __builtin_amdgcn_s_barrier()
#define PG8_SCHED __builtin_amdgcn_sched_barrier(0)
    Unit cur, nxt; int ui = 0;
    if (!S.next(0, cur)) return;
    f32x4 acc[2][2][4][2];
#pragma unroll
    for (int a = 0; a < 2; ++a)
#pragma unroll
        for (int b = 0; b < 2; ++b)
#pragma unroll
            for (int m = 0; m < 4; ++m)
#pragma unroll
                for (int n = 0; n < 2; ++n) acc[a][b][m][n] = (f32x4){0.f, 0.f, 0.f, 0.f};
    bf16x8 At[4][2], B0[2][2], B1[2][2];
    const char* cA = (const char*)g.A + (size_t)cur.pm * tstep; const char* cB = (const char*)g.Bt + (size_t)cur.pn * tstep;
    S.a_ready(cur);
    if constexpr (SP2) {
        PG8_STAGE(PG8_SB(0, 0), cB, voffB); PG8_STAGE(PG8_SB(0, 1), cB + hstep, voffB); PG8_STAGE(PG8_SA(0, 0), cA, voffA); PG8_STAGE(PG8_SA(0, 1), cA + hstep, voffA);
        if (wr == 1) PG8_BAR;
        PG8_WAIT_V(2); PG8_BAR;
        PG8_STAGE(PG8_SB(1, 0), cB + kstep, voffB); PG8_STAGE(PG8_SA(1, 0), cA + kstep, voffA); PG8_STAGE(PG8_SB(1, 1), cB + hstep + kstep, voffB);
        PG8_WAIT_V(6); PG8_BAR;
    } else {
        PG8_STAGE(PG8_SB(0, 0), cB, voffB); PG8_STAGE(PG8_SA(0, 0), cA, voffA); PG8_STAGE(PG8_SB(0, 1), cB + hstep, voffB); PG8_STAGE(PG8_SA(0, 1), cA + hstep, voffA);
        if (wr == 1) PG8_BAR;
        PG8_WAIT_V(4); PG8_BAR;
        PG8_STAGE(PG8_SB(1, 0), cB + kstep, voffB); PG8_STAGE(PG8_SA(1, 0), cA + kstep, voffA); PG8_STAGE(PG8_SB(1, 1), cB + hstep + kstep, voffB);
        PG8_WAIT_V(6); PG8_BAR;
    }
    for (;;) {
        const bool has_next = S.next(ui + 1, nxt);
        const char* nA = has_next ? (const char*)g.A + (size_t)nxt.pm * tstep : cA; const char* nB = has_next ? (const char*)g.Bt + (size_t)nxt.pn * tstep : cB;
        for (int t = 0; t < nt; t += 2) {
            const bool last = (t == nt - 2);
            const char* a1 = cA + (size_t)(t + 1) * kstep;
            const char* a2 = last ? nA : cA + (size_t)(t + 2) * kstep; const char* b2 = last ? nB : cB + (size_t)(t + 2) * kstep;
            const char* a3 = a2 + kstep; const char* b3 = b2 + kstep;
            if (last && has_next) S.a_ready(nxt);
            if constexpr (SP2) {
            PG8_LDB(B0, 0, 0); PG8_LDB(B1, 0, 1); PG8_SCHED; PG8_LDA(At, 0, 0); PG8_STAGE(PG8_SA(1, 1), a1 + hstep, voffA);
            PG8_WAIT_V(8); PG8_WAIT_L(0); PG8_BAR; PG8_MMA(0, 0, At, B0); PG8_MMA(0, 1, At, B1); PG8_BAR; PG8_SCHED;
            PG8_LDA(At, 0, 1); PG8_STAGE(PG8_SB(0, 0), b2, voffB); PG8_STAGE(PG8_SB(0, 1), b2 + hstep, voffB); PG8_STAGE(PG8_SA(0, 0), a2, voffA);
            PG8_WAIT_V(8); PG8_WAIT_L(0); PG8_BAR; PG8_MMA(1, 0, At, B0); PG8_MMA(1, 1, At, B1); PG8_BAR; PG8_SCHED;
            PG8_LDB(B0, 1, 0); PG8_LDB(B1, 1, 1); PG8_SCHED; PG8_LDA(At, 1, 0); PG8_STAGE(PG8_SA(0, 1), a2 + hstep, voffA);
            PG8_WAIT_V(8); PG8_WAIT_L(0); PG8_BAR; PG8_MMA(0, 0, At, B0); PG8_MMA(0, 1, At, B1); PG8_BAR; PG8_SCHED;
            PG8_LDA(At, 1, 1); PG8_STAGE(PG8_SB(1, 0), b3, voffB); PG8_STAGE(PG8_SB(1, 1), b3 + hstep, voffB); PG8_STAGE(PG8_SA(1, 0), a3, voffA);
            PG8_WAIT_V(8); PG8_WAIT_L(0); PG8_BAR; PG8_MMA(1, 0, At, B0); PG8_MMA(1, 1, At, B1); PG8_BAR; PG8_SCHED;
            } else {
            PG8_LDB(B0, 0, 0); PG8_SCHED; PG8_LDA(At, 0, 0); PG8_STAGE(PG8_SA(1, 1), a1 + hstep, voffA);
            PG8_WAIT_L(8); PG8_BAR; PG8_WAIT_L(0); PG8_MMA(0, 0, At, B0); PG8_BAR; PG8_SCHED;
            PG8_LDB(B1, 0, 1); PG8_STAGE(PG8_SB(0, 0), b2, voffB);
            PG8_BAR; PG8_WAIT_L(0); PG8_MMA(0, 1, At, B1); PG8_BAR;
            PG8_LDA(At, 0, 1); PG8_STAGE(PG8_SA(0, 0), a2, voffA);
            PG8_BAR; PG8_WAIT_L(0); PG8_MMA(1, 0, At, B0); PG8_BAR; PG8_SCHED;
            PG8_STAGE(PG8_SB(0, 1), b2 + hstep, voffB);
            PG8_WAIT_V(6); PG8_BAR; PG8_MMA(1, 1, At, B1); PG8_BAR;
            PG8_LDB(B0, 1, 0); PG8_SCHED; PG8_LDA(At, 1, 0); PG8_STAGE(PG8_SA(0, 1), a2 + hstep, voffA);
            PG8_WAIT_L(8); PG8_BAR; PG8_WAIT_L(0); PG8_MMA(0, 0, At, B0); PG8_BAR; PG8_SCHED;
            PG8_LDB(B1, 1, 1); PG8_STAGE(PG8_SB(1, 0), b3, voffB);
            PG8_BAR; PG8_WAIT_L(0); PG8_MMA(0, 1, At, B1); PG8_BAR;
            PG8_LDA(At, 1, 1); PG8_STAGE(PG8_SA(1, 0), a3, voffA);
            PG8_BAR; PG8_WAIT_L(0); PG8_MMA(1, 0, At, B0); PG8_BAR; PG8_SCHED;
            PG8_STAGE(PG8_SB(1, 1), b3 + hstep, voffB);
            PG8_WAIT_V(6); PG8_BAR; PG8_MMA(1, 1, At, B1); PG8_BAR;
            }
        }
        if constexpr (ALIGN_EPI) { if (wr == 0) PG8_BAR; }
        if constexpr (!Epi::AFTER_DRAIN) { E(acc, cur, wr, wc, fr, fq); S.done(cur); }
        if (!has_next) break;
#pragma unroll
        for (int a = 0; a < 2; ++a)
#pragma unroll
            for (int b = 0; b < 2; ++b)
#pragma unroll
                for (int m = 0; m < 4; ++m)
#pragma unroll
                    for (int n = 0; n < 2; ++n) acc[a][b][m][n] = (f32x4){0.f, 0.f, 0.f, 0.f};
        cur = nxt; cA = nA; cB = nB; ++ui;
        if constexpr (ALIGN_EPI) { if (wr == 1) PG8_BAR; }
    }
    PG8_WAIT_V(0);
    if constexpr (!ALIGN_EPI) { if (wr == 0) PG8_BAR; }
    PG8_BAR;
    if constexpr (Epi::AFTER_DRAIN) { E.fused(acc, cur, wr, wc, fr, fq, lds, wid, lane); S.done(cur); }
#undef PG8_SA
#undef PG8_SB
#undef PG8_STAGE
#undef PG8_LDA
#undef PG8_LDB
#undef PG8_MMA
#undef PG8_WAIT_V
#undef PG8_WAIT_L
#undef PG8_BAR
#undef PG8_SCHED
}
}
namespace att {
using bf16x8 = __attribute__((ext_vector_type(8))) short;
using s16x4  = __attribute__((ext_vector_type(4))) short;
using f32x16 = __attribute__((ext_vector_type(16))) float;
using u32x4  = __attribute__((ext_vector_type(4))) unsigned;
typedef unsigned short bf16;
constexpr int DQ = 64, DV = 128, NW = 8, QBLK = 32, KVBLK = 64, LDR = 3072;
constexpr int SHM_V = KVBLK * DV * 2, SHM_K = KVBLK * DQ * 2, SHM_ATTN = 3 * SHM_V + 3 * SHM_K + NW * 64 * 4 + 64;
constexpr int SHM_ATTN_ALL = SHM_ATTN + NW * QBLK * DV * 2;
#ifndef ATT_OVF_LIMIT
#define ATT_OVF_LIMIT 1.152921504606847e18f
#endif
#ifndef ATT_SDEPTH
#define ATT_SDEPTH 2
#endif
constexpr float THR2 = 11.0f;
#define KSWZ64(row, colB) ((row) * 128 + ((colB) ^ ((((row) >> 1) & 7) << 4)))
#define SBAR() __builtin_amdgcn_sched_barrier(0)
template <int K> __device__ __forceinline__ float sx(float v) { return __builtin_bit_cast(float, __builtin_amdgcn_ds_swizzle(__builtin_bit_cast(int, v), (K << 10) | 0x1f)); }
__device__ __forceinline__ int crow(int r, int hi) { return (r & 3) + 8 * (r >> 2) + 4 * hi; }
__device__ __forceinline__ unsigned cvtpk(float lo, float hi) { unsigned r; asm volatile("v_cvt_pk_bf16_f32 %0, %1, %2" : "=v"(r) : "v"(lo), "v"(hi)); return r; }
__device__ __forceinline__ void partialSM(f32x16& p0, f32x16& p1, float& m_reg, float& mn, float& alpha) {
  float pmax = p0[0];
#pragma unroll
  for (int r = 1; r < 16; ++r) pmax = fmaxf(pmax, p0[r]);
#pragma unroll
  for (int r = 0; r < 16; ++r) pmax = fmaxf(pmax, p1[r]);
  { auto rr = __builtin_amdgcn_permlane32_swap(__float_as_uint(pmax), __float_as_uint(pmax), false, false);
    pmax = fmaxf(__uint_as_float(rr[0]), __uint_as_float(rr[1])); }
  if (__builtin_expect(__all(pmax - m_reg <= THR2), 1)) { mn = m_reg; alpha = 1.f; }
  else { mn = fmaxf(m_reg, pmax); alpha = __builtin_amdgcn_exp2f(m_reg - mn); m_reg = mn; }
#pragma unroll
  for (int r = 0; r < 16; ++r) p0[r] = p0[r] - mn;
#pragma unroll
  for (int r = 0; r < 16; ++r) p1[r] = p1[r] - mn;
#pragma unroll
  for (int r = 0; r < 16; ++r) p0[r] = __builtin_amdgcn_exp2f(p0[r]);
}
__device__ __forceinline__ void finishSM(f32x16& p0, f32x16& p1, float alpha, float& l_reg, bf16x8& pa0, bf16x8& pa1, bf16x8& pa2, bf16x8& pa3) {
#pragma unroll
  for (int r = 0; r < 16; ++r) p1[r] = __builtin_amdgcn_exp2f(p1[r]);
  float ps = 0;
#pragma unroll
  for (int r = 0; r < 16; ++r) ps += p0[r];
#pragma unroll
  for (int r = 0; r < 16; ++r) ps += p1[r];
  { auto rr = __builtin_amdgcn_permlane32_swap(__float_as_uint(ps), __float_as_uint(ps), false, false);
    ps = __uint_as_float(rr[0]) + __uint_as_float(rr[1]); }
  l_reg = l_reg * alpha + ps;
#define PK4(P, BASE, OUT) do { unsigned a0 = cvtpk(P[BASE + 0], P[BASE + 1]), a1 = cvtpk(P[BASE + 2], P[BASE + 3]);   \
    unsigned b0 = cvtpk(P[BASE + 4], P[BASE + 5]), b1 = cvtpk(P[BASE + 6], P[BASE + 7]);                              \
    auto r0 = __builtin_amdgcn_permlane32_swap(a0, b0, false, false); auto r1 = __builtin_amdgcn_permlane32_swap(a1, b1, false, false); \
    u32x4 w = {r0[0], r1[0], r0[1], r1[1]}; OUT = *reinterpret_cast<bf16x8*>(&w); } while (0)
  PK4(p0, 0, pa0); PK4(p0, 8, pa1); PK4(p1, 0, pa2); PK4(p1, 8, pa3);
#undef PK4
}
__device__ __forceinline__ void qkt(f32x16& p0, f32x16& p1, const char* Ks, const bf16x8* qr, int r32, int hi) {
  p0 = f32x16{}; p1 = f32x16{};
#pragma unroll
  for (int d0 = 0; d0 < 4; ++d0) { const int cb = (d0 * 16 + hi * 8) * 2;
    bf16x8 b0 = *reinterpret_cast<const bf16x8*>(Ks + KSWZ64(r32, cb));
    bf16x8 b1 = *reinterpret_cast<const bf16x8*>(Ks + KSWZ64(32 + r32, cb));
    p0 = __builtin_amdgcn_mfma_f32_32x32x16_bf16(b0, qr[d0], p0, 0, 0, 0);
    p1 = __builtin_amdgcn_mfma_f32_32x32x16_bf16(b1, qr[d0], p1, 0, 0, 0); }
}
__device__ __forceinline__ void qkt_ref(f32x16& p0, f32x16& p1, const char* Ks, const bf16x8* qr, const f32x16& negm, int r32, int hi) {
#pragma unroll
  for (int d0 = 0; d0 < 4; ++d0) { const int cb = (d0 * 16 + hi * 8) * 2;
    bf16x8 b0 = *reinterpret_cast<const bf16x8*>(Ks + KSWZ64(r32, cb));
    bf16x8 b1 = *reinterpret_cast<const bf16x8*>(Ks + KSWZ64(32 + r32, cb));
    if (d0 == 0) { p0 = __builtin_amdgcn_mfma_f32_32x32x16_bf16(b0, qr[0], negm, 0, 0, 0); p1 = __builtin_amdgcn_mfma_f32_32x32x16_bf16(b1, qr[0], negm, 0, 0, 0); }
    else { p0 = __builtin_amdgcn_mfma_f32_32x32x16_bf16(b0, qr[d0], p0, 0, 0, 0); p1 = __builtin_amdgcn_mfma_f32_32x32x16_bf16(b1, qr[d0], p1, 0, 0, 0); } }
}
__device__ __forceinline__ void exp_half(f32x16& p) {
#pragma unroll
  for (int r = 0; r < 16; ++r) p[r] = __builtin_amdgcn_exp2f(p[r]);
}
__device__ __forceinline__ void sub_exp_half(f32x16& p0, f32x16& p1, float m) {
#pragma unroll
  for (int r = 0; r < 16; ++r) p0[r] = p0[r] - m;
#pragma unroll
  for (int r = 0; r < 16; ++r) p1[r] = p1[r] - m;
#pragma unroll
  for (int r = 0; r < 16; ++r) p0[r] = __builtin_amdgcn_exp2f(p0[r]);
}
__device__ __forceinline__ void finishSM_fast(f32x16& p0, f32x16& p1, float& l_reg, bool& ovf, bf16x8& pa0, bf16x8& pa1, bf16x8& pa2, bf16x8& pa3) {
  float al = 1.f; float l0 = 0.f;
  finishSM(p0, p1, al, l0, pa0, pa1, pa2, pa3);
  ovf = ovf || !(l0 < ATT_OVF_LIMIT);
  l_reg += l0;
}
__device__ __forceinline__ int v_st(int k, int c) { const int kk = (k & ~0xC) | ((k & 4) << 1) | ((k & 8) >> 1); return ((kk >> 3) * 4 + (c >> 5)) * 512 + ((kk & 7) * 32 + (c & 31)) * 2; }
__device__ __forceinline__ int v_rd_base(int lane) { return ((lane & 3) << 3) | (((lane >> 2) & 3) << 6) | (((lane >> 4) & 1) << 5) | (((lane >> 5) & 1) << 8); }
constexpr int v_rd_off(int d0, int ks, int half) { return d0 * 512 + ks * 4096 + half * 2048; }
template <int OFF> __device__ __forceinline__ s16x4 tr_read(int vb) {
  s16x4 r; asm volatile("ds_read_b64_tr_b16 %0, %1 offset:%2" : "=&v"(r) : "v"(vb), "i"(OFF) : "memory"); return r;
}
template <int D0> __device__ __forceinline__ void pv_one(f32x16& od, int vb, bf16x8 pa0, bf16x8 pa1, bf16x8 pa2, bf16x8 pa3) {
  const s16x4 l0 = tr_read<v_rd_off(D0, 0, 0)>(vb), h0 = tr_read<v_rd_off(D0, 0, 1)>(vb), l1 = tr_read<v_rd_off(D0, 1, 0)>(vb), h1 = tr_read<v_rd_off(D0, 1, 1)>(vb);
  const s16x4 l2 = tr_read<v_rd_off(D0, 2, 0)>(vb), h2 = tr_read<v_rd_off(D0, 2, 1)>(vb), l3 = tr_read<v_rd_off(D0, 3, 0)>(vb), h3 = tr_read<v_rd_off(D0, 3, 1)>(vb);
  asm volatile("s_waitcnt lgkmcnt(0)" ::: "memory"); SBAR();
#define PK(L, H) (bf16x8){L[0], L[1], L[2], L[3], H[0], H[1], H[2], H[3]}
  od = __builtin_amdgcn_mfma_f32_32x32x16_bf16(pa0, PK(l0, h0), od, 0, 0, 0);
  od = __builtin_amdgcn_mfma_f32_32x32x16_bf16(pa1, PK(l1, h1), od, 0, 0, 0);
  od = __builtin_amdgcn_mfma_f32_32x32x16_bf16(pa2, PK(l2, h2), od, 0, 0, 0);
  od = __builtin_amdgcn_mfma_f32_32x32x16_bf16(pa3, PK(l3, h3), od, 0, 0, 0);
#undef PK
}
__device__ __forceinline__ void pv_d0(f32x16* o, int vb, bf16x8 pa0, bf16x8 pa1, bf16x8 pa2, bf16x8 pa3) {
  pv_one<0>(o[0], vb, pa0, pa1, pa2, pa3); pv_one<1>(o[1], vb, pa0, pa1, pa2, pa3); pv_one<2>(o[2], vb, pa0, pa1, pa2, pa3); pv_one<3>(o[3], vb, pa0, pa1, pa2, pa3);
}
__device__ __forceinline__ void glds16(const void* gsrc, unsigned lds_dst) { unsigned keep;
  asm volatile("s_mov_b32 %0, m0\n\ts_mov_b32 m0, %2\n\ts_nop 0\n\tglobal_load_lds_dwordx4 %1, off\n\ts_mov_b32 m0, %0" : "=&s"(keep) : "v"(gsrc), "s"(lds_dst) : "memory"); }
template <bool FAST>
__device__ __forceinline__ bool attn_map(const bf16* __restrict__ Kh, const bf16* __restrict__ Vh, const bf16* __restrict__ Qh  , int seq, char* V_lds, char* K_lds, float* ws_base,
                                         f32x16 (&o)[4], float& l_out) {
    int tid = threadIdx.x; asm volatile("" : "+v"(tid));
    const int wid = __builtin_amdgcn_readfirstlane(tid >> 6), r32 = tid & 31, hi = (tid >> 5) & 1;
    float* al_l = ws_base + wid * 64 + 32;
    const bf16* Qw = Qh + (long)(wid * QBLK + r32) * LDR + hi * 8;
    const int lane_ = tid & 63;
    const unsigned lds0 = (unsigned)(uintptr_t)V_lds;
    const bf16 *vsrc0, *vsrc1, *ksrc;
    { const int o0 = (2 * wid) * 1024 + 16 * lane_, o1 = o0 + 1024, ok = wid * 1024 + 16 * lane_;
      auto vmap = [](int o, int& k, int& c) { const int sub = o >> 9, w = o & 511, kk = ((sub >> 2) << 3) | (w >> 6); k = (kk & ~0xC) | ((kk & 4) << 1) | ((kk & 8) >> 1); c = (sub & 3) * 32 + ((w & 63) >> 1); };
      int k0_, c0_, k1_, c1_; vmap(o0, k0_, c0_); vmap(o1, k1_, c1_);
      vsrc0 = Vh + (long)k0_ * LDR + c0_; vsrc1 = Vh + (long)k1_ * LDR + c1_;
      const int row = ok >> 7, cb = (ok & 127) ^ (((row >> 1) & 7) << 4);
      ksrc = Kh + (long)row * LDR + (cb >> 1); }
    const int vb0 = (int)(uintptr_t)V_lds + v_rd_base(tid & 63);
    float m_reg = -1e30f, l_reg = 0; bf16x8 qr[4]; bool ovf = false;
#pragma unroll
    for (int d0 = 0; d0 < 4; ++d0) { o[d0] = f32x16{}; qr[d0] = *reinterpret_cast<const bf16x8*>(Qw + d0 * 16); }
#define DMA_TILE(t, b) do { const long ro_ = (long)(t) * KVBLK * LDR; \
      glds16(vsrc0 + ro_, (unsigned)__builtin_amdgcn_readfirstlane(lds0 + (b) * SHM_V + (2 * wid) * 1024)); \
      glds16(vsrc1 + ro_, (unsigned)__builtin_amdgcn_readfirstlane(lds0 + (b) * SHM_V + (2 * wid + 1) * 1024)); \
      glds16(ksrc + ro_, (unsigned)__builtin_amdgcn_readfirstlane(lds0 + 3 * SHM_V + (b) * SHM_K + wid * 1024)); } while (0)
#define DMA_WAIT() asm volatile("s_waitcnt vmcnt(0)" ::: "memory")
#define RESC(a) do { if constexpr (!FAST) { if (__any((a) < 1.f)) { if (hi == 0) al_l[r32] = (a); asm volatile("s_waitcnt lgkmcnt(0)" ::: "memory"); \
    _Pragma("unroll") for (int d = 0; d < 4; ++d) _Pragma("unroll") for (int r = 0; r < 16; ++r) o[d][r] *= al_l[crow(r, hi)]; } } } while (0)
#define PSM(P0, P1, MN, AL) do { if constexpr (FAST) exp_half(P0); else partialSM(P0, P1, m_reg, MN, AL); } while (0)
#define FSM(P0, P1, AL) do { if constexpr (FAST) finishSM_fast(P0, P1, l_reg, ovf, pa0, pa1, pa2, pa3); else finishSM(P0, P1, AL, l_reg, pa0, pa1, pa2, pa3); } while (0)
#define STEP(PN0, PN1, MNN, ALN, PO0, PO1, ALO, jj) do { \
      SBAR(); if constexpr (FAST) qkt_ref(PN0, PN1, K_lds + bc * SHM_K, qr, negm, r32, hi); else qkt(PN0, PN1, K_lds + bc * SHM_K, qr, r32, hi); \
      if ((jj) + 1 < NT) DMA_TILE((jj) + 1, bn);              \
      FSM(PO0, PO1, ALO); SBAR(); \
      pv_d0(o, vb0 + bp * SHM_V, pa0, pa1, pa2, pa3); PSM(PN0, PN1, MNN, ALN); RESC(ALN); \
      DMA_WAIT(); __syncthreads(); \
      bp = bc; bc = bn; bn = (bn == 2) ? 0 : bn + 1; } while (0)
    f32x16 pA0, pA1, pB0, pB1; float mnA = 0.f, mnB = 0.f, alA = 1.f, alB = 1.f; bf16x8 pa0, pa1, pa2, pa3; const int NT = seq / KVBLK;
    DMA_TILE(0, 0); DMA_WAIT(); __syncthreads();
    if (1 < NT) DMA_TILE(1, 1);
    qkt(pA0, pA1, K_lds, qr, r32, hi); partialSM(pA0, pA1, m_reg, mnA, alA);
    f32x16 negm = f32x16{};
    if constexpr (FAST) {
#pragma unroll
      for (int r = 0; r < 16; ++r) negm[r] = -m_reg;
      asm volatile("" : "+v"(negm));
    }
    DMA_WAIT(); __syncthreads();
    int bp = 0, bc = 1, bn = 2;
    for (int j = 1; j + 1 < NT; j += 2) {
      STEP(pB0, pB1, mnB, alB, pA0, pA1, alA, j);
      STEP(pA0, pA1, mnA, alA, pB0, pB1, alB, j + 1);
    }
    STEP(pB0, pB1, mnB, alB, pA0, pA1, alA, NT - 1);
    FSM(pB0, pB1, alB); SBAR();
    pv_d0(o, vb0 + bp * SHM_V, pa0, pa1, pa2, pa3);
#undef DMA_TILE
#undef DMA_WAIT
#undef RESC
#undef PSM
#undef FSM
#undef STEP
    l_out = l_reg;
    return ovf;
}
__device__ __forceinline__ void attn_unit(const bf16* __restrict__ qkv, long Qrow0, long Krow0, int vh, int seq, float lam, float oscale, const float* __restrict__ subln,
                                          bf16* __restrict__ Ob, int ldo, float* stash, char* lds) {
  int tid = threadIdx.x; asm volatile("" : "+v"(tid));
  const int wid = __builtin_amdgcn_readfirstlane(tid >> 6), lane = tid & 63, r32 = lane & 31, hi = lane >> 5;
  char* V_lds = lds; char* K_lds = lds + 3 * SHM_V;
  float* wsb = (float*)(lds + 3 * SHM_V + 3 * SHM_K); float* li_l = wsb + wid * 64;
  volatile unsigned* ovw = (volatile unsigned*)(lds + 3 * SHM_V + 3 * SHM_K + NW * 64 * 4);
  const bf16* Vh = qkv + Krow0 * LDR + 2048 + vh * DV;
  for (int s = 0; s < 2; ++s) {
    const int head = 2 * vh + s;
    const bf16* Kh = qkv + Krow0 * LDR + 1024 + head * DQ;
    const bf16* Qh = qkv + Qrow0 * LDR + head * DQ;
    f32x16 o[4]; float l_reg;
    const bool ovf = attn_map<true>(Kh, Vh, Qh, seq, V_lds, K_lds, wsb, o, l_reg);
    if (lane == 0) ovw[wid] = __any(ovf) ? 1u : 0u;
    __syncthreads();
    unsigned anyovf = 0u;
#pragma unroll
    for (int w = 0; w < NW; ++w) anyovf |= ovw[w];
    __syncthreads();
    if (__builtin_amdgcn_readfirstlane(anyovf) != 0u) (void)attn_map<false>(Kh, Vh, Qh, seq, V_lds, K_lds, wsb, o, l_reg);
    if (hi == 0) li_l[r32] = l_reg; asm volatile("s_waitcnt lgkmcnt(0)" ::: "memory");
    float rli[16];
#pragma unroll
    for (int r = 0; r < 16; ++r) rli[r] = __builtin_amdgcn_rcpf(li_l[crow(r, hi)]);
    typedef float f32x4_t __attribute__((ext_vector_type(4)));
    f32x4_t* st4 = (f32x4_t*)stash + (size_t)tid * 16;
    if (s == 0) {
#pragma unroll
      for (int d0 = 0; d0 < 4; ++d0)
#pragma unroll
        for (int r4 = 0; r4 < 4; ++r4) { f32x4_t v; v[0] = o[d0][4 * r4] * rli[4 * r4]; v[1] = o[d0][4 * r4 + 1] * rli[4 * r4 + 1]; v[2] = o[d0][4 * r4 + 2] * rli[4 * r4 + 2]; v[3] = o[d0][4 * r4 + 3] * rli[4 * r4 + 3]; st4[d0 * 4 + r4] = v; }
    } else {
      float ssq[16];
#pragma unroll
      for (int r = 0; r < 16; ++r) ssq[r] = 0.f;
#pragma unroll
      for (int d0 = 0; d0 < 4; ++d0)
#pragma unroll
        for (int r4 = 0; r4 < 4; ++r4) { const f32x4_t sv = st4[d0 * 4 + r4];
#pragma unroll
          for (int i = 0; i < 4; ++i) { const int r = 4 * r4 + i; const float v = sv[i] - lam * (o[d0][r] * rli[r]); o[d0][r] = v; ssq[r] += v * v; } }
#pragma unroll
      for (int r = 0; r < 16; ++r) {
        float a = ssq[r];
        a += sx<1>(a); a += sx<2>(a); a += sx<4>(a); a += sx<8>(a); a += sx<16>(a);
        ssq[r] = oscale / sqrtf(a * (1.0f / 128.0f) + 1e-6f);
      }
      float g[4];
#pragma unroll
      for (int d0 = 0; d0 < 4; ++d0) g[d0] = subln[d0 * 32 + r32];
      bf16* stg = (bf16*)(lds + SHM_ATTN) + wid * (QBLK * DV);
      unsigned so = (unsigned)((4 * hi) * DV + r32); asm volatile("" : "+v"(so));
#pragma unroll
      for (int r = 0; r < 16; ++r) {
#pragma unroll
        for (int d0 = 0; d0 < 4; ++d0) { const unsigned w = cvtpk(o[d0][r] * ssq[r] * g[d0], 0.f); (stg + ((r & 3) + 8 * (r >> 2)) * DV + d0 * 32)[so] = (bf16)(w & 0xffffu); } }
      asm volatile("s_waitcnt lgkmcnt(0)" ::: "memory");
      int ldo_ = ldo; asm volatile("" : "+s"(ldo_));
      bf16* Ow = Ob + (long)(wid * QBLK) * ldo_;
      const int srow = lane >> 4, sch = lane & 15;
#pragma unroll
      for (int i = 0; i < 8; ++i) { const int row = i * 4 + srow; const u32x4 v = *(const u32x4*)(stg + row * DV + sch * 8); *(u32x4*)(Ow + (long)row * ldo_ + sch * 8) = v; }
    }
  }
}
#undef SBAR
}
#define GAS __attribute__((address_space(1)))
#define LAS __attribute__((address_space(3)))
typedef unsigned short bf16;
typedef unsigned v4u __attribute__((ext_vector_type(4)));
typedef float f32x4 __attribute__((ext_vector_type(4)));
typedef short bf16x8 __attribute__((ext_vector_type(8)));
typedef GAS unsigned gu32;
typedef GAS unsigned long long gu64;
#define RLX_AGENT __ATOMIC_RELAXED, __HIP_MEMORY_SCOPE_AGENT
#define LDS_WAIT() asm volatile("s_waitcnt lgkmcnt(0)" ::: "memory")
#define VM_WAIT() asm volatile("s_waitcnt vmcnt(0)" ::: "memory")
__device__ __forceinline__ unsigned long long rt() { return __builtin_amdgcn_s_memrealtime(); }
__device__ __forceinline__ unsigned f2bf(float f) { unsigned u = __builtin_bit_cast(unsigned, f); return (u + 0x7fffu + ((u >> 16) & 1u)) >> 16; }
__device__ __forceinline__ unsigned pk2(float lo, float hi) { unsigned r; asm("v_cvt_pk_bf16_f32 %0, %1, %2" : "=v"(r) : "v"(lo), "v"(hi)); return r; }

#define XB_TMO      128
#define XB_XCNT(j)  (256  + 64 * (j))
#define XB_XSUB(j)  (1280 + 64 * (j))
#define XB_XGEN(j)  (2304 + 64 * (j))
#define XB_TOP      3328
#define XB_TOPGEN   3392
#define XCD_BAR_WORDS 3456
#define XB_SPIN_CAP (1u << 18)

__device__ __forceinline__ unsigned xb_ld(unsigned* p)              { return __hip_atomic_load(p, __ATOMIC_RELAXED, __HIP_MEMORY_SCOPE_AGENT); }
__device__ __forceinline__ unsigned xb_add(unsigned* p, unsigned v) { return __hip_atomic_fetch_add(p, v, __ATOMIC_RELAXED, __HIP_MEMORY_SCOPE_AGENT); }
__device__ __forceinline__ unsigned xb_xcc_id() { return (unsigned)__builtin_amdgcn_s_getreg((3 << 11) | 20) & 0xFu; }
#define XB_SPIN(cond, bar) do { unsigned _sp = 0; while (cond) { __builtin_amdgcn_s_sleep(1); \
    if ((++_sp & 255u) == 0u) { if (xb_ld(&(bar)[XB_TMO])) break; if (_sp > XB_SPIN_CAP) { atomicAdd(&(bar)[XB_TMO], 1u); break; } } } } while (0)

struct XcdBarrier {
    unsigned* bar; unsigned x;
    volatile LAS unsigned* st;
};

__device__ __forceinline__ XcdBarrier xcd_barrier_post(unsigned* bar, volatile LAS unsigned* st) {
    XcdBarrier b; b.bar = bar; b.x = xb_xcc_id(); b.st = st;
    if (threadIdx.x == 0) (void)xb_add(&bar[XB_XCNT(b.x)], 1u);
    return b;
}
__device__ __forceinline__ void xcd_barrier_complete(unsigned* bar, unsigned x, unsigned& nloc, unsigned& nx) {
    const unsigned G = gridDim.x * gridDim.y * gridDim.z;
    unsigned sum, cnt, mine, sp = 0u;
    for (;;) {
        sum = 0u; cnt = 0u; mine = 0u;
#pragma unroll
        for (unsigned j = 0; j < 16; ++j) { const unsigned c = xb_ld(&bar[XB_XCNT(j)]); sum += c; cnt += (c > 0u) ? 1u : 0u; mine = (j == x) ? c : mine; }
        if (sum == G) break;
        __builtin_amdgcn_s_sleep(1);
        if ((++sp & 255u) == 0u) { if (xb_ld(&bar[XB_TMO])) break; if (sp > XB_SPIN_CAP) { atomicAdd(&bar[XB_TMO], 1u); break; } }
    }
    nloc = mine > 0u ? mine : 1u; nx = cnt > 0u ? cnt : 1u;
}

__device__ __forceinline__ void xcd_barrier(const XcdBarrier& b) {
    asm volatile("s_waitcnt vmcnt(0)" ::: "memory");
    __syncthreads();
    if (threadIdx.x == 0) {
        unsigned* bar = b.bar;
        __builtin_amdgcn_s_waitcnt(0);
        unsigned nloc = b.st[0], nx = b.st[1];
        if (nloc == 0u) { xcd_barrier_complete(bar, b.x, nloc, nx); b.st[0] = nloc; b.st[1] = nx; }
        const unsigned old = xb_add(&bar[XB_XSUB(b.x)], 1u);
        const unsigned gen = old / nloc;
        if (old + 1u == (gen + 1u) * nloc) {
            __builtin_amdgcn_fence(__ATOMIC_RELEASE, "agent");
            asm volatile("s_waitcnt vmcnt(0)" ::: "memory");
            const unsigned og = xb_add(&bar[XB_TOP], 1u);
            const unsigned tg = og / nx;
            if (og + 1u == (tg + 1u) * nx) xb_add(&bar[XB_TOPGEN], 1u);
            else XB_SPIN(xb_ld(&bar[XB_TOPGEN]) == tg, bar);
            __builtin_amdgcn_fence(__ATOMIC_ACQUIRE, "agent");
            xb_add(&bar[XB_XGEN(b.x)], 1u);
            asm volatile("s_waitcnt vmcnt(0)" ::: "memory");
        } else {
            XB_SPIN(xb_ld(&bar[XB_XGEN(b.x)]) == gen, bar);
            __builtin_amdgcn_fence(__ATOMIC_ACQUIRE, "agent");
            asm volatile("s_waitcnt vmcnt(0)" ::: "memory");
        }
    }
    __syncthreads();
}
#define HYD __device__ __forceinline__
#define HYDM __device__ __forceinline__
#define HY_DEVICE 1
#ifdef HY_DEVICE
#define HY_OPAQUE(x) asm volatile("" : "+v"(x))
#else
#define HY_OPAQUE(x) (void)(x)
#endif
typedef float cf __attribute__((ext_vector_type(2)));
typedef float cf2 __attribute__((ext_vector_type(4)));
template <class P> struct HyP2 {};
template <> struct HyP2<cf*> { typedef cf2* type; };
#ifdef HY_DEVICE
template <> struct HyP2<__attribute__((address_space(3))) cf*> { typedef __attribute__((address_space(3))) cf2* type; };
#endif
HYD cf cf_add(cf a, cf b) { return a + b; }
HYD cf cf_sub(cf a, cf b) { return a - b; }
HYD cf cf_mul(cf a, cf b) { return cf{a.x * b.x - a.y * b.y, a.x * b.y + a.y * b.x}; }
HYD cf cf_mulc(cf a, cf b) { return cf{a.x * b.x + a.y * b.y, a.y * b.x - a.x * b.y}; }
constexpr int FN = 16384, FT = 512, FLOG = 14, FNP = FN + 4 * (FN >> 6);
constexpr int SEQL = 8192;
HYD int HP(int i) { return i + ((i >> 6) << 2); }
#define HY_C1 0.92387953251128674f
#define HY_S1 0.38268343236508977f
#define HY_R2 0.70710678118654752f
template <int M16> HYD cf mul_root16(cf w) {
    if (M16 == 0) return w;
    if (M16 == 4) return cf{w.y, -w.x};
    if (M16 == 2) return cf{(w.x + w.y) * HY_R2, (w.y - w.x) * HY_R2};
    if (M16 == 6) return cf{(w.y - w.x) * HY_R2, -(w.x + w.y) * HY_R2};
    if (M16 == 1) return cf_mul(w, cf{HY_C1, -HY_S1});
    if (M16 == 3) return cf_mul(w, cf{HY_S1, -HY_C1});
    if (M16 == 5) return cf_mul(w, cf{-HY_S1, -HY_C1});
    return cf_mul(w, cf{-HY_C1, -HY_S1});
}
template <int Q, int U, bool INV, bool ZUP, bool HLO> struct HyStage {
    static HYDM void run(cf (&e)[1 << Q], const cf (&tw)[Q]) {
        constexpr int R = 1 << Q, half = R >> (U + 1);
#pragma unroll
        for (int k = 0; k < R; ++k) {
            if ((k & half) == 0) {
                const int kp = k & (half - 1);
                cf w = tw[U];
                switch (kp * 16 / (2 * half)) {
                    case 0: break;
                    case 1: w = mul_root16<1>(w); break;
                    case 2: w = mul_root16<2>(w); break;
                    case 3: w = mul_root16<3>(w); break;
                    case 4: w = mul_root16<4>(w); break;
                    case 5: w = mul_root16<5>(w); break;
                    case 6: w = mul_root16<6>(w); break;
                    default: w = mul_root16<7>(w); break;
                }
                if (!INV) {
                    if (ZUP && U == 0) { e[k + half] = cf_mul(e[k], w); }
                    else { const cf a = e[k], b = e[k + half]; e[k] = cf_add(a, b); e[k + half] = cf_mul(cf_sub(a, b), w); }
                } else {
                    const cf a = e[k], b = cf_mulc(e[k + half], w); e[k] = cf_add(a, b);
                    if (!(HLO && U == 0)) e[k + half] = cf_sub(a, b);
                }
            }
        }
    }
};
template <int Q, bool INV, bool ZUP, bool HLO> HYD void hy_bfly(cf (&e)[1 << Q], cf t) {
    cf tw[Q]; tw[0] = t;
#pragma unroll
    for (int u = 1; u < Q; ++u) tw[u] = cf_mul(tw[u - 1], tw[u - 1]);
    if (Q == 4) {
        if (!INV) { HyStage<Q, 0, INV, ZUP, HLO>::run(e, tw); HyStage<Q, 1, INV, ZUP, HLO>::run(e, tw); HyStage<Q, 2 % Q, INV, ZUP, HLO>::run(e, tw); HyStage<Q, 3 % Q, INV, ZUP, HLO>::run(e, tw); }
        else      { HyStage<Q, 3 % Q, INV, ZUP, HLO>::run(e, tw); HyStage<Q, 2 % Q, INV, ZUP, HLO>::run(e, tw); HyStage<Q, 1, INV, ZUP, HLO>::run(e, tw); HyStage<Q, 0, INV, ZUP, HLO>::run(e, tw); }
    } else {
        if (!INV) { HyStage<Q, 0, INV, ZUP, HLO>::run(e, tw); HyStage<Q, 1, INV, ZUP, HLO>::run(e, tw); }
        else      { HyStage<Q, 1, INV, ZUP, HLO>::run(e, tw); HyStage<Q, 0, INV, ZUP, HLO>::run(e, tw); }
    }
}
#ifdef HY_DEVICE
#define HY_MULT(T, X, Y) "v_pk_mul_f32 " T ", " X ", " Y " op_sel:[1,1] op_sel_hi:[1,0]\n\t"
#define HY_FMAP(R, X, Y, T) "v_pk_fma_f32 " R ", " X ", " Y ", " T " op_sel_hi:[0,1,1] neg_lo:[0,0,1]\n\t"
#define HY_FMAC(R, X, Y, T) "v_pk_fma_f32 " R ", " X ", " Y ", " T " op_sel_hi:[0,1,1] neg_hi:[1,0,0]\n\t"
#define HY_ADD(R, A, B) "v_pk_add_f32 " R ", " A ", " B "\n\t"
#define HY_SUB(R, A, B) "v_pk_add_f32 " R ", " A ", " B " neg_lo:[0,1] neg_hi:[0,1]\n\t"
HYD void hy_cmul2(cf& r0, cf x0, cf y0, cf& r1, cf x1, cf y1) { cf t0, t1;
    asm(HY_MULT("%0", "%4", "%5") HY_MULT("%1", "%6", "%7") HY_FMAP("%2", "%4", "%5", "%0") HY_FMAP("%3", "%6", "%7", "%1")
        : "=&v"(t0), "=&v"(t1), "=&v"(r0), "=&v"(r1) : "v"(x0), "v"(y0), "v"(x1), "v"(y1)); }
HYD cf hy_cmul1(cf x, cf y) { cf t, r;
    asm(HY_MULT("%0", "%2", "%3") "s_nop 0\n\t" HY_FMAP("%1", "%2", "%3", "%0") : "=&v"(t), "=&v"(r) : "v"(x), "v"(y)); return r; }
HYD void hy_bf2_fwd(cf& a0, cf& b0, cf w0, cf& a1, cf& b1, cf w1) { cf d0, d1, t0, t1;
    asm(HY_SUB("%4", "%0", "%1") HY_ADD("%0", "%0", "%1") HY_SUB("%5", "%2", "%3") HY_ADD("%2", "%2", "%3")
        HY_MULT("%6", "%4", "%8") HY_MULT("%7", "%5", "%9") HY_FMAP("%1", "%4", "%8", "%6") HY_FMAP("%3", "%5", "%9", "%7")
        : "+v"(a0), "+v"(b0), "+v"(a1), "+v"(b1), "=&v"(d0), "=&v"(d1), "=&v"(t0), "=&v"(t1) : "v"(w0), "v"(w1)); }
HYD void hy_bf2_fwdz(cf a0, cf& b0, cf w0, cf a1, cf& b1, cf w1) { hy_cmul2(b0, a0, w0, b1, a1, w1); }
HYD void hy_bf2_inv(cf& a0, cf& b0, cf w0, cf& a1, cf& b1, cf w1) { cf t0, t1;
    asm(HY_MULT("%4", "%1", "%6") HY_MULT("%5", "%3", "%7") HY_FMAC("%4", "%1", "%6", "%4") HY_FMAC("%5", "%3", "%7", "%5")
        HY_SUB("%1", "%0", "%4") HY_SUB("%3", "%2", "%5") HY_ADD("%0", "%0", "%4") HY_ADD("%2", "%2", "%5")
        : "+v"(a0), "+v"(b0), "+v"(a1), "+v"(b1), "=&v"(t0), "=&v"(t1) : "v"(w0), "v"(w1)); }
HYD void hy_bf2_invl(cf& a0, cf b0, cf w0, cf& a1, cf b1, cf w1) { cf t0, t1;
    asm(HY_MULT("%2", "%4", "%6") HY_MULT("%3", "%5", "%7") HY_FMAC("%2", "%4", "%6", "%2") HY_FMAC("%3", "%5", "%7", "%3")
        HY_ADD("%0", "%0", "%2") HY_ADD("%1", "%1", "%3")
        : "+v"(a0), "+v"(a1), "=&v"(t0), "=&v"(t1) : "v"(b0), "v"(b1), "v"(w0), "v"(w1)); }
HYD cf hy_rot(cf w) { cf r; asm("v_pk_add_f32 %0, %1, 0 op_sel:[1,0] op_sel_hi:[0,0] neg_hi:[1,0]" : "=v"(r) : "v"(w)); return r; }
#else
HYD void hy_cmul2(cf& r0, cf x0, cf y0, cf& r1, cf x1, cf y1) { const cf p0 = cf_mul(x0, y0), p1 = cf_mul(x1, y1); r0 = p0; r1 = p1; }
HYD cf hy_cmul1(cf x, cf y) { return cf_mul(x, y); }
HYD void hy_bf2_fwd(cf& a0, cf& b0, cf w0, cf& a1, cf& b1, cf w1) { const cf d0 = cf_sub(a0, b0), d1 = cf_sub(a1, b1); a0 = cf_add(a0, b0); a1 = cf_add(a1, b1); b0 = cf_mul(d0, w0); b1 = cf_mul(d1, w1); }
HYD void hy_bf2_fwdz(cf a0, cf& b0, cf w0, cf a1, cf& b1, cf w1) { b0 = cf_mul(a0, w0); b1 = cf_mul(a1, w1); }
HYD void hy_bf2_inv(cf& a0, cf& b0, cf w0, cf& a1, cf& b1, cf w1) { const cf p0 = cf_mulc(b0, w0), p1 = cf_mulc(b1, w1); b0 = cf_sub(a0, p0); b1 = cf_sub(a1, p1); a0 = cf_add(a0, p0); a1 = cf_add(a1, p1); }
HYD void hy_bf2_invl(cf& a0, cf b0, cf w0, cf& a1, cf b1, cf w1) { a0 = cf_add(a0, cf_mulc(b0, w0)); a1 = cf_add(a1, cf_mulc(b1, w1)); }
HYD cf hy_rot(cf w) { return cf{w.y, -w.x}; }
#endif
template <int U, bool INV, bool ZUP, bool HLO> HYD void hy_stage16(cf (&e)[16], const cf* W) {
    constexpr int half = 8 >> U;
#pragma unroll
    for (int j = 0; j < 8; j += 2) {
        const int k0 = ((j / half) * 2 * half) + (j % half), k1 = (((j + 1) / half) * 2 * half) + ((j + 1) % half);
        const cf w0 = W[k0 & (half - 1)], w1 = W[k1 & (half - 1)];
        if (!INV) { if (ZUP && U == 0) hy_bf2_fwdz(e[k0], e[k0 + half], w0, e[k1], e[k1 + half], w1); else hy_bf2_fwd(e[k0], e[k0 + half], w0, e[k1], e[k1 + half], w1); }
        else { if (HLO && U == 0) hy_bf2_invl(e[k0], e[k0 + half], w0, e[k1], e[k1 + half], w1); else hy_bf2_inv(e[k0], e[k0 + half], w0, e[k1], e[k1 + half], w1); }
    }
}
template <bool INV, bool ZUP, bool HLO> HYD void hy_bfly16(cf (&e)[16], cf t) {
    cf W0[8], W1[4], W2[2], W3[1], tw1, tw2;
    cf k1 = cf{HY_C1, -HY_S1}, k2 = cf{HY_R2, -HY_R2}, k3 = cf{HY_S1, -HY_C1};
    W0[0] = t;
    hy_cmul2(W0[1], t, k1, W0[3], t, k3);
    hy_cmul2(W0[2], t, k2, tw1, t, t);
    W1[0] = tw1;
    hy_cmul2(W1[1], tw1, k2, tw2, tw1, tw1);
    W2[0] = tw2;
    W3[0] = hy_cmul1(tw2, tw2);
#pragma unroll
    for (int i = 0; i < 4; ++i) W0[4 + i] = hy_rot(W0[i]);
    W1[2] = hy_rot(W1[0]); W1[3] = hy_rot(W1[1]); W2[1] = hy_rot(W2[0]);
    if (!INV) { hy_stage16<0, INV, ZUP, HLO>(e, W0); hy_stage16<1, INV, ZUP, HLO>(e, W1); hy_stage16<2, INV, ZUP, HLO>(e, W2); hy_stage16<3, INV, ZUP, HLO>(e, W3); }
    else      { hy_stage16<3, INV, ZUP, HLO>(e, W3); hy_stage16<2, INV, ZUP, HLO>(e, W2); hy_stage16<1, INV, ZUP, HLO>(e, W1); hy_stage16<0, INV, ZUP, HLO>(e, W0); }
}
template <class PT> HYD cf hy_twid(PT thi, PT tlo, int e) { return hy_cmul1(thi[e >> 7], tlo[e & 127]); }
template <int S, bool INV, bool ZUP, bool HLO, class P, class PT>
HYD void hy_pass16(P X, PT thi, PT tlo, int tid) {
    constexpr int R = 16;
    constexpr int SP = (S >= 64) ? S + S / 16 : S;
    const int g0 = tid, g1 = tid + FT;
    const int lo0 = g0 & (S - 1), pb0 = HP((g0 / S) * S * R + lo0);
    const int lo1 = g1 & (S - 1), pb1 = HP((g1 / S) * S * R + lo1);
    cf e0[R], e1[R];
#pragma unroll
    for (int k = 0; k < R; ++k) { if (ZUP && k >= 8) e0[k] = cf{0.f, 0.f}; else e0[k] = X[pb0 + k * SP]; }
#pragma unroll
    for (int k = 0; k < R; ++k) { if (ZUP && k >= 8) e1[k] = cf{0.f, 0.f}; else e1[k] = X[pb1 + k * SP]; }
    const cf t0 = hy_twid(thi, tlo, lo0 * (FN / (R * S))), t1 = hy_twid(thi, tlo, lo1 * (FN / (R * S)));
    hy_bfly16<INV, ZUP, HLO>(e0, t0);
#pragma unroll
    for (int k = 0; k < R; ++k) { if (!(HLO && k >= 8)) X[pb0 + k * SP] = e0[k]; }
    hy_bfly16<INV, ZUP, HLO>(e1, t1);
#pragma unroll
    for (int k = 0; k < R; ++k) { if (!(HLO && k >= 8)) X[pb1 + k * SP] = e1[k]; }
}
template <bool INV> HYD void hy_r4(cf (&e)[4]) {
    if (!INV) {
        const cf a0 = e[0] + e[2], b0 = e[0] - e[2], a1 = e[1] + e[3], d = e[1] - e[3], b1 = cf{d.y, -d.x};
        e[0] = a0 + a1; e[1] = a0 - a1; e[2] = b0 + b1; e[3] = b0 - b1;
    } else {
        const cf a0 = e[0] + e[1], a1 = e[0] - e[1], a2 = e[2] + e[3], d = e[2] - e[3], b = cf{-d.y, d.x};
        e[0] = a0 + a2; e[2] = a0 - a2; e[1] = a1 + b; e[3] = a1 - b;
    }
}
template <bool INV, class P, class PK>
HYD void hy_pass4(P X, int tid, PK KM) {
    typedef typename HyP2<P>::type P2;
    const int w = tid >> 6, lane = tid & 63;
#pragma unroll 1
    for (int gb = 0; gb < 2; ++gb) {
        cf2 a[4], b[4], ka[4], kb[4];
        const int g0 = (gb * 8 + w) * 256 + lane;
#pragma unroll
        for (int u = 0; u < 4; ++u) { const int g = g0 + 64 * u; P2 X2 = (P2)(X + HP(4 * g)); a[u] = X2[0]; b[u] = X2[1];
            if (KM) { const unsigned gi = (unsigned)(4 * g) & 0x3fffu; ka[u] = ((const cf2*)(KM + gi))[0]; kb[u] = ((const cf2*)(KM + gi))[1]; } }
#pragma unroll
        for (int u = 0; u < 4; ++u) { const int g = g0 + 64 * u; P2 X2 = (P2)(X + HP(4 * g));
            cf e[4] = {cf{a[u].x, a[u].y}, cf{a[u].z, a[u].w}, cf{b[u].x, b[u].y}, cf{b[u].z, b[u].w}};
            hy_r4<INV>(e);
            if (KM) { cf q0, q1, q2, q3; hy_cmul2(q0, e[0], cf{ka[u].x, ka[u].y}, q1, e[1], cf{ka[u].z, ka[u].w}); hy_cmul2(q2, e[2], cf{kb[u].x, kb[u].y}, q3, e[3], cf{kb[u].z, kb[u].w}); e[0] = q0; e[1] = q1; e[2] = q2; e[3] = q3; }
            X2[0] = cf2{e[0].x, e[0].y, e[1].x, e[1].y}; X2[1] = cf2{e[2].x, e[2].y, e[3].x, e[3].y}; }
    }
}
HYD int hy_brev14(int p) {
    unsigned v = (unsigned)p;
    v = ((v >> 1) & 0x55555555u) | ((v & 0x55555555u) << 1);
    v = ((v >> 2) & 0x33333333u) | ((v & 0x33333333u) << 2);
    v = ((v >> 4) & 0x0F0F0F0Fu) | ((v & 0x0F0F0F0Fu) << 4);
    v = ((v >> 8) & 0x00FF00FFu) | ((v & 0x00FF00FFu) << 8);
    v = (v >> 16) | (v << 16);
    return (int)(v >> (32 - FLOG));
}
HYD float hy_bf2f(unsigned short b) { unsigned u = (unsigned)b << 16; float f; __builtin_memcpy(&f, &u, 4); return f; }
HYD unsigned hy_f2bf(float f) { unsigned u; __builtin_memcpy(&u, &f, 4); return (u + 0x7fffu + ((u >> 16) & 1u)) >> 16; }
template <class PR> HYD void hy_sconv2(PR rowj  , unsigned tid, int j, float w0, float w1, float w2, float b, float& u0, float& u1) {
    const unsigned d1 = rowj[tid];
    const unsigned d0r = (rowj - 1)[tid], d2r = (rowj + 1)[tid];
    const unsigned d0 = (j > 0 || tid > 0) ? d0r : 0u;
    const unsigned d2 = (j < 7 || tid < (unsigned)(FT - 1)) ? d2r : 0u;
    const float pm1 = hy_bf2f((unsigned short)(d0 >> 16)), p0 = hy_bf2f((unsigned short)(d1 & 0xffffu)), p1 = hy_bf2f((unsigned short)(d1 >> 16)), p2 = hy_bf2f((unsigned short)(d2 & 0xffffu));
    u0 = b + w0 * pm1 + w1 * p0 + w2 * p1;
    u1 = b + w0 * p0 + w1 * p1 + w2 * p2;
}
template <class P> HYD void hy_filter_step(P X, const unsigned short* taps, float delta, int tid) {
    typedef typename HyP2<P>::type P2;
    typedef unsigned u32x2h __attribute__((ext_vector_type(2)));
    u32x2h raw[SEQL / (4 * FT)][4];
    const float dscale = -delta * (1.4426950408889634f / (float)(SEQL - 1)); (void)dscale;
#pragma unroll
    for (int j = 0; j < SEQL / (4 * FT); ++j)
#pragma unroll
        for (int q = 0; q < 4; ++q) raw[j][q] = *(const u32x2h*)(taps + (size_t)q * 1024 * SEQL + ((unsigned)(4 * (tid + FT * j)) & 0x1fffu));
#pragma unroll
    for (int j = 0; j < SEQL / (4 * FT); ++j) {
        const int t = 4 * (tid + FT * j);
        cf2 a[4];
#pragma unroll
        for (int q = 0; q < 4; ++q) a[q] = cf2{hy_bf2f((unsigned short)(raw[j][q].x & 0xffffu)), hy_bf2f((unsigned short)(raw[j][q].x >> 16)), hy_bf2f((unsigned short)(raw[j][q].y & 0xffffu)), hy_bf2f((unsigned short)(raw[j][q].y >> 16))};
        cf2 dec;
#pragma unroll
#ifdef HY_DEVICE
        for (int e = 0; e < 4; ++e) dec[e] = __builtin_amdgcn_exp2f((float)(t + e) * dscale);
#else
        for (int e = 0; e < 4; ++e) dec[e] = expf(-((float)(t + e) * (1.0f / (float)(SEQL - 1))) * delta);
#endif
        const cf2 a0 = a[0] * dec, a1 = a[1] * dec, a2 = a[2] * dec, a3 = a[3] * dec;
        P2 Xf = (P2)(X + HP(t));
        if (t == 0) { Xf[0] = cf2{a0[0] + a1[0], a2[0] + a3[0], a0[1], a2[1]}; float z0 = 0.f; HY_OPAQUE(z0); X[HP(SEQL)] = cf{z0, z0}; }
        else Xf[0] = cf2{a0[0], a2[0], a0[1], a2[1]};
        Xf[1] = cf2{a0[2], a2[2], a0[3], a2[3]};
        const int pbk = HP(FN - t - 4);
        X[pbk + 1] = cf{a1[3], a3[3]}; X[pbk + 2] = cf{a1[2], a3[2]}; X[pbk + 3] = cf{a1[1], a3[1]};
        if (t > 0) X[HP(FN - t)] = cf{a1[0], a3[0]};
    }
}
template <class P> HYD void hy_sep_step(P X, cf* K1g, cf* K2g, int tid) {
    const float sc = 0.5f / (float)FN;
#pragma unroll 1
    for (int j0 = 0; j0 < FN / FT; j0 += 4) {
        cf a[4], b[4];
#pragma unroll
        for (int u = 0; u < 4; ++u) { const int p = tid + FT * (j0 + u);
            const int f = hy_brev14(p), q = hy_brev14((FN - f) & (FN - 1));
            a[u] = X[HP(p)]; b[u] = X[HP(q)]; }
#pragma unroll
        for (int u = 0; u < 4; ++u) { const int p = tid + FT * (j0 + u);
            const unsigned pi = (unsigned)p & 0x3fffu;
            K1g[pi] = cf{(a[u].x + b[u].x) * sc, (a[u].y - b[u].y) * sc};
            K2g[pi] = cf{(a[u].y + b[u].y) * sc, -(a[u].x - b[u].x) * sc}; }
    }
}
template <class P> HYD void hy_load_step(P X, const unsigned* r0, const unsigned* r1, float w0, float w1, float w2, float b, float (&zr)[8][4], int tid) {
    typedef typename HyP2<P>::type P2;
#pragma unroll
    for (int j = 0; j < 8; ++j) {
        const int t = 2 * (tid + FT * j);
        hy_sconv2(r0 + FT * j, (unsigned)tid, j, w0, w1, w2, b, zr[j][0], zr[j][2]);
        hy_sconv2(r1 + FT * j, (unsigned)tid, j, w0, w1, w2, b, zr[j][1], zr[j][3]);
        *(P2)(X + HP(t)) = cf2{zr[j][0], zr[j][1], zr[j][2], zr[j][3]};
    }
}
template <class P> HYD void hy_gate1_step(P X, const unsigned* r0, const unsigned* r1, float w0, float w1, float w2, float b, float bias, float (&zr)[8][4], int tid) {
    typedef typename HyP2<P>::type P2;
#pragma unroll
    for (int j = 0; j < 8; ++j) {
        const int t = 2 * (tid + FT * j);
        float xa0, xa1, xb0, xb1;
        hy_sconv2(r0 + FT * j, (unsigned)tid, j, w0, w1, w2, b, xa0, xa1);
        hy_sconv2(r1 + FT * j, (unsigned)tid, j, w0, w1, w2, b, xb0, xb1);
        P2 xp = (P2)(X + HP(t));
        const cf2 y = *xp;
        zr[j][0] = xa0 * (y.x + zr[j][0] * bias); zr[j][1] = xb0 * (y.y + zr[j][1] * bias);
        zr[j][2] = xa1 * (y.z + zr[j][2] * bias); zr[j][3] = xb1 * (y.w + zr[j][3] * bias);
        *xp = cf2{zr[j][0], zr[j][1], zr[j][2], zr[j][3]};
    }
}
template <class P> HYD void hy_gate2_step(P X, const unsigned* r0, const unsigned* r1, float w0, float w1, float w2, float b, float bias, const float (&zr)[8][4], unsigned* out0, unsigned* out1, int tid) {
    typedef typename HyP2<P>::type P2;
#pragma unroll
    for (int j = 0; j < 8; ++j) {
        const int t = 2 * (tid + FT * j);
        float xa0, xa1, xb0, xb1;
        hy_sconv2(r0 + FT * j, (unsigned)tid, j, w0, w1, w2, b, xa0, xa1);
        hy_sconv2(r1 + FT * j, (unsigned)tid, j, w0, w1, w2, b, xb0, xb1);
        const cf2 y = *(P2)(X + HP(t));
        const float za0 = xa0 * (y.x + zr[j][0] * bias), zb0 = xb0 * (y.y + zr[j][1] * bias);
        const float za1 = xa1 * (y.z + zr[j][2] * bias), zb1 = xb1 * (y.w + zr[j][3] * bias);
        (out0 + FT * j)[(unsigned)tid] = hy_f2bf(za0) | (hy_f2bf(za1) << 16);
        (out1 + FT * j)[(unsigned)tid] = hy_f2bf(zb0) | (hy_f2bf(zb1) << 16);
    }
}
HYD float hy_sconv1(unsigned D0, unsigned D1, int t, float w0, float w1, float w2, float b, bool pad0, bool padL) {
    const unsigned sh = ((unsigned)(t - 1) & 1u) << 4;
#ifdef HY_DEVICE
    const unsigned lo = __builtin_amdgcn_alignbit(D1, D0, sh), hi = D1 >> sh;
#else
    const unsigned long long w = (((unsigned long long)D1 << 32) | D0) >> sh; const unsigned lo = (unsigned)w, hi = (unsigned)(w >> 32);
#endif
    float e0 = hy_bf2f((unsigned short)(lo & 0xffffu)), e1 = hy_bf2f((unsigned short)(lo >> 16)), e2 = hy_bf2f((unsigned short)(hi & 0xffffu));
    if (pad0 && t == 0) e0 = 0.f;
    if (padL && t == SEQL - 1) e2 = 0.f;
    return b + w0 * e0 + w1 * e1 + w2 * e2;
}
struct HyRaw { unsigned d[2][8][4]; };
HYD void hy_raw_load(HyRaw& R, const unsigned* r0, const unsigned* r1, int tid) {
#pragma unroll
    for (int r = 0; r < 2; ++r)
#pragma unroll
        for (int k = 0; k < 8; ++k) { const unsigned du = ((unsigned)(tid + FT * r + 1024 * k + 1) >> 1) & 0x1fffu;
            R.d[r][k][0] = (r0 - 1)[du]; R.d[r][k][1] = r0[du]; R.d[r][k][2] = (r1 - 1)[du]; R.d[r][k][3] = r1[du]; }
}
template <class P, class PT> HYD void hy_convA_fwd(P X, PT thi, PT tlo, int tid, const HyRaw& R, float w0, float w1, float w2, float b, cf (&zr)[2][8]) {
#pragma unroll
    for (int r = 0; r < 2; ++r) {
        const int i0 = tid + FT * r, pb = HP(i0);
        cf e[16];
#pragma unroll
        for (int k = 0; k < 8; ++k) { const int t = i0 + 1024 * k; const bool p0 = (r == 0 && k == 0), pL = (r == 1 && k == 7); e[k] = cf{hy_sconv1(R.d[r][k][0], R.d[r][k][1], t, w0, w1, w2, b, p0, pL), hy_sconv1(R.d[r][k][2], R.d[r][k][3], t, w0, w1, w2, b, p0, pL)}; zr[r][k] = e[k]; }
#pragma unroll
        for (int k = 8; k < 16; ++k) e[k] = cf{0.f, 0.f};
        hy_bfly16<false, true, false>(e, hy_twid(thi, tlo, i0));
#pragma unroll
        for (int k = 0; k < 16; ++k) X[pb + k * 1088] = e[k];
    }
}
template <bool LAST, class P, class PT> HYD void hy_gateA(P X, PT thi, PT tlo, int tid, const HyRaw& R, float w0, float w1, float w2, float b, float bias,
                                                           cf (&zr)[2][8], unsigned short* out0, unsigned short* out1) {
#pragma unroll
    for (int r = 0; r < 2; ++r) {
        const int i0 = tid + FT * r, pb = HP(i0);
        cf e[16];
#pragma unroll
        for (int k = 0; k < 16; ++k) e[k] = X[pb + k * 1088];
        const cf tw = hy_twid(thi, tlo, i0);
        hy_bfly16<true, false, true>(e, tw);
#pragma unroll
        for (int k = 0; k < 8; ++k) { const int t = i0 + 1024 * k;
            const bool p0 = (r == 0 && k == 0), pL = (r == 1 && k == 7);
            const float xa = hy_sconv1(R.d[r][k][0], R.d[r][k][1], t, w0, w1, w2, b, p0, pL), xb = hy_sconv1(R.d[r][k][2], R.d[r][k][3], t, w0, w1, w2, b, p0, pL);
            const cf z = cf{xa * (e[k].x + zr[r][k].x * bias), xb * (e[k].y + zr[r][k].y * bias)};
            if (LAST) {
#ifdef HY_DEVICE
                unsigned pk; asm("v_cvt_pk_bf16_f32 %0, %1, %2" : "=v"(pk) : "v"(z.x), "v"(z.y)); const unsigned ti = (unsigned)t & 0x1fffu; out0[ti] = (unsigned short)(pk & 0xffffu); out1[ti] = (unsigned short)(pk >> 16);
#else
                out0[t] = (unsigned short)hy_f2bf(z.x); out1[t] = (unsigned short)hy_f2bf(z.y);
#endif
            }
            else { zr[r][k] = z; e[k] = z; } }
        if (!LAST) {
#pragma unroll
            for (int k = 8; k < 16; ++k) e[k] = cf{0.f, 0.f};
            hy_bfly16<false, true, false>(e, tw);
#pragma unroll
            for (int k = 0; k < 16; ++k) X[pb + k * 1088] = e[k];
        }
    }
}
constexpr int NWAVES = 8, NTHR = NWAVES * 64;
constexpr int DM = 2048, SEQ = 8192, DEPTH = 4, NSEQ = 6, GSEQ = 2, NGRP = NSEQ / GSEQ, MG = GSEQ * SEQ;
constexpr int HYW = 1024, HYIN = 3072, QKVW = 3072, DFF = 5632, GU = 2 * DFF, FEMB = 33, FHID = 64;
constexpr float EPS = 1e-6f;
constexpr float QSCALE = 0.125f * 1.4426950408889634f;
constexpr size_t MiB = 1u << 20;
constexpr size_t WS_CTL = 0, CTL_ZERO_BYTES = 1 * MiB;
constexpr size_t SZ_WHY = (size_t)HYIN * DM * 2, SZ_WQKV = (size_t)QKVW * DM * 2, SZ_WOUT = (size_t)DM * DM * 2, SZ_WGU = (size_t)GU * DM * 2, SZ_WDN = (size_t)DM * DFF * 2;
constexpr size_t OFF_WHY = 0, OFF_WQKV = OFF_WHY + SZ_WHY, OFF_WOUT = OFF_WQKV + SZ_WQKV, OFF_WGU = OFF_WOUT + SZ_WOUT, OFF_WDN = OFF_WGU + SZ_WGU, SZ_WLAYER = OFF_WDN + SZ_WDN;
constexpr size_t WS_W = 1 * MiB;
constexpr size_t WS_ROPE = WS_W + DEPTH * SZ_WLAYER;
constexpr int KPAD = 256;
constexpr size_t WS_H3 = WS_ROPE + (size_t)SEQ * 32 * 8;
constexpr size_t WS_W4T = WS_H3 + (size_t)DEPTH * SEQ * KPAD * 2;
constexpr size_t WS_TAPS = WS_W4T + (size_t)DEPTH * 4096 * KPAD * 2;
constexpr size_t WS_FFTK = WS_TAPS + (size_t)4096 * SEQ * 2;
constexpr size_t WS_STASH = WS_FFTK + (size_t)256 * 2 * 16384 * 8;
constexpr size_t WS_XB = WS_STASH;
constexpr size_t WS_H = WS_XB + (size_t)MG * DM * 2;
constexpr size_t WS_ZT = WS_H + (size_t)MG * DM * 2;
constexpr size_t WS_PROJT = WS_ZT + (size_t)HYW * MG * 2;
constexpr size_t WS_QKV = WS_PROJT + (size_t)HYIN * MG * 2;
constexpr size_t WS_MIX = WS_PROJT;
constexpr size_t WS_FFH = WS_PROJT;
constexpr size_t WS_MIXIN = WS_QKV + (size_t)MG * QKVW * 2;
constexpr size_t WS_END = WS_MIXIN + (size_t)MG * DM * 2;
constexpr size_t SZ_TAPS = (size_t)4096 * SEQ * 2, WS_TAPS_X = WS_END, WS_END_X = WS_TAPS_X + (DEPTH - 1) * SZ_TAPS;
static_assert((size_t)MG * DFF * 2 <= (size_t)HYIN * MG * 2 + (size_t)MG * QKVW * 2, "FFH overlay fits PROJT|QKV");
static_assert(WS_W4T % 256 == 0 && WS_TAPS % 256 == 0 && WS_ROPE % 256 == 0 && WS_H3 % 256 == 0 && WS_FFTK % 256 == 0 && WS_XB % 256 == 0 && WS_H % 256 == 0 && SZ_WLAYER % 256 == 0, "alignment");
constexpr int CW_BAR = 4096;
constexpr int PH_PER_LAYER = 8, PH_PER_GROUP = 1 + DEPTH * PH_PER_LAYER, NPHASE = 1 + NGRP * PH_PER_GROUP;
constexpr int RING_OFF = 0, RING_BYTES = 131072;
constexpr int TAB_OFF = 139264;
constexpr int MISC_OFF = TAB_OFF + 4096;
constexpr int LDS_BYTES = 147456;
static_assert(MISC_OFF + 128 <= LDS_BYTES, "LDS map");
static_assert(att::SHM_ATTN_ALL <= MISC_OFF, "attention LDS fits below the control words");
#ifndef PROBE_DUP
#define PROBE_DUP 0
#endif
#ifndef MK_PER_PHASE
#define MK_PER_PHASE 0
#endif

struct Args { const float* in[30]; float* out; unsigned char* ws; int ph_lo, ph_hi, taps_all, pad; };
enum { I_XP = 0, I_XS, I_GMPRE, I_GMPOST, I_GFPRE, I_GFPOST, I_WIN, I_CONVW, I_CONVB, I_FW1, I_FB1, I_FF1, I_FW2, I_FB2, I_FF2, I_FW3, I_FB3, I_FF3, I_FW4,
       I_HBIAS, I_HNORM, I_LQ1, I_LK1, I_LQ2, I_LK2, I_SUBLN, I_WOUT, I_WGATE, I_WUP, I_WDOWN };

template <int K> __device__ __forceinline__ float swz_xor(float v) { return __builtin_bit_cast(float, __builtin_amdgcn_ds_swizzle(__builtin_bit_cast(int, v), (K << 10) | 0x1f)); }
__device__ __forceinline__ float wave_sum(float v) {
    v += swz_xor<1>(v); v += swz_xor<2>(v); v += swz_xor<4>(v); v += swz_xor<8>(v); v += swz_xor<16>(v);
    auto rr = __builtin_amdgcn_permlane32_swap(__float_as_uint(v), __float_as_uint(v), false, false);
    return __uint_as_float(rr[0]) + __uint_as_float(rr[1]);
}
__device__ __forceinline__ bf16* wt_dst_row(int kind, int n, bf16* d0, bf16* d1, int K) {
    if (kind == 0) return d0 + (size_t)n * K;
    if (kind == 1) { if (n < HYIN) return d0 + (size_t)n * K; int q = n - HYIN; if (q < 2048) { const int hb = q & ~63, i = q & 63; q = hb + (i < 32 ? 2 * i : 2 * (i - 32) + 1); } return d1 + (size_t)q * K; }
    if (kind == 4) return d0 + (size_t)n * KPAD;
    const int r = (n >> 7) * 256 + (n & 127) + (kind == 3 ? 128 : 0); return d0 + (size_t)r * K;
}
__device__ __forceinline__ void p0_transpose_item(const float* W, int K, int N, int kind, bf16* d0, bf16* d1, LAS float* scr, int item, int lane) {
    const int nblk = N / 32, kb = item / nblk, nb = item % nblk, k0 = 64 * kb, n0 = 32 * nb;
#pragma unroll 8
    for (int i = 0; i < 32; ++i) { const int kk = 2 * i + (lane >> 5); scr[kk * 33 + (lane & 31)] = W[(size_t)(k0 + kk) * N + n0 + (lane & 31)]; }
    LDS_WAIT(); asm volatile("" ::: "memory");
    const int c = lane & 7;
#pragma unroll
    for (int j = 0; j < 4; ++j) { const int n = (lane >> 3) + 8 * j; const LAS float* s = scr + (8 * c) * 33 + n;
        v4u o; o.x = pk2(s[0 * 33], s[1 * 33]); o.y = pk2(s[2 * 33], s[3 * 33]); o.z = pk2(s[4 * 33], s[5 * 33]); o.w = pk2(s[6 * 33], s[7 * 33]);
        *(GAS v4u*)(wt_dst_row(kind, n0 + n, d0, d1, K) + k0 + 8 * c) = o; }
    LDS_WAIT(); asm volatile("" ::: "memory");
}
__device__ __forceinline__ void sincos_red(double ang, float& s, float& c) {
    const double k = rint(ang * 0.15915494309189535); const float r = (float)(ang - k * 6.283185307179586);
    s = sinf(r); c = cosf(r);
}
#define GP(p) ((const float*)(const GAS float*)(p))
#define LAUNDER_TID(F) do { int t_ = (F).tid; asm volatile("" : "+v"(t_)); (F).tid = t_; (F).lane = t_ & 63; int z_ = 0; asm volatile("" : "+s"(z_)); (F).z = z_; unsigned long long w_ = (unsigned long long)(F).ws0; asm volatile("" : "+s"(w_)); (F).ws = (unsigned char*)(GAS unsigned char*)w_; int b_ = (F).bx0, v_ = (F).vcu0, g_ = (F).G0; asm volatile("" : "+s"(b_), "+s"(v_), "+s"(g_)); (F).bx = b_; (F).vcu = v_; (F).G = g_; } while (0)
struct Frame {
    LAS unsigned char* lds; volatile LAS unsigned* MISC; gu32* ctl;
    int tid, lane, wave, vcu, G, bx;
    int vcu0, G0, bx0;
    float* out; unsigned char* ws; unsigned char* ws0; int z;
};
__device__ __forceinline__ void p0_prologue(Frame& F, const Args& A) {
    LAS float* scr = (LAS float*)(F.lds + RING_OFF + F.wave * 16384);
    const int gw = F.vcu * NWAVES + F.wave, NGW = F.G * NWAVES;
    constexpr int I_IN = (DM / 64) * ((HYIN + QKVW) / 32), I_OUT = (DM / 64) * (DM / 32), I_G = (DM / 64) * (DFF / 32), I_D = (DFF / 64) * (DM / 32);
    constexpr int I_W4 = 4096 / 32;
    constexpr int PER_L = I_IN + I_OUT + 2 * I_G + I_D + I_W4;
    for (int it = gw; it < DEPTH * PER_L; it += NGW) {
        const int l = it / PER_L; int r = it % PER_L;
        unsigned char* wl = F.ws + WS_W + (size_t)l * SZ_WLAYER;
        if (r < I_IN) { p0_transpose_item(GP(A.in[I_WIN + F.z]) + (size_t)l * DM * (HYIN + QKVW), DM, HYIN + QKVW, 1, (bf16*)(wl + OFF_WHY), (bf16*)(wl + OFF_WQKV), scr, r, F.lane); continue; } r -= I_IN;
        if (r < I_OUT) { p0_transpose_item(GP(A.in[I_WOUT + F.z]) + (size_t)l * DM * DM, DM, DM, 0, (bf16*)(wl + OFF_WOUT), nullptr, scr, r, F.lane); continue; } r -= I_OUT;
        if (r < I_G) { p0_transpose_item(GP(A.in[I_WGATE + F.z]) + (size_t)l * DM * DFF, DM, DFF, 2, (bf16*)(wl + OFF_WGU), nullptr, scr, r, F.lane); continue; } r -= I_G;
        if (r < I_G) { p0_transpose_item(GP(A.in[I_WUP + F.z]) + (size_t)l * DM * DFF, DM, DFF, 3, (bf16*)(wl + OFF_WGU), nullptr, scr, r, F.lane); continue; } r -= I_G;
        if (r < I_D) { p0_transpose_item(GP(A.in[I_WDOWN + F.z]) + (size_t)l * DFF * DM, DFF, DM, 0, (bf16*)(wl + OFF_WDN), nullptr, scr, r, F.lane); continue; } r -= I_D;
        { bf16* w4t = (bf16*)(F.ws + WS_W4T) + (size_t)l * 4096 * KPAD;
          p0_transpose_item(GP(A.in[I_FW4 + F.z]) + (size_t)l * FHID * 4096, FHID, 4096, 4, w4t, nullptr, scr, r, F.lane);
          for (int e = F.lane; e < 32 * 24; e += 64) *(GAS v4u*)(w4t + (size_t)(32 * r + e / 24) * KPAD + 64 + 8 * (e % 24)) = (v4u){0u, 0u, 0u, 0u}; }
    }
    {
        float* cs = (float*)(F.ws + WS_ROPE);
        for (int e = F.vcu * NTHR + F.tid; e < SEQ * 32; e += F.G * NTHR) {
            const int t = e >> 5, p = e & 31;
            const double inv = exp(-9.210340371976184 * (double)(2 * p) / 64.0);
            float s, c; sincos_red((double)t * inv, s, c);
            cs[2 * e] = c; cs[2 * e + 1] = s;
        }
    }
    {
        bf16* h3b = (bf16*)(F.ws + WS_H3);
        LAS float* hb = (LAS float*)(F.lds + RING_OFF + F.wave * 16384);
        for (int task = gw; task < DEPTH * (SEQ / 64); task += NGW) {
            const int l = task / (SEQ / 64), t = (task % (SEQ / 64)) * 64 + F.lane;
            const float* w1 = GP(A.in[I_FW1 + F.z]) + (size_t)l * FEMB * FHID; const float* w2 = GP(A.in[I_FW2 + F.z]) + (size_t)l * FHID * FHID; const float* w3 = GP(A.in[I_FW3 + F.z]) + (size_t)l * FHID * FHID;
            hb[F.lane] = (float)t * (1.0f / (float)(SEQ - 1));
#pragma unroll 1
            for (int bi = 0; bi < 16; ++bi) { const double band = 1e-4 + (double)bi * ((15.0 - 1e-4) / 15.0);
                float s, c; sincos_red(6.283185307179586 * (double)t / (double)SEQ * band, s, c); hb[(1 + bi) * 64 + F.lane] = c; hb[(17 + bi) * 64 + F.lane] = -s; }
#pragma unroll 1
            for (int stage = 0; stage < 3; ++stage) {
                const float* w = stage == 0 ? w1 : (stage == 1 ? w2 : w3);
                const float* bb = (stage == 0 ? GP(A.in[I_FB1 + F.z]) : (stage == 1 ? GP(A.in[I_FB2 + F.z]) : GP(A.in[I_FB3 + F.z]))) + l * FHID;
                const float* ff = (stage == 0 ? GP(A.in[I_FF1 + F.z]) : (stage == 1 ? GP(A.in[I_FF2 + F.z]) : GP(A.in[I_FF3 + F.z]))) + l * FHID;
                const int nin = stage == 0 ? FEMB : FHID;
                typedef float f32x16_t __attribute__((ext_vector_type(16)));
                f32x16_t c0 = {}, c1 = {}, c2 = {}, c3 = {};
                LDS_WAIT();
#pragma unroll 1
                for (int i = 0; i < nin; ++i) { const float hv = hb[i * 64 + F.lane]; const f32x16_t* wr = (const f32x16_t*)(w + i * FHID);
                    c0 += wr[0] * hv; c1 += wr[1] * hv; c2 += wr[2] * hv; c3 += wr[3] * hv; }
                const f32x16_t* b16 = (const f32x16_t*)bb; const f32x16_t* f16 = (const f32x16_t*)ff;
                c0 = (c0 + b16[0]) * f16[0]; c1 = (c1 + b16[1]) * f16[1]; c2 = (c2 + b16[2]) * f16[2]; c3 = (c3 + b16[3]) * f16[3];
                if (stage < 2) {
#pragma unroll
                    for (int e = 0; e < 16; ++e) { hb[e * 64 + F.lane] = sinf(c0[e]); hb[(16 + e) * 64 + F.lane] = sinf(c1[e]); hb[(32 + e) * 64 + F.lane] = sinf(c2[e]); hb[(48 + e) * 64 + F.lane] = sinf(c3[e]); }
                } else {
                    GAS v4u* o = (GAS v4u*)(h3b + ((size_t)l * SEQ + t) * KPAD);
#pragma unroll
                    for (int q = 0; q < 2; ++q) { v4u w; w.x = pk2(sinf(c0[8 * q]), sinf(c0[8 * q + 1])); w.y = pk2(sinf(c0[8 * q + 2]), sinf(c0[8 * q + 3])); w.z = pk2(sinf(c0[8 * q + 4]), sinf(c0[8 * q + 5])); w.w = pk2(sinf(c0[8 * q + 6]), sinf(c0[8 * q + 7])); o[q] = w; }
#pragma unroll
                    for (int q = 0; q < 2; ++q) { v4u w; w.x = pk2(sinf(c1[8 * q]), sinf(c1[8 * q + 1])); w.y = pk2(sinf(c1[8 * q + 2]), sinf(c1[8 * q + 3])); w.z = pk2(sinf(c1[8 * q + 4]), sinf(c1[8 * q + 5])); w.w = pk2(sinf(c1[8 * q + 6]), sinf(c1[8 * q + 7])); o[2 + q] = w; }
#pragma unroll
                    for (int q = 0; q < 2; ++q) { v4u w; w.x = pk2(sinf(c2[8 * q]), sinf(c2[8 * q + 1])); w.y = pk2(sinf(c2[8 * q + 2]), sinf(c2[8 * q + 3])); w.z = pk2(sinf(c2[8 * q + 4]), sinf(c2[8 * q + 5])); w.w = pk2(sinf(c2[8 * q + 6]), sinf(c2[8 * q + 7])); o[4 + q] = w; }
#pragma unroll
                    for (int q = 0; q < 2; ++q) { v4u w; w.x = pk2(sinf(c3[8 * q]), sinf(c3[8 * q + 1])); w.y = pk2(sinf(c3[8 * q + 2]), sinf(c3[8 * q + 3])); w.z = pk2(sinf(c3[8 * q + 4]), sinf(c3[8 * q + 5])); w.w = pk2(sinf(c3[8 * q + 6]), sinf(c3[8 * q + 7])); o[6 + q] = w; }
#pragma unroll 1
                    for (int q = 8; q < 32; ++q) o[q] = (v4u){0u, 0u, 0u, 0u};
                }
            }
        }
    }
}
template <bool XSB>
__device__ __forceinline__ void norm_pass(Frame& F, const void* x_src, const bf16* add, const float* g_add, bf16* xb_dst, float* xf_dst, const float* g_out, bf16* h_dst) {
    const int gw = F.vcu * NWAVES + F.wave, NGW = F.G * NWAVES;
#define UNPK(q, lo, hi) do { lo = (f32x4){__uint_as_float((q).x << 16), __uint_as_float((q).x & 0xffff0000u), __uint_as_float((q).y << 16), __uint_as_float((q).y & 0xffff0000u)}; \
                             hi = (f32x4){__uint_as_float((q).z << 16), __uint_as_float((q).z & 0xffff0000u), __uint_as_float((q).w << 16), __uint_as_float((q).w & 0xffff0000u)}; } while (0)
#define PK8(lo, hi) (v4u){pk2((lo)[0], (lo)[1]), pk2((lo)[2], (lo)[3]), pk2((hi)[0], (hi)[1]), pk2((hi)[2], (hi)[3])}
    f32x4 gA[8], gO[8];
#pragma unroll
    for (int j = 0; j < 8; ++j) { gA[j] = (f32x4){0.f, 0.f, 0.f, 0.f}; gO[j] = (f32x4){0.f, 0.f, 0.f, 0.f}; }
    if (add) { const GAS f32x4* gr = (const GAS f32x4*)g_add + 2 * F.lane;
#pragma unroll
        for (int j = 0; j < 4; ++j) { gA[2 * j] = gr[128 * j]; gA[2 * j + 1] = gr[128 * j + 1]; } }
    if (h_dst) { const GAS f32x4* gr = (const GAS f32x4*)g_out + 2 * F.lane;
#pragma unroll
        for (int j = 0; j < 4; ++j) { gO[2 * j] = gr[128 * j]; gO[2 * j + 1] = gr[128 * j + 1]; } }
    for (int m0 = gw; m0 < MG; m0 += 2 * NGW) {
        const int m1 = m0 + NGW; const bool two = m1 < MG; const int mb = two ? m1 : m0;
        f32x4 va[8], vb[8];
        if (XSB) {
            const GAS v4u* xa = (const GAS v4u*)((const bf16*)x_src + (size_t)m0 * DM) + F.lane; const GAS v4u* xb = (const GAS v4u*)((const bf16*)x_src + (size_t)mb * DM) + F.lane;
            v4u qa[4], qb[4];
#pragma unroll
            for (int j = 0; j < 4; ++j) { qa[j] = xa[64 * j]; qb[j] = xb[64 * j]; }
#pragma unroll
            for (int j = 0; j < 4; ++j) { UNPK(qa[j], va[2 * j], va[2 * j + 1]); UNPK(qb[j], vb[2 * j], vb[2 * j + 1]); }
        } else {
            const GAS f32x4* xa = (const GAS f32x4*)((const float*)x_src + (size_t)m0 * DM) + 2 * F.lane; const GAS f32x4* xb = (const GAS f32x4*)((const float*)x_src + (size_t)mb * DM) + 2 * F.lane;
#pragma unroll
            for (int j = 0; j < 4; ++j) { va[2 * j] = xa[128 * j]; va[2 * j + 1] = xa[128 * j + 1]; vb[2 * j] = xb[128 * j]; vb[2 * j + 1] = xb[128 * j + 1]; }
        }
        if (add) {
            const GAS v4u* aa = (const GAS v4u*)(add + (size_t)m0 * DM) + F.lane; const GAS v4u* ab = (const GAS v4u*)(add + (size_t)mb * DM) + F.lane;
            v4u wa[4], wb[4];
#pragma unroll
            for (int j = 0; j < 4; ++j) { wa[j] = aa[64 * j]; wb[j] = ab[64 * j]; }
            float sa = 0.f, sb = 0.f;
#pragma unroll
            for (int j = 0; j < 4; ++j) { f32x4 a0, a1, b0, b1; UNPK(wa[j], a0, a1); UNPK(wb[j], b0, b1);
                sa += ((a0[0] * a0[0] + a0[1] * a0[1]) + (a0[2] * a0[2] + a0[3] * a0[3])) + ((a1[0] * a1[0] + a1[1] * a1[1]) + (a1[2] * a1[2] + a1[3] * a1[3]));
                sb += ((b0[0] * b0[0] + b0[1] * b0[1]) + (b0[2] * b0[2] + b0[3] * b0[3])) + ((b1[0] * b1[0] + b1[1] * b1[1]) + (b1[2] * b1[2] + b1[3] * b1[3])); }
            const float ra = 1.0f / sqrtf(wave_sum(sa) * (1.0f / DM) + EPS), rb = 1.0f / sqrtf(wave_sum(sb) * (1.0f / DM) + EPS);
#pragma unroll
            for (int j = 0; j < 4; ++j) { const f32x4 g0 = gA[2 * j], g1 = gA[2 * j + 1]; f32x4 a0, a1, b0, b1; UNPK(wa[j], a0, a1); UNPK(wb[j], b0, b1);
                va[2 * j] = va[2 * j] + a0 * ra * g0; va[2 * j + 1] = va[2 * j + 1] + a1 * ra * g1; vb[2 * j] = vb[2 * j] + b0 * rb * g0; vb[2 * j + 1] = vb[2 * j + 1] + b1 * rb * g1; }
        }
        if (xf_dst) { GAS f32x4* oa = (GAS f32x4*)(xf_dst + (size_t)m0 * DM) + 2 * F.lane; GAS f32x4* ob = (GAS f32x4*)(xf_dst + (size_t)mb * DM) + 2 * F.lane;
#pragma unroll
            for (int j = 0; j < 4; ++j) { oa[128 * j] = va[2 * j]; oa[128 * j + 1] = va[2 * j + 1]; if (two) { ob[128 * j] = vb[2 * j]; ob[128 * j + 1] = vb[2 * j + 1]; } } }
        if (xb_dst) { GAS v4u* oa = (GAS v4u*)(xb_dst + (size_t)m0 * DM) + F.lane; GAS v4u* ob = (GAS v4u*)(xb_dst + (size_t)mb * DM) + F.lane;
#pragma unroll
            for (int j = 0; j < 4; ++j) { const v4u w = PK8(va[2 * j], va[2 * j + 1]); oa[64 * j] = w;
                UNPK(w, va[2 * j], va[2 * j + 1]);
                const v4u w2 = PK8(vb[2 * j], vb[2 * j + 1]); if (two) ob[64 * j] = w2;
                UNPK(w2, vb[2 * j], vb[2 * j + 1]); } }
        if (h_dst) {
            float sa = 0.f, sb = 0.f;
#pragma unroll
            for (int j = 0; j < 8; ++j) { sa += (va[j][0] * va[j][0] + va[j][1] * va[j][1]) + (va[j][2] * va[j][2] + va[j][3] * va[j][3]); sb += (vb[j][0] * vb[j][0] + vb[j][1] * vb[j][1]) + (vb[j][2] * vb[j][2] + vb[j][3] * vb[j][3]); }
            const float ra = 1.0f / sqrtf(wave_sum(sa) * (1.0f / DM) + EPS), rb = 1.0f / sqrtf(wave_sum(sb) * (1.0f / DM) + EPS);
            GAS v4u* ha = (GAS v4u*)(h_dst + (size_t)m0 * DM) + F.lane; GAS v4u* hb2 = (GAS v4u*)(h_dst + (size_t)mb * DM) + F.lane;
#pragma unroll
            for (int j = 0; j < 4; ++j) { const f32x4 g0 = gO[2 * j], g1 = gO[2 * j + 1];
                const f32x4 oa0 = va[2 * j] * ra * g0, oa1 = va[2 * j + 1] * ra * g1, ob0 = vb[2 * j] * rb * g0, ob1 = vb[2 * j + 1] * rb * g1;
                ha[64 * j] = PK8(oa0, oa1);
                if (two) hb2[64 * j] = PK8(ob0, ob1); }
        }
    }
#undef UNPK
#undef PK8
}
typedef LAS cf* lcf;
template <bool ZUP> __device__ __forceinline__ void hy_fwd(lcf X, lcf thi, lcf tlo, int tid, const cf* KM) {
    if (ZUP) hy_pass16<1024, false, true, false>(X, thi, tlo, tid); else hy_pass16<1024, false, false, false>(X, thi, tlo, tid);
    __syncthreads();
    hy_pass16<64, false, false, false>(X, thi, tlo, tid);
    hy_pass16<4, false, false, false>(X, thi, tlo, tid);
    hy_pass4<false>(X, tid, KM); __syncthreads();
}
__device__ __forceinline__ void hy_inv(lcf X, lcf thi, lcf tlo, int tid) {
    const cf* nul = nullptr;
    hy_pass4<true>(X, tid, nul); __syncthreads();
    hy_pass16<4, true, false, false>(X, thi, tlo, tid); __syncthreads();
    hy_pass16<64, true, false, false>(X, thi, tlo, tid); __syncthreads();
    hy_pass16<1024, true, false, true>(X, thi, tlo, tid); __syncthreads();
}
__device__ __forceinline__ void hy_mid(lcf X, lcf thi, lcf tlo, int tid, const cf* KM) {
    const cf* nul = nullptr;
    hy_pass16<64, false, false, false>(X, thi, tlo, tid);
    hy_pass16<4, false, false, false>(X, thi, tlo, tid);
    hy_pass4<false>(X, tid, KM);
    hy_pass4<true>(X, tid, nul);
    hy_pass16<4, true, false, false>(X, thi, tlo, tid);
    hy_pass16<64, true, false, false>(X, thi, tlo, tid); __syncthreads();
}
__device__ __forceinline__ void hyena_phase(Frame& F, const Args& A, int l) {
    lcf X = (lcf)(F.lds + RING_OFF); lcf thi = (lcf)(F.lds + TAB_OFF); lcf tlo = thi + 128;
    const int tid = F.tid;
    if (tid < 256) { const int a = tid & 127; const double ang = -6.283185307179586 * (double)(tid < 128 ? 128 * a : a) / (double)FN; float s, c; sincos_red(ang, s, c); (tid < 128 ? thi : tlo)[a] = cf{c, s}; }
    cf* K1g = (cf*)(F.ws + WS_FFTK) + (size_t)F.bx * 2 * FN; cf* K2g = K1g + FN;
    const bf16* taps = (const bf16*)(F.ws + ((A.taps_all && l > 0) ? WS_TAPS_X + (size_t)(l - 1) * SZ_TAPS : WS_TAPS));
    const float* cw = GP(A.in[I_CONVW + F.z]) + (size_t)l * 3 * HYIN; const float* cb = GP(A.in[I_CONVB + F.z]) + (size_t)l * HYIN; const float* hb = GP(A.in[I_HBIAS + F.z]) + (size_t)l * 2 * HYW;
    const bf16* projT = (const bf16*)(F.ws + WS_PROJT); bf16* zT = (bf16*)(F.ws + WS_ZT);
    for (int c = F.vcu; c < HYW; c += F.G) {
        __syncthreads();
        const float delta = fabsf(-15.350567286626973f + (float)c * ((-3.0701134573253945f + 15.350567286626973f) / 1023.0f));
#define TIDX(v) int v = tid; asm volatile("" : "+v"(v))
        { TIDX(t_); hy_filter_step(X, taps + (size_t)c * SEQ, delta, t_); }
        const unsigned* rx1 = (const unsigned*)(projT + (size_t)c * MG); const unsigned* rx2 = (const unsigned*)(projT + (size_t)(HYW + c) * MG); const unsigned* rv = (const unsigned*)(projT + (size_t)(2 * HYW + c) * MG);
        HyRaw R;
        { TIDX(t_); hy_raw_load(R, rv, rv + SEQ / 2, t_); }
        __syncthreads();
        { TIDX(t_); hy_fwd<false>(X, thi, tlo, t_, nullptr); }
        { TIDX(t_); hy_sep_step(X, K1g, K2g, t_); }
        asm volatile("s_waitcnt vmcnt(0)" ::: "memory"); __syncthreads();
        cf zr[2][8];
        { TIDX(t_); hy_convA_fwd(X, thi, tlo, t_, R, cw[2 * HYW + c], cw[HYIN + 2 * HYW + c], cw[2 * HYIN + 2 * HYW + c], cb[2 * HYW + c], zr); }
        { TIDX(t_); hy_raw_load(R, rx1, rx1 + SEQ / 2, t_); }
        __syncthreads();
        { TIDX(t_); hy_mid(X, thi, tlo, t_, K1g); }
        { TIDX(t_); hy_gateA<false>(X, thi, tlo, t_, R, cw[c], cw[HYIN + c], cw[2 * HYIN + c], cb[c], hb[c], zr, (unsigned short*)nullptr, (unsigned short*)nullptr); }
        { TIDX(t_); hy_raw_load(R, rx2, rx2 + SEQ / 2, t_); }
        __syncthreads();
        { TIDX(t_); hy_mid(X, thi, tlo, t_, K2g); }
        unsigned short* zo = (unsigned short*)(zT + (size_t)c * MG);
        { TIDX(t_); hy_gateA<true>(X, thi, tlo, t_, R, cw[HYW + c], cw[HYIN + HYW + c], cw[2 * HYIN + HYW + c], cb[HYW + c], hb[HYW + c], zr, zo, zo + SEQ); }
#undef TIDX
    }
    __syncthreads();
}
__device__ __forceinline__ void hynorm_phase(Frame& F, const Args& A, int l) {
    constexpr int TB = 64;
    LAS unsigned char* tile = F.lds + RING_OFF; LAS float* red = (LAS float*)(F.lds + RING_OFF + TB * HYW * 2); LAS float* rinv = red + 8 * TB;
    const bf16* zT = (const bf16*)(F.ws + WS_ZT); bf16* mixin = (bf16*)(F.ws + WS_MIXIN); const float* gn = GP(A.in[I_HNORM + F.z]) + (size_t)l * HYW;
    const int tid = F.tid;
    for (int tb = F.vcu; tb < MG / TB; tb += F.G) {
        const int t0 = tb * TB; __syncthreads();
        float ps[8];
#pragma unroll
        for (int i = 0; i < 8; ++i) ps[i] = 0.f;
        const int k = tid & 7, crow = tid >> 3;
#pragma unroll
        for (int hb = 0; hb < 2; ++hb) {
            v4u w[8];
#pragma unroll
            for (int it = 0; it < 8; ++it) { const unsigned c = (unsigned)((hb * 8 + it) * 64 + crow) & 1023u; w[it] = *(const GAS v4u*)(zT + (size_t)c * MG + (unsigned)(t0 + 8 * k)); }
#pragma unroll
            for (int it = 0; it < 8; ++it) { const int c = (hb * 8 + it) * 64 + crow;
                LAS unsigned short* d = (LAS unsigned short*)(tile + (8 * k) * 2048 + (((c >> 3) ^ k) << 4) + (c & 7) * 2);
                const unsigned ww[4] = {w[it].x, w[it].y, w[it].z, w[it].w};
#pragma unroll
                for (int i = 0; i < 4; ++i) { d[(2 * i) * 1024] = (unsigned short)(ww[i] & 0xffffu); d[(2 * i + 1) * 1024] = (unsigned short)(ww[i] >> 16);
                    const float a = __uint_as_float(ww[i] << 16), b = __uint_as_float(ww[i] & 0xffff0000u); ps[2 * i] += a * a; ps[2 * i + 1] += b * b; } }
        }
#pragma unroll
        for (int i = 0; i < 8; ++i) { float v = ps[i]; v += swz_xor<8>(v); v += swz_xor<16>(v);
            auto rr = __builtin_amdgcn_permlane32_swap(__float_as_uint(v), __float_as_uint(v), false, false); ps[i] = __uint_as_float(rr[0]) + __uint_as_float(rr[1]); }
        if ((F.lane >> 3) == 0) {
#pragma unroll
            for (int i = 0; i < 8; ++i) red[F.wave * TB + 8 * k + i] = ps[i]; }
        __syncthreads();
        if (tid < TB) { float s = 0.f;
#pragma unroll
            for (int w8 = 0; w8 < 8; ++w8) s += red[w8 * TB + tid];
            rinv[tid] = 1.0f / sqrtf(s * (1.0f / HYW) + EPS); }
        __syncthreads();
        const int cg = tid & 127;
        const f32x4 g0 = *(const f32x4*)(gn + 8 * cg), g1 = *(const f32x4*)(gn + 8 * cg + 4);
#pragma unroll 4
        for (int it = 0; it < 16; ++it) { const int tok = it * 4 + (tid >> 7); const float r = rinv[tok];
            const v4u q = *(const LAS v4u*)(tile + tok * 2048 + ((cg ^ (tok >> 3)) << 4));
            v4u o; o.x = pk2(__uint_as_float(q.x << 16) * r * g0[0], __uint_as_float(q.x & 0xffff0000u) * r * g0[1]); o.y = pk2(__uint_as_float(q.y << 16) * r * g0[2], __uint_as_float(q.y & 0xffff0000u) * r * g0[3]);
            o.z = pk2(__uint_as_float(q.z << 16) * r * g1[0], __uint_as_float(q.z & 0xffff0000u) * r * g1[1]); o.w = pk2(__uint_as_float(q.w << 16) * r * g1[2], __uint_as_float(q.w & 0xffff0000u) * r * g1[3]);
            *(GAS v4u*)(mixin + (size_t)(t0 + tok) * DM + 8 * cg) = o; }
    }
    __syncthreads();
}
__device__ __forceinline__ void attn_phase(Frame& F, const Args& A, int l, unsigned char* lds_generic) {
    const float li = 0.8f - 0.6f * expf(-0.3f * (float)l);
    float lam;
    { const int j = F.lane; const float a = GP(A.in[I_LQ1 + F.z])[l * 64 + j] * GP(A.in[I_LK1 + F.z])[l * 64 + j], b = GP(A.in[I_LQ2 + F.z])[l * 64 + j] * GP(A.in[I_LK2 + F.z])[l * 64 + j];
      lam = expf(wave_sum(a)) - expf(wave_sum(b)) + li; }
    const att::bf16* qkv = (const att::bf16*)(F.ws + WS_QKV); att::bf16* mixin = (att::bf16*)(F.ws + WS_MIXIN);
    float* stash = (float*)(F.ws + WS_H) + (size_t)F.bx * 64 * 512;
    const float* subln = GP(A.in[I_SUBLN + F.z]) + (size_t)l * 128;
    constexpr int NU = GSEQ * 8 * (SEQ / 256);
    for (int u = F.vcu; u < NU; u += F.G) {
        const int bvh = u >> 5, qb = u & 31, b = bvh >> 3, vh = bvh & 7;
        const long krow0 = (long)b * SEQ, qrow0 = krow0 + qb * 256;
        att::attn_unit(qkv, qrow0, krow0, vh, SEQ, lam, 1.0f - li, subln, mixin + (size_t)qrow0 * DM + HYW + vh * 128, DM, stash, (char*)lds_generic);
        __syncthreads();
    }
}
#ifndef PHMASK
#define PHMASK 511
#endif
__global__ void __launch_bounds__(NTHR, 2) hymba_fwd(Args args) {
    extern __shared__ __attribute__((aligned(16))) unsigned char lds[];
    Frame F;
    F.lds = (LAS unsigned char*)lds; F.MISC = (volatile LAS unsigned*)(F.lds + MISC_OFF);
    F.tid = threadIdx.x; F.lane = F.tid & 63; F.wave = __builtin_amdgcn_readfirstlane(F.tid >> 6);
    F.G = gridDim.x; { const int bx = blockIdx.x; F.vcu = (F.G % 8 == 0) ? (bx % 8) * (F.G / 8) + bx / 8 : bx; F.bx = bx; }
    F.vcu0 = F.vcu; F.G0 = F.G; F.bx0 = F.bx;
    F.ctl = (gu32*)(args.ws + WS_CTL); F.out = args.out; F.ws = args.ws; F.ws0 = args.ws; F.z = 0;
    for (int u = F.tid; u < (LDS_BYTES - MISC_OFF) / 4; u += NTHR) ((LAS unsigned*)(F.lds + MISC_OFF))[u] = 0u;
    __syncthreads();
    XcdBarrier bar; bar.bar = (unsigned*)(F.ctl + CW_BAR); bar.x = 0; bar.st = nullptr;
    if (!MK_PER_PHASE) bar = xcd_barrier_post((unsigned*)(F.ctl + CW_BAR), F.MISC + 8);
    const int lo = args.ph_lo, hi = args.ph_hi;
    int ph = 0;
#define IN_() (lo <= ph && ph < hi && ({ LAUNDER_TID(F); true; }))
#define DUP3(...) do { __VA_ARGS__; if (PROBE_DUP == 3) { __VA_ARGS__; } } while (0)
#define SEAM() do { if (!MK_PER_PHASE && lo <= ph && ph + 1 < hi) { XcdBarrier b_ = bar; { unsigned long long p_ = (unsigned long long)b_.bar; unsigned x_ = b_.x; asm volatile("" : "+s"(p_), "+s"(x_)); b_.bar = (unsigned*)(GAS unsigned*)p_; b_.x = x_; } \
        xcd_barrier(b_); if (PROBE_DUP == 7) xcd_barrier(b_); } ++ph; } while (0)
    if ((PHMASK & 1) && IN_()) { p0_prologue(F, args); if (PROBE_DUP == 4) p0_prologue(F, args); }
    SEAM();
#define Hb ((bf16*)(F.ws + WS_H))
#define XB ((bf16*)(F.ws + WS_XB))
#define projT ((bf16*)(F.ws + WS_PROJT))
#define qkv ((bf16*)(F.ws + WS_QKV))
#define mix ((bf16*)(F.ws + WS_MIX))
#define ffh ((bf16*)(F.ws + WS_FFH))
#define mixin ((bf16*)(F.ws + WS_MIXIN))
#define wl (F.ws + WS_W + (size_t)l * SZ_WLAYER)
#define xin ((g == 0) ? GP(args.in[I_XP + F.z]) : GP(args.in[I_XS + F.z]) + (size_t)(g - 1) * MG * DM)
#define xres ((float*)(GAS float*)args.out + (size_t)g * MG * DM)
    for (int g = 0; g < NGRP; ++g) {
        if ((PHMASK & 2) && IN_()) norm_pass<false>(F, xin, nullptr, nullptr, nullptr, nullptr, GP(args.in[I_GMPRE + F.z]), Hb);
        SEAM();
        for (int l = 0; l < DEPTH; ++l) {
            if ((PHMASK & 4) && IN_()) {
                { pg8::Gemm gm{(const bf16*)(wl + OFF_WHY), Hb, HYIN, MG, DM}; pg8::StaticOrder S; S.init(HYIN, MG, F.G, F.bx);
                  pg8::EpiPlain E{projT, MG};
                  DUP3(pg8::gemm_phase<pg8::EpiPlain, pg8::StaticOrder, true, true>(F.lds + RING_OFF, gm, S, E)); }
                if (g == 0 || !args.taps_all) { pg8::Gemm gm{(const bf16*)(F.ws + WS_W4T) + (size_t)l * 4096 * KPAD, (const bf16*)(F.ws + WS_H3) + (size_t)l * SEQ * KPAD, 4096, SEQ, KPAD}; pg8::StaticOrder S; S.init(4096, SEQ, F.G, F.bx);
                  pg8::EpiPlain E{(bf16*)(F.ws + ((args.taps_all && l > 0) ? WS_TAPS_X + (size_t)(l - 1) * SZ_TAPS : WS_TAPS)), SEQ};
                  DUP3(pg8::gemm_phase<pg8::EpiPlain, pg8::StaticOrder, true, true>(F.lds + RING_OFF, gm, S, E)); }
                { pg8::Gemm gm{Hb, (const bf16*)(wl + OFF_WQKV), MG, QKVW, DM}; pg8::StaticOrder S; S.init(MG, QKVW, F.G, F.bx);
                  pg8::EpiRope E{qkv, QKVW, (const float*)(F.ws + WS_ROPE), QSCALE};
                  DUP3(pg8::gemm_phase<pg8::EpiRope, pg8::StaticOrder, true, true>(F.lds + RING_OFF, gm, S, E)); }
            }
            SEAM();
            if (IN_()) { if (PHMASK & 8) hyena_phase(F, args, l); if (PROBE_DUP == 2) hyena_phase(F, args, l); if (PHMASK & 16) attn_phase(F, args, l, lds); if (PROBE_DUP == 1) attn_phase(F, args, l, lds); }
            SEAM();
            if ((PHMASK & 32) && IN_()) { hynorm_phase(F, args, l); if (PROBE_DUP == 4) hynorm_phase(F, args, l); }
            SEAM();
            if ((PHMASK & 64) && IN_()) { pg8::Gemm gm{mixin, (const bf16*)(wl + OFF_WOUT), MG, DM, DM}; pg8::StaticOrder S; S.init(MG, DM, F.G, F.bx);
                pg8::EpiPlain E{mix, DM};
                DUP3(pg8::gemm_phase<pg8::EpiPlain, pg8::StaticOrder, true, true>(F.lds + RING_OFF, gm, S, E)); }
            SEAM();
            if ((PHMASK & 2) && IN_()) { if (l == 0) norm_pass<false>(F, xin, mix, GP(args.in[I_GMPOST + F.z]) + (size_t)l * DM, XB, nullptr, GP(args.in[I_GFPRE + F.z]) + (size_t)l * DM, Hb);
                else norm_pass<true>(F, XB, mix, GP(args.in[I_GMPOST + F.z]) + (size_t)l * DM, XB, nullptr, GP(args.in[I_GFPRE + F.z]) + (size_t)l * DM, Hb); }
            SEAM();
            if ((PHMASK & 128) && IN_()) { pg8::Gemm gm{Hb, (const bf16*)(wl + OFF_WGU), MG, GU, DM}; pg8::StaticOrder S; S.init(MG, GU, F.G, F.bx);
                pg8::EpiSwiGLU E{ffh, DFF};
                DUP3(pg8::gemm_phase<pg8::EpiSwiGLU, pg8::StaticOrder, true, true>(F.lds + RING_OFF, gm, S, E)); }
            SEAM();
            if ((PHMASK & 256) && IN_()) { pg8::Gemm gm{ffh, (const bf16*)(wl + OFF_WDN), MG, DM, DFF}; pg8::StaticOrder S; S.init(MG, DM, F.G, F.bx);
                pg8::EpiPlain E{mixin, DM};
                DUP3(pg8::gemm_phase<pg8::EpiPlain, pg8::StaticOrder, true, true>(F.lds + RING_OFF, gm, S, E)); }
            SEAM();
            if ((PHMASK & 2) && IN_()) { if (l + 1 < DEPTH) norm_pass<true>(F, XB, mixin, GP(args.in[I_GFPOST + F.z]) + (size_t)l * DM, XB, nullptr, GP(args.in[I_GMPRE + F.z]) + (size_t)(l + 1) * DM, Hb);
                else norm_pass<true>(F, XB, mixin, GP(args.in[I_GFPOST + F.z]) + (size_t)l * DM, nullptr, xres, nullptr, nullptr); }
            SEAM();
        }
    }
#undef IN_
#undef SEAM
#undef Hb
#undef XB
#undef projT
#undef qkv
#undef mix
#undef ffh
#undef mixin
#undef wl
#undef xin
#undef xres
}

extern "C" void kernel_launch(void* const* d_in, const int* in_sizes, int n_in, void* d_out, int out_size, void* d_ws, size_t ws_size, hipStream_t stream) {
    static int grid = 0;
    if (grid == 0) {
        if (n_in != 30 || in_sizes[0] != 2 * SEQ * DM || in_sizes[1] != 4 * SEQ * DM || out_size != NSEQ * SEQ * DM || ws_size < WS_END) {
            fprintf(stderr, "kernel_launch: shape mismatch (n_in %d, out %d, ws %zu, need %zu)\n", n_in, out_size, ws_size, (size_t)WS_END); grid = -1; return; }
        int dev = 0, cus = 0;
        if (hipGetDevice(&dev) != hipSuccess || hipDeviceGetAttribute(&cus, hipDeviceAttributeMultiprocessorCount, dev) != hipSuccess) { grid = -1; return; }
        if (hipFuncSetAttribute((const void*)hymba_fwd, hipFuncAttributeMaxDynamicSharedMemorySize, LDS_BYTES) != hipSuccess) { fprintf(stderr, "kernel_launch: hipFuncSetAttribute failed\n"); grid = -1; return; }
        int per_cu = 0;
        if (hipOccupancyMaxActiveBlocksPerMultiprocessor(&per_cu, (const void*)hymba_fwd, NTHR, LDS_BYTES) != hipSuccess || per_cu < 1) fprintf(stderr, "kernel_launch: occupancy query says %d\n", per_cu);
        (void)hipGetLastError();
        grid = cus;
    }
    if (grid < 0) return;
    if (hipMemsetAsync((char*)d_ws + WS_CTL, 0, CTL_ZERO_BYTES, stream) != hipSuccess) return;
    Args a{};
    for (int i = 0; i < 30; ++i) a.in[i] = (const float*)d_in[i];
    a.out = (float*)d_out; a.ws = (unsigned char*)d_ws; a.taps_all = (ws_size >= WS_END_X) ? 1 : 0;
#if MK_PER_PHASE
    for (int p = 0; p < NPHASE; ++p) { a.ph_lo = p; a.ph_hi = p + 1; hipLaunchKernelGGL(hymba_fwd, dim3(grid), dim3(NTHR), LDS_BYTES, stream, a); }
#else
    a.ph_lo = 0; a.ph_hi = NPHASE;
    hipLaunchKernelGGL(hymba_fwd, dim3(grid), dim3(NTHR), LDS_BYTES, stream, a);
#endif
    const hipError_t le = hipPeekAtLastError();
    if (le != hipSuccess) fprintf(stderr, "kernel_launch: launch failed: %s\n", hipGetErrorName(le));
}
```

```cpp
#include <hip/hip_runtime.h>
#include <hip/hip_bf16.h>
#include <cstdio>
#include <cstdint>
#include <cmath>
namespace pg8 {
#define PG8_LAS __attribute__((address_space(3)))
typedef unsigned short bf16_t;
typedef short bf16x8 __attribute__((ext_vector_type(8)));
typedef float f32x4 __attribute__((ext_vector_type(4)));
typedef unsigned u32x4 __attribute__((ext_vector_type(4)));
constexpr int BM = 256, BK = 64, HALF = 128, HTB = HALF * BK * 2  , STAGE_BYTES = 8 * HTB, NXCD = 8, WGM = 8;

__host__ __device__ __forceinline__ int lds_byte(int r, int c) { const int st = (r >> 4) * 2 + (c >> 5), rr = r & 15, cc = c & 31, ob = rr * 64 + cc * 2; return st * 1024 + (ob ^ (((ob >> 9) & 1) << 5)); }
__host__ __device__ __forceinline__ void stage_rc(int b, int& R, int& C) { const int st = b / 1024, sb = b % 1024, swz = sb ^ (((sb >> 9) & 1) << 5); R = (st >> 1) * 16 + swz / 64; C = (st & 1) * 32 + (swz % 64) / 2; }
__host__ __device__ __forceinline__ int perm32(int rho) { const int n = rho >> 4, i = rho & 15; return 8 * (i >> 2) + 4 * n + (i & 3); }

struct Unit { int pm, pn; };
struct Gemm { const bf16_t* A; const bf16_t* Bt; int M, N, K; };

struct StaticOrder {
    int nM, nN, nwg, G, c;
    __host__ __device__ void init(int M, int N, int G_, int c_) { nM = M / BM; nN = N / BM; nwg = nM * nN; G = G_; c = c_; }
    __host__ __device__ bool next(int i, Unit& u) const {
        const long L = (long)i * G + c; if (L >= nwg) return false;
        int wgid = (int)L; { const int q = nwg / NXCD, r = nwg % NXCD, xcd = wgid % NXCD, off = wgid / NXCD; wgid = (xcd < r ? xcd * (q + 1) : r * (q + 1) + (xcd - r) * q) + off; }
        const int nig = WGM * nN, gid = wgid / nig, fm = gid * WGM, gsz = (nM - fm) < WGM ? (nM - fm) : WGM;
        u.pm = fm + ((wgid % nig) % gsz); u.pn = (wgid % nig) / gsz; return true;
    }
    __device__ __forceinline__ void a_ready(const Unit&) const {}
    __device__ __forceinline__ void done(const Unit&) const {}
};

__device__ __forceinline__ unsigned cvt_pk_bf16(float lo, float hi) { unsigned r; asm volatile("v_cvt_pk_bf16_f32 %0, %1, %2" : "=v"(r) : "v"(lo), "v"(hi)); return r; }
typedef float f32x2 __attribute__((ext_vector_type(2)));
struct EpiPlain {
    static constexpr bool PERM = true, AFTER_DRAIN = false;
    bf16_t* O; int ldc;
    __device__ __forceinline__ void operator()(const f32x4 (&acc)[2][2][4][2], const Unit& u, int wr, int wc, int fr, int fq) const {
        const int row0 = u.pm * BM + wr * 64 + fr, col0 = u.pn * BM + wc * 32 + 8 * fq;
#pragma unroll
        for (int ai = 0; ai < 2; ++ai)
#pragma unroll
            for (int m = 0; m < 4; ++m) { bf16_t* rowp = O + (size_t)(row0 + ai * HALF + m * 16) * ldc + col0;
#pragma unroll
                for (int bj = 0; bj < 2; ++bj) { const f32x4 v0 = acc[ai][bj][m][0], v1 = acc[ai][bj][m][1];
                    u32x4 w; w.x = cvt_pk_bf16(v0[0], v0[1]); w.y = cvt_pk_bf16(v0[2], v0[3]); w.z = cvt_pk_bf16(v1[0], v1[1]); w.w = cvt_pk_bf16(v1[2], v1[3]);
                    *(u32x4*)(rowp + bj * HALF) = w; } }
    }
};
struct EpiRope {
    static constexpr bool PERM = true, AFTER_DRAIN = false;
    bf16_t* O; int ldc; const float* cs; float qscale;
    __device__ __forceinline__ void operator()(const f32x4 (&acc)[2][2][4][2], const Unit& u, int wr, int wc, int fr, int fq) const {
        const int row0 = u.pm * BM + wr * 64 + fr, col0 = u.pn * BM + wc * 32 + 8 * fq;
        const bool rope = u.pn < 8; const float sc = u.pn < 4 ? qscale : 1.0f;
        const int p0 = 16 * (wc & 1) + 4 * fq;
        f32x4 tt[2][4][2];
#pragma unroll
        for (int ai = 0; ai < 2; ++ai)
#pragma unroll
            for (int m = 0; m < 4; ++m) { tt[ai][m][0] = (f32x4){1.f, 0.f, 1.f, 0.f}; tt[ai][m][1] = (f32x4){1.f, 0.f, 1.f, 0.f};
                if (rope) { const int row = row0 + ai * HALF + m * 16; const __attribute__((address_space(1))) float* tp = (const __attribute__((address_space(1))) float*)cs + ((size_t)(row & 8191) * 32 + p0) * 2;
                    tt[ai][m][0] = *(const __attribute__((address_space(1))) f32x4*)tp; tt[ai][m][1] = *(const __attribute__((address_space(1))) f32x4*)(tp + 4); } }
#pragma unroll
        for (int ai = 0; ai < 2; ++ai)
#pragma unroll
            for (int m = 0; m < 4; ++m) { const int row = row0 + ai * HALF + m * 16; bf16_t* rowp = O + (size_t)row * ldc + col0;
                const f32x4 t0 = tt[ai][m][0], t1 = tt[ai][m][1];
#pragma unroll
                for (int bj = 0; bj < 2; ++bj) { const f32x4 v0 = acc[ai][bj][m][0], v1 = acc[ai][bj][m][1];
                    f32x4 o0, o1;
                    o0[0] = (v0[0] * t0[0] - v0[1] * t0[1]) * sc; o0[1] = (v0[0] * t0[1] + v0[1] * t0[0]) * sc;
                    o0[2] = (v0[2] * t0[2] - v0[3] * t0[3]) * sc; o0[3] = (v0[2] * t0[3] + v0[3] * t0[2]) * sc;
                    o1[0] = (v1[0] * t1[0] - v1[1] * t1[1]) * sc; o1[1] = (v1[0] * t1[1] + v1[1] * t1[0]) * sc;
                    o1[2] = (v1[2] * t1[2] - v1[3] * t1[3]) * sc; o1[3] = (v1[2] * t1[3] + v1[3] * t1[2]) * sc;
                    u32x4 w; w.x = cvt_pk_bf16(o0[0], o0[1]); w.y = cvt_pk_bf16(o0[2], o0[3]); w.z = cvt_pk_bf16(o1[0], o1[1]); w.w = cvt_pk_bf16(o1[2], o1[3]);
                    *(u32x4*)(rowp + bj * HALF) = w; } }
    }
};
struct EpiSwiGLU {
    static constexpr bool PERM = true, AFTER_DRAIN = false;
    bf16_t* O; int ldc;
    static __device__ __forceinline__ float silu_mul(float g, float u) { return g * u * __builtin_amdgcn_rcpf(1.0f + __builtin_amdgcn_exp2f(-1.4426950408889634f * g)); }
    __device__ __forceinline__ void operator()(const f32x4 (&acc)[2][2][4][2], const Unit& u, int wr, int wc, int fr, int fq) const {
        const int row0 = u.pm * BM + wr * 64 + fr, col0 = u.pn * HALF + wc * 32 + 8 * fq;
#pragma unroll
        for (int ai = 0; ai < 2; ++ai)
#pragma unroll
            for (int m = 0; m < 4; ++m) { bf16_t* rowp = O + (size_t)(row0 + ai * HALF + m * 16) * ldc + col0;
                const f32x4 g0 = acc[ai][0][m][0], g1 = acc[ai][0][m][1], u0 = acc[ai][1][m][0], u1 = acc[ai][1][m][1];
                u32x4 w; w.x = cvt_pk_bf16(silu_mul(g0[0], u0[0]), silu_mul(g0[1], u0[1])); w.y = cvt_pk_bf16(silu_mul(g0[2], u0[2]), silu_mul(g0[3], u0[3]));
                w.z = cvt_pk_bf16(silu_mul(g1[0], u1[0]), silu_mul(g1[1], u1[1])); w.w = cvt_pk_bf16(silu_mul(g1[2], u1[2]), silu_mul(g1[3], u1[3]));
                *(u32x4*)rowp = w; }
    }
};
template <class Epi, class Sched, bool ALIGN_EPI = false, bool SP2 = false>
__device__ __forceinline__ void gemm_phase(PG8_LAS unsigned char* lds, const Gemm g, const Sched& S, const Epi& E) {
    int tid = threadIdx.x; asm volatile("" : "+v"(tid));
    const int wid = __builtin_amdgcn_readfirstlane(tid >> 6), lane = tid & 63, wr = wid >> 2, wc = wid & 3, fr = lane & 15, fq = lane >> 4;
    const int K = g.K, nt = K / BK;
    unsigned voffA[2], voffB[2];
#pragma unroll
    for (int i = 0; i < 2; ++i) { int R, C; stage_rc(tid * 16 + i * 8192, R, C); const int Rb = Epi::PERM ? ((R & ~31) + perm32(R & 31)) : R;
        voffA[i] = (unsigned)(R * K + C) * 2u; voffB[i] = (unsigned)(Rb * K + C) * 2u; }
    const size_t kstep = (size_t)(BK * 2);
    const size_t hstep = (size_t)HALF * K * 2;
    const size_t tstep = 2 * hstep;
    const unsigned ldsw = (unsigned)wid * 1024u;
    const int aoff = lds_byte(wr * 64 + fr, fq * 8), boff = lds_byte(wc * 32 + fr, fq * 8);
#define PG8_SA(b, h) (((b) * 2 + (h)) * HTB)
#define PG8_SB(b, h) ((4 + (b) * 2 + (h)) * HTB)
#define PG8_STAGE(bufoff, gbase, voff) do { _Pragma("unroll") for (int _i = 0; _i < 2; ++_i) \
        __builtin_amdgcn_global_load_lds((const unsigned*)((const char*)(gbase) + (voff)[_i]), (PG8_LAS unsigned*)(lds + (bufoff) + ldsw + _i * 8192), 16, 0, 0); } while (0)
#define PG8_LDA(dst, b, h) do { _Pragma("unroll") for (int m = 0; m < 4; ++m) _Pragma("unroll") for (int k = 0; k < 2; ++k) dst[m][k] = *(const PG8_LAS bf16x8*)(lds + PG8_SA(b, h) + aoff + m * 2048 + k * 1024); } while (0)
#define PG8_LDB(dst, b, h) do { _Pragma("unroll") for (int n = 0; n < 2; ++n) _Pragma("unroll") for (int k = 0; k < 2; ++k) dst[n][k] = *(const PG8_LAS bf16x8*)(lds + PG8_SB(b, h) + boff + n * 2048 + k * 1024); } while (0)
#define PG8_MMA(ai, bj, At, Bt) do { __builtin_amdgcn_s_setprio(1); _Pragma("unroll") for (int m = 0; m < 4; ++m) _Pragma("unroll") for (int n = 0; n < 2; ++n) _Pragma("unroll") for (int k = 0; k < 2; ++k) \
        acc[ai][bj][m][n] = __builtin_amdgcn_mfma_f32_16x16x32_bf16(Bt[n][k], At[m][k], acc[ai][bj][m][n], 0, 0, 0); __builtin_amdgcn_s_setprio(0); } while (0)
#define PG8_WAIT_V(n) asm volatile("s_waitcnt vmcnt(" #n ")" ::: "memory")
#define PG8_WAIT_L(n) asm volatile("s_waitcnt lgkmcnt(" #n ")" ::: "memory")
#define PG8_BAR __builtin_amdgcn_s_barrier()
#define PG8_SCHED __builtin_amdgcn_sched_barrier(0)
    Unit cur, nxt; int ui = 0;
    if (!S.next(0, cur)) return;
    f32x4 acc[2][2][4][2];
#pragma unroll
    for (int a = 0; a < 2; ++a)
#pragma unroll
        for (int b = 0; b < 2; ++b)
#pragma unroll
            for (int m = 0; m < 4; ++m)
#pragma unroll
                for (int n = 0; n < 2; ++n) acc[a][b][m][n] = (f32x4){0.f, 0.f, 0.f, 0.f};
    bf16x8 At[4][2], B0[2][2], B1[2][2];
    const char* cA = (const char*)g.A + (size_t)cur.pm * tstep; const char* cB = (const char*)g.Bt + (size_t)cur.pn * tstep;
    S.a_ready(cur);
    if constexpr (SP2) {
        PG8_STAGE(PG8_SB(0, 0), cB, voffB); PG8_STAGE(PG8_SB(0, 1), cB + hstep, voffB); PG8_STAGE(PG8_SA(0, 0), cA, voffA); PG8_STAGE(PG8_SA(0, 1), cA + hstep, voffA);
        if (wr == 1) PG8_BAR;
        PG8_WAIT_V(2); PG8_BAR;
        PG8_STAGE(PG8_SB(1, 0), cB + kstep, voffB); PG8_STAGE(PG8_SA(1, 0), cA + kstep, voffA); PG8_STAGE(PG8_SB(1, 1), cB + hstep + kstep, voffB);
        PG8_WAIT_V(6); PG8_BAR;
    } else {
        PG8_STAGE(PG8_SB(0, 0), cB, voffB); PG8_STAGE(PG8_SA(0, 0), cA, voffA); PG8_STAGE(PG8_SB(0, 1), cB + hstep, voffB); PG8_STAGE(PG8_SA(0, 1), cA + hstep, voffA);
        if (wr == 1) PG8_BAR;
        PG8_WAIT_V(4); PG8_BAR;
        PG8_STAGE(PG8_SB(1, 0), cB + kstep, voffB); PG8_STAGE(PG8_SA(1, 0), cA + kstep, voffA); PG8_STAGE(PG8_SB(1, 1), cB + hstep + kstep, voffB);
        PG8_WAIT_V(6); PG8_BAR;
    }
    for (;;) {
        const bool has_next = S.next(ui + 1, nxt);
        const char* nA = has_next ? (const char*)g.A + (size_t)nxt.pm * tstep : cA; const char* nB = has_next ? (const char*)g.Bt + (size_t)nxt.pn * tstep : cB;
        for (int t = 0; t < nt; t += 2) {
            const bool last = (t == nt - 2);
            const char* a1 = cA + (size_t)(t + 1) * kstep;
            const char* a2 = last ? nA : cA + (size_t)(t + 2) * kstep; const char* b2 = last ? nB : cB + (size_t)(t + 2) * kstep;
            const char* a3 = a2 + kstep; const char* b3 = b2 + kstep;
            if (last && has_next) S.a_ready(nxt);
            if constexpr (SP2) {
            PG8_LDB(B0, 0, 0); PG8_LDB(B1, 0, 1); PG8_SCHED; PG8_LDA(At, 0, 0); PG8_STAGE(PG8_SA(1, 1), a1 + hstep, voffA);
            PG8_WAIT_V(8); PG8_WAIT_L(0); PG8_BAR; PG8_MMA(0, 0, At, B0); PG8_MMA(0, 1, At, B1); PG8_BAR; PG8_SCHED;
            PG8_LDA(At, 0, 1); PG8_STAGE(PG8_SB(0, 0), b2, voffB); PG8_STAGE(PG8_SB(0, 1), b2 + hstep, voffB); PG8_STAGE(PG8_SA(0, 0), a2, voffA);
            PG8_WAIT_V(8); PG8_WAIT_L(0); PG8_BAR; PG8_MMA(1, 0, At, B0); PG8_MMA(1, 1, At, B1); PG8_BAR; PG8_SCHED;
            PG8_LDB(B0, 1, 0); PG8_LDB(B1, 1, 1); PG8_SCHED; PG8_LDA(At, 1, 0); PG8_STAGE(PG8_SA(0, 1), a2 + hstep, voffA);
            PG8_WAIT_V(8); PG8_WAIT_L(0); PG8_BAR; PG8_MMA(0, 0, At, B0); PG8_MMA(0, 1, At, B1); PG8_BAR; PG8_SCHED;
            PG8_LDA(At, 1, 1); PG8_STAGE(PG8_SB(1, 0), b3, voffB); PG8_STAGE(PG8_SB(1, 1), b3 + hstep, voffB); PG8_STAGE(PG8_SA(1, 0), a3, voffA);
            PG8_WAIT_V(8); PG8_WAIT_L(0); PG8_BAR; PG8_MMA(1, 0, At, B0); PG8_MMA(1, 1, At, B1); PG8_BAR; PG8_SCHED;
            } else {
            PG8_LDB(B0, 0, 0); PG8_SCHED; PG8_LDA(At, 0, 0); PG8_STAGE(PG8_SA(1, 1), a1 + hstep, voffA);
            PG8_WAIT_L(8); PG8_BAR; PG8_WAIT_L(0); PG8_MMA(0, 0, At, B0); PG8_BAR; PG8_SCHED;
            PG8_LDB(B1, 0, 1); PG8_STAGE(PG8_SB(0, 0), b2, voffB);
            PG8_BAR; PG8_WAIT_L(0); PG8_MMA(0, 1, At, B1); PG8_BAR;
            PG8_LDA(At, 0, 1); PG8_STAGE(PG8_SA(0, 0), a2, voffA);
            PG8_BAR; PG8_WAIT_L(0); PG8_MMA(1, 0, At, B0); PG8_BAR; PG8_SCHED;
            PG8_STAGE(PG8_SB(0, 1), b2 + hstep, voffB);
            PG8_WAIT_V(6); PG8_BAR; PG8_MMA(1, 1, At, B1); PG8_BAR;
            PG8_LDB(B0, 1, 0); PG8_SCHED; PG8_LDA(At, 1, 0); PG8_STAGE(PG8_SA(0, 1), a2 + hstep, voffA);
            PG8_WAIT_L(8); PG8_BAR; PG8_WAIT_L(0); PG8_MMA(0, 0, At, B0); PG8_BAR; PG8_SCHED;
            PG8_LDB(B1, 1, 1); PG8_STAGE(PG8_SB(1, 0), b3, voffB);
            PG8_BAR; PG8_WAIT_L(0); PG8_MMA(0, 1, At, B1); PG8_BAR;
            PG8_LDA(At, 1, 1); PG8_STAGE(PG8_SA(1, 0), a3, voffA);
            PG8_BAR; PG8_WAIT_L(0); PG8_MMA(1, 0, At, B0); PG8_BAR; PG8_SCHED;
            PG8_STAGE(PG8_SB(1, 1), b3 + hstep, voffB);
            PG8_WAIT_V(6); PG8_BAR; PG8_MMA(1, 1, At, B1); PG8_BAR;
            }
        }
        if constexpr (ALIGN_EPI) { if (wr == 0) PG8_BAR; }
        if constexpr (!Epi::AFTER_DRAIN) { E(acc, cur, wr, wc, fr, fq); S.done(cur); }
        if (!has_next) break;
#pragma unroll
        for (int a = 0; a < 2; ++a)
#pragma unroll
            for (int b = 0; b < 2; ++b)
#pragma unroll
                for (int m = 0; m < 4; ++m)
#pragma unroll
                    for (int n = 0; n < 2; ++n) acc[a][b][m][n] = (f32x4){0.f, 0.f, 0.f, 0.f};
        cur = nxt; cA = nA; cB = nB; ++ui;
        if constexpr (ALIGN_EPI) { if (wr == 1) PG8_BAR; }
    }
    PG8_WAIT_V(0);
    if constexpr (!ALIGN_EPI) { if (wr == 0) PG8_BAR; }
    PG8_BAR;
    if constexpr (Epi::AFTER_DRAIN) { E.fused(acc, cur, wr, wc, fr, fq, lds, wid, lane); S.done(cur); }
#undef PG8_SA
#undef PG8_SB
#undef PG8_STAGE
#undef PG8_LDA
#undef PG8_LDB
#undef PG8_MMA
#undef PG8_WAIT_V
#undef PG8_WAIT_L
#undef PG8_BAR
#undef PG8_SCHED
}
}
namespace att {
using bf16x8 = __attribute__((ext_vector_type(8))) short;
using s16x4  = __attribute__((ext_vector_type(4))) short;
using f32x16 = __attribute__((ext_vector_type(16))) float;
using u32x4  = __attribute__((ext_vector_type(4))) unsigned;
typedef unsigned short bf16;
constexpr int DQ = 64, DV = 128, NW = 8, QBLK = 32, KVBLK = 64, LDR = 3072;
constexpr int SHM_V = KVBLK * DV * 2, SHM_K = KVBLK * DQ * 2, SHM_ATTN = 3 * SHM_V + 3 * SHM_K + NW * 64 * 4 + 64;
constexpr int SHM_ATTN_ALL = SHM_ATTN + NW * QBLK * DV * 2;
#ifndef ATT_OVF_LIMIT
#define ATT_OVF_LIMIT 1.152921504606847e18f
#endif
#ifndef ATT_SDEPTH
#define ATT_SDEPTH 2
#endif
constexpr float THR2 = 11.0f;
#define KSWZ64(row, colB) ((row) * 128 + ((colB) ^ ((((row) >> 1) & 7) << 4)))
#define SBAR() __builtin_amdgcn_sched_barrier(0)
template <int K> __device__ __forceinline__ float sx(float v) { return __builtin_bit_cast(float, __builtin_amdgcn_ds_swizzle(__builtin_bit_cast(int, v), (K << 10) | 0x1f)); }
__device__ __forceinline__ int crow(int r, int hi) { return (r & 3) + 8 * (r >> 2) + 4 * hi; }
__device__ __forceinline__ unsigned cvtpk(float lo, float hi) { unsigned r; asm volatile("v_cvt_pk_bf16_f32 %0, %1, %2" : "=v"(r) : "v"(lo), "v"(hi)); return r; }
__device__ __forceinline__ void partialSM(f32x16& p0, f32x16& p1, float& m_reg, float& mn, float& alpha) {
  float pmax = p0[0];
#pragma unroll
  for (int r = 1; r < 16; ++r) pmax = fmaxf(pmax, p0[r]);
#pragma unroll
  for (int r = 0; r < 16; ++r) pmax = fmaxf(pmax, p1[r]);
  { auto rr = __builtin_amdgcn_permlane32_swap(__float_as_uint(pmax), __float_as_uint(pmax), false, false);
    pmax = fmaxf(__uint_as_float(rr[0]), __uint_as_float(rr[1])); }
  if (__builtin_expect(__all(pmax - m_reg <= THR2), 1)) { mn = m_reg; alpha = 1.f; }
  else { mn = fmaxf(m_reg, pmax); alpha = __builtin_amdgcn_exp2f(m_reg - mn); m_reg = mn; }
#pragma unroll
  for (int r = 0; r < 16; ++r) p0[r] = p0[r] - mn;
#pragma unroll
  for (int r = 0; r < 16; ++r) p1[r] = p1[r] - mn;
#pragma unroll
  for (int r = 0; r < 16; ++r) p0[r] = __builtin_amdgcn_exp2f(p0[r]);
}
__device__ __forceinline__ void finishSM(f32x16& p0, f32x16& p1, float alpha, float& l_reg, bf16x8& pa0, bf16x8& pa1, bf16x8& pa2, bf16x8& pa3) {
#pragma unroll
  for (int r = 0; r < 16; ++r) p1[r] = __builtin_amdgcn_exp2f(p1[r]);
  float ps = 0;
#pragma unroll
  for (int r = 0; r < 16; ++r) ps += p0[r];
#pragma unroll
  for (int r = 0; r < 16; ++r) ps += p1[r];
  { auto rr = __builtin_amdgcn_permlane32_swap(__float_as_uint(ps), __float_as_uint(ps), false, false);
    ps = __uint_as_float(rr[0]) + __uint_as_float(rr[1]); }
  l_reg = l_reg * alpha + ps;
#define PK4(P, BASE, OUT) do { unsigned a0 = cvtpk(P[BASE + 0], P[BASE + 1]), a1 = cvtpk(P[BASE + 2], P[BASE + 3]);   \
    unsigned b0 = cvtpk(P[BASE + 4], P[BASE + 5]), b1 = cvtpk(P[BASE + 6], P[BASE + 7]);                              \
    auto r0 = __builtin_amdgcn_permlane32_swap(a0, b0, false, false); auto r1 = __builtin_amdgcn_permlane32_swap(a1, b1, false, false); \
    u32x4 w = {r0[0], r1[0], r0[1], r1[1]}; OUT = *reinterpret_cast<bf16x8*>(&w); } while (0)
  PK4(p0, 0, pa0); PK4(p0, 8, pa1); PK4(p1, 0, pa2); PK4(p1, 8, pa3);
#undef PK4
}
__device__ __forceinline__ void qkt(f32x16& p0, f32x16& p1, const char* Ks, const bf16x8* qr, int r32, int hi) {
  p0 = f32x16{}; p1 = f32x16{};
#pragma unroll
  for (int d0 = 0; d0 < 4; ++d0) { const int cb = (d0 * 16 + hi * 8) * 2;
    bf16x8 b0 = *reinterpret_cast<const bf16x8*>(Ks + KSWZ64(r32, cb));
    bf16x8 b1 = *reinterpret_cast<const bf16x8*>(Ks + KSWZ64(32 + r32, cb));
    p0 = __builtin_amdgcn_mfma_f32_32x32x16_bf16(b0, qr[d0], p0, 0, 0, 0);
    p1 = __builtin_amdgcn_mfma_f32_32x32x16_bf16(b1, qr[d0], p1, 0, 0, 0); }
}
__device__ __forceinline__ void qkt_ref(f32x16& p0, f32x16& p1, const char* Ks, const bf16x8* qr, const f32x16& negm, int r32, int hi) {
#pragma unroll
  for (int d0 = 0; d0 < 4; ++d0) { const int cb = (d0 * 16 + hi * 8) * 2;
    bf16x8 b0 = *reinterpret_cast<const bf16x8*>(Ks + KSWZ64(r32, cb));
    bf16x8 b1 = *reinterpret_cast<const bf16x8*>(Ks + KSWZ64(32 + r32, cb));
    if (d0 == 0) { p0 = __builtin_amdgcn_mfma_f32_32x32x16_bf16(b0, qr[0], negm, 0, 0, 0); p1 = __builtin_amdgcn_mfma_f32_32x32x16_bf16(b1, qr[0], negm, 0, 0, 0); }
    else { p0 = __builtin_amdgcn_mfma_f32_32x32x16_bf16(b0, qr[d0], p0, 0, 0, 0); p1 = __builtin_amdgcn_mfma_f32_32x32x16_bf16(b1, qr[d0], p1, 0, 0, 0); } }
}
__device__ __forceinline__ void exp_half(f32x16& p) {
#pragma unroll
  for (int r = 0; r < 16; ++r) p[r] = __builtin_amdgcn_exp2f(p[r]);
}
__device__ __forceinline__ void sub_exp_half(f32x16& p0, f32x16& p1, float m) {
#pragma unroll
  for (int r = 0; r < 16; ++r) p0[r] = p0[r] - m;
#pragma unroll
  for (int r = 0; r < 16; ++r) p1[r] = p1[r] - m;
#pragma unroll
  for (int r = 0; r < 16; ++r) p0[r] = __builtin_amdgcn_exp2f(p0[r]);
}
__device__ __forceinline__ void finishSM_fast(f32x16& p0, f32x16& p1, float& l_reg, bool& ovf, bf16x8& pa0, bf16x8& pa1, bf16x8& pa2, bf16x8& pa3) {
  float al = 1.f; float l0 = 0.f;
  finishSM(p0, p1, al, l0, pa0, pa1, pa2, pa3);
  ovf = ovf || !(l0 < ATT_OVF_LIMIT);
  l_reg += l0;
}
__device__ __forceinline__ int v_st(int k, int c) { const int kk = (k & ~0xC) | ((k & 4) << 1) | ((k & 8) >> 1); return ((kk >> 3) * 4 + (c >> 5)) * 512 + ((kk & 7) * 32 + (c & 31)) * 2; }
__device__ __forceinline__ int v_rd_base(int lane) { return ((lane & 3) << 3) | (((lane >> 2) & 3) << 6) | (((lane >> 4) & 1) << 5) | (((lane >> 5) & 1) << 8); }
constexpr int v_rd_off(int d0, int ks, int half) { return d0 * 512 + ks * 4096 + half * 2048; }
template <int OFF> __device__ __forceinline__ s16x4 tr_read(int vb) {
  s16x4 r; asm volatile("ds_read_b64_tr_b16 %0, %1 offset:%2" : "=&v"(r) : "v"(vb), "i"(OFF) : "memory"); return r;
}
template <int D0> __device__ __forceinline__ void pv_one(f32x16& od, int vb, bf16x8 pa0, bf16x8 pa1, bf16x8 pa2, bf16x8 pa3) {
  const s16x4 l0 = tr_read<v_rd_off(D0, 0, 0)>(vb), h0 = tr_read<v_rd_off(D0, 0, 1)>(vb), l1 = tr_read<v_rd_off(D0, 1, 0)>(vb), h1 = tr_read<v_rd_off(D0, 1, 1)>(vb);
  const s16x4 l2 = tr_read<v_rd_off(D0, 2, 0)>(vb), h2 = tr_read<v_rd_off(D0, 2, 1)>(vb), l3 = tr_read<v_rd_off(D0, 3, 0)>(vb), h3 = tr_read<v_rd_off(D0, 3, 1)>(vb);
  asm volatile("s_waitcnt lgkmcnt(0)" ::: "memory"); SBAR();
#define PK(L, H) (bf16x8){L[0], L[1], L[2], L[3], H[0], H[1], H[2], H[3]}
  od = __builtin_amdgcn_mfma_f32_32x32x16_bf16(pa0, PK(l0, h0), od, 0, 0, 0);
  od = __builtin_amdgcn_mfma_f32_32x32x16_bf16(pa1, PK(l1, h1), od, 0, 0, 0);
  od = __builtin_amdgcn_mfma_f32_32x32x16_bf16(pa2, PK(l2, h2), od, 0, 0, 0);
  od = __builtin_amdgcn_mfma_f32_32x32x16_bf16(pa3, PK(l3, h3), od, 0, 0, 0);
#undef PK
}
__device__ __forceinline__ void pv_d0(f32x16* o, int vb, bf16x8 pa0, bf16x8 pa1, bf16x8 pa2, bf16x8 pa3) {
  pv_one<0>(o[0], vb, pa0, pa1, pa2, pa3); pv_one<1>(o[1], vb, pa0, pa1, pa2, pa3); pv_one<2>(o[2], vb, pa0, pa1, pa2, pa3); pv_one<3>(o[3], vb, pa0, pa1, pa2, pa3);
}
__device__ __forceinline__ void glds16(const void* gsrc, unsigned lds_dst) { unsigned keep;
  asm volatile("s_mov_b32 %0, m0\n\ts_mov_b32 m0, %2\n\ts_nop 0\n\tglobal_load_lds_dwordx4 %1, off\n\ts_mov_b32 m0, %0" : "=&s"(keep) : "v"(gsrc), "s"(lds_dst) : "memory"); }
template <bool FAST>
__device__ __forceinline__ bool attn_map(const bf16* __restrict__ Kh, const bf16* __restrict__ Vh, const bf16* __restrict__ Qh  , int seq, char* V_lds, char* K_lds, float* ws_base,
                                         f32x16 (&o)[4], float& l_out) {
    int tid = threadIdx.x; asm volatile("" : "+v"(tid));
    const int wid = __builtin_amdgcn_readfirstlane(tid >> 6), r32 = tid & 31, hi = (tid >> 5) & 1;
    float* al_l = ws_base + wid * 64 + 32;
    const bf16* Qw = Qh + (long)(wid * QBLK + r32) * LDR + hi * 8;
    const int lane_ = tid & 63;
    const unsigned lds0 = (unsigned)(uintptr_t)V_lds;
    const bf16 *vsrc0, *vsrc1, *ksrc;
    { const int o0 = (2 * wid) * 1024 + 16 * lane_, o1 = o0 + 1024, ok = wid * 1024 + 16 * lane_;
      auto vmap = [](int o, int& k, int& c) { const int sub = o >> 9, w = o & 511, kk = ((sub >> 2) << 3) | (w >> 6); k = (kk & ~0xC) | ((kk & 4) << 1) | ((kk & 8) >> 1); c = (sub & 3) * 32 + ((w & 63) >> 1); };
      int k0_, c0_, k1_, c1_; vmap(o0, k0_, c0_); vmap(o1, k1_, c1_);
      vsrc0 = Vh + (long)k0_ * LDR + c0_; vsrc1 = Vh + (long)k1_ * LDR + c1_;
      const int row = ok >> 7, cb = (ok & 127) ^ (((row >> 1) & 7) << 4);
      ksrc = Kh + (long)row * LDR + (cb >> 1); }
    const int vb0 = (int)(uintptr_t)V_lds + v_rd_base(tid & 63);
    float m_reg = -1e30f, l_reg = 0; bf16x8 qr[4]; bool ovf = false;
#pragma unroll
    for (int d0 = 0; d0 < 4; ++d0) { o[d0] = f32x16{}; qr[d0] = *reinterpret_cast<const bf16x8*>(Qw + d0 * 16); }
#define DMA_TILE(t, b) do { const long ro_ = (long)(t) * KVBLK * LDR; \
      glds16(vsrc0 + ro_, (unsigned)__builtin_amdgcn_readfirstlane(lds0 + (b) * SHM_V + (2 * wid) * 1024)); \
      glds16(vsrc1 + ro_, (unsigned)__builtin_amdgcn_readfirstlane(lds0 + (b) * SHM_V + (2 * wid + 1) * 1024)); \
      glds16(ksrc + ro_, (unsigned)__builtin_amdgcn_readfirstlane(lds0 + 3 * SHM_V + (b) * SHM_K + wid * 1024)); } while (0)
#define DMA_WAIT() asm volatile("s_waitcnt vmcnt(0)" ::: "memory")
#define RESC(a) do { if constexpr (!FAST) { if (__any((a) < 1.f)) { if (hi == 0) al_l[r32] = (a); asm volatile("s_waitcnt lgkmcnt(0)" ::: "memory"); \
    _Pragma("unroll") for (int d = 0; d < 4; ++d) _Pragma("unroll") for (int r = 0; r < 16; ++r) o[d][r] *= al_l[crow(r, hi)]; } } } while (0)
#define PSM(P0, P1, MN, AL) do { if constexpr (FAST) exp_half(P0); else partialSM(P0, P1, m_reg, MN, AL); } while (0)
#define FSM(P0, P1, AL) do { if constexpr (FAST) finishSM_fast(P0, P1, l_reg, ovf, pa0, pa1, pa2, pa3); else finishSM(P0, P1, AL, l_reg, pa0, pa1, pa2, pa3); } while (0)
#define STEP(PN0, PN1, MNN, ALN, PO0, PO1, ALO, jj) do { \
      SBAR(); if constexpr (FAST) qkt_ref(PN0, PN1, K_lds + bc * SHM_K, qr, negm, r32, hi); else qkt(PN0, PN1, K_lds + bc * SHM_K, qr, r32, hi); \
      if ((jj) + 1 < NT) DMA_TILE((jj) + 1, bn);              \
      FSM(PO0, PO1, ALO); SBAR(); \
      pv_d0(o, vb0 + bp * SHM_V, pa0, pa1, pa2, pa3); PSM(PN0, PN1, MNN, ALN); RESC(ALN); \
      DMA_WAIT(); __syncthreads(); \
      bp = bc; bc = bn; bn = (bn == 2) ? 0 : bn + 1; } while (0)
    f32x16 pA0, pA1, pB0, pB1; float mnA = 0.f, mnB = 0.f, alA = 1.f, alB = 1.f; bf16x8 pa0, pa1, pa2, pa3; const int NT = seq / KVBLK;
    DMA_TILE(0, 0); DMA_WAIT(); __syncthreads();
    if (1 < NT) DMA_TILE(1, 1);
    qkt(pA0, pA1, K_lds, qr, r32, hi); partialSM(pA0, pA1, m_reg, mnA, alA);
    f32x16 negm = f32x16{};
    if constexpr (FAST) {
#pragma unroll
      for (int r = 0; r < 16; ++r) negm[r] = -m_reg;
      asm volatile("" : "+v"(negm));
    }
    DMA_WAIT(); __syncthreads();
    int bp = 0, bc = 1, bn = 2;
    for (int j = 1; j + 1 < NT; j += 2) {
      STEP(pB0, pB1, mnB, alB, pA0, pA1, alA, j);
      STEP(pA0, pA1, mnA, alA, pB0, pB1, alB, j + 1);
    }
    STEP(pB0, pB1, mnB, alB, pA0, pA1, alA, NT - 1);
    FSM(pB0, pB1, alB); SBAR();
    pv_d0(o, vb0 + bp * SHM_V, pa0, pa1, pa2, pa3);
#undef DMA_TILE
#undef DMA_WAIT
#undef RESC
#undef PSM
#undef FSM
#undef STEP
    l_out = l_reg;
    return ovf;
}
__device__ __forceinline__ void attn_unit(const bf16* __restrict__ qkv, long Qrow0, long Krow0, int vh, int seq, float lam, float oscale, const float* __restrict__ subln,
                                          bf16* __restrict__ Ob, int ldo, float* stash, char* lds) {
  int tid = threadIdx.x; asm volatile("" : "+v"(tid));
  const int wid = __builtin_amdgcn_readfirstlane(tid >> 6), lane = tid & 63, r32 = lane & 31, hi = lane >> 5;
  char* V_lds = lds; char* K_lds = lds + 3 * SHM_V;
  float* wsb = (float*)(lds + 3 * SHM_V + 3 * SHM_K); float* li_l = wsb + wid * 64;
  volatile unsigned* ovw = (volatile unsigned*)(lds + 3 * SHM_V + 3 * SHM_K + NW * 64 * 4);
  const bf16* Vh = qkv + Krow0 * LDR + 2048 + vh * DV;
  for (int s = 0; s < 2; ++s) {
    const int head = 2 * vh + s;
    const bf16* Kh = qkv + Krow0 * LDR + 1024 + head * DQ;
    const bf16* Qh = qkv + Qrow0 * LDR + head * DQ;
    f32x16 o[4]; float l_reg;
    const bool ovf = attn_map<true>(Kh, Vh, Qh, seq, V_lds, K_lds, wsb, o, l_reg);
    if (lane == 0) ovw[wid] = __any(ovf) ? 1u : 0u;
    __syncthreads();
    unsigned anyovf = 0u;
#pragma unroll
    for (int w = 0; w < NW; ++w) anyovf |= ovw[w];
    __syncthreads();
    if (__builtin_amdgcn_readfirstlane(anyovf) != 0u) (void)attn_map<false>(Kh, Vh, Qh, seq, V_lds, K_lds, wsb, o, l_reg);
    if (hi == 0) li_l[r32] = l_reg; asm volatile("s_waitcnt lgkmcnt(0)" ::: "memory");
    float rli[16];
#pragma unroll
    for (int r = 0; r < 16; ++r) rli[r] = __builtin_amdgcn_rcpf(li_l[crow(r, hi)]);
    typedef float f32x4_t __attribute__((ext_vector_type(4)));
    f32x4_t* st4 = (f32x4_t*)stash + (size_t)tid * 16;
    if (s == 0) {
#pragma unroll
      for (int d0 = 0; d0 < 4; ++d0)
#pragma unroll
        for (int r4 = 0; r4 < 4; ++r4) { f32x4_t v; v[0] = o[d0][4 * r4] * rli[4 * r4]; v[1] = o[d0][4 * r4 + 1] * rli[4 * r4 + 1]; v[2] = o[d0][4 * r4 + 2] * rli[4 * r4 + 2]; v[3] = o[d0][4 * r4 + 3] * rli[4 * r4 + 3]; st4[d0 * 4 + r4] = v; }
    } else {
      float ssq[16];
#pragma unroll
      for (int r = 0; r < 16; ++r) ssq[r] = 0.f;
#pragma unroll
      for (int d0 = 0; d0 < 4; ++d0)
#pragma unroll
        for (int r4 = 0; r4 < 4; ++r4) { const f32x4_t sv = st4[d0 * 4 + r4];
#pragma unroll
          for (int i = 0; i < 4; ++i) { const int r = 4 * r4 + i; const float v = sv[i] - lam * (o[d0][r] * rli[r]); o[d0][r] = v; ssq[r] += v * v; } }
#pragma unroll
      for (int r = 0; r < 16; ++r) {
        float a = ssq[r];
        a += sx<1>(a); a += sx<2>(a); a += sx<4>(a); a += sx<8>(a); a += sx<16>(a);
        ssq[r] = oscale / sqrtf(a * (1.0f / 128.0f) + 1e-6f);
      }
      float g[4];
#pragma unroll
      for (int d0 = 0; d0 < 4; ++d0) g[d0] = subln[d0 * 32 + r32];
      bf16* stg = (bf16*)(lds + SHM_ATTN) + wid * (QBLK * DV);
      unsigned so = (unsigned)((4 * hi) * DV + r32); asm volatile("" : "+v"(so));
#pragma unroll
      for (int r = 0; r < 16; ++r) {
#pragma unroll
        for (int d0 = 0; d0 < 4; ++d0) { const unsigned w = cvtpk(o[d0][r] * ssq[r] * g[d0], 0.f); (stg + ((r & 3) + 8 * (r >> 2)) * DV + d0 * 32)[so] = (bf16)(w & 0xffffu); } }
      asm volatile("s_waitcnt lgkmcnt(0)" ::: "memory");
      int ldo_ = ldo; asm volatile("" : "+s"(ldo_));
      bf16* Ow = Ob + (long)(wid * QBLK) * ldo_;
      const int srow = lane >> 4, sch = lane & 15;
#pragma unroll
      for (int i = 0; i < 8; ++i) { const int row = i * 4 + srow; const u32x4 v = *(const u32x4*)(stg + row * DV + sch * 8); *(u32x4*)(Ow + (long)row * ldo_ + sch * 8) = v; }
    }
  }
}
#undef SBAR
}
#define GAS __attribute__((address_space(1)))
#define LAS __attribute__((address_space(3)))
typedef unsigned short bf16;
typedef unsigned v4u __attribute__((ext_vector_type(4)));
typedef float f32x4 __attribute__((ext_vector_type(4)));
typedef short bf16x8 __attribute__((ext_vector_type(8)));
typedef GAS unsigned gu32;
typedef GAS unsigned long long gu64;
#define RLX_AGENT __ATOMIC_RELAXED, __HIP_MEMORY_SCOPE_AGENT
#define LDS_WAIT() asm volatile("s_waitcnt lgkmcnt(0)" ::: "memory")
#define VM_WAIT() asm volatile("s_waitcnt vmcnt(0)" ::: "memory")
__device__ __forceinline__ unsigned long long rt() { return __builtin_amdgcn_s_memrealtime(); }
__device__ __forceinline__ unsigned f2bf(float f) { unsigned u = __builtin_bit_cast(unsigned, f); return (u + 0x7fffu + ((u >> 16) & 1u)) >> 16; }
__device__ __forceinline__ unsigned pk2(float lo, float hi) { unsigned r; asm("v_cvt_pk_bf16_f32 %0, %1, %2" : "=v"(r) : "v"(lo), "v"(hi)); return r; }

#define XB_TMO      128
#define XB_XCNT(j)  (256  + 64 * (j))
#define XB_XSUB(j)  (1280 + 64 * (j))
#define XB_XGEN(j)  (2304 + 64 * (j))
#define XB_TOP      3328
#define XB_TOPGEN   3392
#define XCD_BAR_WORDS 3456
#define XB_SPIN_CAP (1u << 18)

__device__ __forceinline__ unsigned xb_ld(unsigned* p)              { return __hip_atomic_load(p, __ATOMIC_RELAXED, __HIP_MEMORY_SCOPE_AGENT); }
__device__ __forceinline__ unsigned xb_add(unsigned* p, unsigned v) { return __hip_atomic_fetch_add(p, v, __ATOMIC_RELAXED, __HIP_MEMORY_SCOPE_AGENT); }
__device__ __forceinline__ unsigned xb_xcc_id() { return (unsigned)__builtin_amdgcn_s_getreg((3 << 11) | 20) & 0xFu; }
#define XB_SPIN(cond, bar) do { unsigned _sp = 0; while (cond) { __builtin_amdgcn_s_sleep(1); \
    if ((++_sp & 255u) == 0u) { if (xb_ld(&(bar)[XB_TMO])) break; if (_sp > XB_SPIN_CAP) { atomicAdd(&(bar)[XB_TMO], 1u); break; } } } } while (0)

struct XcdBarrier {
    unsigned* bar; unsigned x;
    volatile LAS unsigned* st;
};

__device__ __forceinline__ XcdBarrier xcd_barrier_post(unsigned* bar, volatile LAS unsigned* st) {
    XcdBarrier b; b.bar = bar; b.x = xb_xcc_id(); b.st = st;
    if (threadIdx.x == 0) (void)xb_add(&bar[XB_XCNT(b.x)], 1u);
    return b;
}
__device__ __forceinline__ void xcd_barrier_complete(unsigned* bar, unsigned x, unsigned& nloc, unsigned& nx) {
    const unsigned G = gridDim.x * gridDim.y * gridDim.z;
    unsigned sum, cnt, mine, sp = 0u;
    for (;;) {
        sum = 0u; cnt = 0u; mine = 0u;
#pragma unroll
        for (unsigned j = 0; j < 16; ++j) { const unsigned c = xb_ld(&bar[XB_XCNT(j)]); sum += c; cnt += (c > 0u) ? 1u : 0u; mine = (j == x) ? c : mine; }
        if (sum == G) break;
        __builtin_amdgcn_s_sleep(1);
        if ((++sp & 255u) == 0u) { if (xb_ld(&bar[XB_TMO])) break; if (sp > XB_SPIN_CAP) { atomicAdd(&bar[XB_TMO], 1u); break; } }
    }
    nloc = mine > 0u ? mine : 1u; nx = cnt > 0u ? cnt : 1u;
}

__device__ __forceinline__ void xcd_barrier(const XcdBarrier& b) {
    asm volatile("s_waitcnt vmcnt(0)" ::: "memory");
    __syncthreads();
    if (threadIdx.x == 0) {
        unsigned* bar = b.bar;
        __builtin_amdgcn_s_waitcnt(0);
        unsigned nloc = b.st[0], nx = b.st[1];
        if (nloc == 0u) { xcd_barrier_complete(bar, b.x, nloc, nx); b.st[0] = nloc; b.st[1] = nx; }
        const unsigned old = xb_add(&bar[XB_XSUB(b.x)], 1u);
        const unsigned gen = old / nloc;
        if (old + 1u == (gen + 1u) * nloc) {
            __builtin_amdgcn_fence(__ATOMIC_RELEASE, "agent");
            asm volatile("s_waitcnt vmcnt(0)" ::: "memory");
            const unsigned og = xb_add(&bar[XB_TOP], 1u);
            const unsigned tg = og / nx;
            if (og + 1u == (tg + 1u) * nx) xb_add(&bar[XB_TOPGEN], 1u);
            else XB_SPIN(xb_ld(&bar[XB_TOPGEN]) == tg, bar);
            __builtin_amdgcn_fence(__ATOMIC_ACQUIRE, "agent");
            xb_add(&bar[XB_XGEN(b.x)], 1u);
            asm volatile("s_waitcnt vmcnt(0)" ::: "memory");
        } else {
            XB_SPIN(xb_ld(&bar[XB_XGEN(b.x)]) == gen, bar);
            __builtin_amdgcn_fence(__ATOMIC_ACQUIRE, "agent");
            asm volatile("s_waitcnt vmcnt(0)" ::: "memory");
        }
    }
    __syncthreads();
}
#define HYD __device__ __forceinline__
#define HYDM __device__ __forceinline__
#define HY_DEVICE 1
#ifdef HY_DEVICE
#define HY_OPAQUE(x) asm volatile("" : "+v"(x))
#else
#define HY_OPAQUE(x) (void)(x)
#endif
typedef float cf __attribute__((ext_vector_type(2)));
typedef float cf2 __attribute__((ext_vector_type(4)));
template <class P> struct HyP2 {};
template <> struct HyP2<cf*> { typedef cf2* type; };
#ifdef HY_DEVICE
template <> struct HyP2<__attribute__((address_space(3))) cf*> { typedef __attribute__((address_space(3))) cf2* type; };
#endif
HYD cf cf_add(cf a, cf b) { return a + b; }
HYD cf cf_sub(cf a, cf b) { return a - b; }
HYD cf cf_mul(cf a, cf b) { return cf{a.x * b.x - a.y * b.y, a.x * b.y + a.y * b.x}; }
HYD cf cf_mulc(cf a, cf b) { return cf{a.x * b.x + a.y * b.y, a.y * b.x - a.x * b.y}; }
constexpr int FN = 16384, FT = 512, FLOG = 14, FNP = FN + 4 * (FN >> 6);
constexpr int SEQL = 8192;
HYD int HP(int i) { return i + ((i >> 6) << 2); }
#define HY_C1 0.92387953251128674f
#define HY_S1 0.38268343236508977f
#define HY_R2 0.70710678118654752f
template <int M16> HYD cf mul_root16(cf w) {
    if (M16 == 0) return w;
    if (M16 == 4) return cf{w.y, -w.x};
    if (M16 == 2) return cf{(w.x + w.y) * HY_R2, (w.y - w.x) * HY_R2};
    if (M16 == 6) return cf{(w.y - w.x) * HY_R2, -(w.x + w.y) * HY_R2};
    if (M16 == 1) return cf_mul(w, cf{HY_C1, -HY_S1});
    if (M16 == 3) return cf_mul(w, cf{HY_S1, -HY_C1});
    if (M16 == 5) return cf_mul(w, cf{-HY_S1, -HY_C1});
    return cf_mul(w, cf{-HY_C1, -HY_S1});
}
template <int Q, int U, bool INV, bool ZUP, bool HLO> struct HyStage {
    static HYDM void run(cf (&e)[1 << Q], const cf (&tw)[Q]) {
        constexpr int R = 1 << Q, half = R >> (U + 1);
#pragma unroll
        for (int k = 0; k < R; ++k) {
            if ((k & half) == 0) {
                const int kp = k & (half - 1);
                cf w = tw[U];
                switch (kp * 16 / (2 * half)) {
                    case 0: break;
                    case 1: w = mul_root16<1>(w); break;
                    case 2: w = mul_root16<2>(w); break;
                    case 3: w = mul_root16<3>(w); break;
                    case 4: w = mul_root16<4>(w); break;
                    case 5: w = mul_root16<5>(w); break;
                    case 6: w = mul_root16<6>(w); break;
                    default: w = mul_root16<7>(w); break;
                }
                if (!INV) {
                    if (ZUP && U == 0) { e[k + half] = cf_mul(e[k], w); }
                    else { const cf a = e[k], b = e[k + half]; e[k] = cf_add(a, b); e[k + half] = cf_mul(cf_sub(a, b), w); }
                } else {
                    const cf a = e[k], b = cf_mulc(e[k + half], w); e[k] = cf_add(a, b);
                    if (!(HLO && U == 0)) e[k + half] = cf_sub(a, b);
                }
            }
        }
    }
};
template <int Q, bool INV, bool ZUP, bool HLO> HYD void hy_bfly(cf (&e)[1 << Q], cf t) {
    cf tw[Q]; tw[0] = t;
#pragma unroll
    for (int u = 1; u < Q; ++u) tw[u] = cf_mul(tw[u - 1], tw[u - 1]);
    if (Q == 4) {
        if (!INV) { HyStage<Q, 0, INV, ZUP, HLO>::run(e, tw); HyStage<Q, 1, INV, ZUP, HLO>::run(e, tw); HyStage<Q, 2 % Q, INV, ZUP, HLO>::run(e, tw); HyStage<Q, 3 % Q, INV, ZUP, HLO>::run(e, tw); }
        else      { HyStage<Q, 3 % Q, INV, ZUP, HLO>::run(e, tw); HyStage<Q, 2 % Q, INV, ZUP, HLO>::run(e, tw); HyStage<Q, 1, INV, ZUP, HLO>::run(e, tw); HyStage<Q, 0, INV, ZUP, HLO>::run(e, tw); }
    } else {
        if (!INV) { HyStage<Q, 0, INV, ZUP, HLO>::run(e, tw); HyStage<Q, 1, INV, ZUP, HLO>::run(e, tw); }
        else      { HyStage<Q, 1, INV, ZUP, HLO>::run(e, tw); HyStage<Q, 0, INV, ZUP, HLO>::run(e, tw); }
    }
}
#ifdef HY_DEVICE
#define HY_MULT(T, X, Y) "v_pk_mul_f32 " T ", " X ", " Y " op_sel:[1,1] op_sel_hi:[1,0]\n\t"
#define HY_FMAP(R, X, Y, T) "v_pk_fma_f32 " R ", " X ", " Y ", " T " op_sel_hi:[0,1,1] neg_lo:[0,0,1]\n\t"
#define HY_FMAC(R, X, Y, T) "v_pk_fma_f32 " R ", " X ", " Y ", " T " op_sel_hi:[0,1,1] neg_hi:[1,0,0]\n\t"
#define HY_ADD(R, A, B) "v_pk_add_f32 " R ", " A ", " B "\n\t"
#define HY_SUB(R, A, B) "v_pk_add_f32 " R ", " A ", " B " neg_lo:[0,1] neg_hi:[0,1]\n\t"
HYD void hy_cmul2(cf& r0, cf x0, cf y0, cf& r1, cf x1, cf y1) { cf t0, t1;
    asm(HY_MULT("%0", "%4", "%5") HY_MULT("%1", "%6", "%7") HY_FMAP("%2", "%4", "%5", "%0") HY_FMAP("%3", "%6", "%7", "%1")
        : "=&v"(t0), "=&v"(t1), "=&v"(r0), "=&v"(r1) : "v"(x0), "v"(y0), "v"(x1), "v"(y1)); }
HYD cf hy_cmul1(cf x, cf y) { cf t, r;
    asm(HY_MULT("%0", "%2", "%3") "s_nop 0\n\t" HY_FMAP("%1", "%2", "%3", "%0") : "=&v"(t), "=&v"(r) : "v"(x), "v"(y)); return r; }
HYD void hy_bf2_fwd(cf& a0, cf& b0, cf w0, cf& a1, cf& b1, cf w1) { cf d0, d1, t0, t1;
    asm(HY_SUB("%4", "%0", "%1") HY_ADD("%0", "%0", "%1") HY_SUB("%5", "%2", "%3") HY_ADD("%2", "%2", "%3")
        HY_MULT("%6", "%4", "%8") HY_MULT("%7", "%5", "%9") HY_FMAP("%1", "%4", "%8", "%6") HY_FMAP("%3", "%5", "%9", "%7")
        : "+v"(a0), "+v"(b0), "+v"(a1), "+v"(b1), "=&v"(d0), "=&v"(d1), "=&v"(t0), "=&v"(t1) : "v"(w0), "v"(w1)); }
HYD void hy_bf2_fwdz(cf a0, cf& b0, cf w0, cf a1, cf& b1, cf w1) { hy_cmul2(b0, a0, w0, b1, a1, w1); }
HYD void hy_bf2_inv(cf& a0, cf& b0, cf w0, cf& a1, cf& b1, cf w1) { cf t0, t1;
    asm(HY_MULT("%4", "%1", "%6") HY_MULT("%5", "%3", "%7") HY_FMAC("%4", "%1", "%6", "%4") HY_FMAC("%5", "%3", "%7", "%5")
        HY_SUB("%1", "%0", "%4") HY_SUB("%3", "%2", "%5") HY_ADD("%0", "%0", "%4") HY_ADD("%2", "%2", "%5")
        : "+v"(a0), "+v"(b0), "+v"(a1), "+v"(b1), "=&v"(t0), "=&v"(t1) : "v"(w0), "v"(w1)); }
HYD void hy_bf2_invl(cf& a0, cf b0, cf w0, cf& a1, cf b1, cf w1) { cf t0, t1;
    asm(HY_MULT("%2", "%4", "%6") HY_MULT("%3", "%5", "%7") HY_FMAC("%2", "%4", "%6", "%2") HY_FMAC("%3", "%5", "%7", "%3")
        HY_ADD("%0", "%0", "%2") HY_ADD("%1", "%1", "%3")
        : "+v"(a0), "+v"(a1), "=&v"(t0), "=&v"(t1) : "v"(b0), "v"(b1), "v"(w0), "v"(w1)); }
HYD cf hy_rot(cf w) { cf r; asm("v_pk_add_f32 %0, %1, 0 op_sel:[1,0] op_sel_hi:[0,0] neg_hi:[1,0]" : "=v"(r) : "v"(w)); return r; }
#else
HYD void hy_cmul2(cf& r0, cf x0, cf y0, cf& r1, cf x1, cf y1) { const cf p0 = cf_mul(x0, y0), p1 = cf_mul(x1, y1); r0 = p0; r1 = p1; }
HYD cf hy_cmul1(cf x, cf y) { return cf_mul(x, y); }
HYD void hy_bf2_fwd(cf& a0, cf& b0, cf w0, cf& a1, cf& b1, cf w1) { const cf d0 = cf_sub(a0, b0), d1 = cf_sub(a1, b1); a0 = cf_add(a0, b0); a1 = cf_add(a1, b1); b0 = cf_mul(d0, w0); b1 = cf_mul(d1, w1); }
HYD void hy_bf2_fwdz(cf a0, cf& b0, cf w0, cf a1, cf& b1, cf w1) { b0 = cf_mul(a0, w0); b1 = cf_mul(a1, w1); }
HYD void hy_bf2_inv(cf& a0, cf& b0, cf w0, cf& a1, cf& b1, cf w1) { const cf p0 = cf_mulc(b0, w0), p1 = cf_mulc(b1, w1); b0 = cf_sub(a0, p0); b1 = cf_sub(a1, p1); a0 = cf_add(a0, p0); a1 = cf_add(a1, p1); }
HYD void hy_bf2_invl(cf& a0, cf b0, cf w0, cf& a1, cf b1, cf w1) { a0 = cf_add(a0, cf_mulc(b0, w0)); a1 = cf_add(a1, cf_mulc(b1, w1)); }
HYD cf hy_rot(cf w) { return cf{w.y, -w.x}; }
#endif
template <int U, bool INV, bool ZUP, bool HLO> HYD void hy_stage16(cf (&e)[16], const cf* W) {
    constexpr int half = 8 >> U;
#pragma unroll
    for (int j = 0; j < 8; j += 2) {
        const int k0 = ((j / half) * 2 * half) + (j % half), k1 = (((j + 1) / half) * 2 * half) + ((j + 1) % half);
        const cf w0 = W[k0 & (half - 1)], w1 = W[k1 & (half - 1)];
        if (!INV) { if (ZUP && U == 0) hy_bf2_fwdz(e[k0], e[k0 + half], w0, e[k1], e[k1 + half], w1); else hy_bf2_fwd(e[k0], e[k0 + half], w0, e[k1], e[k1 + half], w1); }
        else { if (HLO && U == 0) hy_bf2_invl(e[k0], e[k0 + half], w0, e[k1], e[k1 + half], w1); else hy_bf2_inv(e[k0], e[k0 + half], w0, e[k1], e[k1 + half], w1); }
    }
}
template <bool INV, bool ZUP, bool HLO> HYD void hy_bfly16(cf (&e)[16], cf t) {
    cf W0[8], W1[4], W2[2], W3[1], tw1, tw2;
    cf k1 = cf{HY_C1, -HY_S1}, k2 = cf{HY_R2, -HY_R2}, k3 = cf{HY_S1, -HY_C1};
    W0[0] = t;
    hy_cmul2(W0[1], t, k1, W0[3], t, k3);
    hy_cmul2(W0[2], t, k2, tw1, t, t);
    W1[0] = tw1;
    hy_cmul2(W1[1], tw1, k2, tw2, tw1, tw1);
    W2[0] = tw2;
    W3[0] = hy_cmul1(tw2, tw2);
#pragma unroll
    for (int i = 0; i < 4; ++i) W0[4 + i] = hy_rot(W0[i]);
    W1[2] = hy_rot(W1[0]); W1[3] = hy_rot(W1[1]); W2[1] = hy_rot(W2[0]);
    if (!INV) { hy_stage16<0, INV, ZUP, HLO>(e, W0); hy_stage16<1, INV, ZUP, HLO>(e, W1); hy_stage16<2, INV, ZUP, HLO>(e, W2); hy_stage16<3, INV, ZUP, HLO>(e, W3); }
    else      { hy_stage16<3, INV, ZUP, HLO>(e, W3); hy_stage16<2, INV, ZUP, HLO>(e, W2); hy_stage16<1, INV, ZUP, HLO>(e, W1); hy_stage16<0, INV, ZUP, HLO>(e, W0); }
}
template <class PT> HYD cf hy_twid(PT thi, PT tlo, int e) { return hy_cmul1(thi[e >> 7], tlo[e & 127]); }
template <int S, bool INV, bool ZUP, bool HLO, class P, class PT>
HYD void hy_pass16(P X, PT thi, PT tlo, int tid) {
    constexpr int R = 16;
    constexpr int SP = (S >= 64) ? S + S / 16 : S;
    const int g0 = tid, g1 = tid + FT;
    const int lo0 = g0 & (S - 1), pb0 = HP((g0 / S) * S * R + lo0);
    const int lo1 = g1 & (S - 1), pb1 = HP((g1 / S) * S * R + lo1);
    cf e0[R], e1[R];
#pragma unroll
    for (int k = 0; k < R; ++k) { if (ZUP && k >= 8) e0[k] = cf{0.f, 0.f}; else e0[k] = X[pb0 + k * SP]; }
#pragma unroll
    for (int k = 0; k < R; ++k) { if (ZUP && k >= 8) e1[k] = cf{0.f, 0.f}; else e1[k] = X[pb1 + k * SP]; }
    const cf t0 = hy_twid(thi, tlo, lo0 * (FN / (R * S))), t1 = hy_twid(thi, tlo, lo1 * (FN / (R * S)));
    hy_bfly16<INV, ZUP, HLO>(e0, t0);
#pragma unroll
    for (int k = 0; k < R; ++k) { if (!(HLO && k >= 8)) X[pb0 + k * SP] = e0[k]; }
    hy_bfly16<INV, ZUP, HLO>(e1, t1);
#pragma unroll
    for (int k = 0; k < R; ++k) { if (!(HLO && k >= 8)) X[pb1 + k * SP] = e1[k]; }
}
template <bool INV> HYD void hy_r4(cf (&e)[4]) {
    if (!INV) {
        const cf a0 = e[0] + e[2], b0 = e[0] - e[2], a1 = e[1] + e[3], d = e[1] - e[3], b1 = cf{d.y, -d.x};
        e[0] = a0 + a1; e[1] = a0 - a1; e[2] = b0 + b1; e[3] = b0 - b1;
    } else {
        const cf a0 = e[0] + e[1], a1 = e[0] - e[1], a2 = e[2] + e[3], d = e[2] - e[3], b = cf{-d.y, d.x};
        e[0] = a0 + a2; e[2] = a0 - a2; e[1] = a1 + b; e[3] = a1 - b;
    }
}
template <bool INV, class P, class PK>
HYD void hy_pass4(P X, int tid, PK KM) {
    typedef typename HyP2<P>::type P2;
    const int w = tid >> 6, lane = tid & 63;
#pragma unroll 1
    for (int gb = 0; gb < 2; ++gb) {
        cf2 a[4], b[4], ka[4], kb[4];
        const int g0 = (gb * 8 + w) * 256 + lane;
#pragma unroll
        for (int u = 0; u < 4; ++u) { const int g = g0 + 64 * u; P2 X2 = (P2)(X + HP(4 * g)); a[u] = X2[0]; b[u] = X2[1];
            if (KM) { const unsigned gi = (unsigned)(4 * g) & 0x3fffu; ka[u] = ((const cf2*)(KM + gi))[0]; kb[u] = ((const cf2*)(KM + gi))[1]; } }
#pragma unroll
        for (int u = 0; u < 4; ++u) { const int g = g0 + 64 * u; P2 X2 = (P2)(X + HP(4 * g));
            cf e[4] = {cf{a[u].x, a[u].y}, cf{a[u].z, a[u].w}, cf{b[u].x, b[u].y}, cf{b[u].z, b[u].w}};
            hy_r4<INV>(e);
            if (KM) { cf q0, q1, q2, q3; hy_cmul2(q0, e[0], cf{ka[u].x, ka[u].y}, q1, e[1], cf{ka[u].z, ka[u].w}); hy_cmul2(q2, e[2], cf{kb[u].x, kb[u].y}, q3, e[3], cf{kb[u].z, kb[u].w}); e[0] = q0; e[1] = q1; e[2] = q2; e[3] = q3; }
            X2[0] = cf2{e[0].x, e[0].y, e[1].x, e[1].y}; X2[1] = cf2{e[2].x, e[2].y, e[3].x, e[3].y}; }
    }
}
HYD int hy_brev14(int p) {
    unsigned v = (unsigned)p;
    v = ((v >> 1) & 0x55555555u) | ((v & 0x55555555u) << 1);
    v = ((v >> 2) & 0x33333333u) | ((v & 0x33333333u) << 2);
    v = ((v >> 4) & 0x0F0F0F0Fu) | ((v & 0x0F0F0F0Fu) << 4);
    v = ((v >> 8) & 0x00FF00FFu) | ((v & 0x00FF00FFu) << 8);
    v = (v >> 16) | (v << 16);
    return (int)(v >> (32 - FLOG));
}
HYD float hy_bf2f(unsigned short b) { unsigned u = (unsigned)b << 16; float f; __builtin_memcpy(&f, &u, 4); return f; }
HYD unsigned hy_f2bf(float f) { unsigned u; __builtin_memcpy(&u, &f, 4); return (u + 0x7fffu + ((u >> 16) & 1u)) >> 16; }
template <class PR> HYD void hy_sconv2(PR rowj  , unsigned tid, int j, float w0, float w1, float w2, float b, float& u0, float& u1) {
    const unsigned d1 = rowj[tid];
    const unsigned d0r = (rowj - 1)[tid], d2r = (rowj + 1)[tid];
    const unsigned d0 = (j > 0 || tid > 0) ? d0r : 0u;
    const unsigned d2 = (j < 7 || tid < (unsigned)(FT - 1)) ? d2r : 0u;
    const float pm1 = hy_bf2f((unsigned short)(d0 >> 16)), p0 = hy_bf2f((unsigned short)(d1 & 0xffffu)), p1 = hy_bf2f((unsigned short)(d1 >> 16)), p2 = hy_bf2f((unsigned short)(d2 & 0xffffu));
    u0 = b + w0 * pm1 + w1 * p0 + w2 * p1;
    u1 = b + w0 * p0 + w1 * p1 + w2 * p2;
}
template <class P> HYD void hy_filter_step(P X, const unsigned short* taps, float delta, int tid) {
    typedef typename HyP2<P>::type P2;
    typedef unsigned u32x2h __attribute__((ext_vector_type(2)));
    u32x2h raw[SEQL / (4 * FT)][4];
    const float dscale = -delta * (1.4426950408889634f / (float)(SEQL - 1)); (void)dscale;
#pragma unroll
    for (int j = 0; j < SEQL / (4 * FT); ++j)
#pragma unroll
        for (int q = 0; q < 4; ++q) raw[j][q] = *(const u32x2h*)(taps + (size_t)q * 1024 * SEQL + ((unsigned)(4 * (tid + FT * j)) & 0x1fffu));
#pragma unroll
    for (int j = 0; j < SEQL / (4 * FT); ++j) {
        const int t = 4 * (tid + FT * j);
        cf2 a[4];
#pragma unroll
        for (int q = 0; q < 4; ++q) a[q] = cf2{hy_bf2f((unsigned short)(raw[j][q].x & 0xffffu)), hy_bf2f((unsigned short)(raw[j][q].x >> 16)), hy_bf2f((unsigned short)(raw[j][q].y & 0xffffu)), hy_bf2f((unsigned short)(raw[j][q].y >> 16))};
        cf2 dec;
#pragma unroll
#ifdef HY_DEVICE
        for (int e = 0; e < 4; ++e) dec[e] = __builtin_amdgcn_exp2f((float)(t + e) * dscale);
#else
        for (int e = 0; e < 4; ++e) dec[e] = expf(-((float)(t + e) * (1.0f / (float)(SEQL - 1))) * delta);
#endif
        const cf2 a0 = a[0] * dec, a1 = a[1] * dec, a2 = a[2] * dec, a3 = a[3] * dec;
        P2 Xf = (P2)(X + HP(t));
        if (t == 0) { Xf[0] = cf2{a0[0] + a1[0], a2[0] + a3[0], a0[1], a2[1]}; float z0 = 0.f; HY_OPAQUE(z0); X[HP(SEQL)] = cf{z0, z0}; }
        else Xf[0] = cf2{a0[0], a2[0], a0[1], a2[1]};
        Xf[1] = cf2{a0[2], a2[2], a0[3], a2[3]};
        const int pbk = HP(FN - t - 4);
        X[pbk + 1] = cf{a1[3], a3[3]}; X[pbk + 2] = cf{a1[2], a3[2]}; X[pbk + 3] = cf{a1[1], a3[1]};
        if (t > 0) X[HP(FN - t)] = cf{a1[0], a3[0]};
    }
}
template <class P> HYD void hy_sep_step(P X, cf* K1g, cf* K2g, int tid) {
    const float sc = 0.5f / (float)FN;
#pragma unroll 1
    for (int j0 = 0; j0 < FN / FT; j0 += 4) {
        cf a[4], b[4];
#pragma unroll
        for (int u = 0; u < 4; ++u) { const int p = tid + FT * (j0 + u);
            const int f = hy_brev14(p), q = hy_brev14((FN - f) & (FN - 1));
            a[u] = X[HP(p)]; b[u] = X[HP(q)]; }
#pragma unroll
        for (int u = 0; u < 4; ++u) { const int p = tid + FT * (j0 + u);
            const unsigned pi = (unsigned)p & 0x3fffu;
            K1g[pi] = cf{(a[u].x + b[u].x) * sc, (a[u].y - b[u].y) * sc};
            K2g[pi] = cf{(a[u].y + b[u].y) * sc, -(a[u].x - b[u].x) * sc}; }
    }
}
template <class P> HYD void hy_load_step(P X, const unsigned* r0, const unsigned* r1, float w0, float w1, float w2, float b, float (&zr)[8][4], int tid) {
    typedef typename HyP2<P>::type P2;
#pragma unroll
    for (int j = 0; j < 8; ++j) {
        const int t = 2 * (tid + FT * j);
        hy_sconv2(r0 + FT * j, (unsigned)tid, j, w0, w1, w2, b, zr[j][0], zr[j][2]);
        hy_sconv2(r1 + FT * j, (unsigned)tid, j, w0, w1, w2, b, zr[j][1], zr[j][3]);
        *(P2)(X + HP(t)) = cf2{zr[j][0], zr[j][1], zr[j][2], zr[j][3]};
    }
}
template <class P> HYD void hy_gate1_step(P X, const unsigned* r0, const unsigned* r1, float w0, float w1, float w2, float b, float bias, float (&zr)[8][4], int tid) {
    typedef typename HyP2<P>::type P2;
#pragma unroll
    for (int j = 0; j < 8; ++j) {
        const int t = 2 * (tid + FT * j);
        float xa0, xa1, xb0, xb1;
        hy_sconv2(r0 + FT * j, (unsigned)tid, j, w0, w1, w2, b, xa0, xa1);
        hy_sconv2(r1 + FT * j, (unsigned)tid, j, w0, w1, w2, b, xb0, xb1);
        P2 xp = (P2)(X + HP(t));
        const cf2 y = *xp;
        zr[j][0] = xa0 * (y.x + zr[j][0] * bias); zr[j][1] = xb0 * (y.y + zr[j][1] * bias);
        zr[j][2] = xa1 * (y.z + zr[j][2] * bias); zr[j][3] = xb1 * (y.w + zr[j][3] * bias);
        *xp = cf2{zr[j][0], zr[j][1], zr[j][2], zr[j][3]};
    }
}
template <class P> HYD void hy_gate2_step(P X, const unsigned* r0, const unsigned* r1, float w0, float w1, float w2, float b, float bias, const float (&zr)[8][4], unsigned* out0, unsigned* out1, int tid) {
    typedef typename HyP2<P>::type P2;
#pragma unroll
    for (int j = 0; j < 8; ++j) {
        const int t = 2 * (tid + FT * j);
        float xa0, xa1, xb0, xb1;
        hy_sconv2(r0 + FT * j, (unsigned)tid, j, w0, w1, w2, b, xa0, xa1);
        hy_sconv2(r1 + FT * j, (unsigned)tid, j, w0, w1, w2, b, xb0, xb1);
        const cf2 y = *(P2)(X + HP(t));
        const float za0 = xa0 * (y.x + zr[j][0] * bias), zb0 = xb0 * (y.y + zr[j][1] * bias);
        const float za1 = xa1 * (y.z + zr[j][2] * bias), zb1 = xb1 * (y.w + zr[j][3] * bias);
        (out0 + FT * j)[(unsigned)tid] = hy_f2bf(za0) | (hy_f2bf(za1) << 16);
        (out1 + FT * j)[(unsigned)tid] = hy_f2bf(zb0) | (hy_f2bf(zb1) << 16);
    }
}
HYD float hy_sconv1(unsigned D0, unsigned D1, int t, float w0, float w1, float w2, float b, bool pad0, bool padL) {
    const unsigned sh = ((unsigned)(t - 1) & 1u) << 4;
#ifdef HY_DEVICE
    const unsigned lo = __builtin_amdgcn_alignbit(D1, D0, sh), hi = D1 >> sh;
#else
    const unsigned long long w = (((unsigned long long)D1 << 32) | D0) >> sh; const unsigned lo = (unsigned)w, hi = (unsigned)(w >> 32);
#endif
    float e0 = hy_bf2f((unsigned short)(lo & 0xffffu)), e1 = hy_bf2f((unsigned short)(lo >> 16)), e2 = hy_bf2f((unsigned short)(hi & 0xffffu));
    if (pad0 && t == 0) e0 = 0.f;
    if (padL && t == SEQL - 1) e2 = 0.f;
    return b + w0 * e0 + w1 * e1 + w2 * e2;
}
struct HyRaw { unsigned d[2][8][4]; };
HYD void hy_raw_load(HyRaw& R, const unsigned* r0, const unsigned* r1, int tid) {
#pragma unroll
    for (int r = 0; r < 2; ++r)
#pragma unroll
        for (int k = 0; k < 8; ++k) { const unsigned du = ((unsigned)(tid + FT * r + 1024 * k + 1) >> 1) & 0x1fffu;
            R.d[r][k][0] = (r0 - 1)[du]; R.d[r][k][1] = r0[du]; R.d[r][k][2] = (r1 - 1)[du]; R.d[r][k][3] = r1[du]; }
}
template <class P, class PT> HYD void hy_convA_fwd(P X, PT thi, PT tlo, int tid, const HyRaw& R, float w0, float w1, float w2, float b, cf (&zr)[2][8]) {
#pragma unroll
    for (int r = 0; r < 2; ++r) {
        const int i0 = tid + FT * r, pb = HP(i0);
        cf e[16];
#pragma unroll
        for (int k = 0; k < 8; ++k) { const int t = i0 + 1024 * k; const bool p0 = (r == 0 && k == 0), pL = (r == 1 && k == 7); e[k] = cf{hy_sconv1(R.d[r][k][0], R.d[r][k][1], t, w0, w1, w2, b, p0, pL), hy_sconv1(R.d[r][k][2], R.d[r][k][3], t, w0, w1, w2, b, p0, pL)}; zr[r][k] = e[k]; }
#pragma unroll
        for (int k = 8; k < 16; ++k) e[k] = cf{0.f, 0.f};
        hy_bfly16<false, true, false>(e, hy_twid(thi, tlo, i0));
#pragma unroll
        for (int k = 0; k < 16; ++k) X[pb + k * 1088] = e[k];
    }
}
template <bool LAST, class P, class PT> HYD void hy_gateA(P X, PT thi, PT tlo, int tid, const HyRaw& R, float w0, float w1, float w2, float b, float bias,
                                                           cf (&zr)[2][8], unsigned short* out0, unsigned short* out1) {
#pragma unroll
    for (int r = 0; r < 2; ++r) {
        const int i0 = tid + FT * r, pb = HP(i0);
        cf e[16];
#pragma unroll
        for (int k = 0; k < 16; ++k) e[k] = X[pb + k * 1088];
        const cf tw = hy_twid(thi, tlo, i0);
        hy_bfly16<true, false, true>(e, tw);
#pragma unroll
        for (int k = 0; k < 8; ++k) { const int t = i0 + 1024 * k;
            const bool p0 = (r == 0 && k == 0), pL = (r == 1 && k == 7);
            const float xa = hy_sconv1(R.d[r][k][0], R.d[r][k][1], t, w0, w1, w2, b, p0, pL), xb = hy_sconv1(R.d[r][k][2], R.d[r][k][3], t, w0, w1, w2, b, p0, pL);
            const cf z = cf{xa * (e[k].x + zr[r][k].x * bias), xb * (e[k].y + zr[r][k].y * bias)};
            if (LAST) {
#ifdef HY_DEVICE
                unsigned pk; asm("v_cvt_pk_bf16_f32 %0, %1, %2" : "=v"(pk) : "v"(z.x), "v"(z.y)); const unsigned ti = (unsigned)t & 0x1fffu; out0[ti] = (unsigned short)(pk & 0xffffu); out1[ti] = (unsigned short)(pk >> 16);
#else
                out0[t] = (unsigned short)hy_f2bf(z.x); out1[t] = (unsigned short)hy_f2bf(z.y);
#endif
            }
            else { zr[r][k] = z; e[k] = z; } }
        if (!LAST) {
#pragma unroll
            for (int k = 8; k < 16; ++k) e[k] = cf{0.f, 0.f};
            hy_bfly16<false, true, false>(e, tw);
#pragma unroll
            for (int k = 0; k < 16; ++k) X[pb + k * 1088] = e[k];
        }
    }
}
constexpr int NWAVES = 8, NTHR = NWAVES * 64;
constexpr int DM = 2048, SEQ = 8192, DEPTH = 4, NSEQ = 6, GSEQ = 2, NGRP = NSEQ / GSEQ, MG = GSEQ * SEQ;
constexpr int HYW = 1024, HYIN = 3072, QKVW = 3072, DFF = 5632, GU = 2 * DFF, FEMB = 33, FHID = 64;
constexpr float EPS = 1e-6f;
constexpr float QSCALE = 0.125f * 1.4426950408889634f;
constexpr size_t MiB = 1u << 20;
constexpr size_t WS_CTL = 0, CTL_ZERO_BYTES = 1 * MiB;
constexpr size_t SZ_WHY = (size_t)HYIN * DM * 2, SZ_WQKV = (size_t)QKVW * DM * 2, SZ_WOUT = (size_t)DM * DM * 2, SZ_WGU = (size_t)GU * DM * 2, SZ_WDN = (size_t)DM * DFF * 2;
constexpr size_t OFF_WHY = 0, OFF_WQKV = OFF_WHY + SZ_WHY, OFF_WOUT = OFF_WQKV + SZ_WQKV, OFF_WGU = OFF_WOUT + SZ_WOUT, OFF_WDN = OFF_WGU + SZ_WGU, SZ_WLAYER = OFF_WDN + SZ_WDN;
constexpr size_t WS_W = 1 * MiB;
constexpr size_t WS_ROPE = WS_W + DEPTH * SZ_WLAYER;
constexpr int KPAD = 256;
constexpr size_t WS_H3 = WS_ROPE + (size_t)SEQ * 32 * 8;
constexpr size_t WS_W4T = WS_H3 + (size_t)DEPTH * SEQ * KPAD * 2;
constexpr size_t WS_TAPS = WS_W4T + (size_t)DEPTH * 4096 * KPAD * 2;
constexpr size_t WS_FFTK = WS_TAPS + (size_t)4096 * SEQ * 2;
constexpr size_t WS_STASH = WS_FFTK + (size_t)256 * 2 * 16384 * 8;
constexpr size_t WS_XB = WS_STASH;
constexpr size_t WS_H = WS_XB + (size_t)MG * DM * 2;
constexpr size_t WS_ZT = WS_H + (size_t)MG * DM * 2;
constexpr size_t WS_PROJT = WS_ZT + (size_t)HYW * MG * 2;
constexpr size_t WS_QKV = WS_PROJT + (size_t)HYIN * MG * 2;
constexpr size_t WS_MIX = WS_PROJT;
constexpr size_t WS_FFH = WS_PROJT;
constexpr size_t WS_MIXIN = WS_QKV + (size_t)MG * QKVW * 2;
constexpr size_t WS_END = WS_MIXIN + (size_t)MG * DM * 2;
constexpr size_t SZ_TAPS = (size_t)4096 * SEQ * 2, WS_TAPS_X = WS_END, WS_END_X = WS_TAPS_X + (DEPTH - 1) * SZ_TAPS;
static_assert((size_t)MG * DFF * 2 <= (size_t)HYIN * MG * 2 + (size_t)MG * QKVW * 2, "FFH overlay fits PROJT|QKV");
static_assert(WS_W4T % 256 == 0 && WS_TAPS % 256 == 0 && WS_ROPE % 256 == 0 && WS_H3 % 256 == 0 && WS_FFTK % 256 == 0 && WS_XB % 256 == 0 && WS_H % 256 == 0 && SZ_WLAYER % 256 == 0, "alignment");
constexpr int CW_BAR = 4096;
constexpr int PH_PER_LAYER = 8, PH_PER_GROUP = 1 + DEPTH * PH_PER_LAYER, NPHASE = 1 + NGRP * PH_PER_GROUP;
constexpr int RING_OFF = 0, RING_BYTES = 131072;
constexpr int TAB_OFF = 139264;
constexpr int MISC_OFF = TAB_OFF + 4096;
constexpr int LDS_BYTES = 147456;
static_assert(MISC_OFF + 128 <= LDS_BYTES, "LDS map");
static_assert(att::SHM_ATTN_ALL <= MISC_OFF, "attention LDS fits below the control words");
#ifndef PROBE_DUP
#define PROBE_DUP 0
#endif
#ifndef MK_PER_PHASE
#define MK_PER_PHASE 0
#endif

struct Args { const float* in[30]; float* out; unsigned char* ws; int ph_lo, ph_hi, taps_all, pad; };
enum { I_XP = 0, I_XS, I_GMPRE, I_GMPOST, I_GFPRE, I_GFPOST, I_WIN, I_CONVW, I_CONVB, I_FW1, I_FB1, I_FF1, I_FW2, I_FB2, I_FF2, I_FW3, I_FB3, I_FF3, I_FW4,
       I_HBIAS, I_HNORM, I_LQ1, I_LK1, I_LQ2, I_LK2, I_SUBLN, I_WOUT, I_WGATE, I_WUP, I_WDOWN };

template <int K> __device__ __forceinline__ float swz_xor(float v) { return __builtin_bit_cast(float, __builtin_amdgcn_ds_swizzle(__builtin_bit_cast(int, v), (K << 10) | 0x1f)); }
__device__ __forceinline__ float wave_sum(float v) {
    v += swz_xor<1>(v); v += swz_xor<2>(v); v += swz_xor<4>(v); v += swz_xor<8>(v); v += swz_xor<16>(v);
    auto rr = __builtin_amdgcn_permlane32_swap(__float_as_uint(v), __float_as_uint(v), false, false);
    return __uint_as_float(rr[0]) + __uint_as_float(rr[1]);
}
__device__ __forceinline__ bf16* wt_dst_row(int kind, int n, bf16* d0, bf16* d1, int K) {
    if (kind == 0) return d0 + (size_t)n * K;
    if (kind == 1) { if (n < HYIN) return d0 + (size_t)n * K; int q = n - HYIN; if (q < 2048) { const int hb = q & ~63, i = q & 63; q = hb + (i < 32 ? 2 * i : 2 * (i - 32) + 1); } return d1 + (size_t)q * K; }
    if (kind == 4) return d0 + (size_t)n * KPAD;
    const int r = (n >> 7) * 256 + (n & 127) + (kind == 3 ? 128 : 0); return d0 + (size_t)r * K;
}
__device__ __forceinline__ void p0_transpose_item(const float* W, int K, int N, int kind, bf16* d0, bf16* d1, LAS float* scr, int item, int lane) {
    const int nblk = N / 32, kb = item / nblk, nb = item % nblk, k0 = 64 * kb, n0 = 32 * nb;
#pragma unroll 8
    for (int i = 0; i < 32; ++i) { const int kk = 2 * i + (lane >> 5); scr[kk * 33 + (lane & 31)] = W[(size_t)(k0 + kk) * N + n0 + (lane & 31)]; }
    LDS_WAIT(); asm volatile("" ::: "memory");
    const int c = lane & 7;
#pragma unroll
    for (int j = 0; j < 4; ++j) { const int n = (lane >> 3) + 8 * j; const LAS float* s = scr + (8 * c) * 33 + n;
        v4u o; o.x = pk2(s[0 * 33], s[1 * 33]); o.y = pk2(s[2 * 33], s[3 * 33]); o.z = pk2(s[4 * 33], s[5 * 33]); o.w = pk2(s[6 * 33], s[7 * 33]);
        *(GAS v4u*)(wt_dst_row(kind, n0 + n, d0, d1, K) + k0 + 8 * c) = o; }
    LDS_WAIT(); asm volatile("" ::: "memory");
}
__device__ __forceinline__ void sincos_red(double ang, float& s, float& c) {
    const double k = rint(ang * 0.15915494309189535); const float r = (float)(ang - k * 6.283185307179586);
    s = sinf(r); c = cosf(r);
}
#define GP(p) ((const float*)(const GAS float*)(p))
#define LAUNDER_TID(F) do { int t_ = (F).tid; asm volatile("" : "+v"(t_)); (F).tid = t_; (F).lane = t_ & 63; int z_ = 0; asm volatile("" : "+s"(z_)); (F).z = z_; unsigned long long w_ = (unsigned long long)(F).ws0; asm volatile("" : "+s"(w_)); (F).ws = (unsigned char*)(GAS unsigned char*)w_; int b_ = (F).bx0, v_ = (F).vcu0, g_ = (F).G0; asm volatile("" : "+s"(b_), "+s"(v_), "+s"(g_)); (F).bx = b_; (F).vcu = v_; (F).G = g_; } while (0)
struct Frame {
    LAS unsigned char* lds; volatile LAS unsigned* MISC; gu32* ctl;
    int tid, lane, wave, vcu, G, bx;
    int vcu0, G0, bx0;
    float* out; unsigned char* ws; unsigned char* ws0; int z;
};
__device__ __forceinline__ void p0_prologue(Frame& F, const Args& A) {
    LAS float* scr = (LAS float*)(F.lds + RING_OFF + F.wave * 16384);
    const int gw = F.vcu * NWAVES + F.wave, NGW = F.G * NWAVES;
    constexpr int I_IN = (DM / 64) * ((HYIN + QKVW) / 32), I_OUT = (DM / 64) * (DM / 32), I_G = (DM / 64) * (DFF / 32), I_D = (DFF / 64) * (DM / 32);
    constexpr int I_W4 = 4096 / 32;
    constexpr int PER_L = I_IN + I_OUT + 2 * I_G + I_D + I_W4;
    for (int it = gw; it < DEPTH * PER_L; it += NGW) {
        const int l = it / PER_L; int r = it % PER_L;
        unsigned char* wl = F.ws + WS_W + (size_t)l * SZ_WLAYER;
        if (r < I_IN) { p0_transpose_item(GP(A.in[I_WIN + F.z]) + (size_t)l * DM * (HYIN + QKVW), DM, HYIN + QKVW, 1, (bf16*)(wl + OFF_WHY), (bf16*)(wl + OFF_WQKV), scr, r, F.lane); continue; } r -= I_IN;
        if (r < I_OUT) { p0_transpose_item(GP(A.in[I_WOUT + F.z]) + (size_t)l * DM * DM, DM, DM, 0, (bf16*)(wl + OFF_WOUT), nullptr, scr, r, F.lane); continue; } r -= I_OUT;
        if (r < I_G) { p0_transpose_item(GP(A.in[I_WGATE + F.z]) + (size_t)l * DM * DFF, DM, DFF, 2, (bf16*)(wl + OFF_WGU), nullptr, scr, r, F.lane); continue; } r -= I_G;
        if (r < I_G) { p0_transpose_item(GP(A.in[I_WUP + F.z]) + (size_t)l * DM * DFF, DM, DFF, 3, (bf16*)(wl + OFF_WGU), nullptr, scr, r, F.lane); continue; } r -= I_G;
        if (r < I_D) { p0_transpose_item(GP(A.in[I_WDOWN + F.z]) + (size_t)l * DFF * DM, DFF, DM, 0, (bf16*)(wl + OFF_WDN), nullptr, scr, r, F.lane); continue; } r -= I_D;
        { bf16* w4t = (bf16*)(F.ws + WS_W4T) + (size_t)l * 4096 * KPAD;
          p0_transpose_item(GP(A.in[I_FW4 + F.z]) + (size_t)l * FHID * 4096, FHID, 4096, 4, w4t, nullptr, scr, r, F.lane);
          for (int e = F.lane; e < 32 * 24; e += 64) *(GAS v4u*)(w4t + (size_t)(32 * r + e / 24) * KPAD + 64 + 8 * (e % 24)) = (v4u){0u, 0u, 0u, 0u}; }
    }
    {
        float* cs = (float*)(F.ws + WS_ROPE);
        for (int e = F.vcu * NTHR + F.tid; e < SEQ * 32; e += F.G * NTHR) {
            const int t = e >> 5, p = e & 31;
            const double inv = exp(-9.210340371976184 * (double)(2 * p) / 64.0);
            float s, c; sincos_red((double)t * inv, s, c);
            cs[2 * e] = c; cs[2 * e + 1] = s;
        }
    }
    {
        bf16* h3b = (bf16*)(F.ws + WS_H3);
        LAS float* hb = (LAS float*)(F.lds + RING_OFF + F.wave * 16384);
        for (int task = gw; task < DEPTH * (SEQ / 64); task += NGW) {
            const int l = task / (SEQ / 64), t = (task % (SEQ / 64)) * 64 + F.lane;
            const float* w1 = GP(A.in[I_FW1 + F.z]) + (size_t)l * FEMB * FHID; const float* w2 = GP(A.in[I_FW2 + F.z]) + (size_t)l * FHID * FHID; const float* w3 = GP(A.in[I_FW3 + F.z]) + (size_t)l * FHID * FHID;
            hb[F.lane] = (float)t * (1.0f / (float)(SEQ - 1));
#pragma unroll 1
            for (int bi = 0; bi < 16; ++bi) { const double band = 1e-4 + (double)bi * ((15.0 - 1e-4) / 15.0);
                float s, c; sincos_red(6.283185307179586 * (double)t / (double)SEQ * band, s, c); hb[(1 + bi) * 64 + F.lane] = c; hb[(17 + bi) * 64 + F.lane] = -s; }
#pragma unroll 1
            for (int stage = 0; stage < 3; ++stage) {
                const float* w = stage == 0 ? w1 : (stage == 1 ? w2 : w3);
                const float* bb = (stage == 0 ? GP(A.in[I_FB1 + F.z]) : (stage == 1 ? GP(A.in[I_FB2 + F.z]) : GP(A.in[I_FB3 + F.z]))) + l * FHID;
                const float* ff = (stage == 0 ? GP(A.in[I_FF1 + F.z]) : (stage == 1 ? GP(A.in[I_FF2 + F.z]) : GP(A.in[I_FF3 + F.z]))) + l * FHID;
                const int nin = stage == 0 ? FEMB : FHID;
                typedef float f32x16_t __attribute__((ext_vector_type(16)));
                f32x16_t c0 = {}, c1 = {}, c2 = {}, c3 = {};
                LDS_WAIT();
#pragma unroll 1
                for (int i = 0; i < nin; ++i) { const float hv = hb[i * 64 + F.lane]; const f32x16_t* wr = (const f32x16_t*)(w + i * FHID);
                    c0 += wr[0] * hv; c1 += wr[1] * hv; c2 += wr[2] * hv; c3 += wr[3] * hv; }
                const f32x16_t* b16 = (const f32x16_t*)bb; const f32x16_t* f16 = (const f32x16_t*)ff;
                c0 = (c0 + b16[0]) * f16[0]; c1 = (c1 + b16[1]) * f16[1]; c2 = (c2 + b16[2]) * f16[2]; c3 = (c3 + b16[3]) * f16[3];
                if (stage < 2) {
#pragma unroll
                    for (int e = 0; e < 16; ++e) { hb[e * 64 + F.lane] = sinf(c0[e]); hb[(16 + e) * 64 + F.lane] = sinf(c1[e]); hb[(32 + e) * 64 + F.lane] = sinf(c2[e]); hb[(48 + e) * 64 + F.lane] = sinf(c3[e]); }
                } else {
                    GAS v4u* o = (GAS v4u*)(h3b + ((size_t)l * SEQ + t) * KPAD);
#pragma unroll
                    for (int q = 0; q < 2; ++q) { v4u w; w.x = pk2(sinf(c0[8 * q]), sinf(c0[8 * q + 1])); w.y = pk2(sinf(c0[8 * q + 2]), sinf(c0[8 * q + 3])); w.z = pk2(sinf(c0[8 * q + 4]), sinf(c0[8 * q + 5])); w.w = pk2(sinf(c0[8 * q + 6]), sinf(c0[8 * q + 7])); o[q] = w; }
#pragma unroll
                    for (int q = 0; q < 2; ++q) { v4u w; w.x = pk2(sinf(c1[8 * q]), sinf(c1[8 * q + 1])); w.y = pk2(sinf(c1[8 * q + 2]), sinf(c1[8 * q + 3])); w.z = pk2(sinf(c1[8 * q + 4]), sinf(c1[8 * q + 5])); w.w = pk2(sinf(c1[8 * q + 6]), sinf(c1[8 * q + 7])); o[2 + q] = w; }
#pragma unroll
                    for (int q = 0; q < 2; ++q) { v4u w; w.x = pk2(sinf(c2[8 * q]), sinf(c2[8 * q + 1])); w.y = pk2(sinf(c2[8 * q + 2]), sinf(c2[8 * q + 3])); w.z = pk2(sinf(c2[8 * q + 4]), sinf(c2[8 * q + 5])); w.w = pk2(sinf(c2[8 * q + 6]), sinf(c2[8 * q + 7])); o[4 + q] = w; }
#pragma unroll
                    for (int q = 0; q < 2; ++q) { v4u w; w.x = pk2(sinf(c3[8 * q]), sinf(c3[8 * q + 1])); w.y = pk2(sinf(c3[8 * q + 2]), sinf(c3[8 * q + 3])); w.z = pk2(sinf(c3[8 * q + 4]), sinf(c3[8 * q + 5])); w.w = pk2(sinf(c3[8 * q + 6]), sinf(c3[8 * q + 7])); o[6 + q] = w; }
#pragma unroll 1
                    for (int q = 8; q < 32; ++q) o[q] = (v4u){0u, 0u, 0u, 0u};
                }
            }
        }
    }
}
template <bool XSB>
__device__ __forceinline__ void norm_pass(Frame& F, const void* x_src, const bf16* add, const float* g_add, bf16* xb_dst, float* xf_dst, const float* g_out, bf16* h_dst) {
    const int gw = F.vcu * NWAVES + F.wave, NGW = F.G * NWAVES;
#define UNPK(q, lo, hi) do { lo = (f32x4){__uint_as_float((q).x << 16), __uint_as_float((q).x & 0xffff0000u), __uint_as_float((q).y << 16), __uint_as_float((q).y & 0xffff0000u)}; \
                             hi = (f32x4){__uint_as_float((q).z << 16), __uint_as_float((q).z & 0xffff0000u), __uint_as_float((q).w << 16), __uint_as_float((q).w & 0xffff0000u)}; } while (0)
#define PK8(lo, hi) (v4u){pk2((lo)[0], (lo)[1]), pk2((lo)[2], (lo)[3]), pk2((hi)[0], (hi)[1]), pk2((hi)[2], (hi)[3])}
    f32x4 gA[8], gO[8];
#pragma unroll
    for (int j = 0; j < 8; ++j) { gA[j] = (f32x4){0.f, 0.f, 0.f, 0.f}; gO[j] = (f32x4){0.f, 0.f, 0.f, 0.f}; }
    if (add) { const GAS f32x4* gr = (const GAS f32x4*)g_add + 2 * F.lane;
#pragma unroll
        for (int j = 0; j < 4; ++j) { gA[2 * j] = gr[128 * j]; gA[2 * j + 1] = gr[128 * j + 1]; } }
    if (h_dst) { const GAS f32x4* gr = (const GAS f32x4*)g_out + 2 * F.lane;
#pragma unroll
        for (int j = 0; j < 4; ++j) { gO[2 * j] = gr[128 * j]; gO[2 * j + 1] = gr[128 * j + 1]; } }
    for (int m0 = gw; m0 < MG; m0 += 2 * NGW) {
        const int m1 = m0 + NGW; const bool two = m1 < MG; const int mb = two ? m1 : m0;
        f32x4 va[8], vb[8];
        if (XSB) {
            const GAS v4u* xa = (const GAS v4u*)((const bf16*)x_src + (size_t)m0 * DM) + F.lane; const GAS v4u* xb = (const GAS v4u*)((const bf16*)x_src + (size_t)mb * DM) + F.lane;
            v4u qa[4], qb[4];
#pragma unroll
            for (int j = 0; j < 4; ++j) { qa[j] = xa[64 * j]; qb[j] = xb[64 * j]; }
#pragma unroll
            for (int j = 0; j < 4; ++j) { UNPK(qa[j], va[2 * j], va[2 * j + 1]); UNPK(qb[j], vb[2 * j], vb[2 * j + 1]); }
        } else {
            const GAS f32x4* xa = (const GAS f32x4*)((const float*)x_src + (size_t)m0 * DM) + 2 * F.lane; const GAS f32x4* xb = (const GAS f32x4*)((const float*)x_src + (size_t)mb * DM) + 2 * F.lane;
#pragma unroll
            for (int j = 0; j < 4; ++j) { va[2 * j] = xa[128 * j]; va[2 * j + 1] = xa[128 * j + 1]; vb[2 * j] = xb[128 * j]; vb[2 * j + 1] = xb[128 * j + 1]; }
        }
        if (add) {
            const GAS v4u* aa = (const GAS v4u*)(add + (size_t)m0 * DM) + F.lane; const GAS v4u* ab = (const GAS v4u*)(add + (size_t)mb * DM) + F.lane;
            v4u wa[4], wb[4];
#pragma unroll
            for (int j = 0; j < 4; ++j) { wa[j] = aa[64 * j]; wb[j] = ab[64 * j]; }
            float sa = 0.f, sb = 0.f;
#pragma unroll
            for (int j = 0; j < 4; ++j) { f32x4 a0, a1, b0, b1; UNPK(wa[j], a0, a1); UNPK(wb[j], b0, b1);
                sa += ((a0[0] * a0[0] + a0[1] * a0[1]) + (a0[2] * a0[2] + a0[3] * a0[3])) + ((a1[0] * a1[0] + a1[1] * a1[1]) + (a1[2] * a1[2] + a1[3] * a1[3]));
                sb += ((b0[0] * b0[0] + b0[1] * b0[1]) + (b0[2] * b0[2] + b0[3] * b0[3])) + ((b1[0] * b1[0] + b1[1] * b1[1]) + (b1[2] * b1[2] + b1[3] * b1[3])); }
            const float ra = 1.0f / sqrtf(wave_sum(sa) * (1.0f / DM) + EPS), rb = 1.0f / sqrtf(wave_sum(sb) * (1.0f / DM) + EPS);
#pragma unroll
            for (int j = 0; j < 4; ++j) { const f32x4 g0 = gA[2 * j], g1 = gA[2 * j + 1]; f32x4 a0, a1, b0, b1; UNPK(wa[j], a0, a1); UNPK(wb[j], b0, b1);
                va[2 * j] = va[2 * j] + a0 * ra * g0; va[2 * j + 1] = va[2 * j + 1] + a1 * ra * g1; vb[2 * j] = vb[2 * j] + b0 * rb * g0; vb[2 * j + 1] = vb[2 * j + 1] + b1 * rb * g1; }
        }
        if (xf_dst) { GAS f32x4* oa = (GAS f32x4*)(xf_dst + (size_t)m0 * DM) + 2 * F.lane; GAS f32x4* ob = (GAS f32x4*)(xf_dst + (size_t)mb * DM) + 2 * F.lane;
#pragma unroll
            for (int j = 0; j < 4; ++j) { oa[128 * j] = va[2 * j]; oa[128 * j + 1] = va[2 * j + 1]; if (two) { ob[128 * j] = vb[2 * j]; ob[128 * j + 1] = vb[2 * j + 1]; } } }
        if (xb_dst) { GAS v4u* oa = (GAS v4u*)(xb_dst + (size_t)m0 * DM) + F.lane; GAS v4u* ob = (GAS v4u*)(xb_dst + (size_t)mb * DM) + F.lane;
#pragma unroll
            for (int j = 0; j < 4; ++j) { const v4u w = PK8(va[2 * j], va[2 * j + 1]); oa[64 * j] = w;
                UNPK(w, va[2 * j], va[2 * j + 1]);
                const v4u w2 = PK8(vb[2 * j], vb[2 * j + 1]); if (two) ob[64 * j] = w2;
                UNPK(w2, vb[2 * j], vb[2 * j + 1]); } }
        if (h_dst) {
            float sa = 0.f, sb = 0.f;
#pragma unroll
            for (int j = 0; j < 8; ++j) { sa += (va[j][0] * va[j][0] + va[j][1] * va[j][1]) + (va[j][2] * va[j][2] + va[j][3] * va[j][3]); sb += (vb[j][0] * vb[j][0] + vb[j][1] * vb[j][1]) + (vb[j][2] * vb[j][2] + vb[j][3] * vb[j][3]); }
            const float ra = 1.0f / sqrtf(wave_sum(sa) * (1.0f / DM) + EPS), rb = 1.0f / sqrtf(wave_sum(sb) * (1.0f / DM) + EPS);
            GAS v4u* ha = (GAS v4u*)(h_dst + (size_t)m0 * DM) + F.lane; GAS v4u* hb2 = (GAS v4u*)(h_dst + (size_t)mb * DM) + F.lane;
#pragma unroll
            for (int j = 0; j < 4; ++j) { const f32x4 g0 = gO[2 * j], g1 = gO[2 * j + 1];
                const f32x4 oa0 = va[2 * j] * ra * g0, oa1 = va[2 * j + 1] * ra * g1, ob0 = vb[2 * j] * rb * g0, ob1 = vb[2 * j + 1] * rb * g1;
                ha[64 * j] = PK8(oa0, oa1);
                if (two) hb2[64 * j] = PK8(ob0, ob1); }
        }
    }
#undef UNPK
#undef PK8
}
typedef LAS cf* lcf;
template <bool ZUP> __device__ __forceinline__ void hy_fwd(lcf X, lcf thi, lcf tlo, int tid, const cf* KM) {
    if (ZUP) hy_pass16<1024, false, true, false>(X, thi, tlo, tid); else hy_pass16<1024, false, false, false>(X, thi, tlo, tid);
    __syncthreads();
    hy_pass16<64, false, false, false>(X, thi, tlo, tid);
    hy_pass16<4, false, false, false>(X, thi, tlo, tid);
    hy_pass4<false>(X, tid, KM); __syncthreads();
}
__device__ __forceinline__ void hy_inv(lcf X, lcf thi, lcf tlo, int tid) {
    const cf* nul = nullptr;
    hy_pass4<true>(X, tid, nul); __syncthreads();
    hy_pass16<4, true, false, false>(X, thi, tlo, tid); __syncthreads();
    hy_pass16<64, true, false, false>(X, thi, tlo, tid); __syncthreads();
    hy_pass16<1024, true, false, true>(X, thi, tlo, tid); __syncthreads();
}
__device__ __forceinline__ void hy_mid(lcf X, lcf thi, lcf tlo, int tid, const cf* KM) {
    const cf* nul = nullptr;
    hy_pass16<64, false, false, false>(X, thi, tlo, tid);
    hy_pass16<4, false, false, false>(X, thi, tlo, tid);
    hy_pass4<false>(X, tid, KM);
    hy_pass4<true>(X, tid, nul);
    hy_pass16<4, true, false, false>(X, thi, tlo, tid);
    hy_pass16<64, true, false, false>(X, thi, tlo, tid); __syncthreads();
}
__device__ __forceinline__ void hyena_phase(Frame& F, const Args& A, int l) {
    lcf X = (lcf)(F.lds + RING_OFF); lcf thi = (lcf)(F.lds + TAB_OFF); lcf tlo = thi + 128;
    const int tid = F.tid;
    if (tid < 256) { const int a = tid & 127; const double ang = -6.283185307179586 * (double)(tid < 128 ? 128 * a : a) / (double)FN; float s, c; sincos_red(ang, s, c); (tid < 128 ? thi : tlo)[a] = cf{c, s}; }
    cf* K1g = (cf*)(F.ws + WS_FFTK) + (size_t)F.bx * 2 * FN; cf* K2g = K1g + FN;
    const bf16* taps = (const bf16*)(F.ws + ((A.taps_all && l > 0) ? WS_TAPS_X + (size_t)(l - 1) * SZ_TAPS : WS_TAPS));
    const float* cw = GP(A.in[I_CONVW + F.z]) + (size_t)l * 3 * HYIN; const float* cb = GP(A.in[I_CONVB + F.z]) + (size_t)l * HYIN; const float* hb = GP(A.in[I_HBIAS + F.z]) + (size_t)l * 2 * HYW;
    const bf16* projT = (const bf16*)(F.ws + WS_PROJT); bf16* zT = (bf16*)(F.ws + WS_ZT);
    for (int c = F.vcu; c < HYW; c += F.G) {
        __syncthreads();
        const float delta = fabsf(-15.350567286626973f + (float)c * ((-3.0701134573253945f + 15.350567286626973f) / 1023.0f));
#define TIDX(v) int v = tid; asm volatile("" : "+v"(v))
        { TIDX(t_); hy_filter_step(X, taps + (size_t)c * SEQ, delta, t_); }
        const unsigned* rx1 = (const unsigned*)(projT + (size_t)c * MG); const unsigned* rx2 = (const unsigned*)(projT + (size_t)(HYW + c) * MG); const unsigned* rv = (const unsigned*)(projT + (size_t)(2 * HYW + c) * MG);
        HyRaw R;
        { TIDX(t_); hy_raw_load(R, rv, rv + SEQ / 2, t_); }
        __syncthreads();
        { TIDX(t_); hy_fwd<false>(X, thi, tlo, t_, nullptr); }
        { TIDX(t_); hy_sep_step(X, K1g, K2g, t_); }
        asm volatile("s_waitcnt vmcnt(0)" ::: "memory"); __syncthreads();
        cf zr[2][8];
        { TIDX(t_); hy_convA_fwd(X, thi, tlo, t_, R, cw[2 * HYW + c], cw[HYIN + 2 * HYW + c], cw[2 * HYIN + 2 * HYW + c], cb[2 * HYW + c], zr); }
        { TIDX(t_); hy_raw_load(R, rx1, rx1 + SEQ / 2, t_); }
        __syncthreads();
        { TIDX(t_); hy_mid(X, thi, tlo, t_, K1g); }
        { TIDX(t_); hy_gateA<false>(X, thi, tlo, t_, R, cw[c], cw[HYIN + c], cw[2 * HYIN + c], cb[c], hb[c], zr, (unsigned short*)nullptr, (unsigned short*)nullptr); }
        { TIDX(t_); hy_raw_load(R, rx2, rx2 + SEQ / 2, t_); }
        __syncthreads();
        { TIDX(t_); hy_mid(X, thi, tlo, t_, K2g); }
        unsigned short* zo = (unsigned short*)(zT + (size_t)c * MG);
        { TIDX(t_); hy_gateA<true>(X, thi, tlo, t_, R, cw[HYW + c], cw[HYIN + HYW + c], cw[2 * HYIN + HYW + c], cb[HYW + c], hb[HYW + c], zr, zo, zo + SEQ); }
#undef TIDX
    }
    __syncthreads();
}
__device__ __forceinline__ void hynorm_phase(Frame& F, const Args& A, int l) {
    constexpr int TB = 64;
    LAS unsigned char* tile = F.lds + RING_OFF; LAS float* red = (LAS float*)(F.lds + RING_OFF + TB * HYW * 2); LAS float* rinv = red + 8 * TB;
    const bf16* zT = (const bf16*)(F.ws + WS_ZT); bf16* mixin = (bf16*)(F.ws + WS_MIXIN); const float* gn = GP(A.in[I_HNORM + F.z]) + (size_t)l * HYW;
    const int tid = F.tid;
    for (int tb = F.vcu; tb < MG / TB; tb += F.G) {
        const int t0 = tb * TB; __syncthreads();
        float ps[8];
#pragma unroll
        for (int i = 0; i < 8; ++i) ps[i] = 0.f;
        const int k = tid & 7, crow = tid >> 3;
#pragma unroll
        for (int hb = 0; hb < 2; ++hb) {
            v4u w[8];
#pragma unroll
            for (int it = 0; it < 8; ++it) { const unsigned c = (unsigned)((hb * 8 + it) * 64 + crow) & 1023u; w[it] = *(const GAS v4u*)(zT + (size_t)c * MG + (unsigned)(t0 + 8 * k)); }
#pragma unroll
            for (int it = 0; it < 8; ++it) { const int c = (hb * 8 + it) * 64 + crow;
                LAS unsigned short* d = (LAS unsigned short*)(tile + (8 * k) * 2048 + (((c >> 3) ^ k) << 4) + (c & 7) * 2);
                const unsigned ww[4] = {w[it].x, w[it].y, w[it].z, w[it].w};
#pragma unroll
                for (int i = 0; i < 4; ++i) { d[(2 * i) * 1024] = (unsigned short)(ww[i] & 0xffffu); d[(2 * i + 1) * 1024] = (unsigned short)(ww[i] >> 16);
                    const float a = __uint_as_float(ww[i] << 16), b = __uint_as_float(ww[i] & 0xffff0000u); ps[2 * i] += a * a; ps[2 * i + 1] += b * b; } }
        }
#pragma unroll
        for (int i = 0; i < 8; ++i) { float v = ps[i]; v += swz_xor<8>(v); v += swz_xor<16>(v);
            auto rr = __builtin_amdgcn_permlane32_swap(__float_as_uint(v), __float_as_uint(v), false, false); ps[i] = __uint_as_float(rr[0]) + __uint_as_float(rr[1]); }
        if ((F.lane >> 3) == 0) {
#pragma unroll
            for (int i = 0; i < 8; ++i) red[F.wave * TB + 8 * k + i] = ps[i]; }
        __syncthreads();
        if (tid < TB) { float s = 0.f;
#pragma unroll
            for (int w8 = 0; w8 < 8; ++w8) s += red[w8 * TB + tid];
            rinv[tid] = 1.0f / sqrtf(s * (1.0f / HYW) + EPS); }
        __syncthreads();
        const int cg = tid & 127;
        const f32x4 g0 = *(const f32x4*)(gn + 8 * cg), g1 = *(const f32x4*)(gn + 8 * cg + 4);
#pragma unroll 4
        for (int it = 0; it < 16; ++it) { const int tok = it * 4 + (tid >> 7); const float r = rinv[tok];
            const v4u q = *(const LAS v4u*)(tile + tok * 2048 + ((cg ^ (tok >> 3)) << 4));
            v4u o; o.x = pk2(__uint_as_float(q.x << 16) * r * g0[0], __uint_as_float(q.x & 0xffff0000u) * r * g0[1]); o.y = pk2(__uint_as_float(q.y << 16) * r * g0[2], __uint_as_float(q.y & 0xffff0000u) * r * g0[3]);
            o.z = pk2(__uint_as_float(q.z << 16) * r * g1[0], __uint_as_float(q.z & 0xffff0000u) * r * g1[1]); o.w = pk2(__uint_as_float(q.w << 16) * r * g1[2], __uint_as_float(q.w & 0xffff0000u) * r * g1[3]);
            *(GAS v4u*)(mixin + (size_t)(t0 + tok) * DM + 8 * cg) = o; }
    }
    __syncthreads();
}
__device__ __forceinline__ void attn_phase(Frame& F, const Args& A, int l, unsigned char* lds_generic) {
    const float li = 0.8f - 0.6f * expf(-0.3f * (float)l);
    float lam;
    { const int j = F.lane; const float a = GP(A.in[I_LQ1 + F.z])[l * 64 + j] * GP(A.in[I_LK1 + F.z])[l * 64 + j], b = GP(A.in[I_LQ2 + F.z])[l * 64 + j] * GP(A.in[I_LK2 + F.z])[l * 64 + j];
      lam = expf(wave_sum(a)) - expf(wave_sum(b)) + li; }
    const att::bf16* qkv = (const att::bf16*)(F.ws + WS_QKV); att::bf16* mixin = (att::bf16*)(F.ws + WS_MIXIN);
    float* stash = (float*)(F.ws + WS_H) + (size_t)F.bx * 64 * 512;
    const float* subln = GP(A.in[I_SUBLN + F.z]) + (size_t)l * 128;
    constexpr int NU = GSEQ * 8 * (SEQ / 256);
    for (int u = F.vcu; u < NU; u += F.G) {
        const int bvh = u >> 5, qb = u & 31, b = bvh >> 3, vh = bvh & 7;
        const long krow0 = (long)b * SEQ, qrow0 = krow0 + qb * 256;
        att::attn_unit(qkv, qrow0, krow0, vh, SEQ, lam, 1.0f - li, subln, mixin + (size_t)qrow0 * DM + HYW + vh * 128, DM, stash, (char*)lds_generic);
        __syncthreads();
    }
}
#ifndef PHMASK
#define PHMASK 511
#endif
__global__ void __launch_bounds__(NTHR, 2) hymba_fwd(Args args) {
    extern __shared__ __attribute__((aligned(16))) unsigned char lds[];
    Frame F;
    F.lds = (LAS unsigned char*)lds; F.MISC = (volatile LAS unsigned*)(F.lds + MISC_OFF);
    F.tid = threadIdx.x; F.lane = F.tid & 63; F.wave = __builtin_amdgcn_readfirstlane(F.tid >> 6);
    F.G = gridDim.x; { const int bx = blockIdx.x; F.vcu = (F.G % 8 == 0) ? (bx % 8) * (F.G / 8) + bx / 8 : bx; F.bx = bx; }
    F.vcu0 = F.vcu; F.G0 = F.G; F.bx0 = F.bx;
    F.ctl = (gu32*)(args.ws + WS_CTL); F.out = args.out; F.ws = args.ws; F.ws0 = args.ws; F.z = 0;
    for (int u = F.tid; u < (LDS_BYTES - MISC_OFF) / 4; u += NTHR) ((LAS unsigned*)(F.lds + MISC_OFF))[u] = 0u;
    __syncthreads();
    XcdBarrier bar; bar.bar = (unsigned*)(F.ctl + CW_BAR); bar.x = 0; bar.st = nullptr;
    if (!MK_PER_PHASE) bar = xcd_barrier_post((unsigned*)(F.ctl + CW_BAR), F.MISC + 8);
    const int lo = args.ph_lo, hi = args.ph_hi;
    int ph = 0;
#define IN_() (lo <= ph && ph < hi && ({ LAUNDER_TID(F); true; }))
#define DUP3(...) do { __VA_ARGS__; if (PROBE_DUP == 3) { __VA_ARGS__; } } while (0)
#define SEAM() do { if (!MK_PER_PHASE && lo <= ph && ph + 1 < hi) { XcdBarrier b_ = bar; { unsigned long long p_ = (unsigned long long)b_.bar; unsigned x_ = b_.x; asm volatile("" : "+s"(p_), "+s"(x_)); b_.bar = (unsigned*)(GAS unsigned*)p_; b_.x = x_; } \
        xcd_barrier(b_); if (PROBE_DUP == 7) xcd_barrier(b_); } ++ph; } while (0)
    if ((PHMASK & 1) && IN_()) { p0_prologue(F, args); if (PROBE_DUP == 4) p0_prologue(F, args); }
    SEAM();
#define Hb ((bf16*)(F.ws + WS_H))
#define XB ((bf16*)(F.ws + WS_XB))
#define projT ((bf16*)(F.ws + WS_PROJT))
#define qkv ((bf16*)(F.ws + WS_QKV))
#define mix ((bf16*)(F.ws + WS_MIX))
#define ffh ((bf16*)(F.ws + WS_FFH))
#define mixin ((bf16*)(F.ws + WS_MIXIN))
#define wl (F.ws + WS_W + (size_t)l * SZ_WLAYER)
#define xin ((g == 0) ? GP(args.in[I_XP + F.z]) : GP(args.in[I_XS + F.z]) + (size_t)(g - 1) * MG * DM)
#define xres ((float*)(GAS float*)args.out + (size_t)g * MG * DM)
    for (int g = 0; g < NGRP; ++g) {
        if ((PHMASK & 2) && IN_()) norm_pass<false>(F, xin, nullptr, nullptr, nullptr, nullptr, GP(args.in[I_GMPRE + F.z]), Hb);
        SEAM();
        for (int l = 0; l < DEPTH; ++l) {
            if ((PHMASK & 4) && IN_()) {
                { pg8::Gemm gm{(const bf16*)(wl + OFF_WHY), Hb, HYIN, MG, DM}; pg8::StaticOrder S; S.init(HYIN, MG, F.G, F.bx);
                  pg8::EpiPlain E{projT, MG};
                  DUP3(pg8::gemm_phase<pg8::EpiPlain, pg8::StaticOrder, true, true>(F.lds + RING_OFF, gm, S, E)); }
                if (g == 0 || !args.taps_all) { pg8::Gemm gm{(const bf16*)(F.ws + WS_W4T) + (size_t)l * 4096 * KPAD, (const bf16*)(F.ws + WS_H3) + (size_t)l * SEQ * KPAD, 4096, SEQ, KPAD}; pg8::StaticOrder S; S.init(4096, SEQ, F.G, F.bx);
                  pg8::EpiPlain E{(bf16*)(F.ws + ((args.taps_all && l > 0) ? WS_TAPS_X + (size_t)(l - 1) * SZ_TAPS : WS_TAPS)), SEQ};
                  DUP3(pg8::gemm_phase<pg8::EpiPlain, pg8::StaticOrder, true, true>(F.lds + RING_OFF, gm, S, E)); }
                { pg8::Gemm gm{Hb, (const bf16*)(wl + OFF_WQKV), MG, QKVW, DM}; pg8::StaticOrder S; S.init(MG, QKVW, F.G, F.bx);
                  pg8::EpiRope E{qkv, QKVW, (const float*)(F.ws + WS_ROPE), QSCALE};
                  DUP3(pg8::gemm_phase<pg8::EpiRope, pg8::StaticOrder, true, true>(F.lds + RING_OFF, gm, S, E)); }
            }
            SEAM();
            if (IN_()) { if (PHMASK & 8) hyena_phase(F, args, l); if (PROBE_DUP == 2) hyena_phase(F, args, l); if (PHMASK & 16) attn_phase(F, args, l, lds); if (PROBE_DUP == 1) attn_phase(F, args, l, lds); }
            SEAM();
            if ((PHMASK & 32) && IN_()) { hynorm_phase(F, args, l); if (PROBE_DUP == 4) hynorm_phase(F, args, l); }
            SEAM();
            if ((PHMASK & 64) && IN_()) { pg8::Gemm gm{mixin, (const bf16*)(wl + OFF_WOUT), MG, DM, DM}; pg8::StaticOrder S; S.init(MG, DM, F.G, F.bx);
                pg8::EpiPlain E{mix, DM};
                DUP3(pg8::gemm_phase<pg8::EpiPlain, pg8::StaticOrder, true, true>(F.lds + RING_OFF, gm, S, E)); }
            SEAM();
            if ((PHMASK & 2) && IN_()) { if (l == 0) norm_pass<false>(F, xin, mix, GP(args.in[I_GMPOST + F.z]) + (size_t)l * DM, XB, nullptr, GP(args.in[I_GFPRE + F.z]) + (size_t)l * DM, Hb);
                else norm_pass<true>(F, XB, mix, GP(args.in[I_GMPOST + F.z]) + (size_t)l * DM, XB, nullptr, GP(args.in[I_GFPRE + F.z]) + (size_t)l * DM, Hb); }
            SEAM();
            if ((PHMASK & 128) && IN_()) { pg8::Gemm gm{Hb, (const bf16*)(wl + OFF_WGU), MG, GU, DM}; pg8::StaticOrder S; S.init(MG, GU, F.G, F.bx);
                pg8::EpiSwiGLU E{ffh, DFF};
                DUP3(pg8::gemm_phase<pg8::EpiSwiGLU, pg8::StaticOrder, true, true>(F.lds + RING_OFF, gm, S, E)); }
            SEAM();
            if ((PHMASK & 256) && IN_()) { pg8::Gemm gm{ffh, (const bf16*)(wl + OFF_WDN), MG, DM, DFF}; pg8::StaticOrder S; S.init(MG, DM, F.G, F.bx);
                pg8::EpiPlain E{mixin, DM};
                DUP3(pg8::gemm_phase<pg8::EpiPlain, pg8::StaticOrder, true, true>(F.lds + RING_OFF, gm, S, E)); }
            SEAM();
            if ((PHMASK & 2) && IN_()) { if (l + 1 < DEPTH) norm_pass<true>(F, XB, mixin, GP(args.in[I_GFPOST + F.z]) + (size_t)l * DM, XB, nullptr, GP(args.in[I_GMPRE + F.z]) + (size_t)(l + 1) * DM, Hb);
                else norm_pass<true>(F, XB, mixin, GP(args.in[I_GFPOST + F.z]) + (size_t)l * DM, nullptr, xres, nullptr, nullptr); }
            SEAM();
        }
    }
#undef IN_
#undef SEAM
#undef Hb
#undef XB
#undef projT
#undef qkv
#undef mix
#undef ffh
#undef mixin
#undef wl
#undef xin
#undef xres
}

extern "C" void kernel_launch(void* const* d_in, const int* in_sizes, int n_in, void* d_out, int out_size, void* d_ws, size_t ws_size, hipStream_t stream) {
    static int grid = 0;
    if (grid == 0) {
        if (n_in != 30 || in_sizes[0] != 2 * SEQ * DM || in_sizes[1] != 4 * SEQ * DM || out_size != NSEQ * SEQ * DM || ws_size < WS_END) {
            fprintf(stderr, "kernel_launch: shape mismatch (n_in %d, out %d, ws %zu, need %zu)\n", n_in, out_size, ws_size, (size_t)WS_END); grid = -1; return; }
        int dev = 0, cus = 0;
        if (hipGetDevice(&dev) != hipSuccess || hipDeviceGetAttribute(&cus, hipDeviceAttributeMultiprocessorCount, dev) != hipSuccess) { grid = -1; return; }
        if (hipFuncSetAttribute((const void*)hymba_fwd, hipFuncAttributeMaxDynamicSharedMemorySize, LDS_BYTES) != hipSuccess) { fprintf(stderr, "kernel_launch: hipFuncSetAttribute failed\n"); grid = -1; return; }
        int per_cu = 0;
        if (hipOccupancyMaxActiveBlocksPerMultiprocessor(&per_cu, (const void*)hymba_fwd, NTHR, LDS_BYTES) != hipSuccess || per_cu < 1) fprintf(stderr, "kernel_launch: occupancy query says %d\n", per_cu);
        (void)hipGetLastError();
        grid = cus;
    }
    if (grid < 0) return;
    if (hipMemsetAsync((char*)d_ws + WS_CTL, 0, CTL_ZERO_BYTES, stream) != hipSuccess) return;
    Args a{};
    for (int i = 0; i < 30; ++i) a.in[i] = (const float*)d_in[i];
    a.out = (float*)d_out; a.ws = (unsigned char*)d_ws; a.taps_all = (ws_size >= WS_END_X) ? 1 : 0;
#if MK_PER_PHASE
    for (int p = 0; p < NPHASE; ++p) { a.ph_lo = p; a.ph_hi = p + 1; hipLaunchKernelGGL(hymba_fwd, dim3(grid), dim3(NTHR), LDS_BYTES, stream, a); }
#else
    a.ph_lo = 0; a.ph_hi = NPHASE;
    hipLaunchKernelGGL(hymba_fwd, dim3(grid), dim3(NTHR), LDS_BYTES, stream, a);
#endif
    const hipError_t le = hipPeekAtLastError();
    if (le != hipSuccess) fprintf(stderr, "kernel_launch: launch failed: %s\n", hipGetErrorName(le));
}
```

```cpp
#include <hip/hip_runtime.h>
#include <hip/hip_bf16.h>
#include <cstdio>
#include <cstdint>
#include <cmath>
namespace pg8 {
#define PG8_LAS __attribute__((address_space(3)))
typedef unsigned short bf16_t;
typedef short bf16x8 __attribute__((ext_vector_type(8)));
typedef float f32x4 __attribute__((ext_vector_type(4)));
typedef unsigned u32x4 __attribute__((ext_vector_type(4)));
constexpr int BM = 256, BK = 64, HALF = 128, HTB = HALF * BK * 2  , STAGE_BYTES = 8 * HTB, NXCD = 8, WGM = 8;

__host__ __device__ __forceinline__ int lds_byte(int r, int c) { const int st = (r >> 4) * 2 + (c >> 5), rr = r & 15, cc = c & 31, ob = rr * 64 + cc * 2; return st * 1024 + (ob ^ (((ob >> 9) & 1) << 5)); }
__host__ __device__ __forceinline__ void stage_rc(int b, int& R, int& C) { const int st = b / 1024, sb = b % 1024, swz = sb ^ (((sb >> 9) & 1) << 5); R = (st >> 1) * 16 + swz / 64; C = (st & 1) * 32 + (swz % 64) / 2; }
__host__ __device__ __forceinline__ int perm32(int rho) { const int n = rho >> 4, i = rho & 15; return 8 * (i >> 2) + 4 * n + (i & 3); }

struct Unit { int pm, pn; };
struct Gemm { const bf16_t* A; const bf16_t* Bt; int M, N, K; };

struct StaticOrder {
    int nM, nN, nwg, G, c;
    __host__ __device__ void init(int M, int N, int G_, int c_) { nM = M / BM; nN = N / BM; nwg = nM * nN; G = G_; c = c_; }
    __host__ __device__ bool next(int i, Unit& u) const {
        const long L = (long)i * G + c; if (L >= nwg) return false;
        int wgid = (int)L; { const int q = nwg / NXCD, r = nwg % NXCD, xcd = wgid % NXCD, off = wgid / NXCD; wgid = (xcd < r ? xcd * (q + 1) : r * (q + 1) + (xcd - r) * q) + off; }
        const int nig = WGM * nN, gid = wgid / nig, fm = gid * WGM, gsz = (nM - fm) < WGM ? (nM - fm) : WGM;
        u.pm = fm + ((wgid % nig) % gsz); u.pn = (wgid % nig) / gsz; return true;
    }
    __device__ __forceinline__ void a_ready(const Unit&) const {}
    __device__ __forceinline__ void done(const Unit&) const {}
};

__device__ __forceinline__ unsigned cvt_pk_bf16(float lo, float hi) { unsigned r; asm volatile("v_cvt_pk_bf16_f32 %0, %1, %2" : "=v"(r) : "v"(lo), "v"(hi)); return r; }
typedef float f32x2 __attribute__((ext_vector_type(2)));
struct EpiPlain {
    static constexpr bool PERM = true, AFTER_DRAIN = false;
    bf16_t* O; int ldc;
    __device__ __forceinline__ void operator()(const f32x4 (&acc)[2][2][4][2], const Unit& u, int wr, int wc, int fr, int fq) const {
        const int row0 = u.pm * BM + wr * 64 + fr, col0 = u.pn * BM + wc * 32 + 8 * fq;
#pragma unroll
        for (int ai = 0; ai < 2; ++ai)
#pragma unroll
            for (int m = 0; m < 4; ++m) { bf16_t* rowp = O + (size_t)(row0 + ai * HALF + m * 16) * ldc + col0;
#pragma unroll
                for (int bj = 0; bj < 2; ++bj) { const f32x4 v0 = acc[ai][bj][m][0], v1 = acc[ai][bj][m][1];
                    u32x4 w; w.x = cvt_pk_bf16(v0[0], v0[1]); w.y = cvt_pk_bf16(v0[2], v0[3]); w.z = cvt_pk_bf16(v1[0], v1[1]); w.w = cvt_pk_bf16(v1[2], v1[3]);
                    *(u32x4*)(rowp + bj * HALF) = w; } }
    }
};
struct EpiRope {
    static constexpr bool PERM = true, AFTER_DRAIN = false;
    bf16_t* O; int ldc; const float* cs; float qscale;
    __device__ __forceinline__ void operator()(const f32x4 (&acc)[2][2][4][2], const Unit& u, int wr, int wc, int fr, int fq) const {
        const int row0 = u.pm * BM + wr * 64 + fr, col0 = u.pn * BM + wc * 32 + 8 * fq;
        const bool rope = u.pn < 8; const float sc = u.pn < 4 ? qscale : 1.0f;
        const int p0 = 16 * (wc & 1) + 4 * fq;
        f32x4 tt[2][4][2];
#pragma unroll
        for (int ai = 0; ai < 2; ++ai)
#pragma unroll
            for (int m = 0; m < 4; ++m) { tt[ai][m][0] = (f32x4){1.f, 0.f, 1.f, 0.f}; tt[ai][m][1] = (f32x4){1.f, 0.f, 1.f, 0.f};
                if (rope) { const int row = row0 + ai * HALF + m * 16; const __attribute__((address_space(1))) float* tp = (const __attribute__((address_space(1))) float*)cs + ((size_t)(row & 8191) * 32 + p0) * 2;
                    tt[ai][m][0] = *(const __attribute__((address_space(1))) f32x4*)tp; tt[ai][m][1] = *(const __attribute__((address_space(1))) f32x4*)(tp + 4); } }
#pragma unroll
        for (int ai = 0; ai < 2; ++ai)
#pragma unroll
            for (int m = 0; m < 4; ++m) { const int row = row0 + ai * HALF + m * 16; bf16_t* rowp = O + (size_t)row * ldc + col0;
                const f32x4 t0 = tt[ai][m][0], t1 = tt[ai][m][1];
#pragma unroll
                for (int bj = 0; bj < 2; ++bj) { const f32x4 v0 = acc[ai][bj][m][0], v1 = acc[ai][bj][m][1];
                    f32x4 o0, o1;
                    o0[0] = (v0[0] * t0[0] - v0[1] * t0[1]) * sc; o0[1] = (v0[0] * t0[1] + v0[1] * t0[0]) * sc;
                    o0[2] = (v0[2] * t0[2] - v0[3] * t0[3]) * sc; o0[3] = (v0[2] * t0[3] + v0[3] * t0[2]) * sc;
                    o1[0] = (v1[0] * t1[0] - v1[1] * t1[1]) * sc; o1[1] = (v1[0] * t1[1] + v1[1] * t1[0]) * sc;
                    o1[2] = (v1[2] * t1[2] - v1[3] * t1[3]) * sc; o1[3] = (v1[2] * t1[3] + v1[3] * t1[2]) * sc;
                    u32x4 w; w.x = cvt_pk_bf16(o0[0], o0[1]); w.y = cvt_pk_bf16(o0[2], o0[3]); w.z = cvt_pk_bf16(o1[0], o1[1]); w.w = cvt_pk_bf16(o1[2], o1[3]);
                    *(u32x4*)(rowp + bj * HALF) = w; } }
    }
};
struct EpiSwiGLU {
    static constexpr bool PERM = true, AFTER_DRAIN = false;
    bf16_t* O; int ldc;
    static __device__ __forceinline__ float silu_mul(float g, float u) { return g * u * __builtin_amdgcn_rcpf(1.0f + __builtin_amdgcn_exp2f(-1.4426950408889634f * g)); }
    __device__ __forceinline__ void operator()(const f32x4 (&acc)[2][2][4][2], const Unit& u, int wr, int wc, int fr, int fq) const {
        const int row0 = u.pm * BM + wr * 64 + fr, col0 = u.pn * HALF + wc * 32 + 8 * fq;
#pragma unroll
        for (int ai = 0; ai < 2; ++ai)
#pragma unroll
            for (int m = 0; m < 4; ++m) { bf16_t* rowp = O + (size_t)(row0 + ai * HALF + m * 16) * ldc + col0;
                const f32x4 g0 = acc[ai][0][m][0], g1 = acc[ai][0][m][1], u0 = acc[ai][1][m][0], u1 = acc[ai][1][m][1];
                u32x4 w; w.x = cvt_pk_bf16(silu_mul(g0[0], u0[0]), silu_mul(g0[1], u0[1])); w.y = cvt_pk_bf16(silu_mul(g0[2], u0[2]), silu_mul(g0[3], u0[3]));
                w.z = cvt_pk_bf16(silu_mul(g1[0], u1[0]), silu_mul(g1[1], u1[1])); w.w = cvt_pk_bf16(silu_mul(g1[2], u1[2]), silu_mul(g1[3], u1[3]));
                *(u32x4*)rowp = w; }
    }
};
template <class Epi, class Sched, bool ALIGN_EPI = false, bool SP2 = false>
__device__ __forceinline__ void gemm_phase(PG8_LAS unsigned char* lds, const Gemm g, const Sched& S, const Epi& E) {
    int tid = threadIdx.x; asm volatile("" : "+v"(tid));
    const int wid = __builtin_amdgcn_readfirstlane(tid >> 6), lane = tid & 63, wr = wid >> 2, wc = wid & 3, fr = lane & 15, fq = lane >> 4;
    const int K = g.K, nt = K / BK;
    unsigned voffA[2], voffB[2];
#pragma unroll
    for (int i = 0; i < 2; ++i) { int R, C; stage_rc(tid * 16 + i * 8192, R, C); const int Rb = Epi::PERM ? ((R & ~31) + perm32(R & 31)) : R;
        voffA[i] = (unsigned)(R * K + C) * 2u; voffB[i] = (unsigned)(Rb * K + C) * 2u; }
    const size_t kstep = (size_t)(BK * 2);
    const size_t hstep = (size_t)HALF * K * 2;
    const size_t tstep = 2 * hstep;
    const unsigned ldsw = (unsigned)wid * 1024u;
    const int aoff = lds_byte(wr * 64 + fr, fq * 8), boff = lds_byte(wc * 32 + fr, fq * 8);
#define PG8_SA(b, h) (((b) * 2 + (h)) * HTB)
#define PG8_SB(b, h) ((4 + (b) * 2 + (h)) * HTB)
#define PG8_STAGE(bufoff, gbase, voff) do { _Pragma("unroll") for (int _i = 0; _i < 2; ++_i) \
        __builtin_amdgcn_global_load_lds((const unsigned*)((const char*)(gbase) + (voff)[_i]), (PG8_LAS unsigned*)(lds + (bufoff) + ldsw + _i * 8192), 16, 0, 0); } while (0)
#define PG8_LDA(dst, b, h) do { _Pragma("unroll") for (int m = 0; m < 4; ++m) _Pragma("unroll") for (int k = 0; k < 2; ++k) dst[m][k] = *(const PG8_LAS bf16x8*)(lds + PG8_SA(b, h) + aoff + m * 2048 + k * 1024); } while (0)
#define PG8_LDB(dst, b, h) do { _Pragma("unroll") for (int n = 0; n < 2; ++n) _Pragma("unroll") for (int k = 0; k < 2; ++k) dst[n][k] = *(const PG8_LAS bf16x8*)(lds + PG8_SB(b, h) + boff + n * 2048 + k * 1024); } while (0)
#define PG8_MMA(ai, bj, At, Bt) do { __builtin_amdgcn_s_setprio(1); _Pragma("unroll") for (int m = 0; m < 4; ++m) _Pragma("unroll") for (int n = 0; n < 2; ++n) _Pragma("unroll") for (int k = 0; k < 2; ++k) \
        acc[ai][bj][m][n] = __builtin_amdgcn_mfma_f32_16x16x32_bf16(Bt[n][k], At[m][k], acc[ai][bj][m][n], 0, 0, 0); __builtin_amdgcn_s_setprio(0); } while (0)
#define PG8_WAIT_V(n) asm volatile("s_waitcnt vmcnt(" #n ")" ::: "memory")
#define PG8_WAIT_L(n) asm volatile("s_waitcnt lgkmcnt(" #n ")" ::: "memory")
#define PG8_BAR __builtin_amdgcn_s_barrier()
#define PG8_SCHED __builtin_amdgcn_sched_barrier(0)
    Unit cur, nxt; int ui = 0;
    if (!S.next(0, cur)) return;
    f32x4 acc[2][2][4][2];
#pragma unroll
    for (int a = 0; a < 2; ++a)
#pragma unroll
        for (int b = 0; b < 2; ++b)
#pragma unroll
            for (int m = 0; m < 4; ++m)
#pragma unroll
                for (int n = 0; n < 2; ++n) acc[a][b][m][n] = (f32x4){0.f, 0.f, 0.f, 0.f};
    bf16x8 At[4][2], B0[2][2], B1[2][2];
    const char* cA = (const char*)g.A + (size_t)cur.pm * tstep; const char* cB = (const char*)g.Bt + (size_t)cur.pn * tstep;
    S.a_ready(cur);
    if constexpr (SP2) {
        PG8_STAGE(PG8_SB(0, 0), cB, voffB); PG8_STAGE(PG8_SB(0, 1), cB + hstep, voffB); PG8_STAGE(PG8_SA(0, 0), cA, voffA); PG8_STAGE(PG8_SA(0, 1), cA + hstep, voffA);
        if (wr == 1) PG8_BAR;
        PG8_WAIT_V(2); PG8_BAR;
        PG8_STAGE(PG8_SB(1, 0), cB + kstep, voffB); PG8_STAGE(PG8_SA(1, 0), cA + kstep, voffA); PG8_STAGE(PG8_SB(1, 1), cB + hstep + kstep, voffB);
        PG8_WAIT_V(6); PG8_BAR;
    } else {
        PG8_STAGE(PG8_SB(0, 0), cB, voffB); PG8_STAGE(PG8_SA(0, 0), cA, voffA); PG8_STAGE(PG8_SB(0, 1), cB + hstep, voffB); PG8_STAGE(PG8_SA(0, 1), cA + hstep, voffA);
        if (wr == 1) PG8_BAR;
        PG8_WAIT_V(4); PG8_BAR;
        PG8_STAGE(PG8_SB(1, 0), cB + kstep, voffB); PG8_STAGE(PG8_SA(1, 0), cA + kstep, voffA); PG8_STAGE(PG8_SB(1, 1), cB + hstep + kstep, voffB);
        PG8_WAIT_V(6); PG8_BAR;
    }
    for (;;) {
        const bool has_next = S.next(ui + 1, nxt);
        const char* nA = has_next ? (const char*)g.A + (size_t)nxt.pm * tstep : cA; const char* nB = has_next ? (const char*)g.Bt + (size_t)nxt.pn * tstep : cB;
        for (int t = 0; t < nt; t += 2) {
            const bool last = (t == nt - 2);
            const char* a1 = cA + (size_t)(t + 1) * kstep;
            const char* a2 = last ? nA : cA + (size_t)(t + 2) * kstep; const char* b2 = last ? nB : cB + (size_t)(t + 2) * kstep;
            const char* a3 = a2 + kstep; const char* b3 = b2 + kstep;
            if (last && has_next) S.a_ready(nxt);
            if constexpr (SP2) {
            PG8_LDB(B0, 0, 0); PG8_LDB(B1, 0, 1); PG8_SCHED; PG8_LDA(At, 0, 0); PG8_STAGE(PG8_SA(1, 1), a1 + hstep, voffA);
            PG8_WAIT_V(8); PG8_WAIT_L(0); PG8_BAR; PG8_MMA(0, 0, At, B0); PG8_MMA(0, 1, At, B1); PG8_BAR; PG8_SCHED;
            PG8_LDA(At, 0, 1); PG8_STAGE(PG8_SB(0, 0), b2, voffB); PG8_STAGE(PG8_SB(0, 1), b2 + hstep, voffB); PG8_STAGE(PG8_SA(0, 0), a2, voffA);
            PG8_WAIT_V(8); PG8_WAIT_L(0); PG8_BAR; PG8_MMA(1, 0, At, B0); PG8_MMA(1, 1, At, B1); PG8_BAR; PG8_SCHED;
            PG8_LDB(B0, 1, 0); PG8_LDB(B1, 1, 1); PG8_SCHED; PG8_LDA(At, 1, 0); PG8_STAGE(PG8_SA(0, 1), a2 + hstep, voffA);
            PG8_WAIT_V(8); PG8_WAIT_L(0); PG8_BAR; PG8_MMA(0, 0, At, B0); PG8_MMA(0, 1, At, B1); PG8_BAR; PG8_SCHED;
            PG8_LDA(At, 1, 1); PG8_STAGE(PG8_SB(1, 0), b3, voffB); PG8_STAGE(PG8_SB(1, 1), b3 + hstep, voffB); PG8_STAGE(PG8_SA(1, 0), a3, voffA);
            PG8_WAIT_V(8); PG8_WAIT_L(0); PG8_BAR; PG8_MMA(1, 0, At, B0); PG8_MMA(1, 1, At, B1); PG8_BAR; PG8_SCHED;
            } else {
            PG8_LDB(B0, 0, 0); PG8_SCHED; PG8_LDA(At, 0, 0); PG8_STAGE(PG8_SA(1, 1), a1 + hstep, voffA);
            PG8_WAIT_L(8); PG8_BAR; PG8_WAIT_L(0); PG8_MMA(0, 0, At, B0); PG8_BAR; PG8_SCHED;
            PG8_LDB(B1, 0, 1); PG8_STAGE(PG8_SB(0, 0), b2, voffB);
            PG8_BAR; PG8_WAIT_L(0); PG8_MMA(0, 1, At, B1); PG8_BAR;
            PG8_LDA(At, 0, 1); PG8_STAGE(PG8_SA(0, 0), a2, voffA);
            PG8_BAR; PG8_WAIT_L(0); PG8_MMA(1, 0, At, B0); PG8_BAR; PG8_SCHED;
            PG8_STAGE(PG8_SB(0, 1), b2 + hstep, voffB);
            PG8_WAIT_V(6); PG8_BAR; PG8_MMA(1, 1, At, B1); PG8_BAR;
            PG8_LDB(B0, 1, 0); PG8_SCHED; PG8_LDA(At, 1, 0); PG8_STAGE(PG8_SA(0, 1), a2 + hstep, voffA);
            PG8_WAIT_L(8); PG8_BAR; PG8_WAIT_L(0); PG8_MMA(0, 0, At, B0); PG8_BAR; PG8_SCHED;
            PG8_LDB(B1, 1, 1); PG8_STAGE(PG8_SB(1, 0), b3, voffB);
            PG8_BAR; PG8_WAIT_L(0); PG8_MMA(0, 1, At, B1); PG8_BAR;
            PG8_LDA(At, 1, 1); PG8_STAGE(PG8_SA(1, 0), a3, voffA);
            PG8_BAR; PG8_WAIT_L(0); PG8_MMA(1, 0, At, B0); PG8_BAR; PG8_SCHED;
            PG8_STAGE(PG8_SB(1, 1), b3 + hstep, voffB);
            PG8_WAIT_V(6); PG8_BAR; PG8_MMA(1, 1, At, B1); PG8_BAR;
            }
        }
        if constexpr (ALIGN_EPI) { if (wr == 0) PG8_BAR; }
        if constexpr (!Epi::AFTER_DRAIN) { E(acc, cur, wr, wc, fr, fq); S.done(cur); }
        if (!has_next) break;
#pragma unroll
        for (int a = 0; a < 2; ++a)
#pragma unroll
            for (int b = 0; b < 2; ++b)
#pragma unroll
                for (int m = 0; m < 4; ++m)
#pragma unroll
                    for (int n = 0; n < 2; ++n) acc[a][b][m][n] = (f32x4){0.f, 0.f, 0.f, 0.f};
        cur = nxt; cA = nA; cB = nB; ++ui;
        if constexpr (ALIGN_EPI) { if (wr == 1) PG8_BAR; }
    }
    PG8_WAIT_V(0);
    if constexpr (!ALIGN_EPI) { if (wr == 0) PG8_BAR; }
    PG8_BAR;
    if constexpr (Epi::AFTER_DRAIN) { E.fused(acc, cur, wr, wc, fr, fq, lds, wid, lane); S.done(cur); }
#undef PG8_SA
#undef PG8_SB
#undef PG8_STAGE
#undef PG8_LDA
#undef PG8_LDB
#undef PG8_MMA
#undef PG8_WAIT_V
#undef PG8_WAIT_L
#undef PG8_BAR
#undef PG8_SCHED
}
}
namespace att {
using bf16x8 = __attribute__((ext_vector_type(8))) short;
using s16x4  = __attribute__((ext_vector_type(4))) short;
using f32x16 = __attribute__((ext_vector_type(16))) float;
using u32x4  = __attribute__((ext_vector_type(4))) unsigned;
typedef unsigned short bf16;
constexpr int DQ = 64, DV = 128, NW = 8, QBLK = 32, KVBLK = 64, LDR = 3072;
constexpr int SHM_V = KVBLK * DV * 2, SHM_K = KVBLK * DQ * 2, SHM_ATTN = 3 * SHM_V + 3 * SHM_K + NW * 64 * 4 + 64;
constexpr int SHM_ATTN_ALL = SHM_ATTN + NW * QBLK * DV * 2;
#ifndef ATT_OVF_LIMIT
#define ATT_OVF_LIMIT 1.152921504606847e18f
#endif
#ifndef ATT_SDEPTH
#define ATT_SDEPTH 2
#endif
constexpr float THR2 = 11.0f;
#define KSWZ64(row, colB) ((row) * 128 + ((colB) ^ ((((row) >> 1) & 7) << 4)))
#define SBAR() __builtin_amdgcn_sched_barrier(0)
template <int K> __device__ __forceinline__ float sx(float v) { return __builtin_bit_cast(float, __builtin_amdgcn_ds_swizzle(__builtin_bit_cast(int, v), (K << 10) | 0x1f)); }
__device__ __forceinline__ int crow(int r, int hi) { return (r & 3) + 8 * (r >> 2) + 4 * hi; }
__device__ __forceinline__ unsigned cvtpk(float lo, float hi) { unsigned r; asm volatile("v_cvt_pk_bf16_f32 %0, %1, %2" : "=v"(r) : "v"(lo), "v"(hi)); return r; }
__device__ __forceinline__ void partialSM(f32x16& p0, f32x16& p1, float& m_reg, float& mn, float& alpha) {
  float pmax = p0[0];
#pragma unroll
  for (int r = 1; r < 16; ++r) pmax = fmaxf(pmax, p0[r]);
#pragma unroll
  for (int r = 0; r < 16; ++r) pmax = fmaxf(pmax, p1[r]);
  { auto rr = __builtin_amdgcn_permlane32_swap(__float_as_uint(pmax), __float_as_uint(pmax), false, false);
    pmax = fmaxf(__uint_as_float(rr[0]), __uint_as_float(rr[1])); }
  if (__builtin_expect(__all(pmax - m_reg <= THR2), 1)) { mn = m_reg; alpha = 1.f; }
  else { mn = fmaxf(m_reg, pmax); alpha = __builtin_amdgcn_exp2f(m_reg - mn); m_reg = mn; }
#pragma unroll
  for (int r = 0; r < 16; ++r) p0[r] = p0[r] - mn;
#pragma unroll
  for (int r = 0; r < 16; ++r) p1[r] = p1[r] - mn;
#pragma unroll
  for (int r = 0; r < 16; ++r) p0[r] = __builtin_amdgcn_exp2f(p0[r]);
}
__device__ __forceinline__ void finishSM(f32x16& p0, f32x16& p1, float alpha, float& l_reg, bf16x8& pa0, bf16x8& pa1, bf16x8& pa2, bf16x8& pa3) {
#pragma unroll
  for (int r = 0; r < 16; ++r) p1[r] = __builtin_amdgcn_exp2f(p1[r]);
  float ps = 0;
#pragma unroll
  for (int r = 0; r < 16; ++r) ps += p0[r];
#pragma unroll
  for (int r = 0; r < 16; ++r) ps += p1[r];
  { auto rr = __builtin_amdgcn_permlane32_swap(__float_as_uint(ps), __float_as_uint(ps), false, false);
    ps = __uint_as_float(rr[0]) + __uint_as_float(rr[1]); }
  l_reg = l_reg * alpha + ps;
#define PK4(P, BASE, OUT) do { unsigned a0 = cvtpk(P[BASE + 0], P[BASE + 1]), a1 = cvtpk(P[BASE + 2], P[BASE + 3]);   \
    unsigned b0 = cvtpk(P[BASE + 4], P[BASE + 5]), b1 = cvtpk(P[BASE + 6], P[BASE + 7]);                              \
    auto r0 = __builtin_amdgcn_permlane32_swap(a0, b0, false, false); auto r1 = __builtin_amdgcn_permlane32_swap(a1, b1, false, false); \
    u32x4 w = {r0[0], r1[0], r0[1], r1[1]}; OUT = *reinterpret_cast<bf16x8*>(&w); } while (0)
  PK4(p0, 0, pa0); PK4(p0, 8, pa1); PK4(p1, 0, pa2); PK4(p1, 8, pa3);
#undef PK4
}
__device__ __forceinline__ void qkt(f32x16& p0, f32x16& p1, const char* Ks, const bf16x8* qr, int r32, int hi) {
  p0 = f32x16{}; p1 = f32x16{};
#pragma unroll
  for (int d0 = 0; d0 < 4; ++d0) { const int cb = (d0 * 16 + hi * 8) * 2;
    bf16x8 b0 = *reinterpret_cast<const bf16x8*>(Ks + KSWZ64(r32, cb));
    bf16x8 b1 = *reinterpret_cast<const bf16x8*>(Ks + KSWZ64(32 + r32, cb));
    p0 = __builtin_amdgcn_mfma_f32_32x32x16_bf16(b0, qr[d0], p0, 0, 0, 0);
    p1 = __builtin_amdgcn_mfma_f32_32x32x16_bf16(b1, qr[d0], p1, 0, 0, 0); }
}
__device__ __forceinline__ void qkt_ref(f32x16& p0, f32x16& p1, const char* Ks, const bf16x8* qr, const f32x16& negm, int r32, int hi) {
#pragma unroll
  for (int d0 = 0; d0 < 4; ++d0) { const int cb = (d0 * 16 + hi * 8) * 2;
    bf16x8 b0 = *reinterpret_cast<const bf16x8*>(Ks + KSWZ64(r32, cb));
    bf16x8 b1 = *reinterpret_cast<const bf16x8*>(Ks + KSWZ64(32 + r32, cb));
    if (d0 == 0) { p0 = __builtin_amdgcn_mfma_f32_32x32x16_bf16(b0, qr[0], negm, 0, 0, 0); p1 = __builtin_amdgcn_mfma_f32_32x32x16_bf16(b1, qr[0], negm, 0, 0, 0); }
    else { p0 = __builtin_amdgcn_mfma_f32_32x32x16_bf16(b0, qr[d0], p0, 0, 0, 0); p1 = __builtin_amdgcn_mfma_f32_32x32x16_bf16(b1, qr[d0], p1, 0, 0, 0); } }
}
__device__ __forceinline__ void exp_half(f32x16& p) {
#pragma unroll
  for (int r = 0; r < 16; ++r) p[r] = __builtin_amdgcn_exp2f(p[r]);
}
__device__ __forceinline__ void sub_exp_half(f32x16& p0, f32x16& p1, float m) {
#pragma unroll
  for (int r = 0; r < 16; ++r) p0[r] = p0[r] - m;
#pragma unroll
  for (int r = 0; r < 16; ++r) p1[r] = p1[r] - m;
#pragma unroll
  for (int r = 0; r < 16; ++r) p0[r] = __builtin_amdgcn_exp2f(p0[r]);
}
__device__ __forceinline__ void finishSM_fast(f32x16& p0, f32x16& p1, float& l_reg, bool& ovf, bf16x8& pa0, bf16x8& pa1, bf16x8& pa2, bf16x8& pa3) {
  float al = 1.f; float l0 = 0.f;
  finishSM(p0, p1, al, l0, pa0, pa1, pa2, pa3);
  ovf = ovf || !(l0 < ATT_OVF_LIMIT);
  l_reg += l0;
}
__device__ __forceinline__ int v_st(int k, int c) { const int kk = (k & ~0xC) | ((k & 4) << 1) | ((k & 8) >> 1); return ((kk >> 3) * 4 + (c >> 5)) * 512 + ((kk & 7) * 32 + (c & 31)) * 2; }
__device__ __forceinline__ int v_rd_base(int lane) { return ((lane & 3) << 3) | (((lane >> 2) & 3) << 6) | (((lane >> 4) & 1) << 5) | (((lane >> 5) & 1) << 8); }
constexpr int v_rd_off(int d0, int ks, int half) { return d0 * 512 + ks * 4096 + half * 2048; }
template <int OFF> __device__ __forceinline__ s16x4 tr_read(int vb) {
  s16x4 r; asm volatile("ds_read_b64_tr_b16 %0, %1 offset:%2" : "=&v"(r) : "v"(vb), "i"(OFF) : "memory"); return r;
}
template <int D0> __device__ __forceinline__ void pv_one(f32x16& od, int vb, bf16x8 pa0, bf16x8 pa1, bf16x8 pa2, bf16x8 pa3) {
  const s16x4 l0 = tr_read<v_rd_off(D0, 0, 0)>(vb), h0 = tr_read<v_rd_off(D0, 0, 1)>(vb), l1 = tr_read<v_rd_off(D0, 1, 0)>(vb), h1 = tr_read<v_rd_off(D0, 1, 1)>(vb);
  const s16x4 l2 = tr_read<v_rd_off(D0, 2, 0)>(vb), h2 = tr_read<v_rd_off(D0, 2, 1)>(vb), l3 = tr_read<v_rd_off(D0, 3, 0)>(vb), h3 = tr_read<v_rd_off(D0, 3, 1)>(vb);
  asm volatile("s_waitcnt lgkmcnt(0)" ::: "memory"); SBAR();
#define PK(L, H) (bf16x8){L[0], L[1], L[2], L[3], H[0], H[1], H[2], H[3]}
  od = __builtin_amdgcn_mfma_f32_32x32x16_bf16(pa0, PK(l0, h0), od, 0, 0, 0);
  od = __builtin_amdgcn_mfma_f32_32x32x16_bf16(pa1, PK(l1, h1), od, 0, 0, 0);
  od = __builtin_amdgcn_mfma_f32_32x32x16_bf16(pa2, PK(l2, h2), od, 0, 0, 0);
  od = __builtin_amdgcn_mfma_f32_32x32x16_bf16(pa3, PK(l3, h3), od, 0, 0, 0);
#undef PK
}
__device__ __forceinline__ void pv_d0(f32x16* o, int vb, bf16x8 pa0, bf16x8 pa1, bf16x8 pa2, bf16x8 pa3) {
  pv_one<0>(o[0], vb, pa0, pa1, pa2, pa3); pv_one<1>(o[1], vb, pa0, pa1, pa2, pa3); pv_one<2>(o[2], vb, pa0, pa1, pa2, pa3); pv_one<3>(o[3], vb, pa0, pa1, pa2, pa3);
}
__device__ __forceinline__ void glds16(const void* gsrc, unsigned lds_dst) { unsigned keep;
  asm volatile("s_mov_b32 %0, m0\n\ts_mov_b32 m0, %2\n\ts_nop 0\n\tglobal_load_lds_dwordx4 %1, off\n\ts_mov_b32 m0, %0" : "=&s"(keep) : "v"(gsrc), "s"(lds_dst) : "memory"); }
template <bool FAST>
__device__ __forceinline__ bool attn_map(const bf16* __restrict__ Kh, const bf16* __restrict__ Vh, const bf16* __restrict__ Qh  , int seq, char* V_lds, char* K_lds, float* ws_base,
                                         f32x16 (&o)[4], float& l_out) {
    int tid = threadIdx.x; asm volatile("" : "+v"(tid));
    const int wid = __builtin_amdgcn_readfirstlane(tid >> 6), r32 = tid & 31, hi = (tid >> 5) & 1;
    float* al_l = ws_base + wid * 64 + 32;
    const bf16* Qw = Qh + (long)(wid * QBLK + r32) * LDR + hi * 8;
    const int lane_ = tid & 63;
    const unsigned lds0 = (unsigned)(uintptr_t)V_lds;
    const bf16 *vsrc0, *vsrc1, *ksrc;
    { const int o0 = (2 * wid) * 1024 + 16 * lane_, o1 = o0 + 1024, ok = wid * 1024 + 16 * lane_;
      auto vmap = [](int o, int& k, int& c) { const int sub = o >> 9, w = o & 511, kk = ((sub >> 2) << 3) | (w >> 6); k = (kk & ~0xC) | ((kk & 4) << 1) | ((kk & 8) >> 1); c = (sub & 3) * 32 + ((w & 63) >> 1); };
      int k0_, c0_, k1_, c1_; vmap(o0, k0_, c0_); vmap(o1, k1_, c1_);
      vsrc0 = Vh + (long)k0_ * LDR + c0_; vsrc1 = Vh + (long)k1_ * LDR + c1_;
      const int row = ok >> 7, cb = (ok & 127) ^ (((row >> 1) & 7) << 4);
      ksrc = Kh + (long)row * LDR + (cb >> 1); }
    const int vb0 = (int)(uintptr_t)V_lds + v_rd_base(tid & 63);
    float m_reg = -1e30f, l_reg = 0; bf16x8 qr[4]; bool ovf = false;
#pragma unroll
    for (int d0 = 0; d0 < 4; ++d0) { o[d0] = f32x16{}; qr[d0] = *reinterpret_cast<const bf16x8*>(Qw + d0 * 16); }
#define DMA_TILE(t, b) do { const long ro_ = (long)(t) * KVBLK * LDR; \
      glds16(vsrc0 + ro_, (unsigned)__builtin_amdgcn_readfirstlane(lds0 + (b) * SHM_V + (2 * wid) * 1024)); \
      glds16(vsrc1 + ro_, (unsigned)__builtin_amdgcn_readfirstlane(lds0 + (b) * SHM_V + (2 * wid + 1) * 1024)); \
      glds16(ksrc + ro_, (unsigned)__builtin_amdgcn_readfirstlane(lds0 + 3 * SHM_V + (b) * SHM_K + wid * 1024)); } while (0)
#define DMA_WAIT() asm volatile("s_waitcnt vmcnt(0)" ::: "memory")
#define RESC(a) do { if constexpr (!FAST) { if (__any((a) < 1.f)) { if (hi == 0) al_l[r32] = (a); asm volatile("s_waitcnt lgkmcnt(0)" ::: "memory"); \
    _Pragma("unroll") for (int d = 0; d < 4; ++d) _Pragma("unroll") for (int r = 0; r < 16; ++r) o[d][r] *= al_l[crow(r, hi)]; } } } while (0)
#define PSM(P0, P1, MN, AL) do { if constexpr (FAST) exp_half(P0); else partialSM(P0, P1, m_reg, MN, AL); } while (0)
#define FSM(P0, P1, AL) do { if constexpr (FAST) finishSM_fast(P0, P1, l_reg, ovf, pa0, pa1, pa2, pa3); else finishSM(P0, P1, AL, l_reg, pa0, pa1, pa2, pa3); } while (0)
#define STEP(PN0, PN1, MNN, ALN, PO0, PO1, ALO, jj) do { \
      SBAR(); if constexpr (FAST) qkt_ref(PN0, PN1, K_lds + bc * SHM_K, qr, negm, r32, hi); else qkt(PN0, PN1, K_lds + bc * SHM_K, qr, r32, hi); \
      if ((jj) + 1 < NT) DMA_TILE((jj) + 1, bn);              \
      FSM(PO0, PO1, ALO); SBAR(); \
      pv_d0(o, vb0 + bp * SHM_V, pa0, pa1, pa2, pa3); PSM(PN0, PN1, MNN, ALN); RESC(ALN); \
      DMA_WAIT(); __syncthreads(); \
      bp = bc; bc = bn; bn = (bn == 2) ? 0 : bn + 1; } while (0)
    f32x16 pA0, pA1, pB0, pB1; float mnA = 0.f, mnB = 0.f, alA = 1.f, alB = 1.f; bf16x8 pa0, pa1, pa2, pa3; const int NT = seq / KVBLK;
    DMA_TILE(0, 0); DMA_WAIT(); __syncthreads();
    if (1 < NT) DMA_TILE(1, 1);
    qkt(pA0, pA1, K_lds, qr, r32, hi); partialSM(pA0, pA1, m_reg, mnA, alA);
    f32x16 negm = f32x16{};
    if constexpr (FAST) {
#pragma unroll
      for (int r = 0; r < 16; ++r) negm[r] = -m_reg;
      asm volatile("" : "+v"(negm));
    }
    DMA_WAIT(); __syncthreads();
    int bp = 0, bc = 1, bn = 2;
    for (int j = 1; j + 1 < NT; j += 2) {
      STEP(pB0, pB1, mnB, alB, pA0, pA1, alA, j);
      STEP(pA0, pA1, mnA, alA, pB0, pB1, alB, j + 1);
    }
    STEP(pB0, pB1, mnB, alB, pA0, pA1, alA, NT - 1);
    FSM(pB0, pB1, alB); SBAR();
    pv_d0(o, vb0 + bp * SHM_V, pa0, pa1, pa2, pa3);
#undef DMA_TILE
#undef DMA_WAIT
#undef RESC
#undef PSM
#undef FSM
#undef STEP
    l_out = l_reg;
    return ovf;
}
__device__ __forceinline__ void attn_unit(const bf16* __restrict__ qkv, long Qrow0, long Krow0, int vh, int seq, float lam, float oscale, const float* __restrict__ subln,
                                          bf16* __restrict__ Ob, int ldo, float* stash, char* lds) {
  int tid = threadIdx.x; asm volatile("" : "+v"(tid));
  const int wid = __builtin_amdgcn_readfirstlane(tid >> 6), lane = tid & 63, r32 = lane & 31, hi = lane >> 5;
  char* V_lds = lds; char* K_lds = lds + 3 * SHM_V;
  float* wsb = (float*)(lds + 3 * SHM_V + 3 * SHM_K); float* li_l = wsb + wid * 64;
  volatile unsigned* ovw = (volatile unsigned*)(lds + 3 * SHM_V + 3 * SHM_K + NW * 64 * 4);
  const bf16* Vh = qkv + Krow0 * LDR + 2048 + vh * DV;
  for (int s = 0; s < 2; ++s) {
    const int head = 2 * vh + s;
    const bf16* Kh = qkv + Krow0 * LDR + 1024 + head * DQ;
    const bf16* Qh = qkv + Qrow0 * LDR + head * DQ;
    f32x16 o[4]; float l_reg;
    const bool ovf = attn_map<true>(Kh, Vh, Qh, seq, V_lds, K_lds, wsb, o, l_reg);
    if (lane == 0) ovw[wid] = __any(ovf) ? 1u : 0u;
    __syncthreads();
    unsigned anyovf = 0u;
#pragma unroll
    for (int w = 0; w < NW; ++w) anyovf |= ovw[w];
    __syncthreads();
    if (__builtin_amdgcn_readfirstlane(anyovf) != 0u) (void)attn_map<false>(Kh, Vh, Qh, seq, V_lds, K_lds, wsb, o, l_reg);
    if (hi == 0) li_l[r32] = l_reg; asm volatile("s_waitcnt lgkmcnt(0)" ::: "memory");
    float rli[16];
#pragma unroll
    for (int r = 0; r < 16; ++r) rli[r] = __builtin_amdgcn_rcpf(li_l[crow(r, hi)]);
    typedef float f32x4_t __attribute__((ext_vector_type(4)));
    f32x4_t* st4 = (f32x4_t*)stash + (size_t)tid * 16;
    if (s == 0) {
#pragma unroll
      for (int d0 = 0; d0 < 4; ++d0)
#pragma unroll
        for (int r4 = 0; r4 < 4; ++r4) { f32x4_t v; v[0] = o[d0][4 * r4] * rli[4 * r4]; v[1] = o[d0][4 * r4 + 1] * rli[4 * r4 + 1]; v[2] = o[d0][4 * r4 + 2] * rli[4 * r4 + 2]; v[3] = o[d0][4 * r4 + 3] * rli[4 * r4 + 3]; st4[d0 * 4 + r4] = v; }
    } else {
      float ssq[16];
#pragma unroll
      for (int r = 0; r < 16; ++r) ssq[r] = 0.f;
#pragma unroll
      for (int d0 = 0; d0 < 4; ++d0)
#pragma unroll
        for (int r4 = 0; r4 < 4; ++r4) { const f32x4_t sv = st4[d0 * 4 + r4];
#pragma unroll
          for (int i = 0; i < 4; ++i) { const int r = 4 * r4 + i; const float v = sv[i] - lam * (o[d0][r] * rli[r]); o[d0][r] = v; ssq[r] += v * v; } }
#pragma unroll
      for (int r = 0; r < 16; ++r) {
        float a = ssq[r];
        a += sx<1>(a); a += sx<2>(a); a += sx<4>(a); a += sx<8>(a); a += sx<16>(a);
        ssq[r] = oscale / sqrtf(a * (1.0f / 128.0f) + 1e-6f);
      }
      float g[4];
#pragma unroll
      for (int d0 = 0; d0 < 4; ++d0) g[d0] = subln[d0 * 32 + r32];
      bf16* stg = (bf16*)(lds + SHM_ATTN) + wid * (QBLK * DV);
      unsigned so = (unsigned)((4 * hi) * DV + r32); asm volatile("" : "+v"(so));
#pragma unroll
      for (int r = 0; r < 16; ++r) {
#pragma unroll
        for (int d0 = 0; d0 < 4; ++d0) { const unsigned w = cvtpk(o[d0][r] * ssq[r] * g[d0], 0.f); (stg + ((r & 3) + 8 * (r >> 2)) * DV + d0 * 32)[so] = (bf16)(w & 0xffffu); } }
      asm volatile("s_waitcnt lgkmcnt(0)" ::: "memory");
      int ldo_ = ldo; asm volatile("" : "+s"(ldo_));
      bf16* Ow = Ob + (long)(wid * QBLK) * ldo_;
      const int srow = lane >> 4, sch = lane & 15;
#pragma unroll
      for (int i = 0; i < 8; ++i) { const int row = i * 4 + srow; const u32x4 v = *(const u32x4*)(stg + row * DV + sch * 8); *(u32x4*)(Ow + (long)row * ldo_ + sch * 8) = v; }
    }
  }
}
#undef SBAR
}
#define GAS __attribute__((address_space(1)))
#define LAS __attribute__((address_space(3)))
typedef unsigned short bf16;
typedef unsigned v4u __attribute__((ext_vector_type(4)));
typedef float f32x4 __attribute__((ext_vector_type(4)));
typedef short bf16x8 __attribute__((ext_vector_type(8)));
typedef GAS unsigned gu32;
typedef GAS unsigned long long gu64;
#define RLX_AGENT __ATOMIC_RELAXED, __HIP_MEMORY_SCOPE_AGENT
#define LDS_WAIT() asm volatile("s_waitcnt lgkmcnt(0)" ::: "memory")
#define VM_WAIT() asm volatile("s_waitcnt vmcnt(0)" ::: "memory")
__device__ __forceinline__ unsigned long long rt() { return __builtin_amdgcn_s_memrealtime(); }
__device__ __forceinline__ unsigned f2bf(float f) { unsigned u = __builtin_bit_cast(unsigned, f); return (u + 0x7fffu + ((u >> 16) & 1u)) >> 16; }
__device__ __forceinline__ unsigned pk2(float lo, float hi) { unsigned r; asm("v_cvt_pk_bf16_f32 %0, %1, %2" : "=v"(r) : "v"(lo), "v"(hi)); return r; }

#define XB_TMO      128
#define XB_XCNT(j)  (256  + 64 * (j))
#define XB_XSUB(j)  (1280 + 64 * (j))
#define XB_XGEN(j)  (2304 + 64 * (j))
#define XB_TOP      3328
#define XB_TOPGEN   3392
#define XCD_BAR_WORDS 3456
#define XB_SPIN_CAP (1u << 18)

__device__ __forceinline__ unsigned xb_ld(unsigned* p)              { return __hip_atomic_load(p, __ATOMIC_RELAXED, __HIP_MEMORY_SCOPE_AGENT); }
__device__ __forceinline__ unsigned xb_add(unsigned* p, unsigned v) { return __hip_atomic_fetch_add(p, v, __ATOMIC_RELAXED, __HIP_MEMORY_SCOPE_AGENT); }
__device__ __forceinline__ unsigned xb_xcc_id() { return (unsigned)__builtin_amdgcn_s_getreg((3 << 11) | 20) & 0xFu; }
#define XB_SPIN(cond, bar) do { unsigned _sp = 0; while (cond) { __builtin_amdgcn_s_sleep(1); \
    if ((++_sp & 255u) == 0u) { if (xb_ld(&(bar)[XB_TMO])) break; if (_sp > XB_SPIN_CAP) { atomicAdd(&(bar)[XB_TMO], 1u); break; } } } } while (0)

struct XcdBarrier {
    unsigned* bar; unsigned x;
    volatile LAS unsigned* st;
};

__device__ __forceinline__ XcdBarrier xcd_barrier_post(unsigned* bar, volatile LAS unsigned* st) {
    XcdBarrier b; b.bar = bar; b.x = xb_xcc_id(); b.st = st;
    if (threadIdx.x == 0) (void)xb_add(&bar[XB_XCNT(b.x)], 1u);
    return b;
}
__device__ __forceinline__ void xcd_barrier_complete(unsigned* bar, unsigned x, unsigned& nloc, unsigned& nx) {
    const unsigned G = gridDim.x * gridDim.y * gridDim.z;
    unsigned sum, cnt, mine, sp = 0u;
    for (;;) {
        sum = 0u; cnt = 0u; mine = 0u;
#pragma unroll
        for (unsigned j = 0; j < 16; ++j) { const unsigned c = xb_ld(&bar[XB_XCNT(j)]); sum += c; cnt += (c > 0u) ? 1u : 0u; mine = (j == x) ? c : mine; }
        if (sum == G) break;
        __builtin_amdgcn_s_sleep(1);
        if ((++sp & 255u) == 0u) { if (xb_ld(&bar[XB_TMO])) break; if (sp > XB_SPIN_CAP) { atomicAdd(&bar[XB_TMO], 1u); break; } }
    }
    nloc = mine > 0u ? mine : 1u; nx = cnt > 0u ? cnt : 1u;
}

__device__ __forceinline__ void xcd_barrier(const XcdBarrier& b) {
    asm volatile("s_waitcnt vmcnt(0)" ::: "memory");
    __syncthreads();
    if (threadIdx.x == 0) {
        unsigned* bar = b.bar;
        __builtin_amdgcn_s_waitcnt(0);
        unsigned nloc = b.st[0], nx = b.st[1];
        if (nloc == 0u) { xcd_barrier_complete(bar, b.x, nloc, nx); b.st[0] = nloc; b.st[1] = nx; }
        const unsigned old = xb_add(&bar[XB_XSUB(b.x)], 1u);
        const unsigned gen = old / nloc;
        if (old + 1u == (gen + 1u) * nloc) {
            __builtin_amdgcn_fence(__ATOMIC_RELEASE, "agent");
            asm volatile("s_waitcnt vmcnt(0)" ::: "memory");
            const unsigned og = xb_add(&bar[XB_TOP], 1u);
            const unsigned tg = og / nx;
            if (og + 1u == (tg + 1u) * nx) xb_add(&bar[XB_TOPGEN], 1u);
            else XB_SPIN(xb_ld(&bar[XB_TOPGEN]) == tg, bar);
            __builtin_amdgcn_fence(__ATOMIC_ACQUIRE, "agent");
            xb_add(&bar[XB_XGEN(b.x)], 1u);
            asm volatile("s_waitcnt vmcnt(0)" ::: "memory");
        } else {
            XB_SPIN(xb_ld(&bar[XB_XGEN(b.x)]) == gen, bar);
            __builtin_amdgcn_fence(__ATOMIC_ACQUIRE, "agent");
            asm volatile("s_waitcnt vmcnt(0)" ::: "memory");
        }
    }
    __syncthreads();
}
#define HYD __device__ __forceinline__
#define HYDM __device__ __forceinline__
#define HY_DEVICE 1
#ifdef HY_DEVICE
#define HY_OPAQUE(x) asm volatile("" : "+v"(x))
#else
#define HY_OPAQUE(x) (void)(x)
#endif
typedef float cf __attribute__((ext_vector_type(2)));
typedef float cf2 __attribute__((ext_vector_type(4)));
template <class P> struct HyP2 {};
template <> struct HyP2<cf*> { typedef cf2* type; };
#ifdef HY_DEVICE
template <> struct HyP2<__attribute__((address_space(3))) cf*> { typedef __attribute__((address_space(3))) cf2* type; };
#endif
HYD cf cf_add(cf a, cf b) { return a + b; }
HYD cf cf_sub(cf a, cf b) { return a - b; }
HYD cf cf_mul(cf a, cf b) { return cf{a.x * b.x - a.y * b.y, a.x * b.y + a.y * b.x}; }
HYD cf cf_mulc(cf a, cf b) { return cf{a.x * b.x + a.y * b.y, a.y * b.x - a.x * b.y}; }
constexpr int FN = 16384, FT = 512, FLOG = 14, FNP = FN + 4 * (FN >> 6);
constexpr int SEQL = 8192;
HYD int HP(int i) { return i + ((i >> 6) << 2); }
#define HY_C1 0.92387953251128674f
#define HY_S1 0.38268343236508977f
#define HY_R2 0.70710678118654752f
template <int M16> HYD cf mul_root16(cf w) {
    if (M16 == 0) return w;
    if (M16 == 4) return cf{w.y, -w.x};
    if (M16 == 2) return cf{(w.x + w.y) * HY_R2, (w.y - w.x) * HY_R2};
    if (M16 == 6) return cf{(w.y - w.x) * HY_R2, -(w.x + w.y) * HY_R2};
    if (M16 == 1) return cf_mul(w, cf{HY_C1, -HY_S1});
    if (M16 == 3) return cf_mul(w, cf{HY_S1, -HY_C1});
    if (M16 == 5) return cf_mul(w, cf{-HY_S1, -HY_C1});
    return cf_mul(w, cf{-HY_C1, -HY_S1});
}
template <int Q, int U, bool INV, bool ZUP, bool HLO> struct HyStage {
    static HYDM void run(cf (&e)[1 << Q], const cf (&tw)[Q]) {
        constexpr int R = 1 << Q, half = R >> (U + 1);
#pragma unroll
        for (int k = 0; k < R; ++k) {
            if ((k & half) == 0) {
                const int kp = k & (half - 1);
                cf w = tw[U];
                switch (kp * 16 / (2 * half)) {
                    case 0: break;
                    case 1: w = mul_root16<1>(w); break;
                    case 2: w = mul_root16<2>(w); break;
                    case 3: w = mul_root16<3>(w); break;
                    case 4: w = mul_root16<4>(w); break;
                    case 5: w = mul_root16<5>(w); break;
                    case 6: w = mul_root16<6>(w); break;
                    default: w = mul_root16<7>(w); break;
                }
                if (!INV) {
                    if (ZUP && U == 0) { e[k + half] = cf_mul(e[k], w); }
                    else { const cf a = e[k], b = e[k + half]; e[k] = cf_add(a, b); e[k + half] = cf_mul(cf_sub(a, b), w); }
                } else {
                    const cf a = e[k], b = cf_mulc(e[k + half], w); e[k] = cf_add(a, b);
                    if (!(HLO && U == 0)) e[k + half] = cf_sub(a, b);
                }
            }
        }
    }
};
template <int Q, bool INV, bool ZUP, bool HLO> HYD void hy_bfly(cf (&e)[1 << Q], cf t) {
    cf tw[Q]; tw[0] = t;
#pragma unroll
    for (int u = 1; u < Q; ++u) tw[u] = cf_mul(tw[u - 1], tw[u - 1]);
    if (Q == 4) {
        if (!INV) { HyStage<Q, 0, INV, ZUP, HLO>::run(e, tw); HyStage<Q, 1, INV, ZUP, HLO>::run(e, tw); HyStage<Q, 2 % Q, INV, ZUP, HLO>::run(e, tw); HyStage<Q, 3 % Q, INV, ZUP, HLO>::run(e, tw); }
        else      { HyStage<Q, 3 % Q, INV, ZUP, HLO>::run(e, tw); HyStage<Q, 2 % Q, INV, ZUP, HLO>::run(e, tw); HyStage<Q, 1, INV, ZUP, HLO>::run(e, tw); HyStage<Q, 0, INV, ZUP, HLO>::run(e, tw); }
    } else {
        if (!INV) { HyStage<Q, 0, INV, ZUP, HLO>::run(e, tw); HyStage<Q, 1, INV, ZUP, HLO>::run(e, tw); }
        else      { HyStage<Q, 1, INV, ZUP, HLO>::run(e, tw); HyStage<Q, 0, INV, ZUP, HLO>::run(e, tw); }
    }
}
#ifdef HY_DEVICE
#define HY_MULT(T, X, Y) "v_pk_mul_f32 " T ", " X ", " Y " op_sel:[1,1] op_sel_hi:[1,0]\n\t"
#define HY_FMAP(R, X, Y, T) "v_pk_fma_f32 " R ", " X ", " Y ", " T " op_sel_hi:[0,1,1] neg_lo:[0,0,1]\n\t"
#define HY_FMAC(R, X, Y, T) "v_pk_fma_f32 " R ", " X ", " Y ", " T " op_sel_hi:[0,1,1] neg_hi:[1,0,0]\n\t"
#define HY_ADD(R, A, B) "v_pk_add_f32 " R ", " A ", " B "\n\t"
#define HY_SUB(R, A, B) "v_pk_add_f32 " R ", " A ", " B " neg_lo:[0,1] neg_hi:[0,1]\n\t"
HYD void hy_cmul2(cf& r0, cf x0, cf y0, cf& r1, cf x1, cf y1) { cf t0, t1;
    asm(HY_MULT("%0", "%4", "%5") HY_MULT("%1", "%6", "%7") HY_FMAP("%2", "%4", "%5", "%0") HY_FMAP("%3", "%6", "%7", "%1")
        : "=&v"(t0), "=&v"(t1), "=&v"(r0), "=&v"(r1) : "v"(x0), "v"(y0), "v"(x1), "v"(y1)); }
HYD cf hy_cmul1(cf x, cf y) { cf t, r;
    asm(HY_MULT("%0", "%2", "%3") "s_nop 0\n\t" HY_FMAP("%1", "%2", "%3", "%0") : "=&v"(t), "=&v"(r) : "v"(x), "v"(y)); return r; }
HYD void hy_bf2_fwd(cf& a0, cf& b0, cf w0, cf& a1, cf& b1, cf w1) { cf d0, d1, t0, t1;
    asm(HY_SUB("%4", "%0", "%1") HY_ADD("%0", "%0", "%1") HY_SUB("%5", "%2", "%3") HY_ADD("%2", "%2", "%3")
        HY_MULT("%6", "%4", "%8") HY_MULT("%7", "%5", "%9") HY_FMAP("%1", "%4", "%8", "%6") HY_FMAP("%3", "%5", "%9", "%7")
        : "+v"(a0), "+v"(b0), "+v"(a1), "+v"(b1), "=&v"(d0), "=&v"(d1), "=&v"(t0), "=&v"(t1) : "v"(w0), "v"(w1)); }
HYD void hy_bf2_fwdz(cf a0, cf& b0, cf w0, cf a1, cf& b1, cf w1) { hy_cmul2(b0, a0, w0, b1, a1, w1); }
HYD void hy_bf2_inv(cf& a0, cf& b0, cf w0, cf& a1, cf& b1, cf w1) { cf t0, t1;
    asm(HY_MULT("%4", "%1", "%6") HY_MULT("%5", "%3", "%7") HY_FMAC("%4", "%1", "%6", "%4") HY_FMAC("%5", "%3", "%7", "%5")
        HY_SUB("%1", "%0", "%4") HY_SUB("%3", "%2", "%5") HY_ADD("%0", "%0", "%4") HY_ADD("%2", "%2", "%5")
        : "+v"(a0), "+v"(b0), "+v"(a1), "+v"(b1), "=&v"(t0), "=&v"(t1) : "v"(w0), "v"(w1)); }
HYD void hy_bf2_invl(cf& a0, cf b0, cf w0, cf& a1, cf b1, cf w1) { cf t0, t1;
    asm(HY_MULT("%2", "%4", "%6") HY_MULT("%3", "%5", "%7") HY_FMAC("%2", "%4", "%6", "%2") HY_FMAC("%3", "%5", "%7", "%3")
        HY_ADD("%0", "%0", "%2") HY_ADD("%1", "%1", "%3")
        : "+v"(a0), "+v"(a1), "=&v"(t0), "=&v"(t1) : "v"(b0), "v"(b1), "v"(w0), "v"(w1)); }
HYD cf hy_rot(cf w) { cf r; asm("v_pk_add_f32 %0, %1, 0 op_sel:[1,0] op_sel_hi:[0,0] neg_hi:[1,0]" : "=v"(r) : "v"(w)); return r; }
#else
HYD void hy_cmul2(cf& r0, cf x0, cf y0, cf& r1, cf x1, cf y1) { const cf p0 = cf_mul(x0, y0), p1 = cf_mul(x1, y1); r0 = p0; r1 = p1; }
HYD cf hy_cmul1(cf x, cf y) { return cf_mul(x, y); }
HYD void hy_bf2_fwd(cf& a0, cf& b0, cf w0, cf& a1, cf& b1, cf w1) { const cf d0 = cf_sub(a0, b0), d1 = cf_sub(a1, b1); a0 = cf_add(a0, b0); a1 = cf_add(a1, b1); b0 = cf_mul(d0, w0); b1 = cf_mul(d1, w1); }
HYD void hy_bf2_fwdz(cf a0, cf& b0, cf w0, cf a1, cf& b1, cf w1) { b0 = cf_mul(a0, w0); b1 = cf_mul(a1, w1); }
HYD void hy_bf2_inv(cf& a0, cf& b0, cf w0, cf& a1, cf& b1, cf w1) { const cf p0 = cf_mulc(b0, w0), p1 = cf_mulc(b1, w1); b0 = cf_sub(a0, p0); b1 = cf_sub(a1, p1); a0 = cf_add(a0, p0); a1 = cf_add(a1, p1); }
HYD void hy_bf2_invl(cf& a0, cf b0, cf w0, cf& a1, cf b1, cf w1) { a0 = cf_add(a0, cf_mulc(b0, w0)); a1 = cf_add(a1, cf_mulc(b1, w1)); }
HYD cf hy_rot(cf w) { return cf{w.y, -w.x}; }
#endif
template <int U, bool INV, bool ZUP, bool HLO> HYD void hy_stage16(cf (&e)[16], const cf* W) {
    constexpr int half = 8 >> U;
#pragma unroll
    for (int j = 0; j < 8; j += 2) {
        const int k0 = ((j / half) * 2 * half) + (j % half), k1 = (((j + 1) / half) * 2 * half) + ((j + 1) % half);
        const cf w0 = W[k0 & (half - 1)], w1 = W[k1 & (half - 1)];
        if (!INV) { if (ZUP && U == 0) hy_bf2_fwdz(e[k0], e[k0 + half], w0, e[k1], e[k1 + half], w1); else hy_bf2_fwd(e[k0], e[k0 + half], w0, e[k1], e[k1 + half], w1); }
        else { if (HLO && U == 0) hy_bf2_invl(e[k0], e[k0 + half], w0, e[k1], e[k1 + half], w1); else hy_bf2_inv(e[k0], e[k0 + half], w0, e[k1], e[k1 + half], w1); }
    }
}
template <bool INV, bool ZUP, bool HLO> HYD void hy_bfly16(cf (&e)[16], cf t) {
    cf W0[8], W1[4], W2[2], W3[1], tw1, tw2;
    cf k1 = cf{HY_C1, -HY_S1}, k2 = cf{HY_R2, -HY_R2}, k3 = cf{HY_S1, -HY_C1};
    W0[0] = t;
    hy_cmul2(W0[1], t, k1, W0[3], t, k3);
    hy_cmul2(W0[2], t, k2, tw1, t, t);
    W1[0] = tw1;
    hy_cmul2(W1[1], tw1, k2, tw2, tw1, tw1);
    W2[0] = tw2;
    W3[0] = hy_cmul1(tw2, tw2);
#pragma unroll
    for (int i = 0; i < 4; ++i) W0[4 + i] = hy_rot(W0[i]);
    W1[2] = hy_rot(W1[0]); W1[3] = hy_rot(W1[1]); W2[1] = hy_rot(W2[0]);
    if (!INV) { hy_stage16<0, INV, ZUP, HLO>(e, W0); hy_stage16<1, INV, ZUP, HLO>(e, W1); hy_stage16<2, INV, ZUP, HLO>(e, W2); hy_stage16<3, INV, ZUP, HLO>(e, W3); }
    else      { hy_stage16<3, INV, ZUP, HLO>(e, W3); hy_stage16<2, INV, ZUP, HLO>(e, W2); hy_stage16<1, INV, ZUP, HLO>(e, W1); hy_stage16<0, INV, ZUP, HLO>(e, W0); }
}
template <class PT> HYD cf hy_twid(PT thi, PT tlo, int e) { return hy_cmul1(thi[e >> 7], tlo[e & 127]); }
template <int S, bool INV, bool ZUP, bool HLO, class P, class PT>
HYD void hy_pass16(P X, PT thi, PT tlo, int tid) {
    constexpr int R = 16;
    constexpr int SP = (S >= 64) ? S + S / 16 : S;
    const int g0 = tid, g1 = tid + FT;
    const int lo0 = g0 & (S - 1), pb0 = HP((g0 / S) * S * R + lo0);
    const int lo1 = g1 & (S - 1), pb1 = HP((g1 / S) * S * R + lo1);
    cf e0[R], e1[R];
#pragma unroll
    for (int k = 0; k < R; ++k) { if (ZUP && k >= 8) e0[k] = cf{0.f, 0.f}; else e0[k] = X[pb0 + k * SP]; }
#pragma unroll
    for (int k = 0; k < R; ++k) { if (ZUP && k >= 8) e1[k] = cf{0.f, 0.f}; else e1[k] = X[pb1 + k * SP]; }
    const cf t0 = hy_twid(thi, tlo, lo0 * (FN / (R * S))), t1 = hy_twid(thi, tlo, lo1 * (FN / (R * S)));
    hy_bfly16<INV, ZUP, HLO>(e0, t0);
#pragma unroll
    for (int k = 0; k < R; ++k) { if (!(HLO && k >= 8)) X[pb0 + k * SP] = e0[k]; }
    hy_bfly16<INV, ZUP, HLO>(e1, t1);
#pragma unroll
    for (int k = 0; k < R; ++k) { if (!(HLO && k >= 8)) X[pb1 + k * SP] = e1[k]; }
}
template <bool INV> HYD void hy_r4(cf (&e)[4]) {
    if (!INV) {
        const cf a0 = e[0] + e[2], b0 = e[0] - e[2], a1 = e[1] + e[3], d = e[1] - e[3], b1 = cf{d.y, -d.x};
        e[0] = a0 + a1; e[1] = a0 - a1; e[2] = b0 + b1; e[3] = b0 - b1;
    } else {
        const cf a0 = e[0] + e[1], a1 = e[0] - e[1], a2 = e[2] + e[3], d = e[2] - e[3], b = cf{-d.y, d.x};
        e[0] = a0 + a2; e[2] = a0 - a2; e[1] = a1 + b; e[3] = a1 - b;
    }
}
template <bool INV, class P, class PK>
HYD void hy_pass4(P X, int tid, PK KM) {
    typedef typename HyP2<P>::type P2;
    const int w = tid >> 6, lane = tid & 63;
#pragma unroll 1
    for (int gb = 0; gb < 2; ++gb) {
        cf2 a[4], b[4], ka[4], kb[4];
        const int g0 = (gb * 8 + w) * 256 + lane;
#pragma unroll
        for (int u = 0; u < 4; ++u) { const int g = g0 + 64 * u; P2 X2 = (P2)(X + HP(4 * g)); a[u] = X2[0]; b[u] = X2[1];
            if (KM) { const unsigned gi = (unsigned)(4 * g) & 0x3fffu; ka[u] = ((const cf2*)(KM + gi))[0]; kb[u] = ((const cf2*)(KM + gi))[1]; } }
#pragma unroll
        for (int u = 0; u < 4; ++u) { const int g = g0 + 64 * u; P2 X2 = (P2)(X + HP(4 * g));
            cf e[4] = {cf{a[u].x, a[u].y}, cf{a[u].z, a[u].w}, cf{b[u].x, b[u].y}, cf{b[u].z, b[u].w}};
            hy_r4<INV>(e);
            if (KM) { cf q0, q1, q2, q3; hy_cmul2(q0, e[0], cf{ka[u].x, ka[u].y}, q1, e[1], cf{ka[u].z, ka[u].w}); hy_cmul2(q2, e[2], cf{kb[u].x, kb[u].y}, q3, e[3], cf{kb[u].z, kb[u].w}); e[0] = q0; e[1] = q1; e[2] = q2; e[3] = q3; }
            X2[0] = cf2{e[0].x, e[0].y, e[1].x, e[1].y}; X2[1] = cf2{e[2].x, e[2].y, e[3].x, e[3].y}; }
    }
}
HYD int hy_brev14(int p) {
    unsigned v = (unsigned)p;
    v = ((v >> 1) & 0x55555555u) | ((v & 0x55555555u) << 1);
    v = ((v >> 2) & 0x33333333u) | ((v & 0x33333333u) << 2);
    v = ((v >> 4) & 0x0F0F0F0Fu) | ((v & 0x0F0F0F0Fu) << 4);
    v = ((v >> 8) & 0x00FF00FFu) | ((v & 0x00FF00FFu) << 8);
    v = (v >> 16) | (v << 16);
    return (int)(v >> (32 - FLOG));
}
HYD float hy_bf2f(unsigned short b) { unsigned u = (unsigned)b << 16; float f; __builtin_memcpy(&f, &u, 4); return f; }
HYD unsigned hy_f2bf(float f) { unsigned u; __builtin_memcpy(&u, &f, 4); return (u + 0x7fffu + ((u >> 16) & 1u)) >> 16; }
template <class PR> HYD void hy_sconv2(PR rowj  , unsigned tid, int j, float w0, float w1, float w2, float b, float& u0, float& u1) {
    const unsigned d1 = rowj[tid];
    const unsigned d0r = (rowj - 1)[tid], d2r = (rowj + 1)[tid];
    const unsigned d0 = (j > 0 || tid > 0) ? d0r : 0u;
    const unsigned d2 = (j < 7 || tid < (unsigned)(FT - 1)) ? d2r : 0u;
    const float pm1 = hy_bf2f((unsigned short)(d0 >> 16)), p0 = hy_bf2f((unsigned short)(d1 & 0xffffu)), p1 = hy_bf2f((unsigned short)(d1 >> 16)), p2 = hy_bf2f((unsigned short)(d2 & 0xffffu));
    u0 = b + w0 * pm1 + w1 * p0 + w2 * p1;
    u1 = b + w0 * p0 + w1 * p1 + w2 * p2;
}
template <class P> HYD void hy_filter_step(P X, const unsigned short* taps, float delta, int tid) {
    typedef typename HyP2<P>::type P2;
    typedef unsigned u32x2h __attribute__((ext_vector_type(2)));
    u32x2h raw[SEQL / (4 * FT)][4];
    const float dscale = -delta * (1.4426950408889634f / (float)(SEQL - 1)); (void)dscale;
#pragma unroll
    for (int j = 0; j < SEQL / (4 * FT); ++j)
#pragma unroll
        for (int q = 0; q < 4; ++q) raw[j][q] = *(const u32x2h*)(taps + (size_t)q * 1024 * SEQL + ((unsigned)(4 * (tid + FT * j)) & 0x1fffu));
#pragma unroll
    for (int j = 0; j < SEQL / (4 * FT); ++j) {
        const int t = 4 * (tid + FT * j);
        cf2 a[4];
#pragma unroll
        for (int q = 0; q < 4; ++q) a[q] = cf2{hy_bf2f((unsigned short)(raw[j][q].x & 0xffffu)), hy_bf2f((unsigned short)(raw[j][q].x >> 16)), hy_bf2f((unsigned short)(raw[j][q].y & 0xffffu)), hy_bf2f((unsigned short)(raw[j][q].y >> 16))};
        cf2 dec;
#pragma unroll
#ifdef HY_DEVICE
        for (int e = 0; e < 4; ++e) dec[e] = __builtin_amdgcn_exp2f((float)(t + e) * dscale);
#else
        for (int e = 0; e < 4; ++e) dec[e] = expf(-((float)(t + e) * (1.0f / (float)(SEQL - 1))) * delta);
#endif
        const cf2 a0 = a[0] * dec, a1 = a[1] * dec, a2 = a[2] * dec, a3 = a[3] * dec;
        P2 Xf = (P2)(X + HP(t));
        if (t == 0) { Xf[0] = cf2{a0[0] + a1[0], a2[0] + a3[0], a0[1], a2[1]}; float z0 = 0.f; HY_OPAQUE(z0); X[HP(SEQL)] = cf{z0, z0}; }
        else Xf[0] = cf2{a0[0], a2[0], a0[1], a2[1]};
        Xf[1] = cf2{a0[2], a2[2], a0[3], a2[3]};
        const int pbk = HP(FN - t - 4);
        X[pbk + 1] = cf{a1[3], a3[3]}; X[pbk + 2] = cf{a1[2], a3[2]}; X[pbk + 3] = cf{a1[1], a3[1]};
        if (t > 0) X[HP(FN - t)] = cf{a1[0], a3[0]};
    }
}
template <class P> HYD void hy_sep_step(P X, cf* K1g, cf* K2g, int tid) {
    const float sc = 0.5f / (float)FN;
#pragma unroll 1
    for (int j0 = 0; j0 < FN / FT; j0 += 4) {
        cf a[4], b[4];
#pragma unroll
        for (int u = 0; u < 4; ++u) { const int p = tid + FT * (j0 + u);
            const int f = hy_brev14(p), q = hy_brev14((FN - f) & (FN - 1));
            a[u] = X[HP(p)]; b[u] = X[HP(q)]; }
#pragma unroll
        for (int u = 0; u < 4; ++u) { const int p = tid + FT * (j0 + u);
            const unsigned pi = (unsigned)p & 0x3fffu;
            K1g[pi] = cf{(a[u].x + b[u].x) * sc, (a[u].y - b[u].y) * sc};
            K2g[pi] = cf{(a[u].y + b[u].y) * sc, -(a[u].x - b[u].x) * sc}; }
    }
}
template <class P> HYD void hy_load_step(P X, const unsigned* r0, const unsigned* r1, float w0, float w1, float w2, float b, float (&zr)[8][4], int tid) {
    typedef typename HyP2<P>::type P2;
#pragma unroll
    for (int j = 0; j < 8; ++j) {
        const int t = 2 * (tid + FT * j);
        hy_sconv2(r0 + FT * j, (unsigned)tid, j, w0, w1, w2, b, zr[j][0], zr[j][2]);
        hy_sconv2(r1 + FT * j, (unsigned)tid, j, w0, w1, w2, b, zr[j][1], zr[j][3]);
        *(P2)(X + HP(t)) = cf2{zr[j][0], zr[j][1], zr[j][2], zr[j][3]};
    }
}
template <class P> HYD void hy_gate1_step(P X, const unsigned* r0, const unsigned* r1, float w0, float w1, float w2, float b, float bias, float (&zr)[8][4], int tid) {
    typedef typename HyP2<P>::type P2;
#pragma unroll
    for (int j = 0; j < 8; ++j) {
        const int t = 2 * (tid + FT * j);
        float xa0, xa1, xb0, xb1;
        hy_sconv2(r0 + FT * j, (unsigned)tid, j, w0, w1, w2, b, xa0, xa1);
        hy_sconv2(r1 + FT * j, (unsigned)tid, j, w0, w1, w2, b, xb0, xb1);
        P2 xp = (P2)(X + HP(t));
        const cf2 y = *xp;
        zr[j][0] = xa0 * (y.x + zr[j][0] * bias); zr[j][1] = xb0 * (y.y + zr[j][1] * bias);
        zr[j][2] = xa1 * (y.z + zr[j][2] * bias); zr[j][3] = xb1 * (y.w + zr[j][3] * bias);
        *xp = cf2{zr[j][0], zr[j][1], zr[j][2], zr[j][3]};
    }
}
template <class P> HYD void hy_gate2_step(P X, const unsigned* r0, const unsigned* r1, float w0, float w1, float w2, float b, float bias, const float (&zr)[8][4], unsigned* out0, unsigned* out1, int tid) {
    typedef typename HyP2<P>::type P2;
#pragma unroll
    for (int j = 0; j < 8; ++j) {
        const int t = 2 * (tid + FT * j);
        float xa0, xa1, xb0, xb1;
        hy_sconv2(r0 + FT * j, (unsigned)tid, j, w0, w1, w2, b, xa0, xa1);
        hy_sconv2(r1 + FT * j, (unsigned)tid, j, w0, w1, w2, b, xb0, xb1);
        const cf2 y = *(P2)(X + HP(t));
        const float za0 = xa0 * (y.x + zr[j][0] * bias), zb0 = xb0 * (y.y + zr[j][1] * bias);
        const float za1 = xa1 * (y.z + zr[j][2] * bias), zb1 = xb1 * (y.w + zr[j][3] * bias);
        (out0 + FT * j)[(unsigned)tid] = hy_f2bf(za0) | (hy_f2bf(za1) << 16);
        (out1 + FT * j)[(unsigned)tid] = hy_f2bf(zb0) | (hy_f2bf(zb1) << 16);
    }
}
HYD float hy_sconv1(unsigned D0, unsigned D1, int t, float w0, float w1, float w2, float b, bool pad0, bool padL) {
    const unsigned sh = ((unsigned)(t - 1) & 1u) << 4;
#ifdef HY_DEVICE
    const unsigned lo = __builtin_amdgcn_alignbit(D1, D0, sh), hi = D1 >> sh;
#else
    const unsigned long long w = (((unsigned long long)D1 << 32) | D0) >> sh; const unsigned lo = (unsigned)w, hi = (unsigned)(w >> 32);
#endif
    float e0 = hy_bf2f((unsigned short)(lo & 0xffffu)), e1 = hy_bf2f((unsigned short)(lo >> 16)), e2 = hy_bf2f((unsigned short)(hi & 0xffffu));
    if (pad0 && t == 0) e0 = 0.f;
    if (padL && t == SEQL - 1) e2 = 0.f;
    return b + w0 * e0 + w1 * e1 + w2 * e2;
}
struct HyRaw { unsigned d[2][8][4]; };
HYD void hy_raw_load(HyRaw& R, const unsigned* r0, const unsigned* r1, int tid) {
#pragma unroll
    for (int r = 0; r < 2; ++r)
#pragma unroll
        for (int k = 0; k < 8; ++k) { const unsigned du = ((unsigned)(tid + FT * r + 1024 * k + 1) >> 1) & 0x1fffu;
            R.d[r][k][0] = (r0 - 1)[du]; R.d[r][k][1] = r0[du]; R.d[r][k][2] = (r1 - 1)[du]; R.d[r][k][3] = r1[du]; }
}
template <class P, class PT> HYD void hy_convA_fwd(P X, PT thi, PT tlo, int tid, const HyRaw& R, float w0, float w1, float w2, float b, cf (&zr)[2][8]) {
#pragma unroll
    for (int r = 0; r < 2; ++r) {
        const int i0 = tid + FT * r, pb = HP(i0);
        cf e[16];
#pragma unroll
        for (int k = 0; k < 8; ++k) { const int t = i0 + 1024 * k; const bool p0 = (r == 0 && k == 0), pL = (r == 1 && k == 7); e[k] = cf{hy_sconv1(R.d[r][k][0], R.d[r][k][1], t, w0, w1, w2, b, p0, pL), hy_sconv1(R.d[r][k][2], R.d[r][k][3], t, w0, w1, w2, b, p0, pL)}; zr[r][k] = e[k]; }
#pragma unroll
        for (int k = 8; k < 16; ++k) e[k] = cf{0.f, 0.f};
        hy_bfly16<false, true, false>(e, hy_twid(thi, tlo, i0));
#pragma unroll
        for (int k = 0; k < 16; ++k) X[pb + k * 1088] = e[k];
    }
}
template <bool LAST, class P, class PT> HYD void hy_gateA(P X, PT thi, PT tlo, int tid, const HyRaw& R, float w0, float w1, float w2, float b, float bias,
                                                           cf (&zr)[2][8], unsigned short* out0, unsigned short* out1) {
#pragma unroll
    for (int r = 0; r < 2; ++r) {
        const int i0 = tid + FT * r, pb = HP(i0);
        cf e[16];
#pragma unroll
        for (int k = 0; k < 16; ++k) e[k] = X[pb + k * 1088];
        const cf tw = hy_twid(thi, tlo, i0);
        hy_bfly16<true, false, true>(e, tw);
#pragma unroll
        for (int k = 0; k < 8; ++k) { const int t = i0 + 1024 * k;
            const bool p0 = (r == 0 && k == 0), pL = (r == 1 && k == 7);
            const float xa = hy_sconv1(R.d[r][k][0], R.d[r][k][1], t, w0, w1, w2, b, p0, pL), xb = hy_sconv1(R.d[r][k][2], R.d[r][k][3], t, w0, w1, w2, b, p0, pL);
            const cf z = cf{xa * (e[k].x + zr[r][k].x * bias), xb * (e[k].y + zr[r][k].y * bias)};
            if (LAST) {
#ifdef HY_DEVICE
                unsigned pk; asm("v_cvt_pk_bf16_f32 %0, %1, %2" : "=v"(pk) : "v"(z.x), "v"(z.y)); const unsigned ti = (unsigned)t & 0x1fffu; out0[ti] = (unsigned short)(pk & 0xffffu); out1[ti] = (unsigned short)(pk >> 16);
#else
                out0[t] = (unsigned short)hy_f2bf(z.x); out1[t] = (unsigned short)hy_f2bf(z.y);
#endif
            }
            else { zr[r][k] = z; e[k] = z; } }
        if (!LAST) {
#pragma unroll
            for (int k = 8; k < 16; ++k) e[k] = cf{0.f, 0.f};
            hy_bfly16<false, true, false>(e, tw);
#pragma unroll
            for (int k = 0; k < 16; ++k) X[pb + k * 1088] = e[k];
        }
    }
}
constexpr int NWAVES = 8, NTHR = NWAVES * 64;
constexpr int DM = 2048, SEQ = 8192, DEPTH = 4, NSEQ = 6, GSEQ = 2, NGRP = NSEQ / GSEQ, MG = GSEQ * SEQ;
constexpr int HYW = 1024, HYIN = 3072, QKVW = 3072, DFF = 5632, GU = 2 * DFF, FEMB = 33, FHID = 64;
constexpr float EPS = 1e-6f;
constexpr float QSCALE = 0.125f * 1.4426950408889634f;
constexpr size_t MiB = 1u << 20;
constexpr size_t WS_CTL = 0, CTL_ZERO_BYTES = 1 * MiB;
constexpr size_t SZ_WHY = (size_t)HYIN * DM * 2, SZ_WQKV = (size_t)QKVW * DM * 2, SZ_WOUT = (size_t)DM * DM * 2, SZ_WGU = (size_t)GU * DM * 2, SZ_WDN = (size_t)DM * DFF * 2;
constexpr size_t OFF_WHY = 0, OFF_WQKV = OFF_WHY + SZ_WHY, OFF_WOUT = OFF_WQKV + SZ_WQKV, OFF_WGU = OFF_WOUT + SZ_WOUT, OFF_WDN = OFF_WGU + SZ_WGU, SZ_WLAYER = OFF_WDN + SZ_WDN;
constexpr size_t WS_W = 1 * MiB;
constexpr size_t WS_ROPE = WS_W + DEPTH * SZ_WLAYER;
constexpr int KPAD = 256;
constexpr size_t WS_H3 = WS_ROPE + (size_t)SEQ * 32 * 8;
constexpr size_t WS_W4T = WS_H3 + (size_t)DEPTH * SEQ * KPAD * 2;
constexpr size_t WS_TAPS = WS_W4T + (size_t)DEPTH * 4096 * KPAD * 2;
constexpr size_t WS_FFTK = WS_TAPS + (size_t)4096 * SEQ * 2;
constexpr size_t WS_STASH = WS_FFTK + (size_t)256 * 2 * 16384 * 8;
constexpr size_t WS_XB = WS_STASH;
constexpr size_t WS_H = WS_XB + (size_t)MG * DM * 2;
constexpr size_t WS_ZT = WS_H + (size_t)MG * DM * 2;
constexpr size_t WS_PROJT = WS_ZT + (size_t)HYW * MG * 2;
constexpr size_t WS_QKV = WS_PROJT + (size_t)HYIN * MG * 2;
constexpr size_t WS_MIX = WS_PROJT;
constexpr size_t WS_FFH = WS_PROJT;
constexpr size_t WS_MIXIN = WS_QKV + (size_t)MG * QKVW * 2;
constexpr size_t WS_END = WS_MIXIN + (size_t)MG * DM * 2;
constexpr size_t SZ_TAPS = (size_t)4096 * SEQ * 2, WS_TAPS_X = WS_END, WS_END_X = WS_TAPS_X + (DEPTH - 1) * SZ_TAPS;
static_assert((size_t)MG * DFF * 2 <= (size_t)HYIN * MG * 2 + (size_t)MG * QKVW * 2, "FFH overlay fits PROJT|QKV");
static_assert(WS_W4T % 256 == 0 && WS_TAPS % 256 == 0 && WS_ROPE % 256 == 0 && WS_H3 % 256 == 0 && WS_FFTK % 256 == 0 && WS_XB % 256 == 0 && WS_H % 256 == 0 && SZ_WLAYER % 256 == 0, "alignment");
constexpr int CW_BAR = 4096;
constexpr int PH_PER_LAYER = 8, PH_PER_GROUP = 1 + DEPTH * PH_PER_LAYER, NPHASE = 1 + NGRP * PH_PER_GROUP;
constexpr int RING_OFF = 0, RING_BYTES = 131072;
constexpr int TAB_OFF = 139264;
constexpr int MISC_OFF = TAB_OFF + 4096;
constexpr int LDS_BYTES = 147456;
static_assert(MISC_OFF + 128 <= LDS_BYTES, "LDS map");
static_assert(att::SHM_ATTN_ALL <= MISC_OFF, "attention LDS fits below the control words");
#ifndef PROBE_DUP
#define PROBE_DUP 0
#endif
#ifndef MK_PER_PHASE
#define MK_PER_PHASE 0
#endif

struct Args { const float* in[30]; float* out; unsigned char* ws; int ph_lo, ph_hi, taps_all, pad; };
enum { I_XP = 0, I_XS, I_GMPRE, I_GMPOST, I_GFPRE, I_GFPOST, I_WIN, I_CONVW, I_CONVB, I_FW1, I_FB1, I_FF1, I_FW2, I_FB2, I_FF2, I_FW3, I_FB3, I_FF3, I_FW4,
       I_HBIAS, I_HNORM, I_LQ1, I_LK1, I_LQ2, I_LK2, I_SUBLN, I_WOUT, I_WGATE, I_WUP, I_WDOWN };

template <int K> __device__ __forceinline__ float swz_xor(float v) { return __builtin_bit_cast(float, __builtin_amdgcn_ds_swizzle(__builtin_bit_cast(int, v), (K << 10) | 0x1f)); }
__device__ __forceinline__ float wave_sum(float v) {
    v += swz_xor<1>(v); v += swz_xor<2>(v); v += swz_xor<4>(v); v += swz_xor<8>(v); v += swz_xor<16>(v);
    auto rr = __builtin_amdgcn_permlane32_swap(__float_as_uint(v), __float_as_uint(v), false, false);
    return __uint_as_float(rr[0]) + __uint_as_float(rr[1]);
}
__device__ __forceinline__ bf16* wt_dst_row(int kind, int n, bf16* d0, bf16* d1, int K) {
    if (kind == 0) return d0 + (size_t)n * K;
    if (kind == 1) { if (n < HYIN) return d0 + (size_t)n * K; int q = n - HYIN; if (q < 2048) { const int hb = q & ~63, i = q & 63; q = hb + (i < 32 ? 2 * i : 2 * (i - 32) + 1); } return d1 + (size_t)q * K; }
    if (kind == 4) return d0 + (size_t)n * KPAD;
    const int r = (n >> 7) * 256 + (n & 127) + (kind == 3 ? 128 : 0); return d0 + (size_t)r * K;
}
__device__ __forceinline__ void p0_transpose_item(const float* W, int K, int N, int kind, bf16* d0, bf16* d1, LAS float* scr, int item, int lane) {
    const int nblk = N / 32, kb = item / nblk, nb = item % nblk, k0 = 64 * kb, n0 = 32 * nb;
#pragma unroll 8
    for (int i = 0; i < 32; ++i) { const int kk = 2 * i + (lane >> 5); scr[kk * 33 + (lane & 31)] = W[(size_t)(k0 + kk) * N + n0 + (lane & 31)]; }
    LDS_WAIT(); asm volatile("" ::: "memory");
    const int c = lane & 7;
#pragma unroll
    for (int j = 0; j < 4; ++j) { const int n = (lane >> 3) + 8 * j; const LAS float* s = scr + (8 * c) * 33 + n;
        v4u o; o.x = pk2(s[0 * 33], s[1 * 33]); o.y = pk2(s[2 * 33], s[3 * 33]); o.z = pk2(s[4 * 33], s[5 * 33]); o.w = pk2(s[6 * 33], s[7 * 33]);
        *(GAS v4u*)(wt_dst_row(kind, n0 + n, d0, d1, K) + k0 + 8 * c) = o; }
    LDS_WAIT(); asm volatile("" ::: "memory");
}
__device__ __forceinline__ void sincos_red(double ang, float& s, float& c) {
    const double k = rint(ang * 0.15915494309189535); const float r = (float)(ang - k * 6.283185307179586);
    s = sinf(r); c = cosf(r);
}
#define GP(p) ((const float*)(const GAS float*)(p))
#define LAUNDER_TID(F) do { int t_ = (F).tid; asm volatile("" : "+v"(t_)); (F).tid = t_; (F).lane = t_ & 63; int z_ = 0; asm volatile("" : "+s"(z_)); (F).z = z_; unsigned long long w_ = (unsigned long long)(F).ws0; asm volatile("" : "+s"(w_)); (F).ws = (unsigned char*)(GAS unsigned char*)w_; int b_ = (F).bx0, v_ = (F).vcu0, g_ = (F).G0; asm volatile("" : "+s"(b_), "+s"(v_), "+s"(g_)); (F).bx = b_; (F).vcu = v_; (F).G = g_; } while (0)
struct Frame {
    LAS unsigned char* lds; volatile LAS unsigned* MISC; gu32* ctl;
    int tid, lane, wave, vcu, G, bx;
    int vcu0, G0, bx0;
    float* out; unsigned char* ws; unsigned char* ws0; int z;
};
__device__ __forceinline__ void p0_prologue(Frame& F, const Args& A) {
    LAS float* scr = (LAS float*)(F.lds + RING_OFF + F.wave * 16384);
    const int gw = F.vcu * NWAVES + F.wave, NGW = F.G * NWAVES;
    constexpr int I_IN = (DM / 64) * ((HYIN + QKVW) / 32), I_OUT = (DM / 64) * (DM / 32), I_G = (DM / 64) * (DFF / 32), I_D = (DFF / 64) * (DM / 32);
    constexpr int I_W4 = 4096 / 32;
    constexpr int PER_L = I_IN + I_OUT + 2 * I_G + I_D + I_W4;
    for (int it = gw; it < DEPTH * PER_L; it += NGW) {
        const int l = it / PER_L; int r = it % PER_L;
        unsigned char* wl = F.ws + WS_W + (size_t)l * SZ_WLAYER;
        if (r < I_IN) { p0_transpose_item(GP(A.in[I_WIN + F.z]) + (size_t)l * DM * (HYIN + QKVW), DM, HYIN + QKVW, 1, (bf16*)(wl + OFF_WHY), (bf16*)(wl + OFF_WQKV), scr, r, F.lane); continue; } r -= I_IN;
        if (r < I_OUT) { p0_transpose_item(GP(A.in[I_WOUT + F.z]) + (size_t)l * DM * DM, DM, DM, 0, (bf16*)(wl + OFF_WOUT), nullptr, scr, r, F.lane); continue; } r -= I_OUT;
        if (r < I_G) { p0_transpose_item(GP(A.in[I_WGATE + F.z]) + (size_t)l * DM * DFF, DM, DFF, 2, (bf16*)(wl + OFF_WGU), nullptr, scr, r, F.lane); continue; } r -= I_G;
        if (r < I_G) { p0_transpose_item(GP(A.in[I_WUP + F.z]) + (size_t)l * DM * DFF, DM, DFF, 3, (bf16*)(wl + OFF_WGU), nullptr, scr, r, F.lane); continue; } r -= I_G;
        if (r < I_D) { p0_transpose_item(GP(A.in[I_WDOWN + F.z]) + (size_t)l * DFF * DM, DFF, DM, 0, (bf16*)(wl + OFF_WDN), nullptr, scr, r, F.lane); continue; } r -= I_D;
        { bf16* w4t = (bf16*)(F.ws + WS_W4T) + (size_t)l * 4096 * KPAD;
          p0_transpose_item(GP(A.in[I_FW4 + F.z]) + (size_t)l * FHID * 4096, FHID, 4096, 4, w4t, nullptr, scr, r, F.lane);
          for (int e = F.lane; e < 32 * 24; e += 64) *(GAS v4u*)(w4t + (size_t)(32 * r + e / 24) * KPAD + 64 + 8 * (e % 24)) = (v4u){0u, 0u, 0u, 0u}; }
    }
    {
        float* cs = (float*)(F.ws + WS_ROPE);
        for (int e = F.vcu * NTHR + F.tid; e < SEQ * 32; e += F.G * NTHR) {
            const int t = e >> 5, p = e & 31;
            const double inv = exp(-9.210340371976184 * (double)(2 * p) / 64.0);
            float s, c; sincos_red((double)t * inv, s, c);
            cs[2 * e] = c; cs[2 * e + 1] = s;
        }
    }
    {
        bf16* h3b = (bf16*)(F.ws + WS_H3);
        LAS float* hb = (LAS float*)(F.lds + RING_OFF + F.wave * 16384);
        for (int task = gw; task < DEPTH * (SEQ / 64); task += NGW) {
            const int l = task / (SEQ / 64), t = (task % (SEQ / 64)) * 64 + F.lane;
            const float* w1 = GP(A.in[I_FW1 + F.z]) + (size_t)l * FEMB * FHID; const float* w2 = GP(A.in[I_FW2 + F.z]) + (size_t)l * FHID * FHID; const float* w3 = GP(A.in[I_FW3 + F.z]) + (size_t)l * FHID * FHID;
            hb[F.lane] = (float)t * (1.0f / (float)(SEQ - 1));
#pragma unroll 1
            for (int bi = 0; bi < 16; ++bi) { const double band = 1e-4 + (double)bi * ((15.0 - 1e-4) / 15.0);
                float s, c; sincos_red(6.283185307179586 * (double)t / (double)SEQ * band, s, c); hb[(1 + bi) * 64 + F.lane] = c; hb[(17 + bi) * 64 + F.lane] = -s; }
#pragma unroll 1
            for (int stage = 0; stage < 3; ++stage) {
                const float* w = stage == 0 ? w1 : (stage == 1 ? w2 : w3);
                const float* bb = (stage == 0 ? GP(A.in[I_FB1 + F.z]) : (stage == 1 ? GP(A.in[I_FB2 + F.z]) : GP(A.in[I_FB3 + F.z]))) + l * FHID;
                const float* ff = (stage == 0 ? GP(A.in[I_FF1 + F.z]) : (stage == 1 ? GP(A.in[I_FF2 + F.z]) : GP(A.in[I_FF3 + F.z]))) + l * FHID;
                const int nin = stage == 0 ? FEMB : FHID;
                typedef float f32x16_t __attribute__((ext_vector_type(16)));
                f32x16_t c0 = {}, c1 = {}, c2 = {}, c3 = {};
                LDS_WAIT();
#pragma unroll 1
                for (int i = 0; i < nin; ++i) { const float hv = hb[i * 64 + F.lane]; const f32x16_t* wr = (const f32x16_t*)(w + i * FHID);
                    c0 += wr[0] * hv; c1 += wr[1] * hv; c2 += wr[2] * hv; c3 += wr[3] * hv; }
                const f32x16_t* b16 = (const f32x16_t*)bb; const f32x16_t* f16 = (const f32x16_t*)ff;
                c0 = (c0 + b16[0]) * f16[0]; c1 = (c1 + b16[1]) * f16[1]; c2 = (c2 + b16[2]) * f16[2]; c3 = (c3 + b16[3]) * f16[3];
                if (stage < 2) {
#pragma unroll
                    for (int e = 0; e < 16; ++e) { hb[e * 64 + F.lane] = sinf(c0[e]); hb[(16 + e) * 64 + F.lane] = sinf(c1[e]); hb[(32 + e) * 64 + F.lane] = sinf(c2[e]); hb[(48 + e) * 64 + F.lane] = sinf(c3[e]); }
                } else {
                    GAS v4u* o = (GAS v4u*)(h3b + ((size_t)l * SEQ + t) * KPAD);
#pragma unroll
                    for (int q = 0; q < 2; ++q) { v4u w; w.x = pk2(sinf(c0[8 * q]), sinf(c0[8 * q + 1])); w.y = pk2(sinf(c0[8 * q + 2]), sinf(c0[8 * q + 3])); w.z = pk2(sinf(c0[8 * q + 4]), sinf(c0[8 * q + 5])); w.w = pk2(sinf(c0[8 * q + 6]), sinf(c0[8 * q + 7])); o[q] = w; }
#pragma unroll
                    for (int q = 0; q < 2; ++q) { v4u w; w.x = pk2(sinf(c1[8 * q]), sinf(c1[8 * q + 1])); w.y = pk2(sinf(c1[8 * q + 2]), sinf(c1[8 * q + 3])); w.z = pk2(sinf(c1[8 * q + 4]), sinf(c1[8 * q + 5])); w.w = pk2(sinf(c1[8 * q + 6]), sinf(c1[8 * q + 7])); o[2 + q] = w; }
#pragma unroll
                    for (int q = 0; q < 2; ++q) { v4u w; w.x = pk2(sinf(c2[8 * q]), sinf(c2[8 * q + 1])); w.y = pk2(sinf(c2[8 * q + 2]), sinf(c2[8 * q + 3])); w.z = pk2(sinf(c2[8 * q + 4]), sinf(c2[8 * q + 5])); w.w = pk2(sinf(c2[8 * q + 6]), sinf(c2[8 * q + 7])); o[4 + q] = w; }
#pragma unroll
                    for (int q = 0; q < 2; ++q) { v4u w; w.x = pk2(sinf(c3[8 * q]), sinf(c3[8 * q + 1])); w.y = pk2(sinf(c3[8 * q + 2]), sinf(c3[8 * q + 3])); w.z = pk2(sinf(c3[8 * q + 4]), sinf(c3[8 * q + 5])); w.w = pk2(sinf(c3[8 * q + 6]), sinf(c3[8 * q + 7])); o[6 + q] = w; }
#pragma unroll 1
                    for (int q = 8; q < 32; ++q) o[q] = (v4u){0u, 0u, 0u, 0u};
                }
            }
        }
    }
}
template <bool XSB>
__device__ __forceinline__ void norm_pass(Frame& F, const void* x_src, const bf16* add, const float* g_add, bf16* xb_dst, float* xf_dst, const float* g_out, bf16* h_dst) {
    const int gw = F.vcu * NWAVES + F.wave, NGW = F.G * NWAVES;
#define UNPK(q, lo, hi) do { lo = (f32x4){__uint_as_float((q).x << 16), __uint_as_float((q).x & 0xffff0000u), __uint_as_float((q).y << 16), __uint_as_float((q).y & 0xffff0000u)}; \
                             hi = (f32x4){__uint_as_float((q).z << 16), __uint_as_float((q).z & 0xffff0000u), __uint_as_float((q).w << 16), __uint_as_float((q).w & 0xffff0000u)}; } while (0)
#define PK8(lo, hi) (v4u){pk2((lo)[0], (lo)[1]), pk2((lo)[2], (lo)[3]), pk2((hi)[0], (hi)[1]), pk2((hi)[2], (hi)[3])}
    f32x4 gA[8], gO[8];
#pragma unroll
    for (int j = 0; j < 8; ++j) { gA[j] = (f32x4){0.f, 0.f, 0.f, 0.f}; gO[j] = (f32x4){0.f, 0.f, 0.f, 0.f}; }
    if (add) { const GAS f32x4* gr = (const GAS f32x4*)g_add + 2 * F.lane;
#pragma unroll
        for (int j = 0; j < 4; ++j) { gA[2 * j] = gr[128 * j]; gA[2 * j + 1] = gr[128 * j + 1]; } }
    if (h_dst) { const GAS f32x4* gr = (const GAS f32x4*)g_out + 2 * F.lane;
#pragma unroll
        for (int j = 0; j < 4; ++j) { gO[2 * j] = gr[128 * j]; gO[2 * j + 1] = gr[128 * j + 1]; } }
    v4u rq[4], rw[4]; f32x4 rf[8];
#pragma unroll
    for (int j = 0; j < 4; ++j) { rq[j] = (v4u){0u, 0u, 0u, 0u}; rw[j] = (v4u){0u, 0u, 0u, 0u}; }
#define NP_FETCH(m) do { \
        if (XSB) { const GAS v4u* xa_ = (const GAS v4u*)((const bf16*)x_src + (size_t)(m) * DM) + F.lane; _Pragma("unroll") for (int j = 0; j < 4; ++j) rq[j] = xa_[64 * j]; } \
        else { const GAS f32x4* xa_ = (const GAS f32x4*)((const float*)x_src + (size_t)(m) * DM) + 2 * F.lane; _Pragma("unroll") for (int j = 0; j < 4; ++j) { rf[2 * j] = xa_[128 * j]; rf[2 * j + 1] = xa_[128 * j + 1]; } } \
        if (add) { const GAS v4u* aa_ = (const GAS v4u*)(add + (size_t)(m) * DM) + F.lane; _Pragma("unroll") for (int j = 0; j < 4; ++j) rw[j] = aa_[64 * j]; } } while (0)
    if (gw < MG) NP_FETCH(gw);
    for (int m0 = gw; m0 < MG; m0 += NGW) {
        f32x4 va[8]; v4u wa[4];
        if (XSB) {
#pragma unroll
            for (int j = 0; j < 4; ++j) UNPK(rq[j], va[2 * j], va[2 * j + 1]);
        } else {
#pragma unroll
            for (int j = 0; j < 8; ++j) va[j] = rf[j];
        }
#pragma unroll
        for (int j = 0; j < 4; ++j) wa[j] = rw[j];
        if (m0 + NGW < MG) NP_FETCH(m0 + NGW);
        if (add) {
            float sa = 0.f;
#pragma unroll
            for (int j = 0; j < 4; ++j) { f32x4 a0, a1; UNPK(wa[j], a0, a1);
                sa += ((a0[0] * a0[0] + a0[1] * a0[1]) + (a0[2] * a0[2] + a0[3] * a0[3])) + ((a1[0] * a1[0] + a1[1] * a1[1]) + (a1[2] * a1[2] + a1[3] * a1[3])); }
            const float ra = 1.0f / sqrtf(wave_sum(sa) * (1.0f / DM) + EPS);
#pragma unroll
            for (int j = 0; j < 4; ++j) { f32x4 a0, a1; UNPK(wa[j], a0, a1);
                va[2 * j] = va[2 * j] + a0 * ra * gA[2 * j]; va[2 * j + 1] = va[2 * j + 1] + a1 * ra * gA[2 * j + 1]; }
        }
        if (xf_dst) { GAS f32x4* oa = (GAS f32x4*)(xf_dst + (size_t)m0 * DM) + 2 * F.lane;
#pragma unroll
            for (int j = 0; j < 4; ++j) { oa[128 * j] = va[2 * j]; oa[128 * j + 1] = va[2 * j + 1]; } }
        if (xb_dst) { GAS v4u* oa = (GAS v4u*)(xb_dst + (size_t)m0 * DM) + F.lane;
#pragma unroll
            for (int j = 0; j < 4; ++j) { const v4u w = PK8(va[2 * j], va[2 * j + 1]); oa[64 * j] = w;
                UNPK(w, va[2 * j], va[2 * j + 1]); } }
        if (h_dst) {
            float sa = 0.f;
#pragma unroll
            for (int j = 0; j < 8; ++j) sa += (va[j][0] * va[j][0] + va[j][1] * va[j][1]) + (va[j][2] * va[j][2] + va[j][3] * va[j][3]);
            const float ra = 1.0f / sqrtf(wave_sum(sa) * (1.0f / DM) + EPS);
            GAS v4u* ha = (GAS v4u*)(h_dst + (size_t)m0 * DM) + F.lane;
#pragma unroll
            for (int j = 0; j < 4; ++j) { const f32x4 oa0 = va[2 * j] * ra * gO[2 * j], oa1 = va[2 * j + 1] * ra * gO[2 * j + 1]; ha[64 * j] = PK8(oa0, oa1); }
        }
    }
#undef NP_FETCH
#undef UNPK
#undef PK8
}
typedef LAS cf* lcf;
template <bool ZUP> __device__ __forceinline__ void hy_fwd(lcf X, lcf thi, lcf tlo, int tid, const cf* KM) {
    if (ZUP) hy_pass16<1024, false, true, false>(X, thi, tlo, tid); else hy_pass16<1024, false, false, false>(X, thi, tlo, tid);
    __syncthreads();
    hy_pass16<64, false, false, false>(X, thi, tlo, tid);
    hy_pass16<4, false, false, false>(X, thi, tlo, tid);
    hy_pass4<false>(X, tid, KM); __syncthreads();
}
__device__ __forceinline__ void hy_inv(lcf X, lcf thi, lcf tlo, int tid) {
    const cf* nul = nullptr;
    hy_pass4<true>(X, tid, nul); __syncthreads();
    hy_pass16<4, true, false, false>(X, thi, tlo, tid); __syncthreads();
    hy_pass16<64, true, false, false>(X, thi, tlo, tid); __syncthreads();
    hy_pass16<1024, true, false, true>(X, thi, tlo, tid); __syncthreads();
}
__device__ __forceinline__ void hy_mid(lcf X, lcf thi, lcf tlo, int tid, const cf* KM) {
    const cf* nul = nullptr;
    hy_pass16<64, false, false, false>(X, thi, tlo, tid);
    hy_pass16<4, false, false, false>(X, thi, tlo, tid);
    hy_pass4<false>(X, tid, KM);
    hy_pass4<true>(X, tid, nul);
    hy_pass16<4, true, false, false>(X, thi, tlo, tid);
    hy_pass16<64, true, false, false>(X, thi, tlo, tid); __syncthreads();
}
__device__ __forceinline__ void hyena_phase(Frame& F, const Args& A, int l) {
    lcf X = (lcf)(F.lds + RING_OFF); lcf thi = (lcf)(F.lds + TAB_OFF); lcf tlo = thi + 128;
    const int tid = F.tid;
    if (tid < 256) { const int a = tid & 127; const double ang = -6.283185307179586 * (double)(tid < 128 ? 128 * a : a) / (double)FN; float s, c; sincos_red(ang, s, c); (tid < 128 ? thi : tlo)[a] = cf{c, s}; }
    cf* K1g = (cf*)(F.ws + WS_FFTK) + (size_t)F.bx * 2 * FN; cf* K2g = K1g + FN;
    const bf16* taps = (const bf16*)(F.ws + ((A.taps_all && l > 0) ? WS_TAPS_X + (size_t)(l - 1) * SZ_TAPS : WS_TAPS));
    const float* cw = GP(A.in[I_CONVW + F.z]) + (size_t)l * 3 * HYIN; const float* cb = GP(A.in[I_CONVB + F.z]) + (size_t)l * HYIN; const float* hb = GP(A.in[I_HBIAS + F.z]) + (size_t)l * 2 * HYW;
    const bf16* projT = (const bf16*)(F.ws + WS_PROJT); bf16* zT = (bf16*)(F.ws + WS_ZT);
    for (int c = F.vcu; c < HYW; c += F.G) {
        __syncthreads();
        const float delta = fabsf(-15.350567286626973f + (float)c * ((-3.0701134573253945f + 15.350567286626973f) / 1023.0f));
#define TIDX(v) int v = tid; asm volatile("" : "+v"(v))
        { TIDX(t_); hy_filter_step(X, taps + (size_t)c * SEQ, delta, t_); }
        const unsigned* rx1 = (const unsigned*)(projT + (size_t)c * MG); const unsigned* rx2 = (const unsigned*)(projT + (size_t)(HYW + c) * MG); const unsigned* rv = (const unsigned*)(projT + (size_t)(2 * HYW + c) * MG);
        HyRaw R;
        { TIDX(t_); hy_raw_load(R, rv, rv + SEQ / 2, t_); }
        __syncthreads();
        { TIDX(t_); hy_fwd<false>(X, thi, tlo, t_, nullptr); }
        { TIDX(t_); hy_sep_step(X, K1g, K2g, t_); }
        asm volatile("s_waitcnt vmcnt(0)" ::: "memory"); __syncthreads();
        cf zr[2][8];
        { TIDX(t_); hy_convA_fwd(X, thi, tlo, t_, R, cw[2 * HYW + c], cw[HYIN + 2 * HYW + c], cw[2 * HYIN + 2 * HYW + c], cb[2 * HYW + c], zr); }
        { TIDX(t_); hy_raw_load(R, rx1, rx1 + SEQ / 2, t_); }
        __syncthreads();
        { TIDX(t_); hy_mid(X, thi, tlo, t_, K1g); }
        { TIDX(t_); hy_gateA<false>(X, thi, tlo, t_, R, cw[c], cw[HYIN + c], cw[2 * HYIN + c], cb[c], hb[c], zr, (unsigned short*)nullptr, (unsigned short*)nullptr); }
        { TIDX(t_); hy_raw_load(R, rx2, rx2 + SEQ / 2, t_); }
        __syncthreads();
        { TIDX(t_); hy_mid(X, thi, tlo, t_, K2g); }
        unsigned short* zo = (unsigned short*)(zT + (size_t)c * MG);
        { TIDX(t_); hy_gateA<true>(X, thi, tlo, t_, R, cw[HYW + c], cw[HYIN + HYW + c], cw[2 * HYIN + HYW + c], cb[HYW + c], hb[HYW + c], zr, zo, zo + SEQ); }
#undef TIDX
    }
    __syncthreads();
}
__device__ __forceinline__ void hynorm_phase(Frame& F, const Args& A, int l) {
    constexpr int TB = 64;
    LAS unsigned char* tile = F.lds + RING_OFF; LAS float* red = (LAS float*)(F.lds + RING_OFF + TB * HYW * 2); LAS float* rinv = red + 8 * TB;
    const bf16* zT = (const bf16*)(F.ws + WS_ZT); bf16* mixin = (bf16*)(F.ws + WS_MIXIN); const float* gn = GP(A.in[I_HNORM + F.z]) + (size_t)l * HYW;
    const int tid = F.tid;
    for (int tb = F.vcu; tb < MG / TB; tb += F.G) {
        const int t0 = tb * TB; __syncthreads();
        float ps[8];
#pragma unroll
        for (int i = 0; i < 8; ++i) ps[i] = 0.f;
        const int k = tid & 7, crow = tid >> 3;
#pragma unroll
        for (int hb = 0; hb < 2; ++hb) {
            v4u w[8];
#pragma unroll
            for (int it = 0; it < 8; ++it) { const unsigned c = (unsigned)((hb * 8 + it) * 64 + crow) & 1023u; w[it] = *(const GAS v4u*)(zT + (size_t)c * MG + (unsigned)(t0 + 8 * k)); }
#pragma unroll
            for (int it = 0; it < 8; ++it) { const int c = (hb * 8 + it) * 64 + crow;
                LAS unsigned short* d = (LAS unsigned short*)(tile + (8 * k) * 2048 + (((c >> 3) ^ k) << 4) + (c & 7) * 2);
                const unsigned ww[4] = {w[it].x, w[it].y, w[it].z, w[it].w};
#pragma unroll
                for (int i = 0; i < 4; ++i) { d[(2 * i) * 1024] = (unsigned short)(ww[i] & 0xffffu); d[(2 * i + 1) * 1024] = (unsigned short)(ww[i] >> 16);
                    const float a = __uint_as_float(ww[i] << 16), b = __uint_as_float(ww[i] & 0xffff0000u); ps[2 * i] += a * a; ps[2 * i + 1] += b * b; } }
        }
#pragma unroll
        for (int i = 0; i < 8; ++i) { float v = ps[i]; v += swz_xor<8>(v); v += swz_xor<16>(v);
            auto rr = __builtin_amdgcn_permlane32_swap(__float_as_uint(v), __float_as_uint(v), false, false); ps[i] = __uint_as_float(rr[0]) + __uint_as_float(rr[1]); }
        if ((F.lane >> 3) == 0) {
#pragma unroll
            for (int i = 0; i < 8; ++i) red[F.wave * TB + 8 * k + i] = ps[i]; }
        __syncthreads();
        if (tid < TB) { float s = 0.f;
#pragma unroll
            for (int w8 = 0; w8 < 8; ++w8) s += red[w8 * TB + tid];
            rinv[tid] = 1.0f / sqrtf(s * (1.0f / HYW) + EPS); }
        __syncthreads();
        const int cg = tid & 127;
        const f32x4 g0 = *(const f32x4*)(gn + 8 * cg), g1 = *(const f32x4*)(gn + 8 * cg + 4);
#pragma unroll 4
        for (int it = 0; it < 16; ++it) { const int tok = it * 4 + (tid >> 7); const float r = rinv[tok];
            const v4u q = *(const LAS v4u*)(tile + tok * 2048 + ((cg ^ (tok >> 3)) << 4));
            v4u o; o.x = pk2(__uint_as_float(q.x << 16) * r * g0[0], __uint_as_float(q.x & 0xffff0000u) * r * g0[1]); o.y = pk2(__uint_as_float(q.y << 16) * r * g0[2], __uint_as_float(q.y & 0xffff0000u) * r * g0[3]);
            o.z = pk2(__uint_as_float(q.z << 16) * r * g1[0], __uint_as_float(q.z & 0xffff0000u) * r * g1[1]); o.w = pk2(__uint_as_float(q.w << 16) * r * g1[2], __uint_as_float(q.w & 0xffff0000u) * r * g1[3]);
            *(GAS v4u*)(mixin + (size_t)(t0 + tok) * DM + 8 * cg) = o; }
    }
    __syncthreads();
}
__device__ __forceinline__ void attn_phase(Frame& F, const Args& A, int l, unsigned char* lds_generic) {
    const float li = 0.8f - 0.6f * expf(-0.3f * (float)l);
    float lam;
    { const int j = F.lane; const float a = GP(A.in[I_LQ1 + F.z])[l * 64 + j] * GP(A.in[I_LK1 + F.z])[l * 64 + j], b = GP(A.in[I_LQ2 + F.z])[l * 64 + j] * GP(A.in[I_LK2 + F.z])[l * 64 + j];
      lam = expf(wave_sum(a)) - expf(wave_sum(b)) + li; }
    const att::bf16* qkv = (const att::bf16*)(F.ws + WS_QKV); att::bf16* mixin = (att::bf16*)(F.ws + WS_MIXIN);
    float* stash = (float*)(F.ws + WS_H) + (size_t)F.bx * 64 * 512;
    const float* subln = GP(A.in[I_SUBLN + F.z]) + (size_t)l * 128;
    constexpr int NU = GSEQ * 8 * (SEQ / 256);
    for (int u = F.vcu; u < NU; u += F.G) {
        const int bvh = u >> 5, qb = u & 31, b = bvh >> 3, vh = bvh & 7;
        const long krow0 = (long)b * SEQ, qrow0 = krow0 + qb * 256;
        att::attn_unit(qkv, qrow0, krow0, vh, SEQ, lam, 1.0f - li, subln, mixin + (size_t)qrow0 * DM + HYW + vh * 128, DM, stash, (char*)lds_generic);
        __syncthreads();
    }
}
#ifndef PHMASK
#define PHMASK 511
#endif
__global__ void __launch_bounds__(NTHR, 2) hymba_fwd(Args args) {
    extern __shared__ __attribute__((aligned(16))) unsigned char lds[];
    Frame F;
    F.lds = (LAS unsigned char*)lds; F.MISC = (volatile LAS unsigned*)(F.lds + MISC_OFF);
    F.tid = threadIdx.x; F.lane = F.tid & 63; F.wave = __builtin_amdgcn_readfirstlane(F.tid >> 6);
    F.G = gridDim.x; { const int bx = blockIdx.x; F.vcu = (F.G % 8 == 0) ? (bx % 8) * (F.G / 8) + bx / 8 : bx; F.bx = bx; }
    F.vcu0 = F.vcu; F.G0 = F.G; F.bx0 = F.bx;
    F.ctl = (gu32*)(args.ws + WS_CTL); F.out = args.out; F.ws = args.ws; F.ws0 = args.ws; F.z = 0;
    for (int u = F.tid; u < (LDS_BYTES - MISC_OFF) / 4; u += NTHR) ((LAS unsigned*)(F.lds + MISC_OFF))[u] = 0u;
    __syncthreads();
    XcdBarrier bar; bar.bar = (unsigned*)(F.ctl + CW_BAR); bar.x = 0; bar.st = nullptr;
    if (!MK_PER_PHASE) bar = xcd_barrier_post((unsigned*)(F.ctl + CW_BAR), F.MISC + 8);
    const int lo = args.ph_lo, hi = args.ph_hi;
    int ph = 0;
#define IN_() (lo <= ph && ph < hi && ({ LAUNDER_TID(F); true; }))
#define DUP3(...) do { __VA_ARGS__; if (PROBE_DUP == 3) { __VA_ARGS__; } } while (0)
#define SEAM() do { if (!MK_PER_PHASE && lo <= ph && ph + 1 < hi) { XcdBarrier b_ = bar; { unsigned long long p_ = (unsigned long long)b_.bar; unsigned x_ = b_.x; asm volatile("" : "+s"(p_), "+s"(x_)); b_.bar = (unsigned*)(GAS unsigned*)p_; b_.x = x_; } \
        xcd_barrier(b_); if (PROBE_DUP == 7) xcd_barrier(b_); } ++ph; } while (0)
    if ((PHMASK & 1) && IN_()) { p0_prologue(F, args); if (PROBE_DUP == 4) p0_prologue(F, args); }
    SEAM();
#define Hb ((bf16*)(F.ws + WS_H))
#define XB ((bf16*)(F.ws + WS_XB))
#define projT ((bf16*)(F.ws + WS_PROJT))
#define qkv ((bf16*)(F.ws + WS_QKV))
#define mix ((bf16*)(F.ws + WS_MIX))
#define ffh ((bf16*)(F.ws + WS_FFH))
#define mixin ((bf16*)(F.ws + WS_MIXIN))
#define wl (F.ws + WS_W + (size_t)l * SZ_WLAYER)
#define xin ((g == 0) ? GP(args.in[I_XP + F.z]) : GP(args.in[I_XS + F.z]) + (size_t)(g - 1) * MG * DM)
#define xres ((float*)(GAS float*)args.out + (size_t)g * MG * DM)
    for (int g = 0; g < NGRP; ++g) {
        if ((PHMASK & 2) && IN_()) norm_pass<false>(F, xin, nullptr, nullptr, nullptr, nullptr, GP(args.in[I_GMPRE + F.z]), Hb);
        SEAM();
        for (int l = 0; l < DEPTH; ++l) {
            if ((PHMASK & 4) && IN_()) {
                { pg8::Gemm gm{(const bf16*)(wl + OFF_WHY), Hb, HYIN, MG, DM}; pg8::StaticOrder S; S.init(HYIN, MG, F.G, F.bx);
                  pg8::EpiPlain E{projT, MG};
                  DUP3(pg8::gemm_phase<pg8::EpiPlain, pg8::StaticOrder, true, true>(F.lds + RING_OFF, gm, S, E)); }
                if (g == 0 || !args.taps_all) { pg8::Gemm gm{(const bf16*)(F.ws + WS_W4T) + (size_t)l * 4096 * KPAD, (const bf16*)(F.ws + WS_H3) + (size_t)l * SEQ * KPAD, 4096, SEQ, KPAD}; pg8::StaticOrder S; S.init(4096, SEQ, F.G, F.bx);
                  pg8::EpiPlain E{(bf16*)(F.ws + ((args.taps_all && l > 0) ? WS_TAPS_X + (size_t)(l - 1) * SZ_TAPS : WS_TAPS)), SEQ};
                  DUP3(pg8::gemm_phase<pg8::EpiPlain, pg8::StaticOrder, true, true>(F.lds + RING_OFF, gm, S, E)); }
                { pg8::Gemm gm{Hb, (const bf16*)(wl + OFF_WQKV), MG, QKVW, DM}; pg8::StaticOrder S; S.init(MG, QKVW, F.G, F.bx);
                  pg8::EpiRope E{qkv, QKVW, (const float*)(F.ws + WS_ROPE), QSCALE};
                  DUP3(pg8::gemm_phase<pg8::EpiRope, pg8::StaticOrder, true, true>(F.lds + RING_OFF, gm, S, E)); }
            }
            SEAM();
            if (IN_()) { if (PHMASK & 8) hyena_phase(F, args, l); if (PROBE_DUP == 2) hyena_phase(F, args, l); if (PHMASK & 16) attn_phase(F, args, l, lds); if (PROBE_DUP == 1) attn_phase(F, args, l, lds); }
            SEAM();
            if ((PHMASK & 32) && IN_()) { hynorm_phase(F, args, l); if (PROBE_DUP == 4) hynorm_phase(F, args, l); }
            SEAM();
            if ((PHMASK & 64) && IN_()) { pg8::Gemm gm{mixin, (const bf16*)(wl + OFF_WOUT), MG, DM, DM}; pg8::StaticOrder S; S.init(MG, DM, F.G, F.bx);
                pg8::EpiPlain E{mix, DM};
                DUP3(pg8::gemm_phase<pg8::EpiPlain, pg8::StaticOrder, true, true>(F.lds + RING_OFF, gm, S, E)); }
            SEAM();
            if ((PHMASK & 2) && IN_()) { if (l == 0) norm_pass<false>(F, xin, mix, GP(args.in[I_GMPOST + F.z]) + (size_t)l * DM, XB, nullptr, GP(args.in[I_GFPRE + F.z]) + (size_t)l * DM, Hb);
                else norm_pass<true>(F, XB, mix, GP(args.in[I_GMPOST + F.z]) + (size_t)l * DM, XB, nullptr, GP(args.in[I_GFPRE + F.z]) + (size_t)l * DM, Hb); }
            SEAM();
            if ((PHMASK & 128) && IN_()) { pg8::Gemm gm{Hb, (const bf16*)(wl + OFF_WGU), MG, GU, DM}; pg8::StaticOrder S; S.init(MG, GU, F.G, F.bx);
                pg8::EpiSwiGLU E{ffh, DFF};
                DUP3(pg8::gemm_phase<pg8::EpiSwiGLU, pg8::StaticOrder, true, true>(F.lds + RING_OFF, gm, S, E)); }
            SEAM();
            if ((PHMASK & 256) && IN_()) { pg8::Gemm gm{ffh, (const bf16*)(wl + OFF_WDN), MG, DM, DFF}; pg8::StaticOrder S; S.init(MG, DM, F.G, F.bx);
                pg8::EpiPlain E{mixin, DM};
                DUP3(pg8::gemm_phase<pg8::EpiPlain, pg8::StaticOrder, true, true>(F.lds + RING_OFF, gm, S, E)); }
            SEAM();
            if ((PHMASK & 2) && IN_()) { if (l + 1 < DEPTH) norm_pass<true>(F, XB, mixin, GP(args.in[I_GFPOST + F.z]) + (size_t)l * DM, XB, nullptr, GP(args.in[I_GMPRE + F.z]) + (size_t)(l + 1) * DM, Hb);
                else norm_pass<true>(F, XB, mixin, GP(args.in[I_GFPOST + F.z]) + (size_t)l * DM, nullptr, xres, nullptr, nullptr); }
            SEAM();
        }
    }
#undef IN_
#undef SEAM
#undef Hb
#undef XB
#undef projT
#undef qkv
#undef mix
#undef ffh
#undef mixin
#undef wl
#undef xin
#undef xres
}

extern "C" void kernel_launch(void* const* d_in, const int* in_sizes, int n_in, void* d_out, int out_size, void* d_ws, size_t ws_size, hipStream_t stream) {
    static int grid = 0;
    if (grid == 0) {
        if (n_in != 30 || in_sizes[0] != 2 * SEQ * DM || in_sizes[1] != 4 * SEQ * DM || out_size != NSEQ * SEQ * DM || ws_size < WS_END) {
            fprintf(stderr, "kernel_launch: shape mismatch (n_in %d, out %d, ws %zu, need %zu)\n", n_in, out_size, ws_size, (size_t)WS_END); grid = -1; return; }
        int dev = 0, cus = 0;
        if (hipGetDevice(&dev) != hipSuccess || hipDeviceGetAttribute(&cus, hipDeviceAttributeMultiprocessorCount, dev) != hipSuccess) { grid = -1; return; }
        if (hipFuncSetAttribute((const void*)hymba_fwd, hipFuncAttributeMaxDynamicSharedMemorySize, LDS_BYTES) != hipSuccess) { fprintf(stderr, "kernel_launch: hipFuncSetAttribute failed\n"); grid = -1; return; }
        int per_cu = 0;
        if (hipOccupancyMaxActiveBlocksPerMultiprocessor(&per_cu, (const void*)hymba_fwd, NTHR, LDS_BYTES) != hipSuccess || per_cu < 1) fprintf(stderr, "kernel_launch: occupancy query says %d\n", per_cu);
        (void)hipGetLastError();
        grid = cus;
    }
    if (grid < 0) return;
    if (hipMemsetAsync((char*)d_ws + WS_CTL, 0, CTL_ZERO_BYTES, stream) != hipSuccess) return;
    Args a{};
    for (int i = 0; i < 30; ++i) a.in[i] = (const float*)d_in[i];
    a.out = (float*)d_out; a.ws = (unsigned char*)d_ws; a.taps_all = (ws_size >= WS_END_X) ? 1 : 0;
#if MK_PER_PHASE
    for (int p = 0; p < NPHASE; ++p) { a.ph_lo = p; a.ph_hi = p + 1; hipLaunchKernelGGL(hymba_fwd, dim3(grid), dim3(NTHR), LDS_BYTES, stream, a); }
#else
    a.ph_lo = 0; a.ph_hi = NPHASE;
    hipLaunchKernelGGL(hymba_fwd, dim3(grid), dim3(NTHR), LDS_BYTES, stream, a);
#endif
    const hipError_t le = hipPeekAtLastError();
    if (le != hipSuccess) fprintf(stderr, "kernel_launch: launch failed: %s\n", hipGetErrorName(le));
}
```

```cpp
#include <hip/hip_runtime.h>
#include <hip/hip_bf16.h>
#include <cstdio>
#include <cstdint>
#include <cmath>
namespace pg8 {
#define PG8_LAS __attribute__((address_space(3)))
typedef unsigned short bf16_t;
typedef short bf16x8 __attribute__((ext_vector_type(8)));
typedef float f32x4 __attribute__((ext_vector_type(4)));
typedef unsigned u32x4 __attribute__((ext_vector_type(4)));
constexpr int BM = 256, BK = 64, HALF = 128, HTB = HALF * BK * 2  , STAGE_BYTES = 8 * HTB, NXCD = 8, WGM = 8;

__host__ __device__ __forceinline__ int lds_byte(int r, int c) { const int st = (r >> 4) * 2 + (c >> 5), rr = r & 15, cc = c & 31, ob = rr * 64 + cc * 2; return st * 1024 + (ob ^ (((ob >> 9) & 1) << 5)); }
__host__ __device__ __forceinline__ void stage_rc(int b, int& R, int& C) { const int st = b / 1024, sb = b % 1024, swz = sb ^ (((sb >> 9) & 1) << 5); R = (st >> 1) * 16 + swz / 64; C = (st & 1) * 32 + (swz % 64) / 2; }
__host__ __device__ __forceinline__ int perm32(int rho) { const int n = rho >> 4, i = rho & 15; return 8 * (i >> 2) + 4 * n + (i & 3); }

struct Unit { int pm, pn; };
struct Gemm { const bf16_t* A; const bf16_t* Bt; int M, N, K; };

struct StaticOrder {
    int nM, nN, nwg, G, c;
    __host__ __device__ void init(int M, int N, int G_, int c_) { nM = M / BM; nN = N / BM; nwg = nM * nN; G = G_; c = c_; }
    __host__ __device__ bool next(int i, Unit& u) const {
        const long L = (long)i * G + c; if (L >= nwg) return false;
        int wgid = (int)L; { const int q = nwg / NXCD, r = nwg % NXCD, xcd = wgid % NXCD, off = wgid / NXCD; wgid = (xcd < r ? xcd * (q + 1) : r * (q + 1) + (xcd - r) * q) + off; }
        const int nig = WGM * nN, gid = wgid / nig, fm = gid * WGM, gsz = (nM - fm) < WGM ? (nM - fm) : WGM;
        u.pm = fm + ((wgid % nig) % gsz); u.pn = (wgid % nig) / gsz; return true;
    }
    __device__ __forceinline__ void a_ready(const Unit&) const {}
    __device__ __forceinline__ void done(const Unit&) const {}
};

__device__ __forceinline__ unsigned cvt_pk_bf16(float lo, float hi) { unsigned r; asm volatile("v_cvt_pk_bf16_f32 %0, %1, %2" : "=v"(r) : "v"(lo), "v"(hi)); return r; }
typedef float f32x2 __attribute__((ext_vector_type(2)));
struct EpiPlain {
    static constexpr bool PERM = true, AFTER_DRAIN = false;
    bf16_t* O; int ldc;
    __device__ __forceinline__ void operator()(const f32x4 (&acc)[2][2][4][2], const Unit& u, int wr, int wc, int fr, int fq) const {
        const int row0 = u.pm * BM + wr * 64 + fr, col0 = u.pn * BM + wc * 32 + 8 * fq;
#pragma unroll
        for (int ai = 0; ai < 2; ++ai)
#pragma unroll
            for (int m = 0; m < 4; ++m) { bf16_t* rowp = O + (size_t)(row0 + ai * HALF + m * 16) * ldc + col0;
#pragma unroll
                for (int bj = 0; bj < 2; ++bj) { const f32x4 v0 = acc[ai][bj][m][0], v1 = acc[ai][bj][m][1];
                    u32x4 w; w.x = cvt_pk_bf16(v0[0], v0[1]); w.y = cvt_pk_bf16(v0[2], v0[3]); w.z = cvt_pk_bf16(v1[0], v1[1]); w.w = cvt_pk_bf16(v1[2], v1[3]);
                    *(u32x4*)(rowp + bj * HALF) = w; } }
    }
};
struct EpiRope {
    static constexpr bool PERM = true, AFTER_DRAIN = false;
    bf16_t* O; int ldc; const float* cs; float qscale;
    __device__ __forceinline__ void operator()(const f32x4 (&acc)[2][2][4][2], const Unit& u, int wr, int wc, int fr, int fq) const {
        const int row0 = u.pm * BM + wr * 64 + fr, col0 = u.pn * BM + wc * 32 + 8 * fq;
        const bool rope = u.pn < 8; const float sc = u.pn < 4 ? qscale : 1.0f;
        const int p0 = 16 * (wc & 1) + 4 * fq;
        f32x4 tt[2][4][2];
#pragma unroll
        for (int ai = 0; ai < 2; ++ai)
#pragma unroll
            for (int m = 0; m < 4; ++m) { tt[ai][m][0] = (f32x4){1.f, 0.f, 1.f, 0.f}; tt[ai][m][1] = (f32x4){1.f, 0.f, 1.f, 0.f};
                if (rope) { const int row = row0 + ai * HALF + m * 16; const __attribute__((address_space(1))) float* tp = (const __attribute__((address_space(1))) float*)cs + ((size_t)(row & 8191) * 32 + p0) * 2;
                    tt[ai][m][0] = *(const __attribute__((address_space(1))) f32x4*)tp; tt[ai][m][1] = *(const __attribute__((address_space(1))) f32x4*)(tp + 4); } }
#pragma unroll
        for (int ai = 0; ai < 2; ++ai)
#pragma unroll
            for (int m = 0; m < 4; ++m) { const int row = row0 + ai * HALF + m * 16; bf16_t* rowp = O + (size_t)row * ldc + col0;
                const f32x4 t0 = tt[ai][m][0], t1 = tt[ai][m][1];
#pragma unroll
                for (int bj = 0; bj < 2; ++bj) { const f32x4 v0 = acc[ai][bj][m][0], v1 = acc[ai][bj][m][1];
                    f32x4 o0, o1;
                    o0[0] = (v0[0] * t0[0] - v0[1] * t0[1]) * sc; o0[1] = (v0[0] * t0[1] + v0[1] * t0[0]) * sc;
                    o0[2] = (v0[2] * t0[2] - v0[3] * t0[3]) * sc; o0[3] = (v0[2] * t0[3] + v0[3] * t0[2]) * sc;
                    o1[0] = (v1[0] * t1[0] - v1[1] * t1[1]) * sc; o1[1] = (v1[0] * t1[1] + v1[1] * t1[0]) * sc;
                    o1[2] = (v1[2] * t1[2] - v1[3] * t1[3]) * sc; o1[3] = (v1[2] * t1[3] + v1[3] * t1[2]) * sc;
                    u32x4 w; w.x = cvt_pk_bf16(o0[0], o0[1]); w.y = cvt_pk_bf16(o0[2], o0[3]); w.z = cvt_pk_bf16(o1[0], o1[1]); w.w = cvt_pk_bf16(o1[2], o1[3]);
                    *(u32x4*)(rowp + bj * HALF) = w; } }
    }
};
struct EpiSwiGLU {
    static constexpr bool PERM = true, AFTER_DRAIN = false;
    bf16_t* O; int ldc;
    static __device__ __forceinline__ float silu_mul(float g, float u) { return g * u * __builtin_amdgcn_rcpf(1.0f + __builtin_amdgcn_exp2f(-1.4426950408889634f * g)); }
    __device__ __forceinline__ void operator()(const f32x4 (&acc)[2][2][4][2], const Unit& u, int wr, int wc, int fr, int fq) const {
        const int row0 = u.pm * BM + wr * 64 + fr, col0 = u.pn * HALF + wc * 32 + 8 * fq;
#pragma unroll
        for (int ai = 0; ai < 2; ++ai)
#pragma unroll
            for (int m = 0; m < 4; ++m) { bf16_t* rowp = O + (size_t)(row0 + ai * HALF + m * 16) * ldc + col0;
                const f32x4 g0 = acc[ai][0][m][0], g1 = acc[ai][0][m][1], u0 = acc[ai][1][m][0], u1 = acc[ai][1][m][1];
                u32x4 w; w.x = cvt_pk_bf16(silu_mul(g0[0], u0[0]), silu_mul(g0[1], u0[1])); w.y = cvt_pk_bf16(silu_mul(g0[2], u0[2]), silu_mul(g0[3], u0[3]));
                w.z = cvt_pk_bf16(silu_mul(g1[0], u1[0]), silu_mul(g1[1], u1[1])); w.w = cvt_pk_bf16(silu_mul(g1[2], u1[2]), silu_mul(g1[3], u1[3]));
                *(u32x4*)rowp = w; }
    }
};
template <class Epi, class Sched, bool ALIGN_EPI = false, bool SP2 = false>
__device__ __forceinline__ void gemm_phase(PG8_LAS unsigned char* lds, const Gemm g, const Sched& S, const Epi& E) {
    int tid = threadIdx.x; asm volatile("" : "+v"(tid));
    const int wid = __builtin_amdgcn_readfirstlane(tid >> 6), lane = tid & 63, wr = wid >> 2, wc = wid & 3, fr = lane & 15, fq = lane >> 4;
    const int K = g.K, nt = K / BK;
    unsigned voffA[2], voffB[2];
#pragma unroll
    for (int i = 0; i < 2; ++i) { int R, C; stage_rc(tid * 16 + i * 8192, R, C); const int Rb = Epi::PERM ? ((R & ~31) + perm32(R & 31)) : R;
        voffA[i] = (unsigned)(R * K + C) * 2u; voffB[i] = (unsigned)(Rb * K + C) * 2u; }
    const size_t kstep = (size_t)(BK * 2);
    const size_t hstep = (size_t)HALF * K * 2;
    const size_t tstep = 2 * hstep;
    const unsigned ldsw = (unsigned)wid * 1024u;
    const int aoff = lds_byte(wr * 64 + fr, fq * 8), boff = lds_byte(wc * 32 + fr, fq * 8);
#define PG8_SA(b, h) (((b) * 2 + (h)) * HTB)
#define PG8_SB(b, h) ((4 + (b) * 2 + (h)) * HTB)
#define PG8_STAGE(bufoff, gbase, voff) do { _Pragma("unroll") for (int _i = 0; _i < 2; ++_i) \
        __builtin_amdgcn_global_load_lds((const unsigned*)((const char*)(gbase) + (voff)[_i]), (PG8_LAS unsigned*)(lds + (bufoff) + ldsw + _i * 8192), 16, 0, 0); } while (0)
#define PG8_LDA(dst, b, h) do { _Pragma("unroll") for (int m = 0; m < 4; ++m) _Pragma("unroll") for (int k = 0; k < 2; ++k) dst[m][k] = *(const PG8_LAS bf16x8*)(lds + PG8_SA(b, h) + aoff + m * 2048 + k * 1024); } while (0)
#define PG8_LDB(dst, b, h) do { _Pragma("unroll") for (int n = 0; n < 2; ++n) _Pragma("unroll") for (int k = 0; k < 2; ++k) dst[n][k] = *(const PG8_LAS bf16x8*)(lds + PG8_SB(b, h) + boff + n * 2048 + k * 1024); } while (0)
#define PG8_MMA(ai, bj, At, Bt) do { __builtin_amdgcn_s_setprio(1); _Pragma("unroll") for (int m = 0; m < 4; ++m) _Pragma("unroll") for (int n = 0; n < 2; ++n) _Pragma("unroll") for (int k = 0; k < 2; ++k) \
        acc[ai][bj][m][n] = __builtin_amdgcn_mfma_f32_16x16x32_bf16(Bt[n][k], At[m][k], acc[ai][bj][m][n], 0, 0, 0); __builtin_amdgcn_s_setprio(0); } while (0)
#define PG8_WAIT_V(n) asm volatile("s_waitcnt vmcnt(" #n ")" ::: "memory")
#define PG8_WAIT_L(n) asm volatile("s_waitcnt lgkmcnt(" #n ")" ::: "memory")
#define PG8_BAR __builtin_amdgcn_s_barrier()
#define PG8_SCHED __builtin_amdgcn_sched_barrier(0)
    Unit cur, nxt; int ui = 0;
    if (!S.next(0, cur)) return;
    f32x4 acc[2][2][4][2];
#pragma unroll
    for (int a = 0; a < 2; ++a)
#pragma unroll
        for (int b = 0; b < 2; ++b)
#pragma unroll
            for (int m = 0; m < 4; ++m)
#pragma unroll
                for (int n = 0; n < 2; ++n) acc[a][b][m][n] = (f32x4){0.f, 0.f, 0.f, 0.f};
    bf16x8 At[4][2], B0[2][2], B1[2][2];
    const char* cA = (const char*)g.A + (size_t)cur.pm * tstep; const char* cB = (const char*)g.Bt + (size_t)cur.pn * tstep;
    S.a_ready(cur);
    if constexpr (SP2) {
        PG8_STAGE(PG8_SB(0, 0), cB, voffB); PG8_STAGE(PG8_SB(0, 1), cB + hstep, voffB); PG8_STAGE(PG8_SA(0, 0), cA, voffA); PG8_STAGE(PG8_SA(0, 1), cA + hstep, voffA);
        if (wr == 1) PG8_BAR;
        PG8_WAIT_V(2); PG8_BAR;
        PG8_STAGE(PG8_SB(1, 0), cB + kstep, voffB); PG8_STAGE(PG8_SA(1, 0), cA + kstep, voffA); PG8_STAGE(PG8_SB(1, 1), cB + hstep + kstep, voffB);
        PG8_WAIT_V(6); PG8_BAR;
    } else {
        PG8_STAGE(PG8_SB(0, 0), cB, voffB); PG8_STAGE(PG8_SA(0, 0), cA, voffA); PG8_STAGE(PG8_SB(0, 1), cB + hstep, voffB); PG8_STAGE(PG8_SA(0, 1), cA + hstep, voffA);
        if (wr == 1) PG8_BAR;
        PG8_WAIT_V(4); PG8_BAR;
        PG8_STAGE(PG8_SB(1, 0), cB + kstep, voffB); PG8_STAGE(PG8_SA(1, 0), cA + kstep, voffA); PG8_STAGE(PG8_SB(1, 1), cB + hstep + kstep, voffB);
        PG8_WAIT_V(6); PG8_BAR;
    }
    for (;;) {
        const bool has_next = S.next(ui + 1, nxt);
        const char* nA = has_next ? (const char*)g.A + (size_t)nxt.pm * tstep : cA; const char* nB = has_next ? (const char*)g.Bt + (size_t)nxt.pn * tstep : cB;
        for (int t = 0; t < nt; t += 2) {
            const bool last = (t == nt - 2);
            const char* a1 = cA + (size_t)(t + 1) * kstep;
            const char* a2 = last ? nA : cA + (size_t)(t + 2) * kstep; const char* b2 = last ? nB : cB + (size_t)(t + 2) * kstep;
            const char* a3 = a2 + kstep; const char* b3 = b2 + kstep;
            if (last && has_next) S.a_ready(nxt);
            if constexpr (SP2) {
            PG8_LDB(B0, 0, 0); PG8_LDB(B1, 0, 1); PG8_SCHED; PG8_LDA(At, 0, 0); PG8_STAGE(PG8_SA(1, 1), a1 + hstep, voffA);
            PG8_WAIT_V(8); PG8_WAIT_L(0); PG8_BAR; PG8_MMA(0, 0, At, B0); PG8_MMA(0, 1, At, B1); PG8_BAR; PG8_SCHED;
            PG8_LDA(At, 0, 1); PG8_STAGE(PG8_SB(0, 0), b2, voffB); PG8_STAGE(PG8_SB(0, 1), b2 + hstep, voffB); PG8_STAGE(PG8_SA(0, 0), a2, voffA);
            PG8_WAIT_V(8); PG8_WAIT_L(0); PG8_BAR; PG8_MMA(1, 0, At, B0); PG8_MMA(1, 1, At, B1); PG8_BAR; PG8_SCHED;
            PG8_LDB(B0, 1, 0); PG8_LDB(B1, 1, 1); PG8_SCHED; PG8_LDA(At, 1, 0); PG8_STAGE(PG8_SA(0, 1), a2 + hstep, voffA);
            PG8_WAIT_V(8); PG8_WAIT_L(0); PG8_BAR; PG8_MMA(0, 0, At, B0); PG8_MMA(0, 1, At, B1); PG8_BAR; PG8_SCHED;
            PG8_LDA(At, 1, 1); PG8_STAGE(PG8_SB(1, 0), b3, voffB); PG8_STAGE(PG8_SB(1, 1), b3 + hstep, voffB); PG8_STAGE(PG8_SA(1, 0), a3, voffA);
            PG8_WAIT_V(8); PG8_WAIT_L(0); PG8_BAR; PG8_MMA(1, 0, At, B0); PG8_MMA(1, 1, At, B1); PG8_BAR; PG8_SCHED;
            } else {
            PG8_LDB(B0, 0, 0); PG8_SCHED; PG8_LDA(At, 0, 0); PG8_STAGE(PG8_SA(1, 1), a1 + hstep, voffA);
            PG8_WAIT_L(8); PG8_BAR; PG8_WAIT_L(0); PG8_MMA(0, 0, At, B0); PG8_BAR; PG8_SCHED;
            PG8_LDB(B1, 0, 1); PG8_STAGE(PG8_SB(0, 0), b2, voffB);
            PG8_BAR; PG8_WAIT_L(0); PG8_MMA(0, 1, At, B1); PG8_BAR;
            PG8_LDA(At, 0, 1); PG8_STAGE(PG8_SA(0, 0), a2, voffA);
            PG8_BAR; PG8_WAIT_L(0); PG8_MMA(1, 0, At, B0); PG8_BAR; PG8_SCHED;
            PG8_STAGE(PG8_SB(0, 1), b2 + hstep, voffB);
            PG8_WAIT_V(6); PG8_BAR; PG8_MMA(1, 1, At, B1); PG8_BAR;
            PG8_LDB(B0, 1, 0); PG8_SCHED; PG8_LDA(At, 1, 0); PG8_STAGE(PG8_SA(0, 1), a2 + hstep, voffA);
            PG8_WAIT_L(8); PG8_BAR; PG8_WAIT_L(0); PG8_MMA(0, 0, At, B0); PG8_BAR; PG8_SCHED;
            PG8_LDB(B1, 1, 1); PG8_STAGE(PG8_SB(1, 0), b3, voffB);
            PG8_BAR; PG8_WAIT_L(0); PG8_MMA(0, 1, At, B1); PG8_BAR;
            PG8_LDA(At, 1, 1); PG8_STAGE(PG8_SA(1, 0), a3, voffA);
            PG8_BAR; PG8_WAIT_L(0); PG8_MMA(1, 0, At, B0); PG8_BAR; PG8_SCHED;
            PG8_STAGE(PG8_SB(1, 1), b3 + hstep, voffB);
            PG8_WAIT_V(6); PG8_BAR; PG8_MMA(1, 1, At, B1); PG8_BAR;
            }
        }
        if constexpr (ALIGN_EPI) { if (wr == 0) PG8_BAR; }
        if constexpr (!Epi::AFTER_DRAIN) { E(acc, cur, wr, wc, fr, fq); S.done(cur); }
        if (!has_next) break;
#pragma unroll
        for (int a = 0; a < 2; ++a)
#pragma unroll
            for (int b = 0; b < 2; ++b)
#pragma unroll
                for (int m = 0; m < 4; ++m)
#pragma unroll
                    for (int n = 0; n < 2; ++n) acc[a][b][m][n] = (f32x4){0.f, 0.f, 0.f, 0.f};
        cur = nxt; cA = nA; cB = nB; ++ui;
        if constexpr (ALIGN_EPI) { if (wr == 1) PG8_BAR; }
    }
    PG8_WAIT_V(0);
    if constexpr (!ALIGN_EPI) { if (wr == 0) PG8_BAR; }
    PG8_BAR;
    if constexpr (Epi::AFTER_DRAIN) { E.fused(acc, cur, wr, wc, fr, fq, lds, wid, lane); S.done(cur); }
#undef PG8_SA
#undef PG8_SB
#undef PG8_STAGE
#undef PG8_LDA
#undef PG8_LDB
#undef PG8_MMA
#undef PG8_WAIT_V
#undef PG8_WAIT_L
#undef PG8_BAR
#undef PG8_SCHED
}
}
namespace att {
using bf16x8 = __attribute__((ext_vector_type(8))) short;
using s16x4  = __attribute__((ext_vector_type(4))) short;
using f32x16 = __attribute__((ext_vector_type(16))) float;
using u32x4  = __attribute__((ext_vector_type(4))) unsigned;
typedef unsigned short bf16;
constexpr int DQ = 64, DV = 128, NW = 8, QBLK = 32, KVBLK = 64, LDR = 3072;
constexpr int SHM_V = KVBLK * DV * 2, SHM_K = KVBLK * DQ * 2, SHM_ATTN = 3 * SHM_V + 3 * SHM_K + NW * 64 * 4 + 64;
constexpr int SHM_ATTN_ALL = SHM_ATTN + NW * QBLK * DV * 2;
#ifndef ATT_OVF_LIMIT
#define ATT_OVF_LIMIT 1.152921504606847e18f
#endif
#ifndef ATT_SDEPTH
#define ATT_SDEPTH 2
#endif
constexpr float THR2 = 11.0f;
#define KSWZ64(row, colB) ((row) * 128 + ((colB) ^ ((((row) >> 1) & 7) << 4)))
#define SBAR() __builtin_amdgcn_sched_barrier(0)
template <int K> __device__ __forceinline__ float sx(float v) { return __builtin_bit_cast(float, __builtin_amdgcn_ds_swizzle(__builtin_bit_cast(int, v), (K << 10) | 0x1f)); }
__device__ __forceinline__ int crow(int r, int hi) { return (r & 3) + 8 * (r >> 2) + 4 * hi; }
__device__ __forceinline__ unsigned cvtpk(float lo, float hi) { unsigned r; asm volatile("v_cvt_pk_bf16_f32 %0, %1, %2" : "=v"(r) : "v"(lo), "v"(hi)); return r; }
__device__ __forceinline__ void partialSM(f32x16& p0, f32x16& p1, float& m_reg, float& mn, float& alpha) {
  float pmax = p0[0];
#pragma unroll
  for (int r = 1; r < 16; ++r) pmax = fmaxf(pmax, p0[r]);
#pragma unroll
  for (int r = 0; r < 16; ++r) pmax = fmaxf(pmax, p1[r]);
  { auto rr = __builtin_amdgcn_permlane32_swap(__float_as_uint(pmax), __float_as_uint(pmax), false, false);
    pmax = fmaxf(__uint_as_float(rr[0]), __uint_as_float(rr[1])); }
  if (__builtin_expect(__all(pmax - m_reg <= THR2), 1)) { mn = m_reg; alpha = 1.f; }
  else { mn = fmaxf(m_reg, pmax); alpha = __builtin_amdgcn_exp2f(m_reg - mn); m_reg = mn; }
#pragma unroll
  for (int r = 0; r < 16; ++r) p0[r] = p0[r] - mn;
#pragma unroll
  for (int r = 0; r < 16; ++r) p1[r] = p1[r] - mn;
#pragma unroll
  for (int r = 0; r < 16; ++r) p0[r] = __builtin_amdgcn_exp2f(p0[r]);
}
__device__ __forceinline__ void finishSM(f32x16& p0, f32x16& p1, float alpha, float& l_reg, bf16x8& pa0, bf16x8& pa1, bf16x8& pa2, bf16x8& pa3) {
#pragma unroll
  for (int r = 0; r < 16; ++r) p1[r] = __builtin_amdgcn_exp2f(p1[r]);
  float ps = 0;
#pragma unroll
  for (int r = 0; r < 16; ++r) ps += p0[r];
#pragma unroll
  for (int r = 0; r < 16; ++r) ps += p1[r];
  { auto rr = __builtin_amdgcn_permlane32_swap(__float_as_uint(ps), __float_as_uint(ps), false, false);
    ps = __uint_as_float(rr[0]) + __uint_as_float(rr[1]); }
  l_reg = l_reg * alpha + ps;
#define PK4(P, BASE, OUT) do { unsigned a0 = cvtpk(P[BASE + 0], P[BASE + 1]), a1 = cvtpk(P[BASE + 2], P[BASE + 3]);   \
    unsigned b0 = cvtpk(P[BASE + 4], P[BASE + 5]), b1 = cvtpk(P[BASE + 6], P[BASE + 7]);                              \
    auto r0 = __builtin_amdgcn_permlane32_swap(a0, b0, false, false); auto r1 = __builtin_amdgcn_permlane32_swap(a1, b1, false, false); \
    u32x4 w = {r0[0], r1[0], r0[1], r1[1]}; OUT = *reinterpret_cast<bf16x8*>(&w); } while (0)
  PK4(p0, 0, pa0); PK4(p0, 8, pa1); PK4(p1, 0, pa2); PK4(p1, 8, pa3);
#undef PK4
}
__device__ __forceinline__ void qkt(f32x16& p0, f32x16& p1, const char* Ks, const bf16x8* qr, int r32, int hi) {
  p0 = f32x16{}; p1 = f32x16{};
#pragma unroll
  for (int d0 = 0; d0 < 4; ++d0) { const int cb = (d0 * 16 + hi * 8) * 2;
    bf16x8 b0 = *reinterpret_cast<const bf16x8*>(Ks + KSWZ64(r32, cb));
    bf16x8 b1 = *reinterpret_cast<const bf16x8*>(Ks + KSWZ64(32 + r32, cb));
    p0 = __builtin_amdgcn_mfma_f32_32x32x16_bf16(b0, qr[d0], p0, 0, 0, 0);
    p1 = __builtin_amdgcn_mfma_f32_32x32x16_bf16(b1, qr[d0], p1, 0, 0, 0); }
}
__device__ __forceinline__ void qkt_ref(f32x16& p0, f32x16& p1, const char* Ks, const bf16x8* qr, const f32x16& negm, int r32, int hi) {
#pragma unroll
  for (int d0 = 0; d0 < 4; ++d0) { const int cb = (d0 * 16 + hi * 8) * 2;
    bf16x8 b0 = *reinterpret_cast<const bf16x8*>(Ks + KSWZ64(r32, cb));
    bf16x8 b1 = *reinterpret_cast<const bf16x8*>(Ks + KSWZ64(32 + r32, cb));
    if (d0 == 0) { p0 = __builtin_amdgcn_mfma_f32_32x32x16_bf16(b0, qr[0], negm, 0, 0, 0); p1 = __builtin_amdgcn_mfma_f32_32x32x16_bf16(b1, qr[0], negm, 0, 0, 0); }
    else { p0 = __builtin_amdgcn_mfma_f32_32x32x16_bf16(b0, qr[d0], p0, 0, 0, 0); p1 = __builtin_amdgcn_mfma_f32_32x32x16_bf16(b1, qr[d0], p1, 0, 0, 0); } }
}
__device__ __forceinline__ void exp_half(f32x16& p) {
#pragma unroll
  for (int r = 0; r < 16; ++r) p[r] = __builtin_amdgcn_exp2f(p[r]);
}
__device__ __forceinline__ void sub_exp_half(f32x16& p0, f32x16& p1, float m) {
#pragma unroll
  for (int r = 0; r < 16; ++r) p0[r] = p0[r] - m;
#pragma unroll
  for (int r = 0; r < 16; ++r) p1[r] = p1[r] - m;
#pragma unroll
  for (int r = 0; r < 16; ++r) p0[r] = __builtin_amdgcn_exp2f(p0[r]);
}
__device__ __forceinline__ void finishSM_fast(f32x16& p0, f32x16& p1, float& l_reg, bool& ovf, bf16x8& pa0, bf16x8& pa1, bf16x8& pa2, bf16x8& pa3) {
  float al = 1.f; float l0 = 0.f;
  finishSM(p0, p1, al, l0, pa0, pa1, pa2, pa3);
  ovf = ovf || !(l0 < ATT_OVF_LIMIT);
  l_reg += l0;
}
__device__ __forceinline__ int v_st(int k, int c) { const int kk = (k & ~0xC) | ((k & 4) << 1) | ((k & 8) >> 1); return ((kk >> 3) * 4 + (c >> 5)) * 512 + ((kk & 7) * 32 + (c & 31)) * 2; }
__device__ __forceinline__ int v_rd_base(int lane) { return ((lane & 3) << 3) | (((lane >> 2) & 3) << 6) | (((lane >> 4) & 1) << 5) | (((lane >> 5) & 1) << 8); }
constexpr int v_rd_off(int d0, int ks, int half) { return d0 * 512 + ks * 4096 + half * 2048; }
template <int OFF> __device__ __forceinline__ s16x4 tr_read(int vb) {
  s16x4 r; asm volatile("ds_read_b64_tr_b16 %0, %1 offset:%2" : "=&v"(r) : "v"(vb), "i"(OFF) : "memory"); return r;
}
template <int D0> __device__ __forceinline__ void pv_one(f32x16& od, int vb, bf16x8 pa0, bf16x8 pa1, bf16x8 pa2, bf16x8 pa3) {
  const s16x4 l0 = tr_read<v_rd_off(D0, 0, 0)>(vb), h0 = tr_read<v_rd_off(D0, 0, 1)>(vb), l1 = tr_read<v_rd_off(D0, 1, 0)>(vb), h1 = tr_read<v_rd_off(D0, 1, 1)>(vb);
  const s16x4 l2 = tr_read<v_rd_off(D0, 2, 0)>(vb), h2 = tr_read<v_rd_off(D0, 2, 1)>(vb), l3 = tr_read<v_rd_off(D0, 3, 0)>(vb), h3 = tr_read<v_rd_off(D0, 3, 1)>(vb);
  asm volatile("s_waitcnt lgkmcnt(0)" ::: "memory"); SBAR();
#define PK(L, H) (bf16x8){L[0], L[1], L[2], L[3], H[0], H[1], H[2], H[3]}
  od = __builtin_amdgcn_mfma_f32_32x32x16_bf16(pa0, PK(l0, h0), od, 0, 0, 0);
  od = __builtin_amdgcn_mfma_f32_32x32x16_bf16(pa1, PK(l1, h1), od, 0, 0, 0);
  od = __builtin_amdgcn_mfma_f32_32x32x16_bf16(pa2, PK(l2, h2), od, 0, 0, 0);
  od = __builtin_amdgcn_mfma_f32_32x32x16_bf16(pa3, PK(l3, h3), od, 0, 0, 0);
#undef PK
}
__device__ __forceinline__ void pv_d0(f32x16* o, int vb, bf16x8 pa0, bf16x8 pa1, bf16x8 pa2, bf16x8 pa3) {
  pv_one<0>(o[0], vb, pa0, pa1, pa2, pa3); pv_one<1>(o[1], vb, pa0, pa1, pa2, pa3); pv_one<2>(o[2], vb, pa0, pa1, pa2, pa3); pv_one<3>(o[3], vb, pa0, pa1, pa2, pa3);
}
__device__ __forceinline__ void glds16(const void* gsrc, unsigned lds_dst) { unsigned keep;
  asm volatile("s_mov_b32 %0, m0\n\ts_mov_b32 m0, %2\n\ts_nop 0\n\tglobal_load_lds_dwordx4 %1, off\n\ts_mov_b32 m0, %0" : "=&s"(keep) : "v"(gsrc), "s"(lds_dst) : "memory"); }
template <bool FAST>
__device__ __forceinline__ bool attn_map(const bf16* __restrict__ Kh, const bf16* __restrict__ Vh, const bf16* __restrict__ Qh  , int seq, char* V_lds, char* K_lds, float* ws_base,
                                         f32x16 (&o)[4], float& l_out) {
    int tid = threadIdx.x; asm volatile("" : "+v"(tid));
    const int wid = __builtin_amdgcn_readfirstlane(tid >> 6), r32 = tid & 31, hi = (tid >> 5) & 1;
    float* al_l = ws_base + wid * 64 + 32;
    const bf16* Qw = Qh + (long)(wid * QBLK + r32) * LDR + hi * 8;
    const int lane_ = tid & 63;
    const unsigned lds0 = (unsigned)(uintptr_t)V_lds;
    const bf16 *vsrc0, *vsrc1, *ksrc;
    { const int o0 = (2 * wid) * 1024 + 16 * lane_, o1 = o0 + 1024, ok = wid * 1024 + 16 * lane_;
      auto vmap = [](int o, int& k, int& c) { const int sub = o >> 9, w = o & 511, kk = ((sub >> 2) << 3) | (w >> 6); k = (kk & ~0xC) | ((kk & 4) << 1) | ((kk & 8) >> 1); c = (sub & 3) * 32 + ((w & 63) >> 1); };
      int k0_, c0_, k1_, c1_; vmap(o0, k0_, c0_); vmap(o1, k1_, c1_);
      vsrc0 = Vh + (long)k0_ * LDR + c0_; vsrc1 = Vh + (long)k1_ * LDR + c1_;
      const int row = ok >> 7, cb = (ok & 127) ^ (((row >> 1) & 7) << 4);
      ksrc = Kh + (long)row * LDR + (cb >> 1); }
    const int vb0 = (int)(uintptr_t)V_lds + v_rd_base(tid & 63);
    float m_reg = -1e30f, l_reg = 0; bf16x8 qr[4]; bool ovf = false;
#pragma unroll
    for (int d0 = 0; d0 < 4; ++d0) { o[d0] = f32x16{}; qr[d0] = *reinterpret_cast<const bf16x8*>(Qw + d0 * 16); }
#define DMA_TILE(t, b) do { const long ro_ = (long)(t) * KVBLK * LDR; \
      glds16(vsrc0 + ro_, (unsigned)__builtin_amdgcn_readfirstlane(lds0 + (b) * SHM_V + (2 * wid) * 1024)); \
      glds16(vsrc1 + ro_, (unsigned)__builtin_amdgcn_readfirstlane(lds0 + (b) * SHM_V + (2 * wid + 1) * 1024)); \
      glds16(ksrc + ro_, (unsigned)__builtin_amdgcn_readfirstlane(lds0 + 3 * SHM_V + (b) * SHM_K + wid * 1024)); } while (0)
#define DMA_WAIT() asm volatile("s_waitcnt vmcnt(0)" ::: "memory")
#define RESC(a) do { if constexpr (!FAST) { if (__any((a) < 1.f)) { if (hi == 0) al_l[r32] = (a); asm volatile("s_waitcnt lgkmcnt(0)" ::: "memory"); \
    _Pragma("unroll") for (int d = 0; d < 4; ++d) _Pragma("unroll") for (int r = 0; r < 16; ++r) o[d][r] *= al_l[crow(r, hi)]; } } } while (0)
#define PSM(P0, P1, MN, AL) do { if constexpr (FAST) exp_half(P0); else partialSM(P0, P1, m_reg, MN, AL); } while (0)
#define FSM(P0, P1, AL) do { if constexpr (FAST) finishSM_fast(P0, P1, l_reg, ovf, pa0, pa1, pa2, pa3); else finishSM(P0, P1, AL, l_reg, pa0, pa1, pa2, pa3); } while (0)
#define STEP(PN0, PN1, MNN, ALN, PO0, PO1, ALO, jj) do { \
      SBAR(); if constexpr (FAST) qkt_ref(PN0, PN1, K_lds + bc * SHM_K, qr, negm, r32, hi); else qkt(PN0, PN1, K_lds + bc * SHM_K, qr, r32, hi); \
      if ((jj) + 1 < NT) DMA_TILE((jj) + 1, bn);              \
      FSM(PO0, PO1, ALO); SBAR(); \
      pv_d0(o, vb0 + bp * SHM_V, pa0, pa1, pa2, pa3); PSM(PN0, PN1, MNN, ALN); RESC(ALN); \
      DMA_WAIT(); __syncthreads(); \
      bp = bc; bc = bn; bn = (bn == 2) ? 0 : bn + 1; } while (0)
    f32x16 pA0, pA1, pB0, pB1; float mnA = 0.f, mnB = 0.f, alA = 1.f, alB = 1.f; bf16x8 pa0, pa1, pa2, pa3; const int NT = seq / KVBLK;
    DMA_TILE(0, 0); DMA_WAIT(); __syncthreads();
    if (1 < NT) DMA_TILE(1, 1);
    qkt(pA0, pA1, K_lds, qr, r32, hi); partialSM(pA0, pA1, m_reg, mnA, alA);
    f32x16 negm = f32x16{};
    if constexpr (FAST) {
#pragma unroll
      for (int r = 0; r < 16; ++r) negm[r] = -m_reg;
      asm volatile("" : "+v"(negm));
    }
    DMA_WAIT(); __syncthreads();
    int bp = 0, bc = 1, bn = 2;
    for (int j = 1; j + 1 < NT; j += 2) {
      STEP(pB0, pB1, mnB, alB, pA0, pA1, alA, j);
      STEP(pA0, pA1, mnA, alA, pB0, pB1, alB, j + 1);
    }
    STEP(pB0, pB1, mnB, alB, pA0, pA1, alA, NT - 1);
    FSM(pB0, pB1, alB); SBAR();
    pv_d0(o, vb0 + bp * SHM_V, pa0, pa1, pa2, pa3);
#undef DMA_TILE
#undef DMA_WAIT
#undef RESC
#undef PSM
#undef FSM
#undef STEP
    l_out = l_reg;
    return ovf;
}
__device__ __forceinline__ void attn_unit(const bf16* __restrict__ qkv, long Qrow0, long Krow0, int vh, int seq, float lam, float oscale, const float* __restrict__ subln,
                                          bf16* __restrict__ Ob, int ldo, float* stash, char* lds) {
  int tid = threadIdx.x; asm volatile("" : "+v"(tid));
  const int wid = __builtin_amdgcn_readfirstlane(tid >> 6), lane = tid & 63, r32 = lane & 31, hi = lane >> 5;
  char* V_lds = lds; char* K_lds = lds + 3 * SHM_V;
  float* wsb = (float*)(lds + 3 * SHM_V + 3 * SHM_K); float* li_l = wsb + wid * 64;
  __attribute__((address_space(3))) unsigned* ovw = (__attribute__((address_space(3))) unsigned*)(lds + 3 * SHM_V + 3 * SHM_K + NW * 64 * 4);
  const bf16* Vh = qkv + Krow0 * LDR + 2048 + vh * DV;
  for (int s = 0; s < 2; ++s) {
    const int head = 2 * vh + s;
    const bf16* Kh = qkv + Krow0 * LDR + 1024 + head * DQ;
    const bf16* Qh = qkv + Qrow0 * LDR + head * DQ;
    f32x16 o[4]; float l_reg;
    const bool ovf = attn_map<true>(Kh, Vh, Qh, seq, V_lds, K_lds, wsb, o, l_reg);
    if (lane == 0) ovw[wid] = __any(ovf) ? 1u : 0u;
    __syncthreads();
    unsigned anyovf = 0u;
#pragma unroll
    for (int w = 0; w < NW; ++w) anyovf |= ovw[w];
    __syncthreads();
    if (__builtin_amdgcn_readfirstlane(anyovf) != 0u) (void)attn_map<false>(Kh, Vh, Qh, seq, V_lds, K_lds, wsb, o, l_reg);
    if (hi == 0) li_l[r32] = l_reg; asm volatile("s_waitcnt lgkmcnt(0)" ::: "memory");
    float rli[16];
#pragma unroll
    for (int r = 0; r < 16; ++r) rli[r] = __builtin_amdgcn_rcpf(li_l[crow(r, hi)]);
    typedef float f32x4_t __attribute__((ext_vector_type(4)));
    f32x4_t* st4 = (f32x4_t*)stash + (size_t)tid * 16;
    if (s == 0) {
#pragma unroll
      for (int d0 = 0; d0 < 4; ++d0)
#pragma unroll
        for (int r4 = 0; r4 < 4; ++r4) { f32x4_t v; v[0] = o[d0][4 * r4] * rli[4 * r4]; v[1] = o[d0][4 * r4 + 1] * rli[4 * r4 + 1]; v[2] = o[d0][4 * r4 + 2] * rli[4 * r4 + 2]; v[3] = o[d0][4 * r4 + 3] * rli[4 * r4 + 3]; st4[d0 * 4 + r4] = v; }
    } else {
      float ssq[16];
#pragma unroll
      for (int r = 0; r < 16; ++r) ssq[r] = 0.f;
#pragma unroll
      for (int d0 = 0; d0 < 4; ++d0)
#pragma unroll
        for (int r4 = 0; r4 < 4; ++r4) { const f32x4_t sv = st4[d0 * 4 + r4];
#pragma unroll
          for (int i = 0; i < 4; ++i) { const int r = 4 * r4 + i; const float v = sv[i] - lam * (o[d0][r] * rli[r]); o[d0][r] = v; ssq[r] += v * v; } }
#pragma unroll
      for (int r = 0; r < 16; ++r) {
        float a = ssq[r];
        a += sx<1>(a); a += sx<2>(a); a += sx<4>(a); a += sx<8>(a); a += sx<16>(a);
        ssq[r] = oscale / sqrtf(a * (1.0f / 128.0f) + 1e-6f);
      }
      float g[4];
#pragma unroll
      for (int d0 = 0; d0 < 4; ++d0) g[d0] = subln[d0 * 32 + r32];
      bf16* stg = (bf16*)(lds + SHM_ATTN) + wid * (QBLK * DV);
      unsigned so = (unsigned)((4 * hi) * DV + r32); asm volatile("" : "+v"(so));
#pragma unroll
      for (int r = 0; r < 16; ++r) {
#pragma unroll
        for (int d0 = 0; d0 < 4; ++d0) { const unsigned w = cvtpk(o[d0][r] * ssq[r] * g[d0], 0.f); (stg + ((r & 3) + 8 * (r >> 2)) * DV + d0 * 32)[so] = (bf16)(w & 0xffffu); } }
      asm volatile("s_waitcnt lgkmcnt(0)" ::: "memory");
      int ldo_ = ldo; asm volatile("" : "+s"(ldo_));
      bf16* Ow = Ob + (long)(wid * QBLK) * ldo_;
      const int srow = lane >> 4, sch = lane & 15;
#pragma unroll
      for (int i = 0; i < 8; ++i) { const int row = i * 4 + srow; const u32x4 v = *(const u32x4*)(stg + row * DV + sch * 8); *(u32x4*)(Ow + (long)row * ldo_ + sch * 8) = v; }
    }
  }
}
#undef SBAR
}
#define GAS __attribute__((address_space(1)))
#define LAS __attribute__((address_space(3)))
typedef unsigned short bf16;
typedef unsigned v4u __attribute__((ext_vector_type(4)));
typedef float f32x4 __attribute__((ext_vector_type(4)));
typedef short bf16x8 __attribute__((ext_vector_type(8)));
typedef GAS unsigned gu32;
typedef GAS unsigned long long gu64;
#define RLX_AGENT __ATOMIC_RELAXED, __HIP_MEMORY_SCOPE_AGENT
#define LDS_WAIT() asm volatile("s_waitcnt lgkmcnt(0)" ::: "memory")
#define VM_WAIT() asm volatile("s_waitcnt vmcnt(0)" ::: "memory")
__device__ __forceinline__ unsigned long long rt() { return __builtin_amdgcn_s_memrealtime(); }
__device__ __forceinline__ unsigned f2bf(float f) { unsigned u = __builtin_bit_cast(unsigned, f); return (u + 0x7fffu + ((u >> 16) & 1u)) >> 16; }
__device__ __forceinline__ unsigned pk2(float lo, float hi) { unsigned r; asm("v_cvt_pk_bf16_f32 %0, %1, %2" : "=v"(r) : "v"(lo), "v"(hi)); return r; }

#define XB_TMO      128
#define XB_XCNT(j)  (256  + 64 * (j))
#define XB_XSUB(j)  (1280 + 64 * (j))
#define XB_XGEN(j)  (2304 + 64 * (j))
#define XB_TOP      3328
#define XB_TOPGEN   3392
#define XCD_BAR_WORDS 3456
#define XB_SPIN_CAP (1u << 18)

__device__ __forceinline__ unsigned xb_ld(unsigned* p)              { return __hip_atomic_load(p, __ATOMIC_RELAXED, __HIP_MEMORY_SCOPE_AGENT); }
__device__ __forceinline__ unsigned xb_add(unsigned* p, unsigned v) { return __hip_atomic_fetch_add(p, v, __ATOMIC_RELAXED, __HIP_MEMORY_SCOPE_AGENT); }
__device__ __forceinline__ unsigned xb_xcc_id() { return (unsigned)__builtin_amdgcn_s_getreg((3 << 11) | 20) & 0xFu; }
#define XB_SPIN(cond, bar) do { unsigned _sp = 0; while (cond) { __builtin_amdgcn_s_sleep(1); \
    if ((++_sp & 255u) == 0u) { if (xb_ld(&(bar)[XB_TMO])) break; if (_sp > XB_SPIN_CAP) { atomicAdd(&(bar)[XB_TMO], 1u); break; } } } } while (0)

struct XcdBarrier {
    unsigned* bar; unsigned x;
    volatile LAS unsigned* st;
};

__device__ __forceinline__ XcdBarrier xcd_barrier_post(unsigned* bar, volatile LAS unsigned* st) {
    XcdBarrier b; b.bar = bar; b.x = xb_xcc_id(); b.st = st;
    if (threadIdx.x == 0) (void)xb_add(&bar[XB_XCNT(b.x)], 1u);
    return b;
}
__device__ __forceinline__ void xcd_barrier_complete(unsigned* bar, unsigned x, unsigned& nloc, unsigned& nx) {
    const unsigned G = gridDim.x * gridDim.y * gridDim.z;
    unsigned sum, cnt, mine, sp = 0u;
    for (;;) {
        sum = 0u; cnt = 0u; mine = 0u;
#pragma unroll
        for (unsigned j = 0; j < 16; ++j) { const unsigned c = xb_ld(&bar[XB_XCNT(j)]); sum += c; cnt += (c > 0u) ? 1u : 0u; mine = (j == x) ? c : mine; }
        if (sum == G) break;
        __builtin_amdgcn_s_sleep(1);
        if ((++sp & 255u) == 0u) { if (xb_ld(&bar[XB_TMO])) break; if (sp > XB_SPIN_CAP) { atomicAdd(&bar[XB_TMO], 1u); break; } }
    }
    nloc = mine > 0u ? mine : 1u; nx = cnt > 0u ? cnt : 1u;
}

__device__ __forceinline__ void xcd_barrier(const XcdBarrier& b) {
    asm volatile("s_waitcnt vmcnt(0)" ::: "memory");
    __syncthreads();
    if (threadIdx.x == 0) {
        unsigned* bar = b.bar;
        __builtin_amdgcn_s_waitcnt(0);
        unsigned nloc = b.st[0], nx = b.st[1];
        if (nloc == 0u) { xcd_barrier_complete(bar, b.x, nloc, nx); b.st[0] = nloc; b.st[1] = nx; }
        const unsigned old = xb_add(&bar[XB_XSUB(b.x)], 1u);
        const unsigned gen = old / nloc;
        if (old + 1u == (gen + 1u) * nloc) {
            __builtin_amdgcn_fence(__ATOMIC_RELEASE, "agent");
            asm volatile("s_waitcnt vmcnt(0)" ::: "memory");
            const unsigned og = xb_add(&bar[XB_TOP], 1u);
            const unsigned tg = og / nx;
            if (og + 1u == (tg + 1u) * nx) xb_add(&bar[XB_TOPGEN], 1u);
            else XB_SPIN(xb_ld(&bar[XB_TOPGEN]) == tg, bar);
            __builtin_amdgcn_fence(__ATOMIC_ACQUIRE, "agent");
            xb_add(&bar[XB_XGEN(b.x)], 1u);
            asm volatile("s_waitcnt vmcnt(0)" ::: "memory");
        } else {
            XB_SPIN(xb_ld(&bar[XB_XGEN(b.x)]) == gen, bar);
            __builtin_amdgcn_fence(__ATOMIC_ACQUIRE, "agent");
            asm volatile("s_waitcnt vmcnt(0)" ::: "memory");
        }
    }
    __syncthreads();
}
#define HYD __device__ __forceinline__
#define HYDM __device__ __forceinline__
#define HY_DEVICE 1
#ifdef HY_DEVICE
#define HY_OPAQUE(x) asm volatile("" : "+v"(x))
#else
#define HY_OPAQUE(x) (void)(x)
#endif
typedef float cf __attribute__((ext_vector_type(2)));
typedef float cf2 __attribute__((ext_vector_type(4)));
template <class P> struct HyP2 {};
template <> struct HyP2<cf*> { typedef cf2* type; };
#ifdef HY_DEVICE
template <> struct HyP2<__attribute__((address_space(3))) cf*> { typedef __attribute__((address_space(3))) cf2* type; };
#endif
HYD cf cf_add(cf a, cf b) { return a + b; }
HYD cf cf_sub(cf a, cf b) { return a - b; }
HYD cf cf_mul(cf a, cf b) { return cf{a.x * b.x - a.y * b.y, a.x * b.y + a.y * b.x}; }
HYD cf cf_mulc(cf a, cf b) { return cf{a.x * b.x + a.y * b.y, a.y * b.x - a.x * b.y}; }
constexpr int FN = 16384, FT = 512, FLOG = 14, FNP = FN + 4 * (FN >> 6);
constexpr int SEQL = 8192;
HYD int HP(int i) { return i + ((i >> 6) << 2); }
#define HY_C1 0.92387953251128674f
#define HY_S1 0.38268343236508977f
#define HY_R2 0.70710678118654752f
template <int M16> HYD cf mul_root16(cf w) {
    if (M16 == 0) return w;
    if (M16 == 4) return cf{w.y, -w.x};
    if (M16 == 2) return cf{(w.x + w.y) * HY_R2, (w.y - w.x) * HY_R2};
    if (M16 == 6) return cf{(w.y - w.x) * HY_R2, -(w.x + w.y) * HY_R2};
    if (M16 == 1) return cf_mul(w, cf{HY_C1, -HY_S1});
    if (M16 == 3) return cf_mul(w, cf{HY_S1, -HY_C1});
    if (M16 == 5) return cf_mul(w, cf{-HY_S1, -HY_C1});
    return cf_mul(w, cf{-HY_C1, -HY_S1});
}
template <int Q, int U, bool INV, bool ZUP, bool HLO> struct HyStage {
    static HYDM void run(cf (&e)[1 << Q], const cf (&tw)[Q]) {
        constexpr int R = 1 << Q, half = R >> (U + 1);
#pragma unroll
        for (int k = 0; k < R; ++k) {
            if ((k & half) == 0) {
                const int kp = k & (half - 1);
                cf w = tw[U];
                switch (kp * 16 / (2 * half)) {
                    case 0: break;
                    case 1: w = mul_root16<1>(w); break;
                    case 2: w = mul_root16<2>(w); break;
                    case 3: w = mul_root16<3>(w); break;
                    case 4: w = mul_root16<4>(w); break;
                    case 5: w = mul_root16<5>(w); break;
                    case 6: w = mul_root16<6>(w); break;
                    default: w = mul_root16<7>(w); break;
                }
                if (!INV) {
                    if (ZUP && U == 0) { e[k + half] = cf_mul(e[k], w); }
                    else { const cf a = e[k], b = e[k + half]; e[k] = cf_add(a, b); e[k + half] = cf_mul(cf_sub(a, b), w); }
                } else {
                    const cf a = e[k], b = cf_mulc(e[k + half], w); e[k] = cf_add(a, b);
                    if (!(HLO && U == 0)) e[k + half] = cf_sub(a, b);
                }
            }
        }
    }
};
template <int Q, bool INV, bool ZUP, bool HLO> HYD void hy_bfly(cf (&e)[1 << Q], cf t) {
    cf tw[Q]; tw[0] = t;
#pragma unroll
    for (int u = 1; u < Q; ++u) tw[u] = cf_mul(tw[u - 1], tw[u - 1]);
    if (Q == 4) {
        if (!INV) { HyStage<Q, 0, INV, ZUP, HLO>::run(e, tw); HyStage<Q, 1, INV, ZUP, HLO>::run(e, tw); HyStage<Q, 2 % Q, INV, ZUP, HLO>::run(e, tw); HyStage<Q, 3 % Q, INV, ZUP, HLO>::run(e, tw); }
        else      { HyStage<Q, 3 % Q, INV, ZUP, HLO>::run(e, tw); HyStage<Q, 2 % Q, INV, ZUP, HLO>::run(e, tw); HyStage<Q, 1, INV, ZUP, HLO>::run(e, tw); HyStage<Q, 0, INV, ZUP, HLO>::run(e, tw); }
    } else {
        if (!INV) { HyStage<Q, 0, INV, ZUP, HLO>::run(e, tw); HyStage<Q, 1, INV, ZUP, HLO>::run(e, tw); }
        else      { HyStage<Q, 1, INV, ZUP, HLO>::run(e, tw); HyStage<Q, 0, INV, ZUP, HLO>::run(e, tw); }
    }
}
#ifdef HY_DEVICE
#define HY_MULT(T, X, Y) "v_pk_mul_f32 " T ", " X ", " Y " op_sel:[1,1] op_sel_hi:[1,0]\n\t"
#define HY_FMAP(R, X, Y, T) "v_pk_fma_f32 " R ", " X ", " Y ", " T " op_sel_hi:[0,1,1] neg_lo:[0,0,1]\n\t"
#define HY_FMAC(R, X, Y, T) "v_pk_fma_f32 " R ", " X ", " Y ", " T " op_sel_hi:[0,1,1] neg_hi:[1,0,0]\n\t"
#define HY_ADD(R, A, B) "v_pk_add_f32 " R ", " A ", " B "\n\t"
#define HY_SUB(R, A, B) "v_pk_add_f32 " R ", " A ", " B " neg_lo:[0,1] neg_hi:[0,1]\n\t"
HYD void hy_cmul2(cf& r0, cf x0, cf y0, cf& r1, cf x1, cf y1) { cf t0, t1;
    asm(HY_MULT("%0", "%4", "%5") HY_MULT("%1", "%6", "%7") HY_FMAP("%2", "%4", "%5", "%0") HY_FMAP("%3", "%6", "%7", "%1")
        : "=&v"(t0), "=&v"(t1), "=&v"(r0), "=&v"(r1) : "v"(x0), "v"(y0), "v"(x1), "v"(y1)); }
HYD cf hy_cmul1(cf x, cf y) { cf t, r;
    asm(HY_MULT("%0", "%2", "%3") "s_nop 0\n\t" HY_FMAP("%1", "%2", "%3", "%0") : "=&v"(t), "=&v"(r) : "v"(x), "v"(y)); return r; }
HYD void hy_bf2_fwd(cf& a0, cf& b0, cf w0, cf& a1, cf& b1, cf w1) { cf d0, d1, t0, t1;
    asm(HY_SUB("%4", "%0", "%1") HY_ADD("%0", "%0", "%1") HY_SUB("%5", "%2", "%3") HY_ADD("%2", "%2", "%3")
        HY_MULT("%6", "%4", "%8") HY_MULT("%7", "%5", "%9") HY_FMAP("%1", "%4", "%8", "%6") HY_FMAP("%3", "%5", "%9", "%7")
        : "+v"(a0), "+v"(b0), "+v"(a1), "+v"(b1), "=&v"(d0), "=&v"(d1), "=&v"(t0), "=&v"(t1) : "v"(w0), "v"(w1)); }
HYD void hy_bf2_fwdz(cf a0, cf& b0, cf w0, cf a1, cf& b1, cf w1) { hy_cmul2(b0, a0, w0, b1, a1, w1); }
HYD void hy_bf2_inv(cf& a0, cf& b0, cf w0, cf& a1, cf& b1, cf w1) { cf t0, t1;
    asm(HY_MULT("%4", "%1", "%6") HY_MULT("%5", "%3", "%7") HY_FMAC("%4", "%1", "%6", "%4") HY_FMAC("%5", "%3", "%7", "%5")
        HY_SUB("%1", "%0", "%4") HY_SUB("%3", "%2", "%5") HY_ADD("%0", "%0", "%4") HY_ADD("%2", "%2", "%5")
        : "+v"(a0), "+v"(b0), "+v"(a1), "+v"(b1), "=&v"(t0), "=&v"(t1) : "v"(w0), "v"(w1)); }
HYD void hy_bf2_invl(cf& a0, cf b0, cf w0, cf& a1, cf b1, cf w1) { cf t0, t1;
    asm(HY_MULT("%2", "%4", "%6") HY_MULT("%3", "%5", "%7") HY_FMAC("%2", "%4", "%6", "%2") HY_FMAC("%3", "%5", "%7", "%3")
        HY_ADD("%0", "%0", "%2") HY_ADD("%1", "%1", "%3")
        : "+v"(a0), "+v"(a1), "=&v"(t0), "=&v"(t1) : "v"(b0), "v"(b1), "v"(w0), "v"(w1)); }
HYD cf hy_rot(cf w) { cf r; asm("v_pk_add_f32 %0, %1, 0 op_sel:[1,0] op_sel_hi:[0,0] neg_hi:[1,0]" : "=v"(r) : "v"(w)); return r; }
#else
HYD void hy_cmul2(cf& r0, cf x0, cf y0, cf& r1, cf x1, cf y1) { const cf p0 = cf_mul(x0, y0), p1 = cf_mul(x1, y1); r0 = p0; r1 = p1; }
HYD cf hy_cmul1(cf x, cf y) { return cf_mul(x, y); }
HYD void hy_bf2_fwd(cf& a0, cf& b0, cf w0, cf& a1, cf& b1, cf w1) { const cf d0 = cf_sub(a0, b0), d1 = cf_sub(a1, b1); a0 = cf_add(a0, b0); a1 = cf_add(a1, b1); b0 = cf_mul(d0, w0); b1 = cf_mul(d1, w1); }
HYD void hy_bf2_fwdz(cf a0, cf& b0, cf w0, cf a1, cf& b1, cf w1) { b0 = cf_mul(a0, w0); b1 = cf_mul(a1, w1); }
HYD void hy_bf2_inv(cf& a0, cf& b0, cf w0, cf& a1, cf& b1, cf w1) { const cf p0 = cf_mulc(b0, w0), p1 = cf_mulc(b1, w1); b0 = cf_sub(a0, p0); b1 = cf_sub(a1, p1); a0 = cf_add(a0, p0); a1 = cf_add(a1, p1); }
HYD void hy_bf2_invl(cf& a0, cf b0, cf w0, cf& a1, cf b1, cf w1) { a0 = cf_add(a0, cf_mulc(b0, w0)); a1 = cf_add(a1, cf_mulc(b1, w1)); }
HYD cf hy_rot(cf w) { return cf{w.y, -w.x}; }
#endif
template <int U, bool INV, bool ZUP, bool HLO> HYD void hy_stage16(cf (&e)[16], const cf* W) {
    constexpr int half = 8 >> U;
#pragma unroll
    for (int j = 0; j < 8; j += 2) {
        const int k0 = ((j / half) * 2 * half) + (j % half), k1 = (((j + 1) / half) * 2 * half) + ((j + 1) % half);
        const cf w0 = W[k0 & (half - 1)], w1 = W[k1 & (half - 1)];
        if (!INV) { if (ZUP && U == 0) hy_bf2_fwdz(e[k0], e[k0 + half], w0, e[k1], e[k1 + half], w1); else hy_bf2_fwd(e[k0], e[k0 + half], w0, e[k1], e[k1 + half], w1); }
        else { if (HLO && U == 0) hy_bf2_invl(e[k0], e[k0 + half], w0, e[k1], e[k1 + half], w1); else hy_bf2_inv(e[k0], e[k0 + half], w0, e[k1], e[k1 + half], w1); }
    }
}
template <bool INV, bool ZUP, bool HLO> HYD void hy_bfly16(cf (&e)[16], cf t) {
    cf W0[8], W1[4], W2[2], W3[1], tw1, tw2;
    cf k1 = cf{HY_C1, -HY_S1}, k2 = cf{HY_R2, -HY_R2}, k3 = cf{HY_S1, -HY_C1};
    W0[0] = t;
    hy_cmul2(W0[1], t, k1, W0[3], t, k3);
    hy_cmul2(W0[2], t, k2, tw1, t, t);
    W1[0] = tw1;
    hy_cmul2(W1[1], tw1, k2, tw2, tw1, tw1);
    W2[0] = tw2;
    W3[0] = hy_cmul1(tw2, tw2);
#pragma unroll
    for (int i = 0; i < 4; ++i) W0[4 + i] = hy_rot(W0[i]);
    W1[2] = hy_rot(W1[0]); W1[3] = hy_rot(W1[1]); W2[1] = hy_rot(W2[0]);
    if (!INV) { hy_stage16<0, INV, ZUP, HLO>(e, W0); hy_stage16<1, INV, ZUP, HLO>(e, W1); hy_stage16<2, INV, ZUP, HLO>(e, W2); hy_stage16<3, INV, ZUP, HLO>(e, W3); }
    else      { hy_stage16<3, INV, ZUP, HLO>(e, W3); hy_stage16<2, INV, ZUP, HLO>(e, W2); hy_stage16<1, INV, ZUP, HLO>(e, W1); hy_stage16<0, INV, ZUP, HLO>(e, W0); }
}
template <class PT> HYD cf hy_twid(PT thi, PT tlo, int e) { return hy_cmul1(thi[e >> 7], tlo[e & 127]); }
HYD void hy_vstore(volatile cf* p, cf v) { *p = v; }
#ifdef HY_DEVICE
HYD void hy_vstore(volatile __attribute__((address_space(3))) cf* p, cf v) { *p = v; }
#endif
template <int S, bool INV, bool ZUP, bool HLO, class P, class PT>
HYD void hy_pass16(P X, PT thi, PT tlo, int tid) {
    constexpr int R = 16;
    constexpr int SP = (S >= 64) ? S + S / 16 : S;
    const int g0 = tid, g1 = tid + FT;
    const int lo0 = g0 & (S - 1), pb0 = HP((g0 / S) * S * R + lo0);
    const int lo1 = g1 & (S - 1), pb1 = HP((g1 / S) * S * R + lo1);
    cf e0[R], e1[R];
#pragma unroll
    for (int k = 0; k < R; ++k) { if (ZUP && k >= 8) e0[k] = cf{0.f, 0.f}; else e0[k] = X[pb0 + k * SP]; }
#pragma unroll
    for (int k = 0; k < R; ++k) { if (ZUP && k >= 8) e1[k] = cf{0.f, 0.f}; else e1[k] = X[pb1 + k * SP]; }
    const cf t0 = hy_twid(thi, tlo, lo0 * (FN / (R * S))), t1 = hy_twid(thi, tlo, lo1 * (FN / (R * S)));
    hy_bfly16<INV, ZUP, HLO>(e0, t0);
#pragma unroll
    for (int k = 0; k < R; ++k) { if (!(HLO && k >= 8)) hy_vstore(X + (pb0 + k * SP), e0[k]); }
    hy_bfly16<INV, ZUP, HLO>(e1, t1);
#pragma unroll
    for (int k = 0; k < R; ++k) { if (!(HLO && k >= 8)) hy_vstore(X + (pb1 + k * SP), e1[k]); }
}
template <bool INV> HYD void hy_r4(cf (&e)[4]) {
    if (!INV) {
        const cf a0 = e[0] + e[2], b0 = e[0] - e[2], a1 = e[1] + e[3], d = e[1] - e[3], b1 = cf{d.y, -d.x};
        e[0] = a0 + a1; e[1] = a0 - a1; e[2] = b0 + b1; e[3] = b0 - b1;
    } else {
        const cf a0 = e[0] + e[1], a1 = e[0] - e[1], a2 = e[2] + e[3], d = e[2] - e[3], b = cf{-d.y, d.x};
        e[0] = a0 + a2; e[2] = a0 - a2; e[1] = a1 + b; e[3] = a1 - b;
    }
}
template <bool INV, class P, class PK>
HYD void hy_pass4(P X, int tid, PK KM) {
    typedef typename HyP2<P>::type P2;
    const int w = tid >> 6, lane = tid & 63;
#pragma unroll 1
    for (int gb = 0; gb < 2; ++gb) {
        cf2 a[4], b[4], ka[4], kb[4];
        const int g0 = (gb * 8 + w) * 256 + lane;
#pragma unroll
        for (int u = 0; u < 4; ++u) { const int g = g0 + 64 * u; P2 X2 = (P2)(X + HP(4 * g)); a[u] = X2[0]; b[u] = X2[1];
            if (KM) { const unsigned gi = (unsigned)(4 * g) & 0x3fffu; ka[u] = ((const cf2*)(KM + gi))[0]; kb[u] = ((const cf2*)(KM + gi))[1]; } }
#pragma unroll
        for (int u = 0; u < 4; ++u) { const int g = g0 + 64 * u; P2 X2 = (P2)(X + HP(4 * g));
            cf e[4] = {cf{a[u].x, a[u].y}, cf{a[u].z, a[u].w}, cf{b[u].x, b[u].y}, cf{b[u].z, b[u].w}};
            hy_r4<INV>(e);
            if (KM) { cf q0, q1, q2, q3; hy_cmul2(q0, e[0], cf{ka[u].x, ka[u].y}, q1, e[1], cf{ka[u].z, ka[u].w}); hy_cmul2(q2, e[2], cf{kb[u].x, kb[u].y}, q3, e[3], cf{kb[u].z, kb[u].w}); e[0] = q0; e[1] = q1; e[2] = q2; e[3] = q3; }
            X2[0] = cf2{e[0].x, e[0].y, e[1].x, e[1].y}; X2[1] = cf2{e[2].x, e[2].y, e[3].x, e[3].y}; }
    }
}
HYD int hy_brev14(int p) {
    unsigned v = (unsigned)p;
    v = ((v >> 1) & 0x55555555u) | ((v & 0x55555555u) << 1);
    v = ((v >> 2) & 0x33333333u) | ((v & 0x33333333u) << 2);
    v = ((v >> 4) & 0x0F0F0F0Fu) | ((v & 0x0F0F0F0Fu) << 4);
    v = ((v >> 8) & 0x00FF00FFu) | ((v & 0x00FF00FFu) << 8);
    v = (v >> 16) | (v << 16);
    return (int)(v >> (32 - FLOG));
}
HYD float hy_bf2f(unsigned short b) { unsigned u = (unsigned)b << 16; float f; __builtin_memcpy(&f, &u, 4); return f; }
HYD unsigned hy_f2bf(float f) { unsigned u; __builtin_memcpy(&u, &f, 4); return (u + 0x7fffu + ((u >> 16) & 1u)) >> 16; }
template <class PR> HYD void hy_sconv2(PR rowj  , unsigned tid, int j, float w0, float w1, float w2, float b, float& u0, float& u1) {
    const unsigned d1 = rowj[tid];
    const unsigned d0r = (rowj - 1)[tid], d2r = (rowj + 1)[tid];
    const unsigned d0 = (j > 0 || tid > 0) ? d0r : 0u;
    const unsigned d2 = (j < 7 || tid < (unsigned)(FT - 1)) ? d2r : 0u;
    const float pm1 = hy_bf2f((unsigned short)(d0 >> 16)), p0 = hy_bf2f((unsigned short)(d1 & 0xffffu)), p1 = hy_bf2f((unsigned short)(d1 >> 16)), p2 = hy_bf2f((unsigned short)(d2 & 0xffffu));
    u0 = b + w0 * pm1 + w1 * p0 + w2 * p1;
    u1 = b + w0 * p0 + w1 * p1 + w2 * p2;
}
template <class P> HYD void hy_filter_step(P X, const unsigned short* taps, float delta, int tid) {
    typedef typename HyP2<P>::type P2;
    typedef unsigned u32x2h __attribute__((ext_vector_type(2)));
    u32x2h raw[SEQL / (4 * FT)][4];
    const float dscale = -delta * (1.4426950408889634f / (float)(SEQL - 1)); (void)dscale;
#pragma unroll
    for (int j = 0; j < SEQL / (4 * FT); ++j)
#pragma unroll
        for (int q = 0; q < 4; ++q) raw[j][q] = *(const u32x2h*)(taps + (size_t)q * 1024 * SEQL + ((unsigned)(4 * (tid + FT * j)) & 0x1fffu));
#pragma unroll
    for (int j = 0; j < SEQL / (4 * FT); ++j) {
        const int t = 4 * (tid + FT * j);
        cf2 a[4];
#pragma unroll
        for (int q = 0; q < 4; ++q) a[q] = cf2{hy_bf2f((unsigned short)(raw[j][q].x & 0xffffu)), hy_bf2f((unsigned short)(raw[j][q].x >> 16)), hy_bf2f((unsigned short)(raw[j][q].y & 0xffffu)), hy_bf2f((unsigned short)(raw[j][q].y >> 16))};
        cf2 dec;
#pragma unroll
#ifdef HY_DEVICE
        for (int e = 0; e < 4; ++e) dec[e] = __builtin_amdgcn_exp2f((float)(t + e) * dscale);
#else
        for (int e = 0; e < 4; ++e) dec[e] = expf(-((float)(t + e) * (1.0f / (float)(SEQL - 1))) * delta);
#endif
        const cf2 a0 = a[0] * dec, a1 = a[1] * dec, a2 = a[2] * dec, a3 = a[3] * dec;
        P2 Xf = (P2)(X + HP(t));
        if (t == 0) { Xf[0] = cf2{a0[0] + a1[0], a2[0] + a3[0], a0[1], a2[1]}; float z0 = 0.f; HY_OPAQUE(z0); X[HP(SEQL)] = cf{z0, z0}; }
        else Xf[0] = cf2{a0[0], a2[0], a0[1], a2[1]};
        Xf[1] = cf2{a0[2], a2[2], a0[3], a2[3]};
        const int pbk = HP(FN - t - 4);
        X[pbk + 1] = cf{a1[3], a3[3]}; X[pbk + 2] = cf{a1[2], a3[2]}; X[pbk + 3] = cf{a1[1], a3[1]};
        if (t > 0) X[HP(FN - t)] = cf{a1[0], a3[0]};
    }
}
template <class P> HYD void hy_sep_step(P X, cf* K1g, cf* K2g, int tid) {
    const float sc = 0.5f / (float)FN;
#pragma unroll 1
    for (int j0 = 0; j0 < FN / FT; j0 += 4) {
        cf a[4], b[4];
#pragma unroll
        for (int u = 0; u < 4; ++u) { const int p = tid + FT * (j0 + u);
            const int f = hy_brev14(p), q = hy_brev14((FN - f) & (FN - 1));
            a[u] = X[HP(p)]; b[u] = X[HP(q)]; }
#pragma unroll
        for (int u = 0; u < 4; ++u) { const int p = tid + FT * (j0 + u);
            const unsigned pi = (unsigned)p & 0x3fffu;
            K1g[pi] = cf{(a[u].x + b[u].x) * sc, (a[u].y - b[u].y) * sc};
            K2g[pi] = cf{(a[u].y + b[u].y) * sc, -(a[u].x - b[u].x) * sc}; }
    }
}
template <class P> HYD void hy_load_step(P X, const unsigned* r0, const unsigned* r1, float w0, float w1, float w2, float b, float (&zr)[8][4], int tid) {
    typedef typename HyP2<P>::type P2;
#pragma unroll
    for (int j = 0; j < 8; ++j) {
        const int t = 2 * (tid + FT * j);
        hy_sconv2(r0 + FT * j, (unsigned)tid, j, w0, w1, w2, b, zr[j][0], zr[j][2]);
        hy_sconv2(r1 + FT * j, (unsigned)tid, j, w0, w1, w2, b, zr[j][1], zr[j][3]);
        *(P2)(X + HP(t)) = cf2{zr[j][0], zr[j][1], zr[j][2], zr[j][3]};
    }
}
template <class P> HYD void hy_gate1_step(P X, const unsigned* r0, const unsigned* r1, float w0, float w1, float w2, float b, float bias, float (&zr)[8][4], int tid) {
    typedef typename HyP2<P>::type P2;
#pragma unroll
    for (int j = 0; j < 8; ++j) {
        const int t = 2 * (tid + FT * j);
        float xa0, xa1, xb0, xb1;
        hy_sconv2(r0 + FT * j, (unsigned)tid, j, w0, w1, w2, b, xa0, xa1);
        hy_sconv2(r1 + FT * j, (unsigned)tid, j, w0, w1, w2, b, xb0, xb1);
        P2 xp = (P2)(X + HP(t));
        const cf2 y = *xp;
        zr[j][0] = xa0 * (y.x + zr[j][0] * bias); zr[j][1] = xb0 * (y.y + zr[j][1] * bias);
        zr[j][2] = xa1 * (y.z + zr[j][2] * bias); zr[j][3] = xb1 * (y.w + zr[j][3] * bias);
        *xp = cf2{zr[j][0], zr[j][1], zr[j][2], zr[j][3]};
    }
}
template <class P> HYD void hy_gate2_step(P X, const unsigned* r0, const unsigned* r1, float w0, float w1, float w2, float b, float bias, const float (&zr)[8][4], unsigned* out0, unsigned* out1, int tid) {
    typedef typename HyP2<P>::type P2;
#pragma unroll
    for (int j = 0; j < 8; ++j) {
        const int t = 2 * (tid + FT * j);
        float xa0, xa1, xb0, xb1;
        hy_sconv2(r0 + FT * j, (unsigned)tid, j, w0, w1, w2, b, xa0, xa1);
        hy_sconv2(r1 + FT * j, (unsigned)tid, j, w0, w1, w2, b, xb0, xb1);
        const cf2 y = *(P2)(X + HP(t));
        const float za0 = xa0 * (y.x + zr[j][0] * bias), zb0 = xb0 * (y.y + zr[j][1] * bias);
        const float za1 = xa1 * (y.z + zr[j][2] * bias), zb1 = xb1 * (y.w + zr[j][3] * bias);
        (out0 + FT * j)[(unsigned)tid] = hy_f2bf(za0) | (hy_f2bf(za1) << 16);
        (out1 + FT * j)[(unsigned)tid] = hy_f2bf(zb0) | (hy_f2bf(zb1) << 16);
    }
}
HYD float hy_sconv1(unsigned D0, unsigned D1, int t, float w0, float w1, float w2, float b, bool pad0, bool padL) {
    const unsigned sh = ((unsigned)(t - 1) & 1u) << 4;
#ifdef HY_DEVICE
    const unsigned lo = __builtin_amdgcn_alignbit(D1, D0, sh), hi = D1 >> sh;
#else
    const unsigned long long w = (((unsigned long long)D1 << 32) | D0) >> sh; const unsigned lo = (unsigned)w, hi = (unsigned)(w >> 32);
#endif
    float e0 = hy_bf2f((unsigned short)(lo & 0xffffu)), e1 = hy_bf2f((unsigned short)(lo >> 16)), e2 = hy_bf2f((unsigned short)(hi & 0xffffu));
    if (pad0 && t == 0) e0 = 0.f;
    if (padL && t == SEQL - 1) e2 = 0.f;
    return b + w0 * e0 + w1 * e1 + w2 * e2;
}
struct HyRaw { unsigned d[2][8][4]; };
HYD void hy_raw_load(HyRaw& R, const unsigned* r0, const unsigned* r1, int tid) {
#pragma unroll
    for (int r = 0; r < 2; ++r)
#pragma unroll
        for (int k = 0; k < 8; ++k) { const unsigned du = ((unsigned)(tid + FT * r + 1024 * k + 1) >> 1) & 0x1fffu;
            R.d[r][k][0] = (r0 - 1)[du]; R.d[r][k][1] = r0[du]; R.d[r][k][2] = (r1 - 1)[du]; R.d[r][k][3] = r1[du]; }
}
template <class P, class PT> HYD void hy_convA_fwd(P X, PT thi, PT tlo, int tid, const HyRaw& R, float w0, float w1, float w2, float b, cf (&zr)[2][8]) {
#pragma unroll
    for (int r = 0; r < 2; ++r) {
        const int i0 = tid + FT * r, pb = HP(i0);
        cf e[16];
#pragma unroll
        for (int k = 0; k < 8; ++k) { const int t = i0 + 1024 * k; const bool p0 = (r == 0 && k == 0), pL = (r == 1 && k == 7); e[k] = cf{hy_sconv1(R.d[r][k][0], R.d[r][k][1], t, w0, w1, w2, b, p0, pL), hy_sconv1(R.d[r][k][2], R.d[r][k][3], t, w0, w1, w2, b, p0, pL)}; zr[r][k] = e[k]; }
#pragma unroll
        for (int k = 8; k < 16; ++k) e[k] = cf{0.f, 0.f};
        hy_bfly16<false, true, false>(e, hy_twid(thi, tlo, i0));
#pragma unroll
        for (int k = 0; k < 16; ++k) X[pb + k * 1088] = e[k];
    }
}
template <bool LAST, class P, class PT> HYD void hy_gateA(P X, PT thi, PT tlo, int tid, const HyRaw& R, float w0, float w1, float w2, float b, float bias,
                                                           cf (&zr)[2][8], unsigned short* out0, unsigned short* out1) {
#pragma unroll
    for (int r = 0; r < 2; ++r) {
        const int i0 = tid + FT * r, pb = HP(i0);
        cf e[16];
#pragma unroll
        for (int k = 0; k < 16; ++k) e[k] = X[pb + k * 1088];
        const cf tw = hy_twid(thi, tlo, i0);
        hy_bfly16<true, false, true>(e, tw);
#pragma unroll
        for (int k = 0; k < 8; ++k) { const int t = i0 + 1024 * k;
            const bool p0 = (r == 0 && k == 0), pL = (r == 1 && k == 7);
            const float xa = hy_sconv1(R.d[r][k][0], R.d[r][k][1], t, w0, w1, w2, b, p0, pL), xb = hy_sconv1(R.d[r][k][2], R.d[r][k][3], t, w0, w1, w2, b, p0, pL);
            const cf z = cf{xa * (e[k].x + zr[r][k].x * bias), xb * (e[k].y + zr[r][k].y * bias)};
            if (LAST) {
#ifdef HY_DEVICE
                unsigned pk; asm("v_cvt_pk_bf16_f32 %0, %1, %2" : "=v"(pk) : "v"(z.x), "v"(z.y)); const unsigned ti = (unsigned)t & 0x1fffu; out0[ti] = (unsigned short)(pk & 0xffffu); out1[ti] = (unsigned short)(pk >> 16);
#else
                out0[t] = (unsigned short)hy_f2bf(z.x); out1[t] = (unsigned short)hy_f2bf(z.y);
#endif
            }
            else { zr[r][k] = z; e[k] = z; } }
        if (!LAST) {
#pragma unroll
            for (int k = 8; k < 16; ++k) e[k] = cf{0.f, 0.f};
            hy_bfly16<false, true, false>(e, tw);
#pragma unroll
            for (int k = 0; k < 16; ++k) X[pb + k * 1088] = e[k];
        }
    }
}
constexpr int NWAVES = 8, NTHR = NWAVES * 64;
constexpr int DM = 2048, SEQ = 8192, DEPTH = 4, NSEQ = 6, GSEQ = 2, NGRP = NSEQ / GSEQ, MG = GSEQ * SEQ;
constexpr int HYW = 1024, HYIN = 3072, QKVW = 3072, DFF = 5632, GU = 2 * DFF, FEMB = 33, FHID = 64;
constexpr float EPS = 1e-6f;
constexpr float QSCALE = 0.125f * 1.4426950408889634f;
constexpr size_t MiB = 1u << 20;
constexpr size_t WS_CTL = 0, CTL_ZERO_BYTES = 1 * MiB;
constexpr size_t SZ_WHY = (size_t)HYIN * DM * 2, SZ_WQKV = (size_t)QKVW * DM * 2, SZ_WOUT = (size_t)DM * DM * 2, SZ_WGU = (size_t)GU * DM * 2, SZ_WDN = (size_t)DM * DFF * 2;
constexpr size_t OFF_WHY = 0, OFF_WQKV = OFF_WHY + SZ_WHY, OFF_WOUT = OFF_WQKV + SZ_WQKV, OFF_WGU = OFF_WOUT + SZ_WOUT, OFF_WDN = OFF_WGU + SZ_WGU, SZ_WLAYER = OFF_WDN + SZ_WDN;
constexpr size_t WS_W = 1 * MiB;
constexpr size_t WS_ROPE = WS_W + DEPTH * SZ_WLAYER;
constexpr int KPAD = 256;
constexpr size_t WS_H3 = WS_ROPE + (size_t)SEQ * 32 * 8;
constexpr size_t WS_W4T = WS_H3 + (size_t)DEPTH * SEQ * KPAD * 2;
constexpr size_t WS_TAPS = WS_W4T + (size_t)DEPTH * 4096 * KPAD * 2;
constexpr size_t WS_FFTK = WS_TAPS + (size_t)4096 * SEQ * 2;
constexpr size_t WS_STASH = WS_FFTK + (size_t)256 * 2 * 16384 * 8;
constexpr size_t WS_XB = WS_STASH;
constexpr size_t WS_H = WS_XB + (size_t)MG * DM * 2;
constexpr size_t WS_ZT = WS_H + (size_t)MG * DM * 2;
constexpr size_t WS_PROJT = WS_ZT + (size_t)HYW * MG * 2;
constexpr size_t WS_QKV = WS_PROJT + (size_t)HYIN * MG * 2;
constexpr size_t WS_MIX = WS_PROJT;
constexpr size_t WS_FFH = WS_PROJT;
constexpr size_t WS_MIXIN = WS_QKV + (size_t)MG * QKVW * 2;
constexpr size_t WS_END = WS_MIXIN + (size_t)MG * DM * 2;
constexpr size_t SZ_TAPS = (size_t)4096 * SEQ * 2, WS_TAPS_X = WS_END, WS_END_X = WS_TAPS_X + (DEPTH - 1) * SZ_TAPS;
static_assert((size_t)MG * DFF * 2 <= (size_t)HYIN * MG * 2 + (size_t)MG * QKVW * 2, "FFH overlay fits PROJT|QKV");
static_assert(WS_W4T % 256 == 0 && WS_TAPS % 256 == 0 && WS_ROPE % 256 == 0 && WS_H3 % 256 == 0 && WS_FFTK % 256 == 0 && WS_XB % 256 == 0 && WS_H % 256 == 0 && SZ_WLAYER % 256 == 0, "alignment");
constexpr int CW_BAR = 4096;
constexpr int PH_PER_LAYER = 8, PH_PER_GROUP = 1 + DEPTH * PH_PER_LAYER, NPHASE = 1 + NGRP * PH_PER_GROUP;
constexpr int RING_OFF = 0, RING_BYTES = 131072;
constexpr int TAB_OFF = 139264;
constexpr int MISC_OFF = TAB_OFF + 4096;
constexpr int LDS_BYTES = 147456;
static_assert(MISC_OFF + 128 <= LDS_BYTES, "LDS map");
static_assert(att::SHM_ATTN_ALL <= MISC_OFF, "attention LDS fits below the control words");
#ifndef PROBE_DUP
#define PROBE_DUP 0
#endif
#ifndef MK_PER_PHASE
#define MK_PER_PHASE 0
#endif

struct Args { const float* in[30]; float* out; unsigned char* ws; int ph_lo, ph_hi, taps_all, pad; };
enum { I_XP = 0, I_XS, I_GMPRE, I_GMPOST, I_GFPRE, I_GFPOST, I_WIN, I_CONVW, I_CONVB, I_FW1, I_FB1, I_FF1, I_FW2, I_FB2, I_FF2, I_FW3, I_FB3, I_FF3, I_FW4,
       I_HBIAS, I_HNORM, I_LQ1, I_LK1, I_LQ2, I_LK2, I_SUBLN, I_WOUT, I_WGATE, I_WUP, I_WDOWN };

template <int K> __device__ __forceinline__ float swz_xor(float v) { return __builtin_bit_cast(float, __builtin_amdgcn_ds_swizzle(__builtin_bit_cast(int, v), (K << 10) | 0x1f)); }
__device__ __forceinline__ float wave_sum(float v) {
    v += swz_xor<1>(v); v += swz_xor<2>(v); v += swz_xor<4>(v); v += swz_xor<8>(v); v += swz_xor<16>(v);
    auto rr = __builtin_amdgcn_permlane32_swap(__float_as_uint(v), __float_as_uint(v), false, false);
    return __uint_as_float(rr[0]) + __uint_as_float(rr[1]);
}
__device__ __forceinline__ bf16* wt_dst_row(int kind, int n, bf16* d0, bf16* d1, int K) {
    if (kind == 0) return d0 + (size_t)n * K;
    if (kind == 1) { if (n < HYIN) return d0 + (size_t)n * K; int q = n - HYIN; if (q < 2048) { const int hb = q & ~63, i = q & 63; q = hb + (i < 32 ? 2 * i : 2 * (i - 32) + 1); } return d1 + (size_t)q * K; }
    if (kind == 4) return d0 + (size_t)n * KPAD;
    const int r = (n >> 7) * 256 + (n & 127) + (kind == 3 ? 128 : 0); return d0 + (size_t)r * K;
}
__device__ __forceinline__ void p0_transpose_item(const float* W, int K, int N, int kind, bf16* d0, bf16* d1, LAS float* scr, int item, int lane) {
    const int nblk = N / 32, kb = item / nblk, nb = item % nblk, k0 = 64 * kb, n0 = 32 * nb;
#pragma unroll 8
    for (int i = 0; i < 32; ++i) { const int kk = 2 * i + (lane >> 5); scr[kk * 33 + (lane & 31)] = W[(size_t)(k0 + kk) * N + n0 + (lane & 31)]; }
    LDS_WAIT(); asm volatile("" ::: "memory");
    const int c = lane & 7;
#pragma unroll
    for (int j = 0; j < 4; ++j) { const int n = (lane >> 3) + 8 * j; const LAS float* s = scr + (8 * c) * 33 + n;
        v4u o; o.x = pk2(s[0 * 33], s[1 * 33]); o.y = pk2(s[2 * 33], s[3 * 33]); o.z = pk2(s[4 * 33], s[5 * 33]); o.w = pk2(s[6 * 33], s[7 * 33]);
        *(GAS v4u*)(wt_dst_row(kind, n0 + n, d0, d1, K) + k0 + 8 * c) = o; }
    LDS_WAIT(); asm volatile("" ::: "memory");
}
__device__ __forceinline__ void sincos_red(double ang, float& s, float& c) {
    const double k = rint(ang * 0.15915494309189535); const float r = (float)(ang - k * 6.283185307179586);
    s = sinf(r); c = cosf(r);
}
#define GP(p) ((const float*)(const GAS float*)(p))
#define LAUNDER_TID(F) do { int t_ = (F).tid; asm volatile("" : "+v"(t_)); (F).tid = t_; (F).lane = t_ & 63; int z_ = 0; asm volatile("" : "+s"(z_)); (F).z = z_; unsigned long long w_ = (unsigned long long)(F).ws0; asm volatile("" : "+s"(w_)); (F).ws = (unsigned char*)(GAS unsigned char*)w_; int b_ = (F).bx0, v_ = (F).vcu0, g_ = (F).G0; asm volatile("" : "+s"(b_), "+s"(v_), "+s"(g_)); (F).bx = b_; (F).vcu = v_; (F).G = g_; } while (0)
struct Frame {
    LAS unsigned char* lds; volatile LAS unsigned* MISC; gu32* ctl;
    int tid, lane, wave, vcu, G, bx;
    int vcu0, G0, bx0;
    float* out; unsigned char* ws; unsigned char* ws0; int z;
};
__device__ __forceinline__ void p0_prologue(Frame& F, const Args& A) {
    LAS float* scr = (LAS float*)(F.lds + RING_OFF + F.wave * 16384);
    const int gw = F.vcu * NWAVES + F.wave, NGW = F.G * NWAVES;
    constexpr int I_IN = (DM / 64) * ((HYIN + QKVW) / 32), I_OUT = (DM / 64) * (DM / 32), I_G = (DM / 64) * (DFF / 32), I_D = (DFF / 64) * (DM / 32);
    constexpr int I_W4 = 4096 / 32;
    constexpr int PER_L = I_IN + I_OUT + 2 * I_G + I_D + I_W4;
    for (int it = gw; it < DEPTH * PER_L; it += NGW) {
        const int l = it / PER_L; int r = it % PER_L;
        unsigned char* wl = F.ws + WS_W + (size_t)l * SZ_WLAYER;
        if (r < I_IN) { p0_transpose_item(GP(A.in[I_WIN + F.z]) + (size_t)l * DM * (HYIN + QKVW), DM, HYIN + QKVW, 1, (bf16*)(wl + OFF_WHY), (bf16*)(wl + OFF_WQKV), scr, r, F.lane); continue; } r -= I_IN;
        if (r < I_OUT) { p0_transpose_item(GP(A.in[I_WOUT + F.z]) + (size_t)l * DM * DM, DM, DM, 0, (bf16*)(wl + OFF_WOUT), nullptr, scr, r, F.lane); continue; } r -= I_OUT;
        if (r < I_G) { p0_transpose_item(GP(A.in[I_WGATE + F.z]) + (size_t)l * DM * DFF, DM, DFF, 2, (bf16*)(wl + OFF_WGU), nullptr, scr, r, F.lane); continue; } r -= I_G;
        if (r < I_G) { p0_transpose_item(GP(A.in[I_WUP + F.z]) + (size_t)l * DM * DFF, DM, DFF, 3, (bf16*)(wl + OFF_WGU), nullptr, scr, r, F.lane); continue; } r -= I_G;
        if (r < I_D) { p0_transpose_item(GP(A.in[I_WDOWN + F.z]) + (size_t)l * DFF * DM, DFF, DM, 0, (bf16*)(wl + OFF_WDN), nullptr, scr, r, F.lane); continue; } r -= I_D;
        { bf16* w4t = (bf16*)(F.ws + WS_W4T) + (size_t)l * 4096 * KPAD;
          p0_transpose_item(GP(A.in[I_FW4 + F.z]) + (size_t)l * FHID * 4096, FHID, 4096, 4, w4t, nullptr, scr, r, F.lane);
          for (int e = F.lane; e < 32 * 24; e += 64) *(GAS v4u*)(w4t + (size_t)(32 * r + e / 24) * KPAD + 64 + 8 * (e % 24)) = (v4u){0u, 0u, 0u, 0u}; }
    }
    {
        float* cs = (float*)(F.ws + WS_ROPE);
        for (int e = F.vcu * NTHR + F.tid; e < SEQ * 32; e += F.G * NTHR) {
            const int t = e >> 5, p = e & 31;
            const double inv = exp(-9.210340371976184 * (double)(2 * p) / 64.0);
            float s, c; sincos_red((double)t * inv, s, c);
            cs[2 * e] = c; cs[2 * e + 1] = s;
        }
    }
    {
        bf16* h3b = (bf16*)(F.ws + WS_H3);
        LAS float* hb = (LAS float*)(F.lds + RING_OFF + F.wave * 16384);
        for (int task = gw; task < DEPTH * (SEQ / 64); task += NGW) {
            const int l = task / (SEQ / 64), t = (task % (SEQ / 64)) * 64 + F.lane;
            const float* w1 = GP(A.in[I_FW1 + F.z]) + (size_t)l * FEMB * FHID; const float* w2 = GP(A.in[I_FW2 + F.z]) + (size_t)l * FHID * FHID; const float* w3 = GP(A.in[I_FW3 + F.z]) + (size_t)l * FHID * FHID;
            hb[F.lane] = (float)t * (1.0f / (float)(SEQ - 1));
#pragma unroll 1
            for (int bi = 0; bi < 16; ++bi) { const double band = 1e-4 + (double)bi * ((15.0 - 1e-4) / 15.0);
                float s, c; sincos_red(6.283185307179586 * (double)t / (double)SEQ * band, s, c); hb[(1 + bi) * 64 + F.lane] = c; hb[(17 + bi) * 64 + F.lane] = -s; }
#pragma unroll 1
            for (int stage = 0; stage < 3; ++stage) {
                const float* w = stage == 0 ? w1 : (stage == 1 ? w2 : w3);
                const float* bb = (stage == 0 ? GP(A.in[I_FB1 + F.z]) : (stage == 1 ? GP(A.in[I_FB2 + F.z]) : GP(A.in[I_FB3 + F.z]))) + l * FHID;
                const float* ff = (stage == 0 ? GP(A.in[I_FF1 + F.z]) : (stage == 1 ? GP(A.in[I_FF2 + F.z]) : GP(A.in[I_FF3 + F.z]))) + l * FHID;
                const int nin = stage == 0 ? FEMB : FHID;
                typedef float f32x16_t __attribute__((ext_vector_type(16)));
                f32x16_t c0 = {}, c1 = {}, c2 = {}, c3 = {};
                LDS_WAIT();
#pragma unroll 1
                for (int i = 0; i < nin; ++i) { const float hv = hb[i * 64 + F.lane]; const f32x16_t* wr = (const f32x16_t*)(w + i * FHID);
                    c0 += wr[0] * hv; c1 += wr[1] * hv; c2 += wr[2] * hv; c3 += wr[3] * hv; }
                const f32x16_t* b16 = (const f32x16_t*)bb; const f32x16_t* f16 = (const f32x16_t*)ff;
                c0 = (c0 + b16[0]) * f16[0]; c1 = (c1 + b16[1]) * f16[1]; c2 = (c2 + b16[2]) * f16[2]; c3 = (c3 + b16[3]) * f16[3];
                if (stage < 2) {
#pragma unroll
                    for (int e = 0; e < 16; ++e) { hb[e * 64 + F.lane] = sinf(c0[e]); hb[(16 + e) * 64 + F.lane] = sinf(c1[e]); hb[(32 + e) * 64 + F.lane] = sinf(c2[e]); hb[(48 + e) * 64 + F.lane] = sinf(c3[e]); }
                } else {
                    GAS v4u* o = (GAS v4u*)(h3b + ((size_t)l * SEQ + t) * KPAD);
#pragma unroll
                    for (int q = 0; q < 2; ++q) { v4u w; w.x = pk2(sinf(c0[8 * q]), sinf(c0[8 * q + 1])); w.y = pk2(sinf(c0[8 * q + 2]), sinf(c0[8 * q + 3])); w.z = pk2(sinf(c0[8 * q + 4]), sinf(c0[8 * q + 5])); w.w = pk2(sinf(c0[8 * q + 6]), sinf(c0[8 * q + 7])); o[q] = w; }
#pragma unroll
                    for (int q = 0; q < 2; ++q) { v4u w; w.x = pk2(sinf(c1[8 * q]), sinf(c1[8 * q + 1])); w.y = pk2(sinf(c1[8 * q + 2]), sinf(c1[8 * q + 3])); w.z = pk2(sinf(c1[8 * q + 4]), sinf(c1[8 * q + 5])); w.w = pk2(sinf(c1[8 * q + 6]), sinf(c1[8 * q + 7])); o[2 + q] = w; }
#pragma unroll
                    for (int q = 0; q < 2; ++q) { v4u w; w.x = pk2(sinf(c2[8 * q]), sinf(c2[8 * q + 1])); w.y = pk2(sinf(c2[8 * q + 2]), sinf(c2[8 * q + 3])); w.z = pk2(sinf(c2[8 * q + 4]), sinf(c2[8 * q + 5])); w.w = pk2(sinf(c2[8 * q + 6]), sinf(c2[8 * q + 7])); o[4 + q] = w; }
#pragma unroll
                    for (int q = 0; q < 2; ++q) { v4u w; w.x = pk2(sinf(c3[8 * q]), sinf(c3[8 * q + 1])); w.y = pk2(sinf(c3[8 * q + 2]), sinf(c3[8 * q + 3])); w.z = pk2(sinf(c3[8 * q + 4]), sinf(c3[8 * q + 5])); w.w = pk2(sinf(c3[8 * q + 6]), sinf(c3[8 * q + 7])); o[6 + q] = w; }
#pragma unroll 1
                    for (int q = 8; q < 32; ++q) o[q] = (v4u){0u, 0u, 0u, 0u};
                }
            }
        }
    }
}
template <bool XSB>
__device__ __forceinline__ void norm_pass(Frame& F, const void* x_src, const bf16* add, const float* g_add, bf16* xb_dst, float* xf_dst, const float* g_out, bf16* h_dst) {
    const int gw = F.vcu * NWAVES + F.wave, NGW = F.G * NWAVES;
#define UNPK(q, lo, hi) do { lo = (f32x4){__uint_as_float((q).x << 16), __uint_as_float((q).x & 0xffff0000u), __uint_as_float((q).y << 16), __uint_as_float((q).y & 0xffff0000u)}; \
                             hi = (f32x4){__uint_as_float((q).z << 16), __uint_as_float((q).z & 0xffff0000u), __uint_as_float((q).w << 16), __uint_as_float((q).w & 0xffff0000u)}; } while (0)
#define PK8(lo, hi) (v4u){pk2((lo)[0], (lo)[1]), pk2((lo)[2], (lo)[3]), pk2((hi)[0], (hi)[1]), pk2((hi)[2], (hi)[3])}
    f32x4 gA[8], gO[8];
#pragma unroll
    for (int j = 0; j < 8; ++j) { gA[j] = (f32x4){0.f, 0.f, 0.f, 0.f}; gO[j] = (f32x4){0.f, 0.f, 0.f, 0.f}; }
    if (add) { const GAS f32x4* gr = (const GAS f32x4*)g_add + 2 * F.lane;
#pragma unroll
        for (int j = 0; j < 4; ++j) { gA[2 * j] = gr[128 * j]; gA[2 * j + 1] = gr[128 * j + 1]; } }
    if (h_dst) { const GAS f32x4* gr = (const GAS f32x4*)g_out + 2 * F.lane;
#pragma unroll
        for (int j = 0; j < 4; ++j) { gO[2 * j] = gr[128 * j]; gO[2 * j + 1] = gr[128 * j + 1]; } }
    v4u rq[4], rw[4]; f32x4 rf[8];
#pragma unroll
    for (int j = 0; j < 4; ++j) { rq[j] = (v4u){0u, 0u, 0u, 0u}; rw[j] = (v4u){0u, 0u, 0u, 0u}; }
#define NP_FETCH(m) do { \
        if (XSB) { const GAS v4u* xa_ = (const GAS v4u*)((const bf16*)x_src + (size_t)(m) * DM) + F.lane; _Pragma("unroll") for (int j = 0; j < 4; ++j) rq[j] = xa_[64 * j]; } \
        else { const GAS f32x4* xa_ = (const GAS f32x4*)((const float*)x_src + (size_t)(m) * DM) + 2 * F.lane; _Pragma("unroll") for (int j = 0; j < 4; ++j) { rf[2 * j] = xa_[128 * j]; rf[2 * j + 1] = xa_[128 * j + 1]; } } \
        if (add) { const GAS v4u* aa_ = (const GAS v4u*)(add + (size_t)(m) * DM) + F.lane; _Pragma("unroll") for (int j = 0; j < 4; ++j) rw[j] = aa_[64 * j]; } } while (0)
    if (gw < MG) NP_FETCH(gw);
    for (int m0 = gw; m0 < MG; m0 += NGW) {
        f32x4 va[8]; v4u wa[4];
        if (XSB) {
#pragma unroll
            for (int j = 0; j < 4; ++j) UNPK(rq[j], va[2 * j], va[2 * j + 1]);
        } else {
#pragma unroll
            for (int j = 0; j < 8; ++j) va[j] = rf[j];
        }
#pragma unroll
        for (int j = 0; j < 4; ++j) wa[j] = rw[j];
        if (m0 + NGW < MG) NP_FETCH(m0 + NGW);
        if (add) {
            float sa = 0.f;
#pragma unroll
            for (int j = 0; j < 4; ++j) { f32x4 a0, a1; UNPK(wa[j], a0, a1);
                sa += ((a0[0] * a0[0] + a0[1] * a0[1]) + (a0[2] * a0[2] + a0[3] * a0[3])) + ((a1[0] * a1[0] + a1[1] * a1[1]) + (a1[2] * a1[2] + a1[3] * a1[3])); }
            const float ra = 1.0f / sqrtf(wave_sum(sa) * (1.0f / DM) + EPS);
#pragma unroll
            for (int j = 0; j < 4; ++j) { f32x4 a0, a1; UNPK(wa[j], a0, a1);
                va[2 * j] = va[2 * j] + a0 * ra * gA[2 * j]; va[2 * j + 1] = va[2 * j + 1] + a1 * ra * gA[2 * j + 1]; }
        }
        if (xf_dst) { GAS f32x4* oa = (GAS f32x4*)(xf_dst + (size_t)m0 * DM) + 2 * F.lane;
#pragma unroll
            for (int j = 0; j < 4; ++j) { oa[128 * j] = va[2 * j]; oa[128 * j + 1] = va[2 * j + 1]; } }
        if (xb_dst) { GAS v4u* oa = (GAS v4u*)(xb_dst + (size_t)m0 * DM) + F.lane;
#pragma unroll
            for (int j = 0; j < 4; ++j) { const v4u w = PK8(va[2 * j], va[2 * j + 1]); oa[64 * j] = w;
                UNPK(w, va[2 * j], va[2 * j + 1]); } }
        if (h_dst) {
            float sa = 0.f;
#pragma unroll
            for (int j = 0; j < 8; ++j) sa += (va[j][0] * va[j][0] + va[j][1] * va[j][1]) + (va[j][2] * va[j][2] + va[j][3] * va[j][3]);
            const float ra = 1.0f / sqrtf(wave_sum(sa) * (1.0f / DM) + EPS);
            GAS v4u* ha = (GAS v4u*)(h_dst + (size_t)m0 * DM) + F.lane;
#pragma unroll
            for (int j = 0; j < 4; ++j) { const f32x4 oa0 = va[2 * j] * ra * gO[2 * j], oa1 = va[2 * j + 1] * ra * gO[2 * j + 1]; ha[64 * j] = PK8(oa0, oa1); }
        }
    }
#undef NP_FETCH
#undef UNPK
#undef PK8
}
typedef LAS cf* lcf;
template <bool ZUP> __device__ __forceinline__ void hy_fwd(lcf X, lcf thi, lcf tlo, int tid, const cf* KM) {
    if (ZUP) hy_pass16<1024, false, true, false>(X, thi, tlo, tid); else hy_pass16<1024, false, false, false>(X, thi, tlo, tid);
    __syncthreads();
    hy_pass16<64, false, false, false>(X, thi, tlo, tid);
    hy_pass16<4, false, false, false>(X, thi, tlo, tid);
    hy_pass4<false>(X, tid, KM); __syncthreads();
}
__device__ __forceinline__ void hy_inv(lcf X, lcf thi, lcf tlo, int tid) {
    const cf* nul = nullptr;
    hy_pass4<true>(X, tid, nul); __syncthreads();
    hy_pass16<4, true, false, false>(X, thi, tlo, tid); __syncthreads();
    hy_pass16<64, true, false, false>(X, thi, tlo, tid); __syncthreads();
    hy_pass16<1024, true, false, true>(X, thi, tlo, tid); __syncthreads();
}
__device__ __forceinline__ void hy_mid(lcf X, lcf thi, lcf tlo, int tid, const cf* KM) {
    const cf* nul = nullptr;
    hy_pass16<64, false, false, false>(X, thi, tlo, tid);
    hy_pass16<4, false, false, false>(X, thi, tlo, tid);
    hy_pass4<false>(X, tid, KM);
    hy_pass4<true>(X, tid, nul);
    hy_pass16<4, true, false, false>(X, thi, tlo, tid);
    hy_pass16<64, true, false, false>(X, thi, tlo, tid); __syncthreads();
}
__device__ __forceinline__ void hyena_phase(Frame& F, const Args& A, int l) {
    lcf X = (lcf)(F.lds + RING_OFF); lcf thi = (lcf)(F.lds + TAB_OFF); lcf tlo = thi + 128;
    const int tid = F.tid;
    if (tid < 256) { const int a = tid & 127; const double ang = -6.283185307179586 * (double)(tid < 128 ? 128 * a : a) / (double)FN; float s, c; sincos_red(ang, s, c); (tid < 128 ? thi : tlo)[a] = cf{c, s}; }
    cf* K1g = (cf*)(F.ws + WS_FFTK) + (size_t)F.bx * 2 * FN; cf* K2g = K1g + FN;
    const bf16* taps = (const bf16*)(F.ws + ((A.taps_all && l > 0) ? WS_TAPS_X + (size_t)(l - 1) * SZ_TAPS : WS_TAPS));
    const float* cw = GP(A.in[I_CONVW + F.z]) + (size_t)l * 3 * HYIN; const float* cb = GP(A.in[I_CONVB + F.z]) + (size_t)l * HYIN; const float* hb = GP(A.in[I_HBIAS + F.z]) + (size_t)l * 2 * HYW;
    const bf16* projT = (const bf16*)(F.ws + WS_PROJT); bf16* zT = (bf16*)(F.ws + WS_ZT);
    for (int c = F.vcu; c < HYW; c += F.G) {
        __syncthreads();
        const float delta = fabsf(-15.350567286626973f + (float)c * ((-3.0701134573253945f + 15.350567286626973f) / 1023.0f));
#define TIDX(v) int v = tid; asm volatile("" : "+v"(v))
        { TIDX(t_); hy_filter_step(X, taps + (size_t)c * SEQ, delta, t_); }
        const unsigned* rx1 = (const unsigned*)(projT + (size_t)c * MG); const unsigned* rx2 = (const unsigned*)(projT + (size_t)(HYW + c) * MG); const unsigned* rv = (const unsigned*)(projT + (size_t)(2 * HYW + c) * MG);
        HyRaw R;
        { TIDX(t_); hy_raw_load(R, rv, rv + SEQ / 2, t_); }
        __syncthreads();
        { TIDX(t_); hy_fwd<false>(X, thi, tlo, t_, nullptr); }
        { TIDX(t_); hy_sep_step(X, K1g, K2g, t_); }
        asm volatile("s_waitcnt vmcnt(0)" ::: "memory"); __syncthreads();
        cf zr[2][8];
        { TIDX(t_); hy_convA_fwd(X, thi, tlo, t_, R, cw[2 * HYW + c], cw[HYIN + 2 * HYW + c], cw[2 * HYIN + 2 * HYW + c], cb[2 * HYW + c], zr); }
        { TIDX(t_); hy_raw_load(R, rx1, rx1 + SEQ / 2, t_); }
        __syncthreads();
        { TIDX(t_); hy_mid(X, thi, tlo, t_, K1g); }
        { TIDX(t_); hy_gateA<false>(X, thi, tlo, t_, R, cw[c], cw[HYIN + c], cw[2 * HYIN + c], cb[c], hb[c], zr, (unsigned short*)nullptr, (unsigned short*)nullptr); }
        { TIDX(t_); hy_raw_load(R, rx2, rx2 + SEQ / 2, t_); }
        __syncthreads();
        { TIDX(t_); hy_mid(X, thi, tlo, t_, K2g); }
        unsigned short* zo = (unsigned short*)(zT + (size_t)c * MG);
        { TIDX(t_); hy_gateA<true>(X, thi, tlo, t_, R, cw[HYW + c], cw[HYIN + HYW + c], cw[2 * HYIN + HYW + c], cb[HYW + c], hb[HYW + c], zr, zo, zo + SEQ); }
#undef TIDX
    }
    __syncthreads();
}
__device__ __forceinline__ void hynorm_phase(Frame& F, const Args& A, int l) {
    constexpr int TB = 64;
    LAS unsigned char* tile = F.lds + RING_OFF; LAS float* red = (LAS float*)(F.lds + RING_OFF + TB * HYW * 2); LAS float* rinv = red + 8 * TB;
    const bf16* zT = (const bf16*)(F.ws + WS_ZT); bf16* mixin = (bf16*)(F.ws + WS_MIXIN); const float* gn = GP(A.in[I_HNORM + F.z]) + (size_t)l * HYW;
    const int tid = F.tid;
    for (int tb = F.vcu; tb < MG / TB; tb += F.G) {
        const int t0 = tb * TB; __syncthreads();
        float ps[8];
#pragma unroll
        for (int i = 0; i < 8; ++i) ps[i] = 0.f;
        const int k = tid & 7, crow = tid >> 3;
#pragma unroll
        for (int hb = 0; hb < 2; ++hb) {
            v4u w[8];
#pragma unroll
            for (int it = 0; it < 8; ++it) { const unsigned c = (unsigned)((hb * 8 + it) * 64 + crow) & 1023u; w[it] = *(const GAS v4u*)(zT + (size_t)c * MG + (unsigned)(t0 + 8 * k)); }
#pragma unroll
            for (int it = 0; it < 8; ++it) { const int c = (hb * 8 + it) * 64 + crow;
                LAS unsigned short* d = (LAS unsigned short*)(tile + (8 * k) * 2048 + (((c >> 3) ^ k) << 4) + (c & 7) * 2);
                const unsigned ww[4] = {w[it].x, w[it].y, w[it].z, w[it].w};
#pragma unroll
                for (int i = 0; i < 4; ++i) { d[(2 * i) * 1024] = (unsigned short)(ww[i] & 0xffffu); d[(2 * i + 1) * 1024] = (unsigned short)(ww[i] >> 16);
                    const float a = __uint_as_float(ww[i] << 16), b = __uint_as_float(ww[i] & 0xffff0000u); ps[2 * i] += a * a; ps[2 * i + 1] += b * b; } }
        }
#pragma unroll
        for (int i = 0; i < 8; ++i) { float v = ps[i]; v += swz_xor<8>(v); v += swz_xor<16>(v);
            auto rr = __builtin_amdgcn_permlane32_swap(__float_as_uint(v), __float_as_uint(v), false, false); ps[i] = __uint_as_float(rr[0]) + __uint_as_float(rr[1]); }
        if ((F.lane >> 3) == 0) {
#pragma unroll
            for (int i = 0; i < 8; ++i) red[F.wave * TB + 8 * k + i] = ps[i]; }
        __syncthreads();
        if (tid < TB) { float s = 0.f;
#pragma unroll
            for (int w8 = 0; w8 < 8; ++w8) s += red[w8 * TB + tid];
            rinv[tid] = 1.0f / sqrtf(s * (1.0f / HYW) + EPS); }
        __syncthreads();
        const int cg = tid & 127;
        const f32x4 g0 = *(const f32x4*)(gn + 8 * cg), g1 = *(const f32x4*)(gn + 8 * cg + 4);
#pragma unroll 4
        for (int it = 0; it < 16; ++it) { const int tok = it * 4 + (tid >> 7); const float r = rinv[tok];
            const v4u q = *(const LAS v4u*)(tile + tok * 2048 + ((cg ^ (tok >> 3)) << 4));
            v4u o; o.x = pk2(__uint_as_float(q.x << 16) * r * g0[0], __uint_as_float(q.x & 0xffff0000u) * r * g0[1]); o.y = pk2(__uint_as_float(q.y << 16) * r * g0[2], __uint_as_float(q.y & 0xffff0000u) * r * g0[3]);
            o.z = pk2(__uint_as_float(q.z << 16) * r * g1[0], __uint_as_float(q.z & 0xffff0000u) * r * g1[1]); o.w = pk2(__uint_as_float(q.w << 16) * r * g1[2], __uint_as_float(q.w & 0xffff0000u) * r * g1[3]);
            *(GAS v4u*)(mixin + (size_t)(t0 + tok) * DM + 8 * cg) = o; }
    }
    __syncthreads();
}
__device__ __forceinline__ void attn_phase(Frame& F, const Args& A, int l, unsigned char* lds_generic) {
    const float li = 0.8f - 0.6f * expf(-0.3f * (float)l);
    float lam;
    { const int j = F.lane; const float a = GP(A.in[I_LQ1 + F.z])[l * 64 + j] * GP(A.in[I_LK1 + F.z])[l * 64 + j], b = GP(A.in[I_LQ2 + F.z])[l * 64 + j] * GP(A.in[I_LK2 + F.z])[l * 64 + j];
      lam = expf(wave_sum(a)) - expf(wave_sum(b)) + li; }
    const att::bf16* qkv = (const att::bf16*)(F.ws + WS_QKV); att::bf16* mixin = (att::bf16*)(F.ws + WS_MIXIN);
    float* stash = (float*)(F.ws + WS_H) + (size_t)F.bx * 64 * 512;
    const float* subln = GP(A.in[I_SUBLN + F.z]) + (size_t)l * 128;
    constexpr int NU = GSEQ * 8 * (SEQ / 256);
    for (int u = F.vcu; u < NU; u += F.G) {
        const int bvh = u >> 5, qb = u & 31, b = bvh >> 3, vh = bvh & 7;
        const long krow0 = (long)b * SEQ, qrow0 = krow0 + qb * 256;
        att::attn_unit(qkv, qrow0, krow0, vh, SEQ, lam, 1.0f - li, subln, mixin + (size_t)qrow0 * DM + HYW + vh * 128, DM, stash, (char*)lds_generic);
        __syncthreads();
    }
}
#ifndef PHMASK
#define PHMASK 511
#endif
__global__ void __launch_bounds__(NTHR, 2) hymba_fwd(Args args) {
    extern __shared__ __attribute__((aligned(16))) unsigned char lds[];
    Frame F;
    F.lds = (LAS unsigned char*)lds; F.MISC = (volatile LAS unsigned*)(F.lds + MISC_OFF);
    F.tid = threadIdx.x; F.lane = F.tid & 63; F.wave = __builtin_amdgcn_readfirstlane(F.tid >> 6);
    F.G = gridDim.x; { const int bx = blockIdx.x; F.vcu = (F.G % 8 == 0) ? (bx % 8) * (F.G / 8) + bx / 8 : bx; F.bx = bx; }
    F.vcu0 = F.vcu; F.G0 = F.G; F.bx0 = F.bx;
    F.ctl = (gu32*)(args.ws + WS_CTL); F.out = args.out; F.ws = args.ws; F.ws0 = args.ws; F.z = 0;
    for (int u = F.tid; u < (LDS_BYTES - MISC_OFF) / 4; u += NTHR) ((LAS unsigned*)(F.lds + MISC_OFF))[u] = 0u;
    __syncthreads();
    XcdBarrier bar; bar.bar = (unsigned*)(F.ctl + CW_BAR); bar.x = 0; bar.st = nullptr;
    if (!MK_PER_PHASE) bar = xcd_barrier_post((unsigned*)(F.ctl + CW_BAR), F.MISC + 8);
    const int lo = args.ph_lo, hi = args.ph_hi;
    int ph = 0;
#define IN_() (lo <= ph && ph < hi && ({ LAUNDER_TID(F); true; }))
#define DUP3(...) do { __VA_ARGS__; if (PROBE_DUP == 3) { __VA_ARGS__; } } while (0)
#define SEAM() do { if (!MK_PER_PHASE && lo <= ph && ph + 1 < hi) { XcdBarrier b_ = bar; { unsigned long long p_ = (unsigned long long)b_.bar; unsigned x_ = b_.x; asm volatile("" : "+s"(p_), "+s"(x_)); b_.bar = (unsigned*)(GAS unsigned*)p_; b_.x = x_; } \
        xcd_barrier(b_); if (PROBE_DUP == 7) xcd_barrier(b_); } ++ph; } while (0)
    if ((PHMASK & 1) && IN_()) { p0_prologue(F, args); if (PROBE_DUP == 4) p0_prologue(F, args); }
    SEAM();
#define Hb ((bf16*)(F.ws + WS_H))
#define XB ((bf16*)(F.ws + WS_XB))
#define projT ((bf16*)(F.ws + WS_PROJT))
#define qkv ((bf16*)(F.ws + WS_QKV))
#define mix ((bf16*)(F.ws + WS_MIX))
#define ffh ((bf16*)(F.ws + WS_FFH))
#define mixin ((bf16*)(F.ws + WS_MIXIN))
#define wl (F.ws + WS_W + (size_t)l * SZ_WLAYER)
#define xin ((g == 0) ? GP(args.in[I_XP + F.z]) : GP(args.in[I_XS + F.z]) + (size_t)(g - 1) * MG * DM)
#define xres ((float*)(GAS float*)args.out + (size_t)g * MG * DM)
    for (int g = 0; g < NGRP; ++g) {
        if ((PHMASK & 2) && IN_()) norm_pass<false>(F, xin, nullptr, nullptr, nullptr, nullptr, GP(args.in[I_GMPRE + F.z]), Hb);
        SEAM();
        for (int l = 0; l < DEPTH; ++l) {
            if ((PHMASK & 4) && IN_()) {
                { pg8::Gemm gm{(const bf16*)(wl + OFF_WHY), Hb, HYIN, MG, DM}; pg8::StaticOrder S; S.init(HYIN, MG, F.G, F.bx);
                  pg8::EpiPlain E{projT, MG};
                  DUP3(pg8::gemm_phase<pg8::EpiPlain, pg8::StaticOrder, true, true>(F.lds + RING_OFF, gm, S, E)); }
                if (g == 0 || !args.taps_all) { pg8::Gemm gm{(const bf16*)(F.ws + WS_W4T) + (size_t)l * 4096 * KPAD, (const bf16*)(F.ws + WS_H3) + (size_t)l * SEQ * KPAD, 4096, SEQ, KPAD}; pg8::StaticOrder S; S.init(4096, SEQ, F.G, F.bx);
                  pg8::EpiPlain E{(bf16*)(F.ws + ((args.taps_all && l > 0) ? WS_TAPS_X + (size_t)(l - 1) * SZ_TAPS : WS_TAPS)), SEQ};
                  DUP3(pg8::gemm_phase<pg8::EpiPlain, pg8::StaticOrder, true, true>(F.lds + RING_OFF, gm, S, E)); }
                { pg8::Gemm gm{Hb, (const bf16*)(wl + OFF_WQKV), MG, QKVW, DM}; pg8::StaticOrder S; S.init(MG, QKVW, F.G, F.bx);
                  pg8::EpiRope E{qkv, QKVW, (const float*)(F.ws + WS_ROPE), QSCALE};
                  DUP3(pg8::gemm_phase<pg8::EpiRope, pg8::StaticOrder, true, true>(F.lds + RING_OFF, gm, S, E)); }
            }
            SEAM();
            if (IN_()) { if (PHMASK & 8) hyena_phase(F, args, l); if (PROBE_DUP == 2) hyena_phase(F, args, l); if (PHMASK & 16) attn_phase(F, args, l, lds); if (PROBE_DUP == 1) attn_phase(F, args, l, lds); }
            SEAM();
            if ((PHMASK & 32) && IN_()) { hynorm_phase(F, args, l); if (PROBE_DUP == 4) hynorm_phase(F, args, l); }
            SEAM();
            if ((PHMASK & 64) && IN_()) { pg8::Gemm gm{mixin, (const bf16*)(wl + OFF_WOUT), MG, DM, DM}; pg8::StaticOrder S; S.init(MG, DM, F.G, F.bx);
                pg8::EpiPlain E{mix, DM};
                DUP3(pg8::gemm_phase<pg8::EpiPlain, pg8::StaticOrder, true, true>(F.lds + RING_OFF, gm, S, E)); }
            SEAM();
            if ((PHMASK & 2) && IN_()) { if (l == 0) norm_pass<false>(F, xin, mix, GP(args.in[I_GMPOST + F.z]) + (size_t)l * DM, XB, nullptr, GP(args.in[I_GFPRE + F.z]) + (size_t)l * DM, Hb);
                else norm_pass<true>(F, XB, mix, GP(args.in[I_GMPOST + F.z]) + (size_t)l * DM, XB, nullptr, GP(args.in[I_GFPRE + F.z]) + (size_t)l * DM, Hb); }
            SEAM();
            if ((PHMASK & 128) && IN_()) { pg8::Gemm gm{Hb, (const bf16*)(wl + OFF_WGU), MG, GU, DM}; pg8::StaticOrder S; S.init(MG, GU, F.G, F.bx);
                pg8::EpiSwiGLU E{ffh, DFF};
                DUP3(pg8::gemm_phase<pg8::EpiSwiGLU, pg8::StaticOrder, true, true>(F.lds + RING_OFF, gm, S, E)); }
            SEAM();
            if ((PHMASK & 256) && IN_()) { pg8::Gemm gm{ffh, (const bf16*)(wl + OFF_WDN), MG, DM, DFF}; pg8::StaticOrder S; S.init(MG, DM, F.G, F.bx);
                pg8::EpiPlain E{mixin, DM};
                DUP3(pg8::gemm_phase<pg8::EpiPlain, pg8::StaticOrder, true, true>(F.lds + RING_OFF, gm, S, E)); }
            SEAM();
            if ((PHMASK & 2) && IN_()) { if (l + 1 < DEPTH) norm_pass<true>(F, XB, mixin, GP(args.in[I_GFPOST + F.z]) + (size_t)l * DM, XB, nullptr, GP(args.in[I_GMPRE + F.z]) + (size_t)(l + 1) * DM, Hb);
                else norm_pass<true>(F, XB, mixin, GP(args.in[I_GFPOST + F.z]) + (size_t)l * DM, nullptr, xres, nullptr, nullptr); }
            SEAM();
        }
    }
#undef IN_
#undef SEAM
#undef Hb
#undef XB
#undef projT
#undef qkv
#undef mix
#undef ffh
#undef mixin
#undef wl
#undef xin
#undef xres
}

extern "C" void kernel_launch(void* const* d_in, const int* in_sizes, int n_in, void* d_out, int out_size, void* d_ws, size_t ws_size, hipStream_t stream) {
    static int grid = 0;
    if (grid == 0) {
        if (n_in != 30 || in_sizes[0] != 2 * SEQ * DM || in_sizes[1] != 4 * SEQ * DM || out_size != NSEQ * SEQ * DM || ws_size < WS_END) {
            fprintf(stderr, "kernel_launch: shape mismatch (n_in %d, out %d, ws %zu, need %zu)\n", n_in, out_size, ws_size, (size_t)WS_END); grid = -1; return; }
        int dev = 0, cus = 0;
        if (hipGetDevice(&dev) != hipSuccess || hipDeviceGetAttribute(&cus, hipDeviceAttributeMultiprocessorCount, dev) != hipSuccess) { grid = -1; return; }
        if (hipFuncSetAttribute((const void*)hymba_fwd, hipFuncAttributeMaxDynamicSharedMemorySize, LDS_BYTES) != hipSuccess) { fprintf(stderr, "kernel_launch: hipFuncSetAttribute failed\n"); grid = -1; return; }
        int per_cu = 0;
        if (hipOccupancyMaxActiveBlocksPerMultiprocessor(&per_cu, (const void*)hymba_fwd, NTHR, LDS_BYTES) != hipSuccess || per_cu < 1) fprintf(stderr, "kernel_launch: occupancy query says %d\n", per_cu);
        (void)hipGetLastError();
        grid = cus;
    }
    if (grid < 0) return;
    if (hipMemsetAsync((char*)d_ws + WS_CTL, 0, CTL_ZERO_BYTES, stream) != hipSuccess) return;
    Args a{};
    for (int i = 0; i < 30; ++i) a.in[i] = (const float*)d_in[i];
    a.out = (float*)d_out; a.ws = (unsigned char*)d_ws; a.taps_all = (ws_size >= WS_END_X) ? 1 : 0;
#if MK_PER_PHASE
    for (int p = 0; p < NPHASE; ++p) { a.ph_lo = p; a.ph_hi = p + 1; hipLaunchKernelGGL(hymba_fwd, dim3(grid), dim3(NTHR), LDS_BYTES, stream, a); }
#else
    a.ph_lo = 0; a.ph_hi = NPHASE;
    hipLaunchKernelGGL(hymba_fwd, dim3(grid), dim3(NTHR), LDS_BYTES, stream, a);
#endif
    const hipError_t le = hipPeekAtLastError();
    if (le != hipSuccess) fprintf(stderr, "kernel_launch: launch failed: %s\n", hipGetErrorName(le));
}
```

```cpp
#include <hip/hip_runtime.h>
#include <hip/hip_bf16.h>
#include <cstdio>
#include <cstdint>
#include <cmath>
namespace pg8 {
#define PG8_LAS __attribute__((address_space(3)))
typedef unsigned short bf16_t;
typedef short bf16x8 __attribute__((ext_vector_type(8)));
typedef float f32x4 __attribute__((ext_vector_type(4)));
typedef unsigned u32x4 __attribute__((ext_vector_type(4)));
constexpr int BM = 256, BK = 64, HALF = 128, HTB = HALF * BK * 2  , STAGE_BYTES = 8 * HTB, NXCD = 8, WGM = 8;

__host__ __device__ __forceinline__ int lds_byte(int r, int c) { const int st = (r >> 4) * 2 + (c >> 5), rr = r & 15, cc = c & 31, ob = rr * 64 + cc * 2; return st * 1024 + (ob ^ (((ob >> 9) & 1) << 5)); }
__host__ __device__ __forceinline__ void stage_rc(int b, int& R, int& C) { const int st = b / 1024, sb = b % 1024, swz = sb ^ (((sb >> 9) & 1) << 5); R = (st >> 1) * 16 + swz / 64; C = (st & 1) * 32 + (swz % 64) / 2; }
__host__ __device__ __forceinline__ int perm32(int rho) { const int n = rho >> 4, i = rho & 15; return 8 * (i >> 2) + 4 * n + (i & 3); }

struct Unit { int pm, pn; };
struct Gemm { const bf16_t* A; const bf16_t* Bt; int M, N, K; };

struct StaticOrder {
    int nM, nN, nwg, G, c;
    __host__ __device__ void init(int M, int N, int G_, int c_) { nM = M / BM; nN = N / BM; nwg = nM * nN; G = G_; c = c_; }
    __host__ __device__ bool next(int i, Unit& u) const {
        const long L = (long)i * G + c; if (L >= nwg) return false;
        int wgid = (int)L; { const int q = nwg / NXCD, r = nwg % NXCD, xcd = wgid % NXCD, off = wgid / NXCD; wgid = (xcd < r ? xcd * (q + 1) : r * (q + 1) + (xcd - r) * q) + off; }
        const int nig = WGM * nN, gid = wgid / nig, fm = gid * WGM, gsz = (nM - fm) < WGM ? (nM - fm) : WGM;
        u.pm = fm + ((wgid % nig) % gsz); u.pn = (wgid % nig) / gsz; return true;
    }
    __device__ __forceinline__ void a_ready(const Unit&) const {}
    __device__ __forceinline__ void done(const Unit&) const {}
};

__device__ __forceinline__ unsigned cvt_pk_bf16(float lo, float hi) { unsigned r; asm volatile("v_cvt_pk_bf16_f32 %0, %1, %2" : "=v"(r) : "v"(lo), "v"(hi)); return r; }
typedef float f32x2 __attribute__((ext_vector_type(2)));
struct EpiPlain {
    static constexpr bool PERM = true, AFTER_DRAIN = false;
    bf16_t* O; int ldc;
    __device__ __forceinline__ void operator()(const f32x4 (&acc)[2][2][4][2], const Unit& u, int wr, int wc, int fr, int fq) const {
        const int row0 = u.pm * BM + wr * 64 + fr, col0 = u.pn * BM + wc * 32 + 8 * fq;
#pragma unroll
        for (int ai = 0; ai < 2; ++ai)
#pragma unroll
            for (int m = 0; m < 4; ++m) { bf16_t* rowp = O + (size_t)(row0 + ai * HALF + m * 16) * ldc + col0;
#pragma unroll
                for (int bj = 0; bj < 2; ++bj) { const f32x4 v0 = acc[ai][bj][m][0], v1 = acc[ai][bj][m][1];
                    u32x4 w; w.x = cvt_pk_bf16(v0[0], v0[1]); w.y = cvt_pk_bf16(v0[2], v0[3]); w.z = cvt_pk_bf16(v1[0], v1[1]); w.w = cvt_pk_bf16(v1[2], v1[3]);
                    *(u32x4*)(rowp + bj * HALF) = w; } }
    }
};
struct EpiRope {
    static constexpr bool PERM = true, AFTER_DRAIN = false;
    bf16_t* O; int ldc; const float* cs; float qscale;
    __device__ __forceinline__ void operator()(const f32x4 (&acc)[2][2][4][2], const Unit& u, int wr, int wc, int fr, int fq) const {
        const int row0 = u.pm * BM + wr * 64 + fr, col0 = u.pn * BM + wc * 32 + 8 * fq;
        const bool rope = u.pn < 8; const float sc = u.pn < 4 ? qscale : 1.0f;
        const int p0 = 16 * (wc & 1) + 4 * fq;
        f32x4 tt[2][4][2];
#pragma unroll
        for (int ai = 0; ai < 2; ++ai)
#pragma unroll
            for (int m = 0; m < 4; ++m) { tt[ai][m][0] = (f32x4){1.f, 0.f, 1.f, 0.f}; tt[ai][m][1] = (f32x4){1.f, 0.f, 1.f, 0.f};
                if (rope) { const int row = row0 + ai * HALF + m * 16; const __attribute__((address_space(1))) float* tp = (const __attribute__((address_space(1))) float*)cs + ((size_t)(row & 8191) * 32 + p0) * 2;
                    tt[ai][m][0] = *(const __attribute__((address_space(1))) f32x4*)tp; tt[ai][m][1] = *(const __attribute__((address_space(1))) f32x4*)(tp + 4); } }
#pragma unroll
        for (int ai = 0; ai < 2; ++ai)
#pragma unroll
            for (int m = 0; m < 4; ++m) { const int row = row0 + ai * HALF + m * 16; bf16_t* rowp = O + (size_t)row * ldc + col0;
                const f32x4 t0 = tt[ai][m][0], t1 = tt[ai][m][1];
#pragma unroll
                for (int bj = 0; bj < 2; ++bj) { const f32x4 v0 = acc[ai][bj][m][0], v1 = acc[ai][bj][m][1];
                    f32x4 o0, o1;
                    o0[0] = (v0[0] * t0[0] - v0[1] * t0[1]) * sc; o0[1] = (v0[0] * t0[1] + v0[1] * t0[0]) * sc;
                    o0[2] = (v0[2] * t0[2] - v0[3] * t0[3]) * sc; o0[3] = (v0[2] * t0[3] + v0[3] * t0[2]) * sc;
                    o1[0] = (v1[0] * t1[0] - v1[1] * t1[1]) * sc; o1[1] = (v1[0] * t1[1] + v1[1] * t1[0]) * sc;
                    o1[2] = (v1[2] * t1[2] - v1[3] * t1[3]) * sc; o1[3] = (v1[2] * t1[3] + v1[3] * t1[2]) * sc;
                    u32x4 w; w.x = cvt_pk_bf16(o0[0], o0[1]); w.y = cvt_pk_bf16(o0[2], o0[3]); w.z = cvt_pk_bf16(o1[0], o1[1]); w.w = cvt_pk_bf16(o1[2], o1[3]);
                    *(u32x4*)(rowp + bj * HALF) = w; } }
    }
};
struct EpiSwiGLU {
    static constexpr bool PERM = true, AFTER_DRAIN = false;
    bf16_t* O; int ldc;
    static __device__ __forceinline__ float silu_mul(float g, float u) { return g * u * __builtin_amdgcn_rcpf(1.0f + __builtin_amdgcn_exp2f(-1.4426950408889634f * g)); }
    __device__ __forceinline__ void operator()(const f32x4 (&acc)[2][2][4][2], const Unit& u, int wr, int wc, int fr, int fq) const {
        const int row0 = u.pm * BM + wr * 64 + fr, col0 = u.pn * HALF + wc * 32 + 8 * fq;
#pragma unroll
        for (int ai = 0; ai < 2; ++ai)
#pragma unroll
            for (int m = 0; m < 4; ++m) { bf16_t* rowp = O + (size_t)(row0 + ai * HALF + m * 16) * ldc + col0;
                const f32x4 g0 = acc[ai][0][m][0], g1 = acc[ai][0][m][1], u0 = acc[ai][1][m][0], u1 = acc[ai][1][m][1];
                u32x4 w; w.x = cvt_pk_bf16(silu_mul(g0[0], u0[0]), silu_mul(g0[1], u0[1])); w.y = cvt_pk_bf16(silu_mul(g0[2], u0[2]), silu_mul(g0[3], u0[3]));
                w.z = cvt_pk_bf16(silu_mul(g1[0], u1[0]), silu_mul(g1[1], u1[1])); w.w = cvt_pk_bf16(silu_mul(g1[2], u1[2]), silu_mul(g1[3], u1[3]));
                *(u32x4*)rowp = w; }
    }
};
template <class Epi, class Sched, bool ALIGN_EPI = false, bool SP2 = false>
__device__ __forceinline__ void gemm_phase(PG8_LAS unsigned char* lds, const Gemm g, const Sched& S, const Epi& E) {
    int tid = threadIdx.x; asm volatile("" : "+v"(tid));
    const int wid = __builtin_amdgcn_readfirstlane(tid >> 6), lane = tid & 63, wr = wid >> 2, wc = wid & 3, fr = lane & 15, fq = lane >> 4;
    const int K = g.K, nt = K / BK;
    unsigned voffA[2], voffB[2];
#pragma unroll
    for (int i = 0; i < 2; ++i) { int R, C; stage_rc(tid * 16 + i * 8192, R, C); const int Rb = Epi::PERM ? ((R & ~31) + perm32(R & 31)) : R;
        voffA[i] = (unsigned)(R * K + C) * 2u; voffB[i] = (unsigned)(Rb * K + C) * 2u; }
    const size_t kstep = (size_t)(BK * 2);
    const size_t hstep = (size_t)HALF * K * 2;
    const size_t tstep = 2 * hstep;
    const unsigned ldsw = (unsigned)wid * 1024u;
    const int aoff = lds_byte(wr * 64 + fr, fq * 8), boff = lds_byte(wc * 32 + fr, fq * 8);
#define PG8_SA(b, h) (((b) * 2 + (h)) * HTB)
#define PG8_SB(b, h) ((4 + (b) * 2 + (h)) * HTB)
#define PG8_STAGE(bufoff, gbase, voff) do { _Pragma("unroll") for (int _i = 0; _i < 2; ++_i) \
        __builtin_amdgcn_global_load_lds((const unsigned*)((const char*)(gbase) + (voff)[_i]), (PG8_LAS unsigned*)(lds + (bufoff) + ldsw + _i * 8192), 16, 0, 0); } while (0)
#define PG8_LDA(dst, b, h) do { _Pragma("unroll") for (int m = 0; m < 4; ++m) _Pragma("unroll") for (int k = 0; k < 2; ++k) dst[m][k] = *(const PG8_LAS bf16x8*)(lds + PG8_SA(b, h) + aoff + m * 2048 + k * 1024); } while (0)
#define PG8_LDB(dst, b, h) do { _Pragma("unroll") for (int n = 0; n < 2; ++n) _Pragma("unroll") for (int k = 0; k < 2; ++k) dst[n][k] = *(const PG8_LAS bf16x8*)(lds + PG8_SB(b, h) + boff + n * 2048 + k * 1024); } while (0)
#define PG8_MMA(ai, bj, At, Bt) do { __builtin_amdgcn_s_setprio(1); _Pragma("unroll") for (int m = 0; m < 4; ++m) _Pragma("unroll") for (int n = 0; n < 2; ++n) _Pragma("unroll") for (int k = 0; k < 2; ++k) \
        acc[ai][bj][m][n] = __builtin_amdgcn_mfma_f32_16x16x32_bf16(Bt[n][k], At[m][k], acc[ai][bj][m][n], 0, 0, 0); __builtin_amdgcn_s_setprio(0); } while (0)
#define PG8_WAIT_V(n) asm volatile("s_waitcnt vmcnt(" #n ")" ::: "memory")
#define PG8_WAIT_L(n) asm volatile("s_waitcnt lgkmcnt(" #n ")" ::: "memory")
#define PG8_BAR __builtin_amdgcn_s_barrier()
#define PG8_SCHED __builtin_amdgcn_sched_barrier(0)
    Unit cur, nxt; int ui = 0;
    if (!S.next(0, cur)) return;
    f32x4 acc[2][2][4][2];
#pragma unroll
    for (int a = 0; a < 2; ++a)
#pragma unroll
        for (int b = 0; b < 2; ++b)
#pragma unroll
            for (int m = 0; m < 4; ++m)
#pragma unroll
                for (int n = 0; n < 2; ++n) acc[a][b][m][n] = (f32x4){0.f, 0.f, 0.f, 0.f};
    bf16x8 At[4][2], B0[2][2], B1[2][2];
    const char* cA = (const char*)g.A + (size_t)cur.pm * tstep; const char* cB = (const char*)g.Bt + (size_t)cur.pn * tstep;
    S.a_ready(cur);
    if constexpr (SP2) {
        PG8_STAGE(PG8_SB(0, 0), cB, voffB); PG8_STAGE(PG8_SB(0, 1), cB + hstep, voffB); PG8_STAGE(PG8_SA(0, 0), cA, voffA); PG8_STAGE(PG8_SA(0, 1), cA + hstep, voffA);
        if (wr == 1) PG8_BAR;
        PG8_WAIT_V(2); PG8_BAR;
        PG8_STAGE(PG8_SB(1, 0), cB + kstep, voffB); PG8_STAGE(PG8_SA(1, 0), cA + kstep, voffA); PG8_STAGE(PG8_SB(1, 1), cB + hstep + kstep, voffB);
        PG8_WAIT_V(6); PG8_BAR;
    } else {
        PG8_STAGE(PG8_SB(0, 0), cB, voffB); PG8_STAGE(PG8_SA(0, 0), cA, voffA); PG8_STAGE(PG8_SB(0, 1), cB + hstep, voffB); PG8_STAGE(PG8_SA(0, 1), cA + hstep, voffA);
        if (wr == 1) PG8_BAR;
        PG8_WAIT_V(4); PG8_BAR;
        PG8_STAGE(PG8_SB(1, 0), cB + kstep, voffB); PG8_STAGE(PG8_SA(1, 0), cA + kstep, voffA); PG8_STAGE(PG8_SB(1, 1), cB + hstep + kstep, voffB);
        PG8_WAIT_V(6); PG8_BAR;
    }
    for (;;) {
        const bool has_next = S.next(ui + 1, nxt);
        const char* nA = has_next ? (const char*)g.A + (size_t)nxt.pm * tstep : cA; const char* nB = has_next ? (const char*)g.Bt + (size_t)nxt.pn * tstep : cB;
        for (int t = 0; t < nt; t += 2) {
            const bool last = (t == nt - 2);
            const char* a1 = cA + (size_t)(t + 1) * kstep;
            const char* a2 = last ? nA : cA + (size_t)(t + 2) * kstep; const char* b2 = last ? nB : cB + (size_t)(t + 2) * kstep;
            const char* a3 = a2 + kstep; const char* b3 = b2 + kstep;
            if (last && has_next) S.a_ready(nxt);
            if constexpr (SP2) {
            PG8_LDB(B0, 0, 0); PG8_LDB(B1, 0, 1); PG8_SCHED; PG8_LDA(At, 0, 0); PG8_STAGE(PG8_SA(1, 1), a1 + hstep, voffA);
            PG8_WAIT_V(8); PG8_WAIT_L(0); PG8_BAR; PG8_MMA(0, 0, At, B0); PG8_MMA(0, 1, At, B1); PG8_BAR; PG8_SCHED;
            PG8_LDA(At, 0, 1); PG8_STAGE(PG8_SB(0, 0), b2, voffB); PG8_STAGE(PG8_SB(0, 1), b2 + hstep, voffB); PG8_STAGE(PG8_SA(0, 0), a2, voffA);
            PG8_WAIT_V(8); PG8_WAIT_L(0); PG8_BAR; PG8_MMA(1, 0, At, B0); PG8_MMA(1, 1, At, B1); PG8_BAR; PG8_SCHED;
            PG8_LDB(B0, 1, 0); PG8_LDB(B1, 1, 1); PG8_SCHED; PG8_LDA(At, 1, 0); PG8_STAGE(PG8_SA(0, 1), a2 + hstep, voffA);
            PG8_WAIT_V(8); PG8_WAIT_L(0); PG8_BAR; PG8_MMA(0, 0, At, B0); PG8_MMA(0, 1, At, B1); PG8_BAR; PG8_SCHED;
            PG8_LDA(At, 1, 1); PG8_STAGE(PG8_SB(1, 0), b3, voffB); PG8_STAGE(PG8_SB(1, 1), b3 + hstep, voffB); PG8_STAGE(PG8_SA(1, 0), a3, voffA);
            PG8_WAIT_V(8); PG8_WAIT_L(0); PG8_BAR; PG8_MMA(1, 0, At, B0); PG8_MMA(1, 1, At, B1); PG8_BAR; PG8_SCHED;
            } else {
            PG8_LDB(B0, 0, 0); PG8_SCHED; PG8_LDA(At, 0, 0); PG8_STAGE(PG8_SA(1, 1), a1 + hstep, voffA);
            PG8_WAIT_L(8); PG8_BAR; PG8_WAIT_L(0); PG8_MMA(0, 0, At, B0); PG8_BAR; PG8_SCHED;
            PG8_LDB(B1, 0, 1); PG8_STAGE(PG8_SB(0, 0), b2, voffB);
            PG8_BAR; PG8_WAIT_L(0); PG8_MMA(0, 1, At, B1); PG8_BAR;
            PG8_LDA(At, 0, 1); PG8_STAGE(PG8_SA(0, 0), a2, voffA);
            PG8_BAR; PG8_WAIT_L(0); PG8_MMA(1, 0, At, B0); PG8_BAR; PG8_SCHED;
            PG8_STAGE(PG8_SB(0, 1), b2 + hstep, voffB);
            PG8_WAIT_V(6); PG8_BAR; PG8_MMA(1, 1, At, B1); PG8_BAR;
            PG8_LDB(B0, 1, 0); PG8_SCHED; PG8_LDA(At, 1, 0); PG8_STAGE(PG8_SA(0, 1), a2 + hstep, voffA);
            PG8_WAIT_L(8); PG8_BAR; PG8_WAIT_L(0); PG8_MMA(0, 0, At, B0); PG8_BAR; PG8_SCHED;
            PG8_LDB(B1, 1, 1); PG8_STAGE(PG8_SB(1, 0), b3, voffB);
            PG8_BAR; PG8_WAIT_L(0); PG8_MMA(0, 1, At, B1); PG8_BAR;
            PG8_LDA(At, 1, 1); PG8_STAGE(PG8_SA(1, 0), a3, voffA);
            PG8_BAR; PG8_WAIT_L(0); PG8_MMA(1, 0, At, B0); PG8_BAR; PG8_SCHED;
            PG8_STAGE(PG8_SB(1, 1), b3 + hstep, voffB);
            PG8_WAIT_V(6); PG8_BAR; PG8_MMA(1, 1, At, B1); PG8_BAR;
            }
        }
        if constexpr (ALIGN_EPI) { if (wr == 0) PG8_BAR; }
        if constexpr (!Epi::AFTER_DRAIN) { E(acc, cur, wr, wc, fr, fq); S.done(cur); }
        if (!has_next) break;
#pragma unroll
        for (int a = 0; a < 2; ++a)
#pragma unroll
            for (int b = 0; b < 2; ++b)
#pragma unroll
                for (int m = 0; m < 4; ++m)
#pragma unroll
                    for (int n = 0; n < 2; ++n) acc[a][b][m][n] = (f32x4){0.f, 0.f, 0.f, 0.f};
        cur = nxt; cA = nA; cB = nB; ++ui;
        if constexpr (ALIGN_EPI) { if (wr == 1) PG8_BAR; }
    }
    PG8_WAIT_V(0);
    if constexpr (!ALIGN_EPI) { if (wr == 0) PG8_BAR; }
    PG8_BAR;
    if constexpr (Epi::AFTER_DRAIN) { E.fused(acc, cur, wr, wc, fr, fq, lds, wid, lane); S.done(cur); }
#undef PG8_SA
#undef PG8_SB
#undef PG8_STAGE
#undef PG8_LDA
#undef PG8_LDB
#undef PG8_MMA
#undef PG8_WAIT_V
#undef PG8_WAIT_L
#undef PG8_BAR
#undef PG8_SCHED
}
}
namespace att {
using bf16x8 = __attribute__((ext_vector_type(8))) short;
using s16x4  = __attribute__((ext_vector_type(4))) short;
using f32x16 = __attribute__((ext_vector_type(16))) float;
using u32x4  = __attribute__((ext_vector_type(4))) unsigned;
typedef unsigned short bf16;
constexpr int DQ = 64, DV = 128, NW = 8, QBLK = 32, KVBLK = 64, LDR = 3072;
constexpr int SHM_V = KVBLK * DV * 2, SHM_K = KVBLK * DQ * 2, SHM_ATTN = 3 * SHM_V + 3 * SHM_K + NW * 64 * 4 + 64;
constexpr int SHM_ATTN_ALL = SHM_ATTN + NW * QBLK * DV * 2;
#ifndef ATT_OVF_LIMIT
#define ATT_OVF_LIMIT 1.152921504606847e18f
#endif
#ifndef ATT_SDEPTH
#define ATT_SDEPTH 2
#endif
constexpr float THR2 = 11.0f;
#define KSWZ64(row, colB) ((row) * 128 + ((colB) ^ ((((row) >> 1) & 7) << 4)))
#define SBAR() __builtin_amdgcn_sched_barrier(0)
template <int K> __device__ __forceinline__ float sx(float v) { return __builtin_bit_cast(float, __builtin_amdgcn_ds_swizzle(__builtin_bit_cast(int, v), (K << 10) | 0x1f)); }
__device__ __forceinline__ int crow(int r, int hi) { return (r & 3) + 8 * (r >> 2) + 4 * hi; }
__device__ __forceinline__ unsigned cvtpk(float lo, float hi) { unsigned r; asm volatile("v_cvt_pk_bf16_f32 %0, %1, %2" : "=v"(r) : "v"(lo), "v"(hi)); return r; }
__device__ __forceinline__ void partialSM(f32x16& p0, f32x16& p1, float& m_reg, float& mn, float& alpha) {
  float pmax = p0[0];
#pragma unroll
  for (int r = 1; r < 16; ++r) pmax = fmaxf(pmax, p0[r]);
#pragma unroll
  for (int r = 0; r < 16; ++r) pmax = fmaxf(pmax, p1[r]);
  { auto rr = __builtin_amdgcn_permlane32_swap(__float_as_uint(pmax), __float_as_uint(pmax), false, false);
    pmax = fmaxf(__uint_as_float(rr[0]), __uint_as_float(rr[1])); }
  if (__builtin_expect(__all(pmax - m_reg <= THR2), 1)) { mn = m_reg; alpha = 1.f; }
  else { mn = fmaxf(m_reg, pmax); alpha = __builtin_amdgcn_exp2f(m_reg - mn); m_reg = mn; }
#pragma unroll
  for (int r = 0; r < 16; ++r) p0[r] = p0[r] - mn;
#pragma unroll
  for (int r = 0; r < 16; ++r) p1[r] = p1[r] - mn;
#pragma unroll
  for (int r = 0; r < 16; ++r) p0[r] = __builtin_amdgcn_exp2f(p0[r]);
}
__device__ __forceinline__ void finishSM(f32x16& p0, f32x16& p1, float alpha, float& l_reg, bf16x8& pa0, bf16x8& pa1, bf16x8& pa2, bf16x8& pa3) {
#pragma unroll
  for (int r = 0; r < 16; ++r) p1[r] = __builtin_amdgcn_exp2f(p1[r]);
  float ps = 0;
#pragma unroll
  for (int r = 0; r < 16; ++r) ps += p0[r];
#pragma unroll
  for (int r = 0; r < 16; ++r) ps += p1[r];
  { auto rr = __builtin_amdgcn_permlane32_swap(__float_as_uint(ps), __float_as_uint(ps), false, false);
    ps = __uint_as_float(rr[0]) + __uint_as_float(rr[1]); }
  l_reg = l_reg * alpha + ps;
#define PK4(P, BASE, OUT) do { unsigned a0 = cvtpk(P[BASE + 0], P[BASE + 1]), a1 = cvtpk(P[BASE + 2], P[BASE + 3]);   \
    unsigned b0 = cvtpk(P[BASE + 4], P[BASE + 5]), b1 = cvtpk(P[BASE + 6], P[BASE + 7]);                              \
    auto r0 = __builtin_amdgcn_permlane32_swap(a0, b0, false, false); auto r1 = __builtin_amdgcn_permlane32_swap(a1, b1, false, false); \
    u32x4 w = {r0[0], r1[0], r0[1], r1[1]}; OUT = *reinterpret_cast<bf16x8*>(&w); } while (0)
  PK4(p0, 0, pa0); PK4(p0, 8, pa1); PK4(p1, 0, pa2); PK4(p1, 8, pa3);
#undef PK4
}
__device__ __forceinline__ void qkt(f32x16& p0, f32x16& p1, const char* Ks, const bf16x8* qr, int r32, int hi) {
  p0 = f32x16{}; p1 = f32x16{};
#pragma unroll
  for (int d0 = 0; d0 < 4; ++d0) { const int cb = (d0 * 16 + hi * 8) * 2;
    bf16x8 b0 = *reinterpret_cast<const bf16x8*>(Ks + KSWZ64(r32, cb));
    bf16x8 b1 = *reinterpret_cast<const bf16x8*>(Ks + KSWZ64(32 + r32, cb));
    p0 = __builtin_amdgcn_mfma_f32_32x32x16_bf16(b0, qr[d0], p0, 0, 0, 0);
    p1 = __builtin_amdgcn_mfma_f32_32x32x16_bf16(b1, qr[d0], p1, 0, 0, 0); }
}
__device__ __forceinline__ void qkt_ref(f32x16& p0, f32x16& p1, const char* Ks, const bf16x8* qr, const f32x16& negm, int r32, int hi) {
#pragma unroll
  for (int d0 = 0; d0 < 4; ++d0) { const int cb = (d0 * 16 + hi * 8) * 2;
    bf16x8 b0 = *reinterpret_cast<const bf16x8*>(Ks + KSWZ64(r32, cb));
    bf16x8 b1 = *reinterpret_cast<const bf16x8*>(Ks + KSWZ64(32 + r32, cb));
    if (d0 == 0) { p0 = __builtin_amdgcn_mfma_f32_32x32x16_bf16(b0, qr[0], negm, 0, 0, 0); p1 = __builtin_amdgcn_mfma_f32_32x32x16_bf16(b1, qr[0], negm, 0, 0, 0); }
    else { p0 = __builtin_amdgcn_mfma_f32_32x32x16_bf16(b0, qr[d0], p0, 0, 0, 0); p1 = __builtin_amdgcn_mfma_f32_32x32x16_bf16(b1, qr[d0], p1, 0, 0, 0); } }
}
__device__ __forceinline__ void exp_half(f32x16& p) {
#pragma unroll
  for (int r = 0; r < 16; ++r) p[r] = __builtin_amdgcn_exp2f(p[r]);
}
__device__ __forceinline__ void sub_exp_half(f32x16& p0, f32x16& p1, float m) {
#pragma unroll
  for (int r = 0; r < 16; ++r) p0[r] = p0[r] - m;
#pragma unroll
  for (int r = 0; r < 16; ++r) p1[r] = p1[r] - m;
#pragma unroll
  for (int r = 0; r < 16; ++r) p0[r] = __builtin_amdgcn_exp2f(p0[r]);
}
__device__ __forceinline__ void finishSM_fast(f32x16& p0, f32x16& p1, float& l_reg, bool& ovf, bf16x8& pa0, bf16x8& pa1, bf16x8& pa2, bf16x8& pa3) {
  float al = 1.f; float l0 = 0.f;
  finishSM(p0, p1, al, l0, pa0, pa1, pa2, pa3);
  ovf = ovf || !(l0 < ATT_OVF_LIMIT);
  l_reg += l0;
}
__device__ __forceinline__ int v_st(int k, int c) { const int kk = (k & ~0xC) | ((k & 4) << 1) | ((k & 8) >> 1); return ((kk >> 3) * 4 + (c >> 5)) * 512 + ((kk & 7) * 32 + (c & 31)) * 2; }
__device__ __forceinline__ int v_rd_base(int lane) { return ((lane & 3) << 3) | (((lane >> 2) & 3) << 6) | (((lane >> 4) & 1) << 5) | (((lane >> 5) & 1) << 8); }
constexpr int v_rd_off(int d0, int ks, int half) { return d0 * 512 + ks * 4096 + half * 2048; }
template <int OFF> __device__ __forceinline__ s16x4 tr_read(int vb) {
  s16x4 r; asm volatile("ds_read_b64_tr_b16 %0, %1 offset:%2" : "=&v"(r) : "v"(vb), "i"(OFF) : "memory"); return r;
}
template <int D0> __device__ __forceinline__ void pv_one(f32x16& od, int vb, bf16x8 pa0, bf16x8 pa1, bf16x8 pa2, bf16x8 pa3) {
  const s16x4 l0 = tr_read<v_rd_off(D0, 0, 0)>(vb), h0 = tr_read<v_rd_off(D0, 0, 1)>(vb), l1 = tr_read<v_rd_off(D0, 1, 0)>(vb), h1 = tr_read<v_rd_off(D0, 1, 1)>(vb);
  const s16x4 l2 = tr_read<v_rd_off(D0, 2, 0)>(vb), h2 = tr_read<v_rd_off(D0, 2, 1)>(vb), l3 = tr_read<v_rd_off(D0, 3, 0)>(vb), h3 = tr_read<v_rd_off(D0, 3, 1)>(vb);
  asm volatile("s_waitcnt lgkmcnt(0)" ::: "memory"); SBAR();
#define PK(L, H) (bf16x8){L[0], L[1], L[2], L[3], H[0], H[1], H[2], H[3]}
  od = __builtin_amdgcn_mfma_f32_32x32x16_bf16(pa0, PK(l0, h0), od, 0, 0, 0);
  od = __builtin_amdgcn_mfma_f32_32x32x16_bf16(pa1, PK(l1, h1), od, 0, 0, 0);
  od = __builtin_amdgcn_mfma_f32_32x32x16_bf16(pa2, PK(l2, h2), od, 0, 0, 0);
  od = __builtin_amdgcn_mfma_f32_32x32x16_bf16(pa3, PK(l3, h3), od, 0, 0, 0);
#undef PK
}
__device__ __forceinline__ void pv_d0(f32x16* o, int vb, bf16x8 pa0, bf16x8 pa1, bf16x8 pa2, bf16x8 pa3) {
  pv_one<0>(o[0], vb, pa0, pa1, pa2, pa3); pv_one<1>(o[1], vb, pa0, pa1, pa2, pa3); pv_one<2>(o[2], vb, pa0, pa1, pa2, pa3); pv_one<3>(o[3], vb, pa0, pa1, pa2, pa3);
}
__device__ __forceinline__ void glds16(const void* gsrc, unsigned lds_dst) { unsigned keep;
  asm volatile("s_mov_b32 %0, m0\n\ts_mov_b32 m0, %2\n\ts_nop 0\n\tglobal_load_lds_dwordx4 %1, off\n\ts_mov_b32 m0, %0" : "=&s"(keep) : "v"(gsrc), "s"(lds_dst) : "memory"); }
template <bool FAST>
__device__ __forceinline__ bool attn_map(const bf16* __restrict__ Kh, const bf16* __restrict__ Vh, const bf16* __restrict__ Qh  , int seq, char* V_lds, char* K_lds, float* ws_base,
                                         f32x16 (&o)[4], float& l_out) {
    int tid = threadIdx.x; asm volatile("" : "+v"(tid));
    const int wid = __builtin_amdgcn_readfirstlane(tid >> 6), r32 = tid & 31, hi = (tid >> 5) & 1;
    float* al_l = ws_base + wid * 64 + 32;
    const bf16* Qw = Qh + (long)(wid * QBLK + r32) * LDR + hi * 8;
    const int lane_ = tid & 63;
    const unsigned lds0 = (unsigned)(uintptr_t)V_lds;
    const bf16 *vsrc0, *vsrc1, *ksrc;
    { const int o0 = (2 * wid) * 1024 + 16 * lane_, o1 = o0 + 1024, ok = wid * 1024 + 16 * lane_;
      auto vmap = [](int o, int& k, int& c) { const int sub = o >> 9, w = o & 511, kk = ((sub >> 2) << 3) | (w >> 6); k = (kk & ~0xC) | ((kk & 4) << 1) | ((kk & 8) >> 1); c = (sub & 3) * 32 + ((w & 63) >> 1); };
      int k0_, c0_, k1_, c1_; vmap(o0, k0_, c0_); vmap(o1, k1_, c1_);
      vsrc0 = Vh + (long)k0_ * LDR + c0_; vsrc1 = Vh + (long)k1_ * LDR + c1_;
      const int row = ok >> 7, cb = (ok & 127) ^ (((row >> 1) & 7) << 4);
      ksrc = Kh + (long)row * LDR + (cb >> 1); }
    const int vb0 = (int)(uintptr_t)V_lds + v_rd_base(tid & 63);
    float m_reg = -1e30f, l_reg = 0; bf16x8 qr[4]; bool ovf = false;
#pragma unroll
    for (int d0 = 0; d0 < 4; ++d0) { o[d0] = f32x16{}; qr[d0] = *reinterpret_cast<const bf16x8*>(Qw + d0 * 16); }
#define DMA_TILE(t, b) do { const long ro_ = (long)(t) * KVBLK * LDR; \
      glds16(vsrc0 + ro_, (unsigned)__builtin_amdgcn_readfirstlane(lds0 + (b) * SHM_V + (2 * wid) * 1024)); \
      glds16(vsrc1 + ro_, (unsigned)__builtin_amdgcn_readfirstlane(lds0 + (b) * SHM_V + (2 * wid + 1) * 1024)); \
      glds16(ksrc + ro_, (unsigned)__builtin_amdgcn_readfirstlane(lds0 + 3 * SHM_V + (b) * SHM_K + wid * 1024)); } while (0)
#define DMA_WAIT() asm volatile("s_waitcnt vmcnt(0)" ::: "memory")
#define RESC(a) do { if constexpr (!FAST) { if (__any((a) < 1.f)) { if (hi == 0) al_l[r32] = (a); asm volatile("s_waitcnt lgkmcnt(0)" ::: "memory"); \
    _Pragma("unroll") for (int d = 0; d < 4; ++d) _Pragma("unroll") for (int r = 0; r < 16; ++r) o[d][r] *= al_l[crow(r, hi)]; } } } while (0)
#define PSM(P0, P1, MN, AL) do { if constexpr (FAST) exp_half(P0); else partialSM(P0, P1, m_reg, MN, AL); } while (0)
#define FSM(P0, P1, AL) do { if constexpr (FAST) finishSM_fast(P0, P1, l_reg, ovf, pa0, pa1, pa2, pa3); else finishSM(P0, P1, AL, l_reg, pa0, pa1, pa2, pa3); } while (0)
#define STEP(PN0, PN1, MNN, ALN, PO0, PO1, ALO, jj) do { \
      SBAR(); if constexpr (FAST) qkt_ref(PN0, PN1, K_lds + bc * SHM_K, qr, negm, r32, hi); else qkt(PN0, PN1, K_lds + bc * SHM_K, qr, r32, hi); \
      if ((jj) + 1 < NT) DMA_TILE((jj) + 1, bn);              \
      FSM(PO0, PO1, ALO); SBAR(); \
      pv_d0(o, vb0 + bp * SHM_V, pa0, pa1, pa2, pa3); PSM(PN0, PN1, MNN, ALN); RESC(ALN); \
      DMA_WAIT(); __syncthreads(); \
      bp = bc; bc = bn; bn = (bn == 2) ? 0 : bn + 1; } while (0)
    f32x16 pA0, pA1, pB0, pB1; float mnA = 0.f, mnB = 0.f, alA = 1.f, alB = 1.f; bf16x8 pa0, pa1, pa2, pa3; const int NT = seq / KVBLK;
    DMA_TILE(0, 0); DMA_WAIT(); __syncthreads();
    if (1 < NT) DMA_TILE(1, 1);
    qkt(pA0, pA1, K_lds, qr, r32, hi); partialSM(pA0, pA1, m_reg, mnA, alA);
    f32x16 negm = f32x16{};
    if constexpr (FAST) {
#pragma unroll
      for (int r = 0; r < 16; ++r) negm[r] = -m_reg;
      asm volatile("" : "+v"(negm));
    }
    DMA_WAIT(); __syncthreads();
    int bp = 0, bc = 1, bn = 2;
    for (int j = 1; j + 1 < NT; j += 2) {
      STEP(pB0, pB1, mnB, alB, pA0, pA1, alA, j);
      STEP(pA0, pA1, mnA, alA, pB0, pB1, alB, j + 1);
    }
    STEP(pB0, pB1, mnB, alB, pA0, pA1, alA, NT - 1);
    FSM(pB0, pB1, alB); SBAR();
    pv_d0(o, vb0 + bp * SHM_V, pa0, pa1, pa2, pa3);
#undef DMA_TILE
#undef DMA_WAIT
#undef RESC
#undef PSM
#undef FSM
#undef STEP
    l_out = l_reg;
    return ovf;
}
__device__ __forceinline__ void attn_unit(const bf16* __restrict__ qkv, long Qrow0, long Krow0, int vh, int seq, float lam, float oscale, const float* __restrict__ subln,
                                          bf16* __restrict__ Ob, int ldo, float* stash, char* lds) {
  int tid = threadIdx.x; asm volatile("" : "+v"(tid));
  const int wid = __builtin_amdgcn_readfirstlane(tid >> 6), lane = tid & 63, r32 = lane & 31, hi = lane >> 5;
  char* V_lds = lds; char* K_lds = lds + 3 * SHM_V;
  float* wsb = (float*)(lds + 3 * SHM_V + 3 * SHM_K); float* li_l = wsb + wid * 64;
  volatile unsigned* ovw = (volatile unsigned*)(lds + 3 * SHM_V + 3 * SHM_K + NW * 64 * 4);
  const bf16* Vh = qkv + Krow0 * LDR + 2048 + vh * DV;
  for (int s = 0; s < 2; ++s) {
    const int head = 2 * vh + s;
    const bf16* Kh = qkv + Krow0 * LDR + 1024 + head * DQ;
    const bf16* Qh = qkv + Qrow0 * LDR + head * DQ;
    f32x16 o[4]; float l_reg;
    const bool ovf = attn_map<true>(Kh, Vh, Qh, seq, V_lds, K_lds, wsb, o, l_reg);
    if (lane == 0) ovw[wid] = __any(ovf) ? 1u : 0u;
    __syncthreads();
    unsigned anyovf = 0u;
#pragma unroll
    for (int w = 0; w < NW; ++w) anyovf |= ovw[w];
    __syncthreads();
    if (__builtin_amdgcn_readfirstlane(anyovf) != 0u) (void)attn_map<false>(Kh, Vh, Qh, seq, V_lds, K_lds, wsb, o, l_reg);
    if (hi == 0) li_l[r32] = l_reg; asm volatile("s_waitcnt lgkmcnt(0)" ::: "memory");
    float rli[16];
#pragma unroll
    for (int r = 0; r < 16; ++r) rli[r] = __builtin_amdgcn_rcpf(li_l[crow(r, hi)]);
    typedef float f32x4_t __attribute__((ext_vector_type(4)));
    f32x4_t* st4 = (f32x4_t*)stash + (size_t)tid * 16;
    if (s == 0) {
#pragma unroll
      for (int d0 = 0; d0 < 4; ++d0)
#pragma unroll
        for (int r4 = 0; r4 < 4; ++r4) { f32x4_t v; v[0] = o[d0][4 * r4] * rli[4 * r4]; v[1] = o[d0][4 * r4 + 1] * rli[4 * r4 + 1]; v[2] = o[d0][4 * r4 + 2] * rli[4 * r4 + 2]; v[3] = o[d0][4 * r4 + 3] * rli[4 * r4 + 3]; st4[d0 * 4 + r4] = v; }
    } else {
      float ssq[16];
#pragma unroll
      for (int r = 0; r < 16; ++r) ssq[r] = 0.f;
#pragma unroll
      for (int d0 = 0; d0 < 4; ++d0)
#pragma unroll
        for (int r4 = 0; r4 < 4; ++r4) { const f32x4_t sv = st4[d0 * 4 + r4];
#pragma unroll
          for (int i = 0; i < 4; ++i) { const int r = 4 * r4 + i; const float v = sv[i] - lam * (o[d0][r] * rli[r]); o[d0][r] = v; ssq[r] += v * v; } }
#pragma unroll
      for (int r = 0; r < 16; ++r) {
        float a = ssq[r];
        a += sx<1>(a); a += sx<2>(a); a += sx<4>(a); a += sx<8>(a); a += sx<16>(a);
        ssq[r] = oscale / sqrtf(a * (1.0f / 128.0f) + 1e-6f);
      }
      float g[4];
#pragma unroll
      for (int d0 = 0; d0 < 4; ++d0) g[d0] = subln[d0 * 32 + r32];
      bf16* stg = (bf16*)(lds + SHM_ATTN) + wid * (QBLK * DV);
      unsigned so = (unsigned)((4 * hi) * DV + r32); asm volatile("" : "+v"(so));
#pragma unroll
      for (int r = 0; r < 16; ++r) {
#pragma unroll
        for (int d0 = 0; d0 < 4; ++d0) { const unsigned w = cvtpk(o[d0][r] * ssq[r] * g[d0], 0.f); (stg + ((r & 3) + 8 * (r >> 2)) * DV + d0 * 32)[so] = (bf16)(w & 0xffffu); } }
      asm volatile("s_waitcnt lgkmcnt(0)" ::: "memory");
      int ldo_ = ldo; asm volatile("" : "+s"(ldo_));
      bf16* Ow = Ob + (long)(wid * QBLK) * ldo_;
      const int srow = lane >> 4, sch = lane & 15;
#pragma unroll
      for (int i = 0; i < 8; ++i) { const int row = i * 4 + srow; const u32x4 v = *(const u32x4*)(stg + row * DV + sch * 8); *(u32x4*)(Ow + (long)row * ldo_ + sch * 8) = v; }
    }
  }
}
#undef SBAR
}
#define GAS __attribute__((address_space(1)))
#define LAS __attribute__((address_space(3)))
typedef unsigned short bf16;
typedef unsigned v4u __attribute__((ext_vector_type(4)));
typedef float f32x4 __attribute__((ext_vector_type(4)));
typedef short bf16x8 __attribute__((ext_vector_type(8)));
typedef GAS unsigned gu32;
typedef GAS unsigned long long gu64;
#define RLX_AGENT __ATOMIC_RELAXED, __HIP_MEMORY_SCOPE_AGENT
#define LDS_WAIT() asm volatile("s_waitcnt lgkmcnt(0)" ::: "memory")
#define VM_WAIT() asm volatile("s_waitcnt vmcnt(0)" ::: "memory")
__device__ __forceinline__ unsigned long long rt() { return __builtin_amdgcn_s_memrealtime(); }
__device__ __forceinline__ unsigned f2bf(float f) { unsigned u = __builtin_bit_cast(unsigned, f); return (u + 0x7fffu + ((u >> 16) & 1u)) >> 16; }
__device__ __forceinline__ unsigned pk2(float lo, float hi) { unsigned r; asm("v_cvt_pk_bf16_f32 %0, %1, %2" : "=v"(r) : "v"(lo), "v"(hi)); return r; }

#define XB_TMO      128
#define XB_XCNT(j)  (256  + 64 * (j))
#define XB_XSUB(j)  (1280 + 64 * (j))
#define XB_XGEN(j)  (2304 + 64 * (j))
#define XB_TOP      3328
#define XB_TOPGEN   3392
#define XCD_BAR_WORDS 3456
#define XB_SPIN_CAP (1u << 18)

__device__ __forceinline__ unsigned xb_ld(unsigned* p)              { return __hip_atomic_load(p, __ATOMIC_RELAXED, __HIP_MEMORY_SCOPE_AGENT); }
__device__ __forceinline__ unsigned xb_add(unsigned* p, unsigned v) { return __hip_atomic_fetch_add(p, v, __ATOMIC_RELAXED, __HIP_MEMORY_SCOPE_AGENT); }
__device__ __forceinline__ unsigned xb_xcc_id() { return (unsigned)__builtin_amdgcn_s_getreg((3 << 11) | 20) & 0xFu; }
#define XB_SPIN(cond, bar) do { unsigned _sp = 0; while (cond) { __builtin_amdgcn_s_sleep(1); \
    if ((++_sp & 255u) == 0u) { if (xb_ld(&(bar)[XB_TMO])) break; if (_sp > XB_SPIN_CAP) { atomicAdd(&(bar)[XB_TMO], 1u); break; } } } } while (0)

struct XcdBarrier {
    unsigned* bar; unsigned x;
    volatile LAS unsigned* st;
};

__device__ __forceinline__ XcdBarrier xcd_barrier_post(unsigned* bar, volatile LAS unsigned* st) {
    XcdBarrier b; b.bar = bar; b.x = xb_xcc_id(); b.st = st;
    if (threadIdx.x == 0) (void)xb_add(&bar[XB_XCNT(b.x)], 1u);
    return b;
}
__device__ __forceinline__ void xcd_barrier_complete(unsigned* bar, unsigned x, unsigned& nloc, unsigned& nx) {
    const unsigned G = gridDim.x * gridDim.y * gridDim.z;
    unsigned sum, cnt, mine, sp = 0u;
    for (;;) {
        sum = 0u; cnt = 0u; mine = 0u;
#pragma unroll
        for (unsigned j = 0; j < 16; ++j) { const unsigned c = xb_ld(&bar[XB_XCNT(j)]); sum += c; cnt += (c > 0u) ? 1u : 0u; mine = (j == x) ? c : mine; }
        if (sum == G) break;
        __builtin_amdgcn_s_sleep(1);
        if ((++sp & 255u) == 0u) { if (xb_ld(&bar[XB_TMO])) break; if (sp > XB_SPIN_CAP) { atomicAdd(&bar[XB_TMO], 1u); break; } }
    }
    nloc = mine > 0u ? mine : 1u; nx = cnt > 0u ? cnt : 1u;
}

__device__ __forceinline__ void xcd_barrier(const XcdBarrier& b) {
    asm volatile("s_waitcnt vmcnt(0)" ::: "memory");
    __syncthreads();
    if (threadIdx.x == 0) {
        unsigned* bar = b.bar;
        __builtin_amdgcn_s_waitcnt(0);
        unsigned nloc = b.st[0], nx = b.st[1];
        if (nloc == 0u) { xcd_barrier_complete(bar, b.x, nloc, nx); b.st[0] = nloc; b.st[1] = nx; }
        const unsigned old = xb_add(&bar[XB_XSUB(b.x)], 1u);
        const unsigned gen = old / nloc;
        if (old + 1u == (gen + 1u) * nloc) {
            __builtin_amdgcn_fence(__ATOMIC_RELEASE, "agent");
            asm volatile("s_waitcnt vmcnt(0)" ::: "memory");
            const unsigned og = xb_add(&bar[XB_TOP], 1u);
            const unsigned tg = og / nx;
            if (og + 1u == (tg + 1u) * nx) xb_add(&bar[XB_TOPGEN], 1u);
            else XB_SPIN(xb_ld(&bar[XB_TOPGEN]) == tg, bar);
            __builtin_amdgcn_fence(__ATOMIC_ACQUIRE, "agent");
            xb_add(&bar[XB_XGEN(b.x)], 1u);
            asm volatile("s_waitcnt vmcnt(0)" ::: "memory");
        } else {
            XB_SPIN(xb_ld(&bar[XB_XGEN(b.x)]) == gen, bar);
            __builtin_amdgcn_fence(__ATOMIC_ACQUIRE, "agent");
            asm volatile("s_waitcnt vmcnt(0)" ::: "memory");
        }
    }
    __syncthreads();
}
#define HYD __device__ __forceinline__
#define HYDM __device__ __forceinline__
#define HY_DEVICE 1
#ifdef HY_DEVICE
#define HY_OPAQUE(x) asm volatile("" : "+v"(x))
#else
#define HY_OPAQUE(x) (void)(x)
#endif
typedef float cf __attribute__((ext_vector_type(2)));
typedef float cf2 __attribute__((ext_vector_type(4)));
template <class P> struct HyP2 {};
template <> struct HyP2<cf*> { typedef cf2* type; };
#ifdef HY_DEVICE
template <> struct HyP2<__attribute__((address_space(3))) cf*> { typedef __attribute__((address_space(3))) cf2* type; };
#endif
HYD cf cf_add(cf a, cf b) { return a + b; }
HYD cf cf_sub(cf a, cf b) { return a - b; }
HYD cf cf_mul(cf a, cf b) { return cf{a.x * b.x - a.y * b.y, a.x * b.y + a.y * b.x}; }
HYD cf cf_mulc(cf a, cf b) { return cf{a.x * b.x + a.y * b.y, a.y * b.x - a.x * b.y}; }
constexpr int FN = 16384, FT = 512, FLOG = 14, FNP = FN + 4 * (FN >> 6);
constexpr int SEQL = 8192;
HYD int HP(int i) { return i + ((i >> 6) << 2); }
#define HY_C1 0.92387953251128674f
#define HY_S1 0.38268343236508977f
#define HY_R2 0.70710678118654752f
template <int M16> HYD cf mul_root16(cf w) {
    if (M16 == 0) return w;
    if (M16 == 4) return cf{w.y, -w.x};
    if (M16 == 2) return cf{(w.x + w.y) * HY_R2, (w.y - w.x) * HY_R2};
    if (M16 == 6) return cf{(w.y - w.x) * HY_R2, -(w.x + w.y) * HY_R2};
    if (M16 == 1) return cf_mul(w, cf{HY_C1, -HY_S1});
    if (M16 == 3) return cf_mul(w, cf{HY_S1, -HY_C1});
    if (M16 == 5) return cf_mul(w, cf{-HY_S1, -HY_C1});
    return cf_mul(w, cf{-HY_C1, -HY_S1});
}
template <int Q, int U, bool INV, bool ZUP, bool HLO> struct HyStage {
    static HYDM void run(cf (&e)[1 << Q], const cf (&tw)[Q]) {
        constexpr int R = 1 << Q, half = R >> (U + 1);
#pragma unroll
        for (int k = 0; k < R; ++k) {
            if ((k & half) == 0) {
                const int kp = k & (half - 1);
                cf w = tw[U];
                switch (kp * 16 / (2 * half)) {
                    case 0: break;
                    case 1: w = mul_root16<1>(w); break;
                    case 2: w = mul_root16<2>(w); break;
                    case 3: w = mul_root16<3>(w); break;
                    case 4: w = mul_root16<4>(w); break;
                    case 5: w = mul_root16<5>(w); break;
                    case 6: w = mul_root16<6>(w); break;
                    default: w = mul_root16<7>(w); break;
                }
                if (!INV) {
                    if (ZUP && U == 0) { e[k + half] = cf_mul(e[k], w); }
                    else { const cf a = e[k], b = e[k + half]; e[k] = cf_add(a, b); e[k + half] = cf_mul(cf_sub(a, b), w); }
                } else {
                    const cf a = e[k], b = cf_mulc(e[k + half], w); e[k] = cf_add(a, b);
                    if (!(HLO && U == 0)) e[k + half] = cf_sub(a, b);
                }
            }
        }
    }
};
template <int Q, bool INV, bool ZUP, bool HLO> HYD void hy_bfly(cf (&e)[1 << Q], cf t) {
    cf tw[Q]; tw[0] = t;
#pragma unroll
    for (int u = 1; u < Q; ++u) tw[u] = cf_mul(tw[u - 1], tw[u - 1]);
    if (Q == 4) {
        if (!INV) { HyStage<Q, 0, INV, ZUP, HLO>::run(e, tw); HyStage<Q, 1, INV, ZUP, HLO>::run(e, tw); HyStage<Q, 2 % Q, INV, ZUP, HLO>::run(e, tw); HyStage<Q, 3 % Q, INV, ZUP, HLO>::run(e, tw); }
        else      { HyStage<Q, 3 % Q, INV, ZUP, HLO>::run(e, tw); HyStage<Q, 2 % Q, INV, ZUP, HLO>::run(e, tw); HyStage<Q, 1, INV, ZUP, HLO>::run(e, tw); HyStage<Q, 0, INV, ZUP, HLO>::run(e, tw); }
    } else {
        if (!INV) { HyStage<Q, 0, INV, ZUP, HLO>::run(e, tw); HyStage<Q, 1, INV, ZUP, HLO>::run(e, tw); }
        else      { HyStage<Q, 1, INV, ZUP, HLO>::run(e, tw); HyStage<Q, 0, INV, ZUP, HLO>::run(e, tw); }
    }
}
#ifdef HY_DEVICE
#define HY_MULT(T, X, Y) "v_pk_mul_f32 " T ", " X ", " Y " op_sel:[1,1] op_sel_hi:[1,0]\n\t"
#define HY_FMAP(R, X, Y, T) "v_pk_fma_f32 " R ", " X ", " Y ", " T " op_sel_hi:[0,1,1] neg_lo:[0,0,1]\n\t"
#define HY_FMAC(R, X, Y, T) "v_pk_fma_f32 " R ", " X ", " Y ", " T " op_sel_hi:[0,1,1] neg_hi:[1,0,0]\n\t"
#define HY_ADD(R, A, B) "v_pk_add_f32 " R ", " A ", " B "\n\t"
#define HY_SUB(R, A, B) "v_pk_add_f32 " R ", " A ", " B " neg_lo:[0,1] neg_hi:[0,1]\n\t"
HYD void hy_cmul2(cf& r0, cf x0, cf y0, cf& r1, cf x1, cf y1) { cf t0, t1;
    asm(HY_MULT("%0", "%4", "%5") HY_MULT("%1", "%6", "%7") HY_FMAP("%2", "%4", "%5", "%0") HY_FMAP("%3", "%6", "%7", "%1")
        : "=&v"(t0), "=&v"(t1), "=&v"(r0), "=&v"(r1) : "v"(x0), "v"(y0), "v"(x1), "v"(y1)); }
HYD cf hy_cmul1(cf x, cf y) { cf t, r;
    asm(HY_MULT("%0", "%2", "%3") "s_nop 0\n\t" HY_FMAP("%1", "%2", "%3", "%0") : "=&v"(t), "=&v"(r) : "v"(x), "v"(y)); return r; }
HYD void hy_bf2_fwd(cf& a0, cf& b0, cf w0, cf& a1, cf& b1, cf w1) { cf d0, d1, t0, t1;
    asm(HY_SUB("%4", "%0", "%1") HY_ADD("%0", "%0", "%1") HY_SUB("%5", "%2", "%3") HY_ADD("%2", "%2", "%3")
        HY_MULT("%6", "%4", "%8") HY_MULT("%7", "%5", "%9") HY_FMAP("%1", "%4", "%8", "%6") HY_FMAP("%3", "%5", "%9", "%7")
        : "+v"(a0), "+v"(b0), "+v"(a1), "+v"(b1), "=&v"(d0), "=&v"(d1), "=&v"(t0), "=&v"(t1) : "v"(w0), "v"(w1)); }
HYD void hy_bf2_fwdz(cf a0, cf& b0, cf w0, cf a1, cf& b1, cf w1) { hy_cmul2(b0, a0, w0, b1, a1, w1); }
HYD void hy_bf2_inv(cf& a0, cf& b0, cf w0, cf& a1, cf& b1, cf w1) { cf t0, t1;
    asm(HY_MULT("%4", "%1", "%6") HY_MULT("%5", "%3", "%7") HY_FMAC("%4", "%1", "%6", "%4") HY_FMAC("%5", "%3", "%7", "%5")
        HY_SUB("%1", "%0", "%4") HY_SUB("%3", "%2", "%5") HY_ADD("%0", "%0", "%4") HY_ADD("%2", "%2", "%5")
        : "+v"(a0), "+v"(b0), "+v"(a1), "+v"(b1), "=&v"(t0), "=&v"(t1) : "v"(w0), "v"(w1)); }
HYD void hy_bf2_invl(cf& a0, cf b0, cf w0, cf& a1, cf b1, cf w1) { cf t0, t1;
    asm(HY_MULT("%2", "%4", "%6") HY_MULT("%3", "%5", "%7") HY_FMAC("%2", "%4", "%6", "%2") HY_FMAC("%3", "%5", "%7", "%3")
        HY_ADD("%0", "%0", "%2") HY_ADD("%1", "%1", "%3")
        : "+v"(a0), "+v"(a1), "=&v"(t0), "=&v"(t1) : "v"(b0), "v"(b1), "v"(w0), "v"(w1)); }
HYD cf hy_rot(cf w) { cf r; asm("v_pk_add_f32 %0, %1, 0 op_sel:[1,0] op_sel_hi:[0,0] neg_hi:[1,0]" : "=v"(r) : "v"(w)); return r; }
#else
HYD void hy_cmul2(cf& r0, cf x0, cf y0, cf& r1, cf x1, cf y1) { const cf p0 = cf_mul(x0, y0), p1 = cf_mul(x1, y1); r0 = p0; r1 = p1; }
HYD cf hy_cmul1(cf x, cf y) { return cf_mul(x, y); }
HYD void hy_bf2_fwd(cf& a0, cf& b0, cf w0, cf& a1, cf& b1, cf w1) { const cf d0 = cf_sub(a0, b0), d1 = cf_sub(a1, b1); a0 = cf_add(a0, b0); a1 = cf_add(a1, b1); b0 = cf_mul(d0, w0); b1 = cf_mul(d1, w1); }
HYD void hy_bf2_fwdz(cf a0, cf& b0, cf w0, cf a1, cf& b1, cf w1) { b0 = cf_mul(a0, w0); b1 = cf_mul(a1, w1); }
HYD void hy_bf2_inv(cf& a0, cf& b0, cf w0, cf& a1, cf& b1, cf w1) { const cf p0 = cf_mulc(b0, w0), p1 = cf_mulc(b1, w1); b0 = cf_sub(a0, p0); b1 = cf_sub(a1, p1); a0 = cf_add(a0, p0); a1 = cf_add(a1, p1); }
HYD void hy_bf2_invl(cf& a0, cf b0, cf w0, cf& a1, cf b1, cf w1) { a0 = cf_add(a0, cf_mulc(b0, w0)); a1 = cf_add(a1, cf_mulc(b1, w1)); }
HYD cf hy_rot(cf w) { return cf{w.y, -w.x}; }
#endif
template <int U, bool INV, bool ZUP, bool HLO> HYD void hy_stage16(cf (&e)[16], const cf* W) {
    constexpr int half = 8 >> U;
#pragma unroll
    for (int j = 0; j < 8; j += 2) {
        const int k0 = ((j / half) * 2 * half) + (j % half), k1 = (((j + 1) / half) * 2 * half) + ((j + 1) % half);
        const cf w0 = W[k0 & (half - 1)], w1 = W[k1 & (half - 1)];
        if (!INV) { if (ZUP && U == 0) hy_bf2_fwdz(e[k0], e[k0 + half], w0, e[k1], e[k1 + half], w1); else hy_bf2_fwd(e[k0], e[k0 + half], w0, e[k1], e[k1 + half], w1); }
        else { if (HLO && U == 0) hy_bf2_invl(e[k0], e[k0 + half], w0, e[k1], e[k1 + half], w1); else hy_bf2_inv(e[k0], e[k0 + half], w0, e[k1], e[k1 + half], w1); }
    }
}
template <bool INV, bool ZUP, bool HLO> HYD void hy_bfly16(cf (&e)[16], cf t) {
    cf W0[8], W1[4], W2[2], W3[1], tw1, tw2;
    cf k1 = cf{HY_C1, -HY_S1}, k2 = cf{HY_R2, -HY_R2}, k3 = cf{HY_S1, -HY_C1};
    W0[0] = t;
    hy_cmul2(W0[1], t, k1, W0[3], t, k3);
    hy_cmul2(W0[2], t, k2, tw1, t, t);
    W1[0] = tw1;
    hy_cmul2(W1[1], tw1, k2, tw2, tw1, tw1);
    W2[0] = tw2;
    W3[0] = hy_cmul1(tw2, tw2);
#pragma unroll
    for (int i = 0; i < 4; ++i) W0[4 + i] = hy_rot(W0[i]);
    W1[2] = hy_rot(W1[0]); W1[3] = hy_rot(W1[1]); W2[1] = hy_rot(W2[0]);
    if (!INV) { hy_stage16<0, INV, ZUP, HLO>(e, W0); hy_stage16<1, INV, ZUP, HLO>(e, W1); hy_stage16<2, INV, ZUP, HLO>(e, W2); hy_stage16<3, INV, ZUP, HLO>(e, W3); }
    else      { hy_stage16<3, INV, ZUP, HLO>(e, W3); hy_stage16<2, INV, ZUP, HLO>(e, W2); hy_stage16<1, INV, ZUP, HLO>(e, W1); hy_stage16<0, INV, ZUP, HLO>(e, W0); }
}
template <class PT> HYD cf hy_twid(PT thi, PT tlo, int e) { return hy_cmul1(thi[e >> 7], tlo[e & 127]); }
template <int S, bool INV, bool ZUP, bool HLO, class P, class PT>
HYD void hy_pass16(P X, PT thi, PT tlo, int tid) {
    constexpr int R = 16;
    constexpr int SP = (S >= 64) ? S + S / 16 : S;
    const int g0 = tid, g1 = tid + FT;
    const int lo0 = g0 & (S - 1), pb0 = HP((g0 / S) * S * R + lo0);
    const int lo1 = g1 & (S - 1), pb1 = HP((g1 / S) * S * R + lo1);
    cf e0[R], e1[R];
#pragma unroll
    for (int k = 0; k < R; ++k) { if (ZUP && k >= 8) e0[k] = cf{0.f, 0.f}; else e0[k] = X[pb0 + k * SP]; }
#pragma unroll
    for (int k = 0; k < R; ++k) { if (ZUP && k >= 8) e1[k] = cf{0.f, 0.f}; else e1[k] = X[pb1 + k * SP]; }
    const cf t0 = hy_twid(thi, tlo, lo0 * (FN / (R * S))), t1 = hy_twid(thi, tlo, lo1 * (FN / (R * S)));
    hy_bfly16<INV, ZUP, HLO>(e0, t0);
#pragma unroll
    for (int k = 0; k < R; ++k) { if (!(HLO && k >= 8)) X[pb0 + k * SP] = e0[k]; }
    hy_bfly16<INV, ZUP, HLO>(e1, t1);
#pragma unroll
    for (int k = 0; k < R; ++k) { if (!(HLO && k >= 8)) X[pb1 + k * SP] = e1[k]; }
}
typedef _Float16 hy_h2 __attribute__((ext_vector_type(2)));
HYD unsigned hy_pack_h2(float re, float im) { const hy_h2 v = {(_Float16)re, (_Float16)im}; return __builtin_bit_cast(unsigned, v); }
HYD cf hy_unpack_h2(unsigned u, float s) { const hy_h2 v = __builtin_bit_cast(hy_h2, u); return cf{(float)v.x * s, (float)v.y * s}; }
typedef unsigned hy_u4 __attribute__((ext_vector_type(4)));
template <bool INV> HYD void hy_r4(cf (&e)[4]) {
    if (!INV) {
        const cf a0 = e[0] + e[2], b0 = e[0] - e[2], a1 = e[1] + e[3], d = e[1] - e[3], b1 = cf{d.y, -d.x};
        e[0] = a0 + a1; e[1] = a0 - a1; e[2] = b0 + b1; e[3] = b0 - b1;
    } else {
        const cf a0 = e[0] + e[1], a1 = e[0] - e[1], a2 = e[2] + e[3], d = e[2] - e[3], b = cf{-d.y, d.x};
        e[0] = a0 + a2; e[2] = a0 - a2; e[1] = a1 + b; e[3] = a1 - b;
    }
}
template <bool INV, class P, class PK>
HYD void hy_pass4(P X, int tid, PK KM) {
    typedef typename HyP2<P>::type P2;
    const int w = tid >> 6, lane = tid & 63;
#pragma unroll 1
    for (int gb = 0; gb < 2; ++gb) {
        cf2 a[4], b[4]; hy_u4 kq[4];
        const int g0 = (gb * 8 + w) * 256 + lane;
#pragma unroll
        for (int u = 0; u < 4; ++u) { const int g = g0 + 64 * u; P2 X2 = (P2)(X + HP(4 * g)); a[u] = X2[0]; b[u] = X2[1];
            if (KM) { const unsigned gi = (unsigned)(4 * g) & 0x3fffu; kq[u] = *(const hy_u4*)(KM + gi); } }
#pragma unroll
        for (int u = 0; u < 4; ++u) { const int g = g0 + 64 * u; P2 X2 = (P2)(X + HP(4 * g));
            cf e[4] = {cf{a[u].x, a[u].y}, cf{a[u].z, a[u].w}, cf{b[u].x, b[u].y}, cf{b[u].z, b[u].w}};
            hy_r4<INV>(e);
            if (KM) { const float ks = 1.0f / (float)FN; cf q0, q1, q2, q3; hy_cmul2(q0, e[0], hy_unpack_h2(kq[u].x, ks), q1, e[1], hy_unpack_h2(kq[u].y, ks)); hy_cmul2(q2, e[2], hy_unpack_h2(kq[u].z, ks), q3, e[3], hy_unpack_h2(kq[u].w, ks)); e[0] = q0; e[1] = q1; e[2] = q2; e[3] = q3; }
            X2[0] = cf2{e[0].x, e[0].y, e[1].x, e[1].y}; X2[1] = cf2{e[2].x, e[2].y, e[3].x, e[3].y}; }
    }
}
HYD int hy_brev14(int p) {
    unsigned v = (unsigned)p;
    v = ((v >> 1) & 0x55555555u) | ((v & 0x55555555u) << 1);
    v = ((v >> 2) & 0x33333333u) | ((v & 0x33333333u) << 2);
    v = ((v >> 4) & 0x0F0F0F0Fu) | ((v & 0x0F0F0F0Fu) << 4);
    v = ((v >> 8) & 0x00FF00FFu) | ((v & 0x00FF00FFu) << 8);
    v = (v >> 16) | (v << 16);
    return (int)(v >> (32 - FLOG));
}
HYD float hy_bf2f(unsigned short b) { unsigned u = (unsigned)b << 16; float f; __builtin_memcpy(&f, &u, 4); return f; }
HYD unsigned hy_f2bf(float f) { unsigned u; __builtin_memcpy(&u, &f, 4); return (u + 0x7fffu + ((u >> 16) & 1u)) >> 16; }
template <class PR> HYD void hy_sconv2(PR rowj  , unsigned tid, int j, float w0, float w1, float w2, float b, float& u0, float& u1) {
    const unsigned d1 = rowj[tid];
    const unsigned d0r = (rowj - 1)[tid], d2r = (rowj + 1)[tid];
    const unsigned d0 = (j > 0 || tid > 0) ? d0r : 0u;
    const unsigned d2 = (j < 7 || tid < (unsigned)(FT - 1)) ? d2r : 0u;
    const float pm1 = hy_bf2f((unsigned short)(d0 >> 16)), p0 = hy_bf2f((unsigned short)(d1 & 0xffffu)), p1 = hy_bf2f((unsigned short)(d1 >> 16)), p2 = hy_bf2f((unsigned short)(d2 & 0xffffu));
    u0 = b + w0 * pm1 + w1 * p0 + w2 * p1;
    u1 = b + w0 * p0 + w1 * p1 + w2 * p2;
}
template <class P> HYD void hy_filter_step(P X, const unsigned short* taps, float delta, int tid) {
    typedef typename HyP2<P>::type P2;
    typedef unsigned u32x2h __attribute__((ext_vector_type(2)));
    u32x2h raw[SEQL / (4 * FT)][4];
    const float dscale = -delta * (1.4426950408889634f / (float)(SEQL - 1)); (void)dscale;
#pragma unroll
    for (int j = 0; j < SEQL / (4 * FT); ++j)
#pragma unroll
        for (int q = 0; q < 4; ++q) raw[j][q] = *(const u32x2h*)(taps + (size_t)q * 1024 * SEQL + ((unsigned)(4 * (tid + FT * j)) & 0x1fffu));
#pragma unroll
    for (int j = 0; j < SEQL / (4 * FT); ++j) {
        const int t = 4 * (tid + FT * j);
        cf2 a[4];
#pragma unroll
        for (int q = 0; q < 4; ++q) a[q] = cf2{hy_bf2f((unsigned short)(raw[j][q].x & 0xffffu)), hy_bf2f((unsigned short)(raw[j][q].x >> 16)), hy_bf2f((unsigned short)(raw[j][q].y & 0xffffu)), hy_bf2f((unsigned short)(raw[j][q].y >> 16))};
        cf2 dec;
#pragma unroll
#ifdef HY_DEVICE
        for (int e = 0; e < 4; ++e) dec[e] = __builtin_amdgcn_exp2f((float)(t + e) * dscale);
#else
        for (int e = 0; e < 4; ++e) dec[e] = expf(-((float)(t + e) * (1.0f / (float)(SEQL - 1))) * delta);
#endif
        const cf2 a0 = a[0] * dec, a1 = a[1] * dec, a2 = a[2] * dec, a3 = a[3] * dec;
        P2 Xf = (P2)(X + HP(t));
        if (t == 0) { Xf[0] = cf2{a0[0] + a1[0], a2[0] + a3[0], a0[1], a2[1]}; float z0 = 0.f; HY_OPAQUE(z0); X[HP(SEQL)] = cf{z0, z0}; }
        else Xf[0] = cf2{a0[0], a2[0], a0[1], a2[1]};
        Xf[1] = cf2{a0[2], a2[2], a0[3], a2[3]};
        const int pbk = HP(FN - t - 4);
        X[pbk + 1] = cf{a1[3], a3[3]}; X[pbk + 2] = cf{a1[2], a3[2]}; X[pbk + 3] = cf{a1[1], a3[1]};
        if (t > 0) X[HP(FN - t)] = cf{a1[0], a3[0]};
    }
}
template <class P> HYD void hy_sep_step(P X, unsigned* K1g, unsigned* K2g, int tid) {
    const float sc = 0.5f;
#pragma unroll 1
    for (int j0 = 0; j0 < FN / FT; j0 += 4) {
        cf a[4], b[4];
#pragma unroll
        for (int u = 0; u < 4; ++u) { const int p = tid + FT * (j0 + u);
            const int f = hy_brev14(p), q = hy_brev14((FN - f) & (FN - 1));
            a[u] = X[HP(p)]; b[u] = X[HP(q)]; }
#pragma unroll
        for (int u = 0; u < 4; ++u) { const int p = tid + FT * (j0 + u);
            const unsigned pi = (unsigned)p & 0x3fffu;
            K1g[pi] = hy_pack_h2((a[u].x + b[u].x) * sc, (a[u].y - b[u].y) * sc);
            K2g[pi] = hy_pack_h2((a[u].y + b[u].y) * sc, -(a[u].x - b[u].x) * sc); }
    }
}
template <class P> HYD void hy_load_step(P X, const unsigned* r0, const unsigned* r1, float w0, float w1, float w2, float b, float (&zr)[8][4], int tid) {
    typedef typename HyP2<P>::type P2;
#pragma unroll
    for (int j = 0; j < 8; ++j) {
        const int t = 2 * (tid + FT * j);
        hy_sconv2(r0 + FT * j, (unsigned)tid, j, w0, w1, w2, b, zr[j][0], zr[j][2]);
        hy_sconv2(r1 + FT * j, (unsigned)tid, j, w0, w1, w2, b, zr[j][1], zr[j][3]);
        *(P2)(X + HP(t)) = cf2{zr[j][0], zr[j][1], zr[j][2], zr[j][3]};
    }
}
template <class P> HYD void hy_gate1_step(P X, const unsigned* r0, const unsigned* r1, float w0, float w1, float w2, float b, float bias, float (&zr)[8][4], int tid) {
    typedef typename HyP2<P>::type P2;
#pragma unroll
    for (int j = 0; j < 8; ++j) {
        const int t = 2 * (tid + FT * j);
        float xa0, xa1, xb0, xb1;
        hy_sconv2(r0 + FT * j, (unsigned)tid, j, w0, w1, w2, b, xa0, xa1);
        hy_sconv2(r1 + FT * j, (unsigned)tid, j, w0, w1, w2, b, xb0, xb1);
        P2 xp = (P2)(X + HP(t));
        const cf2 y = *xp;
        zr[j][0] = xa0 * (y.x + zr[j][0] * bias); zr[j][1] = xb0 * (y.y + zr[j][1] * bias);
        zr[j][2] = xa1 * (y.z + zr[j][2] * bias); zr[j][3] = xb1 * (y.w + zr[j][3] * bias);
        *xp = cf2{zr[j][0], zr[j][1], zr[j][2], zr[j][3]};
    }
}
template <class P> HYD void hy_gate2_step(P X, const unsigned* r0, const unsigned* r1, float w0, float w1, float w2, float b, float bias, const float (&zr)[8][4], unsigned* out0, unsigned* out1, int tid) {
    typedef typename HyP2<P>::type P2;
#pragma unroll
    for (int j = 0; j < 8; ++j) {
        const int t = 2 * (tid + FT * j);
        float xa0, xa1, xb0, xb1;
        hy_sconv2(r0 + FT * j, (unsigned)tid, j, w0, w1, w2, b, xa0, xa1);
        hy_sconv2(r1 + FT * j, (unsigned)tid, j, w0, w1, w2, b, xb0, xb1);
        const cf2 y = *(P2)(X + HP(t));
        const float za0 = xa0 * (y.x + zr[j][0] * bias), zb0 = xb0 * (y.y + zr[j][1] * bias);
        const float za1 = xa1 * (y.z + zr[j][2] * bias), zb1 = xb1 * (y.w + zr[j][3] * bias);
        (out0 + FT * j)[(unsigned)tid] = hy_f2bf(za0) | (hy_f2bf(za1) << 16);
        (out1 + FT * j)[(unsigned)tid] = hy_f2bf(zb0) | (hy_f2bf(zb1) << 16);
    }
}
HYD float hy_sconv1(unsigned D0, unsigned D1, int t, float w0, float w1, float w2, float b, bool pad0, bool padL) {
    const unsigned sh = ((unsigned)(t - 1) & 1u) << 4;
#ifdef HY_DEVICE
    const unsigned lo = __builtin_amdgcn_alignbit(D1, D0, sh), hi = D1 >> sh;
#else
    const unsigned long long w = (((unsigned long long)D1 << 32) | D0) >> sh; const unsigned lo = (unsigned)w, hi = (unsigned)(w >> 32);
#endif
    float e0 = hy_bf2f((unsigned short)(lo & 0xffffu)), e1 = hy_bf2f((unsigned short)(lo >> 16)), e2 = hy_bf2f((unsigned short)(hi & 0xffffu));
    if (pad0 && t == 0) e0 = 0.f;
    if (padL && t == SEQL - 1) e2 = 0.f;
    return b + w0 * e0 + w1 * e1 + w2 * e2;
}
struct HyRaw { unsigned d[2][8][4]; };
HYD void hy_raw_load(HyRaw& R, const unsigned* r0, const unsigned* r1, int tid) {
#pragma unroll
    for (int r = 0; r < 2; ++r)
#pragma unroll
        for (int k = 0; k < 8; ++k) { const unsigned du = ((unsigned)(tid + FT * r + 1024 * k + 1) >> 1) & 0x1fffu;
            R.d[r][k][0] = (r0 - 1)[du]; R.d[r][k][1] = r0[du]; R.d[r][k][2] = (r1 - 1)[du]; R.d[r][k][3] = r1[du]; }
}
template <class P, class PT> HYD void hy_convA_fwd(P X, PT thi, PT tlo, int tid, const HyRaw& R, float w0, float w1, float w2, float b, cf (&zr)[2][8]) {
#pragma unroll
    for (int r = 0; r < 2; ++r) {
        const int i0 = tid + FT * r, pb = HP(i0);
        cf e[16];
#pragma unroll
        for (int k = 0; k < 8; ++k) { const int t = i0 + 1024 * k; const bool p0 = (r == 0 && k == 0), pL = (r == 1 && k == 7); e[k] = cf{hy_sconv1(R.d[r][k][0], R.d[r][k][1], t, w0, w1, w2, b, p0, pL), hy_sconv1(R.d[r][k][2], R.d[r][k][3], t, w0, w1, w2, b, p0, pL)}; zr[r][k] = e[k]; }
#pragma unroll
        for (int k = 8; k < 16; ++k) e[k] = cf{0.f, 0.f};
        hy_bfly16<false, true, false>(e, hy_twid(thi, tlo, i0));
#pragma unroll
        for (int k = 0; k < 16; ++k) X[pb + k * 1088] = e[k];
    }
}
template <bool LAST, class P, class PT> HYD void hy_gateA(P X, PT thi, PT tlo, int tid, const HyRaw& R, float w0, float w1, float w2, float b, float bias,
                                                           cf (&zr)[2][8], unsigned short* out0, unsigned short* out1) {
#pragma unroll
    for (int r = 0; r < 2; ++r) {
        const int i0 = tid + FT * r, pb = HP(i0);
        cf e[16];
#pragma unroll
        for (int k = 0; k < 16; ++k) e[k] = X[pb + k * 1088];
        const cf tw = hy_twid(thi, tlo, i0);
        hy_bfly16<true, false, true>(e, tw);
#pragma unroll
        for (int k = 0; k < 8; ++k) { const int t = i0 + 1024 * k;
            const bool p0 = (r == 0 && k == 0), pL = (r == 1 && k == 7);
            const float xa = hy_sconv1(R.d[r][k][0], R.d[r][k][1], t, w0, w1, w2, b, p0, pL), xb = hy_sconv1(R.d[r][k][2], R.d[r][k][3], t, w0, w1, w2, b, p0, pL);
            const cf z = cf{xa * (e[k].x + zr[r][k].x * bias), xb * (e[k].y + zr[r][k].y * bias)};
            if (LAST) {
#ifdef HY_DEVICE
                unsigned pk; asm("v_cvt_pk_bf16_f32 %0, %1, %2" : "=v"(pk) : "v"(z.x), "v"(z.y)); const unsigned ti = (unsigned)t & 0x1fffu; out0[ti] = (unsigned short)(pk & 0xffffu); out1[ti] = (unsigned short)(pk >> 16);
#else
                out0[t] = (unsigned short)hy_f2bf(z.x); out1[t] = (unsigned short)hy_f2bf(z.y);
#endif
            }
            else { zr[r][k] = z; e[k] = z; } }
        if (!LAST) {
#pragma unroll
            for (int k = 8; k < 16; ++k) e[k] = cf{0.f, 0.f};
            hy_bfly16<false, true, false>(e, tw);
#pragma unroll
            for (int k = 0; k < 16; ++k) X[pb + k * 1088] = e[k];
        }
    }
}
constexpr int NWAVES = 8, NTHR = NWAVES * 64;
constexpr int DM = 2048, SEQ = 8192, DEPTH = 4, NSEQ = 6, GSEQ = 2, NGRP = NSEQ / GSEQ, MG = GSEQ * SEQ;
constexpr int HYW = 1024, HYIN = 3072, QKVW = 3072, DFF = 5632, GU = 2 * DFF, FEMB = 33, FHID = 64;
constexpr float EPS = 1e-6f;
constexpr float QSCALE = 0.125f * 1.4426950408889634f;
constexpr size_t MiB = 1u << 20;
constexpr size_t WS_CTL = 0, CTL_ZERO_BYTES = 1 * MiB;
constexpr size_t SZ_WHY = (size_t)HYIN * DM * 2, SZ_WQKV = (size_t)QKVW * DM * 2, SZ_WOUT = (size_t)DM * DM * 2, SZ_WGU = (size_t)GU * DM * 2, SZ_WDN = (size_t)DM * DFF * 2;
constexpr size_t OFF_WHY = 0, OFF_WQKV = OFF_WHY + SZ_WHY, OFF_WOUT = OFF_WQKV + SZ_WQKV, OFF_WGU = OFF_WOUT + SZ_WOUT, OFF_WDN = OFF_WGU + SZ_WGU, SZ_WLAYER = OFF_WDN + SZ_WDN;
constexpr size_t WS_W = 1 * MiB;
constexpr size_t WS_ROPE = WS_W + DEPTH * SZ_WLAYER;
constexpr int KPAD = 256;
constexpr size_t WS_H3 = WS_ROPE + (size_t)SEQ * 32 * 8;
constexpr size_t WS_W4T = WS_H3 + (size_t)DEPTH * SEQ * KPAD * 2;
constexpr size_t WS_TAPS = WS_W4T + (size_t)DEPTH * 4096 * KPAD * 2;
constexpr size_t WS_FFTK = WS_TAPS + (size_t)4096 * SEQ * 2;
constexpr size_t WS_STASH = WS_FFTK + (size_t)256 * 2 * 16384 * 8;
constexpr size_t WS_XB = WS_STASH;
constexpr size_t WS_H = WS_XB + (size_t)MG * DM * 2;
constexpr size_t WS_ZT = WS_H + (size_t)MG * DM * 2;
constexpr size_t WS_PROJT = WS_ZT + (size_t)HYW * MG * 2;
constexpr size_t WS_QKV = WS_PROJT + (size_t)HYIN * MG * 2;
constexpr size_t WS_MIX = WS_PROJT;
constexpr size_t WS_FFH = WS_PROJT;
constexpr size_t WS_MIXIN = WS_QKV + (size_t)MG * QKVW * 2;
constexpr size_t WS_END = WS_MIXIN + (size_t)MG * DM * 2;
constexpr size_t SZ_TAPS = (size_t)4096 * SEQ * 2, WS_TAPS_X = WS_END, WS_END_X = WS_TAPS_X + (DEPTH - 1) * SZ_TAPS;
static_assert((size_t)MG * DFF * 2 <= (size_t)HYIN * MG * 2 + (size_t)MG * QKVW * 2, "FFH overlay fits PROJT|QKV");
static_assert(WS_W4T % 256 == 0 && WS_TAPS % 256 == 0 && WS_ROPE % 256 == 0 && WS_H3 % 256 == 0 && WS_FFTK % 256 == 0 && WS_XB % 256 == 0 && WS_H % 256 == 0 && SZ_WLAYER % 256 == 0, "alignment");
constexpr int CW_BAR = 4096;
constexpr int PH_PER_LAYER = 8, PH_PER_GROUP = 1 + DEPTH * PH_PER_LAYER, NPHASE = 1 + NGRP * PH_PER_GROUP;
constexpr int RING_OFF = 0, RING_BYTES = 131072;
constexpr int TAB_OFF = 139264;
constexpr int MISC_OFF = TAB_OFF + 4096;
constexpr int LDS_BYTES = 147456;
static_assert(MISC_OFF + 128 <= LDS_BYTES, "LDS map");
static_assert(att::SHM_ATTN_ALL <= MISC_OFF, "attention LDS fits below the control words");
#ifndef PROBE_DUP
#define PROBE_DUP 0
#endif
#ifndef MK_PER_PHASE
#define MK_PER_PHASE 0
#endif

struct Args { const float* in[30]; float* out; unsigned char* ws; int ph_lo, ph_hi, taps_all, pad; };
enum { I_XP = 0, I_XS, I_GMPRE, I_GMPOST, I_GFPRE, I_GFPOST, I_WIN, I_CONVW, I_CONVB, I_FW1, I_FB1, I_FF1, I_FW2, I_FB2, I_FF2, I_FW3, I_FB3, I_FF3, I_FW4,
       I_HBIAS, I_HNORM, I_LQ1, I_LK1, I_LQ2, I_LK2, I_SUBLN, I_WOUT, I_WGATE, I_WUP, I_WDOWN };

template <int K> __device__ __forceinline__ float swz_xor(float v) { return __builtin_bit_cast(float, __builtin_amdgcn_ds_swizzle(__builtin_bit_cast(int, v), (K << 10) | 0x1f)); }
__device__ __forceinline__ float wave_sum(float v) {
    v += swz_xor<1>(v); v += swz_xor<2>(v); v += swz_xor<4>(v); v += swz_xor<8>(v); v += swz_xor<16>(v);
    auto rr = __builtin_amdgcn_permlane32_swap(__float_as_uint(v), __float_as_uint(v), false, false);
    return __uint_as_float(rr[0]) + __uint_as_float(rr[1]);
}
__device__ __forceinline__ bf16* wt_dst_row(int kind, int n, bf16* d0, bf16* d1, int K) {
    if (kind == 0) return d0 + (size_t)n * K;
    if (kind == 1) { if (n < HYIN) return d0 + (size_t)n * K; int q = n - HYIN; if (q < 2048) { const int hb = q & ~63, i = q & 63; q = hb + (i < 32 ? 2 * i : 2 * (i - 32) + 1); } return d1 + (size_t)q * K; }
    if (kind == 4) return d0 + (size_t)n * KPAD;
    const int r = (n >> 7) * 256 + (n & 127) + (kind == 3 ? 128 : 0); return d0 + (size_t)r * K;
}
__device__ __forceinline__ void p0_transpose_item(const float* W, int K, int N, int kind, bf16* d0, bf16* d1, LAS float* scr, int item, int lane) {
    const int nblk = N / 32, kb = item / nblk, nb = item % nblk, k0 = 64 * kb, n0 = 32 * nb;
#pragma unroll 8
    for (int i = 0; i < 32; ++i) { const int kk = 2 * i + (lane >> 5); scr[kk * 33 + (lane & 31)] = W[(size_t)(k0 + kk) * N + n0 + (lane & 31)]; }
    LDS_WAIT(); asm volatile("" ::: "memory");
    const int c = lane & 7;
#pragma unroll
    for (int j = 0; j < 4; ++j) { const int n = (lane >> 3) + 8 * j; const LAS float* s = scr + (8 * c) * 33 + n;
        v4u o; o.x = pk2(s[0 * 33], s[1 * 33]); o.y = pk2(s[2 * 33], s[3 * 33]); o.z = pk2(s[4 * 33], s[5 * 33]); o.w = pk2(s[6 * 33], s[7 * 33]);
        *(GAS v4u*)(wt_dst_row(kind, n0 + n, d0, d1, K) + k0 + 8 * c) = o; }
    LDS_WAIT(); asm volatile("" ::: "memory");
}
__device__ __forceinline__ void sincos_red(double ang, float& s, float& c) {
    const double k = rint(ang * 0.15915494309189535); const float r = (float)(ang - k * 6.283185307179586);
    s = sinf(r); c = cosf(r);
}
#define GP(p) ((const float*)(const GAS float*)(p))
#define LAUNDER_TID(F) do { int t_ = (F).tid; asm volatile("" : "+v"(t_)); (F).tid = t_; (F).lane = t_ & 63; int z_ = 0; asm volatile("" : "+s"(z_)); (F).z = z_; unsigned long long w_ = (unsigned long long)(F).ws0; asm volatile("" : "+s"(w_)); (F).ws = (unsigned char*)(GAS unsigned char*)w_; int b_ = (F).bx0, v_ = (F).vcu0, g_ = (F).G0; asm volatile("" : "+s"(b_), "+s"(v_), "+s"(g_)); (F).bx = b_; (F).vcu = v_; (F).G = g_; } while (0)
struct Frame {
    LAS unsigned char* lds; volatile LAS unsigned* MISC; gu32* ctl;
    int tid, lane, wave, vcu, G, bx;
    int vcu0, G0, bx0;
    float* out; unsigned char* ws; unsigned char* ws0; int z;
};
__device__ __forceinline__ void p0_prologue(Frame& F, const Args& A) {
    LAS float* scr = (LAS float*)(F.lds + RING_OFF + F.wave * 16384);
    const int gw = F.vcu * NWAVES + F.wave, NGW = F.G * NWAVES;
    constexpr int I_IN = (DM / 64) * ((HYIN + QKVW) / 32), I_OUT = (DM / 64) * (DM / 32), I_G = (DM / 64) * (DFF / 32), I_D = (DFF / 64) * (DM / 32);
    constexpr int I_W4 = 4096 / 32;
    constexpr int PER_L = I_IN + I_OUT + 2 * I_G + I_D + I_W4;
    for (int it = gw; it < DEPTH * PER_L; it += NGW) {
        const int l = it / PER_L; int r = it % PER_L;
        unsigned char* wl = F.ws + WS_W + (size_t)l * SZ_WLAYER;
        if (r < I_IN) { p0_transpose_item(GP(A.in[I_WIN + F.z]) + (size_t)l * DM * (HYIN + QKVW), DM, HYIN + QKVW, 1, (bf16*)(wl + OFF_WHY), (bf16*)(wl + OFF_WQKV), scr, r, F.lane); continue; } r -= I_IN;
        if (r < I_OUT) { p0_transpose_item(GP(A.in[I_WOUT + F.z]) + (size_t)l * DM * DM, DM, DM, 0, (bf16*)(wl + OFF_WOUT), nullptr, scr, r, F.lane); continue; } r -= I_OUT;
        if (r < I_G) { p0_transpose_item(GP(A.in[I_WGATE + F.z]) + (size_t)l * DM * DFF, DM, DFF, 2, (bf16*)(wl + OFF_WGU), nullptr, scr, r, F.lane); continue; } r -= I_G;
        if (r < I_G) { p0_transpose_item(GP(A.in[I_WUP + F.z]) + (size_t)l * DM * DFF, DM, DFF, 3, (bf16*)(wl + OFF_WGU), nullptr, scr, r, F.lane); continue; } r -= I_G;
        if (r < I_D) { p0_transpose_item(GP(A.in[I_WDOWN + F.z]) + (size_t)l * DFF * DM, DFF, DM, 0, (bf16*)(wl + OFF_WDN), nullptr, scr, r, F.lane); continue; } r -= I_D;
        { bf16* w4t = (bf16*)(F.ws + WS_W4T) + (size_t)l * 4096 * KPAD;
          p0_transpose_item(GP(A.in[I_FW4 + F.z]) + (size_t)l * FHID * 4096, FHID, 4096, 4, w4t, nullptr, scr, r, F.lane);
          for (int e = F.lane; e < 32 * 24; e += 64) *(GAS v4u*)(w4t + (size_t)(32 * r + e / 24) * KPAD + 64 + 8 * (e % 24)) = (v4u){0u, 0u, 0u, 0u}; }
    }
    {
        float* cs = (float*)(F.ws + WS_ROPE);
        for (int e = F.vcu * NTHR + F.tid; e < SEQ * 32; e += F.G * NTHR) {
            const int t = e >> 5, p = e & 31;
            const double inv = exp(-9.210340371976184 * (double)(2 * p) / 64.0);
            float s, c; sincos_red((double)t * inv, s, c);
            cs[2 * e] = c; cs[2 * e + 1] = s;
        }
    }
    {
        bf16* h3b = (bf16*)(F.ws + WS_H3);
        LAS float* hb = (LAS float*)(F.lds + RING_OFF + F.wave * 16384);
        for (int task = gw; task < DEPTH * (SEQ / 64); task += NGW) {
            const int l = task / (SEQ / 64), t = (task % (SEQ / 64)) * 64 + F.lane;
            const float* w1 = GP(A.in[I_FW1 + F.z]) + (size_t)l * FEMB * FHID; const float* w2 = GP(A.in[I_FW2 + F.z]) + (size_t)l * FHID * FHID; const float* w3 = GP(A.in[I_FW3 + F.z]) + (size_t)l * FHID * FHID;
            hb[F.lane] = (float)t * (1.0f / (float)(SEQ - 1));
#pragma unroll 1
            for (int bi = 0; bi < 16; ++bi) { const double band = 1e-4 + (double)bi * ((15.0 - 1e-4) / 15.0);
                float s, c; sincos_red(6.283185307179586 * (double)t / (double)SEQ * band, s, c); hb[(1 + bi) * 64 + F.lane] = c; hb[(17 + bi) * 64 + F.lane] = -s; }
#pragma unroll 1
            for (int stage = 0; stage < 3; ++stage) {
                const float* w = stage == 0 ? w1 : (stage == 1 ? w2 : w3);
                const float* bb = (stage == 0 ? GP(A.in[I_FB1 + F.z]) : (stage == 1 ? GP(A.in[I_FB2 + F.z]) : GP(A.in[I_FB3 + F.z]))) + l * FHID;
                const float* ff = (stage == 0 ? GP(A.in[I_FF1 + F.z]) : (stage == 1 ? GP(A.in[I_FF2 + F.z]) : GP(A.in[I_FF3 + F.z]))) + l * FHID;
                const int nin = stage == 0 ? FEMB : FHID;
                typedef float f32x16_t __attribute__((ext_vector_type(16)));
                f32x16_t c0 = {}, c1 = {}, c2 = {}, c3 = {};
                LDS_WAIT();
#pragma unroll 1
                for (int i = 0; i < nin; ++i) { const float hv = hb[i * 64 + F.lane]; const f32x16_t* wr = (const f32x16_t*)(w + i * FHID);
                    c0 += wr[0] * hv; c1 += wr[1] * hv; c2 += wr[2] * hv; c3 += wr[3] * hv; }
                const f32x16_t* b16 = (const f32x16_t*)bb; const f32x16_t* f16 = (const f32x16_t*)ff;
                c0 = (c0 + b16[0]) * f16[0]; c1 = (c1 + b16[1]) * f16[1]; c2 = (c2 + b16[2]) * f16[2]; c3 = (c3 + b16[3]) * f16[3];
                if (stage < 2) {
#pragma unroll
                    for (int e = 0; e < 16; ++e) { hb[e * 64 + F.lane] = sinf(c0[e]); hb[(16 + e) * 64 + F.lane] = sinf(c1[e]); hb[(32 + e) * 64 + F.lane] = sinf(c2[e]); hb[(48 + e) * 64 + F.lane] = sinf(c3[e]); }
                } else {
                    GAS v4u* o = (GAS v4u*)(h3b + ((size_t)l * SEQ + t) * KPAD);
#pragma unroll
                    for (int q = 0; q < 2; ++q) { v4u w; w.x = pk2(sinf(c0[8 * q]), sinf(c0[8 * q + 1])); w.y = pk2(sinf(c0[8 * q + 2]), sinf(c0[8 * q + 3])); w.z = pk2(sinf(c0[8 * q + 4]), sinf(c0[8 * q + 5])); w.w = pk2(sinf(c0[8 * q + 6]), sinf(c0[8 * q + 7])); o[q] = w; }
#pragma unroll
                    for (int q = 0; q < 2; ++q) { v4u w; w.x = pk2(sinf(c1[8 * q]), sinf(c1[8 * q + 1])); w.y = pk2(sinf(c1[8 * q + 2]), sinf(c1[8 * q + 3])); w.z = pk2(sinf(c1[8 * q + 4]), sinf(c1[8 * q + 5])); w.w = pk2(sinf(c1[8 * q + 6]), sinf(c1[8 * q + 7])); o[2 + q] = w; }
#pragma unroll
                    for (int q = 0; q < 2; ++q) { v4u w; w.x = pk2(sinf(c2[8 * q]), sinf(c2[8 * q + 1])); w.y = pk2(sinf(c2[8 * q + 2]), sinf(c2[8 * q + 3])); w.z = pk2(sinf(c2[8 * q + 4]), sinf(c2[8 * q + 5])); w.w = pk2(sinf(c2[8 * q + 6]), sinf(c2[8 * q + 7])); o[4 + q] = w; }
#pragma unroll
                    for (int q = 0; q < 2; ++q) { v4u w; w.x = pk2(sinf(c3[8 * q]), sinf(c3[8 * q + 1])); w.y = pk2(sinf(c3[8 * q + 2]), sinf(c3[8 * q + 3])); w.z = pk2(sinf(c3[8 * q + 4]), sinf(c3[8 * q + 5])); w.w = pk2(sinf(c3[8 * q + 6]), sinf(c3[8 * q + 7])); o[6 + q] = w; }
#pragma unroll 1
                    for (int q = 8; q < 32; ++q) o[q] = (v4u){0u, 0u, 0u, 0u};
                }
            }
        }
    }
}
template <bool XSB>
__device__ __forceinline__ void norm_pass(Frame& F, const void* x_src, const bf16* add, const float* g_add, bf16* xb_dst, float* xf_dst, const float* g_out, bf16* h_dst) {
    const int gw = F.vcu * NWAVES + F.wave, NGW = F.G * NWAVES;
#define UNPK(q, lo, hi) do { lo = (f32x4){__uint_as_float((q).x << 16), __uint_as_float((q).x & 0xffff0000u), __uint_as_float((q).y << 16), __uint_as_float((q).y & 0xffff0000u)}; \
                             hi = (f32x4){__uint_as_float((q).z << 16), __uint_as_float((q).z & 0xffff0000u), __uint_as_float((q).w << 16), __uint_as_float((q).w & 0xffff0000u)}; } while (0)
#define PK8(lo, hi) (v4u){pk2((lo)[0], (lo)[1]), pk2((lo)[2], (lo)[3]), pk2((hi)[0], (hi)[1]), pk2((hi)[2], (hi)[3])}
    f32x4 gA[8], gO[8];
#pragma unroll
    for (int j = 0; j < 8; ++j) { gA[j] = (f32x4){0.f, 0.f, 0.f, 0.f}; gO[j] = (f32x4){0.f, 0.f, 0.f, 0.f}; }
    if (add) { const GAS f32x4* gr = (const GAS f32x4*)g_add + 2 * F.lane;
#pragma unroll
        for (int j = 0; j < 4; ++j) { gA[2 * j] = gr[128 * j]; gA[2 * j + 1] = gr[128 * j + 1]; } }
    if (h_dst) { const GAS f32x4* gr = (const GAS f32x4*)g_out + 2 * F.lane;
#pragma unroll
        for (int j = 0; j < 4; ++j) { gO[2 * j] = gr[128 * j]; gO[2 * j + 1] = gr[128 * j + 1]; } }
    v4u rq[4], rw[4]; f32x4 rf[8];
#pragma unroll
    for (int j = 0; j < 4; ++j) { rq[j] = (v4u){0u, 0u, 0u, 0u}; rw[j] = (v4u){0u, 0u, 0u, 0u}; }
#define NP_FETCH(m) do { \
        if (XSB) { const GAS v4u* xa_ = (const GAS v4u*)((const bf16*)x_src + (size_t)(m) * DM) + F.lane; _Pragma("unroll") for (int j = 0; j < 4; ++j) rq[j] = xa_[64 * j]; } \
        else { const GAS f32x4* xa_ = (const GAS f32x4*)((const float*)x_src + (size_t)(m) * DM) + 2 * F.lane; _Pragma("unroll") for (int j = 0; j < 4; ++j) { rf[2 * j] = xa_[128 * j]; rf[2 * j + 1] = xa_[128 * j + 1]; } } \
        if (add) { const GAS v4u* aa_ = (const GAS v4u*)(add + (size_t)(m) * DM) + F.lane; _Pragma("unroll") for (int j = 0; j < 4; ++j) rw[j] = aa_[64 * j]; } } while (0)
    if (gw < MG) NP_FETCH(gw);
    for (int m0 = gw; m0 < MG; m0 += NGW) {
        f32x4 va[8]; v4u wa[4];
        if (XSB) {
#pragma unroll
            for (int j = 0; j < 4; ++j) UNPK(rq[j], va[2 * j], va[2 * j + 1]);
        } else {
#pragma unroll
            for (int j = 0; j < 8; ++j) va[j] = rf[j];
        }
#pragma unroll
        for (int j = 0; j < 4; ++j) wa[j] = rw[j];
        if (m0 + NGW < MG) NP_FETCH(m0 + NGW);
        if (add) {
            float sa = 0.f;
#pragma unroll
            for (int j = 0; j < 4; ++j) { f32x4 a0, a1; UNPK(wa[j], a0, a1);
                sa += ((a0[0] * a0[0] + a0[1] * a0[1]) + (a0[2] * a0[2] + a0[3] * a0[3])) + ((a1[0] * a1[0] + a1[1] * a1[1]) + (a1[2] * a1[2] + a1[3] * a1[3])); }
            const float ra = 1.0f / sqrtf(wave_sum(sa) * (1.0f / DM) + EPS);
#pragma unroll
            for (int j = 0; j < 4; ++j) { f32x4 a0, a1; UNPK(wa[j], a0, a1);
                va[2 * j] = va[2 * j] + a0 * ra * gA[2 * j]; va[2 * j + 1] = va[2 * j + 1] + a1 * ra * gA[2 * j + 1]; }
        }
        if (xf_dst) { GAS f32x4* oa = (GAS f32x4*)(xf_dst + (size_t)m0 * DM) + 2 * F.lane;
#pragma unroll
            for (int j = 0; j < 4; ++j) { oa[128 * j] = va[2 * j]; oa[128 * j + 1] = va[2 * j + 1]; } }
        if (xb_dst) { GAS v4u* oa = (GAS v4u*)(xb_dst + (size_t)m0 * DM) + F.lane;
#pragma unroll
            for (int j = 0; j < 4; ++j) { const v4u w = PK8(va[2 * j], va[2 * j + 1]); oa[64 * j] = w;
                UNPK(w, va[2 * j], va[2 * j + 1]); } }
        if (h_dst) {
            float sa = 0.f;
#pragma unroll
            for (int j = 0; j < 8; ++j) sa += (va[j][0] * va[j][0] + va[j][1] * va[j][1]) + (va[j][2] * va[j][2] + va[j][3] * va[j][3]);
            const float ra = 1.0f / sqrtf(wave_sum(sa) * (1.0f / DM) + EPS);
            GAS v4u* ha = (GAS v4u*)(h_dst + (size_t)m0 * DM) + F.lane;
#pragma unroll
            for (int j = 0; j < 4; ++j) { const f32x4 oa0 = va[2 * j] * ra * gO[2 * j], oa1 = va[2 * j + 1] * ra * gO[2 * j + 1]; ha[64 * j] = PK8(oa0, oa1); }
        }
    }
#undef NP_FETCH
#undef UNPK
#undef PK8
}
typedef LAS cf* lcf;
template <bool ZUP> __device__ __forceinline__ void hy_fwd(lcf X, lcf thi, lcf tlo, int tid, const unsigned* KM) {
    if (ZUP) hy_pass16<1024, false, true, false>(X, thi, tlo, tid); else hy_pass16<1024, false, false, false>(X, thi, tlo, tid);
    __syncthreads();
    hy_pass16<64, false, false, false>(X, thi, tlo, tid);
    hy_pass16<4, false, false, false>(X, thi, tlo, tid);
    hy_pass4<false>(X, tid, KM); __syncthreads();
}
__device__ __forceinline__ void hy_inv(lcf X, lcf thi, lcf tlo, int tid) {
    const unsigned* nul = nullptr;
    hy_pass4<true>(X, tid, nul); __syncthreads();
    hy_pass16<4, true, false, false>(X, thi, tlo, tid); __syncthreads();
    hy_pass16<64, true, false, false>(X, thi, tlo, tid); __syncthreads();
    hy_pass16<1024, true, false, true>(X, thi, tlo, tid); __syncthreads();
}
__device__ __forceinline__ void hy_mid(lcf X, lcf thi, lcf tlo, int tid, const unsigned* KM) {
    const unsigned* nul = nullptr;
    hy_pass16<64, false, false, false>(X, thi, tlo, tid);
    hy_pass16<4, false, false, false>(X, thi, tlo, tid);
    hy_pass4<false>(X, tid, KM);
    hy_pass4<true>(X, tid, nul);
    hy_pass16<4, true, false, false>(X, thi, tlo, tid);
    hy_pass16<64, true, false, false>(X, thi, tlo, tid); __syncthreads();
}
__device__ __forceinline__ void hyena_phase(Frame& F, const Args& A, int l) {
    lcf X = (lcf)(F.lds + RING_OFF); lcf thi = (lcf)(F.lds + TAB_OFF); lcf tlo = thi + 128;
    const int tid = F.tid;
    if (tid < 256) { const int a = tid & 127; const double ang = -6.283185307179586 * (double)(tid < 128 ? 128 * a : a) / (double)FN; float s, c; sincos_red(ang, s, c); (tid < 128 ? thi : tlo)[a] = cf{c, s}; }
    unsigned* K1g = (unsigned*)(F.ws + WS_FFTK) + (size_t)F.bx * 2 * FN; unsigned* K2g = K1g + FN;
    const bf16* taps = (const bf16*)(F.ws + ((A.taps_all && l > 0) ? WS_TAPS_X + (size_t)(l - 1) * SZ_TAPS : WS_TAPS));
    const float* cw = GP(A.in[I_CONVW + F.z]) + (size_t)l * 3 * HYIN; const float* cb = GP(A.in[I_CONVB + F.z]) + (size_t)l * HYIN; const float* hb = GP(A.in[I_HBIAS + F.z]) + (size_t)l * 2 * HYW;
    const bf16* projT = (const bf16*)(F.ws + WS_PROJT); bf16* zT = (bf16*)(F.ws + WS_ZT);
    for (int c = F.vcu; c < HYW; c += F.G) {
        __syncthreads();
        const float delta = fabsf(-15.350567286626973f + (float)c * ((-3.0701134573253945f + 15.350567286626973f) / 1023.0f));
#define TIDX(v) int v = tid; asm volatile("" : "+v"(v))
        { TIDX(t_); hy_filter_step(X, taps + (size_t)c * SEQ, delta, t_); }
        const unsigned* rx1 = (const unsigned*)(projT + (size_t)c * MG); const unsigned* rx2 = (const unsigned*)(projT + (size_t)(HYW + c) * MG); const unsigned* rv = (const unsigned*)(projT + (size_t)(2 * HYW + c) * MG);
        HyRaw R;
        { TIDX(t_); hy_raw_load(R, rv, rv + SEQ / 2, t_); }
        __syncthreads();
        { TIDX(t_); hy_fwd<false>(X, thi, tlo, t_, nullptr); }
        { TIDX(t_); hy_sep_step(X, K1g, K2g, t_); }
        asm volatile("s_waitcnt vmcnt(0)" ::: "memory"); __syncthreads();
        cf zr[2][8];
        { TIDX(t_); hy_convA_fwd(X, thi, tlo, t_, R, cw[2 * HYW + c], cw[HYIN + 2 * HYW + c], cw[2 * HYIN + 2 * HYW + c], cb[2 * HYW + c], zr); }
        { TIDX(t_); hy_raw_load(R, rx1, rx1 + SEQ / 2, t_); }
        __syncthreads();
        { TIDX(t_); hy_mid(X, thi, tlo, t_, K1g); }
        { TIDX(t_); hy_gateA<false>(X, thi, tlo, t_, R, cw[c], cw[HYIN + c], cw[2 * HYIN + c], cb[c], hb[c], zr, (unsigned short*)nullptr, (unsigned short*)nullptr); }
        { TIDX(t_); hy_raw_load(R, rx2, rx2 + SEQ / 2, t_); }
        __syncthreads();
        { TIDX(t_); hy_mid(X, thi, tlo, t_, K2g); }
        unsigned short* zo = (unsigned short*)(zT + (size_t)c * MG);
        { TIDX(t_); hy_gateA<true>(X, thi, tlo, t_, R, cw[HYW + c], cw[HYIN + HYW + c], cw[2 * HYIN + HYW + c], cb[HYW + c], hb[HYW + c], zr, zo, zo + SEQ); }
#undef TIDX
    }
    __syncthreads();
}
__device__ __forceinline__ void hynorm_phase(Frame& F, const Args& A, int l) {
    constexpr int TB = 64;
    LAS unsigned char* tile = F.lds + RING_OFF; LAS float* red = (LAS float*)(F.lds + RING_OFF + TB * HYW * 2); LAS float* rinv = red + 8 * TB;
    const bf16* zT = (const bf16*)(F.ws + WS_ZT); bf16* mixin = (bf16*)(F.ws + WS_MIXIN); const float* gn = GP(A.in[I_HNORM + F.z]) + (size_t)l * HYW;
    const int tid = F.tid;
    for (int tb = F.vcu; tb < MG / TB; tb += F.G) {
        const int t0 = tb * TB; __syncthreads();
        float ps[8];
#pragma unroll
        for (int i = 0; i < 8; ++i) ps[i] = 0.f;
        const int k = tid & 7, crow = tid >> 3;
#pragma unroll
        for (int hb = 0; hb < 2; ++hb) {
            v4u w[8];
#pragma unroll
            for (int it = 0; it < 8; ++it) { const unsigned c = (unsigned)((hb * 8 + it) * 64 + crow) & 1023u; w[it] = *(const GAS v4u*)(zT + (size_t)c * MG + (unsigned)(t0 + 8 * k)); }
#pragma unroll
            for (int it = 0; it < 8; ++it) { const int c = (hb * 8 + it) * 64 + crow;
                LAS unsigned short* d = (LAS unsigned short*)(tile + (8 * k) * 2048 + (((c >> 3) ^ k) << 4) + (c & 7) * 2);
                const unsigned ww[4] = {w[it].x, w[it].y, w[it].z, w[it].w};
#pragma unroll
                for (int i = 0; i < 4; ++i) { d[(2 * i) * 1024] = (unsigned short)(ww[i] & 0xffffu); d[(2 * i + 1) * 1024] = (unsigned short)(ww[i] >> 16);
                    const float a = __uint_as_float(ww[i] << 16), b = __uint_as_float(ww[i] & 0xffff0000u); ps[2 * i] += a * a; ps[2 * i + 1] += b * b; } }
        }
#pragma unroll
        for (int i = 0; i < 8; ++i) { float v = ps[i]; v += swz_xor<8>(v); v += swz_xor<16>(v);
            auto rr = __builtin_amdgcn_permlane32_swap(__float_as_uint(v), __float_as_uint(v), false, false); ps[i] = __uint_as_float(rr[0]) + __uint_as_float(rr[1]); }
        if ((F.lane >> 3) == 0) {
#pragma unroll
            for (int i = 0; i < 8; ++i) red[F.wave * TB + 8 * k + i] = ps[i]; }
        __syncthreads();
        if (tid < TB) { float s = 0.f;
#pragma unroll
            for (int w8 = 0; w8 < 8; ++w8) s += red[w8 * TB + tid];
            rinv[tid] = 1.0f / sqrtf(s * (1.0f / HYW) + EPS); }
        __syncthreads();
        const int cg = tid & 127;
        const f32x4 g0 = *(const f32x4*)(gn + 8 * cg), g1 = *(const f32x4*)(gn + 8 * cg + 4);
#pragma unroll 4
        for (int it = 0; it < 16; ++it) { const int tok = it * 4 + (tid >> 7); const float r = rinv[tok];
            const v4u q = *(const LAS v4u*)(tile + tok * 2048 + ((cg ^ (tok >> 3)) << 4));
            v4u o; o.x = pk2(__uint_as_float(q.x << 16) * r * g0[0], __uint_as_float(q.x & 0xffff0000u) * r * g0[1]); o.y = pk2(__uint_as_float(q.y << 16) * r * g0[2], __uint_as_float(q.y & 0xffff0000u) * r * g0[3]);
            o.z = pk2(__uint_as_float(q.z << 16) * r * g1[0], __uint_as_float(q.z & 0xffff0000u) * r * g1[1]); o.w = pk2(__uint_as_float(q.w << 16) * r * g1[2], __uint_as_float(q.w & 0xffff0000u) * r * g1[3]);
            *(GAS v4u*)(mixin + (size_t)(t0 + tok) * DM + 8 * cg) = o; }
    }
    __syncthreads();
}
__device__ __forceinline__ void attn_phase(Frame& F, const Args& A, int l, unsigned char* lds_generic) {
    const float li = 0.8f - 0.6f * expf(-0.3f * (float)l);
    float lam;
    { const int j = F.lane; const float a = GP(A.in[I_LQ1 + F.z])[l * 64 + j] * GP(A.in[I_LK1 + F.z])[l * 64 + j], b = GP(A.in[I_LQ2 + F.z])[l * 64 + j] * GP(A.in[I_LK2 + F.z])[l * 64 + j];
      lam = expf(wave_sum(a)) - expf(wave_sum(b)) + li; }
    const att::bf16* qkv = (const att::bf16*)(F.ws + WS_QKV); att::bf16* mixin = (att::bf16*)(F.ws + WS_MIXIN);
    float* stash = (float*)(F.ws + WS_H) + (size_t)F.bx * 64 * 512;
    const float* subln = GP(A.in[I_SUBLN + F.z]) + (size_t)l * 128;
    constexpr int NU = GSEQ * 8 * (SEQ / 256);
    for (int u = F.vcu; u < NU; u += F.G) {
        const int bvh = u >> 5, qb = u & 31, b = bvh >> 3, vh = bvh & 7;
        const long krow0 = (long)b * SEQ, qrow0 = krow0 + qb * 256;
        att::attn_unit(qkv, qrow0, krow0, vh, SEQ, lam, 1.0f - li, subln, mixin + (size_t)qrow0 * DM + HYW + vh * 128, DM, stash, (char*)lds_generic);
        __syncthreads();
    }
}
#ifndef PHMASK
#define PHMASK 511
#endif
__global__ void __launch_bounds__(NTHR, 2) hymba_fwd(Args args) {
    extern __shared__ __attribute__((aligned(16))) unsigned char lds[];
    Frame F;
    F.lds = (LAS unsigned char*)lds; F.MISC = (volatile LAS unsigned*)(F.lds + MISC_OFF);
    F.tid = threadIdx.x; F.lane = F.tid & 63; F.wave = __builtin_amdgcn_readfirstlane(F.tid >> 6);
    F.G = gridDim.x; { const int bx = blockIdx.x; F.vcu = (F.G % 8 == 0) ? (bx % 8) * (F.G / 8) + bx / 8 : bx; F.bx = bx; }
    F.vcu0 = F.vcu; F.G0 = F.G; F.bx0 = F.bx;
    F.ctl = (gu32*)(args.ws + WS_CTL); F.out = args.out; F.ws = args.ws; F.ws0 = args.ws; F.z = 0;
    for (int u = F.tid; u < (LDS_BYTES - MISC_OFF) / 4; u += NTHR) ((LAS unsigned*)(F.lds + MISC_OFF))[u] = 0u;
    __syncthreads();
    XcdBarrier bar; bar.bar = (unsigned*)(F.ctl + CW_BAR); bar.x = 0; bar.st = nullptr;
    if (!MK_PER_PHASE) bar = xcd_barrier_post((unsigned*)(F.ctl + CW_BAR), F.MISC + 8);
    const int lo = args.ph_lo, hi = args.ph_hi;
    int ph = 0;
#define IN_() (lo <= ph && ph < hi && ({ LAUNDER_TID(F); true; }))
#define DUP3(...) do { __VA_ARGS__; if (PROBE_DUP == 3) { __VA_ARGS__; } } while (0)
#define SEAM() do { if (!MK_PER_PHASE && lo <= ph && ph + 1 < hi) { XcdBarrier b_ = bar; { unsigned long long p_ = (unsigned long long)b_.bar; unsigned x_ = b_.x; asm volatile("" : "+s"(p_), "+s"(x_)); b_.bar = (unsigned*)(GAS unsigned*)p_; b_.x = x_; } \
        xcd_barrier(b_); if (PROBE_DUP == 7) xcd_barrier(b_); } ++ph; } while (0)
    if ((PHMASK & 1) && IN_()) { p0_prologue(F, args); if (PROBE_DUP == 4) p0_prologue(F, args); }
    SEAM();
#define Hb ((bf16*)(F.ws + WS_H))
#define XB ((bf16*)(F.ws + WS_XB))
#define projT ((bf16*)(F.ws + WS_PROJT))
#define qkv ((bf16*)(F.ws + WS_QKV))
#define mix ((bf16*)(F.ws + WS_MIX))
#define ffh ((bf16*)(F.ws + WS_FFH))
#define mixin ((bf16*)(F.ws + WS_MIXIN))
#define wl (F.ws + WS_W + (size_t)l * SZ_WLAYER)
#define xin ((g == 0) ? GP(args.in[I_XP + F.z]) : GP(args.in[I_XS + F.z]) + (size_t)(g - 1) * MG * DM)
#define xres ((float*)(GAS float*)args.out + (size_t)g * MG * DM)
    for (int g = 0; g < NGRP; ++g) {
        if ((PHMASK & 2) && IN_()) norm_pass<false>(F, xin, nullptr, nullptr, nullptr, nullptr, GP(args.in[I_GMPRE + F.z]), Hb);
        SEAM();
        for (int l = 0; l < DEPTH; ++l) {
            if ((PHMASK & 4) && IN_()) {
                { pg8::Gemm gm{(const bf16*)(wl + OFF_WHY), Hb, HYIN, MG, DM}; pg8::StaticOrder S; S.init(HYIN, MG, F.G, F.bx);
                  pg8::EpiPlain E{projT, MG};
                  DUP3(pg8::gemm_phase<pg8::EpiPlain, pg8::StaticOrder, true, true>(F.lds + RING_OFF, gm, S, E)); }
                if (g == 0 || !args.taps_all) { pg8::Gemm gm{(const bf16*)(F.ws + WS_W4T) + (size_t)l * 4096 * KPAD, (const bf16*)(F.ws + WS_H3) + (size_t)l * SEQ * KPAD, 4096, SEQ, KPAD}; pg8::StaticOrder S; S.init(4096, SEQ, F.G, F.bx);
                  pg8::EpiPlain E{(bf16*)(F.ws + ((args.taps_all && l > 0) ? WS_TAPS_X + (size_t)(l - 1) * SZ_TAPS : WS_TAPS)), SEQ};
                  DUP3(pg8::gemm_phase<pg8::EpiPlain, pg8::StaticOrder, true, true>(F.lds + RING_OFF, gm, S, E)); }
                { pg8::Gemm gm{Hb, (const bf16*)(wl + OFF_WQKV), MG, QKVW, DM}; pg8::StaticOrder S; S.init(MG, QKVW, F.G, F.bx);
                  pg8::EpiRope E{qkv, QKVW, (const float*)(F.ws + WS_ROPE), QSCALE};
                  DUP3(pg8::gemm_phase<pg8::EpiRope, pg8::StaticOrder, true, true>(F.lds + RING_OFF, gm, S, E)); }
            }
            SEAM();
            if (IN_()) { if (PHMASK & 8) hyena_phase(F, args, l); if (PROBE_DUP == 2) hyena_phase(F, args, l); if (PHMASK & 16) attn_phase(F, args, l, lds); if (PROBE_DUP == 1) attn_phase(F, args, l, lds); }
            SEAM();
            if ((PHMASK & 32) && IN_()) { hynorm_phase(F, args, l); if (PROBE_DUP == 4) hynorm_phase(F, args, l); }
            SEAM();
            if ((PHMASK & 64) && IN_()) { pg8::Gemm gm{mixin, (const bf16*)(wl + OFF_WOUT), MG, DM, DM}; pg8::StaticOrder S; S.init(MG, DM, F.G, F.bx);
                pg8::EpiPlain E{mix, DM};
                DUP3(pg8::gemm_phase<pg8::EpiPlain, pg8::StaticOrder, true, true>(F.lds + RING_OFF, gm, S, E)); }
            SEAM();
            if ((PHMASK & 2) && IN_()) { if (l == 0) norm_pass<false>(F, xin, mix, GP(args.in[I_GMPOST + F.z]) + (size_t)l * DM, XB, nullptr, GP(args.in[I_GFPRE + F.z]) + (size_t)l * DM, Hb);
                else norm_pass<true>(F, XB, mix, GP(args.in[I_GMPOST + F.z]) + (size_t)l * DM, XB, nullptr, GP(args.in[I_GFPRE + F.z]) + (size_t)l * DM, Hb); }
            SEAM();
            if ((PHMASK & 128) && IN_()) { pg8::Gemm gm{Hb, (const bf16*)(wl + OFF_WGU), MG, GU, DM}; pg8::StaticOrder S; S.init(MG, GU, F.G, F.bx);
                pg8::EpiSwiGLU E{ffh, DFF};
                DUP3(pg8::gemm_phase<pg8::EpiSwiGLU, pg8::StaticOrder, true, true>(F.lds + RING_OFF, gm, S, E)); }
            SEAM();
            if ((PHMASK & 256) && IN_()) { pg8::Gemm gm{ffh, (const bf16*)(wl + OFF_WDN), MG, DM, DFF}; pg8::StaticOrder S; S.init(MG, DM, F.G, F.bx);
                pg8::EpiPlain E{mixin, DM};
                DUP3(pg8::gemm_phase<pg8::EpiPlain, pg8::StaticOrder, true, true>(F.lds + RING_OFF, gm, S, E)); }
            SEAM();
            if ((PHMASK & 2) && IN_()) { if (l + 1 < DEPTH) norm_pass<true>(F, XB, mixin, GP(args.in[I_GFPOST + F.z]) + (size_t)l * DM, XB, nullptr, GP(args.in[I_GMPRE + F.z]) + (size_t)(l + 1) * DM, Hb);
                else norm_pass<true>(F, XB, mixin, GP(args.in[I_GFPOST + F.z]) + (size_t)l * DM, nullptr, xres, nullptr, nullptr); }
            SEAM();
        }
    }
#undef IN_
#undef SEAM
#undef Hb
#undef XB
#undef projT
#undef qkv
#undef mix
#undef ffh
#undef mixin
#undef wl
#undef xin
#undef xres
}

extern "C" void kernel_launch(void* const* d_in, const int* in_sizes, int n_in, void* d_out, int out_size, void* d_ws, size_t ws_size, hipStream_t stream) {
    static int grid = 0;
    if (grid == 0) {
        if (n_in != 30 || in_sizes[0] != 2 * SEQ * DM || in_sizes[1] != 4 * SEQ * DM || out_size != NSEQ * SEQ * DM || ws_size < WS_END) {
            fprintf(stderr, "kernel_launch: shape mismatch (n_in %d, out %d, ws %zu, need %zu)\n", n_in, out_size, ws_size, (size_t)WS_END); grid = -1; return; }
        int dev = 0, cus = 0;
        if (hipGetDevice(&dev) != hipSuccess || hipDeviceGetAttribute(&cus, hipDeviceAttributeMultiprocessorCount, dev) != hipSuccess) { grid = -1; return; }
        if (hipFuncSetAttribute((const void*)hymba_fwd, hipFuncAttributeMaxDynamicSharedMemorySize, LDS_BYTES) != hipSuccess) { fprintf(stderr, "kernel_launch: hipFuncSetAttribute failed\n"); grid = -1; return; }
        int per_cu = 0;
        if (hipOccupancyMaxActiveBlocksPerMultiprocessor(&per_cu, (const void*)hymba_fwd, NTHR, LDS_BYTES) != hipSuccess || per_cu < 1) fprintf(stderr, "kernel_launch: occupancy query says %d\n", per_cu);
        (void)hipGetLastError();
        grid = cus;
    }
    if (grid < 0) return;
    if (hipMemsetAsync((char*)d_ws + WS_CTL, 0, CTL_ZERO_BYTES, stream) != hipSuccess) return;
    Args a{};
    for (int i = 0; i < 30; ++i) a.in[i] = (const float*)d_in[i];
    a.out = (float*)d_out; a.ws = (unsigned char*)d_ws; a.taps_all = (ws_size >= WS_END_X) ? 1 : 0;
#if MK_PER_PHASE
    for (int p = 0; p < NPHASE; ++p) { a.ph_lo = p; a.ph_hi = p + 1; hipLaunchKernelGGL(hymba_fwd, dim3(grid), dim3(NTHR), LDS_BYTES, stream, a); }
#else
    a.ph_lo = 0; a.ph_hi = NPHASE;
    hipLaunchKernelGGL(hymba_fwd, dim3(grid), dim3(NTHR), LDS_BYTES, stream, a);
#endif
    const hipError_t le = hipPeekAtLastError();
    if (le != hipSuccess) fprintf(stderr, "kernel_launch: launch failed: %s\n", hipGetErrorName(le));
}
```

```cpp
#include <hip/hip_runtime.h>
#include <hip/hip_bf16.h>
#include <cstdio>
#include <cstdint>
#include <cmath>
namespace pg8 {
#define PG8_LAS __attribute__((address_space(3)))
typedef unsigned short bf16_t;
typedef short bf16x8 __attribute__((ext_vector_type(8)));
typedef float f32x4 __attribute__((ext_vector_type(4)));
typedef unsigned u32x4 __attribute__((ext_vector_type(4)));
constexpr int BM = 256, BK = 64, HALF = 128, HTB = HALF * BK * 2  , STAGE_BYTES = 8 * HTB, NXCD = 8, WGM = 8;

__host__ __device__ __forceinline__ int lds_byte(int r, int c) { const int st = (r >> 4) * 2 + (c >> 5), rr = r & 15, cc = c & 31, ob = rr * 64 + cc * 2; return st * 1024 + (ob ^ (((ob >> 9) & 1) << 5)); }
__host__ __device__ __forceinline__ void stage_rc(int b, int& R, int& C) { const int st = b / 1024, sb = b % 1024, swz = sb ^ (((sb >> 9) & 1) << 5); R = (st >> 1) * 16 + swz / 64; C = (st & 1) * 32 + (swz % 64) / 2; }
__host__ __device__ __forceinline__ int perm32(int rho) { const int n = rho >> 4, i = rho & 15; return 8 * (i >> 2) + 4 * n + (i & 3); }

struct Unit { int pm, pn; };
struct Gemm { const bf16_t* A; const bf16_t* Bt; int M, N, K; };

struct StaticOrder {
    int nM, nN, nwg, G, c;
    __host__ __device__ void init(int M, int N, int G_, int c_) { nM = M / BM; nN = N / BM; nwg = nM * nN; G = G_; c = c_; }
    __host__ __device__ bool next(int i, Unit& u) const {
        const long L = (long)i * G + c; if (L >= nwg) return false;
        int wgid = (int)L; { const int q = nwg / NXCD, r = nwg % NXCD, xcd = wgid % NXCD, off = wgid / NXCD; wgid = (xcd < r ? xcd * (q + 1) : r * (q + 1) + (xcd - r) * q) + off; }
        const int nig = WGM * nN, gid = wgid / nig, fm = gid * WGM, gsz = (nM - fm) < WGM ? (nM - fm) : WGM;
        u.pm = fm + ((wgid % nig) % gsz); u.pn = (wgid % nig) / gsz; return true;
    }
    __device__ __forceinline__ void a_ready(const Unit&) const {}
    __device__ __forceinline__ void done(const Unit&) const {}
};

__device__ __forceinline__ unsigned cvt_pk_bf16(float lo, float hi) { unsigned r; asm volatile("v_cvt_pk_bf16_f32 %0, %1, %2" : "=v"(r) : "v"(lo), "v"(hi)); return r; }
typedef float f32x2 __attribute__((ext_vector_type(2)));
struct EpiPlain {
    static constexpr bool PERM = true, AFTER_DRAIN = false;
    bf16_t* O; int ldc;
    __device__ __forceinline__ void operator()(const f32x4 (&acc)[2][2][4][2], const Unit& u, int wr, int wc, int fr, int fq) const {
        const int row0 = u.pm * BM + wr * 64 + fr, col0 = u.pn * BM + wc * 32 + 8 * fq;
#pragma unroll
        for (int ai = 0; ai < 2; ++ai)
#pragma unroll
            for (int m = 0; m < 4; ++m) { bf16_t* rowp = O + (size_t)(row0 + ai * HALF + m * 16) * ldc + col0;
#pragma unroll
                for (int bj = 0; bj < 2; ++bj) { const f32x4 v0 = acc[ai][bj][m][0], v1 = acc[ai][bj][m][1];
                    u32x4 w; w.x = cvt_pk_bf16(v0[0], v0[1]); w.y = cvt_pk_bf16(v0[2], v0[3]); w.z = cvt_pk_bf16(v1[0], v1[1]); w.w = cvt_pk_bf16(v1[2], v1[3]);
                    *(u32x4*)(rowp + bj * HALF) = w; } }
    }
};
struct EpiRope {
    static constexpr bool PERM = true, AFTER_DRAIN = false;
    bf16_t* O; int ldc; const float* cs; float qscale;
    __device__ __forceinline__ void operator()(const f32x4 (&acc)[2][2][4][2], const Unit& u, int wr, int wc, int fr, int fq) const {
        const int row0 = u.pm * BM + wr * 64 + fr, col0 = u.pn * BM + wc * 32 + 8 * fq;
        const bool rope = u.pn < 8; const float sc = u.pn < 4 ? qscale : 1.0f;
        const int p0 = 16 * (wc & 1) + 4 * fq;
        f32x4 tt[2][4][2];
#pragma unroll
        for (int ai = 0; ai < 2; ++ai)
#pragma unroll
            for (int m = 0; m < 4; ++m) { tt[ai][m][0] = (f32x4){1.f, 0.f, 1.f, 0.f}; tt[ai][m][1] = (f32x4){1.f, 0.f, 1.f, 0.f};
                if (rope) { const int row = row0 + ai * HALF + m * 16; const __attribute__((address_space(1))) float* tp = (const __attribute__((address_space(1))) float*)cs + ((size_t)(row & 8191) * 32 + p0) * 2;
                    tt[ai][m][0] = *(const __attribute__((address_space(1))) f32x4*)tp; tt[ai][m][1] = *(const __attribute__((address_space(1))) f32x4*)(tp + 4); } }
#pragma unroll
        for (int ai = 0; ai < 2; ++ai)
#pragma unroll
            for (int m = 0; m < 4; ++m) { const int row = row0 + ai * HALF + m * 16; bf16_t* rowp = O + (size_t)row * ldc + col0;
                const f32x4 t0 = tt[ai][m][0], t1 = tt[ai][m][1];
#pragma unroll
                for (int bj = 0; bj < 2; ++bj) { const f32x4 v0 = acc[ai][bj][m][0], v1 = acc[ai][bj][m][1];
                    f32x4 o0, o1;
                    o0[0] = (v0[0] * t0[0] - v0[1] * t0[1]) * sc; o0[1] = (v0[0] * t0[1] + v0[1] * t0[0]) * sc;
                    o0[2] = (v0[2] * t0[2] - v0[3] * t0[3]) * sc; o0[3] = (v0[2] * t0[3] + v0[3] * t0[2]) * sc;
                    o1[0] = (v1[0] * t1[0] - v1[1] * t1[1]) * sc; o1[1] = (v1[0] * t1[1] + v1[1] * t1[0]) * sc;
                    o1[2] = (v1[2] * t1[2] - v1[3] * t1[3]) * sc; o1[3] = (v1[2] * t1[3] + v1[3] * t1[2]) * sc;
                    u32x4 w; w.x = cvt_pk_bf16(o0[0], o0[1]); w.y = cvt_pk_bf16(o0[2], o0[3]); w.z = cvt_pk_bf16(o1[0], o1[1]); w.w = cvt_pk_bf16(o1[2], o1[3]);
                    *(u32x4*)(rowp + bj * HALF) = w; } }
    }
};
struct EpiSwiGLU {
    static constexpr bool PERM = true, AFTER_DRAIN = false;
    bf16_t* O; int ldc;
    static __device__ __forceinline__ float silu_mul(float g, float u) { return g * u * __builtin_amdgcn_rcpf(1.0f + __builtin_amdgcn_exp2f(-1.4426950408889634f * g)); }
    __device__ __forceinline__ void operator()(const f32x4 (&acc)[2][2][4][2], const Unit& u, int wr, int wc, int fr, int fq) const {
        const int row0 = u.pm * BM + wr * 64 + fr, col0 = u.pn * HALF + wc * 32 + 8 * fq;
#pragma unroll
        for (int ai = 0; ai < 2; ++ai)
#pragma unroll
            for (int m = 0; m < 4; ++m) { bf16_t* rowp = O + (size_t)(row0 + ai * HALF + m * 16) * ldc + col0;
                const f32x4 g0 = acc[ai][0][m][0], g1 = acc[ai][0][m][1], u0 = acc[ai][1][m][0], u1 = acc[ai][1][m][1];
                u32x4 w; w.x = cvt_pk_bf16(silu_mul(g0[0], u0[0]), silu_mul(g0[1], u0[1])); w.y = cvt_pk_bf16(silu_mul(g0[2], u0[2]), silu_mul(g0[3], u0[3]));
                w.z = cvt_pk_bf16(silu_mul(g1[0], u1[0]), silu_mul(g1[1], u1[1])); w.w = cvt_pk_bf16(silu_mul(g1[2], u1[2]), silu_mul(g1[3], u1[3]));
                *(u32x4*)rowp = w; }
    }
};
template <class Epi, class Sched, bool ALIGN_EPI = false, bool SP2 = false>
__device__ __forceinline__ void gemm_phase(PG8_LAS unsigned char* lds, const Gemm g, const Sched& S, const Epi& E) {
    int tid = threadIdx.x; asm volatile("" : "+v"(tid));
    const int wid = __builtin_amdgcn_readfirstlane(tid >> 6), lane = tid & 63, wr = wid >> 2, wc = wid & 3, fr = lane & 15, fq = lane >> 4;
    const int K = g.K, nt = K / BK;
    unsigned voffA[2], voffB[2];
#pragma unroll
    for (int i = 0; i < 2; ++i) { int R, C; stage_rc(tid * 16 + i * 8192, R, C); const int Rb = Epi::PERM ? ((R & ~31) + perm32(R & 31)) : R;
        voffA[i] = (unsigned)(R * K + C) * 2u; voffB[i] = (unsigned)(Rb * K + C) * 2u; }
    const size_t kstep = (size_t)(BK * 2);
    const size_t hstep = (size_t)HALF * K * 2;
    const size_t tstep = 2 * hstep;
    const unsigned ldsw = (unsigned)wid * 1024u;
    const int aoff = lds_byte(wr * 64 + fr, fq * 8), boff = lds_byte(wc * 32 + fr, fq * 8);
#define PG8_SA(b, h) (((b) * 2 + (h)) * HTB)
#define PG8_SB(b, h) ((4 + (b) * 2 + (h)) * HTB)
#define PG8_STAGE(bufoff, gbase, voff) do { _Pragma("unroll") for (int _i = 0; _i < 2; ++_i) \
        __builtin_amdgcn_global_load_lds((const unsigned*)((const char*)(gbase) + (voff)[_i]), (PG8_LAS unsigned*)(lds + (bufoff) + ldsw + _i * 8192), 16, 0, 0); } while (0)
#define PG8_LDA(dst, b, h) do { _Pragma("unroll") for (int m = 0; m < 4; ++m) _Pragma("unroll") for (int k = 0; k < 2; ++k) dst[m][k] = *(const PG8_LAS bf16x8*)(lds + PG8_SA(b, h) + aoff + m * 2048 + k * 1024); } while (0)
#define PG8_LDB(dst, b, h) do { _Pragma("unroll") for (int n = 0; n < 2; ++n) _Pragma("unroll") for (int k = 0; k < 2; ++k) dst[n][k] = *(const PG8_LAS bf16x8*)(lds + PG8_SB(b, h) + boff + n * 2048 + k * 1024); } while (0)
#define PG8_MMA(ai, bj, At, Bt) do { __builtin_amdgcn_s_setprio(1); _Pragma("unroll") for (int m = 0; m < 4; ++m) _Pragma("unroll") for (int n = 0; n < 2; ++n) _Pragma("unroll") for (int k = 0; k < 2; ++k) \
        acc[ai][bj][m][n] = __builtin_amdgcn_mfma_f32_16x16x32_bf16(Bt[n][k], At[m][k], acc[ai][bj][m][n], 0, 0, 0); __builtin_amdgcn_s_setprio(0); } while (0)
#define PG8_WAIT_V(n) asm volatile("s_waitcnt vmcnt(" #n ")" ::: "memory")
#define PG8_WAIT_L(n) asm volatile("s_waitcnt lgkmcnt(" #n ")" ::: "memory")
#define PG8_BAR __builtin_amdgcn_s_barrier()
#define PG8_SCHED __builtin_amdgcn_sched_barrier(0)
    Unit cur, nxt; int ui = 0;
    if (!S.next(0, cur)) return;
    f32x4 acc[2][2][4][2];
#pragma unroll
    for (int a = 0; a < 2; ++a)
#pragma unroll
        for (int b = 0; b < 2; ++b)
#pragma unroll
            for (int m = 0; m < 4; ++m)
#pragma unroll
                for (int n = 0; n < 2; ++n) acc[a][b][m][n] = (f32x4){0.f, 0.f, 0.f, 0.f};
    bf16x8 At[4][2], B0[2][2], B1[2][2];
    const char* cA = (const char*)g.A + (size_t)cur.pm * tstep; const char* cB = (const char*)g.Bt + (size_t)cur.pn * tstep;
    S.a_ready(cur);
    if constexpr (SP2) {
        PG8_STAGE(PG8_SB(0, 0), cB, voffB); PG8_STAGE(PG8_SB(0, 1), cB + hstep, voffB); PG8_STAGE(PG8_SA(0, 0), cA, voffA); PG8_STAGE(PG8_SA(0, 1), cA + hstep, voffA);
        if (wr == 1) PG8_BAR;
        PG8_WAIT_V(2); PG8_BAR;
        PG8_STAGE(PG8_SB(1, 0), cB + kstep, voffB); PG8_STAGE(PG8_SA(1, 0), cA + kstep, voffA); PG8_STAGE(PG8_SB(1, 1), cB + hstep + kstep, voffB);
        PG8_WAIT_V(6); PG8_BAR;
    } else {
        PG8_STAGE(PG8_SB(0, 0), cB, voffB); PG8_STAGE(PG8_SA(0, 0), cA, voffA); PG8_STAGE(PG8_SB(0, 1), cB + hstep, voffB); PG8_STAGE(PG8_SA(0, 1), cA + hstep, voffA);
        if (wr == 1) PG8_BAR;
        PG8_WAIT_V(4); PG8_BAR;
        PG8_STAGE(PG8_SB(1, 0), cB + kstep, voffB); PG8_STAGE(PG8_SA(1, 0), cA + kstep, voffA); PG8_STAGE(PG8_SB(1, 1), cB + hstep + kstep, voffB);
        PG8_WAIT_V(6); PG8_BAR;
    }
    for (;;) {
        const bool has_next = S.next(ui + 1, nxt);
        const char* nA = has_next ? (const char*)g.A + (size_t)nxt.pm * tstep : cA; const char* nB = has_next ? (const char*)g.Bt + (size_t)nxt.pn * tstep : cB;
        for (int t = 0; t < nt; t += 2) {
            const bool last = (t == nt - 2);
            const char* a1 = cA + (size_t)(t + 1) * kstep;
            const char* a2 = last ? nA : cA + (size_t)(t + 2) * kstep; const char* b2 = last ? nB : cB + (size_t)(t + 2) * kstep;
            const char* a3 = a2 + kstep; const char* b3 = b2 + kstep;
            if (last && has_next) S.a_ready(nxt);
            if constexpr (SP2) {
            PG8_LDB(B0, 0, 0); PG8_LDB(B1, 0, 1); PG8_SCHED; PG8_LDA(At, 0, 0); PG8_STAGE(PG8_SA(1, 1), a1 + hstep, voffA);
            PG8_WAIT_V(8); PG8_WAIT_L(0); PG8_BAR; PG8_MMA(0, 0, At, B0); PG8_MMA(0, 1, At, B1); PG8_BAR; PG8_SCHED;
            PG8_LDA(At, 0, 1); PG8_STAGE(PG8_SB(0, 0), b2, voffB); PG8_STAGE(PG8_SB(0, 1), b2 + hstep, voffB); PG8_STAGE(PG8_SA(0, 0), a2, voffA);
            PG8_WAIT_V(8); PG8_WAIT_L(0); PG8_BAR; PG8_MMA(1, 0, At, B0); PG8_MMA(1, 1, At, B1); PG8_BAR; PG8_SCHED;
            PG8_LDB(B0, 1, 0); PG8_LDB(B1, 1, 1); PG8_SCHED; PG8_LDA(At, 1, 0); PG8_STAGE(PG8_SA(0, 1), a2 + hstep, voffA);
            PG8_WAIT_V(8); PG8_WAIT_L(0); PG8_BAR; PG8_MMA(0, 0, At, B0); PG8_MMA(0, 1, At, B1); PG8_BAR; PG8_SCHED;
            PG8_LDA(At, 1, 1); PG8_STAGE(PG8_SB(1, 0), b3, voffB); PG8_STAGE(PG8_SB(1, 1), b3 + hstep, voffB); PG8_STAGE(PG8_SA(1, 0), a3, voffA);
            PG8_WAIT_V(8); PG8_WAIT_L(0); PG8_BAR; PG8_MMA(1, 0, At, B0); PG8_MMA(1, 1, At, B1); PG8_BAR; PG8_SCHED;
            } else {
            PG8_LDB(B0, 0, 0); PG8_SCHED; PG8_LDA(At, 0, 0); PG8_STAGE(PG8_SA(1, 1), a1 + hstep, voffA);
            PG8_WAIT_L(8); PG8_BAR; PG8_WAIT_L(0); PG8_MMA(0, 0, At, B0); PG8_BAR; PG8_SCHED;
            PG8_LDB(B1, 0, 1); PG8_STAGE(PG8_SB(0, 0), b2, voffB);
            PG8_BAR; PG8_WAIT_L(0); PG8_MMA(0, 1, At, B1); PG8_BAR;
            PG8_LDA(At, 0, 1); PG8_STAGE(PG8_SA(0, 0), a2, voffA);
            PG8_BAR; PG8_WAIT_L(0); PG8_MMA(1, 0, At, B0); PG8_BAR; PG8_SCHED;
            PG8_STAGE(PG8_SB(0, 1), b2 + hstep, voffB);
            PG8_WAIT_V(6); PG8_BAR; PG8_MMA(1, 1, At, B1); PG8_BAR;
            PG8_LDB(B0, 1, 0); PG8_SCHED; PG8_LDA(At, 1, 0); PG8_STAGE(PG8_SA(0, 1), a2 + hstep, voffA);
            PG8_WAIT_L(8); PG8_BAR; PG8_WAIT_L(0); PG8_MMA(0, 0, At, B0); PG8_BAR; PG8_SCHED;
            PG8_LDB(B1, 1, 1); PG8_STAGE(PG8_SB(1, 0), b3, voffB);
            PG8_BAR; PG8_WAIT_L(0); PG8_MMA(0, 1, At, B1); PG8_BAR;
            PG8_LDA(At, 1, 1); PG8_STAGE(PG8_SA(1, 0), a3, voffA);
            PG8_BAR; PG8_WAIT_L(0); PG8_MMA(1, 0, At, B0); PG8_BAR; PG8_SCHED;
            PG8_STAGE(PG8_SB(1, 1), b3 + hstep, voffB);
            PG8_WAIT_V(6); PG8_BAR; PG8_MMA(1, 1, At, B1); PG8_BAR;
            }
        }
        if constexpr (ALIGN_EPI) { if (wr == 0) PG8_BAR; }
        if constexpr (!Epi::AFTER_DRAIN) { E(acc, cur, wr, wc, fr, fq); S.done(cur); }
        if (!has_next) break;
#pragma unroll
        for (int a = 0; a < 2; ++a)
#pragma unroll
            for (int b = 0; b < 2; ++b)
#pragma unroll
                for (int m = 0; m < 4; ++m)
#pragma unroll
                    for (int n = 0; n < 2; ++n) acc[a][b][m][n] = (f32x4){0.f, 0.f, 0.f, 0.f};
        cur = nxt; cA = nA; cB = nB; ++ui;
        if constexpr (ALIGN_EPI) { if (wr == 1) PG8_BAR; }
    }
    PG8_WAIT_V(0);
    if constexpr (!ALIGN_EPI) { if (wr == 0) PG8_BAR; }
    PG8_BAR;
    if constexpr (Epi::AFTER_DRAIN) { E.fused(acc, cur, wr, wc, fr, fq, lds, wid, lane); S.done(cur); }
#undef PG8_SA
#undef PG8_SB
#undef PG8_STAGE
#undef PG8_LDA
#undef PG8_LDB
#undef PG8_MMA
#undef PG8_WAIT_V
#undef PG8_WAIT_L
#undef PG8_BAR
#undef PG8_SCHED
}
}
namespace att {
using bf16x8 = __attribute__((ext_vector_type(8))) short;
using s16x4  = __attribute__((ext_vector_type(4))) short;
using f32x16 = __attribute__((ext_vector_type(16))) float;
using u32x4  = __attribute__((ext_vector_type(4))) unsigned;
typedef unsigned short bf16;
constexpr int DQ = 64, DV = 128, NW = 8, QBLK = 32, KVBLK = 64, LDR = 3072;
constexpr int SHM_V = KVBLK * DV * 2, SHM_K = KVBLK * DQ * 2, SHM_ATTN = 3 * SHM_V + 3 * SHM_K + NW * 64 * 4 + 64;
constexpr int SHM_ATTN_ALL = SHM_ATTN + NW * QBLK * DV * 2;
#ifndef ATT_OVF_LIMIT
#define ATT_OVF_LIMIT 1.152921504606847e18f
#endif
#ifndef ATT_SDEPTH
#define ATT_SDEPTH 2
#endif
constexpr float THR2 = 11.0f;
#define KSWZ64(row, colB) ((row) * 128 + ((colB) ^ ((((row) >> 1) & 7) << 4)))
#define SBAR() __builtin_amdgcn_sched_barrier(0)
template <int K> __device__ __forceinline__ float sx(float v) { return __builtin_bit_cast(float, __builtin_amdgcn_ds_swizzle(__builtin_bit_cast(int, v), (K << 10) | 0x1f)); }
__device__ __forceinline__ int crow(int r, int hi) { return (r & 3) + 8 * (r >> 2) + 4 * hi; }
__device__ __forceinline__ unsigned cvtpk(float lo, float hi) { unsigned r; asm volatile("v_cvt_pk_bf16_f32 %0, %1, %2" : "=v"(r) : "v"(lo), "v"(hi)); return r; }
__device__ __forceinline__ void partialSM(f32x16& p0, f32x16& p1, float& m_reg, float& mn, float& alpha) {
  float pmax = p0[0];
#pragma unroll
  for (int r = 1; r < 16; ++r) pmax = fmaxf(pmax, p0[r]);
#pragma unroll
  for (int r = 0; r < 16; ++r) pmax = fmaxf(pmax, p1[r]);
  { auto rr = __builtin_amdgcn_permlane32_swap(__float_as_uint(pmax), __float_as_uint(pmax), false, false);
    pmax = fmaxf(__uint_as_float(rr[0]), __uint_as_float(rr[1])); }
  if (__builtin_expect(__all(pmax - m_reg <= THR2), 1)) { mn = m_reg; alpha = 1.f; }
  else { mn = fmaxf(m_reg, pmax); alpha = __builtin_amdgcn_exp2f(m_reg - mn); m_reg = mn; }
#pragma unroll
  for (int r = 0; r < 16; ++r) p0[r] = p0[r] - mn;
#pragma unroll
  for (int r = 0; r < 16; ++r) p1[r] = p1[r] - mn;
#pragma unroll
  for (int r = 0; r < 16; ++r) p0[r] = __builtin_amdgcn_exp2f(p0[r]);
}
__device__ __forceinline__ void finishSM(f32x16& p0, f32x16& p1, float alpha, float& l_reg, bf16x8& pa0, bf16x8& pa1, bf16x8& pa2, bf16x8& pa3) {
#pragma unroll
  for (int r = 0; r < 16; ++r) p1[r] = __builtin_amdgcn_exp2f(p1[r]);
  float ps = 0;
#pragma unroll
  for (int r = 0; r < 16; ++r) ps += p0[r];
#pragma unroll
  for (int r = 0; r < 16; ++r) ps += p1[r];
  { auto rr = __builtin_amdgcn_permlane32_swap(__float_as_uint(ps), __float_as_uint(ps), false, false);
    ps = __uint_as_float(rr[0]) + __uint_as_float(rr[1]); }
  l_reg = l_reg * alpha + ps;
#define PK4(P, BASE, OUT) do { unsigned a0 = cvtpk(P[BASE + 0], P[BASE + 1]), a1 = cvtpk(P[BASE + 2], P[BASE + 3]);   \
    unsigned b0 = cvtpk(P[BASE + 4], P[BASE + 5]), b1 = cvtpk(P[BASE + 6], P[BASE + 7]);                              \
    auto r0 = __builtin_amdgcn_permlane32_swap(a0, b0, false, false); auto r1 = __builtin_amdgcn_permlane32_swap(a1, b1, false, false); \
    u32x4 w = {r0[0], r1[0], r0[1], r1[1]}; OUT = *reinterpret_cast<bf16x8*>(&w); } while (0)
  PK4(p0, 0, pa0); PK4(p0, 8, pa1); PK4(p1, 0, pa2); PK4(p1, 8, pa3);
#undef PK4
}
__device__ __forceinline__ void qkt(f32x16& p0, f32x16& p1, const char* Ks, const bf16x8* qr, int r32, int hi) {
  p0 = f32x16{}; p1 = f32x16{};
#pragma unroll
  for (int d0 = 0; d0 < 4; ++d0) { const int cb = (d0 * 16 + hi * 8) * 2;
    bf16x8 b0 = *reinterpret_cast<const bf16x8*>(Ks + KSWZ64(r32, cb));
    bf16x8 b1 = *reinterpret_cast<const bf16x8*>(Ks + KSWZ64(32 + r32, cb));
    p0 = __builtin_amdgcn_mfma_f32_32x32x16_bf16(b0, qr[d0], p0, 0, 0, 0);
    p1 = __builtin_amdgcn_mfma_f32_32x32x16_bf16(b1, qr[d0], p1, 0, 0, 0); }
}
__device__ __forceinline__ void qkt_ref(f32x16& p0, f32x16& p1, const char* Ks, const bf16x8* qr, const f32x16& negm, int r32, int hi) {
#pragma unroll
  for (int d0 = 0; d0 < 4; ++d0) { const int cb = (d0 * 16 + hi * 8) * 2;
    bf16x8 b0 = *reinterpret_cast<const bf16x8*>(Ks + KSWZ64(r32, cb));
    bf16x8 b1 = *reinterpret_cast<const bf16x8*>(Ks + KSWZ64(32 + r32, cb));
    if (d0 == 0) { p0 = __builtin_amdgcn_mfma_f32_32x32x16_bf16(b0, qr[0], negm, 0, 0, 0); p1 = __builtin_amdgcn_mfma_f32_32x32x16_bf16(b1, qr[0], negm, 0, 0, 0); }
    else { p0 = __builtin_amdgcn_mfma_f32_32x32x16_bf16(b0, qr[d0], p0, 0, 0, 0); p1 = __builtin_amdgcn_mfma_f32_32x32x16_bf16(b1, qr[d0], p1, 0, 0, 0); } }
}
__device__ __forceinline__ void exp_half(f32x16& p) {
#pragma unroll
  for (int r = 0; r < 16; ++r) p[r] = __builtin_amdgcn_exp2f(p[r]);
}
__device__ __forceinline__ void sub_exp_half(f32x16& p0, f32x16& p1, float m) {
#pragma unroll
  for (int r = 0; r < 16; ++r) p0[r] = p0[r] - m;
#pragma unroll
  for (int r = 0; r < 16; ++r) p1[r] = p1[r] - m;
#pragma unroll
  for (int r = 0; r < 16; ++r) p0[r] = __builtin_amdgcn_exp2f(p0[r]);
}
__device__ __forceinline__ void finishSM_fast(f32x16& p0, f32x16& p1, float& l_reg, bool& ovf, bf16x8& pa0, bf16x8& pa1, bf16x8& pa2, bf16x8& pa3) {
  float al = 1.f; float l0 = 0.f;
  finishSM(p0, p1, al, l0, pa0, pa1, pa2, pa3);
  ovf = ovf || !(l0 < ATT_OVF_LIMIT);
  l_reg += l0;
}
__device__ __forceinline__ int v_st(int k, int c) { const int kk = (k & ~0xC) | ((k & 4) << 1) | ((k & 8) >> 1); return ((kk >> 3) * 4 + (c >> 5)) * 512 + ((kk & 7) * 32 + (c & 31)) * 2; }
__device__ __forceinline__ int v_rd_base(int lane) { return ((lane & 3) << 3) | (((lane >> 2) & 3) << 6) | (((lane >> 4) & 1) << 5) | (((lane >> 5) & 1) << 8); }
constexpr int v_rd_off(int d0, int ks, int half) { return d0 * 512 + ks * 4096 + half * 2048; }
template <int OFF> __device__ __forceinline__ s16x4 tr_read(int vb) {
  s16x4 r; asm volatile("ds_read_b64_tr_b16 %0, %1 offset:%2" : "=&v"(r) : "v"(vb), "i"(OFF) : "memory"); return r;
}
template <int D0> __device__ __forceinline__ void pv_one(f32x16& od, int vb, bf16x8 pa0, bf16x8 pa1, bf16x8 pa2, bf16x8 pa3) {
  const s16x4 l0 = tr_read<v_rd_off(D0, 0, 0)>(vb), h0 = tr_read<v_rd_off(D0, 0, 1)>(vb), l1 = tr_read<v_rd_off(D0, 1, 0)>(vb), h1 = tr_read<v_rd_off(D0, 1, 1)>(vb);
  const s16x4 l2 = tr_read<v_rd_off(D0, 2, 0)>(vb), h2 = tr_read<v_rd_off(D0, 2, 1)>(vb), l3 = tr_read<v_rd_off(D0, 3, 0)>(vb), h3 = tr_read<v_rd_off(D0, 3, 1)>(vb);
  asm volatile("s_waitcnt lgkmcnt(0)" ::: "memory"); SBAR();
#define PK(L, H) (bf16x8){L[0], L[1], L[2], L[3], H[0], H[1], H[2], H[3]}
  od = __builtin_amdgcn_mfma_f32_32x32x16_bf16(pa0, PK(l0, h0), od, 0, 0, 0);
  od = __builtin_amdgcn_mfma_f32_32x32x16_bf16(pa1, PK(l1, h1), od, 0, 0, 0);
  od = __builtin_amdgcn_mfma_f32_32x32x16_bf16(pa2, PK(l2, h2), od, 0, 0, 0);
  od = __builtin_amdgcn_mfma_f32_32x32x16_bf16(pa3, PK(l3, h3), od, 0, 0, 0);
#undef PK
}
__device__ __forceinline__ void pv_d0(f32x16* o, int vb, bf16x8 pa0, bf16x8 pa1, bf16x8 pa2, bf16x8 pa3) {
  pv_one<0>(o[0], vb, pa0, pa1, pa2, pa3); pv_one<1>(o[1], vb, pa0, pa1, pa2, pa3); pv_one<2>(o[2], vb, pa0, pa1, pa2, pa3); pv_one<3>(o[3], vb, pa0, pa1, pa2, pa3);
}
__device__ __forceinline__ void glds16(const void* gsrc, unsigned lds_dst) { unsigned keep;
  asm volatile("s_mov_b32 %0, m0\n\ts_mov_b32 m0, %2\n\ts_nop 0\n\tglobal_load_lds_dwordx4 %1, off\n\ts_mov_b32 m0, %0" : "=&s"(keep) : "v"(gsrc), "s"(lds_dst) : "memory"); }
template <bool FAST>
__device__ __forceinline__ bool attn_map(const bf16* __restrict__ Kh, const bf16* __restrict__ Vh, const bf16* __restrict__ Qh  , int seq, char* V_lds, char* K_lds, float* ws_base,
                                         f32x16 (&o)[4], float& l_out) {
    int tid = threadIdx.x; asm volatile("" : "+v"(tid));
    const int wid = __builtin_amdgcn_readfirstlane(tid >> 6), r32 = tid & 31, hi = (tid >> 5) & 1;
    float* al_l = ws_base + wid * 64 + 32;
    const bf16* Qw = Qh + (long)(wid * QBLK + r32) * LDR + hi * 8;
    const int lane_ = tid & 63;
    const unsigned lds0 = (unsigned)(uintptr_t)V_lds;
    const bf16 *vsrc0, *vsrc1, *ksrc;
    { const int o0 = (2 * wid) * 1024 + 16 * lane_, o1 = o0 + 1024, ok = wid * 1024 + 16 * lane_;
      auto vmap = [](int o, int& k, int& c) { const int sub = o >> 9, w = o & 511, kk = ((sub >> 2) << 3) | (w >> 6); k = (kk & ~0xC) | ((kk & 4) << 1) | ((kk & 8) >> 1); c = (sub & 3) * 32 + ((w & 63) >> 1); };
      int k0_, c0_, k1_, c1_; vmap(o0, k0_, c0_); vmap(o1, k1_, c1_);
      vsrc0 = Vh + (long)k0_ * LDR + c0_; vsrc1 = Vh + (long)k1_ * LDR + c1_;
      const int row = ok >> 7, cb = (ok & 127) ^ (((row >> 1) & 7) << 4);
      ksrc = Kh + (long)row * LDR + (cb >> 1); }
    const int vb0 = (int)(uintptr_t)V_lds + v_rd_base(tid & 63);
    float m_reg = -1e30f, l_reg = 0; bf16x8 qr[4]; bool ovf = false;
#pragma unroll
    for (int d0 = 0; d0 < 4; ++d0) { o[d0] = f32x16{}; qr[d0] = *reinterpret_cast<const bf16x8*>(Qw + d0 * 16); }
#define DMA_TILE(t, b) do { const long ro_ = (long)(t) * KVBLK * LDR; \
      glds16(vsrc0 + ro_, (unsigned)__builtin_amdgcn_readfirstlane(lds0 + (b) * SHM_V + (2 * wid) * 1024)); \
      glds16(vsrc1 + ro_, (unsigned)__builtin_amdgcn_readfirstlane(lds0 + (b) * SHM_V + (2 * wid + 1) * 1024)); \
      glds16(ksrc + ro_, (unsigned)__builtin_amdgcn_readfirstlane(lds0 + 3 * SHM_V + (b) * SHM_K + wid * 1024)); } while (0)
#define DMA_WAIT() asm volatile("s_waitcnt vmcnt(0)" ::: "memory")
#define RESC(a) do { if constexpr (!FAST) { if (__any((a) < 1.f)) { if (hi == 0) al_l[r32] = (a); asm volatile("s_waitcnt lgkmcnt(0)" ::: "memory"); \
    _Pragma("unroll") for (int d = 0; d < 4; ++d) _Pragma("unroll") for (int r = 0; r < 16; ++r) o[d][r] *= al_l[crow(r, hi)]; } } } while (0)
#define PSM(P0, P1, MN, AL) do { if constexpr (FAST) exp_half(P0); else partialSM(P0, P1, m_reg, MN, AL); } while (0)
#define FSM(P0, P1, AL) do { if constexpr (FAST) finishSM_fast(P0, P1, l_reg, ovf, pa0, pa1, pa2, pa3); else finishSM(P0, P1, AL, l_reg, pa0, pa1, pa2, pa3); } while (0)
#define STEP(PN0, PN1, MNN, ALN, PO0, PO1, ALO, jj) do { \
      SBAR(); if constexpr (FAST) qkt_ref(PN0, PN1, K_lds + bc * SHM_K, qr, negm, r32, hi); else qkt(PN0, PN1, K_lds + bc * SHM_K, qr, r32, hi); \
      if ((jj) + 1 < NT) DMA_TILE((jj) + 1, bn);              \
      FSM(PO0, PO1, ALO); SBAR(); \
      pv_d0(o, vb0 + bp * SHM_V, pa0, pa1, pa2, pa3); PSM(PN0, PN1, MNN, ALN); RESC(ALN); \
      DMA_WAIT(); __syncthreads(); \
      bp = bc; bc = bn; bn = (bn == 2) ? 0 : bn + 1; } while (0)
    f32x16 pA0, pA1, pB0, pB1; float mnA = 0.f, mnB = 0.f, alA = 1.f, alB = 1.f; bf16x8 pa0, pa1, pa2, pa3; const int NT = seq / KVBLK;
    DMA_TILE(0, 0); DMA_WAIT(); __syncthreads();
    if (1 < NT) DMA_TILE(1, 1);
    qkt(pA0, pA1, K_lds, qr, r32, hi); partialSM(pA0, pA1, m_reg, mnA, alA);
    f32x16 negm = f32x16{};
    if constexpr (FAST) {
#pragma unroll
      for (int r = 0; r < 16; ++r) negm[r] = -m_reg;
      asm volatile("" : "+v"(negm));
    }
    DMA_WAIT(); __syncthreads();
    int bp = 0, bc = 1, bn = 2;
    for (int j = 1; j + 1 < NT; j += 2) {
      STEP(pB0, pB1, mnB, alB, pA0, pA1, alA, j);
      STEP(pA0, pA1, mnA, alA, pB0, pB1, alB, j + 1);
    }
    STEP(pB0, pB1, mnB, alB, pA0, pA1, alA, NT - 1);
    FSM(pB0, pB1, alB); SBAR();
    pv_d0(o, vb0 + bp * SHM_V, pa0, pa1, pa2, pa3);
#undef DMA_TILE
#undef DMA_WAIT
#undef RESC
#undef PSM
#undef FSM
#undef STEP
    l_out = l_reg;
    return ovf;
}
__device__ __forceinline__ void attn_unit(const bf16* __restrict__ qkv, long Qrow0, long Krow0, int vh, int seq, float lam, float oscale, const float* __restrict__ subln,
                                          bf16* __restrict__ Ob, int ldo, float* stash, char* lds) {
  int tid = threadIdx.x; asm volatile("" : "+v"(tid));
  const int wid = __builtin_amdgcn_readfirstlane(tid >> 6), lane = tid & 63, r32 = lane & 31, hi = lane >> 5;
  char* V_lds = lds; char* K_lds = lds + 3 * SHM_V;
  float* wsb = (float*)(lds + 3 * SHM_V + 3 * SHM_K); float* li_l = wsb + wid * 64;
  volatile unsigned* ovw = (volatile unsigned*)(lds + 3 * SHM_V + 3 * SHM_K + NW * 64 * 4);
  const bf16* Vh = qkv + Krow0 * LDR + 2048 + vh * DV;
  for (int s = 0; s < 2; ++s) {
    const int head = 2 * vh + s;
    const bf16* Kh = qkv + Krow0 * LDR + 1024 + head * DQ;
    const bf16* Qh = qkv + Qrow0 * LDR + head * DQ;
    f32x16 o[4]; float l_reg;
    const bool ovf = attn_map<true>(Kh, Vh, Qh, seq, V_lds, K_lds, wsb, o, l_reg);
    if (lane == 0) ovw[wid] = __any(ovf) ? 1u : 0u;
    __syncthreads();
    unsigned anyovf = 0u;
#pragma unroll
    for (int w = 0; w < NW; ++w) anyovf |= ovw[w];
    __syncthreads();
    if (__builtin_amdgcn_readfirstlane(anyovf) != 0u) (void)attn_map<false>(Kh, Vh, Qh, seq, V_lds, K_lds, wsb, o, l_reg);
    if (hi == 0) li_l[r32] = l_reg; asm volatile("s_waitcnt lgkmcnt(0)" ::: "memory");
    float rli[16];
#pragma unroll
    for (int r = 0; r < 16; ++r) rli[r] = __builtin_amdgcn_rcpf(li_l[crow(r, hi)]);
    typedef float f32x4_t __attribute__((ext_vector_type(4)));
    f32x4_t* st4 = (f32x4_t*)stash + (size_t)tid * 16;
    if (s == 0) {
#pragma unroll
      for (int d0 = 0; d0 < 4; ++d0)
#pragma unroll
        for (int r4 = 0; r4 < 4; ++r4) { f32x4_t v; v[0] = o[d0][4 * r4] * rli[4 * r4]; v[1] = o[d0][4 * r4 + 1] * rli[4 * r4 + 1]; v[2] = o[d0][4 * r4 + 2] * rli[4 * r4 + 2]; v[3] = o[d0][4 * r4 + 3] * rli[4 * r4 + 3]; st4[d0 * 4 + r4] = v; }
    } else {
      float ssq[16];
#pragma unroll
      for (int r = 0; r < 16; ++r) ssq[r] = 0.f;
#pragma unroll
      for (int d0 = 0; d0 < 4; ++d0)
#pragma unroll
        for (int r4 = 0; r4 < 4; ++r4) { const f32x4_t sv = st4[d0 * 4 + r4];
#pragma unroll
          for (int i = 0; i < 4; ++i) { const int r = 4 * r4 + i; const float v = sv[i] - lam * (o[d0][r] * rli[r]); o[d0][r] = v; ssq[r] += v * v; } }
#pragma unroll
      for (int r = 0; r < 16; ++r) {
        float a = ssq[r];
        a += sx<1>(a); a += sx<2>(a); a += sx<4>(a); a += sx<8>(a); a += sx<16>(a);
        ssq[r] = oscale / sqrtf(a * (1.0f / 128.0f) + 1e-6f);
      }
      float g[4];
#pragma unroll
      for (int d0 = 0; d0 < 4; ++d0) g[d0] = subln[d0 * 32 + r32];
      bf16* stg = (bf16*)(lds + SHM_ATTN) + wid * (QBLK * DV);
      unsigned so = (unsigned)((4 * hi) * DV + r32); asm volatile("" : "+v"(so));
#pragma unroll
      for (int r = 0; r < 16; ++r) {
#pragma unroll
        for (int d0 = 0; d0 < 4; ++d0) { const unsigned w = cvtpk(o[d0][r] * ssq[r] * g[d0], 0.f); (stg + ((r & 3) + 8 * (r >> 2)) * DV + d0 * 32)[so] = (bf16)(w & 0xffffu); } }
      asm volatile("s_waitcnt lgkmcnt(0)" ::: "memory");
      int ldo_ = ldo; asm volatile("" : "+s"(ldo_));
      bf16* Ow = Ob + (long)(wid * QBLK) * ldo_;
      const int srow = lane >> 4, sch = lane & 15;
#pragma unroll
      for (int i = 0; i < 8; ++i) { const int row = i * 4 + srow; const u32x4 v = *(const u32x4*)(stg + row * DV + sch * 8); *(u32x4*)(Ow + (long)row * ldo_ + sch * 8) = v; }
    }
  }
}
#undef SBAR
}
#define GAS __attribute__((address_space(1)))
#define LAS __attribute__((address_space(3)))
typedef unsigned short bf16;
typedef unsigned v4u __attribute__((ext_vector_type(4)));
typedef float f32x4 __attribute__((ext_vector_type(4)));
typedef short bf16x8 __attribute__((ext_vector_type(8)));
typedef GAS unsigned gu32;
typedef GAS unsigned long long gu64;
#define RLX_AGENT __ATOMIC_RELAXED, __HIP_MEMORY_SCOPE_AGENT
#define LDS_WAIT() asm volatile("s_waitcnt lgkmcnt(0)" ::: "memory")
#define VM_WAIT() asm volatile("s_waitcnt vmcnt(0)" ::: "memory")
__device__ __forceinline__ unsigned long long rt() { return __builtin_amdgcn_s_memrealtime(); }
__device__ __forceinline__ unsigned f2bf(float f) { unsigned u = __builtin_bit_cast(unsigned, f); return (u + 0x7fffu + ((u >> 16) & 1u)) >> 16; }
__device__ __forceinline__ unsigned pk2(float lo, float hi) { unsigned r; asm("v_cvt_pk_bf16_f32 %0, %1, %2" : "=v"(r) : "v"(lo), "v"(hi)); return r; }

#define XB_TMO      128
#define XB_XCNT(j)  (256  + 64 * (j))
#define XB_XSUB(j)  (1280 + 64 * (j))
#define XB_XGEN(j)  (2304 + 64 * (j))
#define XB_TOP      3328
#define XB_TOPGEN   3392
#define XCD_BAR_WORDS 3456
#define XB_SPIN_CAP (1u << 18)

__device__ __forceinline__ unsigned xb_ld(unsigned* p)              { return __hip_atomic_load(p, __ATOMIC_RELAXED, __HIP_MEMORY_SCOPE_AGENT); }
__device__ __forceinline__ unsigned xb_add(unsigned* p, unsigned v) { return __hip_atomic_fetch_add(p, v, __ATOMIC_RELAXED, __HIP_MEMORY_SCOPE_AGENT); }
__device__ __forceinline__ unsigned xb_xcc_id() { return (unsigned)__builtin_amdgcn_s_getreg((3 << 11) | 20) & 0xFu; }
#define XB_SPIN(cond, bar) do { unsigned _sp = 0; while (cond) { __builtin_amdgcn_s_sleep(1); \
    if ((++_sp & 255u) == 0u) { if (xb_ld(&(bar)[XB_TMO])) break; if (_sp > XB_SPIN_CAP) { atomicAdd(&(bar)[XB_TMO], 1u); break; } } } } while (0)

struct XcdBarrier {
    unsigned* bar; unsigned x;
    volatile LAS unsigned* st;
};

__device__ __forceinline__ XcdBarrier xcd_barrier_post(unsigned* bar, volatile LAS unsigned* st) {
    XcdBarrier b; b.bar = bar; b.x = xb_xcc_id(); b.st = st;
    if (threadIdx.x == 0) (void)xb_add(&bar[XB_XCNT(b.x)], 1u);
    return b;
}
__device__ __forceinline__ void xcd_barrier_complete(unsigned* bar, unsigned x, unsigned& nloc, unsigned& nx) {
    const unsigned G = gridDim.x * gridDim.y * gridDim.z;
    unsigned sum, cnt, mine, sp = 0u;
    for (;;) {
        sum = 0u; cnt = 0u; mine = 0u;
#pragma unroll
        for (unsigned j = 0; j < 16; ++j) { const unsigned c = xb_ld(&bar[XB_XCNT(j)]); sum += c; cnt += (c > 0u) ? 1u : 0u; mine = (j == x) ? c : mine; }
        if (sum == G) break;
        __builtin_amdgcn_s_sleep(1);
        if ((++sp & 255u) == 0u) { if (xb_ld(&bar[XB_TMO])) break; if (sp > XB_SPIN_CAP) { atomicAdd(&bar[XB_TMO], 1u); break; } }
    }
    nloc = mine > 0u ? mine : 1u; nx = cnt > 0u ? cnt : 1u;
}

__device__ __forceinline__ void xcd_barrier(const XcdBarrier& b) {
    asm volatile("s_waitcnt vmcnt(0)" ::: "memory");
    __syncthreads();
    if (threadIdx.x == 0) {
        unsigned* bar = b.bar;
        __builtin_amdgcn_s_waitcnt(0);
        unsigned nloc = b.st[0], nx = b.st[1];
        if (nloc == 0u) { xcd_barrier_complete(bar, b.x, nloc, nx); b.st[0] = nloc; b.st[1] = nx; }
        const unsigned old = xb_add(&bar[XB_XSUB(b.x)], 1u);
        const unsigned gen = old / nloc;
        if (old + 1u == (gen + 1u) * nloc) {
            __builtin_amdgcn_fence(__ATOMIC_RELEASE, "agent");
            asm volatile("s_waitcnt vmcnt(0)" ::: "memory");
            const unsigned og = xb_add(&bar[XB_TOP], 1u);
            const unsigned tg = og / nx;
            if (og + 1u == (tg + 1u) * nx) xb_add(&bar[XB_TOPGEN], 1u);
            else XB_SPIN(xb_ld(&bar[XB_TOPGEN]) == tg, bar);
            __builtin_amdgcn_fence(__ATOMIC_ACQUIRE, "agent");
            xb_add(&bar[XB_XGEN(b.x)], 1u);
            asm volatile("s_waitcnt vmcnt(0)" ::: "memory");
        } else {
            XB_SPIN(xb_ld(&bar[XB_XGEN(b.x)]) == gen, bar);
            __builtin_amdgcn_fence(__ATOMIC_ACQUIRE, "agent");
            asm volatile("s_waitcnt vmcnt(0)" ::: "memory");
        }
    }
    __syncthreads();
}
#define HYD __device__ __forceinline__
#define HYDM __device__ __forceinline__
#define HY_DEVICE 1
#ifdef HY_DEVICE
#define HY_OPAQUE(x) asm volatile("" : "+v"(x))
#else
#define HY_OPAQUE(x) (void)(x)
#endif
typedef float cf __attribute__((ext_vector_type(2)));
typedef float cf2 __attribute__((ext_vector_type(4)));
template <class P> struct HyP2 {};
template <> struct HyP2<cf*> { typedef cf2* type; };
#ifdef HY_DEVICE
template <> struct HyP2<__attribute__((address_space(3))) cf*> { typedef __attribute__((address_space(3))) cf2* type; };
#endif
HYD cf cf_add(cf a, cf b) { return a + b; }
HYD cf cf_sub(cf a, cf b) { return a - b; }
HYD cf cf_mul(cf a, cf b) { return cf{a.x * b.x - a.y * b.y, a.x * b.y + a.y * b.x}; }
HYD cf cf_mulc(cf a, cf b) { return cf{a.x * b.x + a.y * b.y, a.y * b.x - a.x * b.y}; }
constexpr int FN = 16384, FT = 512, FLOG = 14, FNP = FN + 4 * (FN >> 6);
constexpr int SEQL = 8192;
HYD int HP(int i) { return i + ((i >> 6) << 2); }
#define HY_C1 0.92387953251128674f
#define HY_S1 0.38268343236508977f
#define HY_R2 0.70710678118654752f
template <int M16> HYD cf mul_root16(cf w) {
    if (M16 == 0) return w;
    if (M16 == 4) return cf{w.y, -w.x};
    if (M16 == 2) return cf{(w.x + w.y) * HY_R2, (w.y - w.x) * HY_R2};
    if (M16 == 6) return cf{(w.y - w.x) * HY_R2, -(w.x + w.y) * HY_R2};
    if (M16 == 1) return cf_mul(w, cf{HY_C1, -HY_S1});
    if (M16 == 3) return cf_mul(w, cf{HY_S1, -HY_C1});
    if (M16 == 5) return cf_mul(w, cf{-HY_S1, -HY_C1});
    return cf_mul(w, cf{-HY_C1, -HY_S1});
}
template <int Q, int U, bool INV, bool ZUP, bool HLO> struct HyStage {
    static HYDM void run(cf (&e)[1 << Q], const cf (&tw)[Q]) {
        constexpr int R = 1 << Q, half = R >> (U + 1);
#pragma unroll
        for (int k = 0; k < R; ++k) {
            if ((k & half) == 0) {
                const int kp = k & (half - 1);
                cf w = tw[U];
                switch (kp * 16 / (2 * half)) {
                    case 0: break;
                    case 1: w = mul_root16<1>(w); break;
                    case 2: w = mul_root16<2>(w); break;
                    case 3: w = mul_root16<3>(w); break;
                    case 4: w = mul_root16<4>(w); break;
                    case 5: w = mul_root16<5>(w); break;
                    case 6: w = mul_root16<6>(w); break;
                    default: w = mul_root16<7>(w); break;
                }
                if (!INV) {
                    if (ZUP && U == 0) { e[k + half] = cf_mul(e[k], w); }
                    else { const cf a = e[k], b = e[k + half]; e[k] = cf_add(a, b); e[k + half] = cf_mul(cf_sub(a, b), w); }
                } else {
                    const cf a = e[k], b = cf_mulc(e[k + half], w); e[k] = cf_add(a, b);
                    if (!(HLO && U == 0)) e[k + half] = cf_sub(a, b);
                }
            }
        }
    }
};
template <int Q, bool INV, bool ZUP, bool HLO> HYD void hy_bfly(cf (&e)[1 << Q], cf t) {
    cf tw[Q]; tw[0] = t;
#pragma unroll
    for (int u = 1; u < Q; ++u) tw[u] = cf_mul(tw[u - 1], tw[u - 1]);
    if (Q == 4) {
        if (!INV) { HyStage<Q, 0, INV, ZUP, HLO>::run(e, tw); HyStage<Q, 1, INV, ZUP, HLO>::run(e, tw); HyStage<Q, 2 % Q, INV, ZUP, HLO>::run(e, tw); HyStage<Q, 3 % Q, INV, ZUP, HLO>::run(e, tw); }
        else      { HyStage<Q, 3 % Q, INV, ZUP, HLO>::run(e, tw); HyStage<Q, 2 % Q, INV, ZUP, HLO>::run(e, tw); HyStage<Q, 1, INV, ZUP, HLO>::run(e, tw); HyStage<Q, 0, INV, ZUP, HLO>::run(e, tw); }
    } else {
        if (!INV) { HyStage<Q, 0, INV, ZUP, HLO>::run(e, tw); HyStage<Q, 1, INV, ZUP, HLO>::run(e, tw); }
        else      { HyStage<Q, 1, INV, ZUP, HLO>::run(e, tw); HyStage<Q, 0, INV, ZUP, HLO>::run(e, tw); }
    }
}
#ifdef HY_DEVICE
#define HY_MULT(T, X, Y) "v_pk_mul_f32 " T ", " X ", " Y " op_sel:[1,1] op_sel_hi:[1,0]\n\t"
#define HY_FMAP(R, X, Y, T) "v_pk_fma_f32 " R ", " X ", " Y ", " T " op_sel_hi:[0,1,1] neg_lo:[0,0,1]\n\t"
#define HY_FMAC(R, X, Y, T) "v_pk_fma_f32 " R ", " X ", " Y ", " T " op_sel_hi:[0,1,1] neg_hi:[1,0,0]\n\t"
#define HY_ADD(R, A, B) "v_pk_add_f32 " R ", " A ", " B "\n\t"
#define HY_SUB(R, A, B) "v_pk_add_f32 " R ", " A ", " B " neg_lo:[0,1] neg_hi:[0,1]\n\t"
HYD void hy_cmul2(cf& r0, cf x0, cf y0, cf& r1, cf x1, cf y1) { cf t0, t1;
    asm(HY_MULT("%0", "%4", "%5") HY_MULT("%1", "%6", "%7") HY_FMAP("%2", "%4", "%5", "%0") HY_FMAP("%3", "%6", "%7", "%1")
        : "=&v"(t0), "=&v"(t1), "=&v"(r0), "=&v"(r1) : "v"(x0), "v"(y0), "v"(x1), "v"(y1)); }
HYD cf hy_cmul1(cf x, cf y) { cf t, r;
    asm(HY_MULT("%0", "%2", "%3") "s_nop 0\n\t" HY_FMAP("%1", "%2", "%3", "%0") : "=&v"(t), "=&v"(r) : "v"(x), "v"(y)); return r; }
HYD void hy_bf2_fwd(cf& a0, cf& b0, cf w0, cf& a1, cf& b1, cf w1) { cf d0, d1, t0, t1;
    asm(HY_SUB("%4", "%0", "%1") HY_ADD("%0", "%0", "%1") HY_SUB("%5", "%2", "%3") HY_ADD("%2", "%2", "%3")
        HY_MULT("%6", "%4", "%8") HY_MULT("%7", "%5", "%9") HY_FMAP("%1", "%4", "%8", "%6") HY_FMAP("%3", "%5", "%9", "%7")
        : "+v"(a0), "+v"(b0), "+v"(a1), "+v"(b1), "=&v"(d0), "=&v"(d1), "=&v"(t0), "=&v"(t1) : "v"(w0), "v"(w1)); }
HYD void hy_bf2_fwdz(cf a0, cf& b0, cf w0, cf a1, cf& b1, cf w1) { hy_cmul2(b0, a0, w0, b1, a1, w1); }
HYD void hy_bf2_inv(cf& a0, cf& b0, cf w0, cf& a1, cf& b1, cf w1) { cf t0, t1;
    asm(HY_MULT("%4", "%1", "%6") HY_MULT("%5", "%3", "%7") HY_FMAC("%4", "%1", "%6", "%4") HY_FMAC("%5", "%3", "%7", "%5")
        HY_SUB("%1", "%0", "%4") HY_SUB("%3", "%2", "%5") HY_ADD("%0", "%0", "%4") HY_ADD("%2", "%2", "%5")
        : "+v"(a0), "+v"(b0), "+v"(a1), "+v"(b1), "=&v"(t0), "=&v"(t1) : "v"(w0), "v"(w1)); }
HYD void hy_bf2_invl(cf& a0, cf b0, cf w0, cf& a1, cf b1, cf w1) { cf t0, t1;
    asm(HY_MULT("%2", "%4", "%6") HY_MULT("%3", "%5", "%7") HY_FMAC("%2", "%4", "%6", "%2") HY_FMAC("%3", "%5", "%7", "%3")
        HY_ADD("%0", "%0", "%2") HY_ADD("%1", "%1", "%3")
        : "+v"(a0), "+v"(a1), "=&v"(t0), "=&v"(t1) : "v"(b0), "v"(b1), "v"(w0), "v"(w1)); }
HYD cf hy_rot(cf w) { cf r; asm("v_pk_add_f32 %0, %1, 0 op_sel:[1,0] op_sel_hi:[0,0] neg_hi:[1,0]" : "=v"(r) : "v"(w)); return r; }
#else
HYD void hy_cmul2(cf& r0, cf x0, cf y0, cf& r1, cf x1, cf y1) { const cf p0 = cf_mul(x0, y0), p1 = cf_mul(x1, y1); r0 = p0; r1 = p1; }
HYD cf hy_cmul1(cf x, cf y) { return cf_mul(x, y); }
HYD void hy_bf2_fwd(cf& a0, cf& b0, cf w0, cf& a1, cf& b1, cf w1) { const cf d0 = cf_sub(a0, b0), d1 = cf_sub(a1, b1); a0 = cf_add(a0, b0); a1 = cf_add(a1, b1); b0 = cf_mul(d0, w0); b1 = cf_mul(d1, w1); }
HYD void hy_bf2_fwdz(cf a0, cf& b0, cf w0, cf a1, cf& b1, cf w1) { b0 = cf_mul(a0, w0); b1 = cf_mul(a1, w1); }
HYD void hy_bf2_inv(cf& a0, cf& b0, cf w0, cf& a1, cf& b1, cf w1) { const cf p0 = cf_mulc(b0, w0), p1 = cf_mulc(b1, w1); b0 = cf_sub(a0, p0); b1 = cf_sub(a1, p1); a0 = cf_add(a0, p0); a1 = cf_add(a1, p1); }
HYD void hy_bf2_invl(cf& a0, cf b0, cf w0, cf& a1, cf b1, cf w1) { a0 = cf_add(a0, cf_mulc(b0, w0)); a1 = cf_add(a1, cf_mulc(b1, w1)); }
HYD cf hy_rot(cf w) { return cf{w.y, -w.x}; }
#endif
template <int U, bool INV, bool ZUP, bool HLO> HYD void hy_stage16(cf (&e)[16], const cf* W) {
    constexpr int half = 8 >> U;
#pragma unroll
    for (int j = 0; j < 8; j += 2) {
        const int k0 = ((j / half) * 2 * half) + (j % half), k1 = (((j + 1) / half) * 2 * half) + ((j + 1) % half);
        const cf w0 = W[k0 & (half - 1)], w1 = W[k1 & (half - 1)];
        if (!INV) { if (ZUP && U == 0) hy_bf2_fwdz(e[k0], e[k0 + half], w0, e[k1], e[k1 + half], w1); else hy_bf2_fwd(e[k0], e[k0 + half], w0, e[k1], e[k1 + half], w1); }
        else { if (HLO && U == 0) hy_bf2_invl(e[k0], e[k0 + half], w0, e[k1], e[k1 + half], w1); else hy_bf2_inv(e[k0], e[k0 + half], w0, e[k1], e[k1 + half], w1); }
    }
}
template <bool INV, bool ZUP, bool HLO> HYD void hy_bfly16(cf (&e)[16], cf t) {
    cf W0[8], W1[4], W2[2], W3[1], tw1, tw2;
    cf k1 = cf{HY_C1, -HY_S1}, k2 = cf{HY_R2, -HY_R2}, k3 = cf{HY_S1, -HY_C1};
    W0[0] = t;
    hy_cmul2(W0[1], t, k1, W0[3], t, k3);
    hy_cmul2(W0[2], t, k2, tw1, t, t);
    W1[0] = tw1;
    hy_cmul2(W1[1], tw1, k2, tw2, tw1, tw1);
    W2[0] = tw2;
    W3[0] = hy_cmul1(tw2, tw2);
#pragma unroll
    for (int i = 0; i < 4; ++i) W0[4 + i] = hy_rot(W0[i]);
    W1[2] = hy_rot(W1[0]); W1[3] = hy_rot(W1[1]); W2[1] = hy_rot(W2[0]);
    if (!INV) { hy_stage16<0, INV, ZUP, HLO>(e, W0); hy_stage16<1, INV, ZUP, HLO>(e, W1); hy_stage16<2, INV, ZUP, HLO>(e, W2); hy_stage16<3, INV, ZUP, HLO>(e, W3); }
    else      { hy_stage16<3, INV, ZUP, HLO>(e, W3); hy_stage16<2, INV, ZUP, HLO>(e, W2); hy_stage16<1, INV, ZUP, HLO>(e, W1); hy_stage16<0, INV, ZUP, HLO>(e, W0); }
}
template <class PT> HYD cf hy_twid(PT thi, PT tlo, int e) { return hy_cmul1(thi[e >> 7], tlo[e & 127]); }
template <int S, bool INV, bool ZUP, bool HLO, class P, class PT>
HYD void hy_pass16(P X, PT thi, PT tlo, int tid) {
    constexpr int R = 16;
    constexpr int SP = (S >= 64) ? S + S / 16 : S;
    const int g0 = tid, g1 = tid + FT;
    const int lo0 = g0 & (S - 1), pb0 = HP((g0 / S) * S * R + lo0);
    const int lo1 = g1 & (S - 1), pb1 = HP((g1 / S) * S * R + lo1);
    cf e0[R], e1[R];
#pragma unroll
    for (int k = 0; k < R; ++k) { if (ZUP && k >= 8) e0[k] = cf{0.f, 0.f}; else e0[k] = X[pb0 + k * SP]; }
#pragma unroll
    for (int k = 0; k < R; ++k) { if (ZUP && k >= 8) e1[k] = cf{0.f, 0.f}; else e1[k] = X[pb1 + k * SP]; }
    const cf t0 = hy_twid(thi, tlo, lo0 * (FN / (R * S))), t1 = hy_twid(thi, tlo, lo1 * (FN / (R * S)));
    hy_bfly16<INV, ZUP, HLO>(e0, t0);
#pragma unroll
    for (int k = 0; k < R; ++k) { if (!(HLO && k >= 8)) X[pb0 + k * SP] = e0[k]; }
    hy_bfly16<INV, ZUP, HLO>(e1, t1);
#pragma unroll
    for (int k = 0; k < R; ++k) { if (!(HLO && k >= 8)) X[pb1 + k * SP] = e1[k]; }
}
typedef _Float16 hy_h2 __attribute__((ext_vector_type(2)));
HYD unsigned hy_pack_h2(float re, float im) { const hy_h2 v = {(_Float16)re, (_Float16)im}; return __builtin_bit_cast(unsigned, v); }
HYD cf hy_unpack_h2(unsigned u, float s) { const hy_h2 v = __builtin_bit_cast(hy_h2, u); return cf{(float)v.x * s, (float)v.y * s}; }
typedef unsigned hy_u4 __attribute__((ext_vector_type(4)));
template <bool INV> HYD void hy_r4(cf (&e)[4]) {
    if (!INV) {
        const cf a0 = e[0] + e[2], b0 = e[0] - e[2], a1 = e[1] + e[3], d = e[1] - e[3], b1 = cf{d.y, -d.x};
        e[0] = a0 + a1; e[1] = a0 - a1; e[2] = b0 + b1; e[3] = b0 - b1;
    } else {
        const cf a0 = e[0] + e[1], a1 = e[0] - e[1], a2 = e[2] + e[3], d = e[2] - e[3], b = cf{-d.y, d.x};
        e[0] = a0 + a2; e[2] = a0 - a2; e[1] = a1 + b; e[3] = a1 - b;
    }
}
template <bool INV, class P, class PK>
HYD void hy_pass4(P X, int tid, PK KM) {
    typedef typename HyP2<P>::type P2;
    const int w = tid >> 6, lane = tid & 63;
#pragma unroll 1
    for (int gb = 0; gb < 2; ++gb) {
        cf2 a[4], b[4]; hy_u4 kq[4];
        const int g0 = (gb * 8 + w) * 256 + lane;
#pragma unroll
        for (int u = 0; u < 4; ++u) { const int g = g0 + 64 * u; P2 X2 = (P2)(X + HP(4 * g)); a[u] = X2[0]; b[u] = X2[1];
            if (KM) { const unsigned gi = (unsigned)(4 * g) & 0x3fffu; kq[u] = *(const hy_u4*)(KM + gi); } }
#pragma unroll
        for (int u = 0; u < 4; ++u) { const int g = g0 + 64 * u; P2 X2 = (P2)(X + HP(4 * g));
            cf e[4] = {cf{a[u].x, a[u].y}, cf{a[u].z, a[u].w}, cf{b[u].x, b[u].y}, cf{b[u].z, b[u].w}};
            hy_r4<INV>(e);
            if (KM) { const float ks = 1.0f / (float)FN; cf q0, q1, q2, q3; hy_cmul2(q0, e[0], hy_unpack_h2(kq[u].x, ks), q1, e[1], hy_unpack_h2(kq[u].y, ks)); hy_cmul2(q2, e[2], hy_unpack_h2(kq[u].z, ks), q3, e[3], hy_unpack_h2(kq[u].w, ks)); e[0] = q0; e[1] = q1; e[2] = q2; e[3] = q3; }
            X2[0] = cf2{e[0].x, e[0].y, e[1].x, e[1].y}; X2[1] = cf2{e[2].x, e[2].y, e[3].x, e[3].y}; }
    }
}
HYD int hy_brev14(int p) {
    unsigned v = (unsigned)p;
    v = ((v >> 1) & 0x55555555u) | ((v & 0x55555555u) << 1);
    v = ((v >> 2) & 0x33333333u) | ((v & 0x33333333u) << 2);
    v = ((v >> 4) & 0x0F0F0F0Fu) | ((v & 0x0F0F0F0Fu) << 4);
    v = ((v >> 8) & 0x00FF00FFu) | ((v & 0x00FF00FFu) << 8);
    v = (v >> 16) | (v << 16);
    return (int)(v >> (32 - FLOG));
}
HYD float hy_bf2f(unsigned short b) { unsigned u = (unsigned)b << 16; float f; __builtin_memcpy(&f, &u, 4); return f; }
HYD unsigned hy_f2bf(float f) { unsigned u; __builtin_memcpy(&u, &f, 4); return (u + 0x7fffu + ((u >> 16) & 1u)) >> 16; }
template <class PR> HYD void hy_sconv2(PR rowj  , unsigned tid, int j, float w0, float w1, float w2, float b, float& u0, float& u1) {
    const unsigned d1 = rowj[tid];
    const unsigned d0r = (rowj - 1)[tid], d2r = (rowj + 1)[tid];
    const unsigned d0 = (j > 0 || tid > 0) ? d0r : 0u;
    const unsigned d2 = (j < 7 || tid < (unsigned)(FT - 1)) ? d2r : 0u;
    const float pm1 = hy_bf2f((unsigned short)(d0 >> 16)), p0 = hy_bf2f((unsigned short)(d1 & 0xffffu)), p1 = hy_bf2f((unsigned short)(d1 >> 16)), p2 = hy_bf2f((unsigned short)(d2 & 0xffffu));
    u0 = b + w0 * pm1 + w1 * p0 + w2 * p1;
    u1 = b + w0 * p0 + w1 * p1 + w2 * p2;
}
template <class P> HYD void hy_filter_step(P X, const unsigned short* taps, float delta, int tid) {
    typedef typename HyP2<P>::type P2;
    typedef unsigned u32x2h __attribute__((ext_vector_type(2)));
    u32x2h raw[SEQL / (4 * FT)][4];
    const float dscale = -delta * (1.4426950408889634f / (float)(SEQL - 1)); (void)dscale;
#pragma unroll
    for (int j = 0; j < SEQL / (4 * FT); ++j)
#pragma unroll
        for (int q = 0; q < 4; ++q) raw[j][q] = __builtin_nontemporal_load((const u32x2h*)(taps + (size_t)q * 1024 * SEQL + ((unsigned)(4 * (tid + FT * j)) & 0x1fffu)));
#pragma unroll
    for (int j = 0; j < SEQL / (4 * FT); ++j) {
        const int t = 4 * (tid + FT * j);
        cf2 a[4];
#pragma unroll
        for (int q = 0; q < 4; ++q) a[q] = cf2{hy_bf2f((unsigned short)(raw[j][q].x & 0xffffu)), hy_bf2f((unsigned short)(raw[j][q].x >> 16)), hy_bf2f((unsigned short)(raw[j][q].y & 0xffffu)), hy_bf2f((unsigned short)(raw[j][q].y >> 16))};
        cf2 dec;
#pragma unroll
#ifdef HY_DEVICE
        for (int e = 0; e < 4; ++e) dec[e] = __builtin_amdgcn_exp2f((float)(t + e) * dscale);
#else
        for (int e = 0; e < 4; ++e) dec[e] = expf(-((float)(t + e) * (1.0f / (float)(SEQL - 1))) * delta);
#endif
        const cf2 a0 = a[0] * dec, a1 = a[1] * dec, a2 = a[2] * dec, a3 = a[3] * dec;
        P2 Xf = (P2)(X + HP(t));
        if (t == 0) { Xf[0] = cf2{a0[0] + a1[0], a2[0] + a3[0], a0[1], a2[1]}; float z0 = 0.f; HY_OPAQUE(z0); X[HP(SEQL)] = cf{z0, z0}; }
        else Xf[0] = cf2{a0[0], a2[0], a0[1], a2[1]};
        Xf[1] = cf2{a0[2], a2[2], a0[3], a2[3]};
        const int pbk = HP(FN - t - 4);
        X[pbk + 1] = cf{a1[3], a3[3]}; X[pbk + 2] = cf{a1[2], a3[2]}; X[pbk + 3] = cf{a1[1], a3[1]};
        if (t > 0) X[HP(FN - t)] = cf{a1[0], a3[0]};
    }
}
template <class P> HYD void hy_sep_step(P X, unsigned* K1g, unsigned* K2g, int tid) {
    const float sc = 0.5f;
#pragma unroll 1
    for (int j0 = 0; j0 < FN / FT; j0 += 4) {
        cf a[4], b[4];
#pragma unroll
        for (int u = 0; u < 4; ++u) { const int p = tid + FT * (j0 + u);
            const int f = hy_brev14(p), q = hy_brev14((FN - f) & (FN - 1));
            a[u] = X[HP(p)]; b[u] = X[HP(q)]; }
#pragma unroll
        for (int u = 0; u < 4; ++u) { const int p = tid + FT * (j0 + u);
            const unsigned pi = (unsigned)p & 0x3fffu;
            K1g[pi] = hy_pack_h2((a[u].x + b[u].x) * sc, (a[u].y - b[u].y) * sc);
            K2g[pi] = hy_pack_h2((a[u].y + b[u].y) * sc, -(a[u].x - b[u].x) * sc); }
    }
}
template <class P> HYD void hy_load_step(P X, const unsigned* r0, const unsigned* r1, float w0, float w1, float w2, float b, float (&zr)[8][4], int tid) {
    typedef typename HyP2<P>::type P2;
#pragma unroll
    for (int j = 0; j < 8; ++j) {
        const int t = 2 * (tid + FT * j);
        hy_sconv2(r0 + FT * j, (unsigned)tid, j, w0, w1, w2, b, zr[j][0], zr[j][2]);
        hy_sconv2(r1 + FT * j, (unsigned)tid, j, w0, w1, w2, b, zr[j][1], zr[j][3]);
        *(P2)(X + HP(t)) = cf2{zr[j][0], zr[j][1], zr[j][2], zr[j][3]};
    }
}
template <class P> HYD void hy_gate1_step(P X, const unsigned* r0, const unsigned* r1, float w0, float w1, float w2, float b, float bias, float (&zr)[8][4], int tid) {
    typedef typename HyP2<P>::type P2;
#pragma unroll
    for (int j = 0; j < 8; ++j) {
        const int t = 2 * (tid + FT * j);
        float xa0, xa1, xb0, xb1;
        hy_sconv2(r0 + FT * j, (unsigned)tid, j, w0, w1, w2, b, xa0, xa1);
        hy_sconv2(r1 + FT * j, (unsigned)tid, j, w0, w1, w2, b, xb0, xb1);
        P2 xp = (P2)(X + HP(t));
        const cf2 y = *xp;
        zr[j][0] = xa0 * (y.x + zr[j][0] * bias); zr[j][1] = xb0 * (y.y + zr[j][1] * bias);
        zr[j][2] = xa1 * (y.z + zr[j][2] * bias); zr[j][3] = xb1 * (y.w + zr[j][3] * bias);
        *xp = cf2{zr[j][0], zr[j][1], zr[j][2], zr[j][3]};
    }
}
template <class P> HYD void hy_gate2_step(P X, const unsigned* r0, const unsigned* r1, float w0, float w1, float w2, float b, float bias, const float (&zr)[8][4], unsigned* out0, unsigned* out1, int tid) {
    typedef typename HyP2<P>::type P2;
#pragma unroll
    for (int j = 0; j < 8; ++j) {
        const int t = 2 * (tid + FT * j);
        float xa0, xa1, xb0, xb1;
        hy_sconv2(r0 + FT * j, (unsigned)tid, j, w0, w1, w2, b, xa0, xa1);
        hy_sconv2(r1 + FT * j, (unsigned)tid, j, w0, w1, w2, b, xb0, xb1);
        const cf2 y = *(P2)(X + HP(t));
        const float za0 = xa0 * (y.x + zr[j][0] * bias), zb0 = xb0 * (y.y + zr[j][1] * bias);
        const float za1 = xa1 * (y.z + zr[j][2] * bias), zb1 = xb1 * (y.w + zr[j][3] * bias);
        (out0 + FT * j)[(unsigned)tid] = hy_f2bf(za0) | (hy_f2bf(za1) << 16);
        (out1 + FT * j)[(unsigned)tid] = hy_f2bf(zb0) | (hy_f2bf(zb1) << 16);
    }
}
HYD float hy_sconv1(unsigned D0, unsigned D1, int t, float w0, float w1, float w2, float b, bool pad0, bool padL) {
    const unsigned sh = ((unsigned)(t - 1) & 1u) << 4;
#ifdef HY_DEVICE
    const unsigned lo = __builtin_amdgcn_alignbit(D1, D0, sh), hi = D1 >> sh;
#else
    const unsigned long long w = (((unsigned long long)D1 << 32) | D0) >> sh; const unsigned lo = (unsigned)w, hi = (unsigned)(w >> 32);
#endif
    float e0 = hy_bf2f((unsigned short)(lo & 0xffffu)), e1 = hy_bf2f((unsigned short)(lo >> 16)), e2 = hy_bf2f((unsigned short)(hi & 0xffffu));
    if (pad0 && t == 0) e0 = 0.f;
    if (padL && t == SEQL - 1) e2 = 0.f;
    return b + w0 * e0 + w1 * e1 + w2 * e2;
}
struct HyRaw { unsigned d[2][8][4]; };
HYD void hy_raw_load(HyRaw& R, const unsigned* r0, const unsigned* r1, int tid) {
#pragma unroll
    for (int r = 0; r < 2; ++r)
#pragma unroll
        for (int k = 0; k < 8; ++k) { const unsigned du = ((unsigned)(tid + FT * r + 1024 * k + 1) >> 1) & 0x1fffu;
            R.d[r][k][0] = __builtin_nontemporal_load(r0 - 1 + du); R.d[r][k][1] = __builtin_nontemporal_load(r0 + du); R.d[r][k][2] = __builtin_nontemporal_load(r1 - 1 + du); R.d[r][k][3] = __builtin_nontemporal_load(r1 + du); }
}
template <class P, class PT> HYD void hy_convA_fwd(P X, PT thi, PT tlo, int tid, const HyRaw& R, float w0, float w1, float w2, float b, cf (&zr)[2][8]) {
#pragma unroll
    for (int r = 0; r < 2; ++r) {
        const int i0 = tid + FT * r, pb = HP(i0);
        cf e[16];
#pragma unroll
        for (int k = 0; k < 8; ++k) { const int t = i0 + 1024 * k; const bool p0 = (r == 0 && k == 0), pL = (r == 1 && k == 7); e[k] = cf{hy_sconv1(R.d[r][k][0], R.d[r][k][1], t, w0, w1, w2, b, p0, pL), hy_sconv1(R.d[r][k][2], R.d[r][k][3], t, w0, w1, w2, b, p0, pL)}; zr[r][k] = e[k]; }
#pragma unroll
        for (int k = 8; k < 16; ++k) e[k] = cf{0.f, 0.f};
        hy_bfly16<false, true, false>(e, hy_twid(thi, tlo, i0));
#pragma unroll
        for (int k = 0; k < 16; ++k) X[pb + k * 1088] = e[k];
    }
}
template <bool LAST, class P, class PT> HYD void hy_gateA(P X, PT thi, PT tlo, int tid, const HyRaw& R, float w0, float w1, float w2, float b, float bias,
                                                           cf (&zr)[2][8], unsigned short* out0, unsigned short* out1) {
#pragma unroll
    for (int r = 0; r < 2; ++r) {
        const int i0 = tid + FT * r, pb = HP(i0);
        cf e[16];
#pragma unroll
        for (int k = 0; k < 16; ++k) e[k] = X[pb + k * 1088];
        const cf tw = hy_twid(thi, tlo, i0);
        hy_bfly16<true, false, true>(e, tw);
#pragma unroll
        for (int k = 0; k < 8; ++k) { const int t = i0 + 1024 * k;
            const bool p0 = (r == 0 && k == 0), pL = (r == 1 && k == 7);
            const float xa = hy_sconv1(R.d[r][k][0], R.d[r][k][1], t, w0, w1, w2, b, p0, pL), xb = hy_sconv1(R.d[r][k][2], R.d[r][k][3], t, w0, w1, w2, b, p0, pL);
            const cf z = cf{xa * (e[k].x + zr[r][k].x * bias), xb * (e[k].y + zr[r][k].y * bias)};
            if (LAST) {
#ifdef HY_DEVICE
                unsigned pk; asm("v_cvt_pk_bf16_f32 %0, %1, %2" : "=v"(pk) : "v"(z.x), "v"(z.y)); const unsigned ti = (unsigned)t & 0x1fffu; out0[ti] = (unsigned short)(pk & 0xffffu); out1[ti] = (unsigned short)(pk >> 16);
#else
                out0[t] = (unsigned short)hy_f2bf(z.x); out1[t] = (unsigned short)hy_f2bf(z.y);
#endif
            }
            else { zr[r][k] = z; e[k] = z; } }
        if (!LAST) {
#pragma unroll
            for (int k = 8; k < 16; ++k) e[k] = cf{0.f, 0.f};
            hy_bfly16<false, true, false>(e, tw);
#pragma unroll
            for (int k = 0; k < 16; ++k) X[pb + k * 1088] = e[k];
        }
    }
}
constexpr int NWAVES = 8, NTHR = NWAVES * 64;
constexpr int DM = 2048, SEQ = 8192, DEPTH = 4, NSEQ = 6, GSEQ = 2, NGRP = NSEQ / GSEQ, MG = GSEQ * SEQ;
constexpr int HYW = 1024, HYIN = 3072, QKVW = 3072, DFF = 5632, GU = 2 * DFF, FEMB = 33, FHID = 64;
constexpr float EPS = 1e-6f;
constexpr float QSCALE = 0.125f * 1.4426950408889634f;
constexpr size_t MiB = 1u << 20;
constexpr size_t WS_CTL = 0, CTL_ZERO_BYTES = 1 * MiB;
constexpr size_t SZ_WHY = (size_t)HYIN * DM * 2, SZ_WQKV = (size_t)QKVW * DM * 2, SZ_WOUT = (size_t)DM * DM * 2, SZ_WGU = (size_t)GU * DM * 2, SZ_WDN = (size_t)DM * DFF * 2;
constexpr size_t OFF_WHY = 0, OFF_WQKV = OFF_WHY + SZ_WHY, OFF_WOUT = OFF_WQKV + SZ_WQKV, OFF_WGU = OFF_WOUT + SZ_WOUT, OFF_WDN = OFF_WGU + SZ_WGU, SZ_WLAYER = OFF_WDN + SZ_WDN;
constexpr size_t WS_W = 1 * MiB;
constexpr size_t WS_ROPE = WS_W + DEPTH * SZ_WLAYER;
constexpr int KPAD = 256;
constexpr size_t WS_H3 = WS_ROPE + (size_t)SEQ * 32 * 8;
constexpr size_t WS_W4T = WS_H3 + (size_t)DEPTH * SEQ * KPAD * 2;
constexpr size_t WS_TAPS = WS_W4T + (size_t)DEPTH * 4096 * KPAD * 2;
constexpr size_t WS_FFTK = WS_TAPS + (size_t)4096 * SEQ * 2;
constexpr size_t WS_STASH = WS_FFTK + (size_t)256 * 2 * 16384 * 8;
constexpr size_t WS_XB = WS_STASH;
constexpr size_t WS_H = WS_XB + (size_t)MG * DM * 2;
constexpr size_t WS_ZT = WS_H + (size_t)MG * DM * 2;
constexpr size_t WS_PROJT = WS_ZT + (size_t)HYW * MG * 2;
constexpr size_t WS_QKV = WS_PROJT + (size_t)HYIN * MG * 2;
constexpr size_t WS_MIX = WS_PROJT;
constexpr size_t WS_FFH = WS_PROJT;
constexpr size_t WS_MIXIN = WS_QKV + (size_t)MG * QKVW * 2;
constexpr size_t WS_END = WS_MIXIN + (size_t)MG * DM * 2;
constexpr size_t SZ_TAPS = (size_t)4096 * SEQ * 2, WS_TAPS_X = WS_END, WS_END_X = WS_TAPS_X + (DEPTH - 1) * SZ_TAPS;
static_assert((size_t)MG * DFF * 2 <= (size_t)HYIN * MG * 2 + (size_t)MG * QKVW * 2, "FFH overlay fits PROJT|QKV");
static_assert(WS_W4T % 256 == 0 && WS_TAPS % 256 == 0 && WS_ROPE % 256 == 0 && WS_H3 % 256 == 0 && WS_FFTK % 256 == 0 && WS_XB % 256 == 0 && WS_H % 256 == 0 && SZ_WLAYER % 256 == 0, "alignment");
constexpr int CW_BAR = 4096;
constexpr int PH_PER_LAYER = 8, PH_PER_GROUP = 1 + DEPTH * PH_PER_LAYER, NPHASE = 1 + NGRP * PH_PER_GROUP;
constexpr int RING_OFF = 0, RING_BYTES = 131072;
constexpr int TAB_OFF = 139264;
constexpr int MISC_OFF = TAB_OFF + 4096;
constexpr int LDS_BYTES = 147456;
static_assert(MISC_OFF + 128 <= LDS_BYTES, "LDS map");
static_assert(att::SHM_ATTN_ALL <= MISC_OFF, "attention LDS fits below the control words");
#ifndef PROBE_DUP
#define PROBE_DUP 0
#endif
#ifndef MK_PER_PHASE
#define MK_PER_PHASE 0
#endif

struct Args { const float* in[30]; float* out; unsigned char* ws; int ph_lo, ph_hi, taps_all, pad; };
enum { I_XP = 0, I_XS, I_GMPRE, I_GMPOST, I_GFPRE, I_GFPOST, I_WIN, I_CONVW, I_CONVB, I_FW1, I_FB1, I_FF1, I_FW2, I_FB2, I_FF2, I_FW3, I_FB3, I_FF3, I_FW4,
       I_HBIAS, I_HNORM, I_LQ1, I_LK1, I_LQ2, I_LK2, I_SUBLN, I_WOUT, I_WGATE, I_WUP, I_WDOWN };

template <int K> __device__ __forceinline__ float swz_xor(float v) { return __builtin_bit_cast(float, __builtin_amdgcn_ds_swizzle(__builtin_bit_cast(int, v), (K << 10) | 0x1f)); }
__device__ __forceinline__ float wave_sum(float v) {
    v += swz_xor<1>(v); v += swz_xor<2>(v); v += swz_xor<4>(v); v += swz_xor<8>(v); v += swz_xor<16>(v);
    auto rr = __builtin_amdgcn_permlane32_swap(__float_as_uint(v), __float_as_uint(v), false, false);
    return __uint_as_float(rr[0]) + __uint_as_float(rr[1]);
}
__device__ __forceinline__ bf16* wt_dst_row(int kind, int n, bf16* d0, bf16* d1, int K) {
    if (kind == 0) return d0 + (size_t)n * K;
    if (kind == 1) { if (n < HYIN) return d0 + (size_t)n * K; int q = n - HYIN; if (q < 2048) { const int hb = q & ~63, i = q & 63; q = hb + (i < 32 ? 2 * i : 2 * (i - 32) + 1); } return d1 + (size_t)q * K; }
    if (kind == 4) return d0 + (size_t)n * KPAD;
    const int r = (n >> 7) * 256 + (n & 127) + (kind == 3 ? 128 : 0); return d0 + (size_t)r * K;
}
__device__ __forceinline__ void p0_transpose_item(const float* W, int K, int N, int kind, bf16* d0, bf16* d1, LAS float* scr, int item, int lane) {
    const int nblk = N / 32, kb = item / nblk, nb = item % nblk, k0 = 64 * kb, n0 = 32 * nb;
#pragma unroll 8
    for (int i = 0; i < 32; ++i) { const int kk = 2 * i + (lane >> 5); scr[kk * 33 + (lane & 31)] = W[(size_t)(k0 + kk) * N + n0 + (lane & 31)]; }
    LDS_WAIT(); asm volatile("" ::: "memory");
    const int c = lane & 7;
#pragma unroll
    for (int j = 0; j < 4; ++j) { const int n = (lane >> 3) + 8 * j; const LAS float* s = scr + (8 * c) * 33 + n;
        v4u o; o.x = pk2(s[0 * 33], s[1 * 33]); o.y = pk2(s[2 * 33], s[3 * 33]); o.z = pk2(s[4 * 33], s[5 * 33]); o.w = pk2(s[6 * 33], s[7 * 33]);
        *(GAS v4u*)(wt_dst_row(kind, n0 + n, d0, d1, K) + k0 + 8 * c) = o; }
    LDS_WAIT(); asm volatile("" ::: "memory");
}
__device__ __forceinline__ void sincos_red(double ang, float& s, float& c) {
    const double k = rint(ang * 0.15915494309189535); const float r = (float)(ang - k * 6.283185307179586);
    s = sinf(r); c = cosf(r);
}
#define GP(p) ((const float*)(const GAS float*)(p))
#define LAUNDER_TID(F) do { int t_ = (F).tid; asm volatile("" : "+v"(t_)); (F).tid = t_; (F).lane = t_ & 63; int z_ = 0; asm volatile("" : "+s"(z_)); (F).z = z_; unsigned long long w_ = (unsigned long long)(F).ws0; asm volatile("" : "+s"(w_)); (F).ws = (unsigned char*)(GAS unsigned char*)w_; int b_ = (F).bx0, v_ = (F).vcu0, g_ = (F).G0; asm volatile("" : "+s"(b_), "+s"(v_), "+s"(g_)); (F).bx = b_; (F).vcu = v_; (F).G = g_; } while (0)
struct Frame {
    LAS unsigned char* lds; volatile LAS unsigned* MISC; gu32* ctl;
    int tid, lane, wave, vcu, G, bx;
    int vcu0, G0, bx0;
    float* out; unsigned char* ws; unsigned char* ws0; int z;
};
__device__ __forceinline__ void p0_prologue(Frame& F, const Args& A) {
    LAS float* scr = (LAS float*)(F.lds + RING_OFF + F.wave * 16384);
    const int gw = F.vcu * NWAVES + F.wave, NGW = F.G * NWAVES;
    constexpr int I_IN = (DM / 64) * ((HYIN + QKVW) / 32), I_OUT = (DM / 64) * (DM / 32), I_G = (DM / 64) * (DFF / 32), I_D = (DFF / 64) * (DM / 32);
    constexpr int I_W4 = 4096 / 32;
    constexpr int PER_L = I_IN + I_OUT + 2 * I_G + I_D + I_W4;
    for (int it = gw; it < DEPTH * PER_L; it += NGW) {
        const int l = it / PER_L; int r = it % PER_L;
        unsigned char* wl = F.ws + WS_W + (size_t)l * SZ_WLAYER;
        if (r < I_IN) { p0_transpose_item(GP(A.in[I_WIN + F.z]) + (size_t)l * DM * (HYIN + QKVW), DM, HYIN + QKVW, 1, (bf16*)(wl + OFF_WHY), (bf16*)(wl + OFF_WQKV), scr, r, F.lane); continue; } r -= I_IN;
        if (r < I_OUT) { p0_transpose_item(GP(A.in[I_WOUT + F.z]) + (size_t)l * DM * DM, DM, DM, 0, (bf16*)(wl + OFF_WOUT), nullptr, scr, r, F.lane); continue; } r -= I_OUT;
        if (r < I_G) { p0_transpose_item(GP(A.in[I_WGATE + F.z]) + (size_t)l * DM * DFF, DM, DFF, 2, (bf16*)(wl + OFF_WGU), nullptr, scr, r, F.lane); continue; } r -= I_G;
        if (r < I_G) { p0_transpose_item(GP(A.in[I_WUP + F.z]) + (size_t)l * DM * DFF, DM, DFF, 3, (bf16*)(wl + OFF_WGU), nullptr, scr, r, F.lane); continue; } r -= I_G;
        if (r < I_D) { p0_transpose_item(GP(A.in[I_WDOWN + F.z]) + (size_t)l * DFF * DM, DFF, DM, 0, (bf16*)(wl + OFF_WDN), nullptr, scr, r, F.lane); continue; } r -= I_D;
        { bf16* w4t = (bf16*)(F.ws + WS_W4T) + (size_t)l * 4096 * KPAD;
          p0_transpose_item(GP(A.in[I_FW4 + F.z]) + (size_t)l * FHID * 4096, FHID, 4096, 4, w4t, nullptr, scr, r, F.lane);
          for (int e = F.lane; e < 32 * 24; e += 64) *(GAS v4u*)(w4t + (size_t)(32 * r + e / 24) * KPAD + 64 + 8 * (e % 24)) = (v4u){0u, 0u, 0u, 0u}; }
    }
    {
        float* cs = (float*)(F.ws + WS_ROPE);
        for (int e = F.vcu * NTHR + F.tid; e < SEQ * 32; e += F.G * NTHR) {
            const int t = e >> 5, p = e & 31;
            const double inv = exp(-9.210340371976184 * (double)(2 * p) / 64.0);
            float s, c; sincos_red((double)t * inv, s, c);
            cs[2 * e] = c; cs[2 * e + 1] = s;
        }
    }
    {
        bf16* h3b = (bf16*)(F.ws + WS_H3);
        LAS float* hb = (LAS float*)(F.lds + RING_OFF + F.wave * 16384);
        for (int task = gw; task < DEPTH * (SEQ / 64); task += NGW) {
            const int l = task / (SEQ / 64), t = (task % (SEQ / 64)) * 64 + F.lane;
            const float* w1 = GP(A.in[I_FW1 + F.z]) + (size_t)l * FEMB * FHID; const float* w2 = GP(A.in[I_FW2 + F.z]) + (size_t)l * FHID * FHID; const float* w3 = GP(A.in[I_FW3 + F.z]) + (size_t)l * FHID * FHID;
            hb[F.lane] = (float)t * (1.0f / (float)(SEQ - 1));
#pragma unroll 1
            for (int bi = 0; bi < 16; ++bi) { const double band = 1e-4 + (double)bi * ((15.0 - 1e-4) / 15.0);
                float s, c; sincos_red(6.283185307179586 * (double)t / (double)SEQ * band, s, c); hb[(1 + bi) * 64 + F.lane] = c; hb[(17 + bi) * 64 + F.lane] = -s; }
#pragma unroll 1
            for (int stage = 0; stage < 3; ++stage) {
                const float* w = stage == 0 ? w1 : (stage == 1 ? w2 : w3);
                const float* bb = (stage == 0 ? GP(A.in[I_FB1 + F.z]) : (stage == 1 ? GP(A.in[I_FB2 + F.z]) : GP(A.in[I_FB3 + F.z]))) + l * FHID;
                const float* ff = (stage == 0 ? GP(A.in[I_FF1 + F.z]) : (stage == 1 ? GP(A.in[I_FF2 + F.z]) : GP(A.in[I_FF3 + F.z]))) + l * FHID;
                const int nin = stage == 0 ? FEMB : FHID;
                typedef float f32x16_t __attribute__((ext_vector_type(16)));
                f32x16_t c0 = {}, c1 = {}, c2 = {}, c3 = {};
                LDS_WAIT();
#pragma unroll 1
                for (int i = 0; i < nin; ++i) { const float hv = hb[i * 64 + F.lane]; const f32x16_t* wr = (const f32x16_t*)(w + i * FHID);
                    c0 += wr[0] * hv; c1 += wr[1] * hv; c2 += wr[2] * hv; c3 += wr[3] * hv; }
                const f32x16_t* b16 = (const f32x16_t*)bb; const f32x16_t* f16 = (const f32x16_t*)ff;
                c0 = (c0 + b16[0]) * f16[0]; c1 = (c1 + b16[1]) * f16[1]; c2 = (c2 + b16[2]) * f16[2]; c3 = (c3 + b16[3]) * f16[3];
                if (stage < 2) {
#pragma unroll
                    for (int e = 0; e < 16; ++e) { hb[e * 64 + F.lane] = sinf(c0[e]); hb[(16 + e) * 64 + F.lane] = sinf(c1[e]); hb[(32 + e) * 64 + F.lane] = sinf(c2[e]); hb[(48 + e) * 64 + F.lane] = sinf(c3[e]); }
                } else {
                    GAS v4u* o = (GAS v4u*)(h3b + ((size_t)l * SEQ + t) * KPAD);
#pragma unroll
                    for (int q = 0; q < 2; ++q) { v4u w; w.x = pk2(sinf(c0[8 * q]), sinf(c0[8 * q + 1])); w.y = pk2(sinf(c0[8 * q + 2]), sinf(c0[8 * q + 3])); w.z = pk2(sinf(c0[8 * q + 4]), sinf(c0[8 * q + 5])); w.w = pk2(sinf(c0[8 * q + 6]), sinf(c0[8 * q + 7])); o[q] = w; }
#pragma unroll
                    for (int q = 0; q < 2; ++q) { v4u w; w.x = pk2(sinf(c1[8 * q]), sinf(c1[8 * q + 1])); w.y = pk2(sinf(c1[8 * q + 2]), sinf(c1[8 * q + 3])); w.z = pk2(sinf(c1[8 * q + 4]), sinf(c1[8 * q + 5])); w.w = pk2(sinf(c1[8 * q + 6]), sinf(c1[8 * q + 7])); o[2 + q] = w; }
#pragma unroll
                    for (int q = 0; q < 2; ++q) { v4u w; w.x = pk2(sinf(c2[8 * q]), sinf(c2[8 * q + 1])); w.y = pk2(sinf(c2[8 * q + 2]), sinf(c2[8 * q + 3])); w.z = pk2(sinf(c2[8 * q + 4]), sinf(c2[8 * q + 5])); w.w = pk2(sinf(c2[8 * q + 6]), sinf(c2[8 * q + 7])); o[4 + q] = w; }
#pragma unroll
                    for (int q = 0; q < 2; ++q) { v4u w; w.x = pk2(sinf(c3[8 * q]), sinf(c3[8 * q + 1])); w.y = pk2(sinf(c3[8 * q + 2]), sinf(c3[8 * q + 3])); w.z = pk2(sinf(c3[8 * q + 4]), sinf(c3[8 * q + 5])); w.w = pk2(sinf(c3[8 * q + 6]), sinf(c3[8 * q + 7])); o[6 + q] = w; }
#pragma unroll 1
                    for (int q = 8; q < 32; ++q) o[q] = (v4u){0u, 0u, 0u, 0u};
                }
            }
        }
    }
}
template <bool XSB>
__device__ __forceinline__ void norm_pass(Frame& F, const void* x_src, const bf16* add, const float* g_add, bf16* xb_dst, float* xf_dst, const float* g_out, bf16* h_dst) {
    const int gw = F.vcu * NWAVES + F.wave, NGW = F.G * NWAVES;
#define UNPK(q, lo, hi) do { lo = (f32x4){__uint_as_float((q).x << 16), __uint_as_float((q).x & 0xffff0000u), __uint_as_float((q).y << 16), __uint_as_float((q).y & 0xffff0000u)}; \
                             hi = (f32x4){__uint_as_float((q).z << 16), __uint_as_float((q).z & 0xffff0000u), __uint_as_float((q).w << 16), __uint_as_float((q).w & 0xffff0000u)}; } while (0)
#define PK8(lo, hi) (v4u){pk2((lo)[0], (lo)[1]), pk2((lo)[2], (lo)[3]), pk2((hi)[0], (hi)[1]), pk2((hi)[2], (hi)[3])}
    f32x4 gA[8], gO[8];
#pragma unroll
    for (int j = 0; j < 8; ++j) { gA[j] = (f32x4){0.f, 0.f, 0.f, 0.f}; gO[j] = (f32x4){0.f, 0.f, 0.f, 0.f}; }
    if (add) { const GAS f32x4* gr = (const GAS f32x4*)g_add + 2 * F.lane;
#pragma unroll
        for (int j = 0; j < 4; ++j) { gA[2 * j] = gr[128 * j]; gA[2 * j + 1] = gr[128 * j + 1]; } }
    if (h_dst) { const GAS f32x4* gr = (const GAS f32x4*)g_out + 2 * F.lane;
#pragma unroll
        for (int j = 0; j < 4; ++j) { gO[2 * j] = gr[128 * j]; gO[2 * j + 1] = gr[128 * j + 1]; } }
    v4u rq[4], rw[4]; f32x4 rf[8];
#pragma unroll
    for (int j = 0; j < 4; ++j) { rq[j] = (v4u){0u, 0u, 0u, 0u}; rw[j] = (v4u){0u, 0u, 0u, 0u}; }
#define NP_FETCH(m) do { \
        if (XSB) { const GAS v4u* xa_ = (const GAS v4u*)((const bf16*)x_src + (size_t)(m) * DM) + F.lane; _Pragma("unroll") for (int j = 0; j < 4; ++j) rq[j] = xa_[64 * j]; } \
        else { const GAS f32x4* xa_ = (const GAS f32x4*)((const float*)x_src + (size_t)(m) * DM) + 2 * F.lane; _Pragma("unroll") for (int j = 0; j < 4; ++j) { rf[2 * j] = xa_[128 * j]; rf[2 * j + 1] = xa_[128 * j + 1]; } } \
        if (add) { const GAS v4u* aa_ = (const GAS v4u*)(add + (size_t)(m) * DM) + F.lane; _Pragma("unroll") for (int j = 0; j < 4; ++j) rw[j] = aa_[64 * j]; } } while (0)
    if (gw < MG) NP_FETCH(gw);
    for (int m0 = gw; m0 < MG; m0 += NGW) {
        f32x4 va[8]; v4u wa[4];
        if (XSB) {
#pragma unroll
            for (int j = 0; j < 4; ++j) UNPK(rq[j], va[2 * j], va[2 * j + 1]);
        } else {
#pragma unroll
            for (int j = 0; j < 8; ++j) va[j] = rf[j];
        }
#pragma unroll
        for (int j = 0; j < 4; ++j) wa[j] = rw[j];
        if (m0 + NGW < MG) NP_FETCH(m0 + NGW);
        if (add) {
            float sa = 0.f;
#pragma unroll
            for (int j = 0; j < 4; ++j) { f32x4 a0, a1; UNPK(wa[j], a0, a1);
                sa += ((a0[0] * a0[0] + a0[1] * a0[1]) + (a0[2] * a0[2] + a0[3] * a0[3])) + ((a1[0] * a1[0] + a1[1] * a1[1]) + (a1[2] * a1[2] + a1[3] * a1[3])); }
            const float ra = 1.0f / sqrtf(wave_sum(sa) * (1.0f / DM) + EPS);
#pragma unroll
            for (int j = 0; j < 4; ++j) { f32x4 a0, a1; UNPK(wa[j], a0, a1);
                va[2 * j] = va[2 * j] + a0 * ra * gA[2 * j]; va[2 * j + 1] = va[2 * j + 1] + a1 * ra * gA[2 * j + 1]; }
        }
        if (xf_dst) { GAS f32x4* oa = (GAS f32x4*)(xf_dst + (size_t)m0 * DM) + 2 * F.lane;
#pragma unroll
            for (int j = 0; j < 4; ++j) { oa[128 * j] = va[2 * j]; oa[128 * j + 1] = va[2 * j + 1]; } }
        if (xb_dst) { GAS v4u* oa = (GAS v4u*)(xb_dst + (size_t)m0 * DM) + F.lane;
#pragma unroll
            for (int j = 0; j < 4; ++j) { const v4u w = PK8(va[2 * j], va[2 * j + 1]); oa[64 * j] = w;
                UNPK(w, va[2 * j], va[2 * j + 1]); } }
        if (h_dst) {
            float sa = 0.f;
#pragma unroll
            for (int j = 0; j < 8; ++j) sa += (va[j][0] * va[j][0] + va[j][1] * va[j][1]) + (va[j][2] * va[j][2] + va[j][3] * va[j][3]);
            const float ra = 1.0f / sqrtf(wave_sum(sa) * (1.0f / DM) + EPS);
            GAS v4u* ha = (GAS v4u*)(h_dst + (size_t)m0 * DM) + F.lane;
#pragma unroll
            for (int j = 0; j < 4; ++j) { const f32x4 oa0 = va[2 * j] * ra * gO[2 * j], oa1 = va[2 * j + 1] * ra * gO[2 * j + 1]; ha[64 * j] = PK8(oa0, oa1); }
        }
    }
#undef NP_FETCH
#undef UNPK
#undef PK8
}
typedef LAS cf* lcf;
template <bool ZUP> __device__ __forceinline__ void hy_fwd(lcf X, lcf thi, lcf tlo, int tid, const unsigned* KM) {
    if (ZUP) hy_pass16<1024, false, true, false>(X, thi, tlo, tid); else hy_pass16<1024, false, false, false>(X, thi, tlo, tid);
    __syncthreads();
    hy_pass16<64, false, false, false>(X, thi, tlo, tid);
    hy_pass16<4, false, false, false>(X, thi, tlo, tid);
    hy_pass4<false>(X, tid, KM); __syncthreads();
}
__device__ __forceinline__ void hy_inv(lcf X, lcf thi, lcf tlo, int tid) {
    const unsigned* nul = nullptr;
    hy_pass4<true>(X, tid, nul); __syncthreads();
    hy_pass16<4, true, false, false>(X, thi, tlo, tid); __syncthreads();
    hy_pass16<64, true, false, false>(X, thi, tlo, tid); __syncthreads();
    hy_pass16<1024, true, false, true>(X, thi, tlo, tid); __syncthreads();
}
__device__ __forceinline__ void hy_mid(lcf X, lcf thi, lcf tlo, int tid, const unsigned* KM) {
    const unsigned* nul = nullptr;
    hy_pass16<64, false, false, false>(X, thi, tlo, tid);
    hy_pass16<4, false, false, false>(X, thi, tlo, tid);
    hy_pass4<false>(X, tid, KM);
    hy_pass4<true>(X, tid, nul);
    hy_pass16<4, true, false, false>(X, thi, tlo, tid);
    hy_pass16<64, true, false, false>(X, thi, tlo, tid); __syncthreads();
}
__device__ __forceinline__ void hyena_phase(Frame& F, const Args& A, int l) {
    lcf X = (lcf)(F.lds + RING_OFF); lcf thi = (lcf)(F.lds + TAB_OFF); lcf tlo = thi + 128;
    const int tid = F.tid;
    if (tid < 256) { const int a = tid & 127; const double ang = -6.283185307179586 * (double)(tid < 128 ? 128 * a : a) / (double)FN; float s, c; sincos_red(ang, s, c); (tid < 128 ? thi : tlo)[a] = cf{c, s}; }
    unsigned* K1g = (unsigned*)(F.ws + WS_FFTK) + (size_t)F.bx * 2 * FN; unsigned* K2g = K1g + FN;
    const bf16* taps = (const bf16*)(F.ws + ((A.taps_all && l > 0) ? WS_TAPS_X + (size_t)(l - 1) * SZ_TAPS : WS_TAPS));
    const float* cw = GP(A.in[I_CONVW + F.z]) + (size_t)l * 3 * HYIN; const float* cb = GP(A.in[I_CONVB + F.z]) + (size_t)l * HYIN; const float* hb = GP(A.in[I_HBIAS + F.z]) + (size_t)l * 2 * HYW;
    const bf16* projT = (const bf16*)(F.ws + WS_PROJT); bf16* zT = (bf16*)(F.ws + WS_ZT);
    for (int c = F.vcu; c < HYW; c += F.G) {
        __syncthreads();
        const float delta = fabsf(-15.350567286626973f + (float)c * ((-3.0701134573253945f + 15.350567286626973f) / 1023.0f));
#define TIDX(v) int v = tid; asm volatile("" : "+v"(v))
        { TIDX(t_); hy_filter_step(X, taps + (size_t)c * SEQ, delta, t_); }
        const unsigned* rx1 = (const unsigned*)(projT + (size_t)c * MG); const unsigned* rx2 = (const unsigned*)(projT + (size_t)(HYW + c) * MG); const unsigned* rv = (const unsigned*)(projT + (size_t)(2 * HYW + c) * MG);
        HyRaw R;
        { TIDX(t_); hy_raw_load(R, rv, rv + SEQ / 2, t_); }
        __syncthreads();
        { TIDX(t_); hy_fwd<false>(X, thi, tlo, t_, nullptr); }
        { TIDX(t_); hy_sep_step(X, K1g, K2g, t_); }
        asm volatile("s_waitcnt vmcnt(0)" ::: "memory"); __syncthreads();
        cf zr[2][8];
        { TIDX(t_); hy_convA_fwd(X, thi, tlo, t_, R, cw[2 * HYW + c], cw[HYIN + 2 * HYW + c], cw[2 * HYIN + 2 * HYW + c], cb[2 * HYW + c], zr); }
        { TIDX(t_); hy_raw_load(R, rx1, rx1 + SEQ / 2, t_); }
        __syncthreads();
        { TIDX(t_); hy_mid(X, thi, tlo, t_, K1g); }
        { TIDX(t_); hy_gateA<false>(X, thi, tlo, t_, R, cw[c], cw[HYIN + c], cw[2 * HYIN + c], cb[c], hb[c], zr, (unsigned short*)nullptr, (unsigned short*)nullptr); }
        { TIDX(t_); hy_raw_load(R, rx2, rx2 + SEQ / 2, t_); }
        __syncthreads();
        { TIDX(t_); hy_mid(X, thi, tlo, t_, K2g); }
        unsigned short* zo = (unsigned short*)(zT + (size_t)c * MG);
        { TIDX(t_); hy_gateA<true>(X, thi, tlo, t_, R, cw[HYW + c], cw[HYIN + HYW + c], cw[2 * HYIN + HYW + c], cb[HYW + c], hb[HYW + c], zr, zo, zo + SEQ); }
#undef TIDX
    }
    __syncthreads();
}
__device__ __forceinline__ void hynorm_phase(Frame& F, const Args& A, int l) {
    constexpr int TB = 64;
    LAS unsigned char* tile = F.lds + RING_OFF; LAS float* red = (LAS float*)(F.lds + RING_OFF + TB * HYW * 2); LAS float* rinv = red + 8 * TB;
    const bf16* zT = (const bf16*)(F.ws + WS_ZT); bf16* mixin = (bf16*)(F.ws + WS_MIXIN); const float* gn = GP(A.in[I_HNORM + F.z]) + (size_t)l * HYW;
    const int tid = F.tid;
    for (int tb = F.vcu; tb < MG / TB; tb += F.G) {
        const int t0 = tb * TB; __syncthreads();
        float ps[8];
#pragma unroll
        for (int i = 0; i < 8; ++i) ps[i] = 0.f;
        const int k = tid & 7, crow = tid >> 3;
#pragma unroll
        for (int hb = 0; hb < 2; ++hb) {
            v4u w[8];
#pragma unroll
            for (int it = 0; it < 8; ++it) { const unsigned c = (unsigned)((hb * 8 + it) * 64 + crow) & 1023u; w[it] = *(const GAS v4u*)(zT + (size_t)c * MG + (unsigned)(t0 + 8 * k)); }
#pragma unroll
            for (int it = 0; it < 8; ++it) { const int c = (hb * 8 + it) * 64 + crow;
                LAS unsigned short* d = (LAS unsigned short*)(tile + (8 * k) * 2048 + (((c >> 3) ^ k) << 4) + (c & 7) * 2);
                const unsigned ww[4] = {w[it].x, w[it].y, w[it].z, w[it].w};
#pragma unroll
                for (int i = 0; i < 4; ++i) { d[(2 * i) * 1024] = (unsigned short)(ww[i] & 0xffffu); d[(2 * i + 1) * 1024] = (unsigned short)(ww[i] >> 16);
                    const float a = __uint_as_float(ww[i] << 16), b = __uint_as_float(ww[i] & 0xffff0000u); ps[2 * i] += a * a; ps[2 * i + 1] += b * b; } }
        }
#pragma unroll
        for (int i = 0; i < 8; ++i) { float v = ps[i]; v += swz_xor<8>(v); v += swz_xor<16>(v);
            auto rr = __builtin_amdgcn_permlane32_swap(__float_as_uint(v), __float_as_uint(v), false, false); ps[i] = __uint_as_float(rr[0]) + __uint_as_float(rr[1]); }
        if ((F.lane >> 3) == 0) {
#pragma unroll
            for (int i = 0; i < 8; ++i) red[F.wave * TB + 8 * k + i] = ps[i]; }
        __syncthreads();
        if (tid < TB) { float s = 0.f;
#pragma unroll
            for (int w8 = 0; w8 < 8; ++w8) s += red[w8 * TB + tid];
            rinv[tid] = 1.0f / sqrtf(s * (1.0f / HYW) + EPS); }
        __syncthreads();
        const int cg = tid & 127;
        const f32x4 g0 = *(const f32x4*)(gn + 8 * cg), g1 = *(const f32x4*)(gn + 8 * cg + 4);
#pragma unroll 4
        for (int it = 0; it < 16; ++it) { const int tok = it * 4 + (tid >> 7); const float r = rinv[tok];
            const v4u q = *(const LAS v4u*)(tile + tok * 2048 + ((cg ^ (tok >> 3)) << 4));
            v4u o; o.x = pk2(__uint_as_float(q.x << 16) * r * g0[0], __uint_as_float(q.x & 0xffff0000u) * r * g0[1]); o.y = pk2(__uint_as_float(q.y << 16) * r * g0[2], __uint_as_float(q.y & 0xffff0000u) * r * g0[3]);
            o.z = pk2(__uint_as_float(q.z << 16) * r * g1[0], __uint_as_float(q.z & 0xffff0000u) * r * g1[1]); o.w = pk2(__uint_as_float(q.w << 16) * r * g1[2], __uint_as_float(q.w & 0xffff0000u) * r * g1[3]);
            *(GAS v4u*)(mixin + (size_t)(t0 + tok) * DM + 8 * cg) = o; }
    }
    __syncthreads();
}
__device__ __forceinline__ void attn_phase(Frame& F, const Args& A, int l, unsigned char* lds_generic) {
    const float li = 0.8f - 0.6f * expf(-0.3f * (float)l);
    float lam;
    { const int j = F.lane; const float a = GP(A.in[I_LQ1 + F.z])[l * 64 + j] * GP(A.in[I_LK1 + F.z])[l * 64 + j], b = GP(A.in[I_LQ2 + F.z])[l * 64 + j] * GP(A.in[I_LK2 + F.z])[l * 64 + j];
      lam = expf(wave_sum(a)) - expf(wave_sum(b)) + li; }
    const att::bf16* qkv = (const att::bf16*)(F.ws + WS_QKV); att::bf16* mixin = (att::bf16*)(F.ws + WS_MIXIN);
    float* stash = (float*)(F.ws + WS_H) + (size_t)F.bx * 64 * 512;
    const float* subln = GP(A.in[I_SUBLN + F.z]) + (size_t)l * 128;
    constexpr int NU = GSEQ * 8 * (SEQ / 256);
    for (int u = F.vcu; u < NU; u += F.G) {
        const int bvh = u >> 5, qb = u & 31, b = bvh >> 3, vh = bvh & 7;
        const long krow0 = (long)b * SEQ, qrow0 = krow0 + qb * 256;
        att::attn_unit(qkv, qrow0, krow0, vh, SEQ, lam, 1.0f - li, subln, mixin + (size_t)qrow0 * DM + HYW + vh * 128, DM, stash, (char*)lds_generic);
        __syncthreads();
    }
}
#ifndef PHMASK
#define PHMASK 511
#endif
__global__ void __launch_bounds__(NTHR, 2) hymba_fwd(Args args) {
    extern __shared__ __attribute__((aligned(16))) unsigned char lds[];
    Frame F;
    F.lds = (LAS unsigned char*)lds; F.MISC = (volatile LAS unsigned*)(F.lds + MISC_OFF);
    F.tid = threadIdx.x; F.lane = F.tid & 63; F.wave = __builtin_amdgcn_readfirstlane(F.tid >> 6);
    F.G = gridDim.x; { const int bx = blockIdx.x; F.vcu = (F.G % 8 == 0) ? (bx % 8) * (F.G / 8) + bx / 8 : bx; F.bx = bx; }
    F.vcu0 = F.vcu; F.G0 = F.G; F.bx0 = F.bx;
    F.ctl = (gu32*)(args.ws + WS_CTL); F.out = args.out; F.ws = args.ws; F.ws0 = args.ws; F.z = 0;
    for (int u = F.tid; u < (LDS_BYTES - MISC_OFF) / 4; u += NTHR) ((LAS unsigned*)(F.lds + MISC_OFF))[u] = 0u;
    __syncthreads();
    XcdBarrier bar; bar.bar = (unsigned*)(F.ctl + CW_BAR); bar.x = 0; bar.st = nullptr;
    if (!MK_PER_PHASE) bar = xcd_barrier_post((unsigned*)(F.ctl + CW_BAR), F.MISC + 8);
    const int lo = args.ph_lo, hi = args.ph_hi;
    int ph = 0;
#define IN_() (lo <= ph && ph < hi && ({ LAUNDER_TID(F); true; }))
#define DUP3(...) do { __VA_ARGS__; if (PROBE_DUP == 3) { __VA_ARGS__; } } while (0)
#define SEAM() do { if (!MK_PER_PHASE && lo <= ph && ph + 1 < hi) { XcdBarrier b_ = bar; { unsigned long long p_ = (unsigned long long)b_.bar; unsigned x_ = b_.x; asm volatile("" : "+s"(p_), "+s"(x_)); b_.bar = (unsigned*)(GAS unsigned*)p_; b_.x = x_; } \
        xcd_barrier(b_); if (PROBE_DUP == 7) xcd_barrier(b_); } ++ph; } while (0)
    if ((PHMASK & 1) && IN_()) { p0_prologue(F, args); if (PROBE_DUP == 4) p0_prologue(F, args); }
    SEAM();
#define Hb ((bf16*)(F.ws + WS_H))
#define XB ((bf16*)(F.ws + WS_XB))
#define projT ((bf16*)(F.ws + WS_PROJT))
#define qkv ((bf16*)(F.ws + WS_QKV))
#define mix ((bf16*)(F.ws + WS_MIX))
#define ffh ((bf16*)(F.ws + WS_FFH))
#define mixin ((bf16*)(F.ws + WS_MIXIN))
#define wl (F.ws + WS_W + (size_t)l * SZ_WLAYER)
#define xin ((g == 0) ? GP(args.in[I_XP + F.z]) : GP(args.in[I_XS + F.z]) + (size_t)(g - 1) * MG * DM)
#define xres ((float*)(GAS float*)args.out + (size_t)g * MG * DM)
    for (int g = 0; g < NGRP; ++g) {
        if ((PHMASK & 2) && IN_()) norm_pass<false>(F, xin, nullptr, nullptr, nullptr, nullptr, GP(args.in[I_GMPRE + F.z]), Hb);
        SEAM();
        for (int l = 0; l < DEPTH; ++l) {
            if ((PHMASK & 4) && IN_()) {
                { pg8::Gemm gm{(const bf16*)(wl + OFF_WHY), Hb, HYIN, MG, DM}; pg8::StaticOrder S; S.init(HYIN, MG, F.G, F.bx);
                  pg8::EpiPlain E{projT, MG};
                  DUP3(pg8::gemm_phase<pg8::EpiPlain, pg8::StaticOrder, true, true>(F.lds + RING_OFF, gm, S, E)); }
                if (g == 0 || !args.taps_all) { pg8::Gemm gm{(const bf16*)(F.ws + WS_W4T) + (size_t)l * 4096 * KPAD, (const bf16*)(F.ws + WS_H3) + (size_t)l * SEQ * KPAD, 4096, SEQ, KPAD}; pg8::StaticOrder S; S.init(4096, SEQ, F.G, F.bx);
                  pg8::EpiPlain E{(bf16*)(F.ws + ((args.taps_all && l > 0) ? WS_TAPS_X + (size_t)(l - 1) * SZ_TAPS : WS_TAPS)), SEQ};
                  DUP3(pg8::gemm_phase<pg8::EpiPlain, pg8::StaticOrder, true, true>(F.lds + RING_OFF, gm, S, E)); }
                { pg8::Gemm gm{Hb, (const bf16*)(wl + OFF_WQKV), MG, QKVW, DM}; pg8::StaticOrder S; S.init(MG, QKVW, F.G, F.bx);
                  pg8::EpiRope E{qkv, QKVW, (const float*)(F.ws + WS_ROPE), QSCALE};
                  DUP3(pg8::gemm_phase<pg8::EpiRope, pg8::StaticOrder, true, true>(F.lds + RING_OFF, gm, S, E)); }
            }
            SEAM();
            if (IN_()) { if (PHMASK & 8) hyena_phase(F, args, l); if (PROBE_DUP == 2) hyena_phase(F, args, l); if (PHMASK & 16) attn_phase(F, args, l, lds); if (PROBE_DUP == 1) attn_phase(F, args, l, lds); }
            SEAM();
            if ((PHMASK & 32) && IN_()) { hynorm_phase(F, args, l); if (PROBE_DUP == 4) hynorm_phase(F, args, l); }
            SEAM();
            if ((PHMASK & 64) && IN_()) { pg8::Gemm gm{mixin, (const bf16*)(wl + OFF_WOUT), MG, DM, DM}; pg8::StaticOrder S; S.init(MG, DM, F.G, F.bx);
                pg8::EpiPlain E{mix, DM};
                DUP3(pg8::gemm_phase<pg8::EpiPlain, pg8::StaticOrder, true, true>(F.lds + RING_OFF, gm, S, E)); }
            SEAM();
            if ((PHMASK & 2) && IN_()) { if (l == 0) norm_pass<false>(F, xin, mix, GP(args.in[I_GMPOST + F.z]) + (size_t)l * DM, XB, nullptr, GP(args.in[I_GFPRE + F.z]) + (size_t)l * DM, Hb);
                else norm_pass<true>(F, XB, mix, GP(args.in[I_GMPOST + F.z]) + (size_t)l * DM, XB, nullptr, GP(args.in[I_GFPRE + F.z]) + (size_t)l * DM, Hb); }
            SEAM();
            if ((PHMASK & 128) && IN_()) { pg8::Gemm gm{Hb, (const bf16*)(wl + OFF_WGU), MG, GU, DM}; pg8::StaticOrder S; S.init(MG, GU, F.G, F.bx);
                pg8::EpiSwiGLU E{ffh, DFF};
                DUP3(pg8::gemm_phase<pg8::EpiSwiGLU, pg8::StaticOrder, true, true>(F.lds + RING_OFF, gm, S, E)); }
            SEAM();
            if ((PHMASK & 256) && IN_()) { pg8::Gemm gm{ffh, (const bf16*)(wl + OFF_WDN), MG, DM, DFF}; pg8::StaticOrder S; S.init(MG, DM, F.G, F.bx);
                pg8::EpiPlain E{mixin, DM};
                DUP3(pg8::gemm_phase<pg8::EpiPlain, pg8::StaticOrder, true, true>(F.lds + RING_OFF, gm, S, E)); }
            SEAM();
            if ((PHMASK & 2) && IN_()) { if (l + 1 < DEPTH) norm_pass<true>(F, XB, mixin, GP(args.in[I_GFPOST + F.z]) + (size_t)l * DM, XB, nullptr, GP(args.in[I_GMPRE + F.z]) + (size_t)(l + 1) * DM, Hb);
                else norm_pass<true>(F, XB, mixin, GP(args.in[I_GFPOST + F.z]) + (size_t)l * DM, nullptr, xres, nullptr, nullptr); }
            SEAM();
        }
    }
#undef IN_
#undef SEAM
#undef Hb
#undef XB
#undef projT
#undef qkv
#undef mix
#undef ffh
#undef mixin
#undef wl
#undef xin
#undef xres
}

extern "C" void kernel_launch(void* const* d_in, const int* in_sizes, int n_in, void* d_out, int out_size, void* d_ws, size_t ws_size, hipStream_t stream) {
    static int grid = 0;
    if (grid == 0) {
        if (n_in != 30 || in_sizes[0] != 2 * SEQ * DM || in_sizes[1] != 4 * SEQ * DM || out_size != NSEQ * SEQ * DM || ws_size < WS_END) {
            fprintf(stderr, "kernel_launch: shape mismatch (n_in %d, out %d, ws %zu, need %zu)\n", n_in, out_size, ws_size, (size_t)WS_END); grid = -1; return; }
        int dev = 0, cus = 0;
        if (hipGetDevice(&dev) != hipSuccess || hipDeviceGetAttribute(&cus, hipDeviceAttributeMultiprocessorCount, dev) != hipSuccess) { grid = -1; return; }
        if (hipFuncSetAttribute((const void*)hymba_fwd, hipFuncAttributeMaxDynamicSharedMemorySize, LDS_BYTES) != hipSuccess) { fprintf(stderr, "kernel_launch: hipFuncSetAttribute failed\n"); grid = -1; return; }
        int per_cu = 0;
        if (hipOccupancyMaxActiveBlocksPerMultiprocessor(&per_cu, (const void*)hymba_fwd, NTHR, LDS_BYTES) != hipSuccess || per_cu < 1) fprintf(stderr, "kernel_launch: occupancy query says %d\n", per_cu);
        (void)hipGetLastError();
        grid = cus;
    }
    if (grid < 0) return;
    if (hipMemsetAsync((char*)d_ws + WS_CTL, 0, CTL_ZERO_BYTES, stream) != hipSuccess) return;
    Args a{};
    for (int i = 0; i < 30; ++i) a.in[i] = (const float*)d_in[i];
    a.out = (float*)d_out; a.ws = (unsigned char*)d_ws; a.taps_all = (ws_size >= WS_END_X) ? 1 : 0;
#if MK_PER_PHASE
    for (int p = 0; p < NPHASE; ++p) { a.ph_lo = p; a.ph_hi = p + 1; hipLaunchKernelGGL(hymba_fwd, dim3(grid), dim3(NTHR), LDS_BYTES, stream, a); }
#else
    a.ph_lo = 0; a.ph_hi = NPHASE;
    hipLaunchKernelGGL(hymba_fwd, dim3(grid), dim3(NTHR), LDS_BYTES, stream, a);
#endif
    const hipError_t le = hipPeekAtLastError();
    if (le != hipSuccess) fprintf(stderr, "kernel_launch: launch failed: %s\n", hipGetErrorName(le));
}
```

```cpp
#include <hip/hip_runtime.h>
#include <hip/hip_bf16.h>
#include <cstdio>
#include <cstdint>
#include <cmath>
namespace pg8 {
#define PG8_LAS __attribute__((address_space(3)))
typedef unsigned short bf16_t;
typedef short bf16x8 __attribute__((ext_vector_type(8)));
typedef float f32x4 __attribute__((ext_vector_type(4)));
typedef unsigned u32x4 __attribute__((ext_vector_type(4)));
constexpr int BM = 256, BK = 64, HALF = 128, HTB = HALF * BK * 2  , STAGE_BYTES = 8 * HTB, NXCD = 8, WGM = 8;

__host__ __device__ __forceinline__ int lds_byte(int r, int c) { const int st = (r >> 4) * 2 + (c >> 5), rr = r & 15, cc = c & 31, ob = rr * 64 + cc * 2; return st * 1024 + (ob ^ (((ob >> 9) & 1) << 5)); }
__host__ __device__ __forceinline__ void stage_rc(int b, int& R, int& C) { const int st = b / 1024, sb = b % 1024, swz = sb ^ (((sb >> 9) & 1) << 5); R = (st >> 1) * 16 + swz / 64; C = (st & 1) * 32 + (swz % 64) / 2; }
__host__ __device__ __forceinline__ int perm32(int rho) { const int n = rho >> 4, i = rho & 15; return 8 * (i >> 2) + 4 * n + (i & 3); }

struct Unit { int pm, pn; };
struct Gemm { const bf16_t* A; const bf16_t* Bt; int M, N, K; };

struct StaticOrder {
    int nM, nN, nwg, G, c;
    __host__ __device__ void init(int M, int N, int G_, int c_) { nM = M / BM; nN = N / BM; nwg = nM * nN; G = G_; c = c_; }
    __host__ __device__ bool next(int i, Unit& u) const {
        const long L = (long)i * G + c; if (L >= nwg) return false;
        int wgid = (int)L; { const int q = nwg / NXCD, r = nwg % NXCD, xcd = wgid % NXCD, off = wgid / NXCD; wgid = (xcd < r ? xcd * (q + 1) : r * (q + 1) + (xcd - r) * q) + off; }
        const int nig = WGM * nN, gid = wgid / nig, fm = gid * WGM, gsz = (nM - fm) < WGM ? (nM - fm) : WGM;
        u.pm = fm + ((wgid % nig) % gsz); u.pn = (wgid % nig) / gsz; return true;
    }
    __device__ __forceinline__ void a_ready(const Unit&) const {}
    __device__ __forceinline__ void done(const Unit&) const {}
};

__device__ __forceinline__ unsigned cvt_pk_bf16(float lo, float hi) { unsigned r; asm volatile("v_cvt_pk_bf16_f32 %0, %1, %2" : "=v"(r) : "v"(lo), "v"(hi)); return r; }
typedef float f32x2 __attribute__((ext_vector_type(2)));
struct EpiPlain {
    static constexpr bool PERM = true, AFTER_DRAIN = false;
    bf16_t* O; int ldc;
    __device__ __forceinline__ void operator()(const f32x4 (&acc)[2][2][4][2], const Unit& u, int wr, int wc, int fr, int fq) const {
        const int row0 = u.pm * BM + wr * 64 + fr, col0 = u.pn * BM + wc * 32 + 8 * fq;
#pragma unroll
        for (int ai = 0; ai < 2; ++ai)
#pragma unroll
            for (int m = 0; m < 4; ++m) { bf16_t* rowp = O + (size_t)(row0 + ai * HALF + m * 16) * ldc + col0;
#pragma unroll
                for (int bj = 0; bj < 2; ++bj) { const f32x4 v0 = acc[ai][bj][m][0], v1 = acc[ai][bj][m][1];
                    u32x4 w; w.x = cvt_pk_bf16(v0[0], v0[1]); w.y = cvt_pk_bf16(v0[2], v0[3]); w.z = cvt_pk_bf16(v1[0], v1[1]); w.w = cvt_pk_bf16(v1[2], v1[3]);
                    *(u32x4*)(rowp + bj * HALF) = w; } }
    }
};
struct EpiRope {
    static constexpr bool PERM = true, AFTER_DRAIN = false;
    bf16_t* O; int ldc; const float* cs; float qscale;
    __device__ __forceinline__ void operator()(const f32x4 (&acc)[2][2][4][2], const Unit& u, int wr, int wc, int fr, int fq) const {
        const int row0 = u.pm * BM + wr * 64 + fr, col0 = u.pn * BM + wc * 32 + 8 * fq;
        const bool rope = u.pn < 8; const float sc = u.pn < 4 ? qscale : 1.0f;
        const int p0 = 16 * (wc & 1) + 4 * fq;
        f32x4 tt[2][4][2];
#pragma unroll
        for (int ai = 0; ai < 2; ++ai)
#pragma unroll
            for (int m = 0; m < 4; ++m) { tt[ai][m][0] = (f32x4){1.f, 0.f, 1.f, 0.f}; tt[ai][m][1] = (f32x4){1.f, 0.f, 1.f, 0.f};
                if (rope) { const int row = row0 + ai * HALF + m * 16; const __attribute__((address_space(1))) float* tp = (const __attribute__((address_space(1))) float*)cs + ((size_t)(row & 8191) * 32 + p0) * 2;
                    tt[ai][m][0] = *(const __attribute__((address_space(1))) f32x4*)tp; tt[ai][m][1] = *(const __attribute__((address_space(1))) f32x4*)(tp + 4); } }
#pragma unroll
        for (int ai = 0; ai < 2; ++ai)
#pragma unroll
            for (int m = 0; m < 4; ++m) { const int row = row0 + ai * HALF + m * 16; bf16_t* rowp = O + (size_t)row * ldc + col0;
                const f32x4 t0 = tt[ai][m][0], t1 = tt[ai][m][1];
#pragma unroll
                for (int bj = 0; bj < 2; ++bj) { const f32x4 v0 = acc[ai][bj][m][0], v1 = acc[ai][bj][m][1];
                    f32x4 o0, o1;
                    o0[0] = (v0[0] * t0[0] - v0[1] * t0[1]) * sc; o0[1] = (v0[0] * t0[1] + v0[1] * t0[0]) * sc;
                    o0[2] = (v0[2] * t0[2] - v0[3] * t0[3]) * sc; o0[3] = (v0[2] * t0[3] + v0[3] * t0[2]) * sc;
                    o1[0] = (v1[0] * t1[0] - v1[1] * t1[1]) * sc; o1[1] = (v1[0] * t1[1] + v1[1] * t1[0]) * sc;
                    o1[2] = (v1[2] * t1[2] - v1[3] * t1[3]) * sc; o1[3] = (v1[2] * t1[3] + v1[3] * t1[2]) * sc;
                    u32x4 w; w.x = cvt_pk_bf16(o0[0], o0[1]); w.y = cvt_pk_bf16(o0[2], o0[3]); w.z = cvt_pk_bf16(o1[0], o1[1]); w.w = cvt_pk_bf16(o1[2], o1[3]);
                    *(u32x4*)(rowp + bj * HALF) = w; } }
    }
};
struct EpiSwiGLU {
    static constexpr bool PERM = true, AFTER_DRAIN = false;
    bf16_t* O; int ldc;
    static __device__ __forceinline__ float silu_mul(float g, float u) { return g * u * __builtin_amdgcn_rcpf(1.0f + __builtin_amdgcn_exp2f(-1.4426950408889634f * g)); }
    __device__ __forceinline__ void operator()(const f32x4 (&acc)[2][2][4][2], const Unit& u, int wr, int wc, int fr, int fq) const {
        const int row0 = u.pm * BM + wr * 64 + fr, col0 = u.pn * HALF + wc * 32 + 8 * fq;
#pragma unroll
        for (int ai = 0; ai < 2; ++ai)
#pragma unroll
            for (int m = 0; m < 4; ++m) { bf16_t* rowp = O + (size_t)(row0 + ai * HALF + m * 16) * ldc + col0;
                const f32x4 g0 = acc[ai][0][m][0], g1 = acc[ai][0][m][1], u0 = acc[ai][1][m][0], u1 = acc[ai][1][m][1];
                u32x4 w; w.x = cvt_pk_bf16(silu_mul(g0[0], u0[0]), silu_mul(g0[1], u0[1])); w.y = cvt_pk_bf16(silu_mul(g0[2], u0[2]), silu_mul(g0[3], u0[3]));
                w.z = cvt_pk_bf16(silu_mul(g1[0], u1[0]), silu_mul(g1[1], u1[1])); w.w = cvt_pk_bf16(silu_mul(g1[2], u1[2]), silu_mul(g1[3], u1[3]));
                *(u32x4*)rowp = w; }
    }
};
template <class Epi, class Sched, bool ALIGN_EPI = false, bool SP2 = false>
__device__ __forceinline__ void gemm_phase(PG8_LAS unsigned char* lds, const Gemm g, const Sched& S, const Epi& E) {
    int tid = threadIdx.x; asm volatile("" : "+v"(tid));
    const int wid = __builtin_amdgcn_readfirstlane(tid >> 6), lane = tid & 63, wr = wid >> 2, wc = wid & 3, fr = lane & 15, fq = lane >> 4;
    const int K = g.K, nt = K / BK;
    unsigned voffA[2], voffB[2];
#pragma unroll
    for (int i = 0; i < 2; ++i) { int R, C; stage_rc(tid * 16 + i * 8192, R, C); const int Rb = Epi::PERM ? ((R & ~31) + perm32(R & 31)) : R;
        voffA[i] = (unsigned)(R * K + C) * 2u; voffB[i] = (unsigned)(Rb * K + C) * 2u; }
    const size_t kstep = (size_t)(BK * 2);
    const size_t hstep = (size_t)HALF * K * 2;
    const size_t tstep = 2 * hstep;
    const unsigned ldsw = (unsigned)wid * 1024u;
    const int aoff = lds_byte(wr * 64 + fr, fq * 8), boff = lds_byte(wc * 32 + fr, fq * 8);
#define PG8_SA(b, h) (((b) * 2 + (h)) * HTB)
#define PG8_SB(b, h) ((4 + (b) * 2 + (h)) * HTB)
#define PG8_STAGE(bufoff, gbase, voff) do { _Pragma("unroll") for (int _i = 0; _i < 2; ++_i) \
        __builtin_amdgcn_global_load_lds((const unsigned*)((const char*)(gbase) + (voff)[_i]), (PG8_LAS unsigned*)(lds + (bufoff) + ldsw + _i * 8192), 16, 0, 0); } while (0)
#define PG8_LDA(dst, b, h) do { _Pragma("unroll") for (int m = 0; m < 4; ++m) _Pragma("unroll") for (int k = 0; k < 2; ++k) dst[m][k] = *(const PG8_LAS bf16x8*)(lds + PG8_SA(b, h) + aoff + m * 2048 + k * 1024); } while (0)
#define PG8_LDB(dst, b, h) do { _Pragma("unroll") for (int n = 0; n < 2; ++n) _Pragma("unroll") for (int k = 0; k < 2; ++k) dst[n][k] = *(const PG8_LAS bf16x8*)(lds + PG8_SB(b, h) + boff + n * 2048 + k * 1024); } while (0)
#define PG8_MMA(ai, bj, At, Bt) do { __builtin_amdgcn_s_setprio(1); _Pragma("unroll") for (int m = 0; m < 4; ++m) _Pragma("unroll") for (int n = 0; n < 2; ++n) _Pragma("unroll") for (int k = 0; k < 2; ++k) \
        acc[ai][bj][m][n] = __builtin_amdgcn_mfma_f32_16x16x32_bf16(Bt[n][k], At[m][k], acc[ai][bj][m][n], 0, 0, 0); __builtin_amdgcn_s_setprio(0); } while (0)
#define PG8_WAIT_V(n) asm volatile("s_waitcnt vmcnt(" #n ")" ::: "memory")
#define PG8_WAIT_L(n) asm volatile("s_waitcnt lgkmcnt(" #n ")" ::: "memory")
#define PG8_BAR __builtin_amdgcn_s_barrier()
#define PG8_SCHED __builtin_amdgcn_sched_barrier(0)
    Unit cur, nxt; int ui = 0;
    if (!S.next(0, cur)) return;
    f32x4 acc[2][2][4][2];
#pragma unroll
    for (int a = 0; a < 2; ++a)
#pragma unroll
        for (int b = 0; b < 2; ++b)
#pragma unroll
            for (int m = 0; m < 4; ++m)
#pragma unroll
                for (int n = 0; n < 2; ++n) acc[a][b][m][n] = (f32x4){0.f, 0.f, 0.f, 0.f};
    bf16x8 At[4][2], B0[2][2], B1[2][2];
    const char* cA = (const char*)g.A + (size_t)cur.pm * tstep; const char* cB = (const char*)g.Bt + (size_t)cur.pn * tstep;
    S.a_ready(cur);
    if constexpr (SP2) {
        PG8_STAGE(PG8_SB(0, 0), cB, voffB); PG8_STAGE(PG8_SB(0, 1), cB + hstep, voffB); PG8_STAGE(PG8_SA(0, 0), cA, voffA); PG8_STAGE(PG8_SA(0, 1), cA + hstep, voffA);
        if (wr == 1) PG8_BAR;
        PG8_WAIT_V(2); PG8_BAR;
        PG8_STAGE(PG8_SB(1, 0), cB + kstep, voffB); PG8_STAGE(PG8_SA(1, 0), cA + kstep, voffA); PG8_STAGE(PG8_SB(1, 1), cB + hstep + kstep, voffB);
        PG8_WAIT_V(6); PG8_BAR;
    } else {
        PG8_STAGE(PG8_SB(0, 0), cB, voffB); PG8_STAGE(PG8_SA(0, 0), cA, voffA); PG8_STAGE(PG8_SB(0, 1), cB + hstep, voffB); PG8_STAGE(PG8_SA(0, 1), cA + hstep, voffA);
        if (wr == 1) PG8_BAR;
        PG8_WAIT_V(4); PG8_BAR;
        PG8_STAGE(PG8_SB(1, 0), cB + kstep, voffB); PG8_STAGE(PG8_SA(1, 0), cA + kstep, voffA); PG8_STAGE(PG8_SB(1, 1), cB + hstep + kstep, voffB);
        PG8_WAIT_V(6); PG8_BAR;
    }
    for (;;) {
        const bool has_next = S.next(ui + 1, nxt);
        const char* nA = has_next ? (const char*)g.A + (size_t)nxt.pm * tstep : cA; const char* nB = has_next ? (const char*)g.Bt + (size_t)nxt.pn * tstep : cB;
        for (int t = 0; t < nt; t += 2) {
            const bool last = (t == nt - 2);
            const char* a1 = cA + (size_t)(t + 1) * kstep;
            const char* a2 = last ? nA : cA + (size_t)(t + 2) * kstep; const char* b2 = last ? nB : cB + (size_t)(t + 2) * kstep;
            const char* a3 = a2 + kstep; const char* b3 = b2 + kstep;
            if (last && has_next) S.a_ready(nxt);
            if constexpr (SP2) {
            PG8_LDB(B0, 0, 0); PG8_LDB(B1, 0, 1); PG8_SCHED; PG8_LDA(At, 0, 0); PG8_STAGE(PG8_SA(1, 1), a1 + hstep, voffA);
            PG8_WAIT_V(8); PG8_WAIT_L(0); PG8_BAR; PG8_MMA(0, 0, At, B0); PG8_MMA(0, 1, At, B1); PG8_BAR; PG8_SCHED;
            PG8_LDA(At, 0, 1); PG8_STAGE(PG8_SB(0, 0), b2, voffB); PG8_STAGE(PG8_SB(0, 1), b2 + hstep, voffB); PG8_STAGE(PG8_SA(0, 0), a2, voffA);
            PG8_WAIT_V(8); PG8_WAIT_L(0); PG8_BAR; PG8_MMA(1, 0, At, B0); PG8_MMA(1, 1, At, B1); PG8_BAR; PG8_SCHED;
            PG8_LDB(B0, 1, 0); PG8_LDB(B1, 1, 1); PG8_SCHED; PG8_LDA(At, 1, 0); PG8_STAGE(PG8_SA(0, 1), a2 + hstep, voffA);
            PG8_WAIT_V(8); PG8_WAIT_L(0); PG8_BAR; PG8_MMA(0, 0, At, B0); PG8_MMA(0, 1, At, B1); PG8_BAR; PG8_SCHED;
            PG8_LDA(At, 1, 1); PG8_STAGE(PG8_SB(1, 0), b3, voffB); PG8_STAGE(PG8_SB(1, 1), b3 + hstep, voffB); PG8_STAGE(PG8_SA(1, 0), a3, voffA);
            PG8_WAIT_V(8); PG8_WAIT_L(0); PG8_BAR; PG8_MMA(1, 0, At, B0); PG8_MMA(1, 1, At, B1); PG8_BAR; PG8_SCHED;
            } else {
            PG8_LDB(B0, 0, 0); PG8_SCHED; PG8_LDA(At, 0, 0); PG8_STAGE(PG8_SA(1, 1), a1 + hstep, voffA);
            PG8_WAIT_L(8); PG8_BAR; PG8_WAIT_L(0); PG8_MMA(0, 0, At, B0); PG8_BAR; PG8_SCHED;
            PG8_LDB(B1, 0, 1); PG8_STAGE(PG8_SB(0, 0), b2, voffB);
            PG8_BAR; PG8_WAIT_L(0); PG8_MMA(0, 1, At, B1); PG8_BAR;
            PG8_LDA(At, 0, 1); PG8_STAGE(PG8_SA(0, 0), a2, voffA);
            PG8_BAR; PG8_WAIT_L(0); PG8_MMA(1, 0, At, B0); PG8_BAR; PG8_SCHED;
            PG8_STAGE(PG8_SB(0, 1), b2 + hstep, voffB);
            PG8_WAIT_V(6); PG8_BAR; PG8_MMA(1, 1, At, B1); PG8_BAR;
            PG8_LDB(B0, 1, 0); PG8_SCHED; PG8_LDA(At, 1, 0); PG8_STAGE(PG8_SA(0, 1), a2 + hstep, voffA);
            PG8_WAIT_L(8); PG8_BAR; PG8_WAIT_L(0); PG8_MMA(0, 0, At, B0); PG8_BAR; PG8_SCHED;
            PG8_LDB(B1, 1, 1); PG8_STAGE(PG8_SB(1, 0), b3, voffB);
            PG8_BAR; PG8_WAIT_L(0); PG8_MMA(0, 1, At, B1); PG8_BAR;
            PG8_LDA(At, 1, 1); PG8_STAGE(PG8_SA(1, 0), a3, voffA);
            PG8_BAR; PG8_WAIT_L(0); PG8_MMA(1, 0, At, B0); PG8_BAR; PG8_SCHED;
            PG8_STAGE(PG8_SB(1, 1), b3 + hstep, voffB);
            PG8_WAIT_V(6); PG8_BAR; PG8_MMA(1, 1, At, B1); PG8_BAR;
            }
        }
        if constexpr (ALIGN_EPI) { if (wr == 0) PG8_BAR; }
        if constexpr (!Epi::AFTER_DRAIN) { E(acc, cur, wr, wc, fr, fq); S.done(cur); }
        if (!has_next) break;
#pragma unroll
        for (int a = 0; a < 2; ++a)
#pragma unroll
            for (int b = 0; b < 2; ++b)
#pragma unroll
                for (int m = 0; m < 4; ++m)
#pragma unroll
                    for (int n = 0; n < 2; ++n) acc[a][b][m][n] = (f32x4){0.f, 0.f, 0.f, 0.f};
        cur = nxt; cA = nA; cB = nB; ++ui;
        if constexpr (ALIGN_EPI) { if (wr == 1) PG8_BAR; }
    }
    PG8_WAIT_V(0);
    if constexpr (!ALIGN_EPI) { if (wr == 0) PG8_BAR; }
    PG8_BAR;
    if constexpr (Epi::AFTER_DRAIN) { E.fused(acc, cur, wr, wc, fr, fq, lds, wid, lane); S.done(cur); }
#undef PG8_SA
#undef PG8_SB
#undef PG8_STAGE
#undef PG8_LDA
#undef PG8_LDB
#undef PG8_MMA
#undef PG8_WAIT_V
#undef PG8_WAIT_L
#undef PG8_BAR
#undef PG8_SCHED
}
}
namespace att {
using bf16x8 = __attribute__((ext_vector_type(8))) short;
using s16x4  = __attribute__((ext_vector_type(4))) short;
using f32x16 = __attribute__((ext_vector_type(16))) float;
using u32x4  = __attribute__((ext_vector_type(4))) unsigned;
typedef unsigned short bf16;
constexpr int DQ = 64, DV = 128, NW = 8, QBLK = 32, KVBLK = 64, LDR = 3072;
constexpr int SHM_V = KVBLK * DV * 2, SHM_K = KVBLK * DQ * 2, SHM_ATTN = 3 * SHM_V + 3 * SHM_K + NW * 64 * 4 + 64;
constexpr int SHM_ATTN_ALL = SHM_ATTN + NW * QBLK * DV * 2;
#ifndef ATT_OVF_LIMIT
#define ATT_OVF_LIMIT 1.152921504606847e18f
#endif
#ifndef ATT_SDEPTH
#define ATT_SDEPTH 2
#endif
constexpr float THR2 = 11.0f;
#define KSWZ64(row, colB) ((row) * 128 + ((colB) ^ ((((row) >> 1) & 7) << 4)))
#define SBAR() __builtin_amdgcn_sched_barrier(0)
template <int K> __device__ __forceinline__ float sx(float v) { return __builtin_bit_cast(float, __builtin_amdgcn_ds_swizzle(__builtin_bit_cast(int, v), (K << 10) | 0x1f)); }
__device__ __forceinline__ int crow(int r, int hi) { return (r & 3) + 8 * (r >> 2) + 4 * hi; }
__device__ __forceinline__ unsigned cvtpk(float lo, float hi) { unsigned r; asm volatile("v_cvt_pk_bf16_f32 %0, %1, %2" : "=v"(r) : "v"(lo), "v"(hi)); return r; }
__device__ __forceinline__ void partialSM(f32x16& p0, f32x16& p1, float& m_reg, float& mn, float& alpha) {
  float pmax = p0[0];
#pragma unroll
  for (int r = 1; r < 16; ++r) pmax = fmaxf(pmax, p0[r]);
#pragma unroll
  for (int r = 0; r < 16; ++r) pmax = fmaxf(pmax, p1[r]);
  { auto rr = __builtin_amdgcn_permlane32_swap(__float_as_uint(pmax), __float_as_uint(pmax), false, false);
    pmax = fmaxf(__uint_as_float(rr[0]), __uint_as_float(rr[1])); }
  if (__builtin_expect(__all(pmax - m_reg <= THR2), 1)) { mn = m_reg; alpha = 1.f; }
  else { mn = fmaxf(m_reg, pmax); alpha = __builtin_amdgcn_exp2f(m_reg - mn); m_reg = mn; }
#pragma unroll
  for (int r = 0; r < 16; ++r) p0[r] = p0[r] - mn;
#pragma unroll
  for (int r = 0; r < 16; ++r) p1[r] = p1[r] - mn;
#pragma unroll
  for (int r = 0; r < 16; ++r) p0[r] = __builtin_amdgcn_exp2f(p0[r]);
}
__device__ __forceinline__ void finishSM(f32x16& p0, f32x16& p1, float alpha, float& l_reg, bf16x8& pa0, bf16x8& pa1, bf16x8& pa2, bf16x8& pa3) {
#pragma unroll
  for (int r = 0; r < 16; ++r) p1[r] = __builtin_amdgcn_exp2f(p1[r]);
  float ps = 0;
#pragma unroll
  for (int r = 0; r < 16; ++r) ps += p0[r];
#pragma unroll
  for (int r = 0; r < 16; ++r) ps += p1[r];
  { auto rr = __builtin_amdgcn_permlane32_swap(__float_as_uint(ps), __float_as_uint(ps), false, false);
    ps = __uint_as_float(rr[0]) + __uint_as_float(rr[1]); }
  l_reg = l_reg * alpha + ps;
#define PK4(P, BASE, OUT) do { unsigned a0 = cvtpk(P[BASE + 0], P[BASE + 1]), a1 = cvtpk(P[BASE + 2], P[BASE + 3]);   \
    unsigned b0 = cvtpk(P[BASE + 4], P[BASE + 5]), b1 = cvtpk(P[BASE + 6], P[BASE + 7]);                              \
    auto r0 = __builtin_amdgcn_permlane32_swap(a0, b0, false, false); auto r1 = __builtin_amdgcn_permlane32_swap(a1, b1, false, false); \
    u32x4 w = {r0[0], r1[0], r0[1], r1[1]}; OUT = *reinterpret_cast<bf16x8*>(&w); } while (0)
  PK4(p0, 0, pa0); PK4(p0, 8, pa1); PK4(p1, 0, pa2); PK4(p1, 8, pa3);
#undef PK4
}
__device__ __forceinline__ void qkt(f32x16& p0, f32x16& p1, const char* Ks, const bf16x8* qr, int r32, int hi) {
  p0 = f32x16{}; p1 = f32x16{};
#pragma unroll
  for (int d0 = 0; d0 < 4; ++d0) { const int cb = (d0 * 16 + hi * 8) * 2;
    bf16x8 b0 = *reinterpret_cast<const bf16x8*>(Ks + KSWZ64(r32, cb));
    bf16x8 b1 = *reinterpret_cast<const bf16x8*>(Ks + KSWZ64(32 + r32, cb));
    p0 = __builtin_amdgcn_mfma_f32_32x32x16_bf16(b0, qr[d0], p0, 0, 0, 0);
    p1 = __builtin_amdgcn_mfma_f32_32x32x16_bf16(b1, qr[d0], p1, 0, 0, 0); }
}
__device__ __forceinline__ void qkt_ref(f32x16& p0, f32x16& p1, const char* Ks, const bf16x8* qr, const f32x16& negm, int r32, int hi) {
#pragma unroll
  for (int d0 = 0; d0 < 4; ++d0) { const int cb = (d0 * 16 + hi * 8) * 2;
    bf16x8 b0 = *reinterpret_cast<const bf16x8*>(Ks + KSWZ64(r32, cb));
    bf16x8 b1 = *reinterpret_cast<const bf16x8*>(Ks + KSWZ64(32 + r32, cb));
    if (d0 == 0) { p0 = __builtin_amdgcn_mfma_f32_32x32x16_bf16(b0, qr[0], negm, 0, 0, 0); p1 = __builtin_amdgcn_mfma_f32_32x32x16_bf16(b1, qr[0], negm, 0, 0, 0); }
    else { p0 = __builtin_amdgcn_mfma_f32_32x32x16_bf16(b0, qr[d0], p0, 0, 0, 0); p1 = __builtin_amdgcn_mfma_f32_32x32x16_bf16(b1, qr[d0], p1, 0, 0, 0); } }
}
__device__ __forceinline__ void exp_half(f32x16& p) {
#pragma unroll
  for (int r = 0; r < 16; ++r) p[r] = __builtin_amdgcn_exp2f(p[r]);
}
__device__ __forceinline__ void sub_exp_half(f32x16& p0, f32x16& p1, float m) {
#pragma unroll
  for (int r = 0; r < 16; ++r) p0[r] = p0[r] - m;
#pragma unroll
  for (int r = 0; r < 16; ++r) p1[r] = p1[r] - m;
#pragma unroll
  for (int r = 0; r < 16; ++r) p0[r] = __builtin_amdgcn_exp2f(p0[r]);
}
__device__ __forceinline__ void finishSM_fast(f32x16& p0, f32x16& p1, float& l_reg, bool& ovf, bf16x8& pa0, bf16x8& pa1, bf16x8& pa2, bf16x8& pa3) {
  float al = 1.f; float l0 = 0.f;
  finishSM(p0, p1, al, l0, pa0, pa1, pa2, pa3);
  ovf = ovf || !(l0 < ATT_OVF_LIMIT);
  l_reg += l0;
}
__device__ __forceinline__ int v_st(int k, int c) { const int kk = (k & ~0xC) | ((k & 4) << 1) | ((k & 8) >> 1); return ((kk >> 3) * 4 + (c >> 5)) * 512 + ((kk & 7) * 32 + (c & 31)) * 2; }
__device__ __forceinline__ int v_rd_base(int lane) { return ((lane & 3) << 3) | (((lane >> 2) & 3) << 6) | (((lane >> 4) & 1) << 5) | (((lane >> 5) & 1) << 8); }
constexpr int v_rd_off(int d0, int ks, int half) { return d0 * 512 + ks * 4096 + half * 2048; }
template <int OFF> __device__ __forceinline__ s16x4 tr_read(int vb) {
  s16x4 r; asm volatile("ds_read_b64_tr_b16 %0, %1 offset:%2" : "=&v"(r) : "v"(vb), "i"(OFF) : "memory"); return r;
}
template <int D0> __device__ __forceinline__ void pv_one(f32x16& od, int vb, bf16x8 pa0, bf16x8 pa1, bf16x8 pa2, bf16x8 pa3) {
  const s16x4 l0 = tr_read<v_rd_off(D0, 0, 0)>(vb), h0 = tr_read<v_rd_off(D0, 0, 1)>(vb), l1 = tr_read<v_rd_off(D0, 1, 0)>(vb), h1 = tr_read<v_rd_off(D0, 1, 1)>(vb);
  const s16x4 l2 = tr_read<v_rd_off(D0, 2, 0)>(vb), h2 = tr_read<v_rd_off(D0, 2, 1)>(vb), l3 = tr_read<v_rd_off(D0, 3, 0)>(vb), h3 = tr_read<v_rd_off(D0, 3, 1)>(vb);
  asm volatile("s_waitcnt lgkmcnt(0)" ::: "memory"); SBAR();
#define PK(L, H) (bf16x8){L[0], L[1], L[2], L[3], H[0], H[1], H[2], H[3]}
  od = __builtin_amdgcn_mfma_f32_32x32x16_bf16(pa0, PK(l0, h0), od, 0, 0, 0);
  od = __builtin_amdgcn_mfma_f32_32x32x16_bf16(pa1, PK(l1, h1), od, 0, 0, 0);
  od = __builtin_amdgcn_mfma_f32_32x32x16_bf16(pa2, PK(l2, h2), od, 0, 0, 0);
  od = __builtin_amdgcn_mfma_f32_32x32x16_bf16(pa3, PK(l3, h3), od, 0, 0, 0);
#undef PK
}
__device__ __forceinline__ void pv_d0(f32x16* o, int vb, bf16x8 pa0, bf16x8 pa1, bf16x8 pa2, bf16x8 pa3) {
  pv_one<0>(o[0], vb, pa0, pa1, pa2, pa3); pv_one<1>(o[1], vb, pa0, pa1, pa2, pa3); pv_one<2>(o[2], vb, pa0, pa1, pa2, pa3); pv_one<3>(o[3], vb, pa0, pa1, pa2, pa3);
}
__device__ __forceinline__ void glds16(const void* gsrc, unsigned lds_dst) { unsigned keep;
  asm volatile("s_mov_b32 %0, m0\n\ts_mov_b32 m0, %2\n\ts_nop 0\n\tglobal_load_lds_dwordx4 %1, off\n\ts_mov_b32 m0, %0" : "=&s"(keep) : "v"(gsrc), "s"(lds_dst) : "memory"); }
template <bool FAST>
__device__ __forceinline__ bool attn_map(const bf16* __restrict__ Kh, const bf16* __restrict__ Vh, const bf16* __restrict__ Qh  , int seq, char* V_lds, char* K_lds, float* ws_base,
                                         f32x16 (&o)[4], float& l_out) {
    int tid = threadIdx.x; asm volatile("" : "+v"(tid));
    const int wid = __builtin_amdgcn_readfirstlane(tid >> 6), r32 = tid & 31, hi = (tid >> 5) & 1;
    float* al_l = ws_base + wid * 64 + 32;
    const bf16* Qw = Qh + (long)(wid * QBLK + r32) * LDR + hi * 8;
    const int lane_ = tid & 63;
    const unsigned lds0 = (unsigned)(uintptr_t)V_lds;
    const bf16 *vsrc0, *vsrc1, *ksrc;
    { const int o0 = (2 * wid) * 1024 + 16 * lane_, o1 = o0 + 1024, ok = wid * 1024 + 16 * lane_;
      auto vmap = [](int o, int& k, int& c) { const int sub = o >> 9, w = o & 511, kk = ((sub >> 2) << 3) | (w >> 6); k = (kk & ~0xC) | ((kk & 4) << 1) | ((kk & 8) >> 1); c = (sub & 3) * 32 + ((w & 63) >> 1); };
      int k0_, c0_, k1_, c1_; vmap(o0, k0_, c0_); vmap(o1, k1_, c1_);
      vsrc0 = Vh + (long)k0_ * LDR + c0_; vsrc1 = Vh + (long)k1_ * LDR + c1_;
      const int row = ok >> 7, cb = (ok & 127) ^ (((row >> 1) & 7) << 4);
      ksrc = Kh + (long)row * LDR + (cb >> 1); }
    const int vb0 = (int)(uintptr_t)V_lds + v_rd_base(tid & 63);
    float m_reg = -1e30f, l_reg = 0; bf16x8 qr[4]; bool ovf = false;
#pragma unroll
    for (int d0 = 0; d0 < 4; ++d0) { o[d0] = f32x16{}; qr[d0] = *reinterpret_cast<const bf16x8*>(Qw + d0 * 16); }
#define DMA_TILE(t, b) do { const long ro_ = (long)(t) * KVBLK * LDR; \
      glds16(vsrc0 + ro_, (unsigned)__builtin_amdgcn_readfirstlane(lds0 + (b) * SHM_V + (2 * wid) * 1024)); \
      glds16(vsrc1 + ro_, (unsigned)__builtin_amdgcn_readfirstlane(lds0 + (b) * SHM_V + (2 * wid + 1) * 1024)); \
      glds16(ksrc + ro_, (unsigned)__builtin_amdgcn_readfirstlane(lds0 + 3 * SHM_V + (b) * SHM_K + wid * 1024)); } while (0)
#define DMA_WAIT() asm volatile("s_waitcnt vmcnt(0)" ::: "memory")
#define RESC(a) do { if constexpr (!FAST) { if (__any((a) < 1.f)) { if (hi == 0) al_l[r32] = (a); asm volatile("s_waitcnt lgkmcnt(0)" ::: "memory"); \
    _Pragma("unroll") for (int d = 0; d < 4; ++d) _Pragma("unroll") for (int r = 0; r < 16; ++r) o[d][r] *= al_l[crow(r, hi)]; } } } while (0)
#define PSM(P0, P1, MN, AL) do { if constexpr (FAST) exp_half(P0); else partialSM(P0, P1, m_reg, MN, AL); } while (0)
#define FSM(P0, P1, AL) do { if constexpr (FAST) finishSM_fast(P0, P1, l_reg, ovf, pa0, pa1, pa2, pa3); else finishSM(P0, P1, AL, l_reg, pa0, pa1, pa2, pa3); } while (0)
#define STEP(PN0, PN1, MNN, ALN, PO0, PO1, ALO, jj) do { \
      SBAR(); if constexpr (FAST) qkt_ref(PN0, PN1, K_lds + bc * SHM_K, qr, negm, r32, hi); else qkt(PN0, PN1, K_lds + bc * SHM_K, qr, r32, hi); \
      if ((jj) + 1 < NT) DMA_TILE((jj) + 1, bn);              \
      FSM(PO0, PO1, ALO); SBAR(); \
      pv_d0(o, vb0 + bp * SHM_V, pa0, pa1, pa2, pa3); PSM(PN0, PN1, MNN, ALN); RESC(ALN); \
      DMA_WAIT(); __syncthreads(); \
      bp = bc; bc = bn; bn = (bn == 2) ? 0 : bn + 1; } while (0)
    f32x16 pA0, pA1, pB0, pB1; float mnA = 0.f, mnB = 0.f, alA = 1.f, alB = 1.f; bf16x8 pa0, pa1, pa2, pa3; const int NT = seq / KVBLK;
    DMA_TILE(0, 0); DMA_WAIT(); __syncthreads();
    if (1 < NT) DMA_TILE(1, 1);
    qkt(pA0, pA1, K_lds, qr, r32, hi); partialSM(pA0, pA1, m_reg, mnA, alA);
    f32x16 negm = f32x16{};
    if constexpr (FAST) {
#pragma unroll
      for (int r = 0; r < 16; ++r) negm[r] = -m_reg;
      asm volatile("" : "+v"(negm));
    }
    DMA_WAIT(); __syncthreads();
    int bp = 0, bc = 1, bn = 2;
    for (int j = 1; j + 1 < NT; j += 2) {
      STEP(pB0, pB1, mnB, alB, pA0, pA1, alA, j);
      STEP(pA0, pA1, mnA, alA, pB0, pB1, alB, j + 1);
    }
    STEP(pB0, pB1, mnB, alB, pA0, pA1, alA, NT - 1);
    FSM(pB0, pB1, alB); SBAR();
    pv_d0(o, vb0 + bp * SHM_V, pa0, pa1, pa2, pa3);
#undef DMA_TILE
#undef DMA_WAIT
#undef RESC
#undef PSM
#undef FSM
#undef STEP
    l_out = l_reg;
    return ovf;
}
__device__ __forceinline__ void attn_unit(const bf16* __restrict__ qkv, long Qrow0, long Krow0, int vh, int seq, float lam, float oscale, const float* __restrict__ subln,
                                          bf16* __restrict__ Ob, int ldo, float* stash, char* lds) {
  int tid = threadIdx.x; asm volatile("" : "+v"(tid));
  const int wid = __builtin_amdgcn_readfirstlane(tid >> 6), lane = tid & 63, r32 = lane & 31, hi = lane >> 5;
  char* V_lds = lds; char* K_lds = lds + 3 * SHM_V;
  float* wsb = (float*)(lds + 3 * SHM_V + 3 * SHM_K); float* li_l = wsb + wid * 64;
  volatile unsigned* ovw = (volatile unsigned*)(lds + 3 * SHM_V + 3 * SHM_K + NW * 64 * 4);
  const bf16* Vh = qkv + Krow0 * LDR + 2048 + vh * DV;
  for (int s = 0; s < 2; ++s) {
    const int head = 2 * vh + s;
    const bf16* Kh = qkv + Krow0 * LDR + 1024 + head * DQ;
    const bf16* Qh = qkv + Qrow0 * LDR + head * DQ;
    f32x16 o[4]; float l_reg;
    const bool ovf = attn_map<true>(Kh, Vh, Qh, seq, V_lds, K_lds, wsb, o, l_reg);
    if (lane == 0) ovw[wid] = __any(ovf) ? 1u : 0u;
    __syncthreads();
    unsigned anyovf = 0u;
#pragma unroll
    for (int w = 0; w < NW; ++w) anyovf |= ovw[w];
    __syncthreads();
    if (__builtin_amdgcn_readfirstlane(anyovf) != 0u) (void)attn_map<false>(Kh, Vh, Qh, seq, V_lds, K_lds, wsb, o, l_reg);
    if (hi == 0) li_l[r32] = l_reg; asm volatile("s_waitcnt lgkmcnt(0)" ::: "memory");
    float rli[16];
#pragma unroll
    for (int r = 0; r < 16; ++r) rli[r] = __builtin_amdgcn_rcpf(li_l[crow(r, hi)]);
    typedef float f32x4_t __attribute__((ext_vector_type(4)));
    f32x4_t* st4 = (f32x4_t*)stash + (size_t)tid * 16;
    if (s == 0) {
#pragma unroll
      for (int d0 = 0; d0 < 4; ++d0)
#pragma unroll
        for (int r4 = 0; r4 < 4; ++r4) { f32x4_t v; v[0] = o[d0][4 * r4] * rli[4 * r4]; v[1] = o[d0][4 * r4 + 1] * rli[4 * r4 + 1]; v[2] = o[d0][4 * r4 + 2] * rli[4 * r4 + 2]; v[3] = o[d0][4 * r4 + 3] * rli[4 * r4 + 3]; st4[d0 * 4 + r4] = v; }
    } else {
      float ssq[16];
#pragma unroll
      for (int r = 0; r < 16; ++r) ssq[r] = 0.f;
#pragma unroll
      for (int d0 = 0; d0 < 4; ++d0)
#pragma unroll
        for (int r4 = 0; r4 < 4; ++r4) { const f32x4_t sv = st4[d0 * 4 + r4];
#pragma unroll
          for (int i = 0; i < 4; ++i) { const int r = 4 * r4 + i; const float v = sv[i] - lam * (o[d0][r] * rli[r]); o[d0][r] = v; ssq[r] += v * v; } }
#pragma unroll
      for (int r = 0; r < 16; ++r) {
        float a = ssq[r];
        a += sx<1>(a); a += sx<2>(a); a += sx<4>(a); a += sx<8>(a); a += sx<16>(a);
        ssq[r] = oscale / sqrtf(a * (1.0f / 128.0f) + 1e-6f);
      }
      float g[4];
#pragma unroll
      for (int d0 = 0; d0 < 4; ++d0) g[d0] = subln[d0 * 32 + r32];
      bf16* stg = (bf16*)(lds + SHM_ATTN) + wid * (QBLK * DV);
      unsigned so = (unsigned)((4 * hi) * DV + r32); asm volatile("" : "+v"(so));
#pragma unroll
      for (int r = 0; r < 16; ++r) {
#pragma unroll
        for (int d0 = 0; d0 < 4; ++d0) { const unsigned w = cvtpk(o[d0][r] * ssq[r] * g[d0], 0.f); (stg + ((r & 3) + 8 * (r >> 2)) * DV + d0 * 32)[so] = (bf16)(w & 0xffffu); } }
      asm volatile("s_waitcnt lgkmcnt(0)" ::: "memory");
      int ldo_ = ldo; asm volatile("" : "+s"(ldo_));
      bf16* Ow = Ob + (long)(wid * QBLK) * ldo_;
      const int srow = lane >> 4, sch = lane & 15;
#pragma unroll
      for (int i = 0; i < 8; ++i) { const int row = i * 4 + srow; const u32x4 v = *(const u32x4*)(stg + row * DV + sch * 8); *(u32x4*)(Ow + (long)row * ldo_ + sch * 8) = v; }
    }
  }
}
#undef SBAR
}
#define GAS __attribute__((address_space(1)))
#define LAS __attribute__((address_space(3)))
typedef unsigned short bf16;
typedef unsigned v4u __attribute__((ext_vector_type(4)));
typedef float f32x4 __attribute__((ext_vector_type(4)));
typedef short bf16x8 __attribute__((ext_vector_type(8)));
typedef GAS unsigned gu32;
typedef GAS unsigned long long gu64;
#define RLX_AGENT __ATOMIC_RELAXED, __HIP_MEMORY_SCOPE_AGENT
#define LDS_WAIT() asm volatile("s_waitcnt lgkmcnt(0)" ::: "memory")
#define VM_WAIT() asm volatile("s_waitcnt vmcnt(0)" ::: "memory")
__device__ __forceinline__ unsigned long long rt() { return __builtin_amdgcn_s_memrealtime(); }
__device__ __forceinline__ unsigned f2bf(float f) { unsigned u = __builtin_bit_cast(unsigned, f); return (u + 0x7fffu + ((u >> 16) & 1u)) >> 16; }
__device__ __forceinline__ unsigned pk2(float lo, float hi) { unsigned r; asm("v_cvt_pk_bf16_f32 %0, %1, %2" : "=v"(r) : "v"(lo), "v"(hi)); return r; }

#define XB_TMO      128
#define XB_XCNT(j)  (256  + 64 * (j))
#define XB_XSUB(j)  (1280 + 64 * (j))
#define XB_XGEN(j)  (2304 + 64 * (j))
#define XB_TOP      3328
#define XB_TOPGEN   3392
#define XCD_BAR_WORDS 3456
#define XB_SPIN_CAP (1u << 18)

__device__ __forceinline__ unsigned xb_ld(unsigned* p)              { return __hip_atomic_load(p, __ATOMIC_RELAXED, __HIP_MEMORY_SCOPE_AGENT); }
__device__ __forceinline__ unsigned xb_add(unsigned* p, unsigned v) { return __hip_atomic_fetch_add(p, v, __ATOMIC_RELAXED, __HIP_MEMORY_SCOPE_AGENT); }
__device__ __forceinline__ unsigned xb_xcc_id() { return (unsigned)__builtin_amdgcn_s_getreg((3 << 11) | 20) & 0xFu; }
#define XB_SPIN(cond, bar) do { unsigned _sp = 0; while (cond) { __builtin_amdgcn_s_sleep(1); \
    if ((++_sp & 255u) == 0u) { if (xb_ld(&(bar)[XB_TMO])) break; if (_sp > XB_SPIN_CAP) { atomicAdd(&(bar)[XB_TMO], 1u); break; } } } } while (0)

struct XcdBarrier {
    unsigned* bar; unsigned x;
    volatile LAS unsigned* st;
};

__device__ __forceinline__ XcdBarrier xcd_barrier_post(unsigned* bar, volatile LAS unsigned* st) {
    XcdBarrier b; b.bar = bar; b.x = xb_xcc_id(); b.st = st;
    if (threadIdx.x == 0) (void)xb_add(&bar[XB_XCNT(b.x)], 1u);
    return b;
}
__device__ __forceinline__ void xcd_barrier_complete(unsigned* bar, unsigned x, unsigned& nloc, unsigned& nx) {
    const unsigned G = gridDim.x * gridDim.y * gridDim.z;
    unsigned sum, cnt, mine, sp = 0u;
    for (;;) {
        sum = 0u; cnt = 0u; mine = 0u;
#pragma unroll
        for (unsigned j = 0; j < 16; ++j) { const unsigned c = xb_ld(&bar[XB_XCNT(j)]); sum += c; cnt += (c > 0u) ? 1u : 0u; mine = (j == x) ? c : mine; }
        if (sum == G) break;
        __builtin_amdgcn_s_sleep(1);
        if ((++sp & 255u) == 0u) { if (xb_ld(&bar[XB_TMO])) break; if (sp > XB_SPIN_CAP) { atomicAdd(&bar[XB_TMO], 1u); break; } }
    }
    nloc = mine > 0u ? mine : 1u; nx = cnt > 0u ? cnt : 1u;
}

__device__ __forceinline__ void xcd_barrier(const XcdBarrier& b) {
    asm volatile("s_waitcnt vmcnt(0)" ::: "memory");
    __syncthreads();
    if (threadIdx.x == 0) {
        unsigned* bar = b.bar;
        __builtin_amdgcn_s_waitcnt(0);
        unsigned nloc = b.st[0], nx = b.st[1];
        if (nloc == 0u) { xcd_barrier_complete(bar, b.x, nloc, nx); b.st[0] = nloc; b.st[1] = nx; }
        const unsigned old = xb_add(&bar[XB_XSUB(b.x)], 1u);
        const unsigned gen = old / nloc;
        if (old + 1u == (gen + 1u) * nloc) {
            __builtin_amdgcn_fence(__ATOMIC_RELEASE, "agent");
            asm volatile("s_waitcnt vmcnt(0)" ::: "memory");
            const unsigned og = xb_add(&bar[XB_TOP], 1u);
            const unsigned tg = og / nx;
            if (og + 1u == (tg + 1u) * nx) xb_add(&bar[XB_TOPGEN], 1u);
            else XB_SPIN(xb_ld(&bar[XB_TOPGEN]) == tg, bar);
            __builtin_amdgcn_fence(__ATOMIC_ACQUIRE, "agent");
            xb_add(&bar[XB_XGEN(b.x)], 1u);
            asm volatile("s_waitcnt vmcnt(0)" ::: "memory");
        } else {
            XB_SPIN(xb_ld(&bar[XB_XGEN(b.x)]) == gen, bar);
            __builtin_amdgcn_fence(__ATOMIC_ACQUIRE, "agent");
            asm volatile("s_waitcnt vmcnt(0)" ::: "memory");
        }
    }
    __syncthreads();
}
#define HYD __device__ __forceinline__
#define HYDM __device__ __forceinline__
#define HY_DEVICE 1
#ifdef HY_DEVICE
#define HY_OPAQUE(x) asm volatile("" : "+v"(x))
#else
#define HY_OPAQUE(x) (void)(x)
#endif
typedef float cf __attribute__((ext_vector_type(2)));
typedef float cf2 __attribute__((ext_vector_type(4)));
template <class P> struct HyP2 {};
template <> struct HyP2<cf*> { typedef cf2* type; };
#ifdef HY_DEVICE
template <> struct HyP2<__attribute__((address_space(3))) cf*> { typedef __attribute__((address_space(3))) cf2* type; };
#endif
HYD cf cf_add(cf a, cf b) { return a + b; }
HYD cf cf_sub(cf a, cf b) { return a - b; }
HYD cf cf_mul(cf a, cf b) { return cf{a.x * b.x - a.y * b.y, a.x * b.y + a.y * b.x}; }
HYD cf cf_mulc(cf a, cf b) { return cf{a.x * b.x + a.y * b.y, a.y * b.x - a.x * b.y}; }
constexpr int FN = 16384, FT = 512, FLOG = 14, FNP = FN + 4 * (FN >> 6);
constexpr int SEQL = 8192;
HYD int HP(int i) { return i + ((i >> 6) << 2); }
#define HY_C1 0.92387953251128674f
#define HY_S1 0.38268343236508977f
#define HY_R2 0.70710678118654752f
template <int M16> HYD cf mul_root16(cf w) {
    if (M16 == 0) return w;
    if (M16 == 4) return cf{w.y, -w.x};
    if (M16 == 2) return cf{(w.x + w.y) * HY_R2, (w.y - w.x) * HY_R2};
    if (M16 == 6) return cf{(w.y - w.x) * HY_R2, -(w.x + w.y) * HY_R2};
    if (M16 == 1) return cf_mul(w, cf{HY_C1, -HY_S1});
    if (M16 == 3) return cf_mul(w, cf{HY_S1, -HY_C1});
    if (M16 == 5) return cf_mul(w, cf{-HY_S1, -HY_C1});
    return cf_mul(w, cf{-HY_C1, -HY_S1});
}
template <int Q, int U, bool INV, bool ZUP, bool HLO> struct HyStage {
    static HYDM void run(cf (&e)[1 << Q], const cf (&tw)[Q]) {
        constexpr int R = 1 << Q, half = R >> (U + 1);
#pragma unroll
        for (int k = 0; k < R; ++k) {
            if ((k & half) == 0) {
                const int kp = k & (half - 1);
                cf w = tw[U];
                switch (kp * 16 / (2 * half)) {
                    case 0: break;
                    case 1: w = mul_root16<1>(w); break;
                    case 2: w = mul_root16<2>(w); break;
                    case 3: w = mul_root16<3>(w); break;
                    case 4: w = mul_root16<4>(w); break;
                    case 5: w = mul_root16<5>(w); break;
                    case 6: w = mul_root16<6>(w); break;
                    default: w = mul_root16<7>(w); break;
                }
                if (!INV) {
                    if (ZUP && U == 0) { e[k + half] = cf_mul(e[k], w); }
                    else { const cf a = e[k], b = e[k + half]; e[k] = cf_add(a, b); e[k + half] = cf_mul(cf_sub(a, b), w); }
                } else {
                    const cf a = e[k], b = cf_mulc(e[k + half], w); e[k] = cf_add(a, b);
                    if (!(HLO && U == 0)) e[k + half] = cf_sub(a, b);
                }
            }
        }
    }
};
template <int Q, bool INV, bool ZUP, bool HLO> HYD void hy_bfly(cf (&e)[1 << Q], cf t) {
    cf tw[Q]; tw[0] = t;
#pragma unroll
    for (int u = 1; u < Q; ++u) tw[u] = cf_mul(tw[u - 1], tw[u - 1]);
    if (Q == 4) {
        if (!INV) { HyStage<Q, 0, INV, ZUP, HLO>::run(e, tw); HyStage<Q, 1, INV, ZUP, HLO>::run(e, tw); HyStage<Q, 2 % Q, INV, ZUP, HLO>::run(e, tw); HyStage<Q, 3 % Q, INV, ZUP, HLO>::run(e, tw); }
        else      { HyStage<Q, 3 % Q, INV, ZUP, HLO>::run(e, tw); HyStage<Q, 2 % Q, INV, ZUP, HLO>::run(e, tw); HyStage<Q, 1, INV, ZUP, HLO>::run(e, tw); HyStage<Q, 0, INV, ZUP, HLO>::run(e, tw); }
    } else {
        if (!INV) { HyStage<Q, 0, INV, ZUP, HLO>::run(e, tw); HyStage<Q, 1, INV, ZUP, HLO>::run(e, tw); }
        else      { HyStage<Q, 1, INV, ZUP, HLO>::run(e, tw); HyStage<Q, 0, INV, ZUP, HLO>::run(e, tw); }
    }
}
#ifdef HY_DEVICE
#define HY_MULT(T, X, Y) "v_pk_mul_f32 " T ", " X ", " Y " op_sel:[1,1] op_sel_hi:[1,0]\n\t"
#define HY_FMAP(R, X, Y, T) "v_pk_fma_f32 " R ", " X ", " Y ", " T " op_sel_hi:[0,1,1] neg_lo:[0,0,1]\n\t"
#define HY_FMAC(R, X, Y, T) "v_pk_fma_f32 " R ", " X ", " Y ", " T " op_sel_hi:[0,1,1] neg_hi:[1,0,0]\n\t"
#define HY_ADD(R, A, B) "v_pk_add_f32 " R ", " A ", " B "\n\t"
#define HY_SUB(R, A, B) "v_pk_add_f32 " R ", " A ", " B " neg_lo:[0,1] neg_hi:[0,1]\n\t"
HYD void hy_cmul2(cf& r0, cf x0, cf y0, cf& r1, cf x1, cf y1) { cf t0, t1;
    asm(HY_MULT("%0", "%4", "%5") HY_MULT("%1", "%6", "%7") HY_FMAP("%2", "%4", "%5", "%0") HY_FMAP("%3", "%6", "%7", "%1")
        : "=&v"(t0), "=&v"(t1), "=&v"(r0), "=&v"(r1) : "v"(x0), "v"(y0), "v"(x1), "v"(y1)); }
HYD cf hy_cmul1(cf x, cf y) { cf t, r;
    asm(HY_MULT("%0", "%2", "%3") "s_nop 0\n\t" HY_FMAP("%1", "%2", "%3", "%0") : "=&v"(t), "=&v"(r) : "v"(x), "v"(y)); return r; }
HYD void hy_bf2_fwd(cf& a0, cf& b0, cf w0, cf& a1, cf& b1, cf w1) { cf d0, d1, t0, t1;
    asm(HY_SUB("%4", "%0", "%1") HY_ADD("%0", "%0", "%1") HY_SUB("%5", "%2", "%3") HY_ADD("%2", "%2", "%3")
        HY_MULT("%6", "%4", "%8") HY_MULT("%7", "%5", "%9") HY_FMAP("%1", "%4", "%8", "%6") HY_FMAP("%3", "%5", "%9", "%7")
        : "+v"(a0), "+v"(b0), "+v"(a1), "+v"(b1), "=&v"(d0), "=&v"(d1), "=&v"(t0), "=&v"(t1) : "v"(w0), "v"(w1)); }
HYD void hy_bf2_fwdz(cf a0, cf& b0, cf w0, cf a1, cf& b1, cf w1) { hy_cmul2(b0, a0, w0, b1, a1, w1); }
HYD void hy_bf2_inv(cf& a0, cf& b0, cf w0, cf& a1, cf& b1, cf w1) { cf t0, t1;
    asm(HY_MULT("%4", "%1", "%6") HY_MULT("%5", "%3", "%7") HY_FMAC("%4", "%1", "%6", "%4") HY_FMAC("%5", "%3", "%7", "%5")
        HY_SUB("%1", "%0", "%4") HY_SUB("%3", "%2", "%5") HY_ADD("%0", "%0", "%4") HY_ADD("%2", "%2", "%5")
        : "+v"(a0), "+v"(b0), "+v"(a1), "+v"(b1), "=&v"(t0), "=&v"(t1) : "v"(w0), "v"(w1)); }
HYD void hy_bf2_invl(cf& a0, cf b0, cf w0, cf& a1, cf b1, cf w1) { cf t0, t1;
    asm(HY_MULT("%2", "%4", "%6") HY_MULT("%3", "%5", "%7") HY_FMAC("%2", "%4", "%6", "%2") HY_FMAC("%3", "%5", "%7", "%3")
        HY_ADD("%0", "%0", "%2") HY_ADD("%1", "%1", "%3")
        : "+v"(a0), "+v"(a1), "=&v"(t0), "=&v"(t1) : "v"(b0), "v"(b1), "v"(w0), "v"(w1)); }
HYD cf hy_rot(cf w) { cf r; asm("v_pk_add_f32 %0, %1, 0 op_sel:[1,0] op_sel_hi:[0,0] neg_hi:[1,0]" : "=v"(r) : "v"(w)); return r; }
#else
HYD void hy_cmul2(cf& r0, cf x0, cf y0, cf& r1, cf x1, cf y1) { const cf p0 = cf_mul(x0, y0), p1 = cf_mul(x1, y1); r0 = p0; r1 = p1; }
HYD cf hy_cmul1(cf x, cf y) { return cf_mul(x, y); }
HYD void hy_bf2_fwd(cf& a0, cf& b0, cf w0, cf& a1, cf& b1, cf w1) { const cf d0 = cf_sub(a0, b0), d1 = cf_sub(a1, b1); a0 = cf_add(a0, b0); a1 = cf_add(a1, b1); b0 = cf_mul(d0, w0); b1 = cf_mul(d1, w1); }
HYD void hy_bf2_fwdz(cf a0, cf& b0, cf w0, cf a1, cf& b1, cf w1) { b0 = cf_mul(a0, w0); b1 = cf_mul(a1, w1); }
HYD void hy_bf2_inv(cf& a0, cf& b0, cf w0, cf& a1, cf& b1, cf w1) { const cf p0 = cf_mulc(b0, w0), p1 = cf_mulc(b1, w1); b0 = cf_sub(a0, p0); b1 = cf_sub(a1, p1); a0 = cf_add(a0, p0); a1 = cf_add(a1, p1); }
HYD void hy_bf2_invl(cf& a0, cf b0, cf w0, cf& a1, cf b1, cf w1) { a0 = cf_add(a0, cf_mulc(b0, w0)); a1 = cf_add(a1, cf_mulc(b1, w1)); }
HYD cf hy_rot(cf w) { return cf{w.y, -w.x}; }
#endif
template <int U, bool INV, bool ZUP, bool HLO> HYD void hy_stage16(cf (&e)[16], const cf* W) {
    constexpr int half = 8 >> U;
#pragma unroll
    for (int j = 0; j < 8; j += 2) {
        const int k0 = ((j / half) * 2 * half) + (j % half), k1 = (((j + 1) / half) * 2 * half) + ((j + 1) % half);
        const cf w0 = W[k0 & (half - 1)], w1 = W[k1 & (half - 1)];
        if (!INV) { if (ZUP && U == 0) hy_bf2_fwdz(e[k0], e[k0 + half], w0, e[k1], e[k1 + half], w1); else hy_bf2_fwd(e[k0], e[k0 + half], w0, e[k1], e[k1 + half], w1); }
        else { if (HLO && U == 0) hy_bf2_invl(e[k0], e[k0 + half], w0, e[k1], e[k1 + half], w1); else hy_bf2_inv(e[k0], e[k0 + half], w0, e[k1], e[k1 + half], w1); }
    }
}
template <bool INV, bool ZUP, bool HLO> HYD void hy_bfly16(cf (&e)[16], cf t) {
    cf W0[8], W1[4], W2[2], W3[1], tw1, tw2;
    cf k1 = cf{HY_C1, -HY_S1}, k2 = cf{HY_R2, -HY_R2}, k3 = cf{HY_S1, -HY_C1};
    W0[0] = t;
    hy_cmul2(W0[1], t, k1, W0[3], t, k3);
    hy_cmul2(W0[2], t, k2, tw1, t, t);
    W1[0] = tw1;
    hy_cmul2(W1[1], tw1, k2, tw2, tw1, tw1);
    W2[0] = tw2;
    W3[0] = hy_cmul1(tw2, tw2);
#pragma unroll
    for (int i = 0; i < 4; ++i) W0[4 + i] = hy_rot(W0[i]);
    W1[2] = hy_rot(W1[0]); W1[3] = hy_rot(W1[1]); W2[1] = hy_rot(W2[0]);
    if (!INV) { hy_stage16<0, INV, ZUP, HLO>(e, W0); hy_stage16<1, INV, ZUP, HLO>(e, W1); hy_stage16<2, INV, ZUP, HLO>(e, W2); hy_stage16<3, INV, ZUP, HLO>(e, W3); }
    else      { hy_stage16<3, INV, ZUP, HLO>(e, W3); hy_stage16<2, INV, ZUP, HLO>(e, W2); hy_stage16<1, INV, ZUP, HLO>(e, W1); hy_stage16<0, INV, ZUP, HLO>(e, W0); }
}
template <class PT> HYD cf hy_twid(PT thi, PT tlo, int e) { return hy_cmul1(thi[e >> 7], tlo[e & 127]); }
template <int S, bool INV, bool ZUP, bool HLO, class P, class PT>
HYD void hy_pass16(P X, PT thi, PT tlo, int tid) {
    constexpr int R = 16;
    constexpr int SP = (S >= 64) ? S + S / 16 : S;
    const int g0 = tid, g1 = tid + FT;
    const int lo0 = g0 & (S - 1), pb0 = HP((g0 / S) * S * R + lo0);
    const int lo1 = g1 & (S - 1), pb1 = HP((g1 / S) * S * R + lo1);
    cf e0[R], e1[R];
#pragma unroll
    for (int k = 0; k < R; ++k) { if (ZUP && k >= 8) e0[k] = cf{0.f, 0.f}; else e0[k] = X[pb0 + k * SP]; }
#pragma unroll
    for (int k = 0; k < R; ++k) { if (ZUP && k >= 8) e1[k] = cf{0.f, 0.f}; else e1[k] = X[pb1 + k * SP]; }
    const cf t0 = hy_twid(thi, tlo, lo0 * (FN / (R * S))), t1 = hy_twid(thi, tlo, lo1 * (FN / (R * S)));
    hy_bfly16<INV, ZUP, HLO>(e0, t0);
#pragma unroll
    for (int k = 0; k < R; ++k) { if (!(HLO && k >= 8)) X[pb0 + k * SP] = e0[k]; }
    hy_bfly16<INV, ZUP, HLO>(e1, t1);
#pragma unroll
    for (int k = 0; k < R; ++k) { if (!(HLO && k >= 8)) X[pb1 + k * SP] = e1[k]; }
}
typedef _Float16 hy_h2 __attribute__((ext_vector_type(2)));
HYD unsigned hy_pack_h2(float re, float im) { const hy_h2 v = {(_Float16)re, (_Float16)im}; return __builtin_bit_cast(unsigned, v); }
HYD cf hy_unpack_h2(unsigned u, float s) { const hy_h2 v = __builtin_bit_cast(hy_h2, u); return cf{(float)v.x * s, (float)v.y * s}; }
typedef unsigned hy_u4 __attribute__((ext_vector_type(4)));
template <bool INV> HYD void hy_r4(cf (&e)[4]) {
    if (!INV) {
        const cf a0 = e[0] + e[2], b0 = e[0] - e[2], a1 = e[1] + e[3], d = e[1] - e[3], b1 = cf{d.y, -d.x};
        e[0] = a0 + a1; e[1] = a0 - a1; e[2] = b0 + b1; e[3] = b0 - b1;
    } else {
        const cf a0 = e[0] + e[1], a1 = e[0] - e[1], a2 = e[2] + e[3], d = e[2] - e[3], b = cf{-d.y, d.x};
        e[0] = a0 + a2; e[2] = a0 - a2; e[1] = a1 + b; e[3] = a1 - b;
    }
}
template <bool INV, class P, class PK>
HYD void hy_pass4(P X, int tid, PK KM) {
    typedef typename HyP2<P>::type P2;
    const int w = tid >> 6, lane = tid & 63;
#pragma unroll 1
    for (int gb = 0; gb < 2; ++gb) {
        cf2 a[4], b[4]; hy_u4 kq[4];
        const int g0 = (gb * 8 + w) * 256 + lane;
#pragma unroll
        for (int u = 0; u < 4; ++u) { const int g = g0 + 64 * u; P2 X2 = (P2)(X + HP(4 * g)); a[u] = X2[0]; b[u] = X2[1];
            if (KM) { const unsigned gi = (unsigned)(4 * g) & 0x3fffu; kq[u] = *(const hy_u4*)(KM + gi); } }
#pragma unroll
        for (int u = 0; u < 4; ++u) { const int g = g0 + 64 * u; P2 X2 = (P2)(X + HP(4 * g));
            cf e[4] = {cf{a[u].x, a[u].y}, cf{a[u].z, a[u].w}, cf{b[u].x, b[u].y}, cf{b[u].z, b[u].w}};
            hy_r4<INV>(e);
            if (KM) { const float ks = 1.0f / (float)FN; cf q0, q1, q2, q3; hy_cmul2(q0, e[0], hy_unpack_h2(kq[u].x, ks), q1, e[1], hy_unpack_h2(kq[u].y, ks)); hy_cmul2(q2, e[2], hy_unpack_h2(kq[u].z, ks), q3, e[3], hy_unpack_h2(kq[u].w, ks)); e[0] = q0; e[1] = q1; e[2] = q2; e[3] = q3; }
            X2[0] = cf2{e[0].x, e[0].y, e[1].x, e[1].y}; X2[1] = cf2{e[2].x, e[2].y, e[3].x, e[3].y}; }
    }
}
HYD int hy_brev14(int p) {
    unsigned v = (unsigned)p;
    v = ((v >> 1) & 0x55555555u) | ((v & 0x55555555u) << 1);
    v = ((v >> 2) & 0x33333333u) | ((v & 0x33333333u) << 2);
    v = ((v >> 4) & 0x0F0F0F0Fu) | ((v & 0x0F0F0F0Fu) << 4);
    v = ((v >> 8) & 0x00FF00FFu) | ((v & 0x00FF00FFu) << 8);
    v = (v >> 16) | (v << 16);
    return (int)(v >> (32 - FLOG));
}
HYD float hy_bf2f(unsigned short b) { unsigned u = (unsigned)b << 16; float f; __builtin_memcpy(&f, &u, 4); return f; }
HYD unsigned hy_f2bf(float f) { unsigned u; __builtin_memcpy(&u, &f, 4); return (u + 0x7fffu + ((u >> 16) & 1u)) >> 16; }
template <class PR> HYD void hy_sconv2(PR rowj  , unsigned tid, int j, float w0, float w1, float w2, float b, float& u0, float& u1) {
    const unsigned d1 = rowj[tid];
    const unsigned d0r = (rowj - 1)[tid], d2r = (rowj + 1)[tid];
    const unsigned d0 = (j > 0 || tid > 0) ? d0r : 0u;
    const unsigned d2 = (j < 7 || tid < (unsigned)(FT - 1)) ? d2r : 0u;
    const float pm1 = hy_bf2f((unsigned short)(d0 >> 16)), p0 = hy_bf2f((unsigned short)(d1 & 0xffffu)), p1 = hy_bf2f((unsigned short)(d1 >> 16)), p2 = hy_bf2f((unsigned short)(d2 & 0xffffu));
    u0 = b + w0 * pm1 + w1 * p0 + w2 * p1;
    u1 = b + w0 * p0 + w1 * p1 + w2 * p2;
}
template <class P> HYD void hy_filter_step(P X, const unsigned short* taps, float delta, int tid) {
    typedef typename HyP2<P>::type P2;
    typedef unsigned u32x2h __attribute__((ext_vector_type(2)));
    u32x2h raw[SEQL / (4 * FT)][4];
    const float dscale = -delta * (1.4426950408889634f / (float)(SEQL - 1)); (void)dscale;
#pragma unroll
    for (int j = 0; j < SEQL / (4 * FT); ++j)
#pragma unroll
        for (int q = 0; q < 4; ++q) raw[j][q] = __builtin_nontemporal_load((const u32x2h*)(taps + (size_t)q * 1024 * SEQL + ((unsigned)(4 * (tid + FT * j)) & 0x1fffu)));
#pragma unroll
    for (int j = 0; j < SEQL / (4 * FT); ++j) {
        const int t = 4 * (tid + FT * j);
        cf2 a[4];
#pragma unroll
        for (int q = 0; q < 4; ++q) a[q] = cf2{hy_bf2f((unsigned short)(raw[j][q].x & 0xffffu)), hy_bf2f((unsigned short)(raw[j][q].x >> 16)), hy_bf2f((unsigned short)(raw[j][q].y & 0xffffu)), hy_bf2f((unsigned short)(raw[j][q].y >> 16))};
        cf2 dec;
#pragma unroll
#ifdef HY_DEVICE
        for (int e = 0; e < 4; ++e) dec[e] = __builtin_amdgcn_exp2f((float)(t + e) * dscale);
#else
        for (int e = 0; e < 4; ++e) dec[e] = expf(-((float)(t + e) * (1.0f / (float)(SEQL - 1))) * delta);
#endif
        const cf2 a0 = a[0] * dec, a1 = a[1] * dec, a2 = a[2] * dec, a3 = a[3] * dec;
        P2 Xf = (P2)(X + HP(t));
        if (t == 0) { Xf[0] = cf2{a0[0] + a1[0], a2[0] + a3[0], a0[1], a2[1]}; float z0 = 0.f; HY_OPAQUE(z0); X[HP(SEQL)] = cf{z0, z0}; }
        else Xf[0] = cf2{a0[0], a2[0], a0[1], a2[1]};
        Xf[1] = cf2{a0[2], a2[2], a0[3], a2[3]};
        const int pbk = HP(FN - t - 4);
        X[pbk + 1] = cf{a1[3], a3[3]}; X[pbk + 2] = cf{a1[2], a3[2]}; X[pbk + 3] = cf{a1[1], a3[1]};
        if (t > 0) X[HP(FN - t)] = cf{a1[0], a3[0]};
    }
}
template <class P> HYD void hy_sep_step(P X, unsigned* K1g, unsigned* K2g, int tid) {
    const float sc = 0.5f;
#pragma unroll 1
    for (int j0 = 0; j0 < FN / FT; j0 += 4) {
        cf a[4], b[4];
#pragma unroll
        for (int u = 0; u < 4; ++u) { const int p = tid + FT * (j0 + u);
            const int f = hy_brev14(p), q = hy_brev14((FN - f) & (FN - 1));
            a[u] = X[HP(p)]; b[u] = X[HP(q)]; }
#pragma unroll
        for (int u = 0; u < 4; ++u) { const int p = tid + FT * (j0 + u);
            const unsigned pi = (unsigned)p & 0x3fffu;
            K1g[pi] = hy_pack_h2((a[u].x + b[u].x) * sc, (a[u].y - b[u].y) * sc);
            K2g[pi] = hy_pack_h2((a[u].y + b[u].y) * sc, -(a[u].x - b[u].x) * sc); }
    }
}
template <class P> HYD void hy_load_step(P X, const unsigned* r0, const unsigned* r1, float w0, float w1, float w2, float b, float (&zr)[8][4], int tid) {
    typedef typename HyP2<P>::type P2;
#pragma unroll
    for (int j = 0; j < 8; ++j) {
        const int t = 2 * (tid + FT * j);
        hy_sconv2(r0 + FT * j, (unsigned)tid, j, w0, w1, w2, b, zr[j][0], zr[j][2]);
        hy_sconv2(r1 + FT * j, (unsigned)tid, j, w0, w1, w2, b, zr[j][1], zr[j][3]);
        *(P2)(X + HP(t)) = cf2{zr[j][0], zr[j][1], zr[j][2], zr[j][3]};
    }
}
template <class P> HYD void hy_gate1_step(P X, const unsigned* r0, const unsigned* r1, float w0, float w1, float w2, float b, float bias, float (&zr)[8][4], int tid) {
    typedef typename HyP2<P>::type P2;
#pragma unroll
    for (int j = 0; j < 8; ++j) {
        const int t = 2 * (tid + FT * j);
        float xa0, xa1, xb0, xb1;
        hy_sconv2(r0 + FT * j, (unsigned)tid, j, w0, w1, w2, b, xa0, xa1);
        hy_sconv2(r1 + FT * j, (unsigned)tid, j, w0, w1, w2, b, xb0, xb1);
        P2 xp = (P2)(X + HP(t));
        const cf2 y = *xp;
        zr[j][0] = xa0 * (y.x + zr[j][0] * bias); zr[j][1] = xb0 * (y.y + zr[j][1] * bias);
        zr[j][2] = xa1 * (y.z + zr[j][2] * bias); zr[j][3] = xb1 * (y.w + zr[j][3] * bias);
        *xp = cf2{zr[j][0], zr[j][1], zr[j][2], zr[j][3]};
    }
}
template <class P> HYD void hy_gate2_step(P X, const unsigned* r0, const unsigned* r1, float w0, float w1, float w2, float b, float bias, const float (&zr)[8][4], unsigned* out0, unsigned* out1, int tid) {
    typedef typename HyP2<P>::type P2;
#pragma unroll
    for (int j = 0; j < 8; ++j) {
        const int t = 2 * (tid + FT * j);
        float xa0, xa1, xb0, xb1;
        hy_sconv2(r0 + FT * j, (unsigned)tid, j, w0, w1, w2, b, xa0, xa1);
        hy_sconv2(r1 + FT * j, (unsigned)tid, j, w0, w1, w2, b, xb0, xb1);
        const cf2 y = *(P2)(X + HP(t));
        const float za0 = xa0 * (y.x + zr[j][0] * bias), zb0 = xb0 * (y.y + zr[j][1] * bias);
        const float za1 = xa1 * (y.z + zr[j][2] * bias), zb1 = xb1 * (y.w + zr[j][3] * bias);
        (out0 + FT * j)[(unsigned)tid] = hy_f2bf(za0) | (hy_f2bf(za1) << 16);
        (out1 + FT * j)[(unsigned)tid] = hy_f2bf(zb0) | (hy_f2bf(zb1) << 16);
    }
}
HYD float hy_sconv1(unsigned D0, unsigned D1, int t, float w0, float w1, float w2, float b, bool pad0, bool padL) {
    const unsigned sh = ((unsigned)(t - 1) & 1u) << 4;
#ifdef HY_DEVICE
    const unsigned lo = __builtin_amdgcn_alignbit(D1, D0, sh), hi = D1 >> sh;
#else
    const unsigned long long w = (((unsigned long long)D1 << 32) | D0) >> sh; const unsigned lo = (unsigned)w, hi = (unsigned)(w >> 32);
#endif
    float e0 = hy_bf2f((unsigned short)(lo & 0xffffu)), e1 = hy_bf2f((unsigned short)(lo >> 16)), e2 = hy_bf2f((unsigned short)(hi & 0xffffu));
    if (pad0 && t == 0) e0 = 0.f;
    if (padL && t == SEQL - 1) e2 = 0.f;
    return b + w0 * e0 + w1 * e1 + w2 * e2;
}
struct HyRaw { unsigned d[2][8][4]; };
HYD void hy_raw_load(HyRaw& R, const unsigned* r0, const unsigned* r1, int tid) {
#pragma unroll
    for (int r = 0; r < 2; ++r)
#pragma unroll
        for (int k = 0; k < 8; ++k) { const unsigned du = ((unsigned)(tid + FT * r + 1024 * k + 1) >> 1) & 0x1fffu;
            R.d[r][k][0] = __builtin_nontemporal_load(r0 - 1 + du); R.d[r][k][1] = __builtin_nontemporal_load(r0 + du); R.d[r][k][2] = __builtin_nontemporal_load(r1 - 1 + du); R.d[r][k][3] = __builtin_nontemporal_load(r1 + du); }
}
template <class P, class PT> HYD void hy_convA_fwd(P X, PT thi, PT tlo, int tid, const HyRaw& R, float w0, float w1, float w2, float b, cf (&zr)[2][8]) {
#pragma unroll
    for (int r = 0; r < 2; ++r) {
        const int i0 = tid + FT * r, pb = HP(i0);
        cf e[16];
#pragma unroll
        for (int k = 0; k < 8; ++k) { const int t = i0 + 1024 * k; const bool p0 = (r == 0 && k == 0), pL = (r == 1 && k == 7); e[k] = cf{hy_sconv1(R.d[r][k][0], R.d[r][k][1], t, w0, w1, w2, b, p0, pL), hy_sconv1(R.d[r][k][2], R.d[r][k][3], t, w0, w1, w2, b, p0, pL)}; zr[r][k] = e[k]; }
#pragma unroll
        for (int k = 8; k < 16; ++k) e[k] = cf{0.f, 0.f};
        hy_bfly16<false, true, false>(e, hy_twid(thi, tlo, i0));
#pragma unroll
        for (int k = 0; k < 16; ++k) X[pb + k * 1088] = e[k];
    }
}
template <bool LAST, class P, class PT> HYD void hy_gateA(P X, PT thi, PT tlo, int tid, const HyRaw& R, float w0, float w1, float w2, float b, float bias,
                                                           cf (&zr)[2][8], unsigned short* out0, unsigned short* out1) {
#pragma unroll
    for (int r = 0; r < 2; ++r) {
        const int i0 = tid + FT * r, pb = HP(i0);
        cf e[16];
#pragma unroll
        for (int k = 0; k < 16; ++k) e[k] = X[pb + k * 1088];
        const cf tw = hy_twid(thi, tlo, i0);
        hy_bfly16<true, false, true>(e, tw);
#pragma unroll
        for (int k = 0; k < 8; ++k) { const int t = i0 + 1024 * k;
            const bool p0 = (r == 0 && k == 0), pL = (r == 1 && k == 7);
            const float xa = hy_sconv1(R.d[r][k][0], R.d[r][k][1], t, w0, w1, w2, b, p0, pL), xb = hy_sconv1(R.d[r][k][2], R.d[r][k][3], t, w0, w1, w2, b, p0, pL);
            const cf z = cf{xa * (e[k].x + zr[r][k].x * bias), xb * (e[k].y + zr[r][k].y * bias)};
            if (LAST) {
#ifdef HY_DEVICE
                unsigned pk; asm("v_cvt_pk_bf16_f32 %0, %1, %2" : "=v"(pk) : "v"(z.x), "v"(z.y)); const unsigned ti = (unsigned)t & 0x1fffu; out0[ti] = (unsigned short)(pk & 0xffffu); out1[ti] = (unsigned short)(pk >> 16);
#else
                out0[t] = (unsigned short)hy_f2bf(z.x); out1[t] = (unsigned short)hy_f2bf(z.y);
#endif
            }
            else { zr[r][k] = z; e[k] = z; } }
        if (!LAST) {
#pragma unroll
            for (int k = 8; k < 16; ++k) e[k] = cf{0.f, 0.f};
            hy_bfly16<false, true, false>(e, tw);
#pragma unroll
            for (int k = 0; k < 16; ++k) X[pb + k * 1088] = e[k];
        }
    }
}
constexpr int NWAVES = 8, NTHR = NWAVES * 64;
constexpr int DM = 2048, SEQ = 8192, DEPTH = 4, NSEQ = 6, GSEQ = 2, NGRP = NSEQ / GSEQ, MG = GSEQ * SEQ;
constexpr int HYW = 1024, HYIN = 3072, QKVW = 3072, DFF = 5632, GU = 2 * DFF, FEMB = 33, FHID = 64;
constexpr float EPS = 1e-6f;
constexpr float QSCALE = 0.125f * 1.4426950408889634f;
constexpr size_t MiB = 1u << 20;
constexpr size_t WS_CTL = 0, CTL_ZERO_BYTES = 1 * MiB;
constexpr size_t SZ_WHY = (size_t)HYIN * DM * 2, SZ_WQKV = (size_t)QKVW * DM * 2, SZ_WOUT = (size_t)DM * DM * 2, SZ_WGU = (size_t)GU * DM * 2, SZ_WDN = (size_t)DM * DFF * 2;
constexpr size_t OFF_WHY = 0, OFF_WQKV = OFF_WHY + SZ_WHY, OFF_WOUT = OFF_WQKV + SZ_WQKV, OFF_WGU = OFF_WOUT + SZ_WOUT, OFF_WDN = OFF_WGU + SZ_WGU, SZ_WLAYER = OFF_WDN + SZ_WDN;
constexpr size_t WS_W = 1 * MiB;
constexpr size_t WS_ROPE = WS_W + DEPTH * SZ_WLAYER;
constexpr int KPAD = 256;
constexpr size_t WS_H3 = WS_ROPE + (size_t)SEQ * 32 * 8;
constexpr size_t WS_W4T = WS_H3 + (size_t)DEPTH * SEQ * KPAD * 2;
constexpr size_t WS_TAPS = WS_W4T + (size_t)DEPTH * 4096 * KPAD * 2;
constexpr size_t WS_FFTK = WS_TAPS + (size_t)4096 * SEQ * 2;
constexpr size_t WS_STASH = WS_FFTK + (size_t)256 * 2 * 16384 * 8;
constexpr size_t WS_XB = WS_STASH;
constexpr size_t WS_H = WS_XB + (size_t)MG * DM * 2;
constexpr size_t WS_ZT = WS_H + (size_t)MG * DM * 2;
constexpr size_t WS_PROJT = WS_ZT + (size_t)HYW * MG * 2;
constexpr size_t WS_QKV = WS_PROJT + (size_t)HYIN * MG * 2;
constexpr size_t WS_MIX = WS_PROJT;
constexpr size_t WS_FFH = WS_PROJT;
constexpr size_t WS_MIXIN = WS_QKV + (size_t)MG * QKVW * 2;
constexpr size_t WS_END = WS_MIXIN + (size_t)MG * DM * 2;
constexpr size_t SZ_TAPS = (size_t)4096 * SEQ * 2, WS_TAPS_X = WS_END, WS_END_X = WS_TAPS_X + (DEPTH - 1) * SZ_TAPS;
static_assert((size_t)MG * DFF * 2 <= (size_t)HYIN * MG * 2 + (size_t)MG * QKVW * 2, "FFH overlay fits PROJT|QKV");
static_assert(WS_W4T % 256 == 0 && WS_TAPS % 256 == 0 && WS_ROPE % 256 == 0 && WS_H3 % 256 == 0 && WS_FFTK % 256 == 0 && WS_XB % 256 == 0 && WS_H % 256 == 0 && SZ_WLAYER % 256 == 0, "alignment");
constexpr int CW_BAR = 4096;
constexpr int PH_PER_LAYER = 8, PH_PER_GROUP = 1 + DEPTH * PH_PER_LAYER, NPHASE = 1 + NGRP * PH_PER_GROUP;
constexpr int RING_OFF = 0, RING_BYTES = 131072;
constexpr int TAB_OFF = 139264;
constexpr int MISC_OFF = TAB_OFF + 4096;
constexpr int LDS_BYTES = 147456;
static_assert(MISC_OFF + 128 <= LDS_BYTES, "LDS map");
static_assert(att::SHM_ATTN_ALL <= MISC_OFF, "attention LDS fits below the control words");
#ifndef PROBE_DUP
#define PROBE_DUP 0
#endif
#ifndef MK_PER_PHASE
#define MK_PER_PHASE 0
#endif

struct Args { const float* in[30]; float* out; unsigned char* ws; int ph_lo, ph_hi, taps_all, pad; };
enum { I_XP = 0, I_XS, I_GMPRE, I_GMPOST, I_GFPRE, I_GFPOST, I_WIN, I_CONVW, I_CONVB, I_FW1, I_FB1, I_FF1, I_FW2, I_FB2, I_FF2, I_FW3, I_FB3, I_FF3, I_FW4,
       I_HBIAS, I_HNORM, I_LQ1, I_LK1, I_LQ2, I_LK2, I_SUBLN, I_WOUT, I_WGATE, I_WUP, I_WDOWN };

template <int K> __device__ __forceinline__ float swz_xor(float v) { return __builtin_bit_cast(float, __builtin_amdgcn_ds_swizzle(__builtin_bit_cast(int, v), (K << 10) | 0x1f)); }
__device__ __forceinline__ float wave_sum(float v) {
    v += swz_xor<1>(v); v += swz_xor<2>(v); v += swz_xor<4>(v); v += swz_xor<8>(v); v += swz_xor<16>(v);
    auto rr = __builtin_amdgcn_permlane32_swap(__float_as_uint(v), __float_as_uint(v), false, false);
    return __uint_as_float(rr[0]) + __uint_as_float(rr[1]);
}
__device__ __forceinline__ bf16* wt_dst_row(int kind, int n, bf16* d0, bf16* d1, int K) {
    if (kind == 0) return d0 + (size_t)n * K;
    if (kind == 1) { if (n < HYIN) return d0 + (size_t)n * K; int q = n - HYIN; if (q < 2048) { const int hb = q & ~63, i = q & 63; q = hb + (i < 32 ? 2 * i : 2 * (i - 32) + 1); } return d1 + (size_t)q * K; }
    if (kind == 4) return d0 + (size_t)n * KPAD;
    const int r = (n >> 7) * 256 + (n & 127) + (kind == 3 ? 128 : 0); return d0 + (size_t)r * K;
}
__device__ __forceinline__ void p0_transpose_item(const float* W, int K, int N, int kind, bf16* d0, bf16* d1, LAS float* scr, int item, int lane) {
    const int nblk = N / 32, kb = item / nblk, nb = item % nblk, k0 = 64 * kb, n0 = 32 * nb;
#pragma unroll 8
    for (int i = 0; i < 32; ++i) { const int kk = 2 * i + (lane >> 5); scr[kk * 33 + (lane & 31)] = __builtin_nontemporal_load(W + (size_t)(k0 + kk) * N + n0 + (lane & 31)); }
    LDS_WAIT(); asm volatile("" ::: "memory");
    const int c = lane & 7;
#pragma unroll
    for (int j = 0; j < 4; ++j) { const int n = (lane >> 3) + 8 * j; const LAS float* s = scr + (8 * c) * 33 + n;
        v4u o; o.x = pk2(s[0 * 33], s[1 * 33]); o.y = pk2(s[2 * 33], s[3 * 33]); o.z = pk2(s[4 * 33], s[5 * 33]); o.w = pk2(s[6 * 33], s[7 * 33]);
        *(GAS v4u*)(wt_dst_row(kind, n0 + n, d0, d1, K) + k0 + 8 * c) = o; }
    LDS_WAIT(); asm volatile("" ::: "memory");
}
__device__ __forceinline__ void sincos_red(double ang, float& s, float& c) {
    const double k = rint(ang * 0.15915494309189535); const float r = (float)(ang - k * 6.283185307179586);
    s = sinf(r); c = cosf(r);
}
#define GP(p) ((const float*)(const GAS float*)(p))
#define LAUNDER_TID(F) do { int t_ = (F).tid; asm volatile("" : "+v"(t_)); (F).tid = t_; (F).lane = t_ & 63; int z_ = 0; asm volatile("" : "+s"(z_)); (F).z = z_; unsigned long long w_ = (unsigned long long)(F).ws0; asm volatile("" : "+s"(w_)); (F).ws = (unsigned char*)(GAS unsigned char*)w_; int b_ = (F).bx0, v_ = (F).vcu0, g_ = (F).G0; asm volatile("" : "+s"(b_), "+s"(v_), "+s"(g_)); (F).bx = b_; (F).vcu = v_; (F).G = g_; } while (0)
struct Frame {
    LAS unsigned char* lds; volatile LAS unsigned* MISC; gu32* ctl;
    int tid, lane, wave, vcu, G, bx;
    int vcu0, G0, bx0;
    float* out; unsigned char* ws; unsigned char* ws0; int z;
};
__device__ __forceinline__ void p0_prologue(Frame& F, const Args& A) {
    LAS float* scr = (LAS float*)(F.lds + RING_OFF + F.wave * 16384);
    const int gw = F.vcu * NWAVES + F.wave, NGW = F.G * NWAVES;
    constexpr int I_IN = (DM / 64) * ((HYIN + QKVW) / 32), I_OUT = (DM / 64) * (DM / 32), I_G = (DM / 64) * (DFF / 32), I_D = (DFF / 64) * (DM / 32);
    constexpr int I_W4 = 4096 / 32;
    constexpr int PER_L = I_IN + I_OUT + 2 * I_G + I_D + I_W4;
    for (int it = gw; it < DEPTH * PER_L; it += NGW) {
        const int l = it / PER_L; int r = it % PER_L;
        unsigned char* wl = F.ws + WS_W + (size_t)l * SZ_WLAYER;
        if (r < I_IN) { p0_transpose_item(GP(A.in[I_WIN + F.z]) + (size_t)l * DM * (HYIN + QKVW), DM, HYIN + QKVW, 1, (bf16*)(wl + OFF_WHY), (bf16*)(wl + OFF_WQKV), scr, r, F.lane); continue; } r -= I_IN;
        if (r < I_OUT) { p0_transpose_item(GP(A.in[I_WOUT + F.z]) + (size_t)l * DM * DM, DM, DM, 0, (bf16*)(wl + OFF_WOUT), nullptr, scr, r, F.lane); continue; } r -= I_OUT;
        if (r < I_G) { p0_transpose_item(GP(A.in[I_WGATE + F.z]) + (size_t)l * DM * DFF, DM, DFF, 2, (bf16*)(wl + OFF_WGU), nullptr, scr, r, F.lane); continue; } r -= I_G;
        if (r < I_G) { p0_transpose_item(GP(A.in[I_WUP + F.z]) + (size_t)l * DM * DFF, DM, DFF, 3, (bf16*)(wl + OFF_WGU), nullptr, scr, r, F.lane); continue; } r -= I_G;
        if (r < I_D) { p0_transpose_item(GP(A.in[I_WDOWN + F.z]) + (size_t)l * DFF * DM, DFF, DM, 0, (bf16*)(wl + OFF_WDN), nullptr, scr, r, F.lane); continue; } r -= I_D;
        { bf16* w4t = (bf16*)(F.ws + WS_W4T) + (size_t)l * 4096 * KPAD;
          p0_transpose_item(GP(A.in[I_FW4 + F.z]) + (size_t)l * FHID * 4096, FHID, 4096, 4, w4t, nullptr, scr, r, F.lane);
          for (int e = F.lane; e < 32 * 24; e += 64) *(GAS v4u*)(w4t + (size_t)(32 * r + e / 24) * KPAD + 64 + 8 * (e % 24)) = (v4u){0u, 0u, 0u, 0u}; }
    }
    {
        float* cs = (float*)(F.ws + WS_ROPE);
        for (int e = F.vcu * NTHR + F.tid; e < SEQ * 32; e += F.G * NTHR) {
            const int t = e >> 5, p = e & 31;
            const double inv = exp(-9.210340371976184 * (double)(2 * p) / 64.0);
            float s, c; sincos_red((double)t * inv, s, c);
            cs[2 * e] = c; cs[2 * e + 1] = s;
        }
    }
    {
        bf16* h3b = (bf16*)(F.ws + WS_H3);
        LAS float* hb = (LAS float*)(F.lds + RING_OFF + F.wave * 16384);
        for (int task = gw; task < DEPTH * (SEQ / 64); task += NGW) {
            const int l = task / (SEQ / 64), t = (task % (SEQ / 64)) * 64 + F.lane;
            const float* w1 = GP(A.in[I_FW1 + F.z]) + (size_t)l * FEMB * FHID; const float* w2 = GP(A.in[I_FW2 + F.z]) + (size_t)l * FHID * FHID; const float* w3 = GP(A.in[I_FW3 + F.z]) + (size_t)l * FHID * FHID;
            hb[F.lane] = (float)t * (1.0f / (float)(SEQ - 1));
#pragma unroll 1
            for (int bi = 0; bi < 16; ++bi) { const double band = 1e-4 + (double)bi * ((15.0 - 1e-4) / 15.0);
                float s, c; sincos_red(6.283185307179586 * (double)t / (double)SEQ * band, s, c); hb[(1 + bi) * 64 + F.lane] = c; hb[(17 + bi) * 64 + F.lane] = -s; }
#pragma unroll 1
            for (int stage = 0; stage < 3; ++stage) {
                const float* w = stage == 0 ? w1 : (stage == 1 ? w2 : w3);
                const float* bb = (stage == 0 ? GP(A.in[I_FB1 + F.z]) : (stage == 1 ? GP(A.in[I_FB2 + F.z]) : GP(A.in[I_FB3 + F.z]))) + l * FHID;
                const float* ff = (stage == 0 ? GP(A.in[I_FF1 + F.z]) : (stage == 1 ? GP(A.in[I_FF2 + F.z]) : GP(A.in[I_FF3 + F.z]))) + l * FHID;
                const int nin = stage == 0 ? FEMB : FHID;
                typedef float f32x16_t __attribute__((ext_vector_type(16)));
                f32x16_t c0 = {}, c1 = {}, c2 = {}, c3 = {};
                LDS_WAIT();
#pragma unroll 1
                for (int i = 0; i < nin; ++i) { const float hv = hb[i * 64 + F.lane]; const f32x16_t* wr = (const f32x16_t*)(w + i * FHID);
                    c0 += wr[0] * hv; c1 += wr[1] * hv; c2 += wr[2] * hv; c3 += wr[3] * hv; }
                const f32x16_t* b16 = (const f32x16_t*)bb; const f32x16_t* f16 = (const f32x16_t*)ff;
                c0 = (c0 + b16[0]) * f16[0]; c1 = (c1 + b16[1]) * f16[1]; c2 = (c2 + b16[2]) * f16[2]; c3 = (c3 + b16[3]) * f16[3];
                if (stage < 2) {
#pragma unroll
                    for (int e = 0; e < 16; ++e) { hb[e * 64 + F.lane] = sinf(c0[e]); hb[(16 + e) * 64 + F.lane] = sinf(c1[e]); hb[(32 + e) * 64 + F.lane] = sinf(c2[e]); hb[(48 + e) * 64 + F.lane] = sinf(c3[e]); }
                } else {
                    GAS v4u* o = (GAS v4u*)(h3b + ((size_t)l * SEQ + t) * KPAD);
#pragma unroll
                    for (int q = 0; q < 2; ++q) { v4u w; w.x = pk2(sinf(c0[8 * q]), sinf(c0[8 * q + 1])); w.y = pk2(sinf(c0[8 * q + 2]), sinf(c0[8 * q + 3])); w.z = pk2(sinf(c0[8 * q + 4]), sinf(c0[8 * q + 5])); w.w = pk2(sinf(c0[8 * q + 6]), sinf(c0[8 * q + 7])); o[q] = w; }
#pragma unroll
                    for (int q = 0; q < 2; ++q) { v4u w; w.x = pk2(sinf(c1[8 * q]), sinf(c1[8 * q + 1])); w.y = pk2(sinf(c1[8 * q + 2]), sinf(c1[8 * q + 3])); w.z = pk2(sinf(c1[8 * q + 4]), sinf(c1[8 * q + 5])); w.w = pk2(sinf(c1[8 * q + 6]), sinf(c1[8 * q + 7])); o[2 + q] = w; }
#pragma unroll
                    for (int q = 0; q < 2; ++q) { v4u w; w.x = pk2(sinf(c2[8 * q]), sinf(c2[8 * q + 1])); w.y = pk2(sinf(c2[8 * q + 2]), sinf(c2[8 * q + 3])); w.z = pk2(sinf(c2[8 * q + 4]), sinf(c2[8 * q + 5])); w.w = pk2(sinf(c2[8 * q + 6]), sinf(c2[8 * q + 7])); o[4 + q] = w; }
#pragma unroll
                    for (int q = 0; q < 2; ++q) { v4u w; w.x = pk2(sinf(c3[8 * q]), sinf(c3[8 * q + 1])); w.y = pk2(sinf(c3[8 * q + 2]), sinf(c3[8 * q + 3])); w.z = pk2(sinf(c3[8 * q + 4]), sinf(c3[8 * q + 5])); w.w = pk2(sinf(c3[8 * q + 6]), sinf(c3[8 * q + 7])); o[6 + q] = w; }
#pragma unroll 1
                    for (int q = 8; q < 32; ++q) o[q] = (v4u){0u, 0u, 0u, 0u};
                }
            }
        }
    }
}
template <bool XSB>
__device__ __forceinline__ void norm_pass(Frame& F, const void* x_src, const bf16* add, const float* g_add, bf16* xb_dst, float* xf_dst, const float* g_out, bf16* h_dst) {
    const int gw = F.vcu * NWAVES + F.wave, NGW = F.G * NWAVES;
#define UNPK(q, lo, hi) do { lo = (f32x4){__uint_as_float((q).x << 16), __uint_as_float((q).x & 0xffff0000u), __uint_as_float((q).y << 16), __uint_as_float((q).y & 0xffff0000u)}; \
                             hi = (f32x4){__uint_as_float((q).z << 16), __uint_as_float((q).z & 0xffff0000u), __uint_as_float((q).w << 16), __uint_as_float((q).w & 0xffff0000u)}; } while (0)
#define PK8(lo, hi) (v4u){pk2((lo)[0], (lo)[1]), pk2((lo)[2], (lo)[3]), pk2((hi)[0], (hi)[1]), pk2((hi)[2], (hi)[3])}
    f32x4 gA[8], gO[8];
#pragma unroll
    for (int j = 0; j < 8; ++j) { gA[j] = (f32x4){0.f, 0.f, 0.f, 0.f}; gO[j] = (f32x4){0.f, 0.f, 0.f, 0.f}; }
    if (add) { const GAS f32x4* gr = (const GAS f32x4*)g_add + 2 * F.lane;
#pragma unroll
        for (int j = 0; j < 4; ++j) { gA[2 * j] = gr[128 * j]; gA[2 * j + 1] = gr[128 * j + 1]; } }
    if (h_dst) { const GAS f32x4* gr = (const GAS f32x4*)g_out + 2 * F.lane;
#pragma unroll
        for (int j = 0; j < 4; ++j) { gO[2 * j] = gr[128 * j]; gO[2 * j + 1] = gr[128 * j + 1]; } }
    v4u rq[4], rw[4]; f32x4 rf[8];
#pragma unroll
    for (int j = 0; j < 4; ++j) { rq[j] = (v4u){0u, 0u, 0u, 0u}; rw[j] = (v4u){0u, 0u, 0u, 0u}; }
#define NP_FETCH(m) do { \
        if (XSB) { const GAS v4u* xa_ = (const GAS v4u*)((const bf16*)x_src + (size_t)(m) * DM) + F.lane; _Pragma("unroll") for (int j = 0; j < 4; ++j) rq[j] = __builtin_nontemporal_load(xa_ + 64 * j); } \
        else { const GAS f32x4* xa_ = (const GAS f32x4*)((const float*)x_src + (size_t)(m) * DM) + 2 * F.lane; _Pragma("unroll") for (int j = 0; j < 4; ++j) { rf[2 * j] = __builtin_nontemporal_load(xa_ + 128 * j); rf[2 * j + 1] = __builtin_nontemporal_load(xa_ + 128 * j + 1); } } \
        if (add) { const GAS v4u* aa_ = (const GAS v4u*)(add + (size_t)(m) * DM) + F.lane; _Pragma("unroll") for (int j = 0; j < 4; ++j) rw[j] = __builtin_nontemporal_load(aa_ + 64 * j); } } while (0)
    if (gw < MG) NP_FETCH(gw);
    for (int m0 = gw; m0 < MG; m0 += NGW) {
        f32x4 va[8]; v4u wa[4];
        if (XSB) {
#pragma unroll
            for (int j = 0; j < 4; ++j) UNPK(rq[j], va[2 * j], va[2 * j + 1]);
        } else {
#pragma unroll
            for (int j = 0; j < 8; ++j) va[j] = rf[j];
        }
#pragma unroll
        for (int j = 0; j < 4; ++j) wa[j] = rw[j];
        if (m0 + NGW < MG) NP_FETCH(m0 + NGW);
        if (add) {
            float sa = 0.f;
#pragma unroll
            for (int j = 0; j < 4; ++j) { f32x4 a0, a1; UNPK(wa[j], a0, a1);
                sa += ((a0[0] * a0[0] + a0[1] * a0[1]) + (a0[2] * a0[2] + a0[3] * a0[3])) + ((a1[0] * a1[0] + a1[1] * a1[1]) + (a1[2] * a1[2] + a1[3] * a1[3])); }
            const float ra = 1.0f / sqrtf(wave_sum(sa) * (1.0f / DM) + EPS);
#pragma unroll
            for (int j = 0; j < 4; ++j) { f32x4 a0, a1; UNPK(wa[j], a0, a1);
                va[2 * j] = va[2 * j] + a0 * ra * gA[2 * j]; va[2 * j + 1] = va[2 * j + 1] + a1 * ra * gA[2 * j + 1]; }
        }
        if (xf_dst) { GAS f32x4* oa = (GAS f32x4*)(xf_dst + (size_t)m0 * DM) + 2 * F.lane;
#pragma unroll
            for (int j = 0; j < 4; ++j) { oa[128 * j] = va[2 * j]; oa[128 * j + 1] = va[2 * j + 1]; } }
        if (xb_dst) { GAS v4u* oa = (GAS v4u*)(xb_dst + (size_t)m0 * DM) + F.lane;
#pragma unroll
            for (int j = 0; j < 4; ++j) { const v4u w = PK8(va[2 * j], va[2 * j + 1]); oa[64 * j] = w;
                UNPK(w, va[2 * j], va[2 * j + 1]); } }
        if (h_dst) {
            float sa = 0.f;
#pragma unroll
            for (int j = 0; j < 8; ++j) sa += (va[j][0] * va[j][0] + va[j][1] * va[j][1]) + (va[j][2] * va[j][2] + va[j][3] * va[j][3]);
            const float ra = 1.0f / sqrtf(wave_sum(sa) * (1.0f / DM) + EPS);
            GAS v4u* ha = (GAS v4u*)(h_dst + (size_t)m0 * DM) + F.lane;
#pragma unroll
            for (int j = 0; j < 4; ++j) { const f32x4 oa0 = va[2 * j] * ra * gO[2 * j], oa1 = va[2 * j + 1] * ra * gO[2 * j + 1]; ha[64 * j] = PK8(oa0, oa1); }
        }
    }
#undef NP_FETCH
#undef UNPK
#undef PK8
}
typedef LAS cf* lcf;
template <bool ZUP> __device__ __forceinline__ void hy_fwd(lcf X, lcf thi, lcf tlo, int tid, const unsigned* KM) {
    if (ZUP) hy_pass16<1024, false, true, false>(X, thi, tlo, tid); else hy_pass16<1024, false, false, false>(X, thi, tlo, tid);
    __syncthreads();
    hy_pass16<64, false, false, false>(X, thi, tlo, tid);
    hy_pass16<4, false, false, false>(X, thi, tlo, tid);
    hy_pass4<false>(X, tid, KM); __syncthreads();
}
__device__ __forceinline__ void hy_inv(lcf X, lcf thi, lcf tlo, int tid) {
    const unsigned* nul = nullptr;
    hy_pass4<true>(X, tid, nul); __syncthreads();
    hy_pass16<4, true, false, false>(X, thi, tlo, tid); __syncthreads();
    hy_pass16<64, true, false, false>(X, thi, tlo, tid); __syncthreads();
    hy_pass16<1024, true, false, true>(X, thi, tlo, tid); __syncthreads();
}
__device__ __forceinline__ void hy_mid(lcf X, lcf thi, lcf tlo, int tid, const unsigned* KM) {
    const unsigned* nul = nullptr;
    hy_pass16<64, false, false, false>(X, thi, tlo, tid);
    hy_pass16<4, false, false, false>(X, thi, tlo, tid);
    hy_pass4<false>(X, tid, KM);
    hy_pass4<true>(X, tid, nul);
    hy_pass16<4, true, false, false>(X, thi, tlo, tid);
    hy_pass16<64, true, false, false>(X, thi, tlo, tid); __syncthreads();
}
__device__ __forceinline__ void hyena_phase(Frame& F, const Args& A, int l) {
    lcf X = (lcf)(F.lds + RING_OFF); lcf thi = (lcf)(F.lds + TAB_OFF); lcf tlo = thi + 128;
    const int tid = F.tid;
    if (tid < 256) { const int a = tid & 127; const double ang = -6.283185307179586 * (double)(tid < 128 ? 128 * a : a) / (double)FN; float s, c; sincos_red(ang, s, c); (tid < 128 ? thi : tlo)[a] = cf{c, s}; }
    unsigned* K1g = (unsigned*)(F.ws + WS_FFTK) + (size_t)F.bx * 2 * FN; unsigned* K2g = K1g + FN;
    const bf16* taps = (const bf16*)(F.ws + ((A.taps_all && l > 0) ? WS_TAPS_X + (size_t)(l - 1) * SZ_TAPS : WS_TAPS));
    const float* cw = GP(A.in[I_CONVW + F.z]) + (size_t)l * 3 * HYIN; const float* cb = GP(A.in[I_CONVB + F.z]) + (size_t)l * HYIN; const float* hb = GP(A.in[I_HBIAS + F.z]) + (size_t)l * 2 * HYW;
    const bf16* projT = (const bf16*)(F.ws + WS_PROJT); bf16* zT = (bf16*)(F.ws + WS_ZT);
    for (int c = F.vcu; c < HYW; c += F.G) {
        __syncthreads();
        const float delta = fabsf(-15.350567286626973f + (float)c * ((-3.0701134573253945f + 15.350567286626973f) / 1023.0f));
#define TIDX(v) int v = tid; asm volatile("" : "+v"(v))
        { TIDX(t_); hy_filter_step(X, taps + (size_t)c * SEQ, delta, t_); }
        const unsigned* rx1 = (const unsigned*)(projT + (size_t)c * MG); const unsigned* rx2 = (const unsigned*)(projT + (size_t)(HYW + c) * MG); const unsigned* rv = (const unsigned*)(projT + (size_t)(2 * HYW + c) * MG);
        HyRaw R;
        { TIDX(t_); hy_raw_load(R, rv, rv + SEQ / 2, t_); }
        __syncthreads();
        { TIDX(t_); hy_fwd<false>(X, thi, tlo, t_, nullptr); }
        { TIDX(t_); hy_sep_step(X, K1g, K2g, t_); }
        asm volatile("s_waitcnt vmcnt(0)" ::: "memory"); __syncthreads();
        cf zr[2][8];
        { TIDX(t_); hy_convA_fwd(X, thi, tlo, t_, R, cw[2 * HYW + c], cw[HYIN + 2 * HYW + c], cw[2 * HYIN + 2 * HYW + c], cb[2 * HYW + c], zr); }
        { TIDX(t_); hy_raw_load(R, rx1, rx1 + SEQ / 2, t_); }
        __syncthreads();
        { TIDX(t_); hy_mid(X, thi, tlo, t_, K1g); }
        { TIDX(t_); hy_gateA<false>(X, thi, tlo, t_, R, cw[c], cw[HYIN + c], cw[2 * HYIN + c], cb[c], hb[c], zr, (unsigned short*)nullptr, (unsigned short*)nullptr); }
        { TIDX(t_); hy_raw_load(R, rx2, rx2 + SEQ / 2, t_); }
        __syncthreads();
        { TIDX(t_); hy_mid(X, thi, tlo, t_, K2g); }
        unsigned short* zo = (unsigned short*)(zT + (size_t)c * MG);
        { TIDX(t_); hy_gateA<true>(X, thi, tlo, t_, R, cw[HYW + c], cw[HYIN + HYW + c], cw[2 * HYIN + HYW + c], cb[HYW + c], hb[HYW + c], zr, zo, zo + SEQ); }
#undef TIDX
    }
    __syncthreads();
}
__device__ __forceinline__ void hynorm_phase(Frame& F, const Args& A, int l) {
    constexpr int TB = 64;
    LAS unsigned char* tile = F.lds + RING_OFF; LAS float* red = (LAS float*)(F.lds + RING_OFF + TB * HYW * 2); LAS float* rinv = red + 8 * TB;
    const bf16* zT = (const bf16*)(F.ws + WS_ZT); bf16* mixin = (bf16*)(F.ws + WS_MIXIN); const float* gn = GP(A.in[I_HNORM + F.z]) + (size_t)l * HYW;
    const int tid = F.tid;
    for (int tb = F.vcu; tb < MG / TB; tb += F.G) {
        const int t0 = tb * TB; __syncthreads();
        float ps[8];
#pragma unroll
        for (int i = 0; i < 8; ++i) ps[i] = 0.f;
        const int k = tid & 7, crow = tid >> 3;
#pragma unroll
        for (int hb = 0; hb < 2; ++hb) {
            v4u w[8];
#pragma unroll
            for (int it = 0; it < 8; ++it) { const unsigned c = (unsigned)((hb * 8 + it) * 64 + crow) & 1023u; w[it] = __builtin_nontemporal_load((const GAS v4u*)(zT + (size_t)c * MG + (unsigned)(t0 + 8 * k))); }
#pragma unroll
            for (int it = 0; it < 8; ++it) { const int c = (hb * 8 + it) * 64 + crow;
                LAS unsigned short* d = (LAS unsigned short*)(tile + (8 * k) * 2048 + (((c >> 3) ^ k) << 4) + (c & 7) * 2);
                const unsigned ww[4] = {w[it].x, w[it].y, w[it].z, w[it].w};
#pragma unroll
                for (int i = 0; i < 4; ++i) { d[(2 * i) * 1024] = (unsigned short)(ww[i] & 0xffffu); d[(2 * i + 1) * 1024] = (unsigned short)(ww[i] >> 16);
                    const float a = __uint_as_float(ww[i] << 16), b = __uint_as_float(ww[i] & 0xffff0000u); ps[2 * i] += a * a; ps[2 * i + 1] += b * b; } }
        }
#pragma unroll
        for (int i = 0; i < 8; ++i) { float v = ps[i]; v += swz_xor<8>(v); v += swz_xor<16>(v);
            auto rr = __builtin_amdgcn_permlane32_swap(__float_as_uint(v), __float_as_uint(v), false, false); ps[i] = __uint_as_float(rr[0]) + __uint_as_float(rr[1]); }
        if ((F.lane >> 3) == 0) {
#pragma unroll
            for (int i = 0; i < 8; ++i) red[F.wave * TB + 8 * k + i] = ps[i]; }
        __syncthreads();
        if (tid < TB) { float s = 0.f;
#pragma unroll
            for (int w8 = 0; w8 < 8; ++w8) s += red[w8 * TB + tid];
            rinv[tid] = 1.0f / sqrtf(s * (1.0f / HYW) + EPS); }
        __syncthreads();
        const int cg = tid & 127;
        const f32x4 g0 = *(const f32x4*)(gn + 8 * cg), g1 = *(const f32x4*)(gn + 8 * cg + 4);
#pragma unroll 4
        for (int it = 0; it < 16; ++it) { const int tok = it * 4 + (tid >> 7); const float r = rinv[tok];
            const v4u q = *(const LAS v4u*)(tile + tok * 2048 + ((cg ^ (tok >> 3)) << 4));
            v4u o; o.x = pk2(__uint_as_float(q.x << 16) * r * g0[0], __uint_as_float(q.x & 0xffff0000u) * r * g0[1]); o.y = pk2(__uint_as_float(q.y << 16) * r * g0[2], __uint_as_float(q.y & 0xffff0000u) * r * g0[3]);
            o.z = pk2(__uint_as_float(q.z << 16) * r * g1[0], __uint_as_float(q.z & 0xffff0000u) * r * g1[1]); o.w = pk2(__uint_as_float(q.w << 16) * r * g1[2], __uint_as_float(q.w & 0xffff0000u) * r * g1[3]);
            *(GAS v4u*)(mixin + (size_t)(t0 + tok) * DM + 8 * cg) = o; }
    }
    __syncthreads();
}
__device__ __forceinline__ void attn_phase(Frame& F, const Args& A, int l, unsigned char* lds_generic) {
    const float li = 0.8f - 0.6f * expf(-0.3f * (float)l);
    float lam;
    { const int j = F.lane; const float a = GP(A.in[I_LQ1 + F.z])[l * 64 + j] * GP(A.in[I_LK1 + F.z])[l * 64 + j], b = GP(A.in[I_LQ2 + F.z])[l * 64 + j] * GP(A.in[I_LK2 + F.z])[l * 64 + j];
      lam = expf(wave_sum(a)) - expf(wave_sum(b)) + li; }
    const att::bf16* qkv = (const att::bf16*)(F.ws + WS_QKV); att::bf16* mixin = (att::bf16*)(F.ws + WS_MIXIN);
    float* stash = (float*)(F.ws + WS_H) + (size_t)F.bx * 64 * 512;
    const float* subln = GP(A.in[I_SUBLN + F.z]) + (size_t)l * 128;
    constexpr int NU = GSEQ * 8 * (SEQ / 256);
    for (int u = F.vcu; u < NU; u += F.G) {
        const int bvh = u >> 5, qb = u & 31, b = bvh >> 3, vh = bvh & 7;
        const long krow0 = (long)b * SEQ, qrow0 = krow0 + qb * 256;
        att::attn_unit(qkv, qrow0, krow0, vh, SEQ, lam, 1.0f - li, subln, mixin + (size_t)qrow0 * DM + HYW + vh * 128, DM, stash, (char*)lds_generic);
        __syncthreads();
    }
}
#ifndef PHMASK
#define PHMASK 511
#endif
__global__ void __launch_bounds__(NTHR, 2) hymba_fwd(Args args) {
    extern __shared__ __attribute__((aligned(16))) unsigned char lds[];
    Frame F;
    F.lds = (LAS unsigned char*)lds; F.MISC = (volatile LAS unsigned*)(F.lds + MISC_OFF);
    F.tid = threadIdx.x; F.lane = F.tid & 63; F.wave = __builtin_amdgcn_readfirstlane(F.tid >> 6);
    F.G = gridDim.x; { const int bx = blockIdx.x; F.vcu = (F.G % 8 == 0) ? (bx % 8) * (F.G / 8) + bx / 8 : bx; F.bx = bx; }
    F.vcu0 = F.vcu; F.G0 = F.G; F.bx0 = F.bx;
    F.ctl = (gu32*)(args.ws + WS_CTL); F.out = args.out; F.ws = args.ws; F.ws0 = args.ws; F.z = 0;
    for (int u = F.tid; u < (LDS_BYTES - MISC_OFF) / 4; u += NTHR) ((LAS unsigned*)(F.lds + MISC_OFF))[u] = 0u;
    __syncthreads();
    XcdBarrier bar; bar.bar = (unsigned*)(F.ctl + CW_BAR); bar.x = 0; bar.st = nullptr;
    if (!MK_PER_PHASE) bar = xcd_barrier_post((unsigned*)(F.ctl + CW_BAR), F.MISC + 8);
    const int lo = args.ph_lo, hi = args.ph_hi;
    int ph = 0;
#define IN_() (lo <= ph && ph < hi && ({ LAUNDER_TID(F); true; }))
#define DUP3(...) do { __VA_ARGS__; if (PROBE_DUP == 3) { __VA_ARGS__; } } while (0)
#define SEAM() do { if (!MK_PER_PHASE && lo <= ph && ph + 1 < hi) { XcdBarrier b_ = bar; { unsigned long long p_ = (unsigned long long)b_.bar; unsigned x_ = b_.x; asm volatile("" : "+s"(p_), "+s"(x_)); b_.bar = (unsigned*)(GAS unsigned*)p_; b_.x = x_; } \
        xcd_barrier(b_); if (PROBE_DUP == 7) xcd_barrier(b_); } ++ph; } while (0)
    if ((PHMASK & 1) && IN_()) { p0_prologue(F, args); if (PROBE_DUP == 4) p0_prologue(F, args); }
    SEAM();
#define Hb ((bf16*)(F.ws + WS_H))
#define XB ((bf16*)(F.ws + WS_XB))
#define projT ((bf16*)(F.ws + WS_PROJT))
#define qkv ((bf16*)(F.ws + WS_QKV))
#define mix ((bf16*)(F.ws + WS_MIX))
#define ffh ((bf16*)(F.ws + WS_FFH))
#define mixin ((bf16*)(F.ws + WS_MIXIN))
#define wl (F.ws + WS_W + (size_t)l * SZ_WLAYER)
#define xin ((g == 0) ? GP(args.in[I_XP + F.z]) : GP(args.in[I_XS + F.z]) + (size_t)(g - 1) * MG * DM)
#define xres ((float*)(GAS float*)args.out + (size_t)g * MG * DM)
    for (int g = 0; g < NGRP; ++g) {
        if ((PHMASK & 2) && IN_()) norm_pass<false>(F, xin, nullptr, nullptr, nullptr, nullptr, GP(args.in[I_GMPRE + F.z]), Hb);
        SEAM();
        for (int l = 0; l < DEPTH; ++l) {
            if ((PHMASK & 4) && IN_()) {
                { pg8::Gemm gm{(const bf16*)(wl + OFF_WHY), Hb, HYIN, MG, DM}; pg8::StaticOrder S; S.init(HYIN, MG, F.G, F.bx);
                  pg8::EpiPlain E{projT, MG};
                  DUP3(pg8::gemm_phase<pg8::EpiPlain, pg8::StaticOrder, true, true>(F.lds + RING_OFF, gm, S, E)); }
                if (g == 0 || !args.taps_all) { pg8::Gemm gm{(const bf16*)(F.ws + WS_W4T) + (size_t)l * 4096 * KPAD, (const bf16*)(F.ws + WS_H3) + (size_t)l * SEQ * KPAD, 4096, SEQ, KPAD}; pg8::StaticOrder S; S.init(4096, SEQ, F.G, F.bx);
                  pg8::EpiPlain E{(bf16*)(F.ws + ((args.taps_all && l > 0) ? WS_TAPS_X + (size_t)(l - 1) * SZ_TAPS : WS_TAPS)), SEQ};
                  DUP3(pg8::gemm_phase<pg8::EpiPlain, pg8::StaticOrder, true, true>(F.lds + RING_OFF, gm, S, E)); }
                { pg8::Gemm gm{Hb, (const bf16*)(wl + OFF_WQKV), MG, QKVW, DM}; pg8::StaticOrder S; S.init(MG, QKVW, F.G, F.bx);
                  pg8::EpiRope E{qkv, QKVW, (const float*)(F.ws + WS_ROPE), QSCALE};
                  DUP3(pg8::gemm_phase<pg8::EpiRope, pg8::StaticOrder, true, true>(F.lds + RING_OFF, gm, S, E)); }
            }
            SEAM();
            if (IN_()) { if (PHMASK & 8) hyena_phase(F, args, l); if (PROBE_DUP == 2) hyena_phase(F, args, l); if (PHMASK & 16) attn_phase(F, args, l, lds); if (PROBE_DUP == 1) attn_phase(F, args, l, lds); }
            SEAM();
            if ((PHMASK & 32) && IN_()) { hynorm_phase(F, args, l); if (PROBE_DUP == 4) hynorm_phase(F, args, l); }
            SEAM();
            if ((PHMASK & 64) && IN_()) { pg8::Gemm gm{mixin, (const bf16*)(wl + OFF_WOUT), MG, DM, DM}; pg8::StaticOrder S; S.init(MG, DM, F.G, F.bx);
                pg8::EpiPlain E{mix, DM};
                DUP3(pg8::gemm_phase<pg8::EpiPlain, pg8::StaticOrder, true, true>(F.lds + RING_OFF, gm, S, E)); }
            SEAM();
            if ((PHMASK & 2) && IN_()) { if (l == 0) norm_pass<false>(F, xin, mix, GP(args.in[I_GMPOST + F.z]) + (size_t)l * DM, XB, nullptr, GP(args.in[I_GFPRE + F.z]) + (size_t)l * DM, Hb);
                else norm_pass<true>(F, XB, mix, GP(args.in[I_GMPOST + F.z]) + (size_t)l * DM, XB, nullptr, GP(args.in[I_GFPRE + F.z]) + (size_t)l * DM, Hb); }
            SEAM();
            if ((PHMASK & 128) && IN_()) { pg8::Gemm gm{Hb, (const bf16*)(wl + OFF_WGU), MG, GU, DM}; pg8::StaticOrder S; S.init(MG, GU, F.G, F.bx);
                pg8::EpiSwiGLU E{ffh, DFF};
                DUP3(pg8::gemm_phase<pg8::EpiSwiGLU, pg8::StaticOrder, true, true>(F.lds + RING_OFF, gm, S, E)); }
            SEAM();
            if ((PHMASK & 256) && IN_()) { pg8::Gemm gm{ffh, (const bf16*)(wl + OFF_WDN), MG, DM, DFF}; pg8::StaticOrder S; S.init(MG, DM, F.G, F.bx);
                pg8::EpiPlain E{mixin, DM};
                DUP3(pg8::gemm_phase<pg8::EpiPlain, pg8::StaticOrder, true, true>(F.lds + RING_OFF, gm, S, E)); }
            SEAM();
            if ((PHMASK & 2) && IN_()) { if (l + 1 < DEPTH) norm_pass<true>(F, XB, mixin, GP(args.in[I_GFPOST + F.z]) + (size_t)l * DM, XB, nullptr, GP(args.in[I_GMPRE + F.z]) + (size_t)(l + 1) * DM, Hb);
                else norm_pass<true>(F, XB, mixin, GP(args.in[I_GFPOST + F.z]) + (size_t)l * DM, nullptr, xres, nullptr, nullptr); }
            SEAM();
        }
    }
#undef IN_
#undef SEAM
#undef Hb
#undef XB
#undef projT
#undef qkv
#undef mix
#undef ffh
#undef mixin
#undef wl
#undef xin
#undef xres
}

extern "C" void kernel_launch(void* const* d_in, const int* in_sizes, int n_in, void* d_out, int out_size, void* d_ws, size_t ws_size, hipStream_t stream) {
    static int grid = 0;
    if (grid == 0) {
        if (n_in != 30 || in_sizes[0] != 2 * SEQ * DM || in_sizes[1] != 4 * SEQ * DM || out_size != NSEQ * SEQ * DM || ws_size < WS_END) {
            fprintf(stderr, "kernel_launch: shape mismatch (n_in %d, out %d, ws %zu, need %zu)\n", n_in, out_size, ws_size, (size_t)WS_END); grid = -1; return; }
        int dev = 0, cus = 0;
        if (hipGetDevice(&dev) != hipSuccess || hipDeviceGetAttribute(&cus, hipDeviceAttributeMultiprocessorCount, dev) != hipSuccess) { grid = -1; return; }
        if (hipFuncSetAttribute((const void*)hymba_fwd, hipFuncAttributeMaxDynamicSharedMemorySize, LDS_BYTES) != hipSuccess) { fprintf(stderr, "kernel_launch: hipFuncSetAttribute failed\n"); grid = -1; return; }
        int per_cu = 0;
        if (hipOccupancyMaxActiveBlocksPerMultiprocessor(&per_cu, (const void*)hymba_fwd, NTHR, LDS_BYTES) != hipSuccess || per_cu < 1) fprintf(stderr, "kernel_launch: occupancy query says %d\n", per_cu);
        (void)hipGetLastError();
        grid = cus;
    }
    if (grid < 0) return;
    if (hipMemsetAsync((char*)d_ws + WS_CTL, 0, CTL_ZERO_BYTES, stream) != hipSuccess) return;
    Args a{};
    for (int i = 0; i < 30; ++i) a.in[i] = (const float*)d_in[i];
    a.out = (float*)d_out; a.ws = (unsigned char*)d_ws; a.taps_all = (ws_size >= WS_END_X) ? 1 : 0;
#if MK_PER_PHASE
    for (int p = 0; p < NPHASE; ++p) { a.ph_lo = p; a.ph_hi = p + 1; hipLaunchKernelGGL(hymba_fwd, dim3(grid), dim3(NTHR), LDS_BYTES, stream, a); }
#else
    a.ph_lo = 0; a.ph_hi = NPHASE;
    hipLaunchKernelGGL(hymba_fwd, dim3(grid), dim3(NTHR), LDS_BYTES, stream, a);
#endif
    const hipError_t le = hipPeekAtLastError();
    if (le != hipSuccess) fprintf(stderr, "kernel_launch: launch failed: %s\n", hipGetErrorName(le));
}
```

```cpp
#include <hip/hip_runtime.h>
#include <hip/hip_bf16.h>
#include <cstdio>
#include <cstdint>
#include <cmath>
namespace pg8 {
#define PG8_LAS __attribute__((address_space(3)))
typedef unsigned short bf16_t;
typedef short bf16x8 __attribute__((ext_vector_type(8)));
typedef float f32x4 __attribute__((ext_vector_type(4)));
typedef unsigned u32x4 __attribute__((ext_vector_type(4)));
constexpr int BM = 256, BK = 64, HALF = 128, HTB = HALF * BK * 2  , STAGE_BYTES = 8 * HTB, NXCD = 8, WGM = 8;

__host__ __device__ __forceinline__ int lds_byte(int r, int c) { const int st = (r >> 4) * 2 + (c >> 5), rr = r & 15, cc = c & 31, ob = rr * 64 + cc * 2; return st * 1024 + (ob ^ (((ob >> 9) & 1) << 5)); }
__host__ __device__ __forceinline__ void stage_rc(int b, int& R, int& C) { const int st = b / 1024, sb = b % 1024, swz = sb ^ (((sb >> 9) & 1) << 5); R = (st >> 1) * 16 + swz / 64; C = (st & 1) * 32 + (swz % 64) / 2; }
__host__ __device__ __forceinline__ int perm32(int rho) { const int n = rho >> 4, i = rho & 15; return 8 * (i >> 2) + 4 * n + (i & 3); }

struct Unit { int pm, pn; };
struct Gemm { const bf16_t* A; const bf16_t* Bt; int M, N, K; };

struct StaticOrder {
    int nM, nN, nwg, G, c;
    __host__ __device__ void init(int M, int N, int G_, int c_) { nM = M / BM; nN = N / BM; nwg = nM * nN; G = G_; c = c_; }
    __host__ __device__ bool next(int i, Unit& u) const {
        const long L = (long)i * G + c; if (L >= nwg) return false;
        int wgid = (int)L; { const int q = nwg / NXCD, r = nwg % NXCD, xcd = wgid % NXCD, off = wgid / NXCD; wgid = (xcd < r ? xcd * (q + 1) : r * (q + 1) + (xcd - r) * q) + off; }
        const int nig = WGM * nN, gid = wgid / nig, fm = gid * WGM, gsz = (nM - fm) < WGM ? (nM - fm) : WGM;
        u.pm = fm + ((wgid % nig) % gsz); u.pn = (wgid % nig) / gsz; return true;
    }
    __device__ __forceinline__ void a_ready(const Unit&) const {}
    __device__ __forceinline__ void done(const Unit&) const {}
};

__device__ __forceinline__ unsigned cvt_pk_bf16(float lo, float hi) { unsigned r; asm volatile("v_cvt_pk_bf16_f32 %0, %1, %2" : "=v"(r) : "v"(lo), "v"(hi)); return r; }
typedef float f32x2 __attribute__((ext_vector_type(2)));
struct EpiPlain {
    static constexpr bool PERM = true, AFTER_DRAIN = false;
    bf16_t* O; int ldc;
    __device__ __forceinline__ void operator()(const f32x4 (&acc)[2][2][4][2], const Unit& u, int wr, int wc, int fr, int fq) const {
        const int row0 = u.pm * BM + wr * 64 + fr, col0 = u.pn * BM + wc * 32 + 8 * fq;
#pragma unroll
        for (int ai = 0; ai < 2; ++ai)
#pragma unroll
            for (int m = 0; m < 4; ++m) { bf16_t* rowp = O + (size_t)(row0 + ai * HALF + m * 16) * ldc + col0;
#pragma unroll
                for (int bj = 0; bj < 2; ++bj) { const f32x4 v0 = acc[ai][bj][m][0], v1 = acc[ai][bj][m][1];
                    u32x4 w; w.x = cvt_pk_bf16(v0[0], v0[1]); w.y = cvt_pk_bf16(v0[2], v0[3]); w.z = cvt_pk_bf16(v1[0], v1[1]); w.w = cvt_pk_bf16(v1[2], v1[3]);
                    *(u32x4*)(rowp + bj * HALF) = w; } }
    }
};
struct EpiRope {
    static constexpr bool PERM = true, AFTER_DRAIN = false;
    bf16_t* O; int ldc; const float* cs; float qscale;
    __device__ __forceinline__ void operator()(const f32x4 (&acc)[2][2][4][2], const Unit& u, int wr, int wc, int fr, int fq) const {
        const int row0 = u.pm * BM + wr * 64 + fr, col0 = u.pn * BM + wc * 32 + 8 * fq;
        const bool rope = u.pn < 8; const float sc = u.pn < 4 ? qscale : 1.0f;
        const int p0 = 16 * (wc & 1) + 4 * fq;
        f32x4 tt[2][4][2];
#pragma unroll
        for (int ai = 0; ai < 2; ++ai)
#pragma unroll
            for (int m = 0; m < 4; ++m) { tt[ai][m][0] = (f32x4){1.f, 0.f, 1.f, 0.f}; tt[ai][m][1] = (f32x4){1.f, 0.f, 1.f, 0.f};
                if (rope) { const int row = row0 + ai * HALF + m * 16; const __attribute__((address_space(1))) float* tp = (const __attribute__((address_space(1))) float*)cs + ((size_t)(row & 8191) * 32 + p0) * 2;
                    tt[ai][m][0] = *(const __attribute__((address_space(1))) f32x4*)tp; tt[ai][m][1] = *(const __attribute__((address_space(1))) f32x4*)(tp + 4); } }
#pragma unroll
        for (int ai = 0; ai < 2; ++ai)
#pragma unroll
            for (int m = 0; m < 4; ++m) { const int row = row0 + ai * HALF + m * 16; bf16_t* rowp = O + (size_t)row * ldc + col0;
                const f32x4 t0 = tt[ai][m][0], t1 = tt[ai][m][1];
#pragma unroll
                for (int bj = 0; bj < 2; ++bj) { const f32x4 v0 = acc[ai][bj][m][0], v1 = acc[ai][bj][m][1];
                    f32x4 o0, o1;
                    o0[0] = (v0[0] * t0[0] - v0[1] * t0[1]) * sc; o0[1] = (v0[0] * t0[1] + v0[1] * t0[0]) * sc;
                    o0[2] = (v0[2] * t0[2] - v0[3] * t0[3]) * sc; o0[3] = (v0[2] * t0[3] + v0[3] * t0[2]) * sc;
                    o1[0] = (v1[0] * t1[0] - v1[1] * t1[1]) * sc; o1[1] = (v1[0] * t1[1] + v1[1] * t1[0]) * sc;
                    o1[2] = (v1[2] * t1[2] - v1[3] * t1[3]) * sc; o1[3] = (v1[2] * t1[3] + v1[3] * t1[2]) * sc;
                    u32x4 w; w.x = cvt_pk_bf16(o0[0], o0[1]); w.y = cvt_pk_bf16(o0[2], o0[3]); w.z = cvt_pk_bf16(o1[0], o1[1]); w.w = cvt_pk_bf16(o1[2], o1[3]);
                    *(u32x4*)(rowp + bj * HALF) = w; } }
    }
};
struct EpiSwiGLU {
    static constexpr bool PERM = true, AFTER_DRAIN = false;
    bf16_t* O; int ldc;
    static __device__ __forceinline__ float silu_mul(float g, float u) { return g * u * __builtin_amdgcn_rcpf(1.0f + __builtin_amdgcn_exp2f(-1.4426950408889634f * g)); }
    __device__ __forceinline__ void operator()(const f32x4 (&acc)[2][2][4][2], const Unit& u, int wr, int wc, int fr, int fq) const {
        const int row0 = u.pm * BM + wr * 64 + fr, col0 = u.pn * HALF + wc * 32 + 8 * fq;
#pragma unroll
        for (int ai = 0; ai < 2; ++ai)
#pragma unroll
            for (int m = 0; m < 4; ++m) { bf16_t* rowp = O + (size_t)(row0 + ai * HALF + m * 16) * ldc + col0;
                const f32x4 g0 = acc[ai][0][m][0], g1 = acc[ai][0][m][1], u0 = acc[ai][1][m][0], u1 = acc[ai][1][m][1];
                u32x4 w; w.x = cvt_pk_bf16(silu_mul(g0[0], u0[0]), silu_mul(g0[1], u0[1])); w.y = cvt_pk_bf16(silu_mul(g0[2], u0[2]), silu_mul(g0[3], u0[3]));
                w.z = cvt_pk_bf16(silu_mul(g1[0], u1[0]), silu_mul(g1[1], u1[1])); w.w = cvt_pk_bf16(silu_mul(g1[2], u1[2]), silu_mul(g1[3], u1[3]));
                *(u32x4*)rowp = w; }
    }
};
template <class Epi, class Sched, bool ALIGN_EPI = false, bool SP2 = false>
__device__ __forceinline__ void gemm_phase(PG8_LAS unsigned char* lds, const Gemm g, const Sched& S, const Epi& E) {
    int tid = threadIdx.x; asm volatile("" : "+v"(tid));
    const int wid = __builtin_amdgcn_readfirstlane(tid >> 6), lane = tid & 63, wr = wid >> 2, wc = wid & 3, fr = lane & 15, fq = lane >> 4;
    const int K = g.K, nt = K / BK;
    unsigned voffA[2], voffB[2];
#pragma unroll
    for (int i = 0; i < 2; ++i) { int R, C; stage_rc(tid * 16 + i * 8192, R, C); const int Rb = Epi::PERM ? ((R & ~31) + perm32(R & 31)) : R;
        voffA[i] = (unsigned)(R * K + C) * 2u; voffB[i] = (unsigned)(Rb * K + C) * 2u; }
    const size_t kstep = (size_t)(BK * 2);
    const size_t hstep = (size_t)HALF * K * 2;
    const size_t tstep = 2 * hstep;
    const unsigned ldsw = (unsigned)wid * 1024u;
    const int aoff = lds_byte(wr * 64 + fr, fq * 8), boff = lds_byte(wc * 32 + fr, fq * 8);
#define PG8_SA(b, h) (((b) * 2 + (h)) * HTB)
#define PG8_SB(b, h) ((4 + (b) * 2 + (h)) * HTB)
#define PG8_STAGE(bufoff, gbase, voff) do { _Pragma("unroll") for (int _i = 0; _i < 2; ++_i) \
        __builtin_amdgcn_global_load_lds((const unsigned*)((const char*)(gbase) + (voff)[_i]), (PG8_LAS unsigned*)(lds + (bufoff) + ldsw + _i * 8192), 16, 0, 0); } while (0)
#define PG8_LDA(dst, b, h) do { _Pragma("unroll") for (int m = 0; m < 4; ++m) _Pragma("unroll") for (int k = 0; k < 2; ++k) dst[m][k] = *(const PG8_LAS bf16x8*)(lds + PG8_SA(b, h) + aoff + m * 2048 + k * 1024); } while (0)
#define PG8_LDB(dst, b, h) do { _Pragma("unroll") for (int n = 0; n < 2; ++n) _Pragma("unroll") for (int k = 0; k < 2; ++k) dst[n][k] = *(const PG8_LAS bf16x8*)(lds + PG8_SB(b, h) + boff + n * 2048 + k * 1024); } while (0)
#define PG8_MMA(ai, bj, At, Bt) do { __builtin_amdgcn_s_setprio(1); _Pragma("unroll") for (int m = 0; m < 4; ++m) _Pragma("unroll") for (int n = 0; n < 2; ++n) _Pragma("unroll") for (int k = 0; k < 2; ++k) \
        acc[ai][bj][m][n] = __builtin_amdgcn_mfma_f32_16x16x32_bf16(Bt[n][k], At[m][k], acc[ai][bj][m][n], 0, 0, 0); __builtin_amdgcn_s_setprio(0); } while (0)
#define PG8_WAIT_V(n) asm volatile("s_waitcnt vmcnt(" #n ")" ::: "memory")
#define PG8_WAIT_L(n) asm volatile("s_waitcnt lgkmcnt(" #n ")" ::: "memory")
#define PG8_BAR __builtin_amdgcn_s_barrier()
#define PG8_SCHED __builtin_amdgcn_sched_barrier(0)
    Unit cur, nxt; int ui = 0;
    if (!S.next(0, cur)) return;
    f32x4 acc[2][2][4][2];
#pragma unroll
    for (int a = 0; a < 2; ++a)
#pragma unroll
        for (int b = 0; b < 2; ++b)
#pragma unroll
            for (int m = 0; m < 4; ++m)
#pragma unroll
                for (int n = 0; n < 2; ++n) acc[a][b][m][n] = (f32x4){0.f, 0.f, 0.f, 0.f};
    bf16x8 At[4][2], B0[2][2], B1[2][2];
    const char* cA = (const char*)g.A + (size_t)cur.pm * tstep; const char* cB = (const char*)g.Bt + (size_t)cur.pn * tstep;
    S.a_ready(cur);
    if constexpr (SP2) {
        PG8_STAGE(PG8_SB(0, 0), cB, voffB); PG8_STAGE(PG8_SB(0, 1), cB + hstep, voffB); PG8_STAGE(PG8_SA(0, 0), cA, voffA); PG8_STAGE(PG8_SA(0, 1), cA + hstep, voffA);
        if (wr == 1) PG8_BAR;
        PG8_WAIT_V(2); PG8_BAR;
        PG8_STAGE(PG8_SB(1, 0), cB + kstep, voffB); PG8_STAGE(PG8_SA(1, 0), cA + kstep, voffA); PG8_STAGE(PG8_SB(1, 1), cB + hstep + kstep, voffB);
        PG8_WAIT_V(6); PG8_BAR;
    } else {
        PG8_STAGE(PG8_SB(0, 0), cB, voffB); PG8_STAGE(PG8_SA(0, 0), cA, voffA); PG8_STAGE(PG8_SB(0, 1), cB + hstep, voffB); PG8_STAGE(PG8_SA(0, 1), cA + hstep, voffA);
        if (wr == 1) PG8_BAR;
        PG8_WAIT_V(4); PG8_BAR;
        PG8_STAGE(PG8_SB(1, 0), cB + kstep, voffB); PG8_STAGE(PG8_SA(1, 0), cA + kstep, voffA); PG8_STAGE(PG8_SB(1, 1), cB + hstep + kstep, voffB);
        PG8_WAIT_V(6); PG8_BAR;
    }
    for (;;) {
        const bool has_next = S.next(ui + 1, nxt);
        const char* nA = has_next ? (const char*)g.A + (size_t)nxt.pm * tstep : cA; const char* nB = has_next ? (const char*)g.Bt + (size_t)nxt.pn * tstep : cB;
        for (int t = 0; t < nt; t += 2) {
            const bool last = (t == nt - 2);
            const char* a1 = cA + (size_t)(t + 1) * kstep;
            const char* a2 = last ? nA : cA + (size_t)(t + 2) * kstep; const char* b2 = last ? nB : cB + (size_t)(t + 2) * kstep;
            const char* a3 = a2 + kstep; const char* b3 = b2 + kstep;
            if (last && has_next) S.a_ready(nxt);
            if constexpr (SP2) {
            PG8_LDB(B0, 0, 0); PG8_LDB(B1, 0, 1); PG8_SCHED; PG8_LDA(At, 0, 0); PG8_STAGE(PG8_SA(1, 1), a1 + hstep, voffA);
            PG8_WAIT_V(8); PG8_WAIT_L(0); PG8_BAR; PG8_MMA(0, 0, At, B0); PG8_MMA(0, 1, At, B1); PG8_BAR; PG8_SCHED;
            PG8_LDA(At, 0, 1); PG8_STAGE(PG8_SB(0, 0), b2, voffB); PG8_STAGE(PG8_SB(0, 1), b2 + hstep, voffB); PG8_STAGE(PG8_SA(0, 0), a2, voffA);
            PG8_WAIT_V(8); PG8_WAIT_L(0); PG8_BAR; PG8_MMA(1, 0, At, B0); PG8_MMA(1, 1, At, B1); PG8_BAR; PG8_SCHED;
            PG8_LDB(B0, 1, 0); PG8_LDB(B1, 1, 1); PG8_SCHED; PG8_LDA(At, 1, 0); PG8_STAGE(PG8_SA(0, 1), a2 + hstep, voffA);
            PG8_WAIT_V(8); PG8_WAIT_L(0); PG8_BAR; PG8_MMA(0, 0, At, B0); PG8_MMA(0, 1, At, B1); PG8_BAR; PG8_SCHED;
            PG8_LDA(At, 1, 1); PG8_STAGE(PG8_SB(1, 0), b3, voffB); PG8_STAGE(PG8_SB(1, 1), b3 + hstep, voffB); PG8_STAGE(PG8_SA(1, 0), a3, voffA);
            PG8_WAIT_V(8); PG8_WAIT_L(0); PG8_BAR; PG8_MMA(1, 0, At, B0); PG8_MMA(1, 1, At, B1); PG8_BAR; PG8_SCHED;
            } else {
            PG8_LDB(B0, 0, 0); PG8_SCHED; PG8_LDA(At, 0, 0); PG8_STAGE(PG8_SA(1, 1), a1 + hstep, voffA);
            PG8_WAIT_L(8); PG8_BAR; PG8_WAIT_L(0); PG8_MMA(0, 0, At, B0); PG8_BAR; PG8_SCHED;
            PG8_LDB(B1, 0, 1); PG8_STAGE(PG8_SB(0, 0), b2, voffB);
            PG8_BAR; PG8_WAIT_L(0); PG8_MMA(0, 1, At, B1); PG8_BAR;
            PG8_LDA(At, 0, 1); PG8_STAGE(PG8_SA(0, 0), a2, voffA);
            PG8_BAR; PG8_WAIT_L(0); PG8_MMA(1, 0, At, B0); PG8_BAR; PG8_SCHED;
            PG8_STAGE(PG8_SB(0, 1), b2 + hstep, voffB);
            PG8_WAIT_V(6); PG8_BAR; PG8_MMA(1, 1, At, B1); PG8_BAR;
            PG8_LDB(B0, 1, 0); PG8_SCHED; PG8_LDA(At, 1, 0); PG8_STAGE(PG8_SA(0, 1), a2 + hstep, voffA);
            PG8_WAIT_L(8); PG8_BAR; PG8_WAIT_L(0); PG8_MMA(0, 0, At, B0); PG8_BAR; PG8_SCHED;
            PG8_LDB(B1, 1, 1); PG8_STAGE(PG8_SB(1, 0), b3, voffB);
            PG8_BAR; PG8_WAIT_L(0); PG8_MMA(0, 1, At, B1); PG8_BAR;
            PG8_LDA(At, 1, 1); PG8_STAGE(PG8_SA(1, 0), a3, voffA);
            PG8_BAR; PG8_WAIT_L(0); PG8_MMA(1, 0, At, B0); PG8_BAR; PG8_SCHED;
            PG8_STAGE(PG8_SB(1, 1), b3 + hstep, voffB);
            PG8_WAIT_V(6); PG8_BAR; PG8_MMA(1, 1, At, B1); PG8_BAR;
            }
        }
        if constexpr (ALIGN_EPI) { if (wr == 0) PG8_BAR; }
        if constexpr (!Epi::AFTER_DRAIN) { E(acc, cur, wr, wc, fr, fq); S.done(cur); }
        if (!has_next) break;
#pragma unroll
        for (int a = 0; a < 2; ++a)
#pragma unroll
            for (int b = 0; b < 2; ++b)
#pragma unroll
                for (int m = 0; m < 4; ++m)
#pragma unroll
                    for (int n = 0; n < 2; ++n) acc[a][b][m][n] = (f32x4){0.f, 0.f, 0.f, 0.f};
        cur = nxt; cA = nA; cB = nB; ++ui;
        if constexpr (ALIGN_EPI) { if (wr == 1) PG8_BAR; }
    }
    PG8_WAIT_V(0);
    if constexpr (!ALIGN_EPI) { if (wr == 0) PG8_BAR; }
    PG8_BAR;
    if constexpr (Epi::AFTER_DRAIN) { E.fused(acc, cur, wr, wc, fr, fq, lds, wid, lane); S.done(cur); }
#undef PG8_SA
#undef PG8_SB
#undef PG8_STAGE
#undef PG8_LDA
#undef PG8_LDB
#undef PG8_MMA
#undef PG8_WAIT_V
#undef PG8_WAIT_L
#undef PG8_BAR
#undef PG8_SCHED
}
}
namespace att {
using bf16x8 = __attribute__((ext_vector_type(8))) short;
using s16x4  = __attribute__((ext_vector_type(4))) short;
using f32x16 = __attribute__((ext_vector_type(16))) float;
using u32x4  = __attribute__((ext_vector_type(4))) unsigned;
typedef unsigned short bf16;
constexpr int DQ = 64, DV = 128, NW = 8, QBLK = 32, KVBLK = 64, LDR = 3072;
constexpr int SHM_V = KVBLK * DV * 2, SHM_K = KVBLK * DQ * 2, SHM_ATTN = 3 * SHM_V + 3 * SHM_K + NW * 64 * 4 + 64;
constexpr int SHM_ATTN_ALL = SHM_ATTN + NW * QBLK * DV * 2;
#ifndef ATT_OVF_LIMIT
#define ATT_OVF_LIMIT 1.152921504606847e18f
#endif
#ifndef ATT_SDEPTH
#define ATT_SDEPTH 2
#endif
constexpr float THR2 = 11.0f;
#define KSWZ64(row, colB) ((row) * 128 + ((colB) ^ ((((row) >> 1) & 7) << 4)))
#define SBAR() __builtin_amdgcn_sched_barrier(0)
template <int K> __device__ __forceinline__ float sx(float v) { return __builtin_bit_cast(float, __builtin_amdgcn_ds_swizzle(__builtin_bit_cast(int, v), (K << 10) | 0x1f)); }
__device__ __forceinline__ int crow(int r, int hi) { return (r & 3) + 8 * (r >> 2) + 4 * hi; }
__device__ __forceinline__ unsigned cvtpk(float lo, float hi) { unsigned r; asm volatile("v_cvt_pk_bf16_f32 %0, %1, %2" : "=v"(r) : "v"(lo), "v"(hi)); return r; }
__device__ __forceinline__ void partialSM(f32x16& p0, f32x16& p1, float& m_reg, float& mn, float& alpha) {
  float pmax = p0[0];
#pragma unroll
  for (int r = 1; r < 16; ++r) pmax = fmaxf(pmax, p0[r]);
#pragma unroll
  for (int r = 0; r < 16; ++r) pmax = fmaxf(pmax, p1[r]);
  { auto rr = __builtin_amdgcn_permlane32_swap(__float_as_uint(pmax), __float_as_uint(pmax), false, false);
    pmax = fmaxf(__uint_as_float(rr[0]), __uint_as_float(rr[1])); }
  if (__builtin_expect(__all(pmax - m_reg <= THR2), 1)) { mn = m_reg; alpha = 1.f; }
  else { mn = fmaxf(m_reg, pmax); alpha = __builtin_amdgcn_exp2f(m_reg - mn); m_reg = mn; }
#pragma unroll
  for (int r = 0; r < 16; ++r) p0[r] = p0[r] - mn;
#pragma unroll
  for (int r = 0; r < 16; ++r) p1[r] = p1[r] - mn;
#pragma unroll
  for (int r = 0; r < 16; ++r) p0[r] = __builtin_amdgcn_exp2f(p0[r]);
}
__device__ __forceinline__ void finishSM(f32x16& p0, f32x16& p1, float alpha, float& l_reg, bf16x8& pa0, bf16x8& pa1, bf16x8& pa2, bf16x8& pa3) {
#pragma unroll
  for (int r = 0; r < 16; ++r) p1[r] = __builtin_amdgcn_exp2f(p1[r]);
  float ps = 0;
#pragma unroll
  for (int r = 0; r < 16; ++r) ps += p0[r];
#pragma unroll
  for (int r = 0; r < 16; ++r) ps += p1[r];
  { auto rr = __builtin_amdgcn_permlane32_swap(__float_as_uint(ps), __float_as_uint(ps), false, false);
    ps = __uint_as_float(rr[0]) + __uint_as_float(rr[1]); }
  l_reg = l_reg * alpha + ps;
#define PK4(P, BASE, OUT) do { unsigned a0 = cvtpk(P[BASE + 0], P[BASE + 1]), a1 = cvtpk(P[BASE + 2], P[BASE + 3]);   \
    unsigned b0 = cvtpk(P[BASE + 4], P[BASE + 5]), b1 = cvtpk(P[BASE + 6], P[BASE + 7]);                              \
    auto r0 = __builtin_amdgcn_permlane32_swap(a0, b0, false, false); auto r1 = __builtin_amdgcn_permlane32_swap(a1, b1, false, false); \
    u32x4 w = {r0[0], r1[0], r0[1], r1[1]}; OUT = *reinterpret_cast<bf16x8*>(&w); } while (0)
  PK4(p0, 0, pa0); PK4(p0, 8, pa1); PK4(p1, 0, pa2); PK4(p1, 8, pa3);
#undef PK4
}
__device__ __forceinline__ void qkt(f32x16& p0, f32x16& p1, const char* Ks, const bf16x8* qr, int r32, int hi) {
  p0 = f32x16{}; p1 = f32x16{};
#pragma unroll
  for (int d0 = 0; d0 < 4; ++d0) { const int cb = (d0 * 16 + hi * 8) * 2;
    bf16x8 b0 = *reinterpret_cast<const bf16x8*>(Ks + KSWZ64(r32, cb));
    bf16x8 b1 = *reinterpret_cast<const bf16x8*>(Ks + KSWZ64(32 + r32, cb));
    p0 = __builtin_amdgcn_mfma_f32_32x32x16_bf16(b0, qr[d0], p0, 0, 0, 0);
    p1 = __builtin_amdgcn_mfma_f32_32x32x16_bf16(b1, qr[d0], p1, 0, 0, 0); }
}
__device__ __forceinline__ void qkt_ref(f32x16& p0, f32x16& p1, const char* Ks, const bf16x8* qr, const f32x16& negm, int r32, int hi) {
#pragma unroll
  for (int d0 = 0; d0 < 4; ++d0) { const int cb = (d0 * 16 + hi * 8) * 2;
    bf16x8 b0 = *reinterpret_cast<const bf16x8*>(Ks + KSWZ64(r32, cb));
    bf16x8 b1 = *reinterpret_cast<const bf16x8*>(Ks + KSWZ64(32 + r32, cb));
    if (d0 == 0) { p0 = __builtin_amdgcn_mfma_f32_32x32x16_bf16(b0, qr[0], negm, 0, 0, 0); p1 = __builtin_amdgcn_mfma_f32_32x32x16_bf16(b1, qr[0], negm, 0, 0, 0); }
    else { p0 = __builtin_amdgcn_mfma_f32_32x32x16_bf16(b0, qr[d0], p0, 0, 0, 0); p1 = __builtin_amdgcn_mfma_f32_32x32x16_bf16(b1, qr[d0], p1, 0, 0, 0); } }
}
__device__ __forceinline__ void exp_half(f32x16& p) {
#pragma unroll
  for (int r = 0; r < 16; ++r) p[r] = __builtin_amdgcn_exp2f(p[r]);
}
__device__ __forceinline__ void sub_exp_half(f32x16& p0, f32x16& p1, float m) {
#pragma unroll
  for (int r = 0; r < 16; ++r) p0[r] = p0[r] - m;
#pragma unroll
  for (int r = 0; r < 16; ++r) p1[r] = p1[r] - m;
#pragma unroll
  for (int r = 0; r < 16; ++r) p0[r] = __builtin_amdgcn_exp2f(p0[r]);
}
__device__ __forceinline__ void finishSM_fast(f32x16& p0, f32x16& p1, float& l_reg, bool& ovf, bf16x8& pa0, bf16x8& pa1, bf16x8& pa2, bf16x8& pa3) {
  float al = 1.f; float l0 = 0.f;
  finishSM(p0, p1, al, l0, pa0, pa1, pa2, pa3);
  ovf = ovf || !(l0 < ATT_OVF_LIMIT);
  l_reg += l0;
}
__device__ __forceinline__ int v_st(int k, int c) { const int kk = (k & ~0xC) | ((k & 4) << 1) | ((k & 8) >> 1); return ((kk >> 3) * 4 + (c >> 5)) * 512 + ((kk & 7) * 32 + (c & 31)) * 2; }
__device__ __forceinline__ int v_rd_base(int lane) { return ((lane & 3) << 3) | (((lane >> 2) & 3) << 6) | (((lane >> 4) & 1) << 5) | (((lane >> 5) & 1) << 8); }
constexpr int v_rd_off(int d0, int ks, int half) { return d0 * 512 + ks * 4096 + half * 2048; }
template <int OFF> __device__ __forceinline__ s16x4 tr_read(int vb) {
  s16x4 r; asm volatile("ds_read_b64_tr_b16 %0, %1 offset:%2" : "=&v"(r) : "v"(vb), "i"(OFF) : "memory"); return r;
}
template <int D0> __device__ __forceinline__ void pv_one(f32x16& od, int vb, bf16x8 pa0, bf16x8 pa1, bf16x8 pa2, bf16x8 pa3) {
  const s16x4 l0 = tr_read<v_rd_off(D0, 0, 0)>(vb), h0 = tr_read<v_rd_off(D0, 0, 1)>(vb), l1 = tr_read<v_rd_off(D0, 1, 0)>(vb), h1 = tr_read<v_rd_off(D0, 1, 1)>(vb);
  const s16x4 l2 = tr_read<v_rd_off(D0, 2, 0)>(vb), h2 = tr_read<v_rd_off(D0, 2, 1)>(vb), l3 = tr_read<v_rd_off(D0, 3, 0)>(vb), h3 = tr_read<v_rd_off(D0, 3, 1)>(vb);
  asm volatile("s_waitcnt lgkmcnt(0)" ::: "memory"); SBAR();
#define PK(L, H) (bf16x8){L[0], L[1], L[2], L[3], H[0], H[1], H[2], H[3]}
  od = __builtin_amdgcn_mfma_f32_32x32x16_bf16(pa0, PK(l0, h0), od, 0, 0, 0);
  od = __builtin_amdgcn_mfma_f32_32x32x16_bf16(pa1, PK(l1, h1), od, 0, 0, 0);
  od = __builtin_amdgcn_mfma_f32_32x32x16_bf16(pa2, PK(l2, h2), od, 0, 0, 0);
  od = __builtin_amdgcn_mfma_f32_32x32x16_bf16(pa3, PK(l3, h3), od, 0, 0, 0);
#undef PK
}
__device__ __forceinline__ void pv_d0(f32x16* o, int vb, bf16x8 pa0, bf16x8 pa1, bf16x8 pa2, bf16x8 pa3) {
  pv_one<0>(o[0], vb, pa0, pa1, pa2, pa3); pv_one<1>(o[1], vb, pa0, pa1, pa2, pa3); pv_one<2>(o[2], vb, pa0, pa1, pa2, pa3); pv_one<3>(o[3], vb, pa0, pa1, pa2, pa3);
}
__device__ __forceinline__ void glds16(const void* gsrc, unsigned lds_dst) { unsigned keep;
  asm volatile("s_mov_b32 %0, m0\n\ts_mov_b32 m0, %2\n\ts_nop 0\n\tglobal_load_lds_dwordx4 %1, off\n\ts_mov_b32 m0, %0" : "=&s"(keep) : "v"(gsrc), "s"(lds_dst) : "memory"); }
template <bool FAST>
__device__ __forceinline__ bool attn_map(const bf16* __restrict__ Kh, const bf16* __restrict__ Vh, const bf16* __restrict__ Qh  , int seq, char* V_lds, char* K_lds, float* ws_base,
                                         f32x16 (&o)[4], float& l_out) {
    int tid = threadIdx.x; asm volatile("" : "+v"(tid));
    const int wid = __builtin_amdgcn_readfirstlane(tid >> 6), r32 = tid & 31, hi = (tid >> 5) & 1;
    float* al_l = ws_base + wid * 64 + 32;
    const bf16* Qw = Qh + (long)(wid * QBLK + r32) * LDR + hi * 8;
    const int lane_ = tid & 63;
    const unsigned lds0 = (unsigned)(uintptr_t)V_lds;
    const bf16 *vsrc0, *vsrc1, *ksrc;
    { const int o0 = (2 * wid) * 1024 + 16 * lane_, o1 = o0 + 1024, ok = wid * 1024 + 16 * lane_;
      auto vmap = [](int o, int& k, int& c) { const int sub = o >> 9, w = o & 511, kk = ((sub >> 2) << 3) | (w >> 6); k = (kk & ~0xC) | ((kk & 4) << 1) | ((kk & 8) >> 1); c = (sub & 3) * 32 + ((w & 63) >> 1); };
      int k0_, c0_, k1_, c1_; vmap(o0, k0_, c0_); vmap(o1, k1_, c1_);
      vsrc0 = Vh + (long)k0_ * LDR + c0_; vsrc1 = Vh + (long)k1_ * LDR + c1_;
      const int row = ok >> 7, cb = (ok & 127) ^ (((row >> 1) & 7) << 4);
      ksrc = Kh + (long)row * LDR + (cb >> 1); }
    const int vb0 = (int)(uintptr_t)V_lds + v_rd_base(tid & 63);
    float m_reg = -1e30f, l_reg = 0; bf16x8 qr[4]; bool ovf = false;
#pragma unroll
    for (int d0 = 0; d0 < 4; ++d0) { o[d0] = f32x16{}; qr[d0] = *reinterpret_cast<const bf16x8*>(Qw + d0 * 16); }
#define DMA_TILE(t, b) do { const long ro_ = (long)(t) * KVBLK * LDR; \
      glds16(vsrc0 + ro_, (unsigned)__builtin_amdgcn_readfirstlane(lds0 + (b) * SHM_V + (2 * wid) * 1024)); \
      glds16(vsrc1 + ro_, (unsigned)__builtin_amdgcn_readfirstlane(lds0 + (b) * SHM_V + (2 * wid + 1) * 1024)); \
      glds16(ksrc + ro_, (unsigned)__builtin_amdgcn_readfirstlane(lds0 + 3 * SHM_V + (b) * SHM_K + wid * 1024)); } while (0)
#define DMA_WAIT() asm volatile("s_waitcnt vmcnt(0)" ::: "memory")
#define RESC(a) do { if constexpr (!FAST) { if (__any((a) < 1.f)) { if (hi == 0) al_l[r32] = (a); asm volatile("s_waitcnt lgkmcnt(0)" ::: "memory"); \
    _Pragma("unroll") for (int d = 0; d < 4; ++d) _Pragma("unroll") for (int r = 0; r < 16; ++r) o[d][r] *= al_l[crow(r, hi)]; } } } while (0)
#define PSM(P0, P1, MN, AL) do { if constexpr (FAST) exp_half(P0); else partialSM(P0, P1, m_reg, MN, AL); } while (0)
#define FSM(P0, P1, AL) do { if constexpr (FAST) finishSM_fast(P0, P1, l_reg, ovf, pa0, pa1, pa2, pa3); else finishSM(P0, P1, AL, l_reg, pa0, pa1, pa2, pa3); } while (0)
#define STEP(PN0, PN1, MNN, ALN, PO0, PO1, ALO, jj) do { \
      SBAR(); if constexpr (FAST) qkt_ref(PN0, PN1, K_lds + bc * SHM_K, qr, negm, r32, hi); else qkt(PN0, PN1, K_lds + bc * SHM_K, qr, r32, hi); \
      if ((jj) + 1 < NT) DMA_TILE((jj) + 1, bn);              \
      FSM(PO0, PO1, ALO); SBAR(); \
      pv_d0(o, vb0 + bp * SHM_V, pa0, pa1, pa2, pa3); PSM(PN0, PN1, MNN, ALN); RESC(ALN); \
      DMA_WAIT(); __syncthreads(); \
      bp = bc; bc = bn; bn = (bn == 2) ? 0 : bn + 1; } while (0)
    f32x16 pA0, pA1, pB0, pB1; float mnA = 0.f, mnB = 0.f, alA = 1.f, alB = 1.f; bf16x8 pa0, pa1, pa2, pa3; const int NT = seq / KVBLK;
    DMA_TILE(0, 0); DMA_WAIT(); __syncthreads();
    if (1 < NT) DMA_TILE(1, 1);
    qkt(pA0, pA1, K_lds, qr, r32, hi); partialSM(pA0, pA1, m_reg, mnA, alA);
    f32x16 negm = f32x16{};
    if constexpr (FAST) {
#pragma unroll
      for (int r = 0; r < 16; ++r) negm[r] = -m_reg;
      asm volatile("" : "+v"(negm));
    }
    DMA_WAIT(); __syncthreads();
    int bp = 0, bc = 1, bn = 2;
    for (int j = 1; j + 1 < NT; j += 2) {
      STEP(pB0, pB1, mnB, alB, pA0, pA1, alA, j);
      STEP(pA0, pA1, mnA, alA, pB0, pB1, alB, j + 1);
    }
    STEP(pB0, pB1, mnB, alB, pA0, pA1, alA, NT - 1);
    FSM(pB0, pB1, alB); SBAR();
    pv_d0(o, vb0 + bp * SHM_V, pa0, pa1, pa2, pa3);
#undef DMA_TILE
#undef DMA_WAIT
#undef RESC
#undef PSM
#undef FSM
#undef STEP
    l_out = l_reg;
    return ovf;
}
__device__ __forceinline__ void attn_unit(const bf16* __restrict__ qkv, long Qrow0, long Krow0, int vh, int seq, float lam, float oscale, const float* __restrict__ subln,
                                          bf16* __restrict__ Ob, int ldo, float* stash, char* lds) {
  int tid = threadIdx.x; asm volatile("" : "+v"(tid));
  const int wid = __builtin_amdgcn_readfirstlane(tid >> 6), lane = tid & 63, r32 = lane & 31, hi = lane >> 5;
  char* V_lds = lds; char* K_lds = lds + 3 * SHM_V;
  float* wsb = (float*)(lds + 3 * SHM_V + 3 * SHM_K); float* li_l = wsb + wid * 64;
  volatile unsigned* ovw = (volatile unsigned*)(lds + 3 * SHM_V + 3 * SHM_K + NW * 64 * 4);
  const bf16* Vh = qkv + Krow0 * LDR + 2048 + vh * DV;
  for (int s = 0; s < 2; ++s) {
    const int head = 2 * vh + s;
    const bf16* Kh = qkv + Krow0 * LDR + 1024 + head * DQ;
    const bf16* Qh = qkv + Qrow0 * LDR + head * DQ;
    f32x16 o[4]; float l_reg;
    const bool ovf = attn_map<true>(Kh, Vh, Qh, seq, V_lds, K_lds, wsb, o, l_reg);
    if (lane == 0) ovw[wid] = __any(ovf) ? 1u : 0u;
    __syncthreads();
    unsigned anyovf = 0u;
#pragma unroll
    for (int w = 0; w < NW; ++w) anyovf |= ovw[w];
    __syncthreads();
    if (__builtin_amdgcn_readfirstlane(anyovf) != 0u) (void)attn_map<false>(Kh, Vh, Qh, seq, V_lds, K_lds, wsb, o, l_reg);
    if (hi == 0) li_l[r32] = l_reg; asm volatile("s_waitcnt lgkmcnt(0)" ::: "memory");
    float rli[16];
#pragma unroll
    for (int r = 0; r < 16; ++r) rli[r] = __builtin_amdgcn_rcpf(li_l[crow(r, hi)]);
    typedef float f32x4_t __attribute__((ext_vector_type(4)));
    f32x4_t* st4 = (f32x4_t*)stash + (size_t)tid * 16;
    if (s == 0) {
#pragma unroll
      for (int d0 = 0; d0 < 4; ++d0)
#pragma unroll
        for (int r4 = 0; r4 < 4; ++r4) { f32x4_t v; v[0] = o[d0][4 * r4] * rli[4 * r4]; v[1] = o[d0][4 * r4 + 1] * rli[4 * r4 + 1]; v[2] = o[d0][4 * r4 + 2] * rli[4 * r4 + 2]; v[3] = o[d0][4 * r4 + 3] * rli[4 * r4 + 3]; st4[d0 * 4 + r4] = v; }
    } else {
      f32x4_t svp[16];
#pragma unroll
      for (int i = 0; i < 16; ++i) svp[i] = st4[i];
      asm volatile("s_waitcnt vmcnt(0)" ::: "memory");
      float ssq[16];
#pragma unroll
      for (int r = 0; r < 16; ++r) ssq[r] = 0.f;
#pragma unroll
      for (int d0 = 0; d0 < 4; ++d0)
#pragma unroll
        for (int r4 = 0; r4 < 4; ++r4) { const f32x4_t sv = svp[d0 * 4 + r4];
#pragma unroll
          for (int i = 0; i < 4; ++i) { const int r = 4 * r4 + i; const float v = sv[i] - lam * (o[d0][r] * rli[r]); o[d0][r] = v; ssq[r] += v * v; } }
#pragma unroll
      for (int r = 0; r < 16; ++r) {
        float a = ssq[r];
        a += sx<1>(a); a += sx<2>(a); a += sx<4>(a); a += sx<8>(a); a += sx<16>(a);
        ssq[r] = oscale / sqrtf(a * (1.0f / 128.0f) + 1e-6f);
      }
      float g[4];
#pragma unroll
      for (int d0 = 0; d0 < 4; ++d0) g[d0] = subln[d0 * 32 + r32];
      bf16* stg = (bf16*)(lds + SHM_ATTN) + wid * (QBLK * DV);
      unsigned so = (unsigned)((4 * hi) * DV + r32); asm volatile("" : "+v"(so));
#pragma unroll
      for (int r = 0; r < 16; ++r) {
#pragma unroll
        for (int d0 = 0; d0 < 4; ++d0) { const unsigned w = cvtpk(o[d0][r] * ssq[r] * g[d0], 0.f); (stg + ((r & 3) + 8 * (r >> 2)) * DV + d0 * 32)[so] = (bf16)(w & 0xffffu); } }
      asm volatile("s_waitcnt lgkmcnt(0)" ::: "memory");
      int ldo_ = ldo; asm volatile("" : "+s"(ldo_));
      bf16* Ow = Ob + (long)(wid * QBLK) * ldo_;
      const int srow = lane >> 4, sch = lane & 15;
#pragma unroll
      for (int i = 0; i < 8; ++i) { const int row = i * 4 + srow; const u32x4 v = *(const u32x4*)(stg + row * DV + sch * 8); *(u32x4*)(Ow + (long)row * ldo_ + sch * 8) = v; }
    }
  }
}
#undef SBAR
}
#define GAS __attribute__((address_space(1)))
#define LAS __attribute__((address_space(3)))
typedef unsigned short bf16;
typedef unsigned v4u __attribute__((ext_vector_type(4)));
typedef float f32x4 __attribute__((ext_vector_type(4)));
typedef short bf16x8 __attribute__((ext_vector_type(8)));
typedef GAS unsigned gu32;
typedef GAS unsigned long long gu64;
#define RLX_AGENT __ATOMIC_RELAXED, __HIP_MEMORY_SCOPE_AGENT
#define LDS_WAIT() asm volatile("s_waitcnt lgkmcnt(0)" ::: "memory")
#define VM_WAIT() asm volatile("s_waitcnt vmcnt(0)" ::: "memory")
__device__ __forceinline__ unsigned long long rt() { return __builtin_amdgcn_s_memrealtime(); }
__device__ __forceinline__ unsigned f2bf(float f) { unsigned u = __builtin_bit_cast(unsigned, f); return (u + 0x7fffu + ((u >> 16) & 1u)) >> 16; }
__device__ __forceinline__ unsigned pk2(float lo, float hi) { unsigned r; asm("v_cvt_pk_bf16_f32 %0, %1, %2" : "=v"(r) : "v"(lo), "v"(hi)); return r; }

#define XB_TMO      128
#define XB_XCNT(j)  (256  + 64 * (j))
#define XB_XSUB(j)  (1280 + 64 * (j))
#define XB_XGEN(j)  (2304 + 64 * (j))
#define XB_TOP      3328
#define XB_TOPGEN   3392
#define XCD_BAR_WORDS 3456
#define XB_SPIN_CAP (1u << 18)

__device__ __forceinline__ unsigned xb_ld(unsigned* p)              { return __hip_atomic_load(p, __ATOMIC_RELAXED, __HIP_MEMORY_SCOPE_AGENT); }
__device__ __forceinline__ unsigned xb_add(unsigned* p, unsigned v) { return __hip_atomic_fetch_add(p, v, __ATOMIC_RELAXED, __HIP_MEMORY_SCOPE_AGENT); }
__device__ __forceinline__ unsigned xb_xcc_id() { return (unsigned)__builtin_amdgcn_s_getreg((3 << 11) | 20) & 0xFu; }
#define XB_SPIN(cond, bar) do { unsigned _sp = 0; while (cond) { __builtin_amdgcn_s_sleep(1); \
    if ((++_sp & 255u) == 0u) { if (xb_ld(&(bar)[XB_TMO])) break; if (_sp > XB_SPIN_CAP) { atomicAdd(&(bar)[XB_TMO], 1u); break; } } } } while (0)

struct XcdBarrier {
    unsigned* bar; unsigned x;
    volatile LAS unsigned* st;
};

__device__ __forceinline__ XcdBarrier xcd_barrier_post(unsigned* bar, volatile LAS unsigned* st) {
    XcdBarrier b; b.bar = bar; b.x = xb_xcc_id(); b.st = st;
    if (threadIdx.x == 0) (void)xb_add(&bar[XB_XCNT(b.x)], 1u);
    return b;
}
__device__ __forceinline__ void xcd_barrier_complete(unsigned* bar, unsigned x, unsigned& nloc, unsigned& nx) {
    const unsigned G = gridDim.x * gridDim.y * gridDim.z;
    unsigned sum, cnt, mine, sp = 0u;
    for (;;) {
        sum = 0u; cnt = 0u; mine = 0u;
#pragma unroll
        for (unsigned j = 0; j < 16; ++j) { const unsigned c = xb_ld(&bar[XB_XCNT(j)]); sum += c; cnt += (c > 0u) ? 1u : 0u; mine = (j == x) ? c : mine; }
        if (sum == G) break;
        __builtin_amdgcn_s_sleep(1);
        if ((++sp & 255u) == 0u) { if (xb_ld(&bar[XB_TMO])) break; if (sp > XB_SPIN_CAP) { atomicAdd(&bar[XB_TMO], 1u); break; } }
    }
    nloc = mine > 0u ? mine : 1u; nx = cnt > 0u ? cnt : 1u;
}

__device__ __forceinline__ void xcd_barrier(const XcdBarrier& b) {
    asm volatile("s_waitcnt vmcnt(0)" ::: "memory");
    __syncthreads();
    if (threadIdx.x == 0) {
        unsigned* bar = b.bar;
        __builtin_amdgcn_s_waitcnt(0);
        unsigned nloc = b.st[0], nx = b.st[1];
        if (nloc == 0u) { xcd_barrier_complete(bar, b.x, nloc, nx); b.st[0] = nloc; b.st[1] = nx; }
        const unsigned old = xb_add(&bar[XB_XSUB(b.x)], 1u);
        const unsigned gen = old / nloc;
        if (old + 1u == (gen + 1u) * nloc) {
            __builtin_amdgcn_fence(__ATOMIC_RELEASE, "agent");
            asm volatile("s_waitcnt vmcnt(0)" ::: "memory");
            const unsigned og = xb_add(&bar[XB_TOP], 1u);
            const unsigned tg = og / nx;
            if (og + 1u == (tg + 1u) * nx) xb_add(&bar[XB_TOPGEN], 1u);
            else XB_SPIN(xb_ld(&bar[XB_TOPGEN]) == tg, bar);
            __builtin_amdgcn_fence(__ATOMIC_ACQUIRE, "agent");
            xb_add(&bar[XB_XGEN(b.x)], 1u);
            asm volatile("s_waitcnt vmcnt(0)" ::: "memory");
        } else {
            XB_SPIN(xb_ld(&bar[XB_XGEN(b.x)]) == gen, bar);
            __builtin_amdgcn_fence(__ATOMIC_ACQUIRE, "agent");
            asm volatile("s_waitcnt vmcnt(0)" ::: "memory");
        }
    }
    __syncthreads();
}
#define HYD __device__ __forceinline__
#define HYDM __device__ __forceinline__
#define HY_DEVICE 1
#ifdef HY_DEVICE
#define HY_OPAQUE(x) asm volatile("" : "+v"(x))
#else
#define HY_OPAQUE(x) (void)(x)
#endif
typedef float cf __attribute__((ext_vector_type(2)));
typedef float cf2 __attribute__((ext_vector_type(4)));
template <class P> struct HyP2 {};
template <> struct HyP2<cf*> { typedef cf2* type; };
#ifdef HY_DEVICE
template <> struct HyP2<__attribute__((address_space(3))) cf*> { typedef __attribute__((address_space(3))) cf2* type; };
#endif
HYD cf cf_add(cf a, cf b) { return a + b; }
HYD cf cf_sub(cf a, cf b) { return a - b; }
HYD cf cf_mul(cf a, cf b) { return cf{a.x * b.x - a.y * b.y, a.x * b.y + a.y * b.x}; }
HYD cf cf_mulc(cf a, cf b) { return cf{a.x * b.x + a.y * b.y, a.y * b.x - a.x * b.y}; }
constexpr int FN = 16384, FT = 512, FLOG = 14, FNP = FN + 4 * (FN >> 6);
constexpr int SEQL = 8192;
HYD int HP(int i) { return i + ((i >> 6) << 2); }
#define HY_C1 0.92387953251128674f
#define HY_S1 0.38268343236508977f
#define HY_R2 0.70710678118654752f
template <int M16> HYD cf mul_root16(cf w) {
    if (M16 == 0) return w;
    if (M16 == 4) return cf{w.y, -w.x};
    if (M16 == 2) return cf{(w.x + w.y) * HY_R2, (w.y - w.x) * HY_R2};
    if (M16 == 6) return cf{(w.y - w.x) * HY_R2, -(w.x + w.y) * HY_R2};
    if (M16 == 1) return cf_mul(w, cf{HY_C1, -HY_S1});
    if (M16 == 3) return cf_mul(w, cf{HY_S1, -HY_C1});
    if (M16 == 5) return cf_mul(w, cf{-HY_S1, -HY_C1});
    return cf_mul(w, cf{-HY_C1, -HY_S1});
}
template <int Q, int U, bool INV, bool ZUP, bool HLO> struct HyStage {
    static HYDM void run(cf (&e)[1 << Q], const cf (&tw)[Q]) {
        constexpr int R = 1 << Q, half = R >> (U + 1);
#pragma unroll
        for (int k = 0; k < R; ++k) {
            if ((k & half) == 0) {
                const int kp = k & (half - 1);
                cf w = tw[U];
                switch (kp * 16 / (2 * half)) {
                    case 0: break;
                    case 1: w = mul_root16<1>(w); break;
                    case 2: w = mul_root16<2>(w); break;
                    case 3: w = mul_root16<3>(w); break;
                    case 4: w = mul_root16<4>(w); break;
                    case 5: w = mul_root16<5>(w); break;
                    case 6: w = mul_root16<6>(w); break;
                    default: w = mul_root16<7>(w); break;
                }
                if (!INV) {
                    if (ZUP && U == 0) { e[k + half] = cf_mul(e[k], w); }
                    else { const cf a = e[k], b = e[k + half]; e[k] = cf_add(a, b); e[k + half] = cf_mul(cf_sub(a, b), w); }
                } else {
                    const cf a = e[k], b = cf_mulc(e[k + half], w); e[k] = cf_add(a, b);
                    if (!(HLO && U == 0)) e[k + half] = cf_sub(a, b);
                }
            }
        }
    }
};
template <int Q, bool INV, bool ZUP, bool HLO> HYD void hy_bfly(cf (&e)[1 << Q], cf t) {
    cf tw[Q]; tw[0] = t;
#pragma unroll
    for (int u = 1; u < Q; ++u) tw[u] = cf_mul(tw[u - 1], tw[u - 1]);
    if (Q == 4) {
        if (!INV) { HyStage<Q, 0, INV, ZUP, HLO>::run(e, tw); HyStage<Q, 1, INV, ZUP, HLO>::run(e, tw); HyStage<Q, 2 % Q, INV, ZUP, HLO>::run(e, tw); HyStage<Q, 3 % Q, INV, ZUP, HLO>::run(e, tw); }
        else      { HyStage<Q, 3 % Q, INV, ZUP, HLO>::run(e, tw); HyStage<Q, 2 % Q, INV, ZUP, HLO>::run(e, tw); HyStage<Q, 1, INV, ZUP, HLO>::run(e, tw); HyStage<Q, 0, INV, ZUP, HLO>::run(e, tw); }
    } else {
        if (!INV) { HyStage<Q, 0, INV, ZUP, HLO>::run(e, tw); HyStage<Q, 1, INV, ZUP, HLO>::run(e, tw); }
        else      { HyStage<Q, 1, INV, ZUP, HLO>::run(e, tw); HyStage<Q, 0, INV, ZUP, HLO>::run(e, tw); }
    }
}
#ifdef HY_DEVICE
#define HY_MULT(T, X, Y) "v_pk_mul_f32 " T ", " X ", " Y " op_sel:[1,1] op_sel_hi:[1,0]\n\t"
#define HY_FMAP(R, X, Y, T) "v_pk_fma_f32 " R ", " X ", " Y ", " T " op_sel_hi:[0,1,1] neg_lo:[0,0,1]\n\t"
#define HY_FMAC(R, X, Y, T) "v_pk_fma_f32 " R ", " X ", " Y ", " T " op_sel_hi:[0,1,1] neg_hi:[1,0,0]\n\t"
#define HY_ADD(R, A, B) "v_pk_add_f32 " R ", " A ", " B "\n\t"
#define HY_SUB(R, A, B) "v_pk_add_f32 " R ", " A ", " B " neg_lo:[0,1] neg_hi:[0,1]\n\t"
HYD void hy_cmul2(cf& r0, cf x0, cf y0, cf& r1, cf x1, cf y1) { cf t0, t1;
    asm(HY_MULT("%0", "%4", "%5") HY_MULT("%1", "%6", "%7") HY_FMAP("%2", "%4", "%5", "%0") HY_FMAP("%3", "%6", "%7", "%1")
        : "=&v"(t0), "=&v"(t1), "=&v"(r0), "=&v"(r1) : "v"(x0), "v"(y0), "v"(x1), "v"(y1)); }
HYD cf hy_cmul1(cf x, cf y) { cf t, r;
    asm(HY_MULT("%0", "%2", "%3") "s_nop 0\n\t" HY_FMAP("%1", "%2", "%3", "%0") : "=&v"(t), "=&v"(r) : "v"(x), "v"(y)); return r; }
HYD void hy_bf2_fwd(cf& a0, cf& b0, cf w0, cf& a1, cf& b1, cf w1) { cf d0, d1, t0, t1;
    asm(HY_SUB("%4", "%0", "%1") HY_ADD("%0", "%0", "%1") HY_SUB("%5", "%2", "%3") HY_ADD("%2", "%2", "%3")
        HY_MULT("%6", "%4", "%8") HY_MULT("%7", "%5", "%9") HY_FMAP("%1", "%4", "%8", "%6") HY_FMAP("%3", "%5", "%9", "%7")
        : "+v"(a0), "+v"(b0), "+v"(a1), "+v"(b1), "=&v"(d0), "=&v"(d1), "=&v"(t0), "=&v"(t1) : "v"(w0), "v"(w1)); }
HYD void hy_bf2_fwdz(cf a0, cf& b0, cf w0, cf a1, cf& b1, cf w1) { hy_cmul2(b0, a0, w0, b1, a1, w1); }
HYD void hy_bf2_inv(cf& a0, cf& b0, cf w0, cf& a1, cf& b1, cf w1) { cf t0, t1;
    asm(HY_MULT("%4", "%1", "%6") HY_MULT("%5", "%3", "%7") HY_FMAC("%4", "%1", "%6", "%4") HY_FMAC("%5", "%3", "%7", "%5")
        HY_SUB("%1", "%0", "%4") HY_SUB("%3", "%2", "%5") HY_ADD("%0", "%0", "%4") HY_ADD("%2", "%2", "%5")
        : "+v"(a0), "+v"(b0), "+v"(a1), "+v"(b1), "=&v"(t0), "=&v"(t1) : "v"(w0), "v"(w1)); }
HYD void hy_bf2_invl(cf& a0, cf b0, cf w0, cf& a1, cf b1, cf w1) { cf t0, t1;
    asm(HY_MULT("%2", "%4", "%6") HY_MULT("%3", "%5", "%7") HY_FMAC("%2", "%4", "%6", "%2") HY_FMAC("%3", "%5", "%7", "%3")
        HY_ADD("%0", "%0", "%2") HY_ADD("%1", "%1", "%3")
        : "+v"(a0), "+v"(a1), "=&v"(t0), "=&v"(t1) : "v"(b0), "v"(b1), "v"(w0), "v"(w1)); }
HYD cf hy_rot(cf w) { cf r; asm("v_pk_add_f32 %0, %1, 0 op_sel:[1,0] op_sel_hi:[0,0] neg_hi:[1,0]" : "=v"(r) : "v"(w)); return r; }
#else
HYD void hy_cmul2(cf& r0, cf x0, cf y0, cf& r1, cf x1, cf y1) { const cf p0 = cf_mul(x0, y0), p1 = cf_mul(x1, y1); r0 = p0; r1 = p1; }
HYD cf hy_cmul1(cf x, cf y) { return cf_mul(x, y); }
HYD void hy_bf2_fwd(cf& a0, cf& b0, cf w0, cf& a1, cf& b1, cf w1) { const cf d0 = cf_sub(a0, b0), d1 = cf_sub(a1, b1); a0 = cf_add(a0, b0); a1 = cf_add(a1, b1); b0 = cf_mul(d0, w0); b1 = cf_mul(d1, w1); }
HYD void hy_bf2_fwdz(cf a0, cf& b0, cf w0, cf a1, cf& b1, cf w1) { b0 = cf_mul(a0, w0); b1 = cf_mul(a1, w1); }
HYD void hy_bf2_inv(cf& a0, cf& b0, cf w0, cf& a1, cf& b1, cf w1) { const cf p0 = cf_mulc(b0, w0), p1 = cf_mulc(b1, w1); b0 = cf_sub(a0, p0); b1 = cf_sub(a1, p1); a0 = cf_add(a0, p0); a1 = cf_add(a1, p1); }
HYD void hy_bf2_invl(cf& a0, cf b0, cf w0, cf& a1, cf b1, cf w1) { a0 = cf_add(a0, cf_mulc(b0, w0)); a1 = cf_add(a1, cf_mulc(b1, w1)); }
HYD cf hy_rot(cf w) { return cf{w.y, -w.x}; }
#endif
template <int U, bool INV, bool ZUP, bool HLO> HYD void hy_stage16(cf (&e)[16], const cf* W) {
    constexpr int half = 8 >> U;
#pragma unroll
    for (int j = 0; j < 8; j += 2) {
        const int k0 = ((j / half) * 2 * half) + (j % half), k1 = (((j + 1) / half) * 2 * half) + ((j + 1) % half);
        const cf w0 = W[k0 & (half - 1)], w1 = W[k1 & (half - 1)];
        if (!INV) { if (ZUP && U == 0) hy_bf2_fwdz(e[k0], e[k0 + half], w0, e[k1], e[k1 + half], w1); else hy_bf2_fwd(e[k0], e[k0 + half], w0, e[k1], e[k1 + half], w1); }
        else { if (HLO && U == 0) hy_bf2_invl(e[k0], e[k0 + half], w0, e[k1], e[k1 + half], w1); else hy_bf2_inv(e[k0], e[k0 + half], w0, e[k1], e[k1 + half], w1); }
    }
}
template <bool INV, bool ZUP, bool HLO> HYD void hy_bfly16(cf (&e)[16], cf t) {
    cf W0[8], W1[4], W2[2], W3[1], tw1, tw2;
    cf k1 = cf{HY_C1, -HY_S1}, k2 = cf{HY_R2, -HY_R2}, k3 = cf{HY_S1, -HY_C1};
    W0[0] = t;
    hy_cmul2(W0[1], t, k1, W0[3], t, k3);
    hy_cmul2(W0[2], t, k2, tw1, t, t);
    W1[0] = tw1;
    hy_cmul2(W1[1], tw1, k2, tw2, tw1, tw1);
    W2[0] = tw2;
    W3[0] = hy_cmul1(tw2, tw2);
#pragma unroll
    for (int i = 0; i < 4; ++i) W0[4 + i] = hy_rot(W0[i]);
    W1[2] = hy_rot(W1[0]); W1[3] = hy_rot(W1[1]); W2[1] = hy_rot(W2[0]);
    if (!INV) { hy_stage16<0, INV, ZUP, HLO>(e, W0); hy_stage16<1, INV, ZUP, HLO>(e, W1); hy_stage16<2, INV, ZUP, HLO>(e, W2); hy_stage16<3, INV, ZUP, HLO>(e, W3); }
    else      { hy_stage16<3, INV, ZUP, HLO>(e, W3); hy_stage16<2, INV, ZUP, HLO>(e, W2); hy_stage16<1, INV, ZUP, HLO>(e, W1); hy_stage16<0, INV, ZUP, HLO>(e, W0); }
}
template <class PT> HYD cf hy_twid(PT thi, PT tlo, int e) { return hy_cmul1(thi[e >> 7], tlo[e & 127]); }
template <int S, bool INV, bool ZUP, bool HLO, class P, class PT>
HYD void hy_pass16(P X, PT thi, PT tlo, int tid) {
    constexpr int R = 16;
    constexpr int SP = (S >= 64) ? S + S / 16 : S;
    const int g0 = tid, g1 = tid + FT;
    const int lo0 = g0 & (S - 1), pb0 = HP((g0 / S) * S * R + lo0);
    const int lo1 = g1 & (S - 1), pb1 = HP((g1 / S) * S * R + lo1);
    cf e0[R], e1[R];
#pragma unroll
    for (int k = 0; k < R; ++k) { if (ZUP && k >= 8) e0[k] = cf{0.f, 0.f}; else e0[k] = X[pb0 + k * SP]; }
#pragma unroll
    for (int k = 0; k < R; ++k) { if (ZUP && k >= 8) e1[k] = cf{0.f, 0.f}; else e1[k] = X[pb1 + k * SP]; }
    const cf t0 = hy_twid(thi, tlo, lo0 * (FN / (R * S))), t1 = hy_twid(thi, tlo, lo1 * (FN / (R * S)));
    hy_bfly16<INV, ZUP, HLO>(e0, t0);
#pragma unroll
    for (int k = 0; k < R; ++k) { if (!(HLO && k >= 8)) X[pb0 + k * SP] = e0[k]; }
    hy_bfly16<INV, ZUP, HLO>(e1, t1);
#pragma unroll
    for (int k = 0; k < R; ++k) { if (!(HLO && k >= 8)) X[pb1 + k * SP] = e1[k]; }
}
typedef _Float16 hy_h2 __attribute__((ext_vector_type(2)));
HYD unsigned hy_pack_h2(float re, float im) { const hy_h2 v = {(_Float16)re, (_Float16)im}; return __builtin_bit_cast(unsigned, v); }
HYD cf hy_unpack_h2(unsigned u, float s) { const hy_h2 v = __builtin_bit_cast(hy_h2, u); return cf{(float)v.x * s, (float)v.y * s}; }
typedef unsigned hy_u4 __attribute__((ext_vector_type(4)));
template <bool INV> HYD void hy_r4(cf (&e)[4]) {
    if (!INV) {
        const cf a0 = e[0] + e[2], b0 = e[0] - e[2], a1 = e[1] + e[3], d = e[1] - e[3], b1 = cf{d.y, -d.x};
        e[0] = a0 + a1; e[1] = a0 - a1; e[2] = b0 + b1; e[3] = b0 - b1;
    } else {
        const cf a0 = e[0] + e[1], a1 = e[0] - e[1], a2 = e[2] + e[3], d = e[2] - e[3], b = cf{-d.y, d.x};
        e[0] = a0 + a2; e[2] = a0 - a2; e[1] = a1 + b; e[3] = a1 - b;
    }
}
template <bool INV, class P, class PK>
HYD void hy_pass4(P X, int tid, PK KM) {
    typedef typename HyP2<P>::type P2;
    const int w = tid >> 6, lane = tid & 63;
#pragma unroll 1
    for (int gb = 0; gb < 2; ++gb) {
        cf2 a[4], b[4]; hy_u4 kq[4];
        const int g0 = (gb * 8 + w) * 256 + lane;
#pragma unroll
        for (int u = 0; u < 4; ++u) { const int g = g0 + 64 * u; P2 X2 = (P2)(X + HP(4 * g)); a[u] = X2[0]; b[u] = X2[1];
            if (KM) { const unsigned gi = (unsigned)(4 * g) & 0x3fffu; kq[u] = *(const hy_u4*)(KM + gi); } }
#pragma unroll
        for (int u = 0; u < 4; ++u) { const int g = g0 + 64 * u; P2 X2 = (P2)(X + HP(4 * g));
            cf e[4] = {cf{a[u].x, a[u].y}, cf{a[u].z, a[u].w}, cf{b[u].x, b[u].y}, cf{b[u].z, b[u].w}};
            hy_r4<INV>(e);
            if (KM) { const float ks = 1.0f / (float)FN; cf q0, q1, q2, q3; hy_cmul2(q0, e[0], hy_unpack_h2(kq[u].x, ks), q1, e[1], hy_unpack_h2(kq[u].y, ks)); hy_cmul2(q2, e[2], hy_unpack_h2(kq[u].z, ks), q3, e[3], hy_unpack_h2(kq[u].w, ks)); e[0] = q0; e[1] = q1; e[2] = q2; e[3] = q3; }
            X2[0] = cf2{e[0].x, e[0].y, e[1].x, e[1].y}; X2[1] = cf2{e[2].x, e[2].y, e[3].x, e[3].y}; }
    }
}
HYD int hy_brev14(int p) {
    unsigned v = (unsigned)p;
    v = ((v >> 1) & 0x55555555u) | ((v & 0x55555555u) << 1);
    v = ((v >> 2) & 0x33333333u) | ((v & 0x33333333u) << 2);
    v = ((v >> 4) & 0x0F0F0F0Fu) | ((v & 0x0F0F0F0Fu) << 4);
    v = ((v >> 8) & 0x00FF00FFu) | ((v & 0x00FF00FFu) << 8);
    v = (v >> 16) | (v << 16);
    return (int)(v >> (32 - FLOG));
}
HYD float hy_bf2f(unsigned short b) { unsigned u = (unsigned)b << 16; float f; __builtin_memcpy(&f, &u, 4); return f; }
HYD unsigned hy_f2bf(float f) { unsigned u; __builtin_memcpy(&u, &f, 4); return (u + 0x7fffu + ((u >> 16) & 1u)) >> 16; }
template <class PR> HYD void hy_sconv2(PR rowj  , unsigned tid, int j, float w0, float w1, float w2, float b, float& u0, float& u1) {
    const unsigned d1 = rowj[tid];
    const unsigned d0r = (rowj - 1)[tid], d2r = (rowj + 1)[tid];
    const unsigned d0 = (j > 0 || tid > 0) ? d0r : 0u;
    const unsigned d2 = (j < 7 || tid < (unsigned)(FT - 1)) ? d2r : 0u;
    const float pm1 = hy_bf2f((unsigned short)(d0 >> 16)), p0 = hy_bf2f((unsigned short)(d1 & 0xffffu)), p1 = hy_bf2f((unsigned short)(d1 >> 16)), p2 = hy_bf2f((unsigned short)(d2 & 0xffffu));
    u0 = b + w0 * pm1 + w1 * p0 + w2 * p1;
    u1 = b + w0 * p0 + w1 * p1 + w2 * p2;
}
template <class P> HYD void hy_filter_step(P X, const unsigned short* taps, float delta, int tid) {
    typedef typename HyP2<P>::type P2;
    typedef unsigned u32x2h __attribute__((ext_vector_type(2)));
    u32x2h raw[SEQL / (4 * FT)][4];
    const float dscale = -delta * (1.4426950408889634f / (float)(SEQL - 1)); (void)dscale;
#pragma unroll
    for (int j = 0; j < SEQL / (4 * FT); ++j)
#pragma unroll
        for (int q = 0; q < 4; ++q) raw[j][q] = __builtin_nontemporal_load((const u32x2h*)(taps + (size_t)q * 1024 * SEQL + ((unsigned)(4 * (tid + FT * j)) & 0x1fffu)));
#pragma unroll
    for (int j = 0; j < SEQL / (4 * FT); ++j) {
        const int t = 4 * (tid + FT * j);
        cf2 a[4];
#pragma unroll
        for (int q = 0; q < 4; ++q) a[q] = cf2{hy_bf2f((unsigned short)(raw[j][q].x & 0xffffu)), hy_bf2f((unsigned short)(raw[j][q].x >> 16)), hy_bf2f((unsigned short)(raw[j][q].y & 0xffffu)), hy_bf2f((unsigned short)(raw[j][q].y >> 16))};
        cf2 dec;
#pragma unroll
#ifdef HY_DEVICE
        for (int e = 0; e < 4; ++e) dec[e] = __builtin_amdgcn_exp2f((float)(t + e) * dscale);
#else
        for (int e = 0; e < 4; ++e) dec[e] = expf(-((float)(t + e) * (1.0f / (float)(SEQL - 1))) * delta);
#endif
        const cf2 a0 = a[0] * dec, a1 = a[1] * dec, a2 = a[2] * dec, a3 = a[3] * dec;
        P2 Xf = (P2)(X + HP(t));
        if (t == 0) { Xf[0] = cf2{a0[0] + a1[0], a2[0] + a3[0], a0[1], a2[1]}; float z0 = 0.f; HY_OPAQUE(z0); X[HP(SEQL)] = cf{z0, z0}; }
        else Xf[0] = cf2{a0[0], a2[0], a0[1], a2[1]};
        Xf[1] = cf2{a0[2], a2[2], a0[3], a2[3]};
        const int pbk = HP(FN - t - 4);
        X[pbk + 1] = cf{a1[3], a3[3]}; X[pbk + 2] = cf{a1[2], a3[2]}; X[pbk + 3] = cf{a1[1], a3[1]};
        if (t > 0) X[HP(FN - t)] = cf{a1[0], a3[0]};
    }
}
template <class P> HYD void hy_sep_step(P X, unsigned* K1g, unsigned* K2g, int tid) {
    const float sc = 0.5f;
#pragma unroll 1
    for (int j0 = 0; j0 < FN / FT; j0 += 4) {
        cf a[4], b[4];
#pragma unroll
        for (int u = 0; u < 4; ++u) { const int p = tid + FT * (j0 + u);
            const int f = hy_brev14(p), q = hy_brev14((FN - f) & (FN - 1));
            a[u] = X[HP(p)]; b[u] = X[HP(q)]; }
#pragma unroll
        for (int u = 0; u < 4; ++u) { const int p = tid + FT * (j0 + u);
            const unsigned pi = (unsigned)p & 0x3fffu;
            K1g[pi] = hy_pack_h2((a[u].x + b[u].x) * sc, (a[u].y - b[u].y) * sc);
            K2g[pi] = hy_pack_h2((a[u].y + b[u].y) * sc, -(a[u].x - b[u].x) * sc); }
    }
}
template <class P> HYD void hy_load_step(P X, const unsigned* r0, const unsigned* r1, float w0, float w1, float w2, float b, float (&zr)[8][4], int tid) {
    typedef typename HyP2<P>::type P2;
#pragma unroll
    for (int j = 0; j < 8; ++j) {
        const int t = 2 * (tid + FT * j);
        hy_sconv2(r0 + FT * j, (unsigned)tid, j, w0, w1, w2, b, zr[j][0], zr[j][2]);
        hy_sconv2(r1 + FT * j, (unsigned)tid, j, w0, w1, w2, b, zr[j][1], zr[j][3]);
        *(P2)(X + HP(t)) = cf2{zr[j][0], zr[j][1], zr[j][2], zr[j][3]};
    }
}
template <class P> HYD void hy_gate1_step(P X, const unsigned* r0, const unsigned* r1, float w0, float w1, float w2, float b, float bias, float (&zr)[8][4], int tid) {
    typedef typename HyP2<P>::type P2;
#pragma unroll
    for (int j = 0; j < 8; ++j) {
        const int t = 2 * (tid + FT * j);
        float xa0, xa1, xb0, xb1;
        hy_sconv2(r0 + FT * j, (unsigned)tid, j, w0, w1, w2, b, xa0, xa1);
        hy_sconv2(r1 + FT * j, (unsigned)tid, j, w0, w1, w2, b, xb0, xb1);
        P2 xp = (P2)(X + HP(t));
        const cf2 y = *xp;
        zr[j][0] = xa0 * (y.x + zr[j][0] * bias); zr[j][1] = xb0 * (y.y + zr[j][1] * bias);
        zr[j][2] = xa1 * (y.z + zr[j][2] * bias); zr[j][3] = xb1 * (y.w + zr[j][3] * bias);
        *xp = cf2{zr[j][0], zr[j][1], zr[j][2], zr[j][3]};
    }
}
template <class P> HYD void hy_gate2_step(P X, const unsigned* r0, const unsigned* r1, float w0, float w1, float w2, float b, float bias, const float (&zr)[8][4], unsigned* out0, unsigned* out1, int tid) {
    typedef typename HyP2<P>::type P2;
#pragma unroll
    for (int j = 0; j < 8; ++j) {
        const int t = 2 * (tid + FT * j);
        float xa0, xa1, xb0, xb1;
        hy_sconv2(r0 + FT * j, (unsigned)tid, j, w0, w1, w2, b, xa0, xa1);
        hy_sconv2(r1 + FT * j, (unsigned)tid, j, w0, w1, w2, b, xb0, xb1);
        const cf2 y = *(P2)(X + HP(t));
        const float za0 = xa0 * (y.x + zr[j][0] * bias), zb0 = xb0 * (y.y + zr[j][1] * bias);
        const float za1 = xa1 * (y.z + zr[j][2] * bias), zb1 = xb1 * (y.w + zr[j][3] * bias);
        (out0 + FT * j)[(unsigned)tid] = hy_f2bf(za0) | (hy_f2bf(za1) << 16);
        (out1 + FT * j)[(unsigned)tid] = hy_f2bf(zb0) | (hy_f2bf(zb1) << 16);
    }
}
HYD float hy_sconv1(unsigned D0, unsigned D1, int t, float w0, float w1, float w2, float b, bool pad0, bool padL) {
    const unsigned sh = ((unsigned)(t - 1) & 1u) << 4;
#ifdef HY_DEVICE
    const unsigned lo = __builtin_amdgcn_alignbit(D1, D0, sh), hi = D1 >> sh;
#else
    const unsigned long long w = (((unsigned long long)D1 << 32) | D0) >> sh; const unsigned lo = (unsigned)w, hi = (unsigned)(w >> 32);
#endif
    float e0 = hy_bf2f((unsigned short)(lo & 0xffffu)), e1 = hy_bf2f((unsigned short)(lo >> 16)), e2 = hy_bf2f((unsigned short)(hi & 0xffffu));
    if (pad0 && t == 0) e0 = 0.f;
    if (padL && t == SEQL - 1) e2 = 0.f;
    return b + w0 * e0 + w1 * e1 + w2 * e2;
}
struct HyRaw { unsigned d[2][8][4]; };
HYD void hy_raw_load(HyRaw& R, const unsigned* r0, const unsigned* r1, int tid) {
#pragma unroll
    for (int r = 0; r < 2; ++r)
#pragma unroll
        for (int k = 0; k < 8; ++k) { const unsigned du = ((unsigned)(tid + FT * r + 1024 * k + 1) >> 1) & 0x1fffu;
            R.d[r][k][0] = __builtin_nontemporal_load(r0 - 1 + du); R.d[r][k][1] = __builtin_nontemporal_load(r0 + du); R.d[r][k][2] = __builtin_nontemporal_load(r1 - 1 + du); R.d[r][k][3] = __builtin_nontemporal_load(r1 + du); }
}
template <class P, class PT> HYD void hy_convA_fwd(P X, PT thi, PT tlo, int tid, const HyRaw& R, float w0, float w1, float w2, float b, cf (&zr)[2][8]) {
#pragma unroll
    for (int r = 0; r < 2; ++r) {
        const int i0 = tid + FT * r, pb = HP(i0);
        cf e[16];
#pragma unroll
        for (int k = 0; k < 8; ++k) { const int t = i0 + 1024 * k; const bool p0 = (r == 0 && k == 0), pL = (r == 1 && k == 7); e[k] = cf{hy_sconv1(R.d[r][k][0], R.d[r][k][1], t, w0, w1, w2, b, p0, pL), hy_sconv1(R.d[r][k][2], R.d[r][k][3], t, w0, w1, w2, b, p0, pL)}; zr[r][k] = e[k]; }
#pragma unroll
        for (int k = 8; k < 16; ++k) e[k] = cf{0.f, 0.f};
        hy_bfly16<false, true, false>(e, hy_twid(thi, tlo, i0));
#pragma unroll
        for (int k = 0; k < 16; ++k) X[pb + k * 1088] = e[k];
    }
}
template <bool LAST, class P, class PT> HYD void hy_gateA(P X, PT thi, PT tlo, int tid, const HyRaw& R, float w0, float w1, float w2, float b, float bias,
                                                           cf (&zr)[2][8], unsigned short* out0, unsigned short* out1) {
#pragma unroll
    for (int r = 0; r < 2; ++r) {
        const int i0 = tid + FT * r, pb = HP(i0);
        cf e[16];
#pragma unroll
        for (int k = 0; k < 16; ++k) e[k] = X[pb + k * 1088];
        const cf tw = hy_twid(thi, tlo, i0);
        hy_bfly16<true, false, true>(e, tw);
#pragma unroll
        for (int k = 0; k < 8; ++k) { const int t = i0 + 1024 * k;
            const bool p0 = (r == 0 && k == 0), pL = (r == 1 && k == 7);
            const float xa = hy_sconv1(R.d[r][k][0], R.d[r][k][1], t, w0, w1, w2, b, p0, pL), xb = hy_sconv1(R.d[r][k][2], R.d[r][k][3], t, w0, w1, w2, b, p0, pL);
            const cf z = cf{xa * (e[k].x + zr[r][k].x * bias), xb * (e[k].y + zr[r][k].y * bias)};
            if (LAST) {
#ifdef HY_DEVICE
                unsigned pk; asm("v_cvt_pk_bf16_f32 %0, %1, %2" : "=v"(pk) : "v"(z.x), "v"(z.y)); const unsigned ti = (unsigned)t & 0x1fffu; out0[ti] = (unsigned short)(pk & 0xffffu); out1[ti] = (unsigned short)(pk >> 16);
#else
                out0[t] = (unsigned short)hy_f2bf(z.x); out1[t] = (unsigned short)hy_f2bf(z.y);
#endif
            }
            else { zr[r][k] = z; e[k] = z; } }
        if (!LAST) {
#pragma unroll
            for (int k = 8; k < 16; ++k) e[k] = cf{0.f, 0.f};
            hy_bfly16<false, true, false>(e, tw);
#pragma unroll
            for (int k = 0; k < 16; ++k) X[pb + k * 1088] = e[k];
        }
    }
}
constexpr int NWAVES = 8, NTHR = NWAVES * 64;
constexpr int DM = 2048, SEQ = 8192, DEPTH = 4, NSEQ = 6, GSEQ = 2, NGRP = NSEQ / GSEQ, MG = GSEQ * SEQ;
constexpr int HYW = 1024, HYIN = 3072, QKVW = 3072, DFF = 5632, GU = 2 * DFF, FEMB = 33, FHID = 64;
constexpr float EPS = 1e-6f;
constexpr float QSCALE = 0.125f * 1.4426950408889634f;
constexpr size_t MiB = 1u << 20;
constexpr size_t WS_CTL = 0, CTL_ZERO_BYTES = 1 * MiB;
constexpr size_t SZ_WHY = (size_t)HYIN * DM * 2, SZ_WQKV = (size_t)QKVW * DM * 2, SZ_WOUT = (size_t)DM * DM * 2, SZ_WGU = (size_t)GU * DM * 2, SZ_WDN = (size_t)DM * DFF * 2;
constexpr size_t OFF_WHY = 0, OFF_WQKV = OFF_WHY + SZ_WHY, OFF_WOUT = OFF_WQKV + SZ_WQKV, OFF_WGU = OFF_WOUT + SZ_WOUT, OFF_WDN = OFF_WGU + SZ_WGU, SZ_WLAYER = OFF_WDN + SZ_WDN;
constexpr size_t WS_W = 1 * MiB;
constexpr size_t WS_ROPE = WS_W + DEPTH * SZ_WLAYER;
constexpr int KPAD = 256;
constexpr size_t WS_H3 = WS_ROPE + (size_t)SEQ * 32 * 8;
constexpr size_t WS_W4T = WS_H3 + (size_t)DEPTH * SEQ * KPAD * 2;
constexpr size_t WS_TAPS = WS_W4T + (size_t)DEPTH * 4096 * KPAD * 2;
constexpr size_t WS_FFTK = WS_TAPS + (size_t)4096 * SEQ * 2;
constexpr size_t WS_STASH = WS_FFTK + (size_t)256 * 2 * 16384 * 8;
constexpr size_t WS_XB = WS_STASH;
constexpr size_t WS_H = WS_XB + (size_t)MG * DM * 2;
constexpr size_t WS_ZT = WS_H + (size_t)MG * DM * 2;
constexpr size_t WS_PROJT = WS_ZT + (size_t)HYW * MG * 2;
constexpr size_t WS_QKV = WS_PROJT + (size_t)HYIN * MG * 2;
constexpr size_t WS_MIX = WS_PROJT;
constexpr size_t WS_FFH = WS_PROJT;
constexpr size_t WS_MIXIN = WS_QKV + (size_t)MG * QKVW * 2;
constexpr size_t WS_END = WS_MIXIN + (size_t)MG * DM * 2;
constexpr size_t SZ_TAPS = (size_t)4096 * SEQ * 2, WS_TAPS_X = WS_END, WS_END_X = WS_TAPS_X + (DEPTH - 1) * SZ_TAPS;
static_assert((size_t)MG * DFF * 2 <= (size_t)HYIN * MG * 2 + (size_t)MG * QKVW * 2, "FFH overlay fits PROJT|QKV");
static_assert(WS_W4T % 256 == 0 && WS_TAPS % 256 == 0 && WS_ROPE % 256 == 0 && WS_H3 % 256 == 0 && WS_FFTK % 256 == 0 && WS_XB % 256 == 0 && WS_H % 256 == 0 && SZ_WLAYER % 256 == 0, "alignment");
constexpr int CW_BAR = 4096;
constexpr int PH_PER_LAYER = 8, PH_PER_GROUP = 1 + DEPTH * PH_PER_LAYER, NPHASE = 1 + NGRP * PH_PER_GROUP;
constexpr int RING_OFF = 0, RING_BYTES = 131072;
constexpr int TAB_OFF = 139264;
constexpr int MISC_OFF = TAB_OFF + 4096;
constexpr int LDS_BYTES = 147456;
static_assert(MISC_OFF + 128 <= LDS_BYTES, "LDS map");
static_assert(att::SHM_ATTN_ALL <= MISC_OFF, "attention LDS fits below the control words");
#ifndef PROBE_DUP
#define PROBE_DUP 0
#endif
#ifndef MK_PER_PHASE
#define MK_PER_PHASE 0
#endif

struct Args { const float* in[30]; float* out; unsigned char* ws; int ph_lo, ph_hi, taps_all, pad; };
enum { I_XP = 0, I_XS, I_GMPRE, I_GMPOST, I_GFPRE, I_GFPOST, I_WIN, I_CONVW, I_CONVB, I_FW1, I_FB1, I_FF1, I_FW2, I_FB2, I_FF2, I_FW3, I_FB3, I_FF3, I_FW4,
       I_HBIAS, I_HNORM, I_LQ1, I_LK1, I_LQ2, I_LK2, I_SUBLN, I_WOUT, I_WGATE, I_WUP, I_WDOWN };

template <int K> __device__ __forceinline__ float swz_xor(float v) { return __builtin_bit_cast(float, __builtin_amdgcn_ds_swizzle(__builtin_bit_cast(int, v), (K << 10) | 0x1f)); }
__device__ __forceinline__ float wave_sum(float v) {
    v += swz_xor<1>(v); v += swz_xor<2>(v); v += swz_xor<4>(v); v += swz_xor<8>(v); v += swz_xor<16>(v);
    auto rr = __builtin_amdgcn_permlane32_swap(__float_as_uint(v), __float_as_uint(v), false, false);
    return __uint_as_float(rr[0]) + __uint_as_float(rr[1]);
}
__device__ __forceinline__ bf16* wt_dst_row(int kind, int n, bf16* d0, bf16* d1, int K) {
    if (kind == 0) return d0 + (size_t)n * K;
    if (kind == 1) { if (n < HYIN) return d0 + (size_t)n * K; int q = n - HYIN; if (q < 2048) { const int hb = q & ~63, i = q & 63; q = hb + (i < 32 ? 2 * i : 2 * (i - 32) + 1); } return d1 + (size_t)q * K; }
    if (kind == 4) return d0 + (size_t)n * KPAD;
    const int r = (n >> 7) * 256 + (n & 127) + (kind == 3 ? 128 : 0); return d0 + (size_t)r * K;
}
__device__ __forceinline__ void p0_transpose_item(const float* W, int K, int N, int kind, bf16* d0, bf16* d1, LAS float* scr, int item, int lane) {
    const int nblk = N / 32, kb = item / nblk, nb = item % nblk, k0 = 64 * kb, n0 = 32 * nb;
#pragma unroll 8
    for (int i = 0; i < 32; ++i) { const int kk = 2 * i + (lane >> 5); scr[kk * 33 + (lane & 31)] = __builtin_nontemporal_load(W + (size_t)(k0 + kk) * N + n0 + (lane & 31)); }
    LDS_WAIT(); asm volatile("" ::: "memory");
    const int c = lane & 7;
#pragma unroll
    for (int j = 0; j < 4; ++j) { const int n = (lane >> 3) + 8 * j; const LAS float* s = scr + (8 * c) * 33 + n;
        v4u o; o.x = pk2(s[0 * 33], s[1 * 33]); o.y = pk2(s[2 * 33], s[3 * 33]); o.z = pk2(s[4 * 33], s[5 * 33]); o.w = pk2(s[6 * 33], s[7 * 33]);
        *(GAS v4u*)(wt_dst_row(kind, n0 + n, d0, d1, K) + k0 + 8 * c) = o; }
    LDS_WAIT(); asm volatile("" ::: "memory");
}
__device__ __forceinline__ void sincos_red(double ang, float& s, float& c) {
    const double k = rint(ang * 0.15915494309189535); const float r = (float)(ang - k * 6.283185307179586);
    s = sinf(r); c = cosf(r);
}
#define GP(p) ((const float*)(const GAS float*)(p))
#define LAUNDER_TID(F) do { int t_ = (F).tid; asm volatile("" : "+v"(t_)); (F).tid = t_; (F).lane = t_ & 63; int z_ = 0; asm volatile("" : "+s"(z_)); (F).z = z_; unsigned long long w_ = (unsigned long long)(F).ws0; asm volatile("" : "+s"(w_)); (F).ws = (unsigned char*)(GAS unsigned char*)w_; int b_ = (F).bx0, v_ = (F).vcu0, g_ = (F).G0; asm volatile("" : "+s"(b_), "+s"(v_), "+s"(g_)); (F).bx = b_; (F).vcu = v_; (F).G = g_; } while (0)
struct Frame {
    LAS unsigned char* lds; volatile LAS unsigned* MISC; gu32* ctl;
    int tid, lane, wave, vcu, G, bx;
    int vcu0, G0, bx0;
    float* out; unsigned char* ws; unsigned char* ws0; int z;
};
__device__ __forceinline__ void p0_prologue(Frame& F, const Args& A) {
    LAS float* scr = (LAS float*)(F.lds + RING_OFF + F.wave * 16384);
    const int gw = F.vcu * NWAVES + F.wave, NGW = F.G * NWAVES;
    constexpr int I_IN = (DM / 64) * ((HYIN + QKVW) / 32), I_OUT = (DM / 64) * (DM / 32), I_G = (DM / 64) * (DFF / 32), I_D = (DFF / 64) * (DM / 32);
    constexpr int I_W4 = 4096 / 32;
    constexpr int PER_L = I_IN + I_OUT + 2 * I_G + I_D + I_W4;
    for (int it = gw; it < DEPTH * PER_L; it += NGW) {
        const int l = it / PER_L; int r = it % PER_L;
        unsigned char* wl = F.ws + WS_W + (size_t)l * SZ_WLAYER;
        if (r < I_IN) { p0_transpose_item(GP(A.in[I_WIN + F.z]) + (size_t)l * DM * (HYIN + QKVW), DM, HYIN + QKVW, 1, (bf16*)(wl + OFF_WHY), (bf16*)(wl + OFF_WQKV), scr, r, F.lane); continue; } r -= I_IN;
        if (r < I_OUT) { p0_transpose_item(GP(A.in[I_WOUT + F.z]) + (size_t)l * DM * DM, DM, DM, 0, (bf16*)(wl + OFF_WOUT), nullptr, scr, r, F.lane); continue; } r -= I_OUT;
        if (r < I_G) { p0_transpose_item(GP(A.in[I_WGATE + F.z]) + (size_t)l * DM * DFF, DM, DFF, 2, (bf16*)(wl + OFF_WGU), nullptr, scr, r, F.lane); continue; } r -= I_G;
        if (r < I_G) { p0_transpose_item(GP(A.in[I_WUP + F.z]) + (size_t)l * DM * DFF, DM, DFF, 3, (bf16*)(wl + OFF_WGU), nullptr, scr, r, F.lane); continue; } r -= I_G;
        if (r < I_D) { p0_transpose_item(GP(A.in[I_WDOWN + F.z]) + (size_t)l * DFF * DM, DFF, DM, 0, (bf16*)(wl + OFF_WDN), nullptr, scr, r, F.lane); continue; } r -= I_D;
        { bf16* w4t = (bf16*)(F.ws + WS_W4T) + (size_t)l * 4096 * KPAD;
          p0_transpose_item(GP(A.in[I_FW4 + F.z]) + (size_t)l * FHID * 4096, FHID, 4096, 4, w4t, nullptr, scr, r, F.lane);
          for (int e = F.lane; e < 32 * 24; e += 64) *(GAS v4u*)(w4t + (size_t)(32 * r + e / 24) * KPAD + 64 + 8 * (e % 24)) = (v4u){0u, 0u, 0u, 0u}; }
    }
    {
        float* cs = (float*)(F.ws + WS_ROPE);
        for (int e = F.vcu * NTHR + F.tid; e < SEQ * 32; e += F.G * NTHR) {
            const int t = e >> 5, p = e & 31;
            const double inv = exp(-9.210340371976184 * (double)(2 * p) / 64.0);
            float s, c; sincos_red((double)t * inv, s, c);
            cs[2 * e] = c; cs[2 * e + 1] = s;
        }
    }
    {
        bf16* h3b = (bf16*)(F.ws + WS_H3);
        LAS float* hb = (LAS float*)(F.lds + RING_OFF + F.wave * 16384);
        for (int task = gw; task < DEPTH * (SEQ / 64); task += NGW) {
            const int l = task / (SEQ / 64), t = (task % (SEQ / 64)) * 64 + F.lane;
            const float* w1 = GP(A.in[I_FW1 + F.z]) + (size_t)l * FEMB * FHID; const float* w2 = GP(A.in[I_FW2 + F.z]) + (size_t)l * FHID * FHID; const float* w3 = GP(A.in[I_FW3 + F.z]) + (size_t)l * FHID * FHID;
            hb[F.lane] = (float)t * (1.0f / (float)(SEQ - 1));
#pragma unroll 1
            for (int bi = 0; bi < 16; ++bi) { const double band = 1e-4 + (double)bi * ((15.0 - 1e-4) / 15.0);
                float s, c; sincos_red(6.283185307179586 * (double)t / (double)SEQ * band, s, c); hb[(1 + bi) * 64 + F.lane] = c; hb[(17 + bi) * 64 + F.lane] = -s; }
#pragma unroll 1
            for (int stage = 0; stage < 3; ++stage) {
                const float* w = stage == 0 ? w1 : (stage == 1 ? w2 : w3);
                const float* bb = (stage == 0 ? GP(A.in[I_FB1 + F.z]) : (stage == 1 ? GP(A.in[I_FB2 + F.z]) : GP(A.in[I_FB3 + F.z]))) + l * FHID;
                const float* ff = (stage == 0 ? GP(A.in[I_FF1 + F.z]) : (stage == 1 ? GP(A.in[I_FF2 + F.z]) : GP(A.in[I_FF3 + F.z]))) + l * FHID;
                const int nin = stage == 0 ? FEMB : FHID;
                typedef float f32x16_t __attribute__((ext_vector_type(16)));
                f32x16_t c0 = {}, c1 = {}, c2 = {}, c3 = {};
                LDS_WAIT();
#pragma unroll 1
                for (int i = 0; i < nin; ++i) { const float hv = hb[i * 64 + F.lane]; const f32x16_t* wr = (const f32x16_t*)(w + i * FHID);
                    c0 += wr[0] * hv; c1 += wr[1] * hv; c2 += wr[2] * hv; c3 += wr[3] * hv; }
                const f32x16_t* b16 = (const f32x16_t*)bb; const f32x16_t* f16 = (const f32x16_t*)ff;
                c0 = (c0 + b16[0]) * f16[0]; c1 = (c1 + b16[1]) * f16[1]; c2 = (c2 + b16[2]) * f16[2]; c3 = (c3 + b16[3]) * f16[3];
                if (stage < 2) {
#pragma unroll
                    for (int e = 0; e < 16; ++e) { hb[e * 64 + F.lane] = sinf(c0[e]); hb[(16 + e) * 64 + F.lane] = sinf(c1[e]); hb[(32 + e) * 64 + F.lane] = sinf(c2[e]); hb[(48 + e) * 64 + F.lane] = sinf(c3[e]); }
                } else {
                    GAS v4u* o = (GAS v4u*)(h3b + ((size_t)l * SEQ + t) * KPAD);
#pragma unroll
                    for (int q = 0; q < 2; ++q) { v4u w; w.x = pk2(sinf(c0[8 * q]), sinf(c0[8 * q + 1])); w.y = pk2(sinf(c0[8 * q + 2]), sinf(c0[8 * q + 3])); w.z = pk2(sinf(c0[8 * q + 4]), sinf(c0[8 * q + 5])); w.w = pk2(sinf(c0[8 * q + 6]), sinf(c0[8 * q + 7])); o[q] = w; }
#pragma unroll
                    for (int q = 0; q < 2; ++q) { v4u w; w.x = pk2(sinf(c1[8 * q]), sinf(c1[8 * q + 1])); w.y = pk2(sinf(c1[8 * q + 2]), sinf(c1[8 * q + 3])); w.z = pk2(sinf(c1[8 * q + 4]), sinf(c1[8 * q + 5])); w.w = pk2(sinf(c1[8 * q + 6]), sinf(c1[8 * q + 7])); o[2 + q] = w; }
#pragma unroll
                    for (int q = 0; q < 2; ++q) { v4u w; w.x = pk2(sinf(c2[8 * q]), sinf(c2[8 * q + 1])); w.y = pk2(sinf(c2[8 * q + 2]), sinf(c2[8 * q + 3])); w.z = pk2(sinf(c2[8 * q + 4]), sinf(c2[8 * q + 5])); w.w = pk2(sinf(c2[8 * q + 6]), sinf(c2[8 * q + 7])); o[4 + q] = w; }
#pragma unroll
                    for (int q = 0; q < 2; ++q) { v4u w; w.x = pk2(sinf(c3[8 * q]), sinf(c3[8 * q + 1])); w.y = pk2(sinf(c3[8 * q + 2]), sinf(c3[8 * q + 3])); w.z = pk2(sinf(c3[8 * q + 4]), sinf(c3[8 * q + 5])); w.w = pk2(sinf(c3[8 * q + 6]), sinf(c3[8 * q + 7])); o[6 + q] = w; }
#pragma unroll 1
                    for (int q = 8; q < 32; ++q) o[q] = (v4u){0u, 0u, 0u, 0u};
                }
            }
        }
    }
}
template <bool XSB>
__device__ __forceinline__ void norm_pass(Frame& F, const void* x_src, const bf16* add, const float* g_add, bf16* xb_dst, float* xf_dst, const float* g_out, bf16* h_dst) {
    const int gw = F.vcu * NWAVES + F.wave, NGW = F.G * NWAVES;
#define UNPK(q, lo, hi) do { lo = (f32x4){__uint_as_float((q).x << 16), __uint_as_float((q).x & 0xffff0000u), __uint_as_float((q).y << 16), __uint_as_float((q).y & 0xffff0000u)}; \
                             hi = (f32x4){__uint_as_float((q).z << 16), __uint_as_float((q).z & 0xffff0000u), __uint_as_float((q).w << 16), __uint_as_float((q).w & 0xffff0000u)}; } while (0)
#define PK8(lo, hi) (v4u){pk2((lo)[0], (lo)[1]), pk2((lo)[2], (lo)[3]), pk2((hi)[0], (hi)[1]), pk2((hi)[2], (hi)[3])}
    f32x4 gA[8], gO[8];
#pragma unroll
    for (int j = 0; j < 8; ++j) { gA[j] = (f32x4){0.f, 0.f, 0.f, 0.f}; gO[j] = (f32x4){0.f, 0.f, 0.f, 0.f}; }
    if (add) { const GAS f32x4* gr = (const GAS f32x4*)g_add + 2 * F.lane;
#pragma unroll
        for (int j = 0; j < 4; ++j) { gA[2 * j] = gr[128 * j]; gA[2 * j + 1] = gr[128 * j + 1]; } }
    if (h_dst) { const GAS f32x4* gr = (const GAS f32x4*)g_out + 2 * F.lane;
#pragma unroll
        for (int j = 0; j < 4; ++j) { gO[2 * j] = gr[128 * j]; gO[2 * j + 1] = gr[128 * j + 1]; } }
    v4u rq[4], rw[4]; f32x4 rf[8];
#pragma unroll
    for (int j = 0; j < 4; ++j) { rq[j] = (v4u){0u, 0u, 0u, 0u}; rw[j] = (v4u){0u, 0u, 0u, 0u}; }
#define NP_FETCH(m) do { \
        if (XSB) { const GAS v4u* xa_ = (const GAS v4u*)((const bf16*)x_src + (size_t)(m) * DM) + F.lane; _Pragma("unroll") for (int j = 0; j < 4; ++j) rq[j] = __builtin_nontemporal_load(xa_ + 64 * j); } \
        else { const GAS f32x4* xa_ = (const GAS f32x4*)((const float*)x_src + (size_t)(m) * DM) + 2 * F.lane; _Pragma("unroll") for (int j = 0; j < 4; ++j) { rf[2 * j] = __builtin_nontemporal_load(xa_ + 128 * j); rf[2 * j + 1] = __builtin_nontemporal_load(xa_ + 128 * j + 1); } } \
        if (add) { const GAS v4u* aa_ = (const GAS v4u*)(add + (size_t)(m) * DM) + F.lane; _Pragma("unroll") for (int j = 0; j < 4; ++j) rw[j] = __builtin_nontemporal_load(aa_ + 64 * j); } } while (0)
    if (gw < MG) NP_FETCH(gw);
    for (int m0 = gw; m0 < MG; m0 += NGW) {
        f32x4 va[8]; v4u wa[4];
        if (XSB) {
#pragma unroll
            for (int j = 0; j < 4; ++j) UNPK(rq[j], va[2 * j], va[2 * j + 1]);
        } else {
#pragma unroll
            for (int j = 0; j < 8; ++j) va[j] = rf[j];
        }
#pragma unroll
        for (int j = 0; j < 4; ++j) wa[j] = rw[j];
        if (m0 + NGW < MG) NP_FETCH(m0 + NGW);
        if (add) {
            float sa = 0.f;
#pragma unroll
            for (int j = 0; j < 4; ++j) { f32x4 a0, a1; UNPK(wa[j], a0, a1);
                sa += ((a0[0] * a0[0] + a0[1] * a0[1]) + (a0[2] * a0[2] + a0[3] * a0[3])) + ((a1[0] * a1[0] + a1[1] * a1[1]) + (a1[2] * a1[2] + a1[3] * a1[3])); }
            const float ra = 1.0f / sqrtf(wave_sum(sa) * (1.0f / DM) + EPS);
#pragma unroll
            for (int j = 0; j < 4; ++j) { f32x4 a0, a1; UNPK(wa[j], a0, a1);
                va[2 * j] = va[2 * j] + a0 * ra * gA[2 * j]; va[2 * j + 1] = va[2 * j + 1] + a1 * ra * gA[2 * j + 1]; }
        }
        if (xf_dst) { GAS f32x4* oa = (GAS f32x4*)(xf_dst + (size_t)m0 * DM) + 2 * F.lane;
#pragma unroll
            for (int j = 0; j < 4; ++j) { oa[128 * j] = va[2 * j]; oa[128 * j + 1] = va[2 * j + 1]; } }
        if (xb_dst) { GAS v4u* oa = (GAS v4u*)(xb_dst + (size_t)m0 * DM) + F.lane;
#pragma unroll
            for (int j = 0; j < 4; ++j) { const v4u w = PK8(va[2 * j], va[2 * j + 1]); oa[64 * j] = w;
                UNPK(w, va[2 * j], va[2 * j + 1]); } }
        if (h_dst) {
            float sa = 0.f;
#pragma unroll
            for (int j = 0; j < 8; ++j) sa += (va[j][0] * va[j][0] + va[j][1] * va[j][1]) + (va[j][2] * va[j][2] + va[j][3] * va[j][3]);
            const float ra = 1.0f / sqrtf(wave_sum(sa) * (1.0f / DM) + EPS);
            GAS v4u* ha = (GAS v4u*)(h_dst + (size_t)m0 * DM) + F.lane;
#pragma unroll
            for (int j = 0; j < 4; ++j) { const f32x4 oa0 = va[2 * j] * ra * gO[2 * j], oa1 = va[2 * j + 1] * ra * gO[2 * j + 1]; ha[64 * j] = PK8(oa0, oa1); }
        }
    }
#undef NP_FETCH
#undef UNPK
#undef PK8
}
typedef LAS cf* lcf;
template <bool ZUP> __device__ __forceinline__ void hy_fwd(lcf X, lcf thi, lcf tlo, int tid, const unsigned* KM) {
    if (ZUP) hy_pass16<1024, false, true, false>(X, thi, tlo, tid); else hy_pass16<1024, false, false, false>(X, thi, tlo, tid);
    __syncthreads();
    hy_pass16<64, false, false, false>(X, thi, tlo, tid);
    hy_pass16<4, false, false, false>(X, thi, tlo, tid);
    hy_pass4<false>(X, tid, KM); __syncthreads();
}
__device__ __forceinline__ void hy_inv(lcf X, lcf thi, lcf tlo, int tid) {
    const unsigned* nul = nullptr;
    hy_pass4<true>(X, tid, nul); __syncthreads();
    hy_pass16<4, true, false, false>(X, thi, tlo, tid); __syncthreads();
    hy_pass16<64, true, false, false>(X, thi, tlo, tid); __syncthreads();
    hy_pass16<1024, true, false, true>(X, thi, tlo, tid); __syncthreads();
}
__device__ __forceinline__ void hy_mid(lcf X, lcf thi, lcf tlo, int tid, const unsigned* KM) {
    const unsigned* nul = nullptr;
    hy_pass16<64, false, false, false>(X, thi, tlo, tid);
    hy_pass16<4, false, false, false>(X, thi, tlo, tid);
    hy_pass4<false>(X, tid, KM);
    hy_pass4<true>(X, tid, nul);
    hy_pass16<4, true, false, false>(X, thi, tlo, tid);
    hy_pass16<64, true, false, false>(X, thi, tlo, tid); __syncthreads();
}
__device__ __forceinline__ void hyena_phase(Frame& F, const Args& A, int l) {
    lcf X = (lcf)(F.lds + RING_OFF); lcf thi = (lcf)(F.lds + TAB_OFF); lcf tlo = thi + 128;
    const int tid = F.tid;
    if (tid < 256) { const int a = tid & 127; const double ang = -6.283185307179586 * (double)(tid < 128 ? 128 * a : a) / (double)FN; float s, c; sincos_red(ang, s, c); (tid < 128 ? thi : tlo)[a] = cf{c, s}; }
    unsigned* K1g = (unsigned*)(F.ws + WS_FFTK) + (size_t)F.bx * 2 * FN; unsigned* K2g = K1g + FN;
    const bf16* taps = (const bf16*)(F.ws + ((A.taps_all && l > 0) ? WS_TAPS_X + (size_t)(l - 1) * SZ_TAPS : WS_TAPS));
    const float* cw = GP(A.in[I_CONVW + F.z]) + (size_t)l * 3 * HYIN; const float* cb = GP(A.in[I_CONVB + F.z]) + (size_t)l * HYIN; const float* hb = GP(A.in[I_HBIAS + F.z]) + (size_t)l * 2 * HYW;
    const bf16* projT = (const bf16*)(F.ws + WS_PROJT); bf16* zT = (bf16*)(F.ws + WS_ZT);
    for (int c = F.vcu; c < HYW; c += F.G) {
        __syncthreads();
        const float delta = fabsf(-15.350567286626973f + (float)c * ((-3.0701134573253945f + 15.350567286626973f) / 1023.0f));
#define TIDX(v) int v = tid; asm volatile("" : "+v"(v))
        { TIDX(t_); hy_filter_step(X, taps + (size_t)c * SEQ, delta, t_); }
        const unsigned* rx1 = (const unsigned*)(projT + (size_t)c * MG); const unsigned* rx2 = (const unsigned*)(projT + (size_t)(HYW + c) * MG); const unsigned* rv = (const unsigned*)(projT + (size_t)(2 * HYW + c) * MG);
        HyRaw R;
        { TIDX(t_); hy_raw_load(R, rv, rv + SEQ / 2, t_); }
        __syncthreads();
        { TIDX(t_); hy_fwd<false>(X, thi, tlo, t_, nullptr); }
        { TIDX(t_); hy_sep_step(X, K1g, K2g, t_); }
        asm volatile("s_waitcnt vmcnt(0)" ::: "memory"); __syncthreads();
        cf zr[2][8];
        { TIDX(t_); hy_convA_fwd(X, thi, tlo, t_, R, cw[2 * HYW + c], cw[HYIN + 2 * HYW + c], cw[2 * HYIN + 2 * HYW + c], cb[2 * HYW + c], zr); }
        { TIDX(t_); hy_raw_load(R, rx1, rx1 + SEQ / 2, t_); }
        __syncthreads();
        { TIDX(t_); hy_mid(X, thi, tlo, t_, K1g); }
        { TIDX(t_); hy_gateA<false>(X, thi, tlo, t_, R, cw[c], cw[HYIN + c], cw[2 * HYIN + c], cb[c], hb[c], zr, (unsigned short*)nullptr, (unsigned short*)nullptr); }
        { TIDX(t_); hy_raw_load(R, rx2, rx2 + SEQ / 2, t_); }
        __syncthreads();
        { TIDX(t_); hy_mid(X, thi, tlo, t_, K2g); }
        unsigned short* zo = (unsigned short*)(zT + (size_t)c * MG);
        { TIDX(t_); hy_gateA<true>(X, thi, tlo, t_, R, cw[HYW + c], cw[HYIN + HYW + c], cw[2 * HYIN + HYW + c], cb[HYW + c], hb[HYW + c], zr, zo, zo + SEQ); }
#undef TIDX
    }
    __syncthreads();
}
__device__ __forceinline__ void hynorm_phase(Frame& F, const Args& A, int l) {
    constexpr int TB = 64;
    LAS unsigned char* tile = F.lds + RING_OFF; LAS float* red = (LAS float*)(F.lds + RING_OFF + TB * HYW * 2); LAS float* rinv = red + 8 * TB;
    const bf16* zT = (const bf16*)(F.ws + WS_ZT); bf16* mixin = (bf16*)(F.ws + WS_MIXIN); const float* gn = GP(A.in[I_HNORM + F.z]) + (size_t)l * HYW;
    const int tid = F.tid;
    for (int tb = F.vcu; tb < MG / TB; tb += F.G) {
        const int t0 = tb * TB; __syncthreads();
        float ps[8];
#pragma unroll
        for (int i = 0; i < 8; ++i) ps[i] = 0.f;
        const int k = tid & 7, crow = tid >> 3;
#pragma unroll
        for (int hb = 0; hb < 2; ++hb) {
            v4u w[8];
#pragma unroll
            for (int it = 0; it < 8; ++it) { const unsigned c = (unsigned)((hb * 8 + it) * 64 + crow) & 1023u; w[it] = __builtin_nontemporal_load((const GAS v4u*)(zT + (size_t)c * MG + (unsigned)(t0 + 8 * k))); }
#pragma unroll
            for (int it = 0; it < 8; ++it) { const int c = (hb * 8 + it) * 64 + crow;
                LAS unsigned short* d = (LAS unsigned short*)(tile + (8 * k) * 2048 + (((c >> 3) ^ k) << 4) + (c & 7) * 2);
                const unsigned ww[4] = {w[it].x, w[it].y, w[it].z, w[it].w};
#pragma unroll
                for (int i = 0; i < 4; ++i) { d[(2 * i) * 1024] = (unsigned short)(ww[i] & 0xffffu); d[(2 * i + 1) * 1024] = (unsigned short)(ww[i] >> 16);
                    const float a = __uint_as_float(ww[i] << 16), b = __uint_as_float(ww[i] & 0xffff0000u); ps[2 * i] += a * a; ps[2 * i + 1] += b * b; } }
        }
#pragma unroll
        for (int i = 0; i < 8; ++i) { float v = ps[i]; v += swz_xor<8>(v); v += swz_xor<16>(v);
            auto rr = __builtin_amdgcn_permlane32_swap(__float_as_uint(v), __float_as_uint(v), false, false); ps[i] = __uint_as_float(rr[0]) + __uint_as_float(rr[1]); }
        if ((F.lane >> 3) == 0) {
#pragma unroll
            for (int i = 0; i < 8; ++i) red[F.wave * TB + 8 * k + i] = ps[i]; }
        __syncthreads();
        if (tid < TB) { float s = 0.f;
#pragma unroll
            for (int w8 = 0; w8 < 8; ++w8) s += red[w8 * TB + tid];
            rinv[tid] = 1.0f / sqrtf(s * (1.0f / HYW) + EPS); }
        __syncthreads();
        const int cg = tid & 127;
        const f32x4 g0 = *(const f32x4*)(gn + 8 * cg), g1 = *(const f32x4*)(gn + 8 * cg + 4);
#pragma unroll 4
        for (int it = 0; it < 16; ++it) { const int tok = it * 4 + (tid >> 7); const float r = rinv[tok];
            const v4u q = *(const LAS v4u*)(tile + tok * 2048 + ((cg ^ (tok >> 3)) << 4));
            v4u o; o.x = pk2(__uint_as_float(q.x << 16) * r * g0[0], __uint_as_float(q.x & 0xffff0000u) * r * g0[1]); o.y = pk2(__uint_as_float(q.y << 16) * r * g0[2], __uint_as_float(q.y & 0xffff0000u) * r * g0[3]);
            o.z = pk2(__uint_as_float(q.z << 16) * r * g1[0], __uint_as_float(q.z & 0xffff0000u) * r * g1[1]); o.w = pk2(__uint_as_float(q.w << 16) * r * g1[2], __uint_as_float(q.w & 0xffff0000u) * r * g1[3]);
            *(GAS v4u*)(mixin + (size_t)(t0 + tok) * DM + 8 * cg) = o; }
    }
    __syncthreads();
}
__device__ __forceinline__ void attn_phase(Frame& F, const Args& A, int l, unsigned char* lds_generic) {
    const float li = 0.8f - 0.6f * expf(-0.3f * (float)l);
    float lam;
    { const int j = F.lane; const float a = GP(A.in[I_LQ1 + F.z])[l * 64 + j] * GP(A.in[I_LK1 + F.z])[l * 64 + j], b = GP(A.in[I_LQ2 + F.z])[l * 64 + j] * GP(A.in[I_LK2 + F.z])[l * 64 + j];
      lam = expf(wave_sum(a)) - expf(wave_sum(b)) + li; }
    const att::bf16* qkv = (const att::bf16*)(F.ws + WS_QKV); att::bf16* mixin = (att::bf16*)(F.ws + WS_MIXIN);
    float* stash = (float*)(F.ws + WS_H) + (size_t)F.bx * 64 * 512;
    const float* subln = GP(A.in[I_SUBLN + F.z]) + (size_t)l * 128;
    constexpr int NU = GSEQ * 8 * (SEQ / 256);
    for (int u = F.vcu; u < NU; u += F.G) {
        const int bvh = u >> 5, qb = u & 31, b = bvh >> 3, vh = bvh & 7;
        const long krow0 = (long)b * SEQ, qrow0 = krow0 + qb * 256;
        att::attn_unit(qkv, qrow0, krow0, vh, SEQ, lam, 1.0f - li, subln, mixin + (size_t)qrow0 * DM + HYW + vh * 128, DM, stash, (char*)lds_generic);
        __syncthreads();
    }
}
#ifndef PHMASK
#define PHMASK 511
#endif
__global__ void __launch_bounds__(NTHR, 2) hymba_fwd(Args args) {
    extern __shared__ __attribute__((aligned(16))) unsigned char lds[];
    Frame F;
    F.lds = (LAS unsigned char*)lds; F.MISC = (volatile LAS unsigned*)(F.lds + MISC_OFF);
    F.tid = threadIdx.x; F.lane = F.tid & 63; F.wave = __builtin_amdgcn_readfirstlane(F.tid >> 6);
    F.G = gridDim.x; { const int bx = blockIdx.x; F.vcu = (F.G % 8 == 0) ? (bx % 8) * (F.G / 8) + bx / 8 : bx; F.bx = bx; }
    F.vcu0 = F.vcu; F.G0 = F.G; F.bx0 = F.bx;
    F.ctl = (gu32*)(args.ws + WS_CTL); F.out = args.out; F.ws = args.ws; F.ws0 = args.ws; F.z = 0;
    for (int u = F.tid; u < (LDS_BYTES - MISC_OFF) / 4; u += NTHR) ((LAS unsigned*)(F.lds + MISC_OFF))[u] = 0u;
    __syncthreads();
    XcdBarrier bar; bar.bar = (unsigned*)(F.ctl + CW_BAR); bar.x = 0; bar.st = nullptr;
    if (!MK_PER_PHASE) bar = xcd_barrier_post((unsigned*)(F.ctl + CW_BAR), F.MISC + 8);
    const int lo = args.ph_lo, hi = args.ph_hi;
    int ph = 0;
#define IN_() (lo <= ph && ph < hi && ({ LAUNDER_TID(F); true; }))
#define DUP3(...) do { __VA_ARGS__; if (PROBE_DUP == 3) { __VA_ARGS__; } } while (0)
#define SEAM() do { if (!MK_PER_PHASE && lo <= ph && ph + 1 < hi) { XcdBarrier b_ = bar; { unsigned long long p_ = (unsigned long long)b_.bar; unsigned x_ = b_.x; asm volatile("" : "+s"(p_), "+s"(x_)); b_.bar = (unsigned*)(GAS unsigned*)p_; b_.x = x_; } \
        xcd_barrier(b_); if (PROBE_DUP == 7) xcd_barrier(b_); } ++ph; } while (0)
    if ((PHMASK & 1) && IN_()) { p0_prologue(F, args); if (PROBE_DUP == 4) p0_prologue(F, args); }
    SEAM();
#define Hb ((bf16*)(F.ws + WS_H))
#define XB ((bf16*)(F.ws + WS_XB))
#define projT ((bf16*)(F.ws + WS_PROJT))
#define qkv ((bf16*)(F.ws + WS_QKV))
#define mix ((bf16*)(F.ws + WS_MIX))
#define ffh ((bf16*)(F.ws + WS_FFH))
#define mixin ((bf16*)(F.ws + WS_MIXIN))
#define wl (F.ws + WS_W + (size_t)l * SZ_WLAYER)
#define xin ((g == 0) ? GP(args.in[I_XP + F.z]) : GP(args.in[I_XS + F.z]) + (size_t)(g - 1) * MG * DM)
#define xres ((float*)(GAS float*)args.out + (size_t)g * MG * DM)
    for (int g = 0; g < NGRP; ++g) {
        if ((PHMASK & 2) && IN_()) norm_pass<false>(F, xin, nullptr, nullptr, nullptr, nullptr, GP(args.in[I_GMPRE + F.z]), Hb);
        SEAM();
        for (int l = 0; l < DEPTH; ++l) {
            if ((PHMASK & 4) && IN_()) {
                { pg8::Gemm gm{(const bf16*)(wl + OFF_WHY), Hb, HYIN, MG, DM}; pg8::StaticOrder S; S.init(HYIN, MG, F.G, F.bx);
                  pg8::EpiPlain E{projT, MG};
                  DUP3(pg8::gemm_phase<pg8::EpiPlain, pg8::StaticOrder, true, true>(F.lds + RING_OFF, gm, S, E)); }
                if (g == 0 || !args.taps_all) { pg8::Gemm gm{(const bf16*)(F.ws + WS_W4T) + (size_t)l * 4096 * KPAD, (const bf16*)(F.ws + WS_H3) + (size_t)l * SEQ * KPAD, 4096, SEQ, KPAD}; pg8::StaticOrder S; S.init(4096, SEQ, F.G, F.bx);
                  pg8::EpiPlain E{(bf16*)(F.ws + ((args.taps_all && l > 0) ? WS_TAPS_X + (size_t)(l - 1) * SZ_TAPS : WS_TAPS)), SEQ};
                  DUP3(pg8::gemm_phase<pg8::EpiPlain, pg8::StaticOrder, true, true>(F.lds + RING_OFF, gm, S, E)); }
                { pg8::Gemm gm{Hb, (const bf16*)(wl + OFF_WQKV), MG, QKVW, DM}; pg8::StaticOrder S; S.init(MG, QKVW, F.G, F.bx);
                  pg8::EpiRope E{qkv, QKVW, (const float*)(F.ws + WS_ROPE), QSCALE};
                  DUP3(pg8::gemm_phase<pg8::EpiRope, pg8::StaticOrder, true, true>(F.lds + RING_OFF, gm, S, E)); }
            }
            SEAM();
            if (IN_()) { if (PHMASK & 8) hyena_phase(F, args, l); if (PROBE_DUP == 2) hyena_phase(F, args, l); if (PHMASK & 16) attn_phase(F, args, l, lds); if (PROBE_DUP == 1) attn_phase(F, args, l, lds); }
            SEAM();
            if ((PHMASK & 32) && IN_()) { hynorm_phase(F, args, l); if (PROBE_DUP == 4) hynorm_phase(F, args, l); }
            SEAM();
            if ((PHMASK & 64) && IN_()) { pg8::Gemm gm{mixin, (const bf16*)(wl + OFF_WOUT), MG, DM, DM}; pg8::StaticOrder S; S.init(MG, DM, F.G, F.bx);
                pg8::EpiPlain E{mix, DM};
                DUP3(pg8::gemm_phase<pg8::EpiPlain, pg8::StaticOrder, true, true>(F.lds + RING_OFF, gm, S, E)); }
            SEAM();
            if ((PHMASK & 2) && IN_()) { if (l == 0) norm_pass<false>(F, xin, mix, GP(args.in[I_GMPOST + F.z]) + (size_t)l * DM, XB, nullptr, GP(args.in[I_GFPRE + F.z]) + (size_t)l * DM, Hb);
                else norm_pass<true>(F, XB, mix, GP(args.in[I_GMPOST + F.z]) + (size_t)l * DM, XB, nullptr, GP(args.in[I_GFPRE + F.z]) + (size_t)l * DM, Hb); }
            SEAM();
            if ((PHMASK & 128) && IN_()) { pg8::Gemm gm{Hb, (const bf16*)(wl + OFF_WGU), MG, GU, DM}; pg8::StaticOrder S; S.init(MG, GU, F.G, F.bx);
                pg8::EpiSwiGLU E{ffh, DFF};
                DUP3(pg8::gemm_phase<pg8::EpiSwiGLU, pg8::StaticOrder, true, true>(F.lds + RING_OFF, gm, S, E)); }
            SEAM();
            if ((PHMASK & 256) && IN_()) { pg8::Gemm gm{ffh, (const bf16*)(wl + OFF_WDN), MG, DM, DFF}; pg8::StaticOrder S; S.init(MG, DM, F.G, F.bx);
                pg8::EpiPlain E{mixin, DM};
                DUP3(pg8::gemm_phase<pg8::EpiPlain, pg8::StaticOrder, true, true>(F.lds + RING_OFF, gm, S, E)); }
            SEAM();
            if ((PHMASK & 2) && IN_()) { if (l + 1 < DEPTH) norm_pass<true>(F, XB, mixin, GP(args.in[I_GFPOST + F.z]) + (size_t)l * DM, XB, nullptr, GP(args.in[I_GMPRE + F.z]) + (size_t)(l + 1) * DM, Hb);
                else norm_pass<true>(F, XB, mixin, GP(args.in[I_GFPOST + F.z]) + (size_t)l * DM, nullptr, xres, nullptr, nullptr); }
            SEAM();
        }
    }
#undef IN_
#undef SEAM
#undef Hb
#undef XB
#undef projT
#undef qkv
#undef mix
#undef ffh
#undef mixin
#undef wl
#undef xin
#undef xres
}

extern "C" void kernel_launch(void* const* d_in, const int* in_sizes, int n_in, void* d_out, int out_size, void* d_ws, size_t ws_size, hipStream_t stream) {
    static int grid = 0;
    if (grid == 0) {
        if (n_in != 30 || in_sizes[0] != 2 * SEQ * DM || in_sizes[1] != 4 * SEQ * DM || out_size != NSEQ * SEQ * DM || ws_size < WS_END) {
            fprintf(stderr, "kernel_launch: shape mismatch (n_in %d, out %d, ws %zu, need %zu)\n", n_in, out_size, ws_size, (size_t)WS_END); grid = -1; return; }
        int dev = 0, cus = 0;
        if (hipGetDevice(&dev) != hipSuccess || hipDeviceGetAttribute(&cus, hipDeviceAttributeMultiprocessorCount, dev) != hipSuccess) { grid = -1; return; }
        if (hipFuncSetAttribute((const void*)hymba_fwd, hipFuncAttributeMaxDynamicSharedMemorySize, LDS_BYTES) != hipSuccess) { fprintf(stderr, "kernel_launch: hipFuncSetAttribute failed\n"); grid = -1; return; }
        int per_cu = 0;
        if (hipOccupancyMaxActiveBlocksPerMultiprocessor(&per_cu, (const void*)hymba_fwd, NTHR, LDS_BYTES) != hipSuccess || per_cu < 1) fprintf(stderr, "kernel_launch: occupancy query says %d\n", per_cu);
        (void)hipGetLastError();
        grid = cus;
    }
    if (grid < 0) return;
    if (hipMemsetAsync((char*)d_ws + WS_CTL, 0, CTL_ZERO_BYTES, stream) != hipSuccess) return;
    Args a{};
    for (int i = 0; i < 30; ++i) a.in[i] = (const float*)d_in[i];
    a.out = (float*)d_out; a.ws = (unsigned char*)d_ws; a.taps_all = (ws_size >= WS_END_X) ? 1 : 0;
#if MK_PER_PHASE
    for (int p = 0; p < NPHASE; ++p) { a.ph_lo = p; a.ph_hi = p + 1; hipLaunchKernelGGL(hymba_fwd, dim3(grid), dim3(NTHR), LDS_BYTES, stream, a); }
#else
    a.ph_lo = 0; a.ph_hi = NPHASE;
    hipLaunchKernelGGL(hymba_fwd, dim3(grid), dim3(NTHR), LDS_BYTES, stream, a);
#endif
    const hipError_t le = hipPeekAtLastError();
    if (le != hipSuccess) fprintf(stderr, "kernel_launch: launch failed: %s\n", hipGetErrorName(le));
}
```

```cpp
#include <hip/hip_runtime.h>
#include <hip/hip_bf16.h>
#include <cstdio>
#include <cstdint>
#include <cmath>
namespace pg8 {
#define PG8_LAS __attribute__((address_space(3)))
typedef unsigned short bf16_t;
typedef short bf16x8 __attribute__((ext_vector_type(8)));
typedef float f32x4 __attribute__((ext_vector_type(4)));
typedef unsigned u32x4 __attribute__((ext_vector_type(4)));
constexpr int BM = 256, BK = 64, HALF = 128, HTB = HALF * BK * 2  , STAGE_BYTES = 8 * HTB, NXCD = 8, WGM = 8;

__host__ __device__ __forceinline__ int lds_byte(int r, int c) { const int st = (r >> 4) * 2 + (c >> 5), rr = r & 15, cc = c & 31, ob = rr * 64 + cc * 2; return st * 1024 + (ob ^ (((ob >> 9) & 1) << 5)); }
__host__ __device__ __forceinline__ void stage_rc(int b, int& R, int& C) { const int st = b / 1024, sb = b % 1024, swz = sb ^ (((sb >> 9) & 1) << 5); R = (st >> 1) * 16 + swz / 64; C = (st & 1) * 32 + (swz % 64) / 2; }
__host__ __device__ __forceinline__ int perm32(int rho) { const int n = rho >> 4, i = rho & 15; return 8 * (i >> 2) + 4 * n + (i & 3); }

struct Unit { int pm, pn; };
struct Gemm { const bf16_t* A; const bf16_t* Bt; int M, N, K; };

struct StaticOrder {
    int nM, nN, nwg, G, c;
    __host__ __device__ void init(int M, int N, int G_, int c_) { nM = M / BM; nN = N / BM; nwg = nM * nN; G = G_; c = c_; }
    __host__ __device__ bool next(int i, Unit& u) const {
        const long L = (long)i * G + c; if (L >= nwg) return false;
        int wgid = (int)L; { const int q = nwg / NXCD, r = nwg % NXCD, xcd = wgid % NXCD, off = wgid / NXCD; wgid = (xcd < r ? xcd * (q + 1) : r * (q + 1) + (xcd - r) * q) + off; }
        const int nig = WGM * nN, gid = wgid / nig, fm = gid * WGM, gsz = (nM - fm) < WGM ? (nM - fm) : WGM;
        u.pm = fm + ((wgid % nig) % gsz); u.pn = (wgid % nig) / gsz; return true;
    }
    __device__ __forceinline__ void a_ready(const Unit&) const {}
    __device__ __forceinline__ void done(const Unit&) const {}
};

__device__ __forceinline__ unsigned cvt_pk_bf16(float lo, float hi) { unsigned r; asm volatile("v_cvt_pk_bf16_f32 %0, %1, %2" : "=v"(r) : "v"(lo), "v"(hi)); return r; }
typedef float f32x2 __attribute__((ext_vector_type(2)));
struct EpiPlain {
    static constexpr bool PERM = true, AFTER_DRAIN = false;
    bf16_t* O; int ldc;
    __device__ __forceinline__ void operator()(const f32x4 (&acc)[2][2][4][2], const Unit& u, int wr, int wc, int fr, int fq) const {
        const int row0 = u.pm * BM + wr * 64 + fr, col0 = u.pn * BM + wc * 32 + 8 * fq;
#pragma unroll
        for (int ai = 0; ai < 2; ++ai)
#pragma unroll
            for (int m = 0; m < 4; ++m) { bf16_t* rowp = O + (size_t)(row0 + ai * HALF + m * 16) * ldc + col0;
#pragma unroll
                for (int bj = 0; bj < 2; ++bj) { const f32x4 v0 = acc[ai][bj][m][0], v1 = acc[ai][bj][m][1];
                    u32x4 w; w.x = cvt_pk_bf16(v0[0], v0[1]); w.y = cvt_pk_bf16(v0[2], v0[3]); w.z = cvt_pk_bf16(v1[0], v1[1]); w.w = cvt_pk_bf16(v1[2], v1[3]);
                    *(u32x4*)(rowp + bj * HALF) = w; } }
    }
};
struct EpiRope {
    static constexpr bool PERM = true, AFTER_DRAIN = false;
    bf16_t* O; int ldc; const float* cs; float qscale;
    __device__ __forceinline__ void operator()(const f32x4 (&acc)[2][2][4][2], const Unit& u, int wr, int wc, int fr, int fq) const {
        const int row0 = u.pm * BM + wr * 64 + fr, col0 = u.pn * BM + wc * 32 + 8 * fq;
        const bool rope = u.pn < 8; const float sc = u.pn < 4 ? qscale : 1.0f;
        const int p0 = 16 * (wc & 1) + 4 * fq;
        f32x4 tt[2][4][2];
#pragma unroll
        for (int ai = 0; ai < 2; ++ai)
#pragma unroll
            for (int m = 0; m < 4; ++m) { tt[ai][m][0] = (f32x4){1.f, 0.f, 1.f, 0.f}; tt[ai][m][1] = (f32x4){1.f, 0.f, 1.f, 0.f};
                if (rope) { const int row = row0 + ai * HALF + m * 16; const __attribute__((address_space(1))) float* tp = (const __attribute__((address_space(1))) float*)cs + ((size_t)(row & 8191) * 32 + p0) * 2;
                    tt[ai][m][0] = *(const __attribute__((address_space(1))) f32x4*)tp; tt[ai][m][1] = *(const __attribute__((address_space(1))) f32x4*)(tp + 4); } }
#pragma unroll
        for (int ai = 0; ai < 2; ++ai)
#pragma unroll
            for (int m = 0; m < 4; ++m) { const int row = row0 + ai * HALF + m * 16; bf16_t* rowp = O + (size_t)row * ldc + col0;
                const f32x4 t0 = tt[ai][m][0], t1 = tt[ai][m][1];
#pragma unroll
                for (int bj = 0; bj < 2; ++bj) { const f32x4 v0 = acc[ai][bj][m][0], v1 = acc[ai][bj][m][1];
                    f32x4 o0, o1;
                    o0[0] = (v0[0] * t0[0] - v0[1] * t0[1]) * sc; o0[1] = (v0[0] * t0[1] + v0[1] * t0[0]) * sc;
                    o0[2] = (v0[2] * t0[2] - v0[3] * t0[3]) * sc; o0[3] = (v0[2] * t0[3] + v0[3] * t0[2]) * sc;
                    o1[0] = (v1[0] * t1[0] - v1[1] * t1[1]) * sc; o1[1] = (v1[0] * t1[1] + v1[1] * t1[0]) * sc;
                    o1[2] = (v1[2] * t1[2] - v1[3] * t1[3]) * sc; o1[3] = (v1[2] * t1[3] + v1[3] * t1[2]) * sc;
                    u32x4 w; w.x = cvt_pk_bf16(o0[0], o0[1]); w.y = cvt_pk_bf16(o0[2], o0[3]); w.z = cvt_pk_bf16(o1[0], o1[1]); w.w = cvt_pk_bf16(o1[2], o1[3]);
                    *(u32x4*)(rowp + bj * HALF) = w; } }
    }
};
struct EpiSwiGLU {
    static constexpr bool PERM = true, AFTER_DRAIN = false;
    bf16_t* O; int ldc;
    static __device__ __forceinline__ float silu_mul(float g, float u) { return g * u * __builtin_amdgcn_rcpf(1.0f + __builtin_amdgcn_exp2f(-1.4426950408889634f * g)); }
    __device__ __forceinline__ void operator()(const f32x4 (&acc)[2][2][4][2], const Unit& u, int wr, int wc, int fr, int fq) const {
        const int row0 = u.pm * BM + wr * 64 + fr, col0 = u.pn * HALF + wc * 32 + 8 * fq;
#pragma unroll
        for (int ai = 0; ai < 2; ++ai)
#pragma unroll
            for (int m = 0; m < 4; ++m) { bf16_t* rowp = O + (size_t)(row0 + ai * HALF + m * 16) * ldc + col0;
                const f32x4 g0 = acc[ai][0][m][0], g1 = acc[ai][0][m][1], u0 = acc[ai][1][m][0], u1 = acc[ai][1][m][1];
                u32x4 w; w.x = cvt_pk_bf16(silu_mul(g0[0], u0[0]), silu_mul(g0[1], u0[1])); w.y = cvt_pk_bf16(silu_mul(g0[2], u0[2]), silu_mul(g0[3], u0[3]));
                w.z = cvt_pk_bf16(silu_mul(g1[0], u1[0]), silu_mul(g1[1], u1[1])); w.w = cvt_pk_bf16(silu_mul(g1[2], u1[2]), silu_mul(g1[3], u1[3]));
                *(u32x4*)rowp = w; }
    }
};
template <class Epi, class Sched, bool ALIGN_EPI = false, bool SP2 = false>
__device__ __forceinline__ void gemm_phase(PG8_LAS unsigned char* lds, const Gemm g, const Sched& S, const Epi& E) {
    int tid = threadIdx.x; asm volatile("" : "+v"(tid));
    const int wid = __builtin_amdgcn_readfirstlane(tid >> 6), lane = tid & 63, wr = wid >> 2, wc = wid & 3, fr = lane & 15, fq = lane >> 4;
    const int K = g.K, nt = K / BK;
    unsigned voffA[2], voffB[2];
#pragma unroll
    for (int i = 0; i < 2; ++i) { int R, C; stage_rc(tid * 16 + i * 8192, R, C); const int Rb = Epi::PERM ? ((R & ~31) + perm32(R & 31)) : R;
        voffA[i] = (unsigned)(R * K + C) * 2u; voffB[i] = (unsigned)(Rb * K + C) * 2u; }
    const size_t kstep = (size_t)(BK * 2);
    const size_t hstep = (size_t)HALF * K * 2;
    const size_t tstep = 2 * hstep;
    const unsigned ldsw = (unsigned)wid * 1024u;
    const int aoff = lds_byte(wr * 64 + fr, fq * 8), boff = lds_byte(wc * 32 + fr, fq * 8);
#define PG8_SA(b, h) (((b) * 2 + (h)) * HTB)
#define PG8_SB(b, h) ((4 + (b) * 2 + (h)) * HTB)
#define PG8_STAGE(bufoff, gbase, voff) do { _Pragma("unroll") for (int _i = 0; _i < 2; ++_i) \
        __builtin_amdgcn_global_load_lds((const unsigned*)((const char*)(gbase) + (voff)[_i]), (PG8_LAS unsigned*)(lds + (bufoff) + ldsw + _i * 8192), 16, 0, 0); } while (0)
#define PG8_LDA(dst, b, h) do { _Pragma("unroll") for (int m = 0; m < 4; ++m) _Pragma("unroll") for (int k = 0; k < 2; ++k) dst[m][k] = *(const PG8_LAS bf16x8*)(lds + PG8_SA(b, h) + aoff + m * 2048 + k * 1024); } while (0)
#define PG8_LDB(dst, b, h) do { _Pragma("unroll") for (int n = 0; n < 2; ++n) _Pragma("unroll") for (int k = 0; k < 2; ++k) dst[n][k] = *(const PG8_LAS bf16x8*)(lds + PG8_SB(b, h) + boff + n * 2048 + k * 1024); } while (0)
#define PG8_MMA(ai, bj, At, Bt) do { __builtin_amdgcn_s_setprio(1); _Pragma("unroll") for (int m = 0; m < 4; ++m) _Pragma("unroll") for (int n = 0; n < 2; ++n) _Pragma("unroll") for (int k = 0; k < 2; ++k) \
        acc[ai][bj][m][n] = __builtin_amdgcn_mfma_f32_16x16x32_bf16(Bt[n][k], At[m][k], acc[ai][bj][m][n], 0, 0, 0); __builtin_amdgcn_s_setprio(0); } while (0)
#define PG8_WAIT_V(n) asm volatile("s_waitcnt vmcnt(" #n ")" ::: "memory")
#define PG8_WAIT_L(n) asm volatile("s_waitcnt lgkmcnt(" #n ")" ::: "memory")
#define PG8_BAR __builtin_amdgcn_s_barrier()
#define PG8_SCHED __builtin_amdgcn_sched_barrier(0)
    Unit cur, nxt; int ui = 0;
    if (!S.next(0, cur)) return;
    f32x4 acc[2][2][4][2];
#pragma unroll
    for (int a = 0; a < 2; ++a)
#pragma unroll
        for (int b = 0; b < 2; ++b)
#pragma unroll
            for (int m = 0; m < 4; ++m)
#pragma unroll
                for (int n = 0; n < 2; ++n) acc[a][b][m][n] = (f32x4){0.f, 0.f, 0.f, 0.f};
    bf16x8 At[4][2], B0[2][2], B1[2][2];
    const char* cA = (const char*)g.A + (size_t)cur.pm * tstep; const char* cB = (const char*)g.Bt + (size_t)cur.pn * tstep;
    S.a_ready(cur);
    if constexpr (SP2) {
        PG8_STAGE(PG8_SB(0, 0), cB, voffB); PG8_STAGE(PG8_SB(0, 1), cB + hstep, voffB); PG8_STAGE(PG8_SA(0, 0), cA, voffA); PG8_STAGE(PG8_SA(0, 1), cA + hstep, voffA);
        if (wr == 1) PG8_BAR;
        PG8_WAIT_V(2); PG8_BAR;
        PG8_STAGE(PG8_SB(1, 0), cB + kstep, voffB); PG8_STAGE(PG8_SA(1, 0), cA + kstep, voffA); PG8_STAGE(PG8_SB(1, 1), cB + hstep + kstep, voffB);
        PG8_WAIT_V(6); PG8_BAR;
    } else {
        PG8_STAGE(PG8_SB(0, 0), cB, voffB); PG8_STAGE(PG8_SA(0, 0), cA, voffA); PG8_STAGE(PG8_SB(0, 1), cB + hstep, voffB); PG8_STAGE(PG8_SA(0, 1), cA + hstep, voffA);
        if (wr == 1) PG8_BAR;
        PG8_WAIT_V(4); PG8_BAR;
        PG8_STAGE(PG8_SB(1, 0), cB + kstep, voffB); PG8_STAGE(PG8_SA(1, 0), cA + kstep, voffA); PG8_STAGE(PG8_SB(1, 1), cB + hstep + kstep, voffB);
        PG8_WAIT_V(6); PG8_BAR;
    }
    for (;;) {
        const bool has_next = S.next(ui + 1, nxt);
        const char* nA = has_next ? (const char*)g.A + (size_t)nxt.pm * tstep : cA; const char* nB = has_next ? (const char*)g.Bt + (size_t)nxt.pn * tstep : cB;
        for (int t = 0; t < nt; t += 2) {
            const bool last = (t == nt - 2);
            const char* a1 = cA + (size_t)(t + 1) * kstep;
            const char* a2 = last ? nA : cA + (size_t)(t + 2) * kstep; const char* b2 = last ? nB : cB + (size_t)(t + 2) * kstep;
            const char* a3 = a2 + kstep; const char* b3 = b2 + kstep;
            if (last && has_next) S.a_ready(nxt);
            if constexpr (SP2) {
            PG8_LDB(B0, 0, 0); PG8_LDB(B1, 0, 1); PG8_SCHED; PG8_LDA(At, 0, 0); PG8_STAGE(PG8_SA(1, 1), a1 + hstep, voffA);
            PG8_WAIT_V(8); PG8_WAIT_L(0); PG8_BAR; PG8_MMA(0, 0, At, B0); PG8_MMA(0, 1, At, B1); PG8_BAR; PG8_SCHED;
            PG8_LDA(At, 0, 1); PG8_STAGE(PG8_SB(0, 0), b2, voffB); PG8_STAGE(PG8_SB(0, 1), b2 + hstep, voffB); PG8_STAGE(PG8_SA(0, 0), a2, voffA);
            PG8_WAIT_V(8); PG8_WAIT_L(0); PG8_BAR; PG8_MMA(1, 0, At, B0); PG8_MMA(1, 1, At, B1); PG8_BAR; PG8_SCHED;
            PG8_LDB(B0, 1, 0); PG8_LDB(B1, 1, 1); PG8_SCHED; PG8_LDA(At, 1, 0); PG8_STAGE(PG8_SA(0, 1), a2 + hstep, voffA);
            PG8_WAIT_V(8); PG8_WAIT_L(0); PG8_BAR; PG8_MMA(0, 0, At, B0); PG8_MMA(0, 1, At, B1); PG8_BAR; PG8_SCHED;
            PG8_LDA(At, 1, 1); PG8_STAGE(PG8_SB(1, 0), b3, voffB); PG8_STAGE(PG8_SB(1, 1), b3 + hstep, voffB); PG8_STAGE(PG8_SA(1, 0), a3, voffA);
            PG8_WAIT_V(8); PG8_WAIT_L(0); PG8_BAR; PG8_MMA(1, 0, At, B0); PG8_MMA(1, 1, At, B1); PG8_BAR; PG8_SCHED;
            } else {
            PG8_LDB(B0, 0, 0); PG8_SCHED; PG8_LDA(At, 0, 0); PG8_STAGE(PG8_SA(1, 1), a1 + hstep, voffA);
            PG8_WAIT_L(8); PG8_BAR; PG8_WAIT_L(0); PG8_MMA(0, 0, At, B0); PG8_BAR; PG8_SCHED;
            PG8_LDB(B1, 0, 1); PG8_STAGE(PG8_SB(0, 0), b2, voffB);
            PG8_BAR; PG8_WAIT_L(0); PG8_MMA(0, 1, At, B1); PG8_BAR;
            PG8_LDA(At, 0, 1); PG8_STAGE(PG8_SA(0, 0), a2, voffA);
            PG8_BAR; PG8_WAIT_L(0); PG8_MMA(1, 0, At, B0); PG8_BAR; PG8_SCHED;
            PG8_STAGE(PG8_SB(0, 1), b2 + hstep, voffB);
            PG8_WAIT_V(6); PG8_BAR; PG8_MMA(1, 1, At, B1); PG8_BAR;
            PG8_LDB(B0, 1, 0); PG8_SCHED; PG8_LDA(At, 1, 0); PG8_STAGE(PG8_SA(0, 1), a2 + hstep, voffA);
            PG8_WAIT_L(8); PG8_BAR; PG8_WAIT_L(0); PG8_MMA(0, 0, At, B0); PG8_BAR; PG8_SCHED;
            PG8_LDB(B1, 1, 1); PG8_STAGE(PG8_SB(1, 0), b3, voffB);
            PG8_BAR; PG8_WAIT_L(0); PG8_MMA(0, 1, At, B1); PG8_BAR;
            PG8_LDA(At, 1, 1); PG8_STAGE(PG8_SA(1, 0), a3, voffA);
            PG8_BAR; PG8_WAIT_L(0); PG8_MMA(1, 0, At, B0); PG8_BAR; PG8_SCHED;
            PG8_STAGE(PG8_SB(1, 1), b3 + hstep, voffB);
            PG8_WAIT_V(6); PG8_BAR; PG8_MMA(1, 1, At, B1); PG8_BAR;
            }
        }
        if constexpr (ALIGN_EPI) { if (wr == 0) PG8_BAR; }
        if constexpr (!Epi::AFTER_DRAIN) { E(acc, cur, wr, wc, fr, fq); S.done(cur); }
        if (!has_next) break;
#pragma unroll
        for (int a = 0; a < 2; ++a)
#pragma unroll
            for (int b = 0; b < 2; ++b)
#pragma unroll
                for (int m = 0; m < 4; ++m)
#pragma unroll
                    for (int n = 0; n < 2; ++n) acc[a][b][m][n] = (f32x4){0.f, 0.f, 0.f, 0.f};
        cur = nxt; cA = nA; cB = nB; ++ui;
        if constexpr (ALIGN_EPI) { if (wr == 1) PG8_BAR; }
    }
    PG8_WAIT_V(0);
    if constexpr (!ALIGN_EPI) { if (wr == 0) PG8_BAR; }
    PG8_BAR;
    if constexpr (Epi::AFTER_DRAIN) { E.fused(acc, cur, wr, wc, fr, fq, lds, wid, lane); S.done(cur); }
#undef PG8_SA
#undef PG8_SB
#undef PG8_STAGE
#undef PG8_LDA
#undef PG8_LDB
#undef PG8_MMA
#undef PG8_WAIT_V
#undef PG8_WAIT_L
#undef PG8_BAR
#undef PG8_SCHED
}
}
namespace att {
using bf16x8 = __attribute__((ext_vector_type(8))) short;
using s16x4  = __attribute__((ext_vector_type(4))) short;
using f32x16 = __attribute__((ext_vector_type(16))) float;
using u32x4  = __attribute__((ext_vector_type(4))) unsigned;
typedef unsigned short bf16;
constexpr int DQ = 64, DV = 128, NW = 8, QBLK = 32, KVBLK = 64, LDR = 3072;
constexpr int SHM_V = KVBLK * DV * 2, SHM_K = KVBLK * DQ * 2, SHM_ATTN = 3 * SHM_V + 3 * SHM_K + NW * 64 * 4 + 64;
constexpr int SHM_ATTN_ALL = SHM_ATTN + NW * QBLK * DV * 2;
#ifndef ATT_OVF_LIMIT
#define ATT_OVF_LIMIT 1.152921504606847e18f
#endif
#ifndef ATT_SDEPTH
#define ATT_SDEPTH 2
#endif
constexpr float THR2 = 11.0f;
#define KSWZ64(row, colB) ((row) * 128 + ((colB) ^ ((((row) >> 1) & 7) << 4)))
#define SBAR() __builtin_amdgcn_sched_barrier(0)
template <int K> __device__ __forceinline__ float sx(float v) { return __builtin_bit_cast(float, __builtin_amdgcn_ds_swizzle(__builtin_bit_cast(int, v), (K << 10) | 0x1f)); }
__device__ __forceinline__ int crow(int r, int hi) { return (r & 3) + 8 * (r >> 2) + 4 * hi; }
__device__ __forceinline__ unsigned cvtpk(float lo, float hi) { unsigned r; asm volatile("v_cvt_pk_bf16_f32 %0, %1, %2" : "=v"(r) : "v"(lo), "v"(hi)); return r; }
__device__ __forceinline__ void partialSM(f32x16& p0, f32x16& p1, float& m_reg, float& mn, float& alpha) {
  float pmax = p0[0];
#pragma unroll
  for (int r = 1; r < 16; ++r) pmax = fmaxf(pmax, p0[r]);
#pragma unroll
  for (int r = 0; r < 16; ++r) pmax = fmaxf(pmax, p1[r]);
  { auto rr = __builtin_amdgcn_permlane32_swap(__float_as_uint(pmax), __float_as_uint(pmax), false, false);
    pmax = fmaxf(__uint_as_float(rr[0]), __uint_as_float(rr[1])); }
  if (__builtin_expect(__all(pmax - m_reg <= THR2), 1)) { mn = m_reg; alpha = 1.f; }
  else { mn = fmaxf(m_reg, pmax); alpha = __builtin_amdgcn_exp2f(m_reg - mn); m_reg = mn; }
#pragma unroll
  for (int r = 0; r < 16; ++r) p0[r] = p0[r] - mn;
#pragma unroll
  for (int r = 0; r < 16; ++r) p1[r] = p1[r] - mn;
#pragma unroll
  for (int r = 0; r < 16; ++r) p0[r] = __builtin_amdgcn_exp2f(p0[r]);
}
__device__ __forceinline__ void finishSM(f32x16& p0, f32x16& p1, float alpha, float& l_reg, bf16x8& pa0, bf16x8& pa1, bf16x8& pa2, bf16x8& pa3) {
#pragma unroll
  for (int r = 0; r < 16; ++r) p1[r] = __builtin_amdgcn_exp2f(p1[r]);
  float ps = 0;
#pragma unroll
  for (int r = 0; r < 16; ++r) ps += p0[r];
#pragma unroll
  for (int r = 0; r < 16; ++r) ps += p1[r];
  { auto rr = __builtin_amdgcn_permlane32_swap(__float_as_uint(ps), __float_as_uint(ps), false, false);
    ps = __uint_as_float(rr[0]) + __uint_as_float(rr[1]); }
  l_reg = l_reg * alpha + ps;
#define PK4(P, BASE, OUT) do { unsigned a0 = cvtpk(P[BASE + 0], P[BASE + 1]), a1 = cvtpk(P[BASE + 2], P[BASE + 3]);   \
    unsigned b0 = cvtpk(P[BASE + 4], P[BASE + 5]), b1 = cvtpk(P[BASE + 6], P[BASE + 7]);                              \
    auto r0 = __builtin_amdgcn_permlane32_swap(a0, b0, false, false); auto r1 = __builtin_amdgcn_permlane32_swap(a1, b1, false, false); \
    u32x4 w = {r0[0], r1[0], r0[1], r1[1]}; OUT = *reinterpret_cast<bf16x8*>(&w); } while (0)
  PK4(p0, 0, pa0); PK4(p0, 8, pa1); PK4(p1, 0, pa2); PK4(p1, 8, pa3);
#undef PK4
}
__device__ __forceinline__ void qkt(f32x16& p0, f32x16& p1, const char* Ks, const bf16x8* qr, int r32, int hi) {
  p0 = f32x16{}; p1 = f32x16{};
#pragma unroll
  for (int d0 = 0; d0 < 4; ++d0) { const int cb = (d0 * 16 + hi * 8) * 2;
    bf16x8 b0 = *reinterpret_cast<const bf16x8*>(Ks + KSWZ64(r32, cb));
    bf16x8 b1 = *reinterpret_cast<const bf16x8*>(Ks + KSWZ64(32 + r32, cb));
    p0 = __builtin_amdgcn_mfma_f32_32x32x16_bf16(b0, qr[d0], p0, 0, 0, 0);
    p1 = __builtin_amdgcn_mfma_f32_32x32x16_bf16(b1, qr[d0], p1, 0, 0, 0); }
}
__device__ __forceinline__ void qkt_ref(f32x16& p0, f32x16& p1, const char* Ks, const bf16x8* qr, const f32x16& negm, int r32, int hi) {
#pragma unroll
  for (int d0 = 0; d0 < 4; ++d0) { const int cb = (d0 * 16 + hi * 8) * 2;
    bf16x8 b0 = *reinterpret_cast<const bf16x8*>(Ks + KSWZ64(r32, cb));
    bf16x8 b1 = *reinterpret_cast<const bf16x8*>(Ks + KSWZ64(32 + r32, cb));
    if (d0 == 0) { p0 = __builtin_amdgcn_mfma_f32_32x32x16_bf16(b0, qr[0], negm, 0, 0, 0); p1 = __builtin_amdgcn_mfma_f32_32x32x16_bf16(b1, qr[0], negm, 0, 0, 0); }
    else { p0 = __builtin_amdgcn_mfma_f32_32x32x16_bf16(b0, qr[d0], p0, 0, 0, 0); p1 = __builtin_amdgcn_mfma_f32_32x32x16_bf16(b1, qr[d0], p1, 0, 0, 0); } }
}
__device__ __forceinline__ void exp_half(f32x16& p) {
#pragma unroll
  for (int r = 0; r < 16; ++r) p[r] = __builtin_amdgcn_exp2f(p[r]);
}
__device__ __forceinline__ void sub_exp_half(f32x16& p0, f32x16& p1, float m) {
#pragma unroll
  for (int r = 0; r < 16; ++r) p0[r] = p0[r] - m;
#pragma unroll
  for (int r = 0; r < 16; ++r) p1[r] = p1[r] - m;
#pragma unroll
  for (int r = 0; r < 16; ++r) p0[r] = __builtin_amdgcn_exp2f(p0[r]);
}
__device__ __forceinline__ void finishSM_fast(f32x16& p0, f32x16& p1, float& l_reg, bool& ovf, bf16x8& pa0, bf16x8& pa1, bf16x8& pa2, bf16x8& pa3) {
  float al = 1.f; float l0 = 0.f;
  finishSM(p0, p1, al, l0, pa0, pa1, pa2, pa3);
  ovf = ovf || !(l0 < ATT_OVF_LIMIT);
  l_reg += l0;
}
__device__ __forceinline__ int v_st(int k, int c) { const int kk = (k & ~0xC) | ((k & 4) << 1) | ((k & 8) >> 1); return ((kk >> 3) * 4 + (c >> 5)) * 512 + ((kk & 7) * 32 + (c & 31)) * 2; }
__device__ __forceinline__ int v_rd_base(int lane) { return ((lane & 3) << 3) | (((lane >> 2) & 3) << 6) | (((lane >> 4) & 1) << 5) | (((lane >> 5) & 1) << 8); }
constexpr int v_rd_off(int d0, int ks, int half) { return d0 * 512 + ks * 4096 + half * 2048; }
template <int OFF> __device__ __forceinline__ s16x4 tr_read(int vb) {
  s16x4 r; asm volatile("ds_read_b64_tr_b16 %0, %1 offset:%2" : "=&v"(r) : "v"(vb), "i"(OFF) : "memory"); return r;
}
template <int D0> __device__ __forceinline__ void pv_one(f32x16& od, int vb, bf16x8 pa0, bf16x8 pa1, bf16x8 pa2, bf16x8 pa3) {
  const s16x4 l0 = tr_read<v_rd_off(D0, 0, 0)>(vb), h0 = tr_read<v_rd_off(D0, 0, 1)>(vb), l1 = tr_read<v_rd_off(D0, 1, 0)>(vb), h1 = tr_read<v_rd_off(D0, 1, 1)>(vb);
  const s16x4 l2 = tr_read<v_rd_off(D0, 2, 0)>(vb), h2 = tr_read<v_rd_off(D0, 2, 1)>(vb), l3 = tr_read<v_rd_off(D0, 3, 0)>(vb), h3 = tr_read<v_rd_off(D0, 3, 1)>(vb);
  asm volatile("s_waitcnt lgkmcnt(0)" ::: "memory"); SBAR();
#define PK(L, H) (bf16x8){L[0], L[1], L[2], L[3], H[0], H[1], H[2], H[3]}
  od = __builtin_amdgcn_mfma_f32_32x32x16_bf16(pa0, PK(l0, h0), od, 0, 0, 0);
  od = __builtin_amdgcn_mfma_f32_32x32x16_bf16(pa1, PK(l1, h1), od, 0, 0, 0);
  od = __builtin_amdgcn_mfma_f32_32x32x16_bf16(pa2, PK(l2, h2), od, 0, 0, 0);
  od = __builtin_amdgcn_mfma_f32_32x32x16_bf16(pa3, PK(l3, h3), od, 0, 0, 0);
#undef PK
}
__device__ __forceinline__ void pv_d0(f32x16* o, int vb, bf16x8 pa0, bf16x8 pa1, bf16x8 pa2, bf16x8 pa3) {
  pv_one<0>(o[0], vb, pa0, pa1, pa2, pa3); pv_one<1>(o[1], vb, pa0, pa1, pa2, pa3); pv_one<2>(o[2], vb, pa0, pa1, pa2, pa3); pv_one<3>(o[3], vb, pa0, pa1, pa2, pa3);
}
__device__ __forceinline__ void glds16(const void* gsrc, unsigned lds_dst) { unsigned keep;
  asm volatile("s_mov_b32 %0, m0\n\ts_mov_b32 m0, %2\n\ts_nop 0\n\tglobal_load_lds_dwordx4 %1, off\n\ts_mov_b32 m0, %0" : "=&s"(keep) : "v"(gsrc), "s"(lds_dst) : "memory"); }
template <bool FAST>
__device__ __forceinline__ bool attn_map(const bf16* __restrict__ Kh, const bf16* __restrict__ Vh, const bf16* __restrict__ Qh  , int seq, char* V_lds, char* K_lds, float* ws_base,
                                         f32x16 (&o)[4], float& l_out) {
    int tid = threadIdx.x; asm volatile("" : "+v"(tid));
    const int wid = __builtin_amdgcn_readfirstlane(tid >> 6), r32 = tid & 31, hi = (tid >> 5) & 1;
    float* al_l = ws_base + wid * 64 + 32;
    const bf16* Qw = Qh + (long)(wid * QBLK + r32) * LDR + hi * 8;
    const int lane_ = tid & 63;
    const unsigned lds0 = (unsigned)(uintptr_t)V_lds;
    const bf16 *vsrc0, *vsrc1, *ksrc;
    { const int o0 = (2 * wid) * 1024 + 16 * lane_, o1 = o0 + 1024, ok = wid * 1024 + 16 * lane_;
      auto vmap = [](int o, int& k, int& c) { const int sub = o >> 9, w = o & 511, kk = ((sub >> 2) << 3) | (w >> 6); k = (kk & ~0xC) | ((kk & 4) << 1) | ((kk & 8) >> 1); c = (sub & 3) * 32 + ((w & 63) >> 1); };
      int k0_, c0_, k1_, c1_; vmap(o0, k0_, c0_); vmap(o1, k1_, c1_);
      vsrc0 = Vh + (long)k0_ * LDR + c0_; vsrc1 = Vh + (long)k1_ * LDR + c1_;
      const int row = ok >> 7, cb = (ok & 127) ^ (((row >> 1) & 7) << 4);
      ksrc = Kh + (long)row * LDR + (cb >> 1); }
    const int vb0 = (int)(uintptr_t)V_lds + v_rd_base(tid & 63);
    float m_reg = -1e30f, l_reg = 0; bf16x8 qr[4]; bool ovf = false;
#pragma unroll
    for (int d0 = 0; d0 < 4; ++d0) { o[d0] = f32x16{}; qr[d0] = *reinterpret_cast<const bf16x8*>(Qw + d0 * 16); }
#define DMA_TILE(t, b) do { const long ro_ = (long)(t) * KVBLK * LDR; \
      glds16(vsrc0 + ro_, (unsigned)__builtin_amdgcn_readfirstlane(lds0 + (b) * SHM_V + (2 * wid) * 1024)); \
      glds16(vsrc1 + ro_, (unsigned)__builtin_amdgcn_readfirstlane(lds0 + (b) * SHM_V + (2 * wid + 1) * 1024)); \
      glds16(ksrc + ro_, (unsigned)__builtin_amdgcn_readfirstlane(lds0 + 3 * SHM_V + (b) * SHM_K + wid * 1024)); } while (0)
#define DMA_WAIT() asm volatile("s_waitcnt vmcnt(0)" ::: "memory")
#define RESC(a) do { if constexpr (!FAST) { if (__any((a) < 1.f)) { if (hi == 0) al_l[r32] = (a); asm volatile("s_waitcnt lgkmcnt(0)" ::: "memory"); \
    _Pragma("unroll") for (int d = 0; d < 4; ++d) _Pragma("unroll") for (int r = 0; r < 16; ++r) o[d][r] *= al_l[crow(r, hi)]; } } } while (0)
#define PSM(P0, P1, MN, AL) do { if constexpr (FAST) exp_half(P0); else partialSM(P0, P1, m_reg, MN, AL); } while (0)
#define FSM(P0, P1, AL) do { if constexpr (FAST) finishSM_fast(P0, P1, l_reg, ovf, pa0, pa1, pa2, pa3); else finishSM(P0, P1, AL, l_reg, pa0, pa1, pa2, pa3); } while (0)
#define STEP(PN0, PN1, MNN, ALN, PO0, PO1, ALO, jj) do { \
      SBAR(); if constexpr (FAST) qkt_ref(PN0, PN1, K_lds + bc * SHM_K, qr, negm, r32, hi); else qkt(PN0, PN1, K_lds + bc * SHM_K, qr, r32, hi); \
      if ((jj) + 1 < NT) DMA_TILE((jj) + 1, bn);              \
      FSM(PO0, PO1, ALO); SBAR(); \
      pv_d0(o, vb0 + bp * SHM_V, pa0, pa1, pa2, pa3); PSM(PN0, PN1, MNN, ALN); RESC(ALN); \
      DMA_WAIT(); __syncthreads(); \
      bp = bc; bc = bn; bn = (bn == 2) ? 0 : bn + 1; } while (0)
    f32x16 pA0, pA1, pB0, pB1; float mnA = 0.f, mnB = 0.f, alA = 1.f, alB = 1.f; bf16x8 pa0, pa1, pa2, pa3; const int NT = seq / KVBLK;
    DMA_TILE(0, 0); DMA_WAIT(); __syncthreads();
    if (1 < NT) DMA_TILE(1, 1);
    qkt(pA0, pA1, K_lds, qr, r32, hi); partialSM(pA0, pA1, m_reg, mnA, alA);
    f32x16 negm = f32x16{};
    if constexpr (FAST) {
#pragma unroll
      for (int r = 0; r < 16; ++r) negm[r] = -m_reg;
      asm volatile("" : "+v"(negm));
    }
    DMA_WAIT(); __syncthreads();
    int bp = 0, bc = 1, bn = 2;
    for (int j = 1; j + 1 < NT; j += 2) {
      STEP(pB0, pB1, mnB, alB, pA0, pA1, alA, j);
      STEP(pA0, pA1, mnA, alA, pB0, pB1, alB, j + 1);
    }
    STEP(pB0, pB1, mnB, alB, pA0, pA1, alA, NT - 1);
    FSM(pB0, pB1, alB); SBAR();
    pv_d0(o, vb0 + bp * SHM_V, pa0, pa1, pa2, pa3);
#undef DMA_TILE
#undef DMA_WAIT
#undef RESC
#undef PSM
#undef FSM
#undef STEP
    l_out = l_reg;
    return ovf;
}
__device__ __forceinline__ void attn_unit(const bf16* __restrict__ qkv, long Qrow0, long Krow0, int vh, int seq, float lam, float oscale, const float* __restrict__ subln,
                                          bf16* __restrict__ Ob, int ldo, float* stash, char* lds) {
  int tid = threadIdx.x; asm volatile("" : "+v"(tid));
  const int wid = __builtin_amdgcn_readfirstlane(tid >> 6), lane = tid & 63, r32 = lane & 31, hi = lane >> 5;
  char* V_lds = lds; char* K_lds = lds + 3 * SHM_V;
  float* wsb = (float*)(lds + 3 * SHM_V + 3 * SHM_K); float* li_l = wsb + wid * 64;
  volatile unsigned* ovw = (volatile unsigned*)(lds + 3 * SHM_V + 3 * SHM_K + NW * 64 * 4);
  const bf16* Vh = qkv + Krow0 * LDR + 2048 + vh * DV;
  for (int s = 0; s < 2; ++s) {
    const int head = 2 * vh + s;
    const bf16* Kh = qkv + Krow0 * LDR + 1024 + head * DQ;
    const bf16* Qh = qkv + Qrow0 * LDR + head * DQ;
    f32x16 o[4]; float l_reg;
    const bool ovf = attn_map<true>(Kh, Vh, Qh, seq, V_lds, K_lds, wsb, o, l_reg);
    if (lane == 0) ovw[wid] = __any(ovf) ? 1u : 0u;
    __syncthreads();
    unsigned anyovf = 0u;
#pragma unroll
    for (int w = 0; w < NW; ++w) anyovf |= ovw[w];
    __syncthreads();
    if (__builtin_amdgcn_readfirstlane(anyovf) != 0u) (void)attn_map<false>(Kh, Vh, Qh, seq, V_lds, K_lds, wsb, o, l_reg);
    if (hi == 0) li_l[r32] = l_reg; asm volatile("s_waitcnt lgkmcnt(0)" ::: "memory");
    float rli[16];
#pragma unroll
    for (int r = 0; r < 16; ++r) rli[r] = __builtin_amdgcn_rcpf(li_l[crow(r, hi)]);
    typedef float f32x4_t __attribute__((ext_vector_type(4)));
    f32x4_t* st4 = (f32x4_t*)stash + (size_t)tid * 16;
    if (s == 0) {
#pragma unroll
      for (int d0 = 0; d0 < 4; ++d0)
#pragma unroll
        for (int r4 = 0; r4 < 4; ++r4) { f32x4_t v; v[0] = o[d0][4 * r4] * rli[4 * r4]; v[1] = o[d0][4 * r4 + 1] * rli[4 * r4 + 1]; v[2] = o[d0][4 * r4 + 2] * rli[4 * r4 + 2]; v[3] = o[d0][4 * r4 + 3] * rli[4 * r4 + 3]; st4[d0 * 4 + r4] = v; }
    } else {
      f32x4_t svp[16];
#pragma unroll
      for (int i = 0; i < 16; ++i) svp[i] = st4[i];
      float ssq[16];
#pragma unroll
      for (int r = 0; r < 16; ++r) ssq[r] = 0.f;
#pragma unroll
      for (int d0 = 0; d0 < 4; ++d0)
#pragma unroll
        for (int r4 = 0; r4 < 4; ++r4) { const f32x4_t sv = svp[d0 * 4 + r4];
#pragma unroll
          for (int i = 0; i < 4; ++i) { const int r = 4 * r4 + i; const float v = sv[i] - lam * (o[d0][r] * rli[r]); o[d0][r] = v; ssq[r] += v * v; } }
#pragma unroll
      for (int r = 0; r < 16; ++r) {
        float a = ssq[r];
        a += sx<1>(a); a += sx<2>(a); a += sx<4>(a); a += sx<8>(a); a += sx<16>(a);
        ssq[r] = oscale / sqrtf(a * (1.0f / 128.0f) + 1e-6f);
      }
      float g[4];
#pragma unroll
      for (int d0 = 0; d0 < 4; ++d0) g[d0] = subln[d0 * 32 + r32];
      bf16* stg = (bf16*)(lds + SHM_ATTN) + wid * (QBLK * DV);
      unsigned so = (unsigned)((4 * hi) * DV + r32); asm volatile("" : "+v"(so));
#pragma unroll
      for (int r = 0; r < 16; ++r) {
#pragma unroll
        for (int d0 = 0; d0 < 4; ++d0) { const unsigned w = cvtpk(o[d0][r] * ssq[r] * g[d0], 0.f); (stg + ((r & 3) + 8 * (r >> 2)) * DV + d0 * 32)[so] = (bf16)(w & 0xffffu); } }
      asm volatile("s_waitcnt lgkmcnt(0)" ::: "memory");
      int ldo_ = ldo; asm volatile("" : "+s"(ldo_));
      bf16* Ow = Ob + (long)(wid * QBLK) * ldo_;
      const int srow = lane >> 4, sch = lane & 15;
#pragma unroll
      for (int i = 0; i < 8; ++i) { const int row = i * 4 + srow; const u32x4 v = *(const u32x4*)(stg + row * DV + sch * 8); *(u32x4*)(Ow + (long)row * ldo_ + sch * 8) = v; }
    }
  }
}
#undef SBAR
}
#define GAS __attribute__((address_space(1)))
#define LAS __attribute__((address_space(3)))
typedef unsigned short bf16;
typedef unsigned v4u __attribute__((ext_vector_type(4)));
typedef float f32x4 __attribute__((ext_vector_type(4)));
typedef short bf16x8 __attribute__((ext_vector_type(8)));
typedef GAS unsigned gu32;
typedef GAS unsigned long long gu64;
#define RLX_AGENT __ATOMIC_RELAXED, __HIP_MEMORY_SCOPE_AGENT
#define LDS_WAIT() asm volatile("s_waitcnt lgkmcnt(0)" ::: "memory")
#define VM_WAIT() asm volatile("s_waitcnt vmcnt(0)" ::: "memory")
__device__ __forceinline__ unsigned long long rt() { return __builtin_amdgcn_s_memrealtime(); }
__device__ __forceinline__ unsigned f2bf(float f) { unsigned u = __builtin_bit_cast(unsigned, f); return (u + 0x7fffu + ((u >> 16) & 1u)) >> 16; }
__device__ __forceinline__ unsigned pk2(float lo, float hi) { unsigned r; asm("v_cvt_pk_bf16_f32 %0, %1, %2" : "=v"(r) : "v"(lo), "v"(hi)); return r; }

#define XB_TMO      128
#define XB_XCNT(j)  (256  + 64 * (j))
#define XB_XSUB(j)  (1280 + 64 * (j))
#define XB_XGEN(j)  (2304 + 64 * (j))
#define XB_TOP      3328
#define XB_TOPGEN   3392
#define XCD_BAR_WORDS 3456
#define XB_SPIN_CAP (1u << 18)

__device__ __forceinline__ unsigned xb_ld(unsigned* p)              { return __hip_atomic_load(p, __ATOMIC_RELAXED, __HIP_MEMORY_SCOPE_AGENT); }
__device__ __forceinline__ unsigned xb_add(unsigned* p, unsigned v) { return __hip_atomic_fetch_add(p, v, __ATOMIC_RELAXED, __HIP_MEMORY_SCOPE_AGENT); }
__device__ __forceinline__ unsigned xb_xcc_id() { return (unsigned)__builtin_amdgcn_s_getreg((3 << 11) | 20) & 0xFu; }
#define XB_SPIN(cond, bar) do { unsigned _sp = 0; while (cond) { __builtin_amdgcn_s_sleep(1); \
    if ((++_sp & 255u) == 0u) { if (xb_ld(&(bar)[XB_TMO])) break; if (_sp > XB_SPIN_CAP) { atomicAdd(&(bar)[XB_TMO], 1u); break; } } } } while (0)

struct XcdBarrier {
    unsigned* bar; unsigned x;
    volatile LAS unsigned* st;
};

__device__ __forceinline__ XcdBarrier xcd_barrier_post(unsigned* bar, volatile LAS unsigned* st) {
    XcdBarrier b; b.bar = bar; b.x = xb_xcc_id(); b.st = st;
    if (threadIdx.x == 0) (void)xb_add(&bar[XB_XCNT(b.x)], 1u);
    return b;
}
__device__ __forceinline__ void xcd_barrier_complete(unsigned* bar, unsigned x, unsigned& nloc, unsigned& nx) {
    const unsigned G = gridDim.x * gridDim.y * gridDim.z;
    unsigned sum, cnt, mine, sp = 0u;
    for (;;) {
        sum = 0u; cnt = 0u; mine = 0u;
#pragma unroll
        for (unsigned j = 0; j < 16; ++j) { const unsigned c = xb_ld(&bar[XB_XCNT(j)]); sum += c; cnt += (c > 0u) ? 1u : 0u; mine = (j == x) ? c : mine; }
        if (sum == G) break;
        __builtin_amdgcn_s_sleep(1);
        if ((++sp & 255u) == 0u) { if (xb_ld(&bar[XB_TMO])) break; if (sp > XB_SPIN_CAP) { atomicAdd(&bar[XB_TMO], 1u); break; } }
    }
    nloc = mine > 0u ? mine : 1u; nx = cnt > 0u ? cnt : 1u;
}

__device__ __forceinline__ void xcd_barrier(const XcdBarrier& b) {
    asm volatile("s_waitcnt vmcnt(0)" ::: "memory");
    __syncthreads();
    if (threadIdx.x == 0) {
        unsigned* bar = b.bar;
        __builtin_amdgcn_s_waitcnt(0);
        unsigned nloc = b.st[0], nx = b.st[1];
        if (nloc == 0u) { xcd_barrier_complete(bar, b.x, nloc, nx); b.st[0] = nloc; b.st[1] = nx; }
        const unsigned old = xb_add(&bar[XB_XSUB(b.x)], 1u);
        const unsigned gen = old / nloc;
        if (old + 1u == (gen + 1u) * nloc) {
            __builtin_amdgcn_fence(__ATOMIC_RELEASE, "agent");
            asm volatile("s_waitcnt vmcnt(0)" ::: "memory");
            const unsigned og = xb_add(&bar[XB_TOP], 1u);
            const unsigned tg = og / nx;
            if (og + 1u == (tg + 1u) * nx) xb_add(&bar[XB_TOPGEN], 1u);
            else XB_SPIN(xb_ld(&bar[XB_TOPGEN]) == tg, bar);
            __builtin_amdgcn_fence(__ATOMIC_ACQUIRE, "agent");
            xb_add(&bar[XB_XGEN(b.x)], 1u);
            asm volatile("s_waitcnt vmcnt(0)" ::: "memory");
        } else {
            XB_SPIN(xb_ld(&bar[XB_XGEN(b.x)]) == gen, bar);
            __builtin_amdgcn_fence(__ATOMIC_ACQUIRE, "agent");
            asm volatile("s_waitcnt vmcnt(0)" ::: "memory");
        }
    }
    __syncthreads();
}
#define HYD __device__ __forceinline__
#define HYDM __device__ __forceinline__
#define HY_DEVICE 1
#ifdef HY_DEVICE
#define HY_OPAQUE(x) asm volatile("" : "+v"(x))
#else
#define HY_OPAQUE(x) (void)(x)
#endif
typedef float cf __attribute__((ext_vector_type(2)));
typedef float cf2 __attribute__((ext_vector_type(4)));
template <class P> struct HyP2 {};
template <> struct HyP2<cf*> { typedef cf2* type; };
#ifdef HY_DEVICE
template <> struct HyP2<__attribute__((address_space(3))) cf*> { typedef __attribute__((address_space(3))) cf2* type; };
#endif
HYD cf cf_add(cf a, cf b) { return a + b; }
HYD cf cf_sub(cf a, cf b) { return a - b; }
HYD cf cf_mul(cf a, cf b) { return cf{a.x * b.x - a.y * b.y, a.x * b.y + a.y * b.x}; }
HYD cf cf_mulc(cf a, cf b) { return cf{a.x * b.x + a.y * b.y, a.y * b.x - a.x * b.y}; }
constexpr int FN = 16384, FT = 512, FLOG = 14, FNP = FN + 4 * (FN >> 6);
constexpr int SEQL = 8192;
HYD int HP(int i) { return i + ((i >> 6) << 2); }
#define HY_C1 0.92387953251128674f
#define HY_S1 0.38268343236508977f
#define HY_R2 0.70710678118654752f
template <int M16> HYD cf mul_root16(cf w) {
    if (M16 == 0) return w;
    if (M16 == 4) return cf{w.y, -w.x};
    if (M16 == 2) return cf{(w.x + w.y) * HY_R2, (w.y - w.x) * HY_R2};
    if (M16 == 6) return cf{(w.y - w.x) * HY_R2, -(w.x + w.y) * HY_R2};
    if (M16 == 1) return cf_mul(w, cf{HY_C1, -HY_S1});
    if (M16 == 3) return cf_mul(w, cf{HY_S1, -HY_C1});
    if (M16 == 5) return cf_mul(w, cf{-HY_S1, -HY_C1});
    return cf_mul(w, cf{-HY_C1, -HY_S1});
}
template <int Q, int U, bool INV, bool ZUP, bool HLO> struct HyStage {
    static HYDM void run(cf (&e)[1 << Q], const cf (&tw)[Q]) {
        constexpr int R = 1 << Q, half = R >> (U + 1);
#pragma unroll
        for (int k = 0; k < R; ++k) {
            if ((k & half) == 0) {
                const int kp = k & (half - 1);
                cf w = tw[U];
                switch (kp * 16 / (2 * half)) {
                    case 0: break;
                    case 1: w = mul_root16<1>(w); break;
                    case 2: w = mul_root16<2>(w); break;
                    case 3: w = mul_root16<3>(w); break;
                    case 4: w = mul_root16<4>(w); break;
                    case 5: w = mul_root16<5>(w); break;
                    case 6: w = mul_root16<6>(w); break;
                    default: w = mul_root16<7>(w); break;
                }
                if (!INV) {
                    if (ZUP && U == 0) { e[k + half] = cf_mul(e[k], w); }
                    else { const cf a = e[k], b = e[k + half]; e[k] = cf_add(a, b); e[k + half] = cf_mul(cf_sub(a, b), w); }
                } else {
                    const cf a = e[k], b = cf_mulc(e[k + half], w); e[k] = cf_add(a, b);
                    if (!(HLO && U == 0)) e[k + half] = cf_sub(a, b);
                }
            }
        }
    }
};
template <int Q, bool INV, bool ZUP, bool HLO> HYD void hy_bfly(cf (&e)[1 << Q], cf t) {
    cf tw[Q]; tw[0] = t;
#pragma unroll
    for (int u = 1; u < Q; ++u) tw[u] = cf_mul(tw[u - 1], tw[u - 1]);
    if (Q == 4) {
        if (!INV) { HyStage<Q, 0, INV, ZUP, HLO>::run(e, tw); HyStage<Q, 1, INV, ZUP, HLO>::run(e, tw); HyStage<Q, 2 % Q, INV, ZUP, HLO>::run(e, tw); HyStage<Q, 3 % Q, INV, ZUP, HLO>::run(e, tw); }
        else      { HyStage<Q, 3 % Q, INV, ZUP, HLO>::run(e, tw); HyStage<Q, 2 % Q, INV, ZUP, HLO>::run(e, tw); HyStage<Q, 1, INV, ZUP, HLO>::run(e, tw); HyStage<Q, 0, INV, ZUP, HLO>::run(e, tw); }
    } else {
        if (!INV) { HyStage<Q, 0, INV, ZUP, HLO>::run(e, tw); HyStage<Q, 1, INV, ZUP, HLO>::run(e, tw); }
        else      { HyStage<Q, 1, INV, ZUP, HLO>::run(e, tw); HyStage<Q, 0, INV, ZUP, HLO>::run(e, tw); }
    }
}
#ifdef HY_DEVICE
#define HY_MULT(T, X, Y) "v_pk_mul_f32 " T ", " X ", " Y " op_sel:[1,1] op_sel_hi:[1,0]\n\t"
#define HY_FMAP(R, X, Y, T) "v_pk_fma_f32 " R ", " X ", " Y ", " T " op_sel_hi:[0,1,1] neg_lo:[0,0,1]\n\t"
#define HY_FMAC(R, X, Y, T) "v_pk_fma_f32 " R ", " X ", " Y ", " T " op_sel_hi:[0,1,1] neg_hi:[1,0,0]\n\t"
#define HY_ADD(R, A, B) "v_pk_add_f32 " R ", " A ", " B "\n\t"
#define HY_SUB(R, A, B) "v_pk_add_f32 " R ", " A ", " B " neg_lo:[0,1] neg_hi:[0,1]\n\t"
HYD void hy_cmul2(cf& r0, cf x0, cf y0, cf& r1, cf x1, cf y1) { cf t0, t1;
    asm(HY_MULT("%0", "%4", "%5") HY_MULT("%1", "%6", "%7") HY_FMAP("%2", "%4", "%5", "%0") HY_FMAP("%3", "%6", "%7", "%1")
        : "=&v"(t0), "=&v"(t1), "=&v"(r0), "=&v"(r1) : "v"(x0), "v"(y0), "v"(x1), "v"(y1)); }
HYD cf hy_cmul1(cf x, cf y) { cf t, r;
    asm(HY_MULT("%0", "%2", "%3") "s_nop 0\n\t" HY_FMAP("%1", "%2", "%3", "%0") : "=&v"(t), "=&v"(r) : "v"(x), "v"(y)); return r; }
HYD void hy_bf2_fwd(cf& a0, cf& b0, cf w0, cf& a1, cf& b1, cf w1) { cf d0, d1, t0, t1;
    asm(HY_SUB("%4", "%0", "%1") HY_ADD("%0", "%0", "%1") HY_SUB("%5", "%2", "%3") HY_ADD("%2", "%2", "%3")
        HY_MULT("%6", "%4", "%8") HY_MULT("%7", "%5", "%9") HY_FMAP("%1", "%4", "%8", "%6") HY_FMAP("%3", "%5", "%9", "%7")
        : "+v"(a0), "+v"(b0), "+v"(a1), "+v"(b1), "=&v"(d0), "=&v"(d1), "=&v"(t0), "=&v"(t1) : "v"(w0), "v"(w1)); }
HYD void hy_bf2_fwdz(cf a0, cf& b0, cf w0, cf a1, cf& b1, cf w1) { hy_cmul2(b0, a0, w0, b1, a1, w1); }
HYD void hy_bf2_inv(cf& a0, cf& b0, cf w0, cf& a1, cf& b1, cf w1) { cf t0, t1;
    asm(HY_MULT("%4", "%1", "%6") HY_MULT("%5", "%3", "%7") HY_FMAC("%4", "%1", "%6", "%4") HY_FMAC("%5", "%3", "%7", "%5")
        HY_SUB("%1", "%0", "%4") HY_SUB("%3", "%2", "%5") HY_ADD("%0", "%0", "%4") HY_ADD("%2", "%2", "%5")
        : "+v"(a0), "+v"(b0), "+v"(a1), "+v"(b1), "=&v"(t0), "=&v"(t1) : "v"(w0), "v"(w1)); }
HYD void hy_bf2_invl(cf& a0, cf b0, cf w0, cf& a1, cf b1, cf w1) { cf t0, t1;
    asm(HY_MULT("%2", "%4", "%6") HY_MULT("%3", "%5", "%7") HY_FMAC("%2", "%4", "%6", "%2") HY_FMAC("%3", "%5", "%7", "%3")
        HY_ADD("%0", "%0", "%2") HY_ADD("%1", "%1", "%3")
        : "+v"(a0), "+v"(a1), "=&v"(t0), "=&v"(t1) : "v"(b0), "v"(b1), "v"(w0), "v"(w1)); }
HYD cf hy_rot(cf w) { cf r; asm("v_pk_add_f32 %0, %1, 0 op_sel:[1,0] op_sel_hi:[0,0] neg_hi:[1,0]" : "=v"(r) : "v"(w)); return r; }
#else
HYD void hy_cmul2(cf& r0, cf x0, cf y0, cf& r1, cf x1, cf y1) { const cf p0 = cf_mul(x0, y0), p1 = cf_mul(x1, y1); r0 = p0; r1 = p1; }
HYD cf hy_cmul1(cf x, cf y) { return cf_mul(x, y); }
HYD void hy_bf2_fwd(cf& a0, cf& b0, cf w0, cf& a1, cf& b1, cf w1) { const cf d0 = cf_sub(a0, b0), d1 = cf_sub(a1, b1); a0 = cf_add(a0, b0); a1 = cf_add(a1, b1); b0 = cf_mul(d0, w0); b1 = cf_mul(d1, w1); }
HYD void hy_bf2_fwdz(cf a0, cf& b0, cf w0, cf a1, cf& b1, cf w1) { b0 = cf_mul(a0, w0); b1 = cf_mul(a1, w1); }
HYD void hy_bf2_inv(cf& a0, cf& b0, cf w0, cf& a1, cf& b1, cf w1) { const cf p0 = cf_mulc(b0, w0), p1 = cf_mulc(b1, w1); b0 = cf_sub(a0, p0); b1 = cf_sub(a1, p1); a0 = cf_add(a0, p0); a1 = cf_add(a1, p1); }
HYD void hy_bf2_invl(cf& a0, cf b0, cf w0, cf& a1, cf b1, cf w1) { a0 = cf_add(a0, cf_mulc(b0, w0)); a1 = cf_add(a1, cf_mulc(b1, w1)); }
HYD cf hy_rot(cf w) { return cf{w.y, -w.x}; }
#endif
template <int U, bool INV, bool ZUP, bool HLO> HYD void hy_stage16(cf (&e)[16], const cf* W) {
    constexpr int half = 8 >> U;
#pragma unroll
    for (int j = 0; j < 8; j += 2) {
        const int k0 = ((j / half) * 2 * half) + (j % half), k1 = (((j + 1) / half) * 2 * half) + ((j + 1) % half);
        const cf w0 = W[k0 & (half - 1)], w1 = W[k1 & (half - 1)];
        if (!INV) { if (ZUP && U == 0) hy_bf2_fwdz(e[k0], e[k0 + half], w0, e[k1], e[k1 + half], w1); else hy_bf2_fwd(e[k0], e[k0 + half], w0, e[k1], e[k1 + half], w1); }
        else { if (HLO && U == 0) hy_bf2_invl(e[k0], e[k0 + half], w0, e[k1], e[k1 + half], w1); else hy_bf2_inv(e[k0], e[k0 + half], w0, e[k1], e[k1 + half], w1); }
    }
}
template <bool INV, bool ZUP, bool HLO> HYD void hy_bfly16(cf (&e)[16], cf t) {
    cf W0[8], W1[4], W2[2], W3[1], tw1, tw2;
    cf k1 = cf{HY_C1, -HY_S1}, k2 = cf{HY_R2, -HY_R2}, k3 = cf{HY_S1, -HY_C1};
    W0[0] = t;
    hy_cmul2(W0[1], t, k1, W0[3], t, k3);
    hy_cmul2(W0[2], t, k2, tw1, t, t);
    W1[0] = tw1;
    hy_cmul2(W1[1], tw1, k2, tw2, tw1, tw1);
    W2[0] = tw2;
    W3[0] = hy_cmul1(tw2, tw2);
#pragma unroll
    for (int i = 0; i < 4; ++i) W0[4 + i] = hy_rot(W0[i]);
    W1[2] = hy_rot(W1[0]); W1[3] = hy_rot(W1[1]); W2[1] = hy_rot(W2[0]);
    if (!INV) { hy_stage16<0, INV, ZUP, HLO>(e, W0); hy_stage16<1, INV, ZUP, HLO>(e, W1); hy_stage16<2, INV, ZUP, HLO>(e, W2); hy_stage16<3, INV, ZUP, HLO>(e, W3); }
    else      { hy_stage16<3, INV, ZUP, HLO>(e, W3); hy_stage16<2, INV, ZUP, HLO>(e, W2); hy_stage16<1, INV, ZUP, HLO>(e, W1); hy_stage16<0, INV, ZUP, HLO>(e, W0); }
}
template <class PT> HYD cf hy_twid(PT thi, PT tlo, int e) { return hy_cmul1(thi[e >> 7], tlo[e & 127]); }
template <int S, bool INV, bool ZUP, bool HLO, class P, class PT>
HYD void hy_pass16(P X, PT thi, PT tlo, int tid) {
    constexpr int R = 16;
    constexpr int SP = (S >= 64) ? S + S / 16 : S;
    const int g0 = tid, g1 = tid + FT;
    const int lo0 = g0 & (S - 1), pb0 = HP((g0 / S) * S * R + lo0);
    const int lo1 = g1 & (S - 1), pb1 = HP((g1 / S) * S * R + lo1);
    cf e0[R], e1[R];
#pragma unroll
    for (int k = 0; k < R; ++k) { if (ZUP && k >= 8) e0[k] = cf{0.f, 0.f}; else e0[k] = X[pb0 + k * SP]; }
#pragma unroll
    for (int k = 0; k < R; ++k) { if (ZUP && k >= 8) e1[k] = cf{0.f, 0.f}; else e1[k] = X[pb1 + k * SP]; }
    const cf t0 = hy_twid(thi, tlo, lo0 * (FN / (R * S))), t1 = hy_twid(thi, tlo, lo1 * (FN / (R * S)));
    hy_bfly16<INV, ZUP, HLO>(e0, t0);
#pragma unroll
    for (int k = 0; k < R; ++k) { if (!(HLO && k >= 8)) X[pb0 + k * SP] = e0[k]; }
    hy_bfly16<INV, ZUP, HLO>(e1, t1);
#pragma unroll
    for (int k = 0; k < R; ++k) { if (!(HLO && k >= 8)) X[pb1 + k * SP] = e1[k]; }
}
typedef _Float16 hy_h2 __attribute__((ext_vector_type(2)));
HYD unsigned hy_pack_h2(float re, float im) { const hy_h2 v = {(_Float16)re, (_Float16)im}; return __builtin_bit_cast(unsigned, v); }
HYD cf hy_unpack_h2(unsigned u, float s) { const hy_h2 v = __builtin_bit_cast(hy_h2, u); return cf{(float)v.x * s, (float)v.y * s}; }
typedef unsigned hy_u4 __attribute__((ext_vector_type(4)));
template <bool INV> HYD void hy_r4(cf (&e)[4]) {
    if (!INV) {
        const cf a0 = e[0] + e[2], b0 = e[0] - e[2], a1 = e[1] + e[3], d = e[1] - e[3], b1 = cf{d.y, -d.x};
        e[0] = a0 + a1; e[1] = a0 - a1; e[2] = b0 + b1; e[3] = b0 - b1;
    } else {
        const cf a0 = e[0] + e[1], a1 = e[0] - e[1], a2 = e[2] + e[3], d = e[2] - e[3], b = cf{-d.y, d.x};
        e[0] = a0 + a2; e[2] = a0 - a2; e[1] = a1 + b; e[3] = a1 - b;
    }
}
template <bool INV, class P, class PK>
HYD void hy_pass4(P X, int tid, PK KM) {
    typedef typename HyP2<P>::type P2;
    const int w = tid >> 6, lane = tid & 63;
#pragma unroll 1
    for (int gb = 0; gb < 2; ++gb) {
        cf2 a[4], b[4]; hy_u4 kq[4];
        const int g0 = (gb * 8 + w) * 256 + lane;
#pragma unroll
        for (int u = 0; u < 4; ++u) { const int g = g0 + 64 * u; P2 X2 = (P2)(X + HP(4 * g)); a[u] = X2[0]; b[u] = X2[1];
            if (KM) { const unsigned gi = (unsigned)(4 * g) & 0x3fffu; kq[u] = *(const hy_u4*)(KM + gi); } }
#pragma unroll
        for (int u = 0; u < 4; ++u) { const int g = g0 + 64 * u; P2 X2 = (P2)(X + HP(4 * g));
            cf e[4] = {cf{a[u].x, a[u].y}, cf{a[u].z, a[u].w}, cf{b[u].x, b[u].y}, cf{b[u].z, b[u].w}};
            hy_r4<INV>(e);
            if (KM) { const float ks = 1.0f / (float)FN; cf q0, q1, q2, q3; hy_cmul2(q0, e[0], hy_unpack_h2(kq[u].x, ks), q1, e[1], hy_unpack_h2(kq[u].y, ks)); hy_cmul2(q2, e[2], hy_unpack_h2(kq[u].z, ks), q3, e[3], hy_unpack_h2(kq[u].w, ks)); e[0] = q0; e[1] = q1; e[2] = q2; e[3] = q3; }
            X2[0] = cf2{e[0].x, e[0].y, e[1].x, e[1].y}; X2[1] = cf2{e[2].x, e[2].y, e[3].x, e[3].y}; }
    }
}
HYD int hy_brev14(int p) {
    unsigned v = (unsigned)p;
    v = ((v >> 1) & 0x55555555u) | ((v & 0x55555555u) << 1);
    v = ((v >> 2) & 0x33333333u) | ((v & 0x33333333u) << 2);
    v = ((v >> 4) & 0x0F0F0F0Fu) | ((v & 0x0F0F0F0Fu) << 4);
    v = ((v >> 8) & 0x00FF00FFu) | ((v & 0x00FF00FFu) << 8);
    v = (v >> 16) | (v << 16);
    return (int)(v >> (32 - FLOG));
}
HYD float hy_bf2f(unsigned short b) { unsigned u = (unsigned)b << 16; float f; __builtin_memcpy(&f, &u, 4); return f; }
HYD unsigned hy_f2bf(float f) { unsigned u; __builtin_memcpy(&u, &f, 4); return (u + 0x7fffu + ((u >> 16) & 1u)) >> 16; }
template <class PR> HYD void hy_sconv2(PR rowj  , unsigned tid, int j, float w0, float w1, float w2, float b, float& u0, float& u1) {
    const unsigned d1 = rowj[tid];
    const unsigned d0r = (rowj - 1)[tid], d2r = (rowj + 1)[tid];
    const unsigned d0 = (j > 0 || tid > 0) ? d0r : 0u;
    const unsigned d2 = (j < 7 || tid < (unsigned)(FT - 1)) ? d2r : 0u;
    const float pm1 = hy_bf2f((unsigned short)(d0 >> 16)), p0 = hy_bf2f((unsigned short)(d1 & 0xffffu)), p1 = hy_bf2f((unsigned short)(d1 >> 16)), p2 = hy_bf2f((unsigned short)(d2 & 0xffffu));
    u0 = b + w0 * pm1 + w1 * p0 + w2 * p1;
    u1 = b + w0 * p0 + w1 * p1 + w2 * p2;
}
template <class P> HYD void hy_filter_step(P X, const unsigned short* taps, float delta, int tid) {
    typedef typename HyP2<P>::type P2;
    typedef unsigned u32x2h __attribute__((ext_vector_type(2)));
    u32x2h raw[SEQL / (4 * FT)][4];
    const float dscale = -delta * (1.4426950408889634f / (float)(SEQL - 1)); (void)dscale;
#pragma unroll
    for (int j = 0; j < SEQL / (4 * FT); ++j)
#pragma unroll
        for (int q = 0; q < 4; ++q) raw[j][q] = __builtin_nontemporal_load((const u32x2h*)(taps + (size_t)q * 1024 * SEQL + ((unsigned)(4 * (tid + FT * j)) & 0x1fffu)));
#pragma unroll
    for (int j = 0; j < SEQL / (4 * FT); ++j) {
        const int t = 4 * (tid + FT * j);
        cf2 a[4];
#pragma unroll
        for (int q = 0; q < 4; ++q) a[q] = cf2{hy_bf2f((unsigned short)(raw[j][q].x & 0xffffu)), hy_bf2f((unsigned short)(raw[j][q].x >> 16)), hy_bf2f((unsigned short)(raw[j][q].y & 0xffffu)), hy_bf2f((unsigned short)(raw[j][q].y >> 16))};
        cf2 dec;
#pragma unroll
#ifdef HY_DEVICE
        for (int e = 0; e < 4; ++e) dec[e] = __builtin_amdgcn_exp2f((float)(t + e) * dscale);
#else
        for (int e = 0; e < 4; ++e) dec[e] = expf(-((float)(t + e) * (1.0f / (float)(SEQL - 1))) * delta);
#endif
        const cf2 a0 = a[0] * dec, a1 = a[1] * dec, a2 = a[2] * dec, a3 = a[3] * dec;
        P2 Xf = (P2)(X + HP(t));
        if (t == 0) { Xf[0] = cf2{a0[0] + a1[0], a2[0] + a3[0], a0[1], a2[1]}; float z0 = 0.f; HY_OPAQUE(z0); X[HP(SEQL)] = cf{z0, z0}; }
        else Xf[0] = cf2{a0[0], a2[0], a0[1], a2[1]};
        Xf[1] = cf2{a0[2], a2[2], a0[3], a2[3]};
        const int pbk = HP(FN - t - 4);
        X[pbk + 1] = cf{a1[3], a3[3]}; X[pbk + 2] = cf{a1[2], a3[2]}; X[pbk + 3] = cf{a1[1], a3[1]};
        if (t > 0) X[HP(FN - t)] = cf{a1[0], a3[0]};
    }
}
template <class P> HYD void hy_sep_step(P X, unsigned* K1g, unsigned* K2g, int tid) {
    const float sc = 0.5f;
#pragma unroll 1
    for (int j0 = 0; j0 < FN / FT; j0 += 4) {
        cf a[4], b[4];
#pragma unroll
        for (int u = 0; u < 4; ++u) { const int p = tid + FT * (j0 + u);
            const int f = hy_brev14(p), q = hy_brev14((FN - f) & (FN - 1));
            a[u] = X[HP(p)]; b[u] = X[HP(q)]; }
#pragma unroll
        for (int u = 0; u < 4; ++u) { const int p = tid + FT * (j0 + u);
            const unsigned pi = (unsigned)p & 0x3fffu;
            K1g[pi] = hy_pack_h2((a[u].x + b[u].x) * sc, (a[u].y - b[u].y) * sc);
            K2g[pi] = hy_pack_h2((a[u].y + b[u].y) * sc, -(a[u].x - b[u].x) * sc); }
    }
}
template <class P> HYD void hy_load_step(P X, const unsigned* r0, const unsigned* r1, float w0, float w1, float w2, float b, float (&zr)[8][4], int tid) {
    typedef typename HyP2<P>::type P2;
#pragma unroll
    for (int j = 0; j < 8; ++j) {
        const int t = 2 * (tid + FT * j);
        hy_sconv2(r0 + FT * j, (unsigned)tid, j, w0, w1, w2, b, zr[j][0], zr[j][2]);
        hy_sconv2(r1 + FT * j, (unsigned)tid, j, w0, w1, w2, b, zr[j][1], zr[j][3]);
        *(P2)(X + HP(t)) = cf2{zr[j][0], zr[j][1], zr[j][2], zr[j][3]};
    }
}
template <class P> HYD void hy_gate1_step(P X, const unsigned* r0, const unsigned* r1, float w0, float w1, float w2, float b, float bias, float (&zr)[8][4], int tid) {
    typedef typename HyP2<P>::type P2;
#pragma unroll
    for (int j = 0; j < 8; ++j) {
        const int t = 2 * (tid + FT * j);
        float xa0, xa1, xb0, xb1;
        hy_sconv2(r0 + FT * j, (unsigned)tid, j, w0, w1, w2, b, xa0, xa1);
        hy_sconv2(r1 + FT * j, (unsigned)tid, j, w0, w1, w2, b, xb0, xb1);
        P2 xp = (P2)(X + HP(t));
        const cf2 y = *xp;
        zr[j][0] = xa0 * (y.x + zr[j][0] * bias); zr[j][1] = xb0 * (y.y + zr[j][1] * bias);
        zr[j][2] = xa1 * (y.z + zr[j][2] * bias); zr[j][3] = xb1 * (y.w + zr[j][3] * bias);
        *xp = cf2{zr[j][0], zr[j][1], zr[j][2], zr[j][3]};
    }
}
template <class P> HYD void hy_gate2_step(P X, const unsigned* r0, const unsigned* r1, float w0, float w1, float w2, float b, float bias, const float (&zr)[8][4], unsigned* out0, unsigned* out1, int tid) {
    typedef typename HyP2<P>::type P2;
#pragma unroll
    for (int j = 0; j < 8; ++j) {
        const int t = 2 * (tid + FT * j);
        float xa0, xa1, xb0, xb1;
        hy_sconv2(r0 + FT * j, (unsigned)tid, j, w0, w1, w2, b, xa0, xa1);
        hy_sconv2(r1 + FT * j, (unsigned)tid, j, w0, w1, w2, b, xb0, xb1);
        const cf2 y = *(P2)(X + HP(t));
        const float za0 = xa0 * (y.x + zr[j][0] * bias), zb0 = xb0 * (y.y + zr[j][1] * bias);
        const float za1 = xa1 * (y.z + zr[j][2] * bias), zb1 = xb1 * (y.w + zr[j][3] * bias);
        (out0 + FT * j)[(unsigned)tid] = hy_f2bf(za0) | (hy_f2bf(za1) << 16);
        (out1 + FT * j)[(unsigned)tid] = hy_f2bf(zb0) | (hy_f2bf(zb1) << 16);
    }
}
HYD float hy_sconv1(unsigned D0, unsigned D1, int t, float w0, float w1, float w2, float b, bool pad0, bool padL) {
    const unsigned sh = ((unsigned)(t - 1) & 1u) << 4;
#ifdef HY_DEVICE
    const unsigned lo = __builtin_amdgcn_alignbit(D1, D0, sh), hi = D1 >> sh;
#else
    const unsigned long long w = (((unsigned long long)D1 << 32) | D0) >> sh; const unsigned lo = (unsigned)w, hi = (unsigned)(w >> 32);
#endif
    float e0 = hy_bf2f((unsigned short)(lo & 0xffffu)), e1 = hy_bf2f((unsigned short)(lo >> 16)), e2 = hy_bf2f((unsigned short)(hi & 0xffffu));
    if (pad0 && t == 0) e0 = 0.f;
    if (padL && t == SEQL - 1) e2 = 0.f;
    return b + w0 * e0 + w1 * e1 + w2 * e2;
}
struct HyRaw { unsigned d[2][8][4]; };
HYD void hy_raw_load(HyRaw& R, const unsigned* r0, const unsigned* r1, int tid) {
#pragma unroll
    for (int r = 0; r < 2; ++r)
#pragma unroll
        for (int k = 0; k < 8; ++k) { const unsigned du = ((unsigned)(tid + FT * r + 1024 * k + 1) >> 1) & 0x1fffu;
            R.d[r][k][0] = __builtin_nontemporal_load(r0 - 1 + du); R.d[r][k][1] = __builtin_nontemporal_load(r0 + du); R.d[r][k][2] = __builtin_nontemporal_load(r1 - 1 + du); R.d[r][k][3] = __builtin_nontemporal_load(r1 + du); }
}
template <class P, class PT> HYD void hy_convA_fwd(P X, PT thi, PT tlo, int tid, const HyRaw& R, float w0, float w1, float w2, float b, cf (&zr)[2][8]) {
#pragma unroll
    for (int r = 0; r < 2; ++r) {
        const int i0 = tid + FT * r, pb = HP(i0);
        cf e[16];
#pragma unroll
        for (int k = 0; k < 8; ++k) { const int t = i0 + 1024 * k; const bool p0 = (r == 0 && k == 0), pL = (r == 1 && k == 7); e[k] = cf{hy_sconv1(R.d[r][k][0], R.d[r][k][1], t, w0, w1, w2, b, p0, pL), hy_sconv1(R.d[r][k][2], R.d[r][k][3], t, w0, w1, w2, b, p0, pL)}; zr[r][k] = e[k]; }
#pragma unroll
        for (int k = 8; k < 16; ++k) e[k] = cf{0.f, 0.f};
        hy_bfly16<false, true, false>(e, hy_twid(thi, tlo, i0));
#pragma unroll
        for (int k = 0; k < 16; ++k) X[pb + k * 1088] = e[k];
    }
}
template <bool LAST, class P, class PT> HYD void hy_gateA(P X, PT thi, PT tlo, int tid, const HyRaw& R, float w0, float w1, float w2, float b, float bias,
                                                           cf (&zr)[2][8], unsigned short* out0, unsigned short* out1) {
#pragma unroll
    for (int r = 0; r < 2; ++r) {
        const int i0 = tid + FT * r, pb = HP(i0);
        cf e[16];
#pragma unroll
        for (int k = 0; k < 16; ++k) e[k] = X[pb + k * 1088];
        const cf tw = hy_twid(thi, tlo, i0);
        hy_bfly16<true, false, true>(e, tw);
#pragma unroll
        for (int k = 0; k < 8; ++k) { const int t = i0 + 1024 * k;
            const bool p0 = (r == 0 && k == 0), pL = (r == 1 && k == 7);
            const float xa = hy_sconv1(R.d[r][k][0], R.d[r][k][1], t, w0, w1, w2, b, p0, pL), xb = hy_sconv1(R.d[r][k][2], R.d[r][k][3], t, w0, w1, w2, b, p0, pL);
            const cf z = cf{xa * (e[k].x + zr[r][k].x * bias), xb * (e[k].y + zr[r][k].y * bias)};
            if (LAST) {
#ifdef HY_DEVICE
                unsigned pk; asm("v_cvt_pk_bf16_f32 %0, %1, %2" : "=v"(pk) : "v"(z.x), "v"(z.y)); const unsigned ti = (unsigned)t & 0x1fffu; out0[ti] = (unsigned short)(pk & 0xffffu); out1[ti] = (unsigned short)(pk >> 16);
#else
                out0[t] = (unsigned short)hy_f2bf(z.x); out1[t] = (unsigned short)hy_f2bf(z.y);
#endif
            }
            else { zr[r][k] = z; e[k] = z; } }
        if (!LAST) {
#pragma unroll
            for (int k = 8; k < 16; ++k) e[k] = cf{0.f, 0.f};
            hy_bfly16<false, true, false>(e, tw);
#pragma unroll
            for (int k = 0; k < 16; ++k) X[pb + k * 1088] = e[k];
        }
    }
}
constexpr int NWAVES = 8, NTHR = NWAVES * 64;
constexpr int DM = 2048, SEQ = 8192, DEPTH = 4, NSEQ = 6, GSEQ = 2, NGRP = NSEQ / GSEQ, MG = GSEQ * SEQ;
constexpr int HYW = 1024, HYIN = 3072, QKVW = 3072, DFF = 5632, GU = 2 * DFF, FEMB = 33, FHID = 64;
constexpr float EPS = 1e-6f;
constexpr float QSCALE = 0.125f * 1.4426950408889634f;
constexpr size_t MiB = 1u << 20;
constexpr size_t WS_CTL = 0, CTL_ZERO_BYTES = 1 * MiB;
constexpr size_t SZ_WHY = (size_t)HYIN * DM * 2, SZ_WQKV = (size_t)QKVW * DM * 2, SZ_WOUT = (size_t)DM * DM * 2, SZ_WGU = (size_t)GU * DM * 2, SZ_WDN = (size_t)DM * DFF * 2;
constexpr size_t OFF_WHY = 0, OFF_WQKV = OFF_WHY + SZ_WHY, OFF_WOUT = OFF_WQKV + SZ_WQKV, OFF_WGU = OFF_WOUT + SZ_WOUT, OFF_WDN = OFF_WGU + SZ_WGU, SZ_WLAYER = OFF_WDN + SZ_WDN;
constexpr size_t WS_W = 1 * MiB;
constexpr size_t WS_ROPE = WS_W + DEPTH * SZ_WLAYER;
constexpr int KPAD = 256;
constexpr size_t WS_H3 = WS_ROPE + (size_t)SEQ * 32 * 8;
constexpr size_t WS_W4T = WS_H3 + (size_t)DEPTH * SEQ * KPAD * 2;
constexpr size_t WS_TAPS = WS_W4T + (size_t)DEPTH * 4096 * KPAD * 2;
constexpr size_t WS_FFTK = WS_TAPS + (size_t)4096 * SEQ * 2;
constexpr size_t WS_STASH = WS_FFTK + (size_t)256 * 2 * 16384 * 8;
constexpr size_t WS_XB = WS_STASH;
constexpr size_t WS_H = WS_XB + (size_t)MG * DM * 2;
constexpr size_t WS_ZT = WS_H + (size_t)MG * DM * 2;
constexpr size_t WS_PROJT = WS_ZT + (size_t)HYW * MG * 2;
constexpr size_t WS_QKV = WS_PROJT + (size_t)HYIN * MG * 2;
constexpr size_t WS_MIX = WS_PROJT;
constexpr size_t WS_FFH = WS_PROJT;
constexpr size_t WS_MIXIN = WS_QKV + (size_t)MG * QKVW * 2;
constexpr size_t WS_END = WS_MIXIN + (size_t)MG * DM * 2;
constexpr size_t SZ_TAPS = (size_t)4096 * SEQ * 2, WS_TAPS_X = WS_END, WS_END_X = WS_TAPS_X + (DEPTH - 1) * SZ_TAPS;
static_assert((size_t)MG * DFF * 2 <= (size_t)HYIN * MG * 2 + (size_t)MG * QKVW * 2, "FFH overlay fits PROJT|QKV");
static_assert(WS_W4T % 256 == 0 && WS_TAPS % 256 == 0 && WS_ROPE % 256 == 0 && WS_H3 % 256 == 0 && WS_FFTK % 256 == 0 && WS_XB % 256 == 0 && WS_H % 256 == 0 && SZ_WLAYER % 256 == 0, "alignment");
constexpr int CW_BAR = 4096;
constexpr int PH_PER_LAYER = 8, PH_PER_GROUP = 1 + DEPTH * PH_PER_LAYER, NPHASE = 1 + NGRP * PH_PER_GROUP;
constexpr int RING_OFF = 0, RING_BYTES = 131072;
constexpr int TAB_OFF = 139264;
constexpr int MISC_OFF = TAB_OFF + 4096;
constexpr int LDS_BYTES = 147456;
static_assert(MISC_OFF + 128 <= LDS_BYTES, "LDS map");
static_assert(att::SHM_ATTN_ALL <= MISC_OFF, "attention LDS fits below the control words");
#ifndef PROBE_DUP
#define PROBE_DUP 0
#endif
#ifndef MK_PER_PHASE
#define MK_PER_PHASE 0
#endif

struct Args { const float* in[30]; float* out; unsigned char* ws; int ph_lo, ph_hi, taps_all, pad; };
enum { I_XP = 0, I_XS, I_GMPRE, I_GMPOST, I_GFPRE, I_GFPOST, I_WIN, I_CONVW, I_CONVB, I_FW1, I_FB1, I_FF1, I_FW2, I_FB2, I_FF2, I_FW3, I_FB3, I_FF3, I_FW4,
       I_HBIAS, I_HNORM, I_LQ1, I_LK1, I_LQ2, I_LK2, I_SUBLN, I_WOUT, I_WGATE, I_WUP, I_WDOWN };

template <int K> __device__ __forceinline__ float swz_xor(float v) { return __builtin_bit_cast(float, __builtin_amdgcn_ds_swizzle(__builtin_bit_cast(int, v), (K << 10) | 0x1f)); }
__device__ __forceinline__ float wave_sum(float v) {
    v += swz_xor<1>(v); v += swz_xor<2>(v); v += swz_xor<4>(v); v += swz_xor<8>(v); v += swz_xor<16>(v);
    auto rr = __builtin_amdgcn_permlane32_swap(__float_as_uint(v), __float_as_uint(v), false, false);
    return __uint_as_float(rr[0]) + __uint_as_float(rr[1]);
}
__device__ __forceinline__ bf16* wt_dst_row(int kind, int n, bf16* d0, bf16* d1, int K) {
    if (kind == 0) return d0 + (size_t)n * K;
    if (kind == 1) { if (n < HYIN) return d0 + (size_t)n * K; int q = n - HYIN; if (q < 2048) { const int hb = q & ~63, i = q & 63; q = hb + (i < 32 ? 2 * i : 2 * (i - 32) + 1); } return d1 + (size_t)q * K; }
    if (kind == 4) return d0 + (size_t)n * KPAD;
    const int r = (n >> 7) * 256 + (n & 127) + (kind == 3 ? 128 : 0); return d0 + (size_t)r * K;
}
__device__ __forceinline__ void p0_transpose_item(const float* W, int K, int N, int kind, bf16* d0, bf16* d1, LAS float* scr, int item, int lane) {
    const int nblk = N / 32, kb = item / nblk, nb = item % nblk, k0 = 64 * kb, n0 = 32 * nb;
#pragma unroll 8
    for (int i = 0; i < 32; ++i) { const int kk = 2 * i + (lane >> 5); scr[kk * 33 + (lane & 31)] = __builtin_nontemporal_load(W + (size_t)(k0 + kk) * N + n0 + (lane & 31)); }
    LDS_WAIT(); asm volatile("" ::: "memory");
    const int c = lane & 7;
#pragma unroll
    for (int j = 0; j < 4; ++j) { const int n = (lane >> 3) + 8 * j; const LAS float* s = scr + (8 * c) * 33 + n;
        v4u o; o.x = pk2(s[0 * 33], s[1 * 33]); o.y = pk2(s[2 * 33], s[3 * 33]); o.z = pk2(s[4 * 33], s[5 * 33]); o.w = pk2(s[6 * 33], s[7 * 33]);
        *(GAS v4u*)(wt_dst_row(kind, n0 + n, d0, d1, K) + k0 + 8 * c) = o; }
    LDS_WAIT(); asm volatile("" ::: "memory");
}
__device__ __forceinline__ void sincos_red(double ang, float& s, float& c) {
    const double k = rint(ang * 0.15915494309189535); const float r = (float)(ang - k * 6.283185307179586);
    s = sinf(r); c = cosf(r);
}
#define GP(p) ((const float*)(const GAS float*)(p))
#define LAUNDER_TID(F) do { int t_ = (F).tid; asm volatile("" : "+v"(t_)); (F).tid = t_; (F).lane = t_ & 63; int z_ = 0; asm volatile("" : "+s"(z_)); (F).z = z_; unsigned long long w_ = (unsigned long long)(F).ws0; asm volatile("" : "+s"(w_)); (F).ws = (unsigned char*)(GAS unsigned char*)w_; int b_ = (F).bx0, v_ = (F).vcu0, g_ = (F).G0; asm volatile("" : "+s"(b_), "+s"(v_), "+s"(g_)); (F).bx = b_; (F).vcu = v_; (F).G = g_; } while (0)
struct Frame {
    LAS unsigned char* lds; volatile LAS unsigned* MISC; gu32* ctl;
    int tid, lane, wave, vcu, G, bx;
    int vcu0, G0, bx0;
    float* out; unsigned char* ws; unsigned char* ws0; int z;
};
__device__ __forceinline__ void p0_prologue(Frame& F, const Args& A) {
    LAS float* scr = (LAS float*)(F.lds + RING_OFF + F.wave * 16384);
    const int gw = F.vcu * NWAVES + F.wave, NGW = F.G * NWAVES;
    constexpr int I_IN = (DM / 64) * ((HYIN + QKVW) / 32), I_OUT = (DM / 64) * (DM / 32), I_G = (DM / 64) * (DFF / 32), I_D = (DFF / 64) * (DM / 32);
    constexpr int I_W4 = 4096 / 32;
    constexpr int PER_L = I_IN + I_OUT + 2 * I_G + I_D + I_W4;
    for (int it = gw; it < DEPTH * PER_L; it += NGW) {
        const int l = it / PER_L; int r = it % PER_L;
        unsigned char* wl = F.ws + WS_W + (size_t)l * SZ_WLAYER;
        if (r < I_IN) { p0_transpose_item(GP(A.in[I_WIN + F.z]) + (size_t)l * DM * (HYIN + QKVW), DM, HYIN + QKVW, 1, (bf16*)(wl + OFF_WHY), (bf16*)(wl + OFF_WQKV), scr, r, F.lane); continue; } r -= I_IN;
        if (r < I_OUT) { p0_transpose_item(GP(A.in[I_WOUT + F.z]) + (size_t)l * DM * DM, DM, DM, 0, (bf16*)(wl + OFF_WOUT), nullptr, scr, r, F.lane); continue; } r -= I_OUT;
        if (r < I_G) { p0_transpose_item(GP(A.in[I_WGATE + F.z]) + (size_t)l * DM * DFF, DM, DFF, 2, (bf16*)(wl + OFF_WGU), nullptr, scr, r, F.lane); continue; } r -= I_G;
        if (r < I_G) { p0_transpose_item(GP(A.in[I_WUP + F.z]) + (size_t)l * DM * DFF, DM, DFF, 3, (bf16*)(wl + OFF_WGU), nullptr, scr, r, F.lane); continue; } r -= I_G;
        if (r < I_D) { p0_transpose_item(GP(A.in[I_WDOWN + F.z]) + (size_t)l * DFF * DM, DFF, DM, 0, (bf16*)(wl + OFF_WDN), nullptr, scr, r, F.lane); continue; } r -= I_D;
        { bf16* w4t = (bf16*)(F.ws + WS_W4T) + (size_t)l * 4096 * KPAD;
          p0_transpose_item(GP(A.in[I_FW4 + F.z]) + (size_t)l * FHID * 4096, FHID, 4096, 4, w4t, nullptr, scr, r, F.lane);
          for (int e = F.lane; e < 32 * 24; e += 64) *(GAS v4u*)(w4t + (size_t)(32 * r + e / 24) * KPAD + 64 + 8 * (e % 24)) = (v4u){0u, 0u, 0u, 0u}; }
    }
    {
        float* cs = (float*)(F.ws + WS_ROPE);
        for (int e = F.vcu * NTHR + F.tid; e < SEQ * 32; e += F.G * NTHR) {
            const int t = e >> 5, p = e & 31;
            const double inv = exp(-9.210340371976184 * (double)(2 * p) / 64.0);
            float s, c; sincos_red((double)t * inv, s, c);
            cs[2 * e] = c; cs[2 * e + 1] = s;
        }
    }
    {
        bf16* h3b = (bf16*)(F.ws + WS_H3);
        LAS float* hb = (LAS float*)(F.lds + RING_OFF + F.wave * 16384);
        for (int task = gw; task < DEPTH * (SEQ / 64); task += NGW) {
            const int l = task / (SEQ / 64), t = (task % (SEQ / 64)) * 64 + F.lane;
            const float* w1 = GP(A.in[I_FW1 + F.z]) + (size_t)l * FEMB * FHID; const float* w2 = GP(A.in[I_FW2 + F.z]) + (size_t)l * FHID * FHID; const float* w3 = GP(A.in[I_FW3 + F.z]) + (size_t)l * FHID * FHID;
            hb[F.lane] = (float)t * (1.0f / (float)(SEQ - 1));
#pragma unroll 1
            for (int bi = 0; bi < 16; ++bi) { const double band = 1e-4 + (double)bi * ((15.0 - 1e-4) / 15.0);
                float s, c; sincos_red(6.283185307179586 * (double)t / (double)SEQ * band, s, c); hb[(1 + bi) * 64 + F.lane] = c; hb[(17 + bi) * 64 + F.lane] = -s; }
#pragma unroll 1
            for (int stage = 0; stage < 3; ++stage) {
                const float* w = stage == 0 ? w1 : (stage == 1 ? w2 : w3);
                const float* bb = (stage == 0 ? GP(A.in[I_FB1 + F.z]) : (stage == 1 ? GP(A.in[I_FB2 + F.z]) : GP(A.in[I_FB3 + F.z]))) + l * FHID;
                const float* ff = (stage == 0 ? GP(A.in[I_FF1 + F.z]) : (stage == 1 ? GP(A.in[I_FF2 + F.z]) : GP(A.in[I_FF3 + F.z]))) + l * FHID;
                const int nin = stage == 0 ? FEMB : FHID;
                typedef float f32x16_t __attribute__((ext_vector_type(16)));
                f32x16_t c0 = {}, c1 = {}, c2 = {}, c3 = {};
                LDS_WAIT();
#pragma unroll 1
                for (int i = 0; i < nin; ++i) { const float hv = hb[i * 64 + F.lane]; const f32x16_t* wr = (const f32x16_t*)(w + i * FHID);
                    c0 += wr[0] * hv; c1 += wr[1] * hv; c2 += wr[2] * hv; c3 += wr[3] * hv; }
                const f32x16_t* b16 = (const f32x16_t*)bb; const f32x16_t* f16 = (const f32x16_t*)ff;
                c0 = (c0 + b16[0]) * f16[0]; c1 = (c1 + b16[1]) * f16[1]; c2 = (c2 + b16[2]) * f16[2]; c3 = (c3 + b16[3]) * f16[3];
                if (stage < 2) {
#pragma unroll
                    for (int e = 0; e < 16; ++e) { hb[e * 64 + F.lane] = sinf(c0[e]); hb[(16 + e) * 64 + F.lane] = sinf(c1[e]); hb[(32 + e) * 64 + F.lane] = sinf(c2[e]); hb[(48 + e) * 64 + F.lane] = sinf(c3[e]); }
                } else {
                    GAS v4u* o = (GAS v4u*)(h3b + ((size_t)l * SEQ + t) * KPAD);
#pragma unroll
                    for (int q = 0; q < 2; ++q) { v4u w; w.x = pk2(sinf(c0[8 * q]), sinf(c0[8 * q + 1])); w.y = pk2(sinf(c0[8 * q + 2]), sinf(c0[8 * q + 3])); w.z = pk2(sinf(c0[8 * q + 4]), sinf(c0[8 * q + 5])); w.w = pk2(sinf(c0[8 * q + 6]), sinf(c0[8 * q + 7])); o[q] = w; }
#pragma unroll
                    for (int q = 0; q < 2; ++q) { v4u w; w.x = pk2(sinf(c1[8 * q]), sinf(c1[8 * q + 1])); w.y = pk2(sinf(c1[8 * q + 2]), sinf(c1[8 * q + 3])); w.z = pk2(sinf(c1[8 * q + 4]), sinf(c1[8 * q + 5])); w.w = pk2(sinf(c1[8 * q + 6]), sinf(c1[8 * q + 7])); o[2 + q] = w; }
#pragma unroll
                    for (int q = 0; q < 2; ++q) { v4u w; w.x = pk2(sinf(c2[8 * q]), sinf(c2[8 * q + 1])); w.y = pk2(sinf(c2[8 * q + 2]), sinf(c2[8 * q + 3])); w.z = pk2(sinf(c2[8 * q + 4]), sinf(c2[8 * q + 5])); w.w = pk2(sinf(c2[8 * q + 6]), sinf(c2[8 * q + 7])); o[4 + q] = w; }
#pragma unroll
                    for (int q = 0; q < 2; ++q) { v4u w; w.x = pk2(sinf(c3[8 * q]), sinf(c3[8 * q + 1])); w.y = pk2(sinf(c3[8 * q + 2]), sinf(c3[8 * q + 3])); w.z = pk2(sinf(c3[8 * q + 4]), sinf(c3[8 * q + 5])); w.w = pk2(sinf(c3[8 * q + 6]), sinf(c3[8 * q + 7])); o[6 + q] = w; }
#pragma unroll 1
                    for (int q = 8; q < 32; ++q) o[q] = (v4u){0u, 0u, 0u, 0u};
                }
            }
        }
    }
}
template <bool XSB>
__device__ __forceinline__ void norm_pass(Frame& F, const void* x_src, const bf16* add, const float* g_add, bf16* xb_dst, float* xf_dst, const float* g_out, bf16* h_dst) {
    const int gw = F.vcu * NWAVES + F.wave, NGW = F.G * NWAVES;
#define UNPK(q, lo, hi) do { lo = (f32x4){__uint_as_float((q).x << 16), __uint_as_float((q).x & 0xffff0000u), __uint_as_float((q).y << 16), __uint_as_float((q).y & 0xffff0000u)}; \
                             hi = (f32x4){__uint_as_float((q).z << 16), __uint_as_float((q).z & 0xffff0000u), __uint_as_float((q).w << 16), __uint_as_float((q).w & 0xffff0000u)}; } while (0)
#define PK8(lo, hi) (v4u){pk2((lo)[0], (lo)[1]), pk2((lo)[2], (lo)[3]), pk2((hi)[0], (hi)[1]), pk2((hi)[2], (hi)[3])}
    f32x4 gA[8], gO[8];
#pragma unroll
    for (int j = 0; j < 8; ++j) { gA[j] = (f32x4){0.f, 0.f, 0.f, 0.f}; gO[j] = (f32x4){0.f, 0.f, 0.f, 0.f}; }
    if (add) { const GAS f32x4* gr = (const GAS f32x4*)g_add + 2 * F.lane;
#pragma unroll
        for (int j = 0; j < 4; ++j) { gA[2 * j] = gr[128 * j]; gA[2 * j + 1] = gr[128 * j + 1]; } }
    if (h_dst) { const GAS f32x4* gr = (const GAS f32x4*)g_out + 2 * F.lane;
#pragma unroll
        for (int j = 0; j < 4; ++j) { gO[2 * j] = gr[128 * j]; gO[2 * j + 1] = gr[128 * j + 1]; } }
    v4u rq[4], rw[4]; f32x4 rf[8];
#pragma unroll
    for (int j = 0; j < 4; ++j) { rq[j] = (v4u){0u, 0u, 0u, 0u}; rw[j] = (v4u){0u, 0u, 0u, 0u}; }
#define NP_FETCH(m) do { \
        if (XSB) { const GAS v4u* xa_ = (const GAS v4u*)((const bf16*)x_src + (size_t)(m) * DM) + F.lane; _Pragma("unroll") for (int j = 0; j < 4; ++j) rq[j] = __builtin_nontemporal_load(xa_ + 64 * j); } \
        else { const GAS f32x4* xa_ = (const GAS f32x4*)((const float*)x_src + (size_t)(m) * DM) + 2 * F.lane; _Pragma("unroll") for (int j = 0; j < 4; ++j) { rf[2 * j] = __builtin_nontemporal_load(xa_ + 128 * j); rf[2 * j + 1] = __builtin_nontemporal_load(xa_ + 128 * j + 1); } } \
        if (add) { const GAS v4u* aa_ = (const GAS v4u*)(add + (size_t)(m) * DM) + F.lane; _Pragma("unroll") for (int j = 0; j < 4; ++j) rw[j] = __builtin_nontemporal_load(aa_ + 64 * j); } } while (0)
    if (gw < MG) NP_FETCH(gw);
    for (int m0 = gw; m0 < MG; m0 += NGW) {
        f32x4 va[8]; v4u wa[4];
        if (XSB) {
#pragma unroll
            for (int j = 0; j < 4; ++j) UNPK(rq[j], va[2 * j], va[2 * j + 1]);
        } else {
#pragma unroll
            for (int j = 0; j < 8; ++j) va[j] = rf[j];
        }
#pragma unroll
        for (int j = 0; j < 4; ++j) wa[j] = rw[j];
        if (m0 + NGW < MG) NP_FETCH(m0 + NGW);
        if (add) {
            float sa = 0.f;
#pragma unroll
            for (int j = 0; j < 4; ++j) { f32x4 a0, a1; UNPK(wa[j], a0, a1);
                sa += ((a0[0] * a0[0] + a0[1] * a0[1]) + (a0[2] * a0[2] + a0[3] * a0[3])) + ((a1[0] * a1[0] + a1[1] * a1[1]) + (a1[2] * a1[2] + a1[3] * a1[3])); }
            const float ra = 1.0f / sqrtf(wave_sum(sa) * (1.0f / DM) + EPS);
#pragma unroll
            for (int j = 0; j < 4; ++j) { f32x4 a0, a1; UNPK(wa[j], a0, a1);
                va[2 * j] = va[2 * j] + a0 * ra * gA[2 * j]; va[2 * j + 1] = va[2 * j + 1] + a1 * ra * gA[2 * j + 1]; }
        }
        if (xf_dst) { GAS f32x4* oa = (GAS f32x4*)(xf_dst + (size_t)m0 * DM) + 2 * F.lane;
#pragma unroll
            for (int j = 0; j < 4; ++j) { oa[128 * j] = va[2 * j]; oa[128 * j + 1] = va[2 * j + 1]; } }
        if (xb_dst) { GAS v4u* oa = (GAS v4u*)(xb_dst + (size_t)m0 * DM) + F.lane;
#pragma unroll
            for (int j = 0; j < 4; ++j) { const v4u w = PK8(va[2 * j], va[2 * j + 1]); oa[64 * j] = w;
                UNPK(w, va[2 * j], va[2 * j + 1]); } }
        if (h_dst) {
            float sa = 0.f;
#pragma unroll
            for (int j = 0; j < 8; ++j) sa += (va[j][0] * va[j][0] + va[j][1] * va[j][1]) + (va[j][2] * va[j][2] + va[j][3] * va[j][3]);
            const float ra = 1.0f / sqrtf(wave_sum(sa) * (1.0f / DM) + EPS);
            GAS v4u* ha = (GAS v4u*)(h_dst + (size_t)m0 * DM) + F.lane;
#pragma unroll
            for (int j = 0; j < 4; ++j) { const f32x4 oa0 = va[2 * j] * ra * gO[2 * j], oa1 = va[2 * j + 1] * ra * gO[2 * j + 1]; ha[64 * j] = PK8(oa0, oa1); }
        }
    }
#undef NP_FETCH
#undef UNPK
#undef PK8
}
typedef LAS cf* lcf;
template <bool ZUP> __device__ __forceinline__ void hy_fwd(lcf X, lcf thi, lcf tlo, int tid, const unsigned* KM) {
    if (ZUP) hy_pass16<1024, false, true, false>(X, thi, tlo, tid); else hy_pass16<1024, false, false, false>(X, thi, tlo, tid);
    __syncthreads();
    hy_pass16<64, false, false, false>(X, thi, tlo, tid);
    hy_pass16<4, false, false, false>(X, thi, tlo, tid);
    hy_pass4<false>(X, tid, KM); __syncthreads();
}
__device__ __forceinline__ void hy_inv(lcf X, lcf thi, lcf tlo, int tid) {
    const unsigned* nul = nullptr;
    hy_pass4<true>(X, tid, nul); __syncthreads();
    hy_pass16<4, true, false, false>(X, thi, tlo, tid); __syncthreads();
    hy_pass16<64, true, false, false>(X, thi, tlo, tid); __syncthreads();
    hy_pass16<1024, true, false, true>(X, thi, tlo, tid); __syncthreads();
}
__device__ __forceinline__ void hy_mid(lcf X, lcf thi, lcf tlo, int tid, const unsigned* KM) {
    const unsigned* nul = nullptr;
    hy_pass16<64, false, false, false>(X, thi, tlo, tid);
    hy_pass16<4, false, false, false>(X, thi, tlo, tid);
    hy_pass4<false>(X, tid, KM);
    hy_pass4<true>(X, tid, nul);
    hy_pass16<4, true, false, false>(X, thi, tlo, tid);
    hy_pass16<64, true, false, false>(X, thi, tlo, tid); __syncthreads();
}
__device__ __forceinline__ void hyena_phase(Frame& F, const Args& A, int l) {
    lcf X = (lcf)(F.lds + RING_OFF); lcf thi = (lcf)(F.lds + TAB_OFF); lcf tlo = thi + 128;
    const int tid = F.tid;
    if (tid < 256) { const int a = tid & 127; const double ang = -6.283185307179586 * (double)(tid < 128 ? 128 * a : a) / (double)FN; float s, c; sincos_red(ang, s, c); (tid < 128 ? thi : tlo)[a] = cf{c, s}; }
    unsigned* K1g = (unsigned*)(F.ws + WS_FFTK) + (size_t)F.bx * 2 * FN; unsigned* K2g = K1g + FN;
    const bf16* taps = (const bf16*)(F.ws + ((A.taps_all && l > 0) ? WS_TAPS_X + (size_t)(l - 1) * SZ_TAPS : WS_TAPS));
    const float* cw = GP(A.in[I_CONVW + F.z]) + (size_t)l * 3 * HYIN; const float* cb = GP(A.in[I_CONVB + F.z]) + (size_t)l * HYIN; const float* hb = GP(A.in[I_HBIAS + F.z]) + (size_t)l * 2 * HYW;
    const bf16* projT = (const bf16*)(F.ws + WS_PROJT); bf16* zT = (bf16*)(F.ws + WS_ZT);
    for (int c = F.vcu; c < HYW; c += F.G) {
        __syncthreads();
        const float delta = fabsf(-15.350567286626973f + (float)c * ((-3.0701134573253945f + 15.350567286626973f) / 1023.0f));
#define TIDX(v) int v = tid; asm volatile("" : "+v"(v))
        { TIDX(t_); hy_filter_step(X, taps + (size_t)c * SEQ, delta, t_); }
        const unsigned* rx1 = (const unsigned*)(projT + (size_t)c * MG); const unsigned* rx2 = (const unsigned*)(projT + (size_t)(HYW + c) * MG); const unsigned* rv = (const unsigned*)(projT + (size_t)(2 * HYW + c) * MG);
        HyRaw R;
        { TIDX(t_); hy_raw_load(R, rv, rv + SEQ / 2, t_); }
        __syncthreads();
        { TIDX(t_); hy_fwd<false>(X, thi, tlo, t_, nullptr); }
        { TIDX(t_); hy_sep_step(X, K1g, K2g, t_); }
        asm volatile("s_waitcnt vmcnt(0)" ::: "memory"); __syncthreads();
        cf zr[2][8];
        { TIDX(t_); hy_convA_fwd(X, thi, tlo, t_, R, cw[2 * HYW + c], cw[HYIN + 2 * HYW + c], cw[2 * HYIN + 2 * HYW + c], cb[2 * HYW + c], zr); }
        { TIDX(t_); hy_raw_load(R, rx1, rx1 + SEQ / 2, t_); }
        __syncthreads();
        { TIDX(t_); hy_mid(X, thi, tlo, t_, K1g); }
        { TIDX(t_); hy_gateA<false>(X, thi, tlo, t_, R, cw[c], cw[HYIN + c], cw[2 * HYIN + c], cb[c], hb[c], zr, (unsigned short*)nullptr, (unsigned short*)nullptr); }
        { TIDX(t_); hy_raw_load(R, rx2, rx2 + SEQ / 2, t_); }
        __syncthreads();
        { TIDX(t_); hy_mid(X, thi, tlo, t_, K2g); }
        unsigned short* zo = (unsigned short*)(zT + (size_t)c * MG);
        { TIDX(t_); hy_gateA<true>(X, thi, tlo, t_, R, cw[HYW + c], cw[HYIN + HYW + c], cw[2 * HYIN + HYW + c], cb[HYW + c], hb[HYW + c], zr, zo, zo + SEQ); }
#undef TIDX
    }
    __syncthreads();
}
__device__ __forceinline__ void hynorm_phase(Frame& F, const Args& A, int l) {
    constexpr int TB = 64;
    LAS unsigned char* tile = F.lds + RING_OFF; LAS float* red = (LAS float*)(F.lds + RING_OFF + TB * HYW * 2); LAS float* rinv = red + 8 * TB;
    const bf16* zT = (const bf16*)(F.ws + WS_ZT); bf16* mixin = (bf16*)(F.ws + WS_MIXIN); const float* gn = GP(A.in[I_HNORM + F.z]) + (size_t)l * HYW;
    const int tid = F.tid;
    for (int tb = F.vcu; tb < MG / TB; tb += F.G) {
        const int t0 = tb * TB; __syncthreads();
        float ps[8];
#pragma unroll
        for (int i = 0; i < 8; ++i) ps[i] = 0.f;
        const int k = tid & 7, crow = tid >> 3;
#pragma unroll
        for (int hb = 0; hb < 2; ++hb) {
            v4u w[8];
#pragma unroll
            for (int it = 0; it < 8; ++it) { const unsigned c = (unsigned)((hb * 8 + it) * 64 + crow) & 1023u; w[it] = __builtin_nontemporal_load((const GAS v4u*)(zT + (size_t)c * MG + (unsigned)(t0 + 8 * k))); }
#pragma unroll
            for (int it = 0; it < 8; ++it) { const int c = (hb * 8 + it) * 64 + crow;
                LAS unsigned short* d = (LAS unsigned short*)(tile + (8 * k) * 2048 + (((c >> 3) ^ k) << 4) + (c & 7) * 2);
                const unsigned ww[4] = {w[it].x, w[it].y, w[it].z, w[it].w};
#pragma unroll
                for (int i = 0; i < 4; ++i) { d[(2 * i) * 1024] = (unsigned short)(ww[i] & 0xffffu); d[(2 * i + 1) * 1024] = (unsigned short)(ww[i] >> 16);
                    const float a = __uint_as_float(ww[i] << 16), b = __uint_as_float(ww[i] & 0xffff0000u); ps[2 * i] += a * a; ps[2 * i + 1] += b * b; } }
        }
#pragma unroll
        for (int i = 0; i < 8; ++i) { float v = ps[i]; v += swz_xor<8>(v); v += swz_xor<16>(v);
            auto rr = __builtin_amdgcn_permlane32_swap(__float_as_uint(v), __float_as_uint(v), false, false); ps[i] = __uint_as_float(rr[0]) + __uint_as_float(rr[1]); }
        if ((F.lane >> 3) == 0) {
#pragma unroll
            for (int i = 0; i < 8; ++i) red[F.wave * TB + 8 * k + i] = ps[i]; }
        __syncthreads();
        if (tid < TB) { float s = 0.f;
#pragma unroll
            for (int w8 = 0; w8 < 8; ++w8) s += red[w8 * TB + tid];
            rinv[tid] = 1.0f / sqrtf(s * (1.0f / HYW) + EPS); }
        __syncthreads();
        const int cg = tid & 127;
        const f32x4 g0 = *(const f32x4*)(gn + 8 * cg), g1 = *(const f32x4*)(gn + 8 * cg + 4);
#pragma unroll 4
        for (int it = 0; it < 16; ++it) { const int tok = it * 4 + (tid >> 7); const float r = rinv[tok];
            const v4u q = *(const LAS v4u*)(tile + tok * 2048 + ((cg ^ (tok >> 3)) << 4));
            v4u o; o.x = pk2(__uint_as_float(q.x << 16) * r * g0[0], __uint_as_float(q.x & 0xffff0000u) * r * g0[1]); o.y = pk2(__uint_as_float(q.y << 16) * r * g0[2], __uint_as_float(q.y & 0xffff0000u) * r * g0[3]);
            o.z = pk2(__uint_as_float(q.z << 16) * r * g1[0], __uint_as_float(q.z & 0xffff0000u) * r * g1[1]); o.w = pk2(__uint_as_float(q.w << 16) * r * g1[2], __uint_as_float(q.w & 0xffff0000u) * r * g1[3]);
            *(GAS v4u*)(mixin + (size_t)(t0 + tok) * DM + 8 * cg) = o; }
    }
    __syncthreads();
}
__device__ __forceinline__ void attn_phase(Frame& F, const Args& A, int l, unsigned char* lds_generic) {
    const float li = 0.8f - 0.6f * expf(-0.3f * (float)l);
    float lam;
    { const int j = F.lane; const float a = GP(A.in[I_LQ1 + F.z])[l * 64 + j] * GP(A.in[I_LK1 + F.z])[l * 64 + j], b = GP(A.in[I_LQ2 + F.z])[l * 64 + j] * GP(A.in[I_LK2 + F.z])[l * 64 + j];
      lam = expf(wave_sum(a)) - expf(wave_sum(b)) + li; }
    const att::bf16* qkv = (const att::bf16*)(F.ws + WS_QKV); att::bf16* mixin = (att::bf16*)(F.ws + WS_MIXIN);
    float* stash = (float*)(F.ws + WS_H) + (size_t)F.bx * 64 * 512;
    const float* subln = GP(A.in[I_SUBLN + F.z]) + (size_t)l * 128;
    constexpr int NU = GSEQ * 8 * (SEQ / 256);
    for (int u = F.vcu; u < NU; u += F.G) {
        const int bvh = u >> 5, qb = u & 31, b = bvh >> 3, vh = bvh & 7;
        const long krow0 = (long)b * SEQ, qrow0 = krow0 + qb * 256;
        att::attn_unit(qkv, qrow0, krow0, vh, SEQ, lam, 1.0f - li, subln, mixin + (size_t)qrow0 * DM + HYW + vh * 128, DM, stash, (char*)lds_generic);
        __syncthreads();
    }
}
#ifndef PHMASK
#define PHMASK 511
#endif
__global__ void __launch_bounds__(NTHR, 2) hymba_fwd(Args args) {
    extern __shared__ __attribute__((aligned(16))) unsigned char lds[];
    Frame F;
    F.lds = (LAS unsigned char*)lds; F.MISC = (volatile LAS unsigned*)(F.lds + MISC_OFF);
    F.tid = threadIdx.x; F.lane = F.tid & 63; F.wave = __builtin_amdgcn_readfirstlane(F.tid >> 6);
    F.G = gridDim.x; { const int bx = blockIdx.x; F.vcu = (F.G % 8 == 0) ? (bx % 8) * (F.G / 8) + bx / 8 : bx; F.bx = bx; }
    F.vcu0 = F.vcu; F.G0 = F.G; F.bx0 = F.bx;
    F.ctl = (gu32*)(args.ws + WS_CTL); F.out = args.out; F.ws = args.ws; F.ws0 = args.ws; F.z = 0;
    for (int u = F.tid; u < (LDS_BYTES - MISC_OFF) / 4; u += NTHR) ((LAS unsigned*)(F.lds + MISC_OFF))[u] = 0u;
    __syncthreads();
    XcdBarrier bar; bar.bar = (unsigned*)(F.ctl + CW_BAR); bar.x = 0; bar.st = nullptr;
    if (!MK_PER_PHASE) bar = xcd_barrier_post((unsigned*)(F.ctl + CW_BAR), F.MISC + 8);
    const int lo = args.ph_lo, hi = args.ph_hi;
    int ph = 0;
#define IN_() (lo <= ph && ph < hi && ({ LAUNDER_TID(F); true; }))
#define DUP3(...) do { __VA_ARGS__; if (PROBE_DUP == 3) { __VA_ARGS__; } } while (0)
#define SEAM() do { if (!MK_PER_PHASE && lo <= ph && ph + 1 < hi) { XcdBarrier b_ = bar; { unsigned long long p_ = (unsigned long long)b_.bar; unsigned x_ = b_.x; asm volatile("" : "+s"(p_), "+s"(x_)); b_.bar = (unsigned*)(GAS unsigned*)p_; b_.x = x_; } \
        xcd_barrier(b_); if (PROBE_DUP == 7) xcd_barrier(b_); } ++ph; } while (0)
    if ((PHMASK & 1) && IN_()) { p0_prologue(F, args); if (PROBE_DUP == 4) p0_prologue(F, args); }
    SEAM();
#define Hb ((bf16*)(F.ws + WS_H))
#define XB ((bf16*)(F.ws + WS_XB))
#define projT ((bf16*)(F.ws + WS_PROJT))
#define qkv ((bf16*)(F.ws + WS_QKV))
#define mix ((bf16*)(F.ws + WS_MIX))
#define ffh ((bf16*)(F.ws + WS_FFH))
#define mixin ((bf16*)(F.ws + WS_MIXIN))
#define wl (F.ws + WS_W + (size_t)l * SZ_WLAYER)
#define xin ((g == 0) ? GP(args.in[I_XP + F.z]) : GP(args.in[I_XS + F.z]) + (size_t)(g - 1) * MG * DM)
#define xres ((float*)(GAS float*)args.out + (size_t)g * MG * DM)
    for (int g = 0; g < NGRP; ++g) {
        if ((PHMASK & 2) && IN_()) norm_pass<false>(F, xin, nullptr, nullptr, nullptr, nullptr, GP(args.in[I_GMPRE + F.z]), Hb);
        SEAM();
        for (int l = 0; l < DEPTH; ++l) {
            if ((PHMASK & 4) && IN_()) {
                { pg8::Gemm gm{(const bf16*)(wl + OFF_WHY), Hb, HYIN, MG, DM}; pg8::StaticOrder S; S.init(HYIN, MG, F.G, F.bx);
                  pg8::EpiPlain E{projT, MG};
                  DUP3(pg8::gemm_phase<pg8::EpiPlain, pg8::StaticOrder, true, true>(F.lds + RING_OFF, gm, S, E)); }
                if (g == 0 || !args.taps_all) { pg8::Gemm gm{(const bf16*)(F.ws + WS_W4T) + (size_t)l * 4096 * KPAD, (const bf16*)(F.ws + WS_H3) + (size_t)l * SEQ * KPAD, 4096, SEQ, KPAD}; pg8::StaticOrder S; S.init(4096, SEQ, F.G, F.bx);
                  pg8::EpiPlain E{(bf16*)(F.ws + ((args.taps_all && l > 0) ? WS_TAPS_X + (size_t)(l - 1) * SZ_TAPS : WS_TAPS)), SEQ};
                  DUP3(pg8::gemm_phase<pg8::EpiPlain, pg8::StaticOrder, true, true>(F.lds + RING_OFF, gm, S, E)); }
                { pg8::Gemm gm{Hb, (const bf16*)(wl + OFF_WQKV), MG, QKVW, DM}; pg8::StaticOrder S; S.init(MG, QKVW, F.G, F.bx);
                  pg8::EpiRope E{qkv, QKVW, (const float*)(F.ws + WS_ROPE), QSCALE};
                  DUP3(pg8::gemm_phase<pg8::EpiRope, pg8::StaticOrder, true, true>(F.lds + RING_OFF, gm, S, E)); }
            }
            SEAM();
            if (IN_()) { if (PHMASK & 8) hyena_phase(F, args, l); if (PROBE_DUP == 2) hyena_phase(F, args, l); if (PHMASK & 16) attn_phase(F, args, l, lds); if (PROBE_DUP == 1) attn_phase(F, args, l, lds); }
            SEAM();
            if ((PHMASK & 32) && IN_()) { hynorm_phase(F, args, l); if (PROBE_DUP == 4) hynorm_phase(F, args, l); }
            SEAM();
            if ((PHMASK & 64) && IN_()) { pg8::Gemm gm{mixin, (const bf16*)(wl + OFF_WOUT), MG, DM, DM}; pg8::StaticOrder S; S.init(MG, DM, F.G, F.bx);
                pg8::EpiPlain E{mix, DM};
                DUP3(pg8::gemm_phase<pg8::EpiPlain, pg8::StaticOrder, true, true>(F.lds + RING_OFF, gm, S, E)); }
            SEAM();
            if ((PHMASK & 2) && IN_()) { if (l == 0) norm_pass<false>(F, xin, mix, GP(args.in[I_GMPOST + F.z]) + (size_t)l * DM, XB, nullptr, GP(args.in[I_GFPRE + F.z]) + (size_t)l * DM, Hb);
                else norm_pass<true>(F, XB, mix, GP(args.in[I_GMPOST + F.z]) + (size_t)l * DM, XB, nullptr, GP(args.in[I_GFPRE + F.z]) + (size_t)l * DM, Hb); }
            SEAM();
            if ((PHMASK & 128) && IN_()) { pg8::Gemm gm{Hb, (const bf16*)(wl + OFF_WGU), MG, GU, DM}; pg8::StaticOrder S; S.init(MG, GU, F.G, F.bx);
                pg8::EpiSwiGLU E{ffh, DFF};
                DUP3(pg8::gemm_phase<pg8::EpiSwiGLU, pg8::StaticOrder, true, true>(F.lds + RING_OFF, gm, S, E)); }
            SEAM();
            if ((PHMASK & 256) && IN_()) { pg8::Gemm gm{ffh, (const bf16*)(wl + OFF_WDN), MG, DM, DFF}; pg8::StaticOrder S; S.init(MG, DM, F.G, F.bx);
                pg8::EpiPlain E{mixin, DM};
                DUP3(pg8::gemm_phase<pg8::EpiPlain, pg8::StaticOrder, true, true>(F.lds + RING_OFF, gm, S, E)); }
            SEAM();
            if ((PHMASK & 2) && IN_()) { if (l + 1 < DEPTH) norm_pass<true>(F, XB, mixin, GP(args.in[I_GFPOST + F.z]) + (size_t)l * DM, XB, nullptr, GP(args.in[I_GMPRE + F.z]) + (size_t)(l + 1) * DM, Hb);
                else norm_pass<true>(F, XB, mixin, GP(args.in[I_GFPOST + F.z]) + (size_t)l * DM, nullptr, xres, nullptr, nullptr); }
            SEAM();
        }
    }
#undef IN_
#undef SEAM
#undef Hb
#undef XB
#undef projT
#undef qkv
#undef mix
#undef ffh
#undef mixin
#undef wl
#undef xin
#undef xres
}

extern "C" void kernel_launch(void* const* d_in, const int* in_sizes, int n_in, void* d_out, int out_size, void* d_ws, size_t ws_size, hipStream_t stream) {
    static int grid = 0;
    if (grid == 0) {
        if (n_in != 30 || in_sizes[0] != 2 * SEQ * DM || in_sizes[1] != 4 * SEQ * DM || out_size != NSEQ * SEQ * DM || ws_size < WS_END) {
            fprintf(stderr, "kernel_launch: shape mismatch (n_in %d, out %d, ws %zu, need %zu)\n", n_in, out_size, ws_size, (size_t)WS_END); grid = -1; return; }
        int dev = 0, cus = 0;
        if (hipGetDevice(&dev) != hipSuccess || hipDeviceGetAttribute(&cus, hipDeviceAttributeMultiprocessorCount, dev) != hipSuccess) { grid = -1; return; }
        if (hipFuncSetAttribute((const void*)hymba_fwd, hipFuncAttributeMaxDynamicSharedMemorySize, LDS_BYTES) != hipSuccess) { fprintf(stderr, "kernel_launch: hipFuncSetAttribute failed\n"); grid = -1; return; }
        int per_cu = 0;
        if (hipOccupancyMaxActiveBlocksPerMultiprocessor(&per_cu, (const void*)hymba_fwd, NTHR, LDS_BYTES) != hipSuccess || per_cu < 1) fprintf(stderr, "kernel_launch: occupancy query says %d\n", per_cu);
        (void)hipGetLastError();
        grid = cus;
    }
    if (grid < 0) return;
    if (hipMemsetAsync((char*)d_ws + WS_CTL, 0, CTL_ZERO_BYTES, stream) != hipSuccess) return;
    Args a{};
    for (int i = 0; i < 30; ++i) a.in[i] = (const float*)d_in[i];
    a.out = (float*)d_out; a.ws = (unsigned char*)d_ws; a.taps_all = (ws_size >= WS_END_X) ? 1 : 0;
#if MK_PER_PHASE
    for (int p = 0; p < NPHASE; ++p) { a.ph_lo = p; a.ph_hi = p + 1; hipLaunchKernelGGL(hymba_fwd, dim3(grid), dim3(NTHR), LDS_BYTES, stream, a); }
#else
    a.ph_lo = 0; a.ph_hi = NPHASE;
    hipLaunchKernelGGL(hymba_fwd, dim3(grid), dim3(NTHR), LDS_BYTES, stream, a);
#endif
    const hipError_t le = hipPeekAtLastError();
    if (le != hipSuccess) fprintf(stderr, "kernel_launch: launch failed: %s\n", hipGetErrorName(le));
}
```
